# Optimizing an MI355X kernel written in HIP

```python
import math
import jax, jax.numpy as jnp
from jax import lax
import numpy as np

D_MODEL = 2048
BATCH = 2
SEQ = 4096
DEPTH = 1

A_HEADS = 16
A_KV_HEADS = 4
A_HEAD_DIM = 64
WINDOW = 128
A_BLOCK = 128
B_HEADS = 8
B_Q_RANK = 512
B_KV_RANK = 256
B_NOPE_DIM = 128
B_ROPE_DIM = 64
B_V_DIM = 128
B_BLOCK = 128
ROPE_THETA = 10000.0
A_WIDTH = A_HEADS * A_HEAD_DIM
B_WIDTH = B_HEADS * B_V_DIM
MIX_WIDTH = A_WIDTH + B_WIDTH
A_KV_COLS = A_KV_HEADS * A_HEAD_DIM
IN_COL_SIZES = (A_WIDTH, A_KV_COLS, A_KV_COLS, B_Q_RANK, B_KV_RANK, B_ROPE_DIM)
IN_COLS = sum(IN_COL_SIZES)
IN_SPLITS = [sum(IN_COL_SIZES[:i + 1]) for i in range(len(IN_COL_SIZES) - 1)]
N_EXPERTS = 32
TOP_K = 4
D_FF = 2048
SWIGLU_ALPHA = 1.702
SWIGLU_LIMIT = 7.0
MOE_BLOCK = 128
EPS = 1e-5

kernel_name = "hybrid_swa_mla_moe_encoder"


def rmsnorm(x, g):
    xf = x.astype(jnp.float32)
    y = xf * lax.rsqrt(jnp.mean(xf * xf, axis=-1, keepdims=True) + EPS)
    return (y * g.astype(jnp.float32)).astype(x.dtype)


def alibi_slopes(n):
    return jnp.power(2.0, -8.0 * jnp.arange(1, n + 1, dtype=jnp.float32) / n)


def window_gqa_sink(q, k, v, sink):
    b, s, hq, dh = q.shape
    hkv = k.shape[2]
    g = hq // hkv
    nb = s // A_BLOCK
    qb = q.reshape(b, nb, A_BLOCK, hkv, g, dh)

    def band(t):
        tb = t.reshape(b, nb, A_BLOCK, hkv, dh)
        tp = jnp.pad(tb, ((0, 0), (1, 1), (0, 0), (0, 0), (0, 0)))
        return jnp.concatenate([tp[:, :-2], tp[:, 1:-1], tp[:, 2:]], axis=2)

    kb, vb = band(k), band(v)
    scores = jnp.einsum('bnqhgd,bnkhd->bnhgqk', qb, kb).astype(jnp.float32) * (dh ** -0.5)
    qi = jnp.arange(A_BLOCK)[:, None]
    kj = jnp.arange(3 * A_BLOCK)[None, :]
    dist = qi + A_BLOCK - kj
    kpos = jnp.arange(nb)[:, None, None] * A_BLOCK - A_BLOCK + kj[None]
    valid = (jnp.abs(dist)[None] <= WINDOW) & (kpos >= 0) & (kpos < s)
    slopes = alibi_slopes(hq).reshape(hkv, g)
    bias = -slopes[:, :, None, None] * jnp.abs(dist).astype(jnp.float32)
    scores = jnp.where(valid[None, :, None, None], scores + bias, -jnp.inf)
    sink_l = sink.astype(jnp.float32).reshape(hkv, g)[None, None, :, :, None, None]
    m = jnp.maximum(jnp.max(scores, axis=-1, keepdims=True), sink_l)
    p = jnp.exp(scores - m)
    p = p / (jnp.sum(p, axis=-1, keepdims=True) + jnp.exp(sink_l - m))
    out = jnp.einsum('bnhgqk,bnkhd->bnqhgd', p.astype(v.dtype), vb)
    return out.reshape(b, s, hq * dh)


def rotate(x, cos, sin):
    x1, x2 = jnp.split(x, 2, axis=-1)
    return jnp.concatenate([x1 * cos - x2 * sin, x1 * sin + x2 * cos], axis=-1)


def mla(c_q, c_kv, k_pe, q_norm, w_uq, kv_norm, w_ukv):
    b, s, _ = c_q.shape
    q = (rmsnorm(c_q, q_norm) @ w_uq).reshape(b, s, B_HEADS, B_NOPE_DIM + B_ROPE_DIM)
    q_nope, q_pe = q[..., :B_NOPE_DIM], q[..., B_NOPE_DIM:]
    kv = (rmsnorm(c_kv, kv_norm) @ w_ukv).reshape(b, s, B_HEADS, B_NOPE_DIM + B_V_DIM)
    k_nope, v = kv[..., :B_NOPE_DIM], kv[..., B_NOPE_DIM:]
    pos = jnp.arange(s, dtype=jnp.float32)
    inv_freq = jnp.power(ROPE_THETA, -jnp.arange(0, B_ROPE_DIM, 2, dtype=jnp.float32) / B_ROPE_DIM)
    ang = pos[:, None] * inv_freq[None, :]
    cos, sin = jnp.cos(ang).astype(q.dtype), jnp.sin(ang).astype(q.dtype)
    q_pe = rotate(q_pe, cos[None, :, None], sin[None, :, None])
    k_pe = rotate(k_pe, cos[None], sin[None])
    scale = (B_NOPE_DIM + B_ROPE_DIM) ** -0.5
    nb = s // B_BLOCK
    qn_b = q_nope.reshape(b, nb, B_BLOCK, B_HEADS, B_NOPE_DIM).transpose(1, 0, 2, 3, 4)
    qp_b = q_pe.reshape(b, nb, B_BLOCK, B_HEADS, B_ROPE_DIM).transpose(1, 0, 2, 3, 4)

    def attend(args):
        qn, qp = args
        sc = (jnp.einsum('bqhd,bkhd->bhqk', qn, k_nope)
              + jnp.einsum('bqhd,bkd->bhqk', qp, k_pe)).astype(jnp.float32) * scale
        p = jax.nn.softmax(sc, axis=-1)
        return jnp.einsum('bhqk,bkhd->bqhd', p.astype(v.dtype), v)

    out = lax.map(attend, (qn_b, qp_b))
    return out.transpose(1, 0, 2, 3, 4).reshape(b, s, B_HEADS * B_V_DIM)


def moe(x, w_router, b_router, w_up, b_up, w_down, b_down):
    b, s, d = x.shape
    t = b * s
    xt = x.reshape(t, d)
    logits = (xt @ w_router + b_router).astype(jnp.float32)
    top_vals, top_idx = lax.top_k(logits, TOP_K)
    gates = jax.nn.softmax(top_vals, axis=-1)
    a = t * TOP_K
    e_flat = top_idx.reshape(a)
    tok_flat = jnp.arange(a, dtype=jnp.int32) // TOP_K
    g_flat = gates.reshape(a)
    order = jnp.argsort(e_flat)
    e_sorted = e_flat[order]
    counts = jnp.bincount(e_flat, length=N_EXPERTS)
    starts = jnp.cumsum(counts) - counts
    padded = (counts + MOE_BLOCK - 1) // MOE_BLOCK * MOE_BLOCK
    pad_ends = jnp.cumsum(padded)
    pad_starts = pad_ends - padded
    rank = jnp.arange(a) - starts[e_sorted]
    dest = pad_starts[e_sorted] + rank
    n_blocks = (a + N_EXPERTS * (MOE_BLOCK - 1) + MOE_BLOCK - 1) // MOE_BLOCK
    n_slots = n_blocks * MOE_BLOCK
    slot_tok = jnp.zeros((n_slots,), jnp.int32).at[dest].set(tok_flat[order])
    slot_gate = jnp.zeros((n_slots,), jnp.float32).at[dest].set(g_flat[order])
    block_expert = jnp.minimum(
        jnp.searchsorted(pad_ends, jnp.arange(n_blocks) * MOE_BLOCK, side='right'), N_EXPERTS - 1)
    tok_blocks = slot_tok.reshape(n_blocks, MOE_BLOCK)

    def expert_block(args):
        e, tok = args
        h = xt[tok] @ w_up[e] + b_up[e]
        gate = jnp.minimum(h[:, :D_FF], SWIGLU_LIMIT)
        up = jnp.clip(h[:, D_FF:], -SWIGLU_LIMIT, SWIGLU_LIMIT)
        glu = gate * jax.nn.sigmoid(gate * SWIGLU_ALPHA)
        return ((up + 1.0) * glu) @ w_down[e] + b_down[e]

    y = lax.map(expert_block, (block_expert, tok_blocks)).reshape(n_slots, d)
    y = y * slot_gate[:, None].astype(y.dtype)
    out = jax.ops.segment_sum(y, slot_tok, num_segments=t)
    return out.reshape(b, s, d)


def _dense(key, shape, fan_in):
    return jax.random.normal(key, shape, jnp.float32) * (fan_in ** -0.5)


def _gain(key, shape):
    return 1.0 + 0.02 * jax.random.normal(key, shape, jnp.float32)


def setup_inputs(seed: int = 0) -> dict:
    key = jax.random.key(seed)
    ks = jax.random.split(key, 20)
    L = DEPTH
    return {
        "x": jax.random.normal(ks[0], (BATCH, SEQ, D_MODEL), jnp.float32),
        "attn_norm": _gain(ks[1], (L, D_MODEL)),
        "w_in": _dense(ks[2], (L, D_MODEL, IN_COLS), D_MODEL),
        "a_sink": 0.5 * jax.random.normal(ks[3], (L, A_HEADS), jnp.float32),
        "b_q_norm": _gain(ks[4], (L, B_Q_RANK)),
        "b_w_uq": _dense(ks[5], (L, B_Q_RANK, B_HEADS * (B_NOPE_DIM + B_ROPE_DIM)), B_Q_RANK),
        "b_kv_norm": _gain(ks[6], (L, B_KV_RANK)),
        "b_w_ukv": _dense(ks[7], (L, B_KV_RANK, B_HEADS * (B_NOPE_DIM + B_V_DIM)), B_KV_RANK),
        "out_norm_a": _gain(ks[8], (L, A_WIDTH)),
        "out_norm_b": _gain(ks[9], (L, B_WIDTH)),
        "w_o": _dense(ks[10], (L, MIX_WIDTH, D_MODEL), MIX_WIDTH),
        "mlp_norm": _gain(ks[11], (L, D_MODEL)),
        "w_router": _dense(ks[12], (L, D_MODEL, N_EXPERTS), D_MODEL),
        "b_router": 0.01 * jax.random.normal(ks[13], (L, N_EXPERTS), jnp.float32),
        "w_up": _dense(ks[14], (L, N_EXPERTS, D_MODEL, 2 * D_FF), D_MODEL),
        "b_up": 0.01 * jax.random.normal(ks[15], (L, N_EXPERTS, 2 * D_FF), jnp.float32),
        "w_down": _dense(ks[16], (L, N_EXPERTS, D_FF, D_MODEL), D_FF),
        "b_down": 0.01 * jax.random.normal(ks[17], (L, N_EXPERTS, D_MODEL), jnp.float32),
        "final_norm": _gain(ks[18], (D_MODEL,)),
    }


def reference(x, attn_norm, w_in, a_sink, b_q_norm, b_w_uq, b_kv_norm, b_w_ukv, out_norm_a,
              out_norm_b, w_o, mlp_norm, w_router, b_router, w_up, b_up, w_down, b_down,
              final_norm):
    b, s, _ = x.shape
    for l in range(DEPTH):
        xn = rmsnorm(x, attn_norm[l])
        proj = xn @ w_in[l]
        a_q, a_k, a_v, b_cq, b_ckv, b_kpe = jnp.split(proj, IN_SPLITS, axis=-1)
        y_a = window_gqa_sink(a_q.reshape(b, s, A_HEADS, A_HEAD_DIM),
                              a_k.reshape(b, s, A_KV_HEADS, A_HEAD_DIM),
                              a_v.reshape(b, s, A_KV_HEADS, A_HEAD_DIM),
                              a_sink[l])
        y_b = mla(b_cq, b_ckv, b_kpe, b_q_norm[l], b_w_uq[l], b_kv_norm[l], b_w_ukv[l])
        mixed = jnp.concatenate([rmsnorm(y_a, out_norm_a[l]), rmsnorm(y_b, out_norm_b[l])], axis=-1)
        x = x + mixed @ w_o[l]
        x = x + moe(rmsnorm(x, mlp_norm[l]), w_router[l], b_router[l], w_up[l], b_up[l],
                    w_down[l], b_down[l])
    return rmsnorm(x, final_norm)
```

```cpp
#include <hip/hip_runtime.h>
#include <stdint.h>
#include <stdio.h>

#define LAS __attribute__((address_space(3)))
typedef unsigned short bf16_t;
typedef short bf16x8 __attribute__((ext_vector_type(8)));
typedef short s16x4 __attribute__((ext_vector_type(4)));
typedef short v4i16_t __attribute__((ext_vector_type(4)));
typedef float f32x2 __attribute__((ext_vector_type(2)));
typedef float f32x4 __attribute__((ext_vector_type(4)));
typedef float f32x16 __attribute__((ext_vector_type(16)));
typedef int i32x4 __attribute__((ext_vector_type(4)));
typedef unsigned u32x2 __attribute__((ext_vector_type(2)));
typedef unsigned u32x4 __attribute__((ext_vector_type(4)));
typedef __bf16 bf16x2_t __attribute__((ext_vector_type(2)));
typedef int v8i __attribute__((ext_vector_type(8)));
typedef int v2i __attribute__((ext_vector_type(2)));
typedef short v2s __attribute__((ext_vector_type(2)));

constexpr int D_MODEL = 2048, SEQ = 4096, BATCH = 2, NTOK = BATCH * SEQ;
constexpr int IN_COLS = 2368;
constexpr int N_EXP = 32, TOP_K = 4, D_FF = 2048;
constexpr float EPS = 1e-5f;
constexpr float LOG2E = 1.4426950408889634f;

constexpr size_t MiB = 1u << 20;
constexpr size_t WS_CTL = 0, CTL_BYTES = 1 * MiB;
constexpr size_t WS_XN = 1 * MiB, WS_QA = 33 * MiB, WS_KA = 49 * MiB, WS_VA = 53 * MiB, WS_CQ = 57 * MiB, WS_CKV = 65 * MiB, WS_KPE = 69 * MiB;
constexpr size_t WS_QB = 70 * MiB, WS_KVB = 94 * MiB, WS_Y = 126 * MiB, WS_X2 = 158 * MiB, WS_ROPE = 222 * MiB, WS_WRT = 223 * MiB;
constexpr size_t WS_TOKL = 224 * MiB, WS_SEL = 225 * MiB, WS_ACT = 226 * MiB, WS_YS = 386 * MiB, WS_END = 546 * MiB;
constexpr size_t WS_SSQP = WS_WRT + 262144;
constexpr size_t WS_SSQC = WS_SEL + 524288;
constexpr size_t WS_SSQK = WS_SEL + 786432;
constexpr size_t CTL_BAR = 0, CTL_CNT = 16384, CTL_SSQ_CQ = 65536, CTL_SSQ_CKV = 98304, CTL_SSQ_A = 131072, CTL_SSQ_B = 163840, CTL_SSQ_X2 = 196608;

__device__ __forceinline__ unsigned pk_bf16(float lo, float hi) { f32x2 v = {lo, hi}; bf16x2_t b = __builtin_convertvector(v, bf16x2_t); return __builtin_bit_cast(unsigned, b); }
__device__ __forceinline__ unsigned pk4_fp8(float a, float b, float c, float d) { int w = __builtin_amdgcn_cvt_pk_fp8_f32(a, b, 0, false); w = __builtin_amdgcn_cvt_pk_fp8_f32(c, d, w, true); return (unsigned)w; }
__device__ __forceinline__ unsigned pk4_fp8_x64(f32x4 v) { v2s r; asm("" : "=v"(r));
    r = __builtin_amdgcn_cvt_scalef32_pk_fp8_f32(r, v[0], v[1], 0.015625f, false); r = __builtin_amdgcn_cvt_scalef32_pk_fp8_f32(r, v[2], v[3], 0.015625f, true); return __builtin_bit_cast(unsigned, r); }
__device__ __forceinline__ float bf_lo(unsigned u) { return __uint_as_float(u << 16); }
__device__ __forceinline__ float bf_hi(unsigned u) { return __uint_as_float(u & 0xffff0000u); }
__device__ __forceinline__ float wave_sum(float v) {
#pragma unroll
    for (int o = 32; o >= 1; o >>= 1) v += __shfl_xor(v, o, 64);
    return v;
}
__device__ __forceinline__ int crow(int r, int hi) { return (r & 3) + 8 * (r >> 2) + 4 * hi; }
__device__ __forceinline__ s16x4 vtr(const LAS char* p) { return __builtin_bit_cast(s16x4, __builtin_amdgcn_ds_read_tr16_b64_v4i16((LAS v4i16_t*)p)); }
#define SBAR() __builtin_amdgcn_sched_barrier(0)

#define XB_TMO      128
#define XB_XCNT(j)  (256  + 64 * (j))
#define XB_XSUB(j)  (1280 + 64 * (j))
#define XB_XGEN(j)  (2304 + 64 * (j))
#define XB_TOP      3328
#define XB_TOPGEN   3392
#define XCD_BAR_WORDS 3456
#define XB_SPIN_CAP (1u << 18)
__device__ __forceinline__ unsigned xb_ld(unsigned* p)              { return __hip_atomic_load(p, __ATOMIC_RELAXED, __HIP_MEMORY_SCOPE_AGENT); }
__device__ __forceinline__ unsigned xb_add(unsigned* p, unsigned v) { return __hip_atomic_fetch_add(p, v, __ATOMIC_RELAXED, __HIP_MEMORY_SCOPE_AGENT); }
__device__ __forceinline__ unsigned xb_xcc_id() { return (unsigned)__builtin_amdgcn_s_getreg((3 << 11) | 20) & 0xFu; }
#define XB_SPIN(cond, bar) do { unsigned _sp = 0; while (cond) { __builtin_amdgcn_s_sleep(1); \
    if ((++_sp & 255u) == 0u) { if (xb_ld(&(bar)[XB_TMO])) break; if (_sp > XB_SPIN_CAP) { atomicAdd(&(bar)[XB_TMO], 1u); break; } } } } while (0)
struct XcdBarrier { unsigned* bar; unsigned x; volatile LAS unsigned* st; };
__device__ __forceinline__ XcdBarrier xcd_barrier_post(unsigned* bar, volatile LAS unsigned* st) {
    XcdBarrier b; b.bar = bar; b.x = xb_xcc_id(); b.st = st;
    if (threadIdx.x == 0) (void)xb_add(&bar[XB_XCNT(b.x)], 1u);
    return b;
}
__device__ __forceinline__ void xcd_barrier_complete(unsigned* bar, unsigned x, unsigned& nloc, unsigned& nx) {
    const unsigned G = gridDim.x * gridDim.y * gridDim.z;
    unsigned sum, cnt, mine, sp = 0u;
    for (;;) {
        sum = 0u; cnt = 0u; mine = 0u;
#pragma unroll
        for (unsigned j = 0; j < 16; ++j) { const unsigned c = xb_ld(&bar[XB_XCNT(j)]); sum += c; cnt += (c > 0u) ? 1u : 0u; mine = (j == x) ? c : mine; }
        if (sum == G) break;
        __builtin_amdgcn_s_sleep(1);
        if ((++sp & 255u) == 0u) { if (xb_ld(&bar[XB_TMO])) break; if (sp > XB_SPIN_CAP) { atomicAdd(&bar[XB_TMO], 1u); break; } }
    }
    nloc = mine > 0u ? mine : 1u; nx = cnt > 0u ? cnt : 1u;
}
__device__ __forceinline__ void xcd_barrier(const XcdBarrier& b) {
    asm volatile("s_waitcnt vmcnt(0)" ::: "memory");
    __syncthreads();
    if (threadIdx.x == 0) {
        unsigned* bar = b.bar;
        __builtin_amdgcn_s_waitcnt(0);
        unsigned nloc = b.st[0], nx = b.st[1];
        if (nloc == 0u) { xcd_barrier_complete(bar, b.x, nloc, nx); b.st[0] = nloc; b.st[1] = nx; }
        const unsigned old = xb_add(&bar[XB_XSUB(b.x)], 1u);
        const unsigned gen = old / nloc;
        if (old + 1u == (gen + 1u) * nloc) {
            __builtin_amdgcn_fence(__ATOMIC_RELEASE, "agent");
            asm volatile("s_waitcnt vmcnt(0)" ::: "memory");
            const unsigned og = xb_add(&bar[XB_TOP], 1u);
            const unsigned tg = og / nx;
            if (og + 1u == (tg + 1u) * nx) xb_add(&bar[XB_TOPGEN], 1u);
            else XB_SPIN(xb_ld(&bar[XB_TOPGEN]) == tg, bar);
            __builtin_amdgcn_fence(__ATOMIC_ACQUIRE, "agent");
            xb_add(&bar[XB_XGEN(b.x)], 1u);
            asm volatile("s_waitcnt vmcnt(0)" ::: "memory");
        } else {
            XB_SPIN(xb_ld(&bar[XB_XGEN(b.x)]) == gen, bar);
            __builtin_amdgcn_fence(__ATOMIC_ACQUIRE, "agent");
            asm volatile("s_waitcnt vmcnt(0)" ::: "memory");
        }
    }
    __syncthreads();
}

constexpr int A_TILE_B = 256 * 64 * 2;
constexpr int B_PITCH = 544;
constexpr int B_TILE_B = 64 * B_PITCH;
constexpr int G_STAGE_B = A_TILE_B + B_TILE_B;
constexpr int LDS_MISC = 155648;
constexpr int LDS_BYTES = LDS_MISC + 1024;

__device__ __forceinline__ int a_img_byte(int r, int chunk) { return r * 128 + ((chunk ^ ((r >> 1) & 7)) << 4); }
#define WAIT_L0() asm volatile("s_waitcnt lgkmcnt(0)" ::: "memory")
__device__ __forceinline__ void glds16(const void* gsrc, unsigned lds_dst) { unsigned keep;
    asm volatile("s_mov_b32 %0, m0\n\ts_mov_b32 m0, %2\n\ts_nop 0\n\tglobal_load_lds_dwordx4 %1, off\n\ts_mov_b32 m0, %0" : "=&s"(keep) : "v"(gsrc), "s"(lds_dst) : "memory"); }
#define RAW_BARRIER() do { WAIT_L0(); __builtin_amdgcn_s_barrier(); } while (0)

__device__ __forceinline__ const char* uniform_ptr(const void* p) {
    const unsigned long long v = (unsigned long long)p;
    const unsigned lo = __builtin_amdgcn_readfirstlane((unsigned)v), hi = __builtin_amdgcn_readfirstlane((unsigned)(v >> 32));
    return (const char*)(((unsigned long long)hi << 32) | lo);
}
__device__ __forceinline__ void glds16s(const char* sbase, unsigned voff, unsigned lds_dst) { unsigned keep;
    asm volatile("s_mov_b32 %0, m0\n\ts_mov_b32 m0, %3\n\ts_nop 4\n\tglobal_load_lds_dwordx4 %1, %2\n\ts_mov_b32 m0, %0" : "=&s"(keep) : "v"(voff), "s"(sbase), "s"(lds_dst) : "memory"); }
#define WAIT_V4(n, a, b, c, d) asm volatile("s_waitcnt vmcnt(" #n ")" : "+v"(a), "+v"(b), "+v"(c), "+v"(d) :: "memory")
template <bool MID, class AF, class BF, class EPI>
__device__ __forceinline__ void gemm_unit(LAS char* lds, const int nt, const AF& af, const BF& bf, EPI& epi) {
    const int tid = threadIdx.x, wid = __builtin_amdgcn_readfirstlane(tid >> 6), lane = tid & 63, wr = wid >> 2, wc = wid & 3, fr = lane & 15, fq = lane >> 4;
    const char* abase = uniform_ptr(af.base);
    unsigned aoff[4];
#pragma unroll
    for (int i = 0; i < 4; ++i) { const int R = wid * 8 + i * 64 + (lane >> 3), C = ((lane & 7) ^ ((R >> 1) & 7)) * 8; aoff[i] = (af.rowoff(R) + (unsigned)C) * 2u; }
    const int a_ldsw = wid * 1024;
    const unsigned lds_u = (unsigned)__builtin_amdgcn_readfirstlane((int)(unsigned)(size_t)lds);
    const size_t ldb4 = (size_t)bf.ld * 4;
    const char* bbase = uniform_ptr(bf.base) + (size_t)wid * ldb4;
    const unsigned boff = bf.coloff(4 * lane) * 4u;
    const int b_lds0 = A_TILE_B + wid * B_PITCH + 8 * lane, b_lds1 = A_TILE_B + wid * B_PITCH + ((8 * lane) ^ 128);
    const int a_rd0 = a_img_byte(wr * 128 + fr, fq), a_rd1 = a_rd0 ^ 64;
    const int b_rd = A_TILE_B + (8 * fq + ((lane & 15) >> 2)) * B_PITCH + ((wc ^ (fq & 1)) << 7) + 8 * (lane & 3);
    f32x4 acc[8][4];
#pragma unroll
    for (int m = 0; m < 8; ++m)
#pragma unroll
        for (int n = 0; n < 4; ++n) acc[m][n] = (f32x4){0.f, 0.f, 0.f, 0.f};
    f32x4 sb[8];
#define G_STAGE_A(i, kt, buf) glds16s(abase + (size_t)(kt) * 128, aoff[i], lds_u + (unsigned)((buf) * G_STAGE_B + a_ldsw + (i) * 8192))
#define G_ISSUE_B(i, kt) asm volatile("s_nop 4\n\tglobal_load_dwordx4 %0, %1, %2" : "=v"(sb[i]) : "v"(boff), "s"(bbase + ((size_t)(kt) * 64 + (i) * 8) * ldb4) : "memory")
#define G_WRITE_B(i, buf) do { u32x2 w_ = {pk_bf16(sb[i][0], sb[i][1]), pk_bf16(sb[i][2], sb[i][3])}; \
        *(LAS u32x2*)(lds + (buf) * G_STAGE_B + (((i) & 1) ? b_lds1 : b_lds0) + (i) * 8 * B_PITCH) = w_; } while (0)
#define G_KSTEP(buf, ks) do { bf16x8 At[8], Bf[4]; \
        _Pragma("unroll") for (int n = 0; n < 4; ++n) { const s16x4 lo_ = vtr(lds + (buf) * G_STAGE_B + b_rd + (ks) * 32 * B_PITCH + n * 32), hi_ = vtr(lds + (buf) * G_STAGE_B + b_rd + (ks) * 32 * B_PITCH + 4 * B_PITCH + n * 32); \
            Bf[n] = (bf16x8){lo_[0], lo_[1], lo_[2], lo_[3], hi_[0], hi_[1], hi_[2], hi_[3]}; } \
        _Pragma("unroll") for (int m = 0; m < 8; ++m) At[m] = *(const LAS bf16x8*)(lds + (buf) * G_STAGE_B + ((ks) ? a_rd1 : a_rd0) + m * 2048); \
        SBAR(); __builtin_amdgcn_s_setprio(1); \
        _Pragma("unroll") for (int m = 0; m < 8; ++m) _Pragma("unroll") for (int n = 0; n < 4; ++n) \
            acc[m][n] = __builtin_amdgcn_mfma_f32_16x16x32_bf16(Bf[n], At[m], acc[m][n], 0, 0, 0); \
        __builtin_amdgcn_s_setprio(0); SBAR(); } while (0)
#pragma unroll
    for (int i = 0; i < 4; ++i) G_STAGE_A(i, 0, 0);
#pragma unroll
    for (int i = 0; i < 8; ++i) G_ISSUE_B(i, 0);
    WAIT_V4(0, sb[0], sb[1], sb[2], sb[3]); WAIT_V4(0, sb[4], sb[5], sb[6], sb[7]);
#pragma unroll
    for (int i = 0; i < 8; ++i) G_WRITE_B(i, 0);
    SBAR();
#pragma unroll
    for (int i = 0; i < 8; ++i) G_ISSUE_B(i, 1);
    SBAR();
    RAW_BARRIER();
#pragma unroll 1
    for (int t = 0; t < nt; ++t) {
        const int cur = t & 1, nxt = cur ^ 1;
        if constexpr (MID) { if (t == (nt >> 1)) epi.mid(acc, wr, wc, fr, fq); }
        const int k1 = (t + 1 < nt) ? t + 1 : nt - 1, k2 = (t + 2 < nt) ? t + 2 : nt - 1;
        G_STAGE_A(0, k1, nxt); G_STAGE_A(1, k1, nxt); G_STAGE_A(2, k1, nxt); G_STAGE_A(3, k1, nxt);
        G_KSTEP(cur, 0);
        WAIT_V4(8, sb[0], sb[1], sb[2], sb[3]);
        G_WRITE_B(0, nxt); G_WRITE_B(1, nxt); G_WRITE_B(2, nxt); G_WRITE_B(3, nxt); SBAR();
        G_ISSUE_B(0, k2); G_ISSUE_B(1, k2); G_ISSUE_B(2, k2); G_ISSUE_B(3, k2); SBAR();
        G_KSTEP(cur, 1);
        WAIT_V4(8, sb[4], sb[5], sb[6], sb[7]);
        G_WRITE_B(4, nxt); G_WRITE_B(5, nxt); G_WRITE_B(6, nxt); G_WRITE_B(7, nxt); SBAR();
        G_ISSUE_B(4, k2); G_ISSUE_B(5, k2); G_ISSUE_B(6, k2); G_ISSUE_B(7, k2); SBAR();
        asm volatile("s_waitcnt vmcnt(8)" ::: "memory");
        RAW_BARRIER();
    }
    WAIT_V4(0, sb[0], sb[1], sb[2], sb[3]); WAIT_V4(0, sb[4], sb[5], sb[6], sb[7]);
    epi.fin(acc, wr, wc, fr, fq);
#undef G_STAGE_A
#undef G_ISSUE_B
#undef G_WRITE_B
#undef G_KSTEP
}

constexpr int A8_TILE_B = 16384, B8_PITCH = 288, B8_TILE_B = 64 * B8_PITCH;
constexpr int A8_RING = 5, B8_RING = 4, B8_OFF = A8_RING * A8_TILE_B;
static_assert(B8_OFF + B8_RING * B8_TILE_B <= LDS_MISC, "fp8 rings fit below the misc words");
__device__ __forceinline__ v2i vtr8(const LAS char* p) { return __builtin_amdgcn_ds_read_tr8_b64_v2i32((LAS v2i*)p); }
template <int SCALE_X, class AF, class BF, class EPI>
__device__ __forceinline__ void gemm_unit8(LAS char* lds, LAS unsigned* ring_cnt, const int nt, const AF& af, const BF& bf, EPI& epi) {
    const int tid = threadIdx.x, wid = __builtin_amdgcn_readfirstlane(tid >> 6), lane = tid & 63, wr = wid >> 2, wc = wid & 3, r32 = lane & 31, hi = lane >> 5;
    const char* abase = uniform_ptr(af.base);
    unsigned aoff[2];
#pragma unroll
    for (int i = 0; i < 2; ++i) { const int R = wid * 16 + i * 128 + (lane >> 2), C = ((lane & 3) ^ ((lane >> 4) & 3)) * 16; aoff[i] = af.rowoff(R) + (unsigned)C; }
    const unsigned lds_u = (unsigned)__builtin_amdgcn_readfirstlane((int)(unsigned)(size_t)lds) + (unsigned)(wid * 1024);
    const size_t ldb4 = (size_t)bf.ld * 4;
    const char* bbase = uniform_ptr(bf.base) + (size_t)wid * ldb4;
    const unsigned boff = bf.coloff(4 * lane) * 4u;
    const int b_wr = B8_OFF + wid * B8_PITCH + 4 * lane;
    const int a_rd0 = (wr * 128 + r32) * 64 + (((2 * hi) ^ ((r32 >> 2) & 3)) << 4), a_rd1 = a_rd0 ^ 16;
    const int b_rd = B8_OFF + (32 * hi + ((lane & 15) >> 1)) * B8_PITCH + wc * 64 + 16 * ((lane >> 4) & 1) + 8 * (lane & 1);
    f32x16 acc[4][2];
#pragma unroll
    for (int m = 0; m < 4; ++m)
#pragma unroll
        for (int n = 0; n < 2; ++n)
#pragma unroll
            for (int r = 0; r < 16; ++r) acc[m][n][r] = 0.f;
    f32x4 sb[8];
#define H_STAGE_A(i, kt, slot) glds16s(abase + (size_t)(kt) * 64, aoff[i], lds_u + (unsigned)((slot) * A8_TILE_B + (i) * 8192))
#define H_ISSUE_B(i, kt) asm volatile("s_nop 4\n\tglobal_load_dwordx4 %0, %1, %2" : "=v"(sb[i]) : "v"(boff), "s"(bbase + ((size_t)(kt) * 64 + (i) * 8) * ldb4) : "memory")
#define H_WRITE_B(i, slot) *(LAS unsigned*)(lds + (slot) * B8_TILE_B + b_wr + (i) * 8 * B8_PITCH) = pk4_fp8_x64(sb[i])
#define H_KSTEP(sa, sbk) do { v8i Xf[4], Wf[2]; \
        _Pragma("unroll") for (int n = 0; n < 2; ++n) _Pragma("unroll") for (int r = 0; r < 4; ++r) { const v2i t_ = vtr8(lds + (sbk) * B8_TILE_B + b_rd + r * 8 * B8_PITCH + n * 32); Wf[n][2 * r] = t_[0]; Wf[n][2 * r + 1] = t_[1]; } \
        _Pragma("unroll") for (int m = 0; m < 4; ++m) { const i32x4 lo_ = *(const LAS i32x4*)(lds + (sa) * A8_TILE_B + a_rd0 + m * 2048), hi_ = *(const LAS i32x4*)(lds + (sa) * A8_TILE_B + a_rd1 + m * 2048); \
            Xf[m] = (v8i){lo_[0], lo_[1], lo_[2], lo_[3], hi_[0], hi_[1], hi_[2], hi_[3]}; } \
        SBAR(); __builtin_amdgcn_s_setprio(1); \
        _Pragma("unroll") for (int m = 0; m < 4; ++m) _Pragma("unroll") for (int n = 0; n < 2; ++n) \
            acc[m][n] = __builtin_amdgcn_mfma_scale_f32_32x32x64_f8f6f4(Wf[n], Xf[m], acc[m][n], 0, 0, 0, 0x79797979, 0, SCALE_X); \
        __builtin_amdgcn_s_setprio(0); SBAR(); } while (0)
    if (tid < 8) ring_cnt[tid] = 0u;
    H_STAGE_A(0, 0, 0); H_STAGE_A(1, 0, 0); H_STAGE_A(0, 1, 1); H_STAGE_A(1, 1, 1);
#pragma unroll
    for (int i = 0; i < 8; ++i) H_ISSUE_B(i, 0);
    WAIT_V4(0, sb[0], sb[1], sb[2], sb[3]); WAIT_V4(0, sb[4], sb[5], sb[6], sb[7]);
#pragma unroll
    for (int i = 0; i < 8; ++i) H_WRITE_B(i, 0);
    SBAR();
#pragma unroll
    for (int i = 0; i < 8; ++i) H_ISSUE_B(i, 1);
    WAIT_V4(0, sb[0], sb[1], sb[2], sb[3]); WAIT_V4(0, sb[4], sb[5], sb[6], sb[7]);
#pragma unroll
    for (int i = 0; i < 8; ++i) H_WRITE_B(i, 1);
    SBAR();
    H_STAGE_A(0, 2, 2); H_STAGE_A(1, 2, 2);
#pragma unroll
    for (int i = 0; i < 8; ++i) H_ISSUE_B(i, 2);
    SBAR();
    RAW_BARRIER();
    int sa_r = 0, sa_w = 3, sb_r = 0, sb_w = 2;
#pragma unroll 1
    for (int t = 0; t < nt; ++t) {
        if (t >= 2) {
            const unsigned need = (unsigned)(t - 1);
            for (;;) { asm volatile("" ::: "memory"); const unsigned v = *(volatile LAS unsigned*)(ring_cnt + (lane & 7)); if (__all(v >= need)) break; __builtin_amdgcn_s_sleep(1); }
            asm volatile("" ::: "memory");
        }
        const int k3 = (t + 3 < nt) ? t + 3 : nt - 1;
        H_STAGE_A(0, k3, sa_w); H_STAGE_A(1, k3, sa_w);
        H_KSTEP(sa_r, sb_r);
        WAIT_V4(6, sb[0], sb[1], sb[2], sb[3]);
        H_WRITE_B(0, sb_w); H_WRITE_B(1, sb_w); H_WRITE_B(2, sb_w); H_WRITE_B(3, sb_w); SBAR();
        H_ISSUE_B(0, k3); H_ISSUE_B(1, k3); H_ISSUE_B(2, k3); H_ISSUE_B(3, k3); SBAR();
        WAIT_V4(6, sb[4], sb[5], sb[6], sb[7]);
        H_WRITE_B(4, sb_w); H_WRITE_B(5, sb_w); H_WRITE_B(6, sb_w); H_WRITE_B(7, sb_w); SBAR();
        H_ISSUE_B(4, k3); H_ISSUE_B(5, k3); H_ISSUE_B(6, k3); H_ISSUE_B(7, k3); SBAR();
        asm volatile("" ::: "memory");
        if (lane == 0) *(volatile LAS unsigned*)(ring_cnt + wid) = (unsigned)(t + 1);
        asm volatile("" ::: "memory");
        sa_r = (sa_r == A8_RING - 1) ? 0 : sa_r + 1; sa_w = (sa_w == A8_RING - 1) ? 0 : sa_w + 1;
        sb_r = (sb_r == B8_RING - 1) ? 0 : sb_r + 1; sb_w = (sb_w == B8_RING - 1) ? 0 : sb_w + 1;
    }
    WAIT_V4(0, sb[0], sb[1], sb[2], sb[3]); WAIT_V4(0, sb[4], sb[5], sb[6], sb[7]);
    RAW_BARRIER();
    epi.fin(acc, wr, wc, r32, hi);
#undef H_STAGE_A
#undef H_ISSUE_B
#undef H_WRITE_B
#undef H_KSTEP
}

struct Params {
    const float *x, *attn_norm, *w_in, *a_sink, *b_q_norm, *b_w_uq, *b_kv_norm, *b_w_ukv, *out_norm_a, *out_norm_b, *w_o, *mlp_norm, *w_router, *b_router,
        *w_up, *b_up, *w_down, *b_down, *final_norm;
    float* out; unsigned char* ws; int ph_lo, ph_hi;
};

struct ARows { const bf16_t* base; unsigned ld; __device__ __forceinline__ unsigned rowoff(int r) const { return (unsigned)r * ld; } };
struct AGather { const bf16_t* base; const int* tokl; int r0, cnt; __device__ __forceinline__ unsigned rowoff(int r) const { int rk = r0 + r; rk = rk < cnt ? rk : 0; return (unsigned)tokl[rk] * (unsigned)D_MODEL; } };
struct ARows8 { const unsigned char* base; unsigned ld; __device__ __forceinline__ unsigned rowoff(int r) const { return (unsigned)r * ld; } };
struct AGather8 { const unsigned char* base; const int* tokl; int r0, cnt; __device__ __forceinline__ unsigned rowoff(int r) const { int rk = r0 + r; rk = rk < cnt ? rk : 0; return (unsigned)tokl[rk] * (unsigned)D_MODEL; } };
struct BPlain { const float* base; size_t ld; int ncols;
    __device__ __forceinline__ unsigned coloff(int c) const { return (unsigned)(c < ncols ? c : (c & (ncols - 1))); } };
struct BGateUp { const float* base; size_t ld;
    __device__ __forceinline__ unsigned coloff(int c) const { const int wc = c >> 6, w = c & 63; return (unsigned)(wc * 32 + (w & 31) + ((w & 32) ? D_FF : 0)); } };

struct EpiProj {
    int pn, brow; unsigned char* ws; const float *qg, *kvg;
    __device__ __forceinline__ void mid(f32x4 (&)[8][4], int, int, int, int) {}
    __device__ __forceinline__ void fin(f32x4 (&acc)[8][4], int wr, int wc, int fr, int fq) {
        if (pn < 6) {
            bf16_t* dst; int ldd, c0;
            if (pn < 4) { dst = (bf16_t*)(ws + WS_QA); ldd = 1024; c0 = pn * 256; } else if (pn == 4) { dst = (bf16_t*)(ws + WS_KA); ldd = 256; c0 = 0; } else { dst = (bf16_t*)(ws + WS_VA); ldd = 256; c0 = 0; }
#pragma unroll
            for (int m = 0; m < 8; ++m) { const int row = brow + wr * 128 + m * 16 + fr;
#pragma unroll
                for (int n = 0; n < 4; ++n) { const int col = c0 + wc * 64 + n * 16 + fq * 4; const f32x4 v = acc[m][n];
                    *(u32x2*)(dst + (size_t)row * ldd + col) = (u32x2){pk_bf16(v[0], v[1]), pk_bf16(v[2], v[3])}; } }
        } else if (pn < 9) {
            bf16_t* dst; int ldd, c0; const float* g; float* ssq; int nsl, sl;
            if (pn < 8) { dst = (bf16_t*)(ws + WS_CQ); ldd = 512; c0 = (pn - 6) * 256; g = qg; ssq = (float*)(ws + WS_SSQC); nsl = 8; sl = (pn - 6) * 4 + wc; }
            else { dst = (bf16_t*)(ws + WS_CKV); ldd = 256; c0 = 0; g = kvg; ssq = (float*)(ws + WS_SSQK); nsl = 4; sl = wc; }
            f32x4 gvv[4];
#pragma unroll
            for (int n = 0; n < 4; ++n) gvv[n] = *(const f32x4*)(g + c0 + wc * 64 + n * 16 + fq * 4);
#pragma unroll
            for (int m = 0; m < 8; ++m) { const int row = brow + wr * 128 + m * 16 + fr; float ss = 0.f;
#pragma unroll
                for (int n = 0; n < 4; ++n) { const int col = c0 + wc * 64 + n * 16 + fq * 4; const f32x4 v = acc[m][n]; const f32x4 gv = gvv[n];
                    ss += v[0] * v[0] + v[1] * v[1] + v[2] * v[2] + v[3] * v[3];
                    *(u32x2*)(dst + (size_t)row * ldd + col) = (u32x2){pk_bf16(v[0] * gv[0], v[1] * gv[1]), pk_bf16(v[2] * gv[2], v[3] * gv[3])}; }
                ss += __shfl_xor(ss, 16, 64); ss += __shfl_xor(ss, 32, 64);
                if (fq == 0) ssq[(size_t)row * nsl + sl] = ss; }
        } else {
            if (wc == 0) {
                bf16_t* dst = (bf16_t*)(ws + WS_KPE); const float* rope = (const float*)(ws + WS_ROPE);
#pragma unroll
                for (int mb = 0; mb < 8; mb += 4) { f32x4 cs[4][2][2];
#pragma unroll
                    for (int m = 0; m < 4; ++m) { const int pos = (brow + wr * 128 + (mb + m) * 16 + fr) & (SEQ - 1);
#pragma unroll
                        for (int n = 0; n < 2; ++n) { const int i0 = n * 16 + fq * 4; cs[m][n][0] = *(const f32x4*)(rope + ((size_t)pos * 32 + i0) * 2); cs[m][n][1] = *(const f32x4*)(rope + ((size_t)pos * 32 + i0) * 2 + 4); } }
                    SBAR();
#pragma unroll
                    for (int m = 0; m < 4; ++m) { const int row = brow + wr * 128 + (mb + m) * 16 + fr;
#pragma unroll
                        for (int n = 0; n < 2; ++n) { const int i0 = n * 16 + fq * 4; const f32x4 x1 = acc[mb + m][n], x2 = acc[mb + m][n + 2]; const f32x4 cs0 = cs[m][n][0], cs1 = cs[m][n][1];
                            const float c[4] = {cs0[0], cs0[2], cs1[0], cs1[2]}, s[4] = {cs0[1], cs0[3], cs1[1], cs1[3]};
                            float o1[4], o2[4];
#pragma unroll
                            for (int j = 0; j < 4; ++j) { o1[j] = x1[j] * c[j] - x2[j] * s[j]; o2[j] = x1[j] * s[j] + x2[j] * c[j]; }
                            *(u32x2*)(dst + (size_t)row * 64 + i0) = (u32x2){pk_bf16(o1[0], o1[1]), pk_bf16(o1[2], o1[3])};
                            *(u32x2*)(dst + (size_t)row * 64 + 32 + i0) = (u32x2){pk_bf16(o2[0], o2[1]), pk_bf16(o2[2], o2[3])}; } } }
            }
        }
    }
};
struct EpiQUp {
    int pn, brow; unsigned char* ws;
    __device__ __forceinline__ void mid(f32x4 (&)[8][4], int, int, int, int) {}
    __device__ __forceinline__ void fin(f32x4 (&acc)[8][4], int wr, int wc, int fr, int fq) {
        bf16_t* dst = (bf16_t*)(ws + WS_QB); const float* rope = (const float*)(ws + WS_ROPE); const float* ssq = (const float*)(ws + WS_CTL + CTL_SSQ_CQ);
        const int seg = pn * 4 + wc, head = seg / 3, part = seg - head * 3;
        float sq[8];
#pragma unroll
        for (int m = 0; m < 8; ++m) { const f32x4* pp = (const f32x4*)((const float*)(ws + WS_SSQC) + (size_t)(brow + wr * 128 + m * 16 + fr) * 8); const f32x4 p0 = pp[0], p1 = pp[1];
            sq[m] = ((p0[0] + p0[1]) + (p0[2] + p0[3])) + ((p1[0] + p1[1]) + (p1[2] + p1[3])); }
        if (part < 2) {
#pragma unroll
            for (int m = 0; m < 8; ++m) { const int row = brow + wr * 128 + m * 16 + fr; const float rs = rsqrtf(sq[m] * (1.f / 512.f) + EPS);
                bf16_t* drow = dst + (size_t)row * 1536 + head * 192 + part * 64;
#pragma unroll
                for (int n = 0; n < 4; ++n) { const f32x4 v = acc[m][n]; *(u32x2*)(drow + n * 16 + fq * 4) = (u32x2){pk_bf16(v[0] * rs, v[1] * rs), pk_bf16(v[2] * rs, v[3] * rs)}; } }
        } else {
#pragma unroll
            for (int mb = 0; mb < 8; mb += 4) { f32x4 cs[4][2][2];
#pragma unroll
                for (int m = 0; m < 4; ++m) { const int pos = (brow + wr * 128 + (mb + m) * 16 + fr) & (SEQ - 1);
#pragma unroll
                    for (int n = 0; n < 2; ++n) { const int i0 = n * 16 + fq * 4; cs[m][n][0] = *(const f32x4*)(rope + ((size_t)pos * 32 + i0) * 2); cs[m][n][1] = *(const f32x4*)(rope + ((size_t)pos * 32 + i0) * 2 + 4); } }
                SBAR();
#pragma unroll
                for (int m = 0; m < 4; ++m) { const int row = brow + wr * 128 + (mb + m) * 16 + fr; const float rs = rsqrtf(sq[mb + m] * (1.f / 512.f) + EPS);
                    bf16_t* drow = dst + (size_t)row * 1536 + head * 192 + part * 64;
#pragma unroll
                    for (int n = 0; n < 2; ++n) { const int i0 = n * 16 + fq * 4; const f32x4 x1 = acc[mb + m][n], x2 = acc[mb + m][n + 2]; const f32x4 cs0 = cs[m][n][0], cs1 = cs[m][n][1];
                        const float c[4] = {cs0[0], cs0[2], cs1[0], cs1[2]}, s[4] = {cs0[1], cs0[3], cs1[1], cs1[3]};
                        float o1[4], o2[4];
#pragma unroll
                        for (int j = 0; j < 4; ++j) { o1[j] = (x1[j] * c[j] - x2[j] * s[j]) * rs; o2[j] = (x1[j] * s[j] + x2[j] * c[j]) * rs; }
                        *(u32x2*)(drow + i0) = (u32x2){pk_bf16(o1[0], o1[1]), pk_bf16(o1[2], o1[3])};
                        *(u32x2*)(drow + 32 + i0) = (u32x2){pk_bf16(o2[0], o2[1]), pk_bf16(o2[2], o2[3])}; } } }
        }
    }
};
struct EpiKvUp {
    int pn, brow; unsigned char* ws;
    __device__ __forceinline__ void mid(f32x4 (&)[8][4], int, int, int, int) {}
    __device__ __forceinline__ void fin(f32x4 (&acc)[8][4], int wr, int wc, int fr, int fq) {
        bf16_t* dst = (bf16_t*)(ws + WS_KVB);
        float sq[8];
#pragma unroll
        for (int m = 0; m < 8; ++m) { const f32x4 p0 = *(const f32x4*)((const float*)(ws + WS_SSQK) + (size_t)(brow + wr * 128 + m * 16 + fr) * 4); sq[m] = (p0[0] + p0[1]) + (p0[2] + p0[3]); }
#pragma unroll
        for (int m = 0; m < 8; ++m) { const int row = brow + wr * 128 + m * 16 + fr; const float rs = rsqrtf(sq[m] * (1.f / 256.f) + EPS);
#pragma unroll
            for (int n = 0; n < 4; ++n) { const int col = pn * 256 + wc * 64 + n * 16 + fq * 4; const f32x4 v = acc[m][n];
                *(u32x2*)(dst + (size_t)row * 2048 + col) = (u32x2){pk_bf16(v[0] * rs, v[1] * rs), pk_bf16(v[2] * rs, v[3] * rs)}; } }
    }
};
struct EpiWo {
    int pn, brow; unsigned char* ws; const float* x; const LAS float* tab;
    __device__ __forceinline__ void mid(f32x4 (&acc)[8][4], int wr, int wc, int fr, int fq) {
#pragma unroll
        for (int m = 0; m < 8; ++m) { const int r = wr * 128 + m * 16 + fr;
            const float f = __builtin_amdgcn_sqrtf((tab[256 + r] + EPS) * __builtin_amdgcn_rcpf(tab[r] + EPS));
#pragma unroll
            for (int n = 0; n < 4; ++n) acc[m][n] *= f;
            SBAR(); }
    }
    __device__ __forceinline__ void fin(f32x4 (&acc)[8][4], int wr, int wc, int fr, int fq) {
        float* x2 = (float*)(ws + WS_X2);
        const size_t o0 = (size_t)(brow + wr * 128 + fr) * D_MODEL + pn * 256 + wc * 64 + fq * 4;
        f32x4 xv[4][4];
#pragma unroll
        for (int m = 0; m < 4; ++m)
#pragma unroll
            for (int n = 0; n < 4; ++n) xv[m][n] = *(const f32x4*)(x + o0 + (size_t)m * 16 * D_MODEL + n * 16);
#pragma unroll
        for (int m = 0; m < 4; ++m) { const float rbm = rsqrtf(tab[256 + wr * 128 + m * 16 + fr] + EPS);
#pragma unroll
            for (int n = 0; n < 4; ++n) acc[m][n] = acc[m][n] * rbm + xv[m][n]; }
        SBAR();
#pragma unroll
        for (int m = 0; m < 4; ++m)
#pragma unroll
            for (int n = 0; n < 4; ++n) xv[m][n] = *(const f32x4*)(x + o0 + (size_t)(m + 4) * 16 * D_MODEL + n * 16);
        SBAR();
#pragma unroll
        for (int m = 0; m < 4; ++m)
#pragma unroll
            for (int n = 0; n < 4; ++n) *(f32x4*)(x2 + o0 + (size_t)m * 16 * D_MODEL + n * 16) = acc[m][n];
        SBAR();
#pragma unroll
        for (int m = 4; m < 8; ++m) { const float rbm = rsqrtf(tab[256 + wr * 128 + m * 16 + fr] + EPS);
#pragma unroll
            for (int n = 0; n < 4; ++n) *(f32x4*)(x2 + o0 + (size_t)m * 16 * D_MODEL + n * 16) = acc[m][n] * rbm + xv[m - 4][n]; }
    }
};
struct EpiUp8 {
    int j0, r0, cnt; unsigned char* dst; const float* bias;
    __device__ __forceinline__ void fin(f32x16 (&acc)[4][2], int wr, int wc, int r32, int hi) {
        f32x4 bg[4], bu[4];
#pragma unroll
        for (int rg = 0; rg < 4; ++rg) { const int j = j0 + wc * 32 + 8 * rg + 4 * hi; bg[rg] = *(const f32x4*)(bias + j); bu[rg] = *(const f32x4*)(bias + D_FF + j); }
#pragma unroll
        for (int m = 0; m < 4; ++m) { const int r = wr * 128 + m * 32 + r32; unsigned o8[4];
#pragma unroll
            for (int rg = 0; rg < 4; ++rg) { float o[4];
#pragma unroll
                for (int q = 0; q < 4; ++q) { const float g = fminf(acc[m][0][4 * rg + q] + bg[rg][q], 7.f), u = fminf(fmaxf(acc[m][1][4 * rg + q] + bu[rg][q], -7.f), 7.f);
                    const float sg = __builtin_amdgcn_rcpf(1.f + __builtin_amdgcn_exp2f(-1.702f * LOG2E * g)); o[q] = 4.f * (u + 1.f) * (g * sg); }
                o8[rg] = pk4_fp8(o[0], o[1], o[2], o[3]); }
            if (r0 + r < cnt) {
#pragma unroll
                for (int rg = 0; rg < 4; ++rg) *(unsigned*)(dst + (size_t)r * D_FF + j0 + wc * 32 + 8 * rg + 4 * hi) = o8[rg]; }
        }
    }
};
struct EpiDown8 {
    int c0, r0, cnt; bf16_t* dst; const float* bias;
    __device__ __forceinline__ void fin(f32x16 (&acc)[4][2], int wr, int wc, int r32, int hi) {
        f32x4 b[2][4];
#pragma unroll
        for (int n = 0; n < 2; ++n)
#pragma unroll
            for (int rg = 0; rg < 4; ++rg) b[n][rg] = *(const f32x4*)(bias + c0 + wc * 64 + n * 32 + 8 * rg + 4 * hi);
#pragma unroll
        for (int m = 0; m < 4; ++m) { const int r = wr * 128 + m * 32 + r32;
            if (r0 + r < cnt) {
#pragma unroll
                for (int n = 0; n < 2; ++n)
#pragma unroll
                    for (int rg = 0; rg < 4; ++rg) { const int col = c0 + wc * 64 + n * 32 + 8 * rg + 4 * hi;
                        *(u32x2*)(dst + (size_t)r * D_MODEL + col) = (u32x2){pk_bf16(acc[m][n][4 * rg] + b[n][rg][0], acc[m][n][4 * rg + 1] + b[n][rg][1]), pk_bf16(acc[m][n][4 * rg + 2] + b[n][rg][2], acc[m][n][4 * rg + 3] + b[n][rg][3])}; } }
        }
    }
};

__device__ __forceinline__ void sincos_d(double x, double& s, double& c) {
    const double k = __builtin_rint(x * 0.63661977236758134308);
    double r = __builtin_fma(-k, 1.57079632679489655800e+00, x); r = __builtin_fma(-k, 6.12323399573676603587e-17, r);
    const double r2 = r * r;
    double sp = -7.6471637318198164759e-13; sp = sp * r2 + 1.6059043836821614599e-10; sp = sp * r2 - 2.5052108385441718775e-08; sp = sp * r2 + 2.7557319223985890653e-06;
    sp = sp * r2 - 1.9841269841269841270e-04; sp = sp * r2 + 8.3333333333333333333e-03; sp = sp * r2 - 1.6666666666666666667e-01; const double sn = r + r * r2 * sp;
    double cp = 4.7794773323873852974e-14; cp = cp * r2 - 1.1470745597729724714e-11; cp = cp * r2 + 2.0876756987868098979e-09; cp = cp * r2 - 2.7557319223985890653e-07;
    cp = cp * r2 + 2.4801587301587301587e-05; cp = cp * r2 - 1.3888888888888888889e-03; cp = cp * r2 + 4.1666666666666666667e-02; cp = cp * r2 - 0.5; const double cn = 1.0 + r2 * cp;
    const int q = ((int)k) & 3;
    s = (q == 0) ? sn : (q == 1) ? cn : (q == 2) ? -sn : -cn;
    c = (q == 0) ? cn : (q == 1) ? -sn : (q == 2) ? -cn : sn;
}

__device__ __forceinline__ void phase_prologue(const Params& p) {
    const int tid = threadIdx.x, wid = tid >> 6, lane = tid & 63;
    bf16_t* xn = (bf16_t*)(p.ws + WS_XN);
    for (int row = blockIdx.x * 8 + wid; row < NTOK; row += gridDim.x * 8) {
        const f32x4* xr = (const f32x4*)(p.x + (size_t)row * D_MODEL); f32x4 v[8]; float ss = 0.f;
#pragma unroll
        for (int i = 0; i < 8; ++i) { v[i] = xr[lane + 64 * i]; ss += v[i][0] * v[i][0] + v[i][1] * v[i][1] + v[i][2] * v[i][2] + v[i][3] * v[i][3]; }
        ss = wave_sum(ss); const float rs = rsqrtf(ss * (1.f / D_MODEL) + EPS);
#pragma unroll
        for (int i = 0; i < 8; ++i) { const f32x4 g = ((const f32x4*)p.attn_norm)[lane + 64 * i];
            *(u32x2*)(xn + (size_t)row * D_MODEL + 4 * (lane + 64 * i)) = (u32x2){pk_bf16(v[i][0] * rs * g[0], v[i][1] * rs * g[1]), pk_bf16(v[i][2] * rs * g[2], v[i][3] * rs * g[3])}; }
    }
    const int gtid = blockIdx.x * 512 + tid;
    if (gtid < SEQ * 32) {
        const int pos = gtid >> 5, i = gtid & 31;
        double b = 10000.0; for (int q = 0; q < 5; ++q) b = __builtin_sqrt(b);
        double f = 1.0; for (int q = 0; q < i; ++q) f *= b;
        const float inv_freq = (float)(1.0 / f); const float ang = (float)pos * inv_freq;
        double s, c; sincos_d((double)ang, s, c);
        float* rope = (float*)(p.ws + WS_ROPE); rope[(size_t)gtid * 2] = (float)c; rope[(size_t)gtid * 2 + 1] = (float)s;
    }
    if (gtid < N_EXP * D_MODEL) {
        ((float*)(p.ws + WS_WRT))[gtid] = p.w_router[gtid] * p.mlp_norm[gtid >> 5];
    }
}

constexpr int AA_PITCH = 144;
constexpr int AA_K = 0, AA_V = 384 * AA_PITCH;
constexpr int AA_WS = 2 * 384 * AA_PITCH;
__device__ __forceinline__ void attn_a_unit(const Params& p, LAS char* lds, int u) {
    const int tid = threadIdx.x, wid = __builtin_amdgcn_readfirstlane(tid >> 6), lane = tid & 63, r32 = lane & 31, hi = lane >> 5;
    const int b = u >> 7, nq = (u >> 2) & 31, kvh = u & 3;
    const bf16_t* QA = (const bf16_t*)(p.ws + WS_QA); const bf16_t* KA = (const bf16_t*)(p.ws + WS_KA); const bf16_t* VA = (const bf16_t*)(p.ws + WS_VA);
    const int P0 = (nq - 1) * 128;
    __syncthreads();
    for (int c = tid; c < 384 * 8; c += 512) { const int r = c >> 3, ch = c & 7; const int pos = P0 + r;
        i32x4 kv = {0, 0, 0, 0}, vv = {0, 0, 0, 0};
        if (pos >= 0 && pos < SEQ) { const size_t g = ((size_t)(b * SEQ + pos)) * 256 + kvh * 64 + ch * 8; kv = *(const i32x4*)(KA + g); vv = *(const i32x4*)(VA + g); }
        *(LAS i32x4*)(lds + AA_K + r * AA_PITCH + ch * 16) = kv; *(LAS i32x4*)(lds + AA_V + r * AA_PITCH + ch * 16) = vv; }
    __syncthreads();
    LAS float* wsf = (LAS float*)(lds + AA_WS) + wid * 64;
    const int hq = kvh * 4 + (wid >> 1);
    const float slope2 = __builtin_amdgcn_exp2f(-8.f * (float)(hq + 1) / 16.f) * LOG2E;
    const float sink2 = p.a_sink[hq] * LOG2E;
    const float C = 0.125f * LOG2E;
    const float* ga = p.out_norm_a + hq * 64;
    bf16_t* Y = (bf16_t*)(p.ws + WS_Y); float* ssqa = (float*)(p.ws + WS_SSQP);
    for (int blk = 0; blk < 2; ++blk) {
        const int q0 = nq * 128 + (wid & 1) * 64 + blk * 32;
        const int tq = q0 + r32;
        bf16x8 qr[4];
        { const bf16_t* qp = QA + ((size_t)(b * SEQ + tq)) * 1024 + hq * 64 + hi * 8;
#pragma unroll
          for (int d0 = 0; d0 < 4; ++d0) qr[d0] = *(const bf16x8*)(qp + d0 * 16); }
        float m_reg = sink2, l_reg = 1.f; f32x16 o[2] = {};
        for (int jt = 0; jt < 6; ++jt) {
            const int kp0 = P0 + jt * 64;
            if (kp0 + 63 < q0 - 128 || kp0 > q0 + 31 + 128 || kp0 + 63 < 0 || kp0 >= SEQ) continue;
            f32x16 p0 = {}, p1 = {};
#pragma unroll
            for (int d0 = 0; d0 < 4; ++d0) {
                const bf16x8 k0 = *(const LAS bf16x8*)(lds + AA_K + (jt * 64 + r32) * AA_PITCH + (d0 * 16 + hi * 8) * 2);
                const bf16x8 k1 = *(const LAS bf16x8*)(lds + AA_K + (jt * 64 + 32 + r32) * AA_PITCH + (d0 * 16 + hi * 8) * 2);
                p0 = __builtin_amdgcn_mfma_f32_32x32x16_bf16(k0, qr[d0], p0, 0, 0, 0);
                p1 = __builtin_amdgcn_mfma_f32_32x32x16_bf16(k1, qr[d0], p1, 0, 0, 0);
            }
            float pmax = -1e30f;
#pragma unroll
            for (int r = 0; r < 16; ++r) {
                { const int kp = kp0 + crow(r, hi); const int dist = tq > kp ? tq - kp : kp - tq; const bool ok = dist <= 128 && kp >= 0 && kp < SEQ;
                  p0[r] = ok ? p0[r] * C - slope2 * (float)dist : -1e30f; pmax = fmaxf(pmax, p0[r]); }
                { const int kp = kp0 + 32 + crow(r, hi); const int dist = tq > kp ? tq - kp : kp - tq; const bool ok = dist <= 128 && kp >= 0 && kp < SEQ;
                  p1[r] = ok ? p1[r] * C - slope2 * (float)dist : -1e30f; pmax = fmaxf(pmax, p1[r]); }
            }
            { auto rr = __builtin_amdgcn_permlane32_swap(__float_as_uint(pmax), __float_as_uint(pmax), false, false); pmax = fmaxf(__uint_as_float(rr[0]), __uint_as_float(rr[1])); }
            const float mn = fmaxf(m_reg, pmax); const float alpha = __builtin_amdgcn_exp2f(m_reg - mn); m_reg = mn;
            float ps = 0.f;
#pragma unroll
            for (int r = 0; r < 16; ++r) { p0[r] = __builtin_amdgcn_exp2f(p0[r] - mn); p1[r] = __builtin_amdgcn_exp2f(p1[r] - mn); ps += p0[r] + p1[r]; }
            { auto rr = __builtin_amdgcn_permlane32_swap(__float_as_uint(ps), __float_as_uint(ps), false, false); ps = __uint_as_float(rr[0]) + __uint_as_float(rr[1]); }
            l_reg = l_reg * alpha + ps;
            if (hi == 0) wsf[r32] = alpha;
            WAIT_L0();
#pragma unroll
            for (int r = 0; r < 16; ++r) { const float a = wsf[crow(r, hi)]; o[0][r] *= a; o[1][r] *= a; }
            bf16x8 pa[4];
#define PK4(P, BASE, OUT) do { unsigned a0 = pk_bf16(P[BASE + 0], P[BASE + 1]), a1 = pk_bf16(P[BASE + 2], P[BASE + 3]); \
    unsigned b0 = pk_bf16(P[BASE + 4], P[BASE + 5]), b1 = pk_bf16(P[BASE + 6], P[BASE + 7]); \
    auto r0_ = __builtin_amdgcn_permlane32_swap(a0, b0, false, false); auto r1_ = __builtin_amdgcn_permlane32_swap(a1, b1, false, false); \
    u32x4 w_ = {r0_[0], r1_[0], r0_[1], r1_[1]}; OUT = __builtin_bit_cast(bf16x8, w_); } while (0)
            PK4(p0, 0, pa[0]); PK4(p0, 8, pa[1]); PK4(p1, 0, pa[2]); PK4(p1, 8, pa[3]);
            const int g16 = (lane >> 4) & 1, qq = (lane & 15) >> 2, pp = lane & 3;
#pragma unroll
            for (int db = 0; db < 2; ++db) {
#pragma unroll
                for (int ks = 0; ks < 4; ++ks) {
                    const LAS char* vp = lds + AA_V + (jt * 64 + ks * 16 + 8 * hi + qq) * AA_PITCH + (db * 32 + 16 * g16 + 4 * pp) * 2;
                    const s16x4 lo = vtr(vp), hh = vtr(vp + 4 * AA_PITCH);
                    const bf16x8 vb = (bf16x8){lo[0], lo[1], lo[2], lo[3], hh[0], hh[1], hh[2], hh[3]};
                    o[db] = __builtin_amdgcn_mfma_f32_32x32x16_bf16(pa[ks], vb, o[db], 0, 0, 0);
                }
            }
            WAIT_L0();
        }
        if (hi == 0) wsf[r32] = 1.f / l_reg;
        WAIT_L0();
        const float g0 = ga[r32], g1 = ga[32 + r32];
#pragma unroll
        for (int r = 0; r < 16; ++r) { const int qrow = crow(r, hi); const float il = wsf[qrow]; const float v0 = o[0][r] * il, v1 = o[1][r] * il;
            const size_t tok = (size_t)(b * SEQ + q0 + qrow);
            bf16_t* yp = Y + tok * 2048 + hq * 64;
            yp[r32] = (bf16_t)(pk_bf16(v0 * g0, 0.f) & 0xffffu); yp[32 + r32] = (bf16_t)(pk_bf16(v1 * g1, 0.f) & 0xffffu);
            float ss = v0 * v0 + v1 * v1;
#pragma unroll
            for (int s = 16; s >= 1; s >>= 1) ss += __shfl_xor(ss, s, 64);
            if (r32 == 0) ssqa[tok * 24 + hq] = ss; }
        WAIT_L0();
    }
}

constexpr int MB_V = 0, MB_KN = 32768, MB_KP = 65536, MB_WS = 81920, MB_QP = 83968;
#define KSWZ(row, colB) ((row) * 256 + ((colB) ^ (((row) & 7) << 4)))
#define KPSWZ(row, colB) ((row) * 128 + ((colB) ^ (((row) & 7) << 4)))
constexpr float MLA_SCALE = 0.07216878364870322f;
constexpr float MLA_THR = 8.f;
__device__ __forceinline__ void mla_partialSM(f32x16& p0, f32x16& p1, float& m_reg, float& mn, float& alpha) {
    constexpr float C = MLA_SCALE * LOG2E;
    float pmax = p0[0];
#pragma unroll
    for (int r = 1; r < 16; ++r) pmax = fmaxf(pmax, p0[r]);
#pragma unroll
    for (int r = 0; r < 16; ++r) pmax = fmaxf(pmax, p1[r]);
    { auto rr = __builtin_amdgcn_permlane32_swap(__float_as_uint(pmax), __float_as_uint(pmax), false, false); pmax = fmaxf(__uint_as_float(rr[0]), __uint_as_float(rr[1])); }
    if (__builtin_expect(__all(pmax - m_reg <= MLA_THR / MLA_SCALE), 1)) { mn = m_reg; alpha = 1.f; }
    else { mn = fmaxf(m_reg, pmax); alpha = __builtin_amdgcn_exp2f((m_reg - mn) * C); m_reg = mn; }
    const float mnC = -mn * C;
#pragma unroll
    for (int r = 0; r < 16; ++r) p0[r] = fmaf(p0[r], C, mnC);
#pragma unroll
    for (int r = 0; r < 16; ++r) p1[r] = fmaf(p1[r], C, mnC);
#pragma unroll
    for (int r = 0; r < 16; ++r) p0[r] = __builtin_amdgcn_exp2f(p0[r]);
}
__device__ __forceinline__ void mla_finishSM(f32x16& p0, f32x16& p1, float alpha, float& l_reg, bf16x8& pa0, bf16x8& pa1, bf16x8& pa2, bf16x8& pa3) {
#pragma unroll
    for (int r = 0; r < 16; ++r) p1[r] = __builtin_amdgcn_exp2f(p1[r]);
    float ps = 0;
#pragma unroll
    for (int r = 0; r < 16; ++r) ps += p0[r];
#pragma unroll
    for (int r = 0; r < 16; ++r) ps += p1[r];
    { auto rr = __builtin_amdgcn_permlane32_swap(__float_as_uint(ps), __float_as_uint(ps), false, false); ps = __uint_as_float(rr[0]) + __uint_as_float(rr[1]); }
    l_reg = l_reg * alpha + ps;
    PK4(p0, 0, pa0); PK4(p0, 8, pa1); PK4(p1, 0, pa2); PK4(p1, 8, pa3);
}
__device__ __forceinline__ void mla_qkt(f32x16& p0, f32x16& p1, const LAS char* Kn, const LAS char* Kp, const bf16x8* qr, const LAS char* qp, int r32, int hi) {
    p0 = f32x16{}; p1 = f32x16{};
#pragma unroll
    for (int d0 = 0; d0 < 8; ++d0) { const int cb = (d0 * 16 + hi * 8) * 2;
        const bf16x8 b0 = *(const LAS bf16x8*)(Kn + KSWZ(r32, cb)); const bf16x8 b1 = *(const LAS bf16x8*)(Kn + KSWZ(32 + r32, cb));
        p0 = __builtin_amdgcn_mfma_f32_32x32x16_bf16(b0, qr[d0], p0, 0, 0, 0); p1 = __builtin_amdgcn_mfma_f32_32x32x16_bf16(b1, qr[d0], p1, 0, 0, 0); }
#pragma unroll
    for (int d0 = 0; d0 < 4; ++d0) { const int cb = (d0 * 16 + hi * 8) * 2;
        const bf16x8 b0 = *(const LAS bf16x8*)(Kp + KPSWZ(r32, cb)); const bf16x8 b1 = *(const LAS bf16x8*)(Kp + KPSWZ(32 + r32, cb));
        const bf16x8 q = *(const LAS bf16x8*)(qp + d0 * 1024);
        p0 = __builtin_amdgcn_mfma_f32_32x32x16_bf16(b0, q, p0, 0, 0, 0); p1 = __builtin_amdgcn_mfma_f32_32x32x16_bf16(b1, q, p1, 0, 0, 0); }
}
__device__ __forceinline__ int v_st(int k, int c) { const int kk = (k & ~0xC) | ((k & 4) << 1) | ((k & 8) >> 1); return ((kk >> 3) * 4 + (c >> 5)) * 512 + ((kk & 7) * 32 + (c & 31)) * 2; }
__device__ __forceinline__ int v_rd_base(int lane) { return ((lane & 3) << 3) | (((lane >> 2) & 3) << 6) | (((lane >> 4) & 1) << 5) | (((lane >> 5) & 1) << 8); }
constexpr int v_rd_off(int d0, int ks, int half) { return d0 * 512 + ks * 4096 + half * 2048; }
template <int D0> __device__ __forceinline__ void mla_pv_one(f32x16& od, const LAS char* vb, bf16x8 pa0, bf16x8 pa1, bf16x8 pa2, bf16x8 pa3) {
    const s16x4 l0 = vtr(vb + v_rd_off(D0, 0, 0)), h0 = vtr(vb + v_rd_off(D0, 0, 1)), l1 = vtr(vb + v_rd_off(D0, 1, 0)), h1 = vtr(vb + v_rd_off(D0, 1, 1));
    const s16x4 l2 = vtr(vb + v_rd_off(D0, 2, 0)), h2 = vtr(vb + v_rd_off(D0, 2, 1)), l3 = vtr(vb + v_rd_off(D0, 3, 0)), h3 = vtr(vb + v_rd_off(D0, 3, 1));
#define PKV(L, H) (bf16x8){L[0], L[1], L[2], L[3], H[0], H[1], H[2], H[3]}
    od = __builtin_amdgcn_mfma_f32_32x32x16_bf16(pa0, PKV(l0, h0), od, 0, 0, 0);
    od = __builtin_amdgcn_mfma_f32_32x32x16_bf16(pa1, PKV(l1, h1), od, 0, 0, 0);
    od = __builtin_amdgcn_mfma_f32_32x32x16_bf16(pa2, PKV(l2, h2), od, 0, 0, 0);
    od = __builtin_amdgcn_mfma_f32_32x32x16_bf16(pa3, PKV(l3, h3), od, 0, 0, 0);
#undef PKV
}
__device__ __forceinline__ void mla_pv(f32x16* o, const LAS char* vb, bf16x8 pa0, bf16x8 pa1, bf16x8 pa2, bf16x8 pa3) {
    mla_pv_one<0>(o[0], vb, pa0, pa1, pa2, pa3); mla_pv_one<1>(o[1], vb, pa0, pa1, pa2, pa3); mla_pv_one<2>(o[2], vb, pa0, pa1, pa2, pa3); mla_pv_one<3>(o[3], vb, pa0, pa1, pa2, pa3);
}
__device__ __forceinline__ void mla_unit(const Params& p, LAS char* lds, int u) {
    const int tid = threadIdx.x, wid = __builtin_amdgcn_readfirstlane(tid >> 6), lane = tid & 63, r32 = lane & 31, hi = lane >> 5;
    const int bh = u >> 4, qb = u & 15, b = bh >> 3, h = bh & 7;
    const bf16_t* QB = (const bf16_t*)(p.ws + WS_QB); const bf16_t* KVB = (const bf16_t*)(p.ws + WS_KVB); const bf16_t* KPE = (const bf16_t*)(p.ws + WS_KPE);
    const bf16_t* Kh = KVB + (size_t)b * SEQ * 2048 + h * 256;
    const bf16_t* Ph = KPE + (size_t)b * SEQ * 64;
    LAS float* wsf = (LAS float*)(lds + MB_WS) + wid * 64; LAS float* li_l = wsf; LAS float* al_l = wsf + 32;
    float m_reg = -1e30f, l_reg = 0; f32x16 o[4] = {}; bf16x8 qr[8];
    LAS char* qp = lds + MB_QP + wid * 4096 + lane * 16;
    { const bf16_t* Qw = QB + ((size_t)(b * SEQ + qb * 256 + wid * 32 + r32)) * 1536 + h * 192 + hi * 8;
#pragma unroll
      for (int d0 = 0; d0 < 8; ++d0) qr[d0] = *(const bf16x8*)(Qw + d0 * 16);
      __syncthreads();
#pragma unroll
      for (int d0 = 0; d0 < 4; ++d0) *(LAS bf16x8*)(qp + d0 * 1024) = *(const bf16x8*)(Qw + (8 + d0) * 16); }
    const int sr = tid >> 4, sc = (tid & 15) * 8, vst0 = v_st(sr, sc), vst1 = v_st(32 + sr, sc);
    const int pr = tid >> 3, pc = (tid & 7) * 8;
    const LAS char* vb0 = lds + MB_V + v_rd_base(lane);
    bf16x8 vs0, vs1, ks0, ks1, kp0;
#define SLOAD(k0) do { vs0 = *(const bf16x8*)(Kh + (size_t)((k0) + sr) * 2048 + 128 + sc); vs1 = *(const bf16x8*)(Kh + (size_t)((k0) + 32 + sr) * 2048 + 128 + sc); \
    ks0 = *(const bf16x8*)(Kh + (size_t)((k0) + sr) * 2048 + sc); ks1 = *(const bf16x8*)(Kh + (size_t)((k0) + 32 + sr) * 2048 + sc); \
    kp0 = *(const bf16x8*)(Ph + (size_t)((k0) + pr) * 64 + pc); } while (0)
#define SWRITE(bb) do { *(LAS bf16x8*)(lds + MB_V + (bb) * 16384 + vst0) = vs0; *(LAS bf16x8*)(lds + MB_V + (bb) * 16384 + vst1) = vs1; \
    *(LAS bf16x8*)(lds + MB_KN + (bb) * 16384 + KSWZ(sr, sc * 2)) = ks0; *(LAS bf16x8*)(lds + MB_KN + (bb) * 16384 + KSWZ(32 + sr, sc * 2)) = ks1; \
    *(LAS bf16x8*)(lds + MB_KP + (bb) * 8192 + KPSWZ(pr, pc * 2)) = kp0; } while (0)
#define RESC(a) do { if (__any((a) < 1.f)) { if (hi == 0) al_l[r32] = (a); WAIT_L0(); \
    _Pragma("unroll") for (int d = 0; d < 4; ++d) _Pragma("unroll") for (int r = 0; r < 16; ++r) o[d][r] *= al_l[crow(r, hi)]; } } while (0)
    f32x16 pA0, pA1, pB0, pB1; float mnA, mnB, alA, alB; bf16x8 pa0, pa1, pa2, pa3; constexpr int NT = SEQ / 64;
    SLOAD(0); SWRITE(0); __syncthreads();
    mla_qkt(pA0, pA1, lds + MB_KN, lds + MB_KP, qr, qp, r32, hi); mla_partialSM(pA0, pA1, m_reg, mnA, alA);
    SLOAD(64); SWRITE(1); __syncthreads();
    for (int j = 1; j + 1 < NT; j += 2) {
        SBAR(); mla_qkt(pB0, pB1, lds + MB_KN + 16384, lds + MB_KP + 8192, qr, qp, r32, hi);
        mla_finishSM(pA0, pA1, alA, l_reg, pa0, pa1, pa2, pa3); SBAR();
        SLOAD((j + 1) * 64); SBAR();
        mla_pv(o, vb0, pa0, pa1, pa2, pa3); mla_partialSM(pB0, pB1, m_reg, mnB, alB);
        __syncthreads(); SWRITE(0);
        RESC(alB); __syncthreads();
        SBAR(); mla_qkt(pA0, pA1, lds + MB_KN, lds + MB_KP, qr, qp, r32, hi);
        mla_finishSM(pB0, pB1, alB, l_reg, pa0, pa1, pa2, pa3); SBAR();
        SLOAD((j + 2) * 64); SBAR();
        mla_pv(o, vb0 + 16384, pa0, pa1, pa2, pa3); mla_partialSM(pA0, pA1, m_reg, mnA, alA);
        __syncthreads(); SWRITE(1);
        RESC(alA); __syncthreads();
    }
    SBAR(); mla_qkt(pB0, pB1, lds + MB_KN + 16384, lds + MB_KP + 8192, qr, qp, r32, hi);
    mla_finishSM(pA0, pA1, alA, l_reg, pa0, pa1, pa2, pa3); SBAR();
    mla_pv(o, vb0, pa0, pa1, pa2, pa3); mla_partialSM(pB0, pB1, m_reg, mnB, alB);
    __syncthreads(); RESC(alB);
    mla_finishSM(pB0, pB1, alB, l_reg, pa0, pa1, pa2, pa3); SBAR();
    mla_pv(o, vb0 + 16384, pa0, pa1, pa2, pa3);
    if (hi == 0) li_l[r32] = l_reg; WAIT_L0();
    bf16_t* Y = (bf16_t*)(p.ws + WS_Y); float* ssqb = (float*)(p.ws + WS_SSQP);
    const float* gb = p.out_norm_b + h * 128;
    float g[4];
#pragma unroll
    for (int d0 = 0; d0 < 4; ++d0) g[d0] = gb[d0 * 32 + r32];
#pragma unroll
    for (int r = 0; r < 16; ++r) { const int orow = crow(r, hi); const float il = __builtin_amdgcn_rcpf(li_l[orow]);
        const size_t tok = (size_t)(b * SEQ + qb * 256 + wid * 32 + orow); bf16_t* yp = Y + tok * 2048 + 1024 + h * 128; float ss = 0.f;
#pragma unroll
        for (int d0 = 0; d0 < 4; ++d0) { const float v = o[d0][r] * il; ss += v * v; yp[d0 * 32 + r32] = (bf16_t)(pk_bf16(v * g[d0], 0.f) & 0xffffu); }
#pragma unroll
        for (int s = 16; s >= 1; s >>= 1) ss += __shfl_xor(ss, s, 64);
        if (r32 == 0) ssqb[tok * 24 + 16 + h] = ss; }
#undef SLOAD
#undef SWRITE
#undef RESC
}

__device__ __forceinline__ void phase_router(const Params& p, LAS char* lds) {
    const int tid = threadIdx.x, wid = __builtin_amdgcn_readfirstlane(tid >> 6), lane = tid & 63;
    const float* x2 = (const float*)(p.ws + WS_X2); const float* wg = (const float*)(p.ws + WS_WRT);
    unsigned char* xn8 = p.ws + WS_XN; unsigned* cnt = (unsigned*)(p.ws + WS_CTL + CTL_CNT);
    int* tokl = (int*)(p.ws + WS_TOKL); int* sel_e = (int*)(p.ws + WS_SEL); int* sel_r = sel_e + NTOK * 4; float* sel_g = (float*)(sel_r + NTOK * 4);
    LAS float* part = (LAS float*)lds;
    LAS float* rsv = (LAS float*)(lds + 32768);
    LAS unsigned* hist = (LAS unsigned*)(lds + 32768 + 128); LAS unsigned* hbase = hist + 32;
    for (int t0 = blockIdx.x * 32; t0 < NTOK; t0 += gridDim.x * 32) {
        __syncthreads();
        if (tid < N_EXP) hist[tid] = 0u;
#pragma unroll 1
        for (int j = 0; j < 4; ++j) { const int t = t0 + 4 * wid + j; f32x4 xr[8]; float ss = 0.f;
#pragma unroll
            for (int i = 0; i < 8; ++i) { xr[i] = ((const f32x4*)(x2 + (size_t)t * D_MODEL))[lane + 64 * i]; ss += xr[i][0] * xr[i][0] + xr[i][1] * xr[i][1] + xr[i][2] * xr[i][2] + xr[i][3] * xr[i][3]; }
            const float rs = rsqrtf(wave_sum(ss) * (1.f / D_MODEL) + EPS);
            if (lane == 0) rsv[4 * wid + j] = rs;
#pragma unroll
            for (int i = 0; i < 8; ++i) { const f32x4 v = xr[i]; const f32x4 g = ((const f32x4*)p.mlp_norm)[lane + 64 * i]; const float s16 = 16.f * rs;
                *(unsigned*)(xn8 + (size_t)t * D_MODEL + 4 * (lane + 64 * i)) = pk4_fp8(s16 * v[0] * g[0], s16 * v[1] * g[1], s16 * v[2] * g[2], s16 * v[3] * g[3]); } }
        { f32x16 acc;
#pragma unroll
          for (int r = 0; r < 16; ++r) acc[r] = 0.f;
          const float* ap = x2 + (size_t)(t0 + (lane & 31)) * D_MODEL + 256 * wid + 4 * (lane >> 5);
          const float* bp = wg + (size_t)(256 * wid + 4 * (lane >> 5)) * N_EXP + (lane & 31);
#pragma unroll 4
          for (int c = 0; c < 32; ++c) { const f32x4 a4 = *(const f32x4*)(ap + 8 * c);
#pragma unroll
              for (int q = 0; q < 4; ++q) acc = __builtin_amdgcn_mfma_f32_32x32x2f32(a4[q], bp[(size_t)(8 * c + q) * N_EXP], acc, 0, 0, 0); }
#pragma unroll
          for (int r = 0; r < 16; ++r) part[wid * 1024 + crow(r, lane >> 5) * 32 + (lane & 31)] = acc[r]; }
        __syncthreads();
        int my_e[4]; unsigned my_lr[4]; float my_g[4];
#pragma unroll
        for (int j = 0; j < 4; ++j) { const int tl = 4 * wid + j;
            float v = -3.0e38f;
            if (lane < 32) { float s = 0.f;
#pragma unroll
                for (int w = 0; w < 8; ++w) s += part[w * 1024 + tl * 32 + lane];
                v = s * rsv[tl] + p.b_router[lane]; }
            float tv[4]; int ti[4];
#pragma unroll
            for (int r = 0; r < 4; ++r) {
                float bv = v; int bi = lane;
#pragma unroll
                for (int o = 32; o >= 1; o >>= 1) { const float ov = __shfl_xor(bv, o, 64); const int oi = __shfl_xor(bi, o, 64); if (ov > bv || (ov == bv && oi < bi)) { bv = ov; bi = oi; } }
                tv[r] = bv; ti[r] = bi; if (lane == bi) v = -3.0e38f;
            }
            const float e0 = 1.f, e1 = __expf(tv[1] - tv[0]), e2 = __expf(tv[2] - tv[0]), e3 = __expf(tv[3] - tv[0]); const float inv = 1.f / (e0 + e1 + e2 + e3);
            const float gts[4] = {e0 * inv, e1 * inv, e2 * inv, e3 * inv};
            my_e[j] = ti[lane & 3]; my_g[j] = gts[lane & 3]; my_lr[j] = 0u;
            if (lane < 4) my_lr[j] = __hip_atomic_fetch_add(hist + my_e[j], 1u, __ATOMIC_RELAXED, __HIP_MEMORY_SCOPE_WORKGROUP);
        }
        __syncthreads();
        if (tid < N_EXP) hbase[tid] = atomicAdd(cnt + tid * 16, hist[tid]);
        __syncthreads();
        if (lane < 4) {
#pragma unroll
            for (int j = 0; j < 4; ++j) { const int t = t0 + 4 * wid + j; const int e = my_e[j]; const unsigned rk = hbase[e] + my_lr[j];
                tokl[e * NTOK + rk] = t; sel_e[t * 4 + lane] = e; sel_r[t * 4 + lane] = (int)rk; sel_g[t * 4 + lane] = my_g[j]; }
        }
    }
}

__device__ __forceinline__ void phase_combine(const Params& p, const LAS int* s_roff) {
    const int tid = threadIdx.x, wid = tid >> 6, lane = tid & 63;
    const float* x2 = (const float*)(p.ws + WS_X2); const bf16_t* ys = (const bf16_t*)(p.ws + WS_YS);
    const int* sel_e = (const int*)(p.ws + WS_SEL); const int* sel_r = sel_e + NTOK * 4; const float* sel_g = (const float*)(sel_r + NTOK * 4);
    for (int t = blockIdx.x * 8 + wid; t < NTOK; t += gridDim.x * 8) {
        f32x4 v[8];
#pragma unroll
        for (int i = 0; i < 8; ++i) v[i] = ((const f32x4*)(x2 + (size_t)t * D_MODEL))[lane + 64 * i];
#pragma unroll
        for (int k = 0; k < 4; ++k) { const int e = sel_e[t * 4 + k]; const size_t slot = (size_t)(s_roff[e] + sel_r[t * 4 + k]); const float g = sel_g[t * 4 + k];
            const u32x2* yr = (const u32x2*)(ys + slot * D_MODEL);
#pragma unroll
            for (int i = 0; i < 8; ++i) { const u32x2 w = yr[lane + 64 * i]; v[i][0] += g * bf_lo(w[0]); v[i][1] += g * bf_hi(w[0]); v[i][2] += g * bf_lo(w[1]); v[i][3] += g * bf_hi(w[1]); } }
        float ss = 0.f;
#pragma unroll
        for (int i = 0; i < 8; ++i) ss += v[i][0] * v[i][0] + v[i][1] * v[i][1] + v[i][2] * v[i][2] + v[i][3] * v[i][3];
        ss = wave_sum(ss); const float rs = rsqrtf(ss * (1.f / D_MODEL) + EPS);
#pragma unroll
        for (int i = 0; i < 8; ++i) { const f32x4 g = ((const f32x4*)p.final_norm)[lane + 64 * i];
            ((f32x4*)(p.out + (size_t)t * D_MODEL))[lane + 64 * i] = (f32x4){v[i][0] * rs * g[0], v[i][1] * rs * g[1], v[i][2] * rs * g[2], v[i][3] * rs * g[3]}; }
    }
}

constexpr int NPHASE = 9;
__global__ void __launch_bounds__(512, 2) mega_fwd(Params p) {
    extern __shared__ __attribute__((aligned(1024))) char smem_raw[];
    LAS char* lds = (LAS char*)smem_raw;
    LAS unsigned* misc = (LAS unsigned*)(lds + LDS_MISC);
    const int tid = threadIdx.x;
    if (tid < 4) misc[tid] = 0u;
    __syncthreads();
    unsigned* bar = (unsigned*)(p.ws + WS_CTL + CTL_BAR);
    XcdBarrier xb = xcd_barrier_post(bar, (volatile LAS unsigned*)misc);
    const int lo = p.ph_lo, hi = p.ph_hi;
    const int G = gridDim.x, bid = blockIdx.x;
    const int xperm = (bid & 7) * (G >> 3) + (bid >> 3);
#ifdef PH_ONLY
#define IN(k) ((k)==PH_ONLY)
#else
#define IN(k) (lo <= (k) && (k) < hi)
#endif
#define SEAM(k) do { if (IN(k) && IN((k) + 1)) xcd_barrier(xb); } while (0)
    if (IN(0)) phase_prologue(p);
    SEAM(0);
    if (IN(1)) {
        for (int u = xperm; u < 32 * 8; u += G) {
            const int pn = u / 32, pm = u % 32;
            ARows af{(const bf16_t*)(p.ws + WS_XN) + (size_t)pm * 256 * D_MODEL, (unsigned)D_MODEL};
            BPlain bf{p.w_in + pn * 256, (size_t)IN_COLS, 256};
            EpiProj ep{pn, pm * 256, p.ws, p.b_q_norm, p.b_kv_norm};
            gemm_unit<false>(lds, D_MODEL / 64, af, bf, ep);
        }
    }
    SEAM(1);
    if (IN(2)) {
        { const int b0 = bid;
            if ((b0 & 3) == 0) {
                const int h = b0 >> 2, pn = 8 + (h >> 5), pm = h & 31;
                ARows af{(const bf16_t*)(p.ws + WS_XN) + (size_t)pm * 256 * D_MODEL, (unsigned)D_MODEL};
                BPlain bf{p.w_in + pn * 256, (size_t)IN_COLS, pn == 9 ? 64 : 256};
                EpiProj ep{pn, pm * 256, p.ws, p.b_q_norm, p.b_kv_norm};
                gemm_unit<false>(lds, D_MODEL / 64, af, bf, ep);
            } else {
                const int v = (b0 >> 2) * 3 + (b0 & 3) - 1;
                { const int pn = v / 32, pm = v % 32;
                  ARows af{(const bf16_t*)(p.ws + WS_CQ) + (size_t)pm * 256 * 512, 512u};
                  BPlain bf{p.b_w_uq + pn * 256, (size_t)1536, 256};
                  EpiQUp ep{pn, pm * 256, p.ws};
                  gemm_unit<false>(lds, 512 / 64, af, bf, ep); }
                attn_a_unit(p, lds, v);
                if (v < 64) attn_a_unit(p, lds, 192 + v);
            }
        }
        xcd_barrier(xb);
        for (int u = xperm; u < 32 * 8; u += G) {
            const int pn = u / 32, pm = u % 32;
            ARows af{(const bf16_t*)(p.ws + WS_CKV) + (size_t)pm * 256 * 256, 256u};
            BPlain bf{p.b_w_ukv + pn * 256, (size_t)2048, 256};
            EpiKvUp ep{pn, pm * 256, p.ws};
            gemm_unit<false>(lds, 256 / 64, af, bf, ep);
        }
    }
    SEAM(2);
    if (IN(3)) { for (int u = xperm; u < 256; u += G) mla_unit(p, lds, u); }
    SEAM(3);
    if (IN(4)) {
        __syncthreads();
        for (int u = xperm; u < 32 * 8; u += G) {
            const int pn = u / 32, pm = u % 32;
            ARows af{(const bf16_t*)(p.ws + WS_Y) + (size_t)pm * 256 * D_MODEL, (unsigned)D_MODEL};
            BPlain bf{p.w_o + pn * 256, (size_t)D_MODEL, 256};
            LAS float* tab = (LAS float*)(lds + 2 * G_STAGE_B);
            __syncthreads();
            if (tid < 256) { const f32x4* pp = (const f32x4*)((const float*)(p.ws + WS_SSQP) + (size_t)(pm * 256 + tid) * 24); float sa = 0.f, sb2 = 0.f;
#pragma unroll
                for (int q = 0; q < 4; ++q) { const f32x4 v = pp[q]; sa += (v[0] + v[1]) + (v[2] + v[3]); }
#pragma unroll
                for (int q = 4; q < 6; ++q) { const f32x4 v = pp[q]; sb2 += (v[0] + v[1]) + (v[2] + v[3]); }
                tab[tid] = sa * (1.f / 1024.f); tab[256 + tid] = sb2 * (1.f / 1024.f); }
            __syncthreads();
            EpiWo ep{pn, pm * 256, p.ws, p.x, tab};
            gemm_unit<true>(lds, D_MODEL / 64, af, bf, ep);
        }
    }
    SEAM(4);
    if (IN(5)) phase_router(p, lds);
    SEAM(5);
    LAS int* s_cnt = (LAS int*)(misc + 16); LAS int* s_toff = (LAS int*)(misc + 48); LAS int* s_roff = (LAS int*)(misc + 96);
    if (IN(6) || IN(7) || IN(8)) {
        if (tid == 0) { const unsigned* cnt = (const unsigned*)(p.ws + WS_CTL + CTL_CNT); int to = 0;
            for (int e = 0; e < N_EXP; ++e) { const int c = (int)xb_ld((unsigned*)cnt + e * 16); s_cnt[e] = c; s_toff[e] = to; s_roff[e] = to * 256; to += (c + 255) >> 8; }
            s_toff[N_EXP] = to; }
        __syncthreads();
    }
    if (IN(6)) {
        const int TM = s_toff[N_EXP];
#ifdef PROBE_P6
        for (int rep = 0; rep < 2; ++rep)
#endif
        for (int L = xperm; L < TM * 16; L += G) {
            int e = 0; while (s_toff[e + 1] * 16 <= L) ++e;
            const int w = L - s_toff[e] * 16, nte = s_toff[e + 1] - s_toff[e], ntile = w / nte, mt = w - ntile * nte, cntE = s_cnt[e];
            AGather8 af{p.ws + WS_XN, (const int*)(p.ws + WS_TOKL) + (size_t)e * NTOK, mt * 256, cntE};
            BGateUp bf{p.w_up + (size_t)e * D_MODEL * (2 * D_FF) + ntile * 128, (size_t)(2 * D_FF)};
            EpiUp8 ep{ntile * 128, mt * 256, cntE, p.ws + WS_ACT + ((size_t)s_roff[e] + mt * 256) * D_FF, p.b_up + (size_t)e * (2 * D_FF)};
            gemm_unit8<0x7B7B7B7B>(lds, (LAS unsigned*)(misc + 8), D_MODEL / 64, af, bf, ep);
        }
    }
    SEAM(6);
    if (IN(7)) {
        const int TM = s_toff[N_EXP];
#ifdef PROBE_P7
        for (int rep = 0; rep < 2; ++rep)
#endif
        for (int L = xperm; L < TM * 8; L += G) {
            int e = 0; while (s_toff[e + 1] * 8 <= L) ++e;
            const int w = L - s_toff[e] * 8, nte = s_toff[e + 1] - s_toff[e], ntile = w / nte, mt = w - ntile * nte, cntE = s_cnt[e];
            ARows8 af{p.ws + WS_ACT + ((size_t)s_roff[e] + mt * 256) * D_FF, (unsigned)D_FF};
            BPlain bf{p.w_down + (size_t)e * D_FF * D_MODEL + ntile * 256, (size_t)D_MODEL, 256};
            EpiDown8 ep{ntile * 256, mt * 256, cntE, (bf16_t*)(p.ws + WS_YS) + ((size_t)s_roff[e] + mt * 256) * D_MODEL, p.b_down + (size_t)e * D_MODEL};
            gemm_unit8<0x7D7D7D7D>(lds, (LAS unsigned*)(misc + 8), D_FF / 64, af, bf, ep);
        }
    }
    SEAM(7);
    if (IN(8)) phase_combine(p, s_roff);
}

extern "C" void kernel_launch(void* const* d_in, const int* in_sizes, int n_in, void* d_out, int out_size, void* d_ws, size_t ws_size, hipStream_t stream) {
    static int ready = 0;
    if (!ready) {
        if (hipFuncSetAttribute((const void*)mega_fwd, hipFuncAttributeMaxDynamicSharedMemorySize, LDS_BYTES) != hipSuccess) { fprintf(stderr, "kernel_launch: hipFuncSetAttribute failed\n"); return; }
        int per_cu = 0; hipOccupancyMaxActiveBlocksPerMultiprocessor(&per_cu, (const void*)mega_fwd, 512, LDS_BYTES);
        if (per_cu < 1) { fprintf(stderr, "kernel_launch: occupancy query says 0 blocks per CU\n"); return; }
        ready = 1;
    }
    if (ws_size < WS_END) { fprintf(stderr, "kernel_launch: workspace too small\n"); return; }
    hipMemsetAsync((unsigned char*)d_ws + WS_CTL, 0, CTL_BYTES, stream);
    Params p{};
    const float** f = (const float**)&p;
    for (int i = 0; i < 19; ++i) f[i] = (const float*)d_in[i];
    p.out = (float*)d_out; p.ws = (unsigned char*)d_ws; p.ph_lo = 0; p.ph_hi = NPHASE;
    hipLaunchKernelGGL(mega_fwd, dim3(256), dim3(512), LDS_BYTES, stream, p);
}
```

```cpp
#include <hip/hip_runtime.h>
#include <stdint.h>
#include <stdio.h>

#define LAS __attribute__((address_space(3)))
typedef unsigned short bf16_t;
typedef short bf16x8 __attribute__((ext_vector_type(8)));
typedef short s16x4 __attribute__((ext_vector_type(4)));
typedef short v4i16_t __attribute__((ext_vector_type(4)));
typedef float f32x2 __attribute__((ext_vector_type(2)));
typedef float f32x4 __attribute__((ext_vector_type(4)));
typedef float f32x16 __attribute__((ext_vector_type(16)));
typedef int i32x4 __attribute__((ext_vector_type(4)));
typedef unsigned u32x2 __attribute__((ext_vector_type(2)));
typedef unsigned u32x4 __attribute__((ext_vector_type(4)));
typedef __bf16 bf16x2_t __attribute__((ext_vector_type(2)));
typedef int v8i __attribute__((ext_vector_type(8)));
typedef int v2i __attribute__((ext_vector_type(2)));
typedef short v2s __attribute__((ext_vector_type(2)));

constexpr int D_MODEL = 2048, SEQ = 4096, BATCH = 2, NTOK = BATCH * SEQ;
constexpr int IN_COLS = 2368;
constexpr int N_EXP = 32, TOP_K = 4, D_FF = 2048;
constexpr float EPS = 1e-5f;
constexpr float LOG2E = 1.4426950408889634f;

constexpr size_t MiB = 1u << 20;
constexpr size_t WS_CTL = 0, CTL_BYTES = 1 * MiB;
constexpr size_t WS_XN = 1 * MiB, WS_QA = 33 * MiB, WS_KA = 49 * MiB, WS_VA = 53 * MiB, WS_CQ = 57 * MiB, WS_CKV = 65 * MiB, WS_KPE = 69 * MiB;
constexpr size_t WS_QB = 70 * MiB, WS_KVB = 94 * MiB, WS_Y = 126 * MiB, WS_X2 = 158 * MiB, WS_ROPE = 222 * MiB, WS_WRT = 223 * MiB;
constexpr size_t WS_TOKL = 224 * MiB, WS_SEL = 225 * MiB, WS_ACT = 226 * MiB, WS_YS = 386 * MiB, WS_END = 546 * MiB;
constexpr size_t WS_SSQP = WS_WRT + 262144;
constexpr size_t WS_SSQC = WS_SEL + 524288;
constexpr size_t WS_SSQK = WS_SEL + 786432;
constexpr size_t CTL_BAR = 0, CTL_CNT = 16384, CTL_SSQ_CQ = 65536, CTL_SSQ_CKV = 98304, CTL_SSQ_A = 131072, CTL_SSQ_B = 163840, CTL_SSQ_X2 = 196608;

__device__ __forceinline__ unsigned pk_bf16(float lo, float hi) { f32x2 v = {lo, hi}; bf16x2_t b = __builtin_convertvector(v, bf16x2_t); return __builtin_bit_cast(unsigned, b); }
__device__ __forceinline__ unsigned pk4_fp8(float a, float b, float c, float d) { int w = __builtin_amdgcn_cvt_pk_fp8_f32(a, b, 0, false); w = __builtin_amdgcn_cvt_pk_fp8_f32(c, d, w, true); return (unsigned)w; }
__device__ __forceinline__ unsigned pk4_fp8_x64(f32x4 v) { v2s r; asm("" : "=v"(r));
    r = __builtin_amdgcn_cvt_scalef32_pk_fp8_f32(r, v[0], v[1], 0.015625f, false); r = __builtin_amdgcn_cvt_scalef32_pk_fp8_f32(r, v[2], v[3], 0.015625f, true); return __builtin_bit_cast(unsigned, r); }
__device__ __forceinline__ float bf_lo(unsigned u) { return __uint_as_float(u << 16); }
__device__ __forceinline__ float bf_hi(unsigned u) { return __uint_as_float(u & 0xffff0000u); }
__device__ __forceinline__ float wave_sum(float v) {
#pragma unroll
    for (int o = 32; o >= 1; o >>= 1) v += __shfl_xor(v, o, 64);
    return v;
}
__device__ __forceinline__ int crow(int r, int hi) { return (r & 3) + 8 * (r >> 2) + 4 * hi; }
__device__ __forceinline__ s16x4 vtr(const LAS char* p) { return __builtin_bit_cast(s16x4, __builtin_amdgcn_ds_read_tr16_b64_v4i16((LAS v4i16_t*)p)); }
#define SBAR() __builtin_amdgcn_sched_barrier(0)

#define XB_TMO      128
#define XB_XCNT(j)  (256  + 64 * (j))
#define XB_XSUB(j)  (1280 + 64 * (j))
#define XB_XGEN(j)  (2304 + 64 * (j))
#define XB_TOP      3328
#define XB_TOPGEN   3392
#define XCD_BAR_WORDS 3456
#define XB_SPIN_CAP (1u << 18)
__device__ __forceinline__ unsigned xb_ld(unsigned* p)              { return __hip_atomic_load(p, __ATOMIC_RELAXED, __HIP_MEMORY_SCOPE_AGENT); }
__device__ __forceinline__ unsigned xb_add(unsigned* p, unsigned v) { return __hip_atomic_fetch_add(p, v, __ATOMIC_RELAXED, __HIP_MEMORY_SCOPE_AGENT); }
__device__ __forceinline__ unsigned xb_xcc_id() { return (unsigned)__builtin_amdgcn_s_getreg((3 << 11) | 20) & 0xFu; }
#define XB_SPIN(cond, bar) do { unsigned _sp = 0; while (cond) { __builtin_amdgcn_s_sleep(1); \
    if ((++_sp & 255u) == 0u) { if (xb_ld(&(bar)[XB_TMO])) break; if (_sp > XB_SPIN_CAP) { atomicAdd(&(bar)[XB_TMO], 1u); break; } } } } while (0)
struct XcdBarrier { unsigned* bar; unsigned x; volatile LAS unsigned* st; };
__device__ __forceinline__ XcdBarrier xcd_barrier_post(unsigned* bar, volatile LAS unsigned* st) {
    XcdBarrier b; b.bar = bar; b.x = xb_xcc_id(); b.st = st;
    if (threadIdx.x == 0) (void)xb_add(&bar[XB_XCNT(b.x)], 1u);
    return b;
}
__device__ __forceinline__ void xcd_barrier_complete(unsigned* bar, unsigned x, unsigned& nloc, unsigned& nx) {
    const unsigned G = gridDim.x * gridDim.y * gridDim.z;
    unsigned sum, cnt, mine, sp = 0u;
    for (;;) {
        sum = 0u; cnt = 0u; mine = 0u;
#pragma unroll
        for (unsigned j = 0; j < 16; ++j) { const unsigned c = xb_ld(&bar[XB_XCNT(j)]); sum += c; cnt += (c > 0u) ? 1u : 0u; mine = (j == x) ? c : mine; }
        if (sum == G) break;
        __builtin_amdgcn_s_sleep(1);
        if ((++sp & 255u) == 0u) { if (xb_ld(&bar[XB_TMO])) break; if (sp > XB_SPIN_CAP) { atomicAdd(&bar[XB_TMO], 1u); break; } }
    }
    nloc = mine > 0u ? mine : 1u; nx = cnt > 0u ? cnt : 1u;
}
__device__ __forceinline__ void xcd_barrier(const XcdBarrier& b) {
    asm volatile("s_waitcnt vmcnt(0)" ::: "memory");
    __syncthreads();
    if (threadIdx.x == 0) {
        unsigned* bar = b.bar;
        __builtin_amdgcn_s_waitcnt(0);
        unsigned nloc = b.st[0], nx = b.st[1];
        if (nloc == 0u) { xcd_barrier_complete(bar, b.x, nloc, nx); b.st[0] = nloc; b.st[1] = nx; }
        const unsigned old = xb_add(&bar[XB_XSUB(b.x)], 1u);
        const unsigned gen = old / nloc;
        if (old + 1u == (gen + 1u) * nloc) {
            __builtin_amdgcn_fence(__ATOMIC_RELEASE, "agent");
            asm volatile("s_waitcnt vmcnt(0)" ::: "memory");
            const unsigned og = xb_add(&bar[XB_TOP], 1u);
            const unsigned tg = og / nx;
            if (og + 1u == (tg + 1u) * nx) xb_add(&bar[XB_TOPGEN], 1u);
            else XB_SPIN(xb_ld(&bar[XB_TOPGEN]) == tg, bar);
            __builtin_amdgcn_fence(__ATOMIC_ACQUIRE, "agent");
            xb_add(&bar[XB_XGEN(b.x)], 1u);
            asm volatile("s_waitcnt vmcnt(0)" ::: "memory");
        } else {
            XB_SPIN(xb_ld(&bar[XB_XGEN(b.x)]) == gen, bar);
            __builtin_amdgcn_fence(__ATOMIC_ACQUIRE, "agent");
            asm volatile("s_waitcnt vmcnt(0)" ::: "memory");
        }
    }
    __syncthreads();
}

constexpr int A_TILE_B = 256 * 64 * 2;
constexpr int B_PITCH = 544;
constexpr int B_TILE_B = 64 * B_PITCH;
constexpr int G_STAGE_B = A_TILE_B + B_TILE_B;
constexpr int LDS_MISC = 155648;
constexpr int LDS_BYTES = LDS_MISC + 1024;

__device__ __forceinline__ int a_img_byte(int r, int chunk) { return r * 128 + ((chunk ^ ((r >> 1) & 7)) << 4); }
#define WAIT_L0() asm volatile("s_waitcnt lgkmcnt(0)" ::: "memory")
__device__ __forceinline__ void glds16(const void* gsrc, unsigned lds_dst) { unsigned keep;
    asm volatile("s_mov_b32 %0, m0\n\ts_mov_b32 m0, %2\n\ts_nop 0\n\tglobal_load_lds_dwordx4 %1, off\n\ts_mov_b32 m0, %0" : "=&s"(keep) : "v"(gsrc), "s"(lds_dst) : "memory"); }
#define RAW_BARRIER() do { WAIT_L0(); __builtin_amdgcn_s_barrier(); } while (0)

__device__ __forceinline__ const char* uniform_ptr(const void* p) {
    const unsigned long long v = (unsigned long long)p;
    const unsigned lo = __builtin_amdgcn_readfirstlane((unsigned)v), hi = __builtin_amdgcn_readfirstlane((unsigned)(v >> 32));
    return (const char*)(((unsigned long long)hi << 32) | lo);
}
__device__ __forceinline__ void glds16s(const char* sbase, unsigned voff, unsigned lds_dst) { unsigned keep;
    asm volatile("s_mov_b32 %0, m0\n\ts_mov_b32 m0, %3\n\ts_nop 4\n\tglobal_load_lds_dwordx4 %1, %2\n\ts_mov_b32 m0, %0" : "=&s"(keep) : "v"(voff), "s"(sbase), "s"(lds_dst) : "memory"); }
#define WAIT_V4(n, a, b, c, d) asm volatile("s_waitcnt vmcnt(" #n ")" : "+v"(a), "+v"(b), "+v"(c), "+v"(d) :: "memory")
template <bool MID, class AF, class BF, class EPI>
__device__ __forceinline__ void gemm_unit(LAS char* lds, const int nt, const AF& af, const BF& bf, EPI& epi) {
    const int tid = threadIdx.x, wid = __builtin_amdgcn_readfirstlane(tid >> 6), lane = tid & 63, wr = wid >> 2, wc = wid & 3, fr = lane & 15, fq = lane >> 4;
    const char* abase = uniform_ptr(af.base);
    unsigned aoff[4];
#pragma unroll
    for (int i = 0; i < 4; ++i) { const int R = wid * 8 + i * 64 + (lane >> 3), C = ((lane & 7) ^ ((R >> 1) & 7)) * 8; aoff[i] = (af.rowoff(R) + (unsigned)C) * 2u; }
    const int a_ldsw = wid * 1024;
    const unsigned lds_u = (unsigned)__builtin_amdgcn_readfirstlane((int)(unsigned)(size_t)lds);
    const size_t ldb4 = (size_t)bf.ld * 4;
    const char* bbase = uniform_ptr(bf.base) + (size_t)wid * ldb4;
    const unsigned boff = bf.coloff(4 * lane) * 4u;
    const int b_lds0 = A_TILE_B + wid * B_PITCH + 8 * lane, b_lds1 = A_TILE_B + wid * B_PITCH + ((8 * lane) ^ 128);
    const int a_rd0 = a_img_byte(wr * 128 + fr, fq), a_rd1 = a_rd0 ^ 64;
    const int b_rd = A_TILE_B + (8 * fq + ((lane & 15) >> 2)) * B_PITCH + ((wc ^ (fq & 1)) << 7) + 8 * (lane & 3);
    f32x4 acc[8][4];
#pragma unroll
    for (int m = 0; m < 8; ++m)
#pragma unroll
        for (int n = 0; n < 4; ++n) acc[m][n] = (f32x4){0.f, 0.f, 0.f, 0.f};
    f32x4 sb[8];
#define G_STAGE_A(i, kt, buf) glds16s(abase + (size_t)(kt) * 128, aoff[i], lds_u + (unsigned)((buf) * G_STAGE_B + a_ldsw + (i) * 8192))
#define G_ISSUE_B(i, kt) asm volatile("s_nop 4\n\tglobal_load_dwordx4 %0, %1, %2" : "=v"(sb[i]) : "v"(boff), "s"(bbase + ((size_t)(kt) * 64 + (i) * 8) * ldb4) : "memory")
#define G_WRITE_B(i, buf) do { u32x2 w_ = {pk_bf16(sb[i][0], sb[i][1]), pk_bf16(sb[i][2], sb[i][3])}; \
        *(LAS u32x2*)(lds + (buf) * G_STAGE_B + (((i) & 1) ? b_lds1 : b_lds0) + (i) * 8 * B_PITCH) = w_; } while (0)
#define G_KSTEP(buf, ks) do { bf16x8 At[8], Bf[4]; \
        _Pragma("unroll") for (int n = 0; n < 4; ++n) { const s16x4 lo_ = vtr(lds + (buf) * G_STAGE_B + b_rd + (ks) * 32 * B_PITCH + n * 32), hi_ = vtr(lds + (buf) * G_STAGE_B + b_rd + (ks) * 32 * B_PITCH + 4 * B_PITCH + n * 32); \
            Bf[n] = (bf16x8){lo_[0], lo_[1], lo_[2], lo_[3], hi_[0], hi_[1], hi_[2], hi_[3]}; } \
        _Pragma("unroll") for (int m = 0; m < 8; ++m) At[m] = *(const LAS bf16x8*)(lds + (buf) * G_STAGE_B + ((ks) ? a_rd1 : a_rd0) + m * 2048); \
        SBAR(); __builtin_amdgcn_s_setprio(1); \
        _Pragma("unroll") for (int m = 0; m < 8; ++m) _Pragma("unroll") for (int n = 0; n < 4; ++n) \
            acc[m][n] = __builtin_amdgcn_mfma_f32_16x16x32_bf16(Bf[n], At[m], acc[m][n], 0, 0, 0); \
        __builtin_amdgcn_s_setprio(0); SBAR(); } while (0)
#pragma unroll
    for (int i = 0; i < 4; ++i) G_STAGE_A(i, 0, 0);
#pragma unroll
    for (int i = 0; i < 8; ++i) G_ISSUE_B(i, 0);
    WAIT_V4(0, sb[0], sb[1], sb[2], sb[3]); WAIT_V4(0, sb[4], sb[5], sb[6], sb[7]);
#pragma unroll
    for (int i = 0; i < 8; ++i) G_WRITE_B(i, 0);
    SBAR();
#pragma unroll
    for (int i = 0; i < 8; ++i) G_ISSUE_B(i, 1);
    SBAR();
    RAW_BARRIER();
#pragma unroll 1
    for (int t = 0; t < nt; ++t) {
        const int cur = t & 1, nxt = cur ^ 1;
        if constexpr (MID) { if (t == (nt >> 1)) epi.mid(acc, wr, wc, fr, fq); }
        const int k1 = (t + 1 < nt) ? t + 1 : nt - 1, k2 = (t + 2 < nt) ? t + 2 : nt - 1;
        G_STAGE_A(0, k1, nxt); G_STAGE_A(1, k1, nxt); G_STAGE_A(2, k1, nxt); G_STAGE_A(3, k1, nxt);
        G_KSTEP(cur, 0);
        WAIT_V4(8, sb[0], sb[1], sb[2], sb[3]);
        G_WRITE_B(0, nxt); G_WRITE_B(1, nxt); G_WRITE_B(2, nxt); G_WRITE_B(3, nxt); SBAR();
        G_ISSUE_B(0, k2); G_ISSUE_B(1, k2); G_ISSUE_B(2, k2); G_ISSUE_B(3, k2); SBAR();
        G_KSTEP(cur, 1);
        WAIT_V4(8, sb[4], sb[5], sb[6], sb[7]);
        G_WRITE_B(4, nxt); G_WRITE_B(5, nxt); G_WRITE_B(6, nxt); G_WRITE_B(7, nxt); SBAR();
        G_ISSUE_B(4, k2); G_ISSUE_B(5, k2); G_ISSUE_B(6, k2); G_ISSUE_B(7, k2); SBAR();
        asm volatile("s_waitcnt vmcnt(8)" ::: "memory");
        RAW_BARRIER();
    }
    WAIT_V4(0, sb[0], sb[1], sb[2], sb[3]); WAIT_V4(0, sb[4], sb[5], sb[6], sb[7]);
    epi.fin(acc, wr, wc, fr, fq);
#undef G_STAGE_A
#undef G_ISSUE_B
#undef G_WRITE_B
#undef G_KSTEP
}

constexpr int A8_TILE_B = 16384, B8_PITCH = 288, B8_TILE_B = 64 * B8_PITCH;
constexpr int A8_RING = 5, B8_RING = 4, B8_OFF = A8_RING * A8_TILE_B;
static_assert(B8_OFF + B8_RING * B8_TILE_B <= LDS_MISC, "fp8 rings fit below the misc words");
__device__ __forceinline__ v2i vtr8(const LAS char* p) { return __builtin_amdgcn_ds_read_tr8_b64_v2i32((LAS v2i*)p); }
template <int SCALE_X, class AF, class BF, class EPI>
__device__ __forceinline__ void gemm_unit8(LAS char* lds, LAS unsigned* ring_cnt, const int nt, const AF& af, const BF& bf, EPI& epi) {
    const int tid = threadIdx.x, wid = __builtin_amdgcn_readfirstlane(tid >> 6), lane = tid & 63, wr = wid >> 2, wc = wid & 3, r32 = lane & 31, hi = lane >> 5;
    const char* abase = uniform_ptr(af.base);
    unsigned aoff[2];
#pragma unroll
    for (int i = 0; i < 2; ++i) { const int R = wid * 16 + i * 128 + (lane >> 2), C = ((lane & 3) ^ ((lane >> 4) & 3)) * 16; aoff[i] = af.rowoff(R) + (unsigned)C; }
    const unsigned lds_u = (unsigned)__builtin_amdgcn_readfirstlane((int)(unsigned)(size_t)lds) + (unsigned)(wid * 1024);
    const size_t ldb4 = (size_t)bf.ld * 4;
    const char* bbase = uniform_ptr(bf.base) + (size_t)wid * ldb4;
    const unsigned boff = bf.coloff(4 * lane) * 4u;
    const int b_wr = B8_OFF + wid * B8_PITCH + 4 * lane;
    const int a_rd0 = (wr * 128 + r32) * 64 + (((2 * hi) ^ ((r32 >> 2) & 3)) << 4), a_rd1 = a_rd0 ^ 16;
    const int b_rd = B8_OFF + (32 * hi + ((lane & 15) >> 1)) * B8_PITCH + wc * 64 + 16 * ((lane >> 4) & 1) + 8 * (lane & 1);
    f32x16 acc[4][2];
#pragma unroll
    for (int m = 0; m < 4; ++m)
#pragma unroll
        for (int n = 0; n < 2; ++n)
#pragma unroll
            for (int r = 0; r < 16; ++r) acc[m][n][r] = 0.f;
    f32x4 sb[8], sa[2];
    const int a_wr = wid * 1024 + lane * 16;
#define H_STAGE_A(i, kt, slot) glds16s(abase + (size_t)(kt) * 64, aoff[i], lds_u + (unsigned)((slot) * A8_TILE_B + (i) * 8192))
#define H_ISSUE_A(i, kt) asm volatile("s_nop 4\n\tglobal_load_dwordx4 %0, %1, %2" : "=v"(sa[i]) : "v"(aoff[i]), "s"(abase + (size_t)(kt) * 64) : "memory")
#define H_WRITE_A(i, slot) *(LAS f32x4*)(lds + (slot) * A8_TILE_B + a_wr + (i) * 8192) = sa[i]
#define H_ISSUE_B(i, kt) asm volatile("s_nop 4\n\tglobal_load_dwordx4 %0, %1, %2" : "=v"(sb[i]) : "v"(boff), "s"(bbase + ((size_t)(kt) * 64 + (i) * 8) * ldb4) : "memory")
#define H_WRITE_B(i, slot) *(LAS unsigned*)(lds + (slot) * B8_TILE_B + b_wr + (i) * 8 * B8_PITCH) = pk4_fp8_x64(sb[i])
#define H_KSTEP(sa, sbk) do { v8i Xf[4], Wf[2]; \
        _Pragma("unroll") for (int n = 0; n < 2; ++n) _Pragma("unroll") for (int r = 0; r < 4; ++r) { const v2i t_ = vtr8(lds + (sbk) * B8_TILE_B + b_rd + r * 8 * B8_PITCH + n * 32); Wf[n][2 * r] = t_[0]; Wf[n][2 * r + 1] = t_[1]; } \
        _Pragma("unroll") for (int m = 0; m < 4; ++m) { const i32x4 lo_ = *(const LAS i32x4*)(lds + (sa) * A8_TILE_B + a_rd0 + m * 2048), hi_ = *(const LAS i32x4*)(lds + (sa) * A8_TILE_B + a_rd1 + m * 2048); \
            Xf[m] = (v8i){lo_[0], lo_[1], lo_[2], lo_[3], hi_[0], hi_[1], hi_[2], hi_[3]}; } \
        SBAR(); __builtin_amdgcn_s_setprio(1); \
        _Pragma("unroll") for (int m = 0; m < 4; ++m) _Pragma("unroll") for (int n = 0; n < 2; ++n) \
            acc[m][n] = __builtin_amdgcn_mfma_scale_f32_32x32x64_f8f6f4(Wf[n], Xf[m], acc[m][n], 0, 0, 0, 0x79797979, 0, SCALE_X); \
        __builtin_amdgcn_s_setprio(0); SBAR(); } while (0)
    if (tid < 8) ring_cnt[tid] = 0u;
    H_STAGE_A(0, 0, 0); H_STAGE_A(1, 0, 0); H_STAGE_A(0, 1, 1); H_STAGE_A(1, 1, 1);
#pragma unroll
    for (int i = 0; i < 8; ++i) H_ISSUE_B(i, 0);
    WAIT_V4(0, sb[0], sb[1], sb[2], sb[3]); WAIT_V4(0, sb[4], sb[5], sb[6], sb[7]);
#pragma unroll
    for (int i = 0; i < 8; ++i) H_WRITE_B(i, 0);
    SBAR();
#pragma unroll
    for (int i = 0; i < 8; ++i) H_ISSUE_B(i, 1);
    WAIT_V4(0, sb[0], sb[1], sb[2], sb[3]); WAIT_V4(0, sb[4], sb[5], sb[6], sb[7]);
#pragma unroll
    for (int i = 0; i < 8; ++i) H_WRITE_B(i, 1);
    SBAR();
#pragma unroll
    for (int i = 0; i < 8; ++i) H_ISSUE_B(i, 2);
    H_ISSUE_A(0, 2); H_ISSUE_A(1, 2);
    SBAR();
    RAW_BARRIER();
    int sa_r = 0, sa_w = 2, sb_r = 0, sb_w = 2;
#pragma unroll 1
    for (int t = 0; t < nt; ++t) {
        if (t >= 2) {
            const unsigned need = (unsigned)(t - 1);
            for (;;) { asm volatile("" ::: "memory"); const unsigned v = *(volatile LAS unsigned*)(ring_cnt + (lane & 7)); if (__all(v >= need)) break; __builtin_amdgcn_s_sleep(1); }
            asm volatile("" ::: "memory");
        }
        const int k3 = (t + 3 < nt) ? t + 3 : nt - 1;
        H_KSTEP(sa_r, sb_r);
        WAIT_V4(6, sb[0], sb[1], sb[2], sb[3]);
        H_WRITE_B(0, sb_w); H_WRITE_B(1, sb_w); H_WRITE_B(2, sb_w); H_WRITE_B(3, sb_w); SBAR();
        H_ISSUE_B(0, k3); H_ISSUE_B(1, k3); H_ISSUE_B(2, k3); H_ISSUE_B(3, k3); SBAR();
        WAIT_V4(6, sb[4], sb[5], sb[6], sb[7]);
        H_WRITE_B(4, sb_w); H_WRITE_B(5, sb_w); H_WRITE_B(6, sb_w); H_WRITE_B(7, sb_w); SBAR();
        H_ISSUE_B(4, k3); H_ISSUE_B(5, k3); H_ISSUE_B(6, k3); H_ISSUE_B(7, k3); SBAR();
        asm volatile("s_waitcnt vmcnt(8)" : "+v"(sa[0]), "+v"(sa[1]) :: "memory");
        H_WRITE_A(0, sa_w); H_WRITE_A(1, sa_w); SBAR();
        H_ISSUE_A(0, k3); H_ISSUE_A(1, k3); SBAR();
        asm volatile("" ::: "memory");
        if (lane == 0) *(volatile LAS unsigned*)(ring_cnt + wid) = (unsigned)(t + 1);
        asm volatile("" ::: "memory");
        sa_r = (sa_r == A8_RING - 1) ? 0 : sa_r + 1; sa_w = (sa_w == A8_RING - 1) ? 0 : sa_w + 1;
        sb_r = (sb_r == B8_RING - 1) ? 0 : sb_r + 1; sb_w = (sb_w == B8_RING - 1) ? 0 : sb_w + 1;
    }
    WAIT_V4(0, sb[0], sb[1], sb[2], sb[3]); WAIT_V4(0, sb[4], sb[5], sb[6], sb[7]);
    asm volatile("s_waitcnt vmcnt(0)" : "+v"(sa[0]), "+v"(sa[1]) :: "memory");
    RAW_BARRIER();
    epi.fin(acc, wr, wc, r32, hi);
#undef H_STAGE_A
#undef H_ISSUE_B
#undef H_ISSUE_A
#undef H_WRITE_A
#undef H_WRITE_B
#undef H_KSTEP
}

struct Params {
    const float *x, *attn_norm, *w_in, *a_sink, *b_q_norm, *b_w_uq, *b_kv_norm, *b_w_ukv, *out_norm_a, *out_norm_b, *w_o, *mlp_norm, *w_router, *b_router,
        *w_up, *b_up, *w_down, *b_down, *final_norm;
    float* out; unsigned char* ws; int ph_lo, ph_hi;
};

struct ARows { const bf16_t* base; unsigned ld; __device__ __forceinline__ unsigned rowoff(int r) const { return (unsigned)r * ld; } };
struct AGather { const bf16_t* base; const int* tokl; int r0, cnt; __device__ __forceinline__ unsigned rowoff(int r) const { int rk = r0 + r; rk = rk < cnt ? rk : 0; return (unsigned)tokl[rk] * (unsigned)D_MODEL; } };
struct ARows8 { const unsigned char* base; unsigned ld; __device__ __forceinline__ unsigned rowoff(int r) const { return (unsigned)r * ld; } };
struct AGather8 { const unsigned char* base; const int* tokl; int r0, cnt; __device__ __forceinline__ unsigned rowoff(int r) const { int rk = r0 + r; rk = rk < cnt ? rk : 0; return (unsigned)tokl[rk] * (unsigned)D_MODEL; } };
struct BPlain { const float* base; size_t ld; int ncols;
    __device__ __forceinline__ unsigned coloff(int c) const { return (unsigned)(c < ncols ? c : (c & (ncols - 1))); } };
struct BGateUp { const float* base; size_t ld;
    __device__ __forceinline__ unsigned coloff(int c) const { const int wc = c >> 6, w = c & 63; return (unsigned)(wc * 32 + (w & 31) + ((w & 32) ? D_FF : 0)); } };

struct EpiProj {
    int pn, brow; unsigned char* ws; const float *qg, *kvg;
    __device__ __forceinline__ void mid(f32x4 (&)[8][4], int, int, int, int) {}
    __device__ __forceinline__ void fin(f32x4 (&acc)[8][4], int wr, int wc, int fr, int fq) {
        if (pn < 6) {
            bf16_t* dst; int ldd, c0;
            if (pn < 4) { dst = (bf16_t*)(ws + WS_QA); ldd = 1024; c0 = pn * 256; } else if (pn == 4) { dst = (bf16_t*)(ws + WS_KA); ldd = 256; c0 = 0; } else { dst = (bf16_t*)(ws + WS_VA); ldd = 256; c0 = 0; }
#pragma unroll
            for (int m = 0; m < 8; ++m) { const int row = brow + wr * 128 + m * 16 + fr;
#pragma unroll
                for (int n = 0; n < 4; ++n) { const int col = c0 + wc * 64 + n * 16 + fq * 4; const f32x4 v = acc[m][n];
                    *(u32x2*)(dst + (size_t)row * ldd + col) = (u32x2){pk_bf16(v[0], v[1]), pk_bf16(v[2], v[3])}; } }
        } else if (pn < 9) {
            bf16_t* dst; int ldd, c0; const float* g; float* ssq; int nsl, sl;
            if (pn < 8) { dst = (bf16_t*)(ws + WS_CQ); ldd = 512; c0 = (pn - 6) * 256; g = qg; ssq = (float*)(ws + WS_SSQC); nsl = 8; sl = (pn - 6) * 4 + wc; }
            else { dst = (bf16_t*)(ws + WS_CKV); ldd = 256; c0 = 0; g = kvg; ssq = (float*)(ws + WS_SSQK); nsl = 4; sl = wc; }
            f32x4 gvv[4];
#pragma unroll
            for (int n = 0; n < 4; ++n) gvv[n] = *(const f32x4*)(g + c0 + wc * 64 + n * 16 + fq * 4);
#pragma unroll
            for (int m = 0; m < 8; ++m) { const int row = brow + wr * 128 + m * 16 + fr; float ss = 0.f;
#pragma unroll
                for (int n = 0; n < 4; ++n) { const int col = c0 + wc * 64 + n * 16 + fq * 4; const f32x4 v = acc[m][n]; const f32x4 gv = gvv[n];
                    ss += v[0] * v[0] + v[1] * v[1] + v[2] * v[2] + v[3] * v[3];
                    *(u32x2*)(dst + (size_t)row * ldd + col) = (u32x2){pk_bf16(v[0] * gv[0], v[1] * gv[1]), pk_bf16(v[2] * gv[2], v[3] * gv[3])}; }
                ss += __shfl_xor(ss, 16, 64); ss += __shfl_xor(ss, 32, 64);
                if (fq == 0) ssq[(size_t)row * nsl + sl] = ss; }
        } else {
            if (wc == 0) {
                bf16_t* dst = (bf16_t*)(ws + WS_KPE); const float* rope = (const float*)(ws + WS_ROPE);
#pragma unroll
                for (int m = 0; m < 8; ++m) { const int row = brow + wr * 128 + m * 16 + fr; const int pos = row & (SEQ - 1);
#pragma unroll
                    for (int n = 0; n < 2; ++n) { const int i0 = n * 16 + fq * 4; const f32x4 x1 = acc[m][n], x2 = acc[m][n + 2];
                        const f32x4 cs0 = *(const f32x4*)(rope + ((size_t)pos * 32 + i0) * 2), cs1 = *(const f32x4*)(rope + ((size_t)pos * 32 + i0) * 2 + 4);
                        const float c[4] = {cs0[0], cs0[2], cs1[0], cs1[2]}, s[4] = {cs0[1], cs0[3], cs1[1], cs1[3]};
                        float o1[4], o2[4];
#pragma unroll
                        for (int j = 0; j < 4; ++j) { o1[j] = x1[j] * c[j] - x2[j] * s[j]; o2[j] = x1[j] * s[j] + x2[j] * c[j]; }
                        *(u32x2*)(dst + (size_t)row * 64 + i0) = (u32x2){pk_bf16(o1[0], o1[1]), pk_bf16(o1[2], o1[3])};
                        *(u32x2*)(dst + (size_t)row * 64 + 32 + i0) = (u32x2){pk_bf16(o2[0], o2[1]), pk_bf16(o2[2], o2[3])}; } }
            }
        }
    }
};
struct EpiQUp {
    int pn, brow; unsigned char* ws;
    __device__ __forceinline__ void mid(f32x4 (&)[8][4], int, int, int, int) {}
    __device__ __forceinline__ void fin(f32x4 (&acc)[8][4], int wr, int wc, int fr, int fq) {
        bf16_t* dst = (bf16_t*)(ws + WS_QB); const float* rope = (const float*)(ws + WS_ROPE); const float* ssq = (const float*)(ws + WS_CTL + CTL_SSQ_CQ);
        const int seg = pn * 4 + wc, head = seg / 3, part = seg - head * 3;
        float sq[8];
#pragma unroll
        for (int m = 0; m < 8; ++m) { const f32x4* pp = (const f32x4*)((const float*)(ws + WS_SSQC) + (size_t)(brow + wr * 128 + m * 16 + fr) * 8); const f32x4 p0 = pp[0], p1 = pp[1];
            sq[m] = ((p0[0] + p0[1]) + (p0[2] + p0[3])) + ((p1[0] + p1[1]) + (p1[2] + p1[3])); }
#pragma unroll
        for (int m = 0; m < 8; ++m) { const int row = brow + wr * 128 + m * 16 + fr; const float rs = rsqrtf(sq[m] * (1.f / 512.f) + EPS);
            bf16_t* drow = dst + (size_t)row * 1536 + head * 192 + part * 64;
            if (part < 2) {
#pragma unroll
                for (int n = 0; n < 4; ++n) { const f32x4 v = acc[m][n]; *(u32x2*)(drow + n * 16 + fq * 4) = (u32x2){pk_bf16(v[0] * rs, v[1] * rs), pk_bf16(v[2] * rs, v[3] * rs)}; }
            } else { const int pos = row & (SEQ - 1);
#pragma unroll
                for (int n = 0; n < 2; ++n) { const int i0 = n * 16 + fq * 4; const f32x4 x1 = acc[m][n], x2 = acc[m][n + 2];
                    const f32x4 cs0 = *(const f32x4*)(rope + ((size_t)pos * 32 + i0) * 2), cs1 = *(const f32x4*)(rope + ((size_t)pos * 32 + i0) * 2 + 4);
                    const float c[4] = {cs0[0], cs0[2], cs1[0], cs1[2]}, s[4] = {cs0[1], cs0[3], cs1[1], cs1[3]};
                    float o1[4], o2[4];
#pragma unroll
                    for (int j = 0; j < 4; ++j) { o1[j] = (x1[j] * c[j] - x2[j] * s[j]) * rs; o2[j] = (x1[j] * s[j] + x2[j] * c[j]) * rs; }
                    *(u32x2*)(drow + i0) = (u32x2){pk_bf16(o1[0], o1[1]), pk_bf16(o1[2], o1[3])};
                    *(u32x2*)(drow + 32 + i0) = (u32x2){pk_bf16(o2[0], o2[1]), pk_bf16(o2[2], o2[3])}; } }
        }
    }
};
struct EpiKvUp {
    int pn, brow; unsigned char* ws;
    __device__ __forceinline__ void mid(f32x4 (&)[8][4], int, int, int, int) {}
    __device__ __forceinline__ void fin(f32x4 (&acc)[8][4], int wr, int wc, int fr, int fq) {
        bf16_t* dst = (bf16_t*)(ws + WS_KVB);
        float sq[8];
#pragma unroll
        for (int m = 0; m < 8; ++m) { const f32x4 p0 = *(const f32x4*)((const float*)(ws + WS_SSQK) + (size_t)(brow + wr * 128 + m * 16 + fr) * 4); sq[m] = (p0[0] + p0[1]) + (p0[2] + p0[3]); }
#pragma unroll
        for (int m = 0; m < 8; ++m) { const int row = brow + wr * 128 + m * 16 + fr; const float rs = rsqrtf(sq[m] * (1.f / 256.f) + EPS);
#pragma unroll
            for (int n = 0; n < 4; ++n) { const int col = pn * 256 + wc * 64 + n * 16 + fq * 4; const f32x4 v = acc[m][n];
                *(u32x2*)(dst + (size_t)row * 2048 + col) = (u32x2){pk_bf16(v[0] * rs, v[1] * rs), pk_bf16(v[2] * rs, v[3] * rs)}; } }
    }
};
struct EpiWo {
    int pn, brow; unsigned char* ws; const float* x; const LAS float* tab;
    __device__ __forceinline__ void mid(f32x4 (&acc)[8][4], int wr, int wc, int fr, int fq) {
#pragma unroll
        for (int m = 0; m < 8; ++m) { const int r = wr * 128 + m * 16 + fr;
            const float f = __builtin_amdgcn_sqrtf((tab[256 + r] + EPS) * __builtin_amdgcn_rcpf(tab[r] + EPS));
#pragma unroll
            for (int n = 0; n < 4; ++n) acc[m][n] *= f;
            SBAR(); }
    }
    __device__ __forceinline__ void fin(f32x4 (&acc)[8][4], int wr, int wc, int fr, int fq) {
        float* x2 = (float*)(ws + WS_X2);
#pragma unroll
        for (int m = 0; m < 8; ++m) { const int r = wr * 128 + m * 16 + fr, row = brow + r; const float rbm = rsqrtf(tab[256 + r] + EPS); f32x4 xv[4];
#pragma unroll
            for (int n = 0; n < 4; ++n) xv[n] = *(const f32x4*)(x + (size_t)row * D_MODEL + pn * 256 + wc * 64 + n * 16 + fq * 4);
#pragma unroll
            for (int n = 0; n < 4; ++n) { const int col = pn * 256 + wc * 64 + n * 16 + fq * 4;
                const f32x4 v = acc[m][n] * rbm + xv[n];
                *(f32x4*)(x2 + (size_t)row * D_MODEL + col) = v; } }
    }
};
struct EpiUp8 {
    int j0, r0, cnt; unsigned char* dst; const float* bias;
    __device__ __forceinline__ void fin(f32x16 (&acc)[4][2], int wr, int wc, int r32, int hi) {
        f32x4 bg[4], bu[4];
#pragma unroll
        for (int rg = 0; rg < 4; ++rg) { const int j = j0 + wc * 32 + 8 * rg + 4 * hi; bg[rg] = *(const f32x4*)(bias + j); bu[rg] = *(const f32x4*)(bias + D_FF + j); }
#pragma unroll
        for (int m = 0; m < 4; ++m) { const int r = wr * 128 + m * 32 + r32; unsigned o8[4];
#pragma unroll
            for (int rg = 0; rg < 4; ++rg) { float o[4];
#pragma unroll
                for (int q = 0; q < 4; ++q) { const float g = fminf(acc[m][0][4 * rg + q] + bg[rg][q], 7.f), u = fminf(fmaxf(acc[m][1][4 * rg + q] + bu[rg][q], -7.f), 7.f);
                    const float sg = __builtin_amdgcn_rcpf(1.f + __builtin_amdgcn_exp2f(-1.702f * LOG2E * g)); o[q] = 4.f * (u + 1.f) * (g * sg); }
                o8[rg] = pk4_fp8(o[0], o[1], o[2], o[3]); }
            if (r0 + r < cnt) {
#pragma unroll
                for (int rg = 0; rg < 4; ++rg) *(unsigned*)(dst + (size_t)r * D_FF + j0 + wc * 32 + 8 * rg + 4 * hi) = o8[rg]; }
        }
    }
};
struct EpiDown8 {
    int c0, r0, cnt; bf16_t* dst; const float* bias;
    __device__ __forceinline__ void fin(f32x16 (&acc)[4][2], int wr, int wc, int r32, int hi) {
        f32x4 b[2][4];
#pragma unroll
        for (int n = 0; n < 2; ++n)
#pragma unroll
            for (int rg = 0; rg < 4; ++rg) b[n][rg] = *(const f32x4*)(bias + c0 + wc * 64 + n * 32 + 8 * rg + 4 * hi);
#pragma unroll
        for (int m = 0; m < 4; ++m) { const int r = wr * 128 + m * 32 + r32;
            if (r0 + r < cnt) {
#pragma unroll
                for (int n = 0; n < 2; ++n)
#pragma unroll
                    for (int rg = 0; rg < 4; ++rg) { const int col = c0 + wc * 64 + n * 32 + 8 * rg + 4 * hi;
                        *(u32x2*)(dst + (size_t)r * D_MODEL + col) = (u32x2){pk_bf16(acc[m][n][4 * rg] + b[n][rg][0], acc[m][n][4 * rg + 1] + b[n][rg][1]), pk_bf16(acc[m][n][4 * rg + 2] + b[n][rg][2], acc[m][n][4 * rg + 3] + b[n][rg][3])}; } }
        }
    }
};

__device__ __forceinline__ void sincos_d(double x, double& s, double& c) {
    const double k = __builtin_rint(x * 0.63661977236758134308);
    double r = __builtin_fma(-k, 1.57079632679489655800e+00, x); r = __builtin_fma(-k, 6.12323399573676603587e-17, r);
    const double r2 = r * r;
    double sp = -7.6471637318198164759e-13; sp = sp * r2 + 1.6059043836821614599e-10; sp = sp * r2 - 2.5052108385441718775e-08; sp = sp * r2 + 2.7557319223985890653e-06;
    sp = sp * r2 - 1.9841269841269841270e-04; sp = sp * r2 + 8.3333333333333333333e-03; sp = sp * r2 - 1.6666666666666666667e-01; const double sn = r + r * r2 * sp;
    double cp = 4.7794773323873852974e-14; cp = cp * r2 - 1.1470745597729724714e-11; cp = cp * r2 + 2.0876756987868098979e-09; cp = cp * r2 - 2.7557319223985890653e-07;
    cp = cp * r2 + 2.4801587301587301587e-05; cp = cp * r2 - 1.3888888888888888889e-03; cp = cp * r2 + 4.1666666666666666667e-02; cp = cp * r2 - 0.5; const double cn = 1.0 + r2 * cp;
    const int q = ((int)k) & 3;
    s = (q == 0) ? sn : (q == 1) ? cn : (q == 2) ? -sn : -cn;
    c = (q == 0) ? cn : (q == 1) ? -sn : (q == 2) ? -cn : sn;
}

__device__ __forceinline__ void phase_prologue(const Params& p) {
    const int tid = threadIdx.x, wid = tid >> 6, lane = tid & 63;
    bf16_t* xn = (bf16_t*)(p.ws + WS_XN);
    for (int row = blockIdx.x * 8 + wid; row < NTOK; row += gridDim.x * 8) {
        const f32x4* xr = (const f32x4*)(p.x + (size_t)row * D_MODEL); f32x4 v[8]; float ss = 0.f;
#pragma unroll
        for (int i = 0; i < 8; ++i) { v[i] = xr[lane + 64 * i]; ss += v[i][0] * v[i][0] + v[i][1] * v[i][1] + v[i][2] * v[i][2] + v[i][3] * v[i][3]; }
        ss = wave_sum(ss); const float rs = rsqrtf(ss * (1.f / D_MODEL) + EPS);
#pragma unroll
        for (int i = 0; i < 8; ++i) { const f32x4 g = ((const f32x4*)p.attn_norm)[lane + 64 * i];
            *(u32x2*)(xn + (size_t)row * D_MODEL + 4 * (lane + 64 * i)) = (u32x2){pk_bf16(v[i][0] * rs * g[0], v[i][1] * rs * g[1]), pk_bf16(v[i][2] * rs * g[2], v[i][3] * rs * g[3])}; }
    }
    const int gtid = blockIdx.x * 512 + tid;
    if (gtid < SEQ * 32) {
        const int pos = gtid >> 5, i = gtid & 31;
        double b = 10000.0; for (int q = 0; q < 5; ++q) b = __builtin_sqrt(b);
        double f = 1.0; for (int q = 0; q < i; ++q) f *= b;
        const float inv_freq = (float)(1.0 / f); const float ang = (float)pos * inv_freq;
        double s, c; sincos_d((double)ang, s, c);
        float* rope = (float*)(p.ws + WS_ROPE); rope[(size_t)gtid * 2] = (float)c; rope[(size_t)gtid * 2 + 1] = (float)s;
    }
    if (gtid < N_EXP * D_MODEL) {
        ((float*)(p.ws + WS_WRT))[gtid] = p.w_router[gtid] * p.mlp_norm[gtid >> 5];
    }
}

constexpr int AA_PITCH = 144;
constexpr int AA_K = 0, AA_V = 384 * AA_PITCH;
constexpr int AA_WS = 2 * 384 * AA_PITCH;
__device__ __forceinline__ void attn_a_unit(const Params& p, LAS char* lds, int u) {
    const int tid = threadIdx.x, wid = __builtin_amdgcn_readfirstlane(tid >> 6), lane = tid & 63, r32 = lane & 31, hi = lane >> 5;
    const int b = u >> 7, nq = (u >> 2) & 31, kvh = u & 3;
    const bf16_t* QA = (const bf16_t*)(p.ws + WS_QA); const bf16_t* KA = (const bf16_t*)(p.ws + WS_KA); const bf16_t* VA = (const bf16_t*)(p.ws + WS_VA);
    const int P0 = (nq - 1) * 128;
    __syncthreads();
    for (int c = tid; c < 384 * 8; c += 512) { const int r = c >> 3, ch = c & 7; const int pos = P0 + r;
        i32x4 kv = {0, 0, 0, 0}, vv = {0, 0, 0, 0};
        if (pos >= 0 && pos < SEQ) { const size_t g = ((size_t)(b * SEQ + pos)) * 256 + kvh * 64 + ch * 8; kv = *(const i32x4*)(KA + g); vv = *(const i32x4*)(VA + g); }
        *(LAS i32x4*)(lds + AA_K + r * AA_PITCH + ch * 16) = kv; *(LAS i32x4*)(lds + AA_V + r * AA_PITCH + ch * 16) = vv; }
    __syncthreads();
    LAS float* wsf = (LAS float*)(lds + AA_WS) + wid * 64;
    const int hq = kvh * 4 + (wid >> 1);
    const float slope2 = __builtin_amdgcn_exp2f(-8.f * (float)(hq + 1) / 16.f) * LOG2E;
    const float sink2 = p.a_sink[hq] * LOG2E;
    const float C = 0.125f * LOG2E;
    const float* ga = p.out_norm_a + hq * 64;
    bf16_t* Y = (bf16_t*)(p.ws + WS_Y); float* ssqa = (float*)(p.ws + WS_SSQP);
    for (int blk = 0; blk < 2; ++blk) {
        const int q0 = nq * 128 + (wid & 1) * 64 + blk * 32;
        const int tq = q0 + r32;
        bf16x8 qr[4];
        { const bf16_t* qp = QA + ((size_t)(b * SEQ + tq)) * 1024 + hq * 64 + hi * 8;
#pragma unroll
          for (int d0 = 0; d0 < 4; ++d0) qr[d0] = *(const bf16x8*)(qp + d0 * 16); }
        float m_reg = sink2, l_reg = 1.f; f32x16 o[2] = {};
        for (int jt = 0; jt < 6; ++jt) {
            const int kp0 = P0 + jt * 64;
            if (kp0 + 63 < q0 - 128 || kp0 > q0 + 31 + 128 || kp0 + 63 < 0 || kp0 >= SEQ) continue;
            f32x16 p0 = {}, p1 = {};
#pragma unroll
            for (int d0 = 0; d0 < 4; ++d0) {
                const bf16x8 k0 = *(const LAS bf16x8*)(lds + AA_K + (jt * 64 + r32) * AA_PITCH + (d0 * 16 + hi * 8) * 2);
                const bf16x8 k1 = *(const LAS bf16x8*)(lds + AA_K + (jt * 64 + 32 + r32) * AA_PITCH + (d0 * 16 + hi * 8) * 2);
                p0 = __builtin_amdgcn_mfma_f32_32x32x16_bf16(k0, qr[d0], p0, 0, 0, 0);
                p1 = __builtin_amdgcn_mfma_f32_32x32x16_bf16(k1, qr[d0], p1, 0, 0, 0);
            }
            float pmax = -1e30f;
#pragma unroll
            for (int r = 0; r < 16; ++r) {
                { const int kp = kp0 + crow(r, hi); const int dist = tq > kp ? tq - kp : kp - tq; const bool ok = dist <= 128 && kp >= 0 && kp < SEQ;
                  p0[r] = ok ? p0[r] * C - slope2 * (float)dist : -1e30f; pmax = fmaxf(pmax, p0[r]); }
                { const int kp = kp0 + 32 + crow(r, hi); const int dist = tq > kp ? tq - kp : kp - tq; const bool ok = dist <= 128 && kp >= 0 && kp < SEQ;
                  p1[r] = ok ? p1[r] * C - slope2 * (float)dist : -1e30f; pmax = fmaxf(pmax, p1[r]); }
            }
            { auto rr = __builtin_amdgcn_permlane32_swap(__float_as_uint(pmax), __float_as_uint(pmax), false, false); pmax = fmaxf(__uint_as_float(rr[0]), __uint_as_float(rr[1])); }
            const float mn = fmaxf(m_reg, pmax); const float alpha = __builtin_amdgcn_exp2f(m_reg - mn); m_reg = mn;
            float ps = 0.f;
#pragma unroll
            for (int r = 0; r < 16; ++r) { p0[r] = __builtin_amdgcn_exp2f(p0[r] - mn); p1[r] = __builtin_amdgcn_exp2f(p1[r] - mn); ps += p0[r] + p1[r]; }
            { auto rr = __builtin_amdgcn_permlane32_swap(__float_as_uint(ps), __float_as_uint(ps), false, false); ps = __uint_as_float(rr[0]) + __uint_as_float(rr[1]); }
            l_reg = l_reg * alpha + ps;
            if (hi == 0) wsf[r32] = alpha;
            WAIT_L0();
#pragma unroll
            for (int r = 0; r < 16; ++r) { const float a = wsf[crow(r, hi)]; o[0][r] *= a; o[1][r] *= a; }
            bf16x8 pa[4];
#define PK4(P, BASE, OUT) do { unsigned a0 = pk_bf16(P[BASE + 0], P[BASE + 1]), a1 = pk_bf16(P[BASE + 2], P[BASE + 3]); \
    unsigned b0 = pk_bf16(P[BASE + 4], P[BASE + 5]), b1 = pk_bf16(P[BASE + 6], P[BASE + 7]); \
    auto r0_ = __builtin_amdgcn_permlane32_swap(a0, b0, false, false); auto r1_ = __builtin_amdgcn_permlane32_swap(a1, b1, false, false); \
    u32x4 w_ = {r0_[0], r1_[0], r0_[1], r1_[1]}; OUT = __builtin_bit_cast(bf16x8, w_); } while (0)
            PK4(p0, 0, pa[0]); PK4(p0, 8, pa[1]); PK4(p1, 0, pa[2]); PK4(p1, 8, pa[3]);
            const int g16 = (lane >> 4) & 1, qq = (lane & 15) >> 2, pp = lane & 3;
#pragma unroll
            for (int db = 0; db < 2; ++db) {
#pragma unroll
                for (int ks = 0; ks < 4; ++ks) {
                    const LAS char* vp = lds + AA_V + (jt * 64 + ks * 16 + 8 * hi + qq) * AA_PITCH + (db * 32 + 16 * g16 + 4 * pp) * 2;
                    const s16x4 lo = vtr(vp), hh = vtr(vp + 4 * AA_PITCH);
                    const bf16x8 vb = (bf16x8){lo[0], lo[1], lo[2], lo[3], hh[0], hh[1], hh[2], hh[3]};
                    o[db] = __builtin_amdgcn_mfma_f32_32x32x16_bf16(pa[ks], vb, o[db], 0, 0, 0);
                }
            }
            WAIT_L0();
        }
        if (hi == 0) wsf[r32] = 1.f / l_reg;
        WAIT_L0();
        const float g0 = ga[r32], g1 = ga[32 + r32];
#pragma unroll
        for (int r = 0; r < 16; ++r) { const int qrow = crow(r, hi); const float il = wsf[qrow]; const float v0 = o[0][r] * il, v1 = o[1][r] * il;
            const size_t tok = (size_t)(b * SEQ + q0 + qrow);
            bf16_t* yp = Y + tok * 2048 + hq * 64;
            yp[r32] = (bf16_t)(pk_bf16(v0 * g0, 0.f) & 0xffffu); yp[32 + r32] = (bf16_t)(pk_bf16(v1 * g1, 0.f) & 0xffffu);
            float ss = v0 * v0 + v1 * v1;
#pragma unroll
            for (int s = 16; s >= 1; s >>= 1) ss += __shfl_xor(ss, s, 64);
            if (r32 == 0) ssqa[tok * 24 + hq] = ss; }
        WAIT_L0();
    }
}

constexpr int MB_V = 0, MB_KN = 32768, MB_KP = 65536, MB_WS = 81920, MB_QP = 83968;
#define KSWZ(row, colB) ((row) * 256 + ((colB) ^ (((row) & 7) << 4)))
#define KPSWZ(row, colB) ((row) * 128 + ((colB) ^ (((row) & 7) << 4)))
constexpr float MLA_SCALE = 0.07216878364870322f;
constexpr float MLA_THR = 8.f;
__device__ __forceinline__ void mla_partialSM(f32x16& p0, f32x16& p1, float& m_reg, float& mn, float& alpha) {
    constexpr float C = MLA_SCALE * LOG2E;
    float pmax = p0[0];
#pragma unroll
    for (int r = 1; r < 16; ++r) pmax = fmaxf(pmax, p0[r]);
#pragma unroll
    for (int r = 0; r < 16; ++r) pmax = fmaxf(pmax, p1[r]);
    { auto rr = __builtin_amdgcn_permlane32_swap(__float_as_uint(pmax), __float_as_uint(pmax), false, false); pmax = fmaxf(__uint_as_float(rr[0]), __uint_as_float(rr[1])); }
    if (__builtin_expect(__all(pmax - m_reg <= MLA_THR / MLA_SCALE), 1)) { mn = m_reg; alpha = 1.f; }
    else { mn = fmaxf(m_reg, pmax); alpha = __builtin_amdgcn_exp2f((m_reg - mn) * C); m_reg = mn; }
    const float mnC = -mn * C;
#pragma unroll
    for (int r = 0; r < 16; ++r) p0[r] = fmaf(p0[r], C, mnC);
#pragma unroll
    for (int r = 0; r < 16; ++r) p1[r] = fmaf(p1[r], C, mnC);
#pragma unroll
    for (int r = 0; r < 16; ++r) p0[r] = __builtin_amdgcn_exp2f(p0[r]);
}
__device__ __forceinline__ void mla_finishSM(f32x16& p0, f32x16& p1, float alpha, float& l_reg, bf16x8& pa0, bf16x8& pa1, bf16x8& pa2, bf16x8& pa3) {
#pragma unroll
    for (int r = 0; r < 16; ++r) p1[r] = __builtin_amdgcn_exp2f(p1[r]);
    float ps = 0;
#pragma unroll
    for (int r = 0; r < 16; ++r) ps += p0[r];
#pragma unroll
    for (int r = 0; r < 16; ++r) ps += p1[r];
    { auto rr = __builtin_amdgcn_permlane32_swap(__float_as_uint(ps), __float_as_uint(ps), false, false); ps = __uint_as_float(rr[0]) + __uint_as_float(rr[1]); }
    l_reg = l_reg * alpha + ps;
    PK4(p0, 0, pa0); PK4(p0, 8, pa1); PK4(p1, 0, pa2); PK4(p1, 8, pa3);
}
__device__ __forceinline__ void mla_qkt(f32x16& p0, f32x16& p1, const LAS char* Kn, const LAS char* Kp, const bf16x8* qr, const LAS char* qp, int r32, int hi) {
    p0 = f32x16{}; p1 = f32x16{};
#pragma unroll
    for (int d0 = 0; d0 < 8; ++d0) { const int cb = (d0 * 16 + hi * 8) * 2;
        const bf16x8 b0 = *(const LAS bf16x8*)(Kn + KSWZ(r32, cb)); const bf16x8 b1 = *(const LAS bf16x8*)(Kn + KSWZ(32 + r32, cb));
        p0 = __builtin_amdgcn_mfma_f32_32x32x16_bf16(b0, qr[d0], p0, 0, 0, 0); p1 = __builtin_amdgcn_mfma_f32_32x32x16_bf16(b1, qr[d0], p1, 0, 0, 0); }
#pragma unroll
    for (int d0 = 0; d0 < 4; ++d0) { const int cb = (d0 * 16 + hi * 8) * 2;
        const bf16x8 b0 = *(const LAS bf16x8*)(Kp + KPSWZ(r32, cb)); const bf16x8 b1 = *(const LAS bf16x8*)(Kp + KPSWZ(32 + r32, cb));
        const bf16x8 q = *(const LAS bf16x8*)(qp + d0 * 1024);
        p0 = __builtin_amdgcn_mfma_f32_32x32x16_bf16(b0, q, p0, 0, 0, 0); p1 = __builtin_amdgcn_mfma_f32_32x32x16_bf16(b1, q, p1, 0, 0, 0); }
}
__device__ __forceinline__ int v_st(int k, int c) { const int kk = (k & ~0xC) | ((k & 4) << 1) | ((k & 8) >> 1); return ((kk >> 3) * 4 + (c >> 5)) * 512 + ((kk & 7) * 32 + (c & 31)) * 2; }
__device__ __forceinline__ int v_rd_base(int lane) { return ((lane & 3) << 3) | (((lane >> 2) & 3) << 6) | (((lane >> 4) & 1) << 5) | (((lane >> 5) & 1) << 8); }
constexpr int v_rd_off(int d0, int ks, int half) { return d0 * 512 + ks * 4096 + half * 2048; }
template <int D0> __device__ __forceinline__ void mla_pv_one(f32x16& od, const LAS char* vb, bf16x8 pa0, bf16x8 pa1, bf16x8 pa2, bf16x8 pa3) {
    const s16x4 l0 = vtr(vb + v_rd_off(D0, 0, 0)), h0 = vtr(vb + v_rd_off(D0, 0, 1)), l1 = vtr(vb + v_rd_off(D0, 1, 0)), h1 = vtr(vb + v_rd_off(D0, 1, 1));
    const s16x4 l2 = vtr(vb + v_rd_off(D0, 2, 0)), h2 = vtr(vb + v_rd_off(D0, 2, 1)), l3 = vtr(vb + v_rd_off(D0, 3, 0)), h3 = vtr(vb + v_rd_off(D0, 3, 1));
#define PKV(L, H) (bf16x8){L[0], L[1], L[2], L[3], H[0], H[1], H[2], H[3]}
    od = __builtin_amdgcn_mfma_f32_32x32x16_bf16(pa0, PKV(l0, h0), od, 0, 0, 0);
    od = __builtin_amdgcn_mfma_f32_32x32x16_bf16(pa1, PKV(l1, h1), od, 0, 0, 0);
    od = __builtin_amdgcn_mfma_f32_32x32x16_bf16(pa2, PKV(l2, h2), od, 0, 0, 0);
    od = __builtin_amdgcn_mfma_f32_32x32x16_bf16(pa3, PKV(l3, h3), od, 0, 0, 0);
#undef PKV
}
__device__ __forceinline__ void mla_pv(f32x16* o, const LAS char* vb, bf16x8 pa0, bf16x8 pa1, bf16x8 pa2, bf16x8 pa3) {
    mla_pv_one<0>(o[0], vb, pa0, pa1, pa2, pa3); mla_pv_one<1>(o[1], vb, pa0, pa1, pa2, pa3); mla_pv_one<2>(o[2], vb, pa0, pa1, pa2, pa3); mla_pv_one<3>(o[3], vb, pa0, pa1, pa2, pa3);
}
__device__ __forceinline__ void mla_unit(const Params& p, LAS char* lds, int u) {
    const int tid = threadIdx.x, wid = __builtin_amdgcn_readfirstlane(tid >> 6), lane = tid & 63, r32 = lane & 31, hi = lane >> 5;
    const int bh = u >> 4, qb = u & 15, b = bh >> 3, h = bh & 7;
    const bf16_t* QB = (const bf16_t*)(p.ws + WS_QB); const bf16_t* KVB = (const bf16_t*)(p.ws + WS_KVB); const bf16_t* KPE = (const bf16_t*)(p.ws + WS_KPE);
    const bf16_t* Kh = KVB + (size_t)b * SEQ * 2048 + h * 256;
    const bf16_t* Ph = KPE + (size_t)b * SEQ * 64;
    LAS float* wsf = (LAS float*)(lds + MB_WS) + wid * 64; LAS float* li_l = wsf; LAS float* al_l = wsf + 32;
    float m_reg = -1e30f, l_reg = 0; f32x16 o[4] = {}; bf16x8 qr[8];
    LAS char* qp = lds + MB_QP + wid * 4096 + lane * 16;
    { const bf16_t* Qw = QB + ((size_t)(b * SEQ + qb * 256 + wid * 32 + r32)) * 1536 + h * 192 + hi * 8;
#pragma unroll
      for (int d0 = 0; d0 < 8; ++d0) qr[d0] = *(const bf16x8*)(Qw + d0 * 16);
      __syncthreads();
#pragma unroll
      for (int d0 = 0; d0 < 4; ++d0) *(LAS bf16x8*)(qp + d0 * 1024) = *(const bf16x8*)(Qw + (8 + d0) * 16); }
    const int sr = tid >> 4, sc = (tid & 15) * 8, vst0 = v_st(sr, sc), vst1 = v_st(32 + sr, sc);
    const int pr = tid >> 3, pc = (tid & 7) * 8;
    const LAS char* vb0 = lds + MB_V + v_rd_base(lane);
    bf16x8 vs0, vs1, ks0, ks1, kp0;
#define SLOAD(k0) do { vs0 = *(const bf16x8*)(Kh + (size_t)((k0) + sr) * 2048 + 128 + sc); vs1 = *(const bf16x8*)(Kh + (size_t)((k0) + 32 + sr) * 2048 + 128 + sc); \
    ks0 = *(const bf16x8*)(Kh + (size_t)((k0) + sr) * 2048 + sc); ks1 = *(const bf16x8*)(Kh + (size_t)((k0) + 32 + sr) * 2048 + sc); \
    kp0 = *(const bf16x8*)(Ph + (size_t)((k0) + pr) * 64 + pc); } while (0)
#define SWRITE(bb) do { *(LAS bf16x8*)(lds + MB_V + (bb) * 16384 + vst0) = vs0; *(LAS bf16x8*)(lds + MB_V + (bb) * 16384 + vst1) = vs1; \
    *(LAS bf16x8*)(lds + MB_KN + (bb) * 16384 + KSWZ(sr, sc * 2)) = ks0; *(LAS bf16x8*)(lds + MB_KN + (bb) * 16384 + KSWZ(32 + sr, sc * 2)) = ks1; \
    *(LAS bf16x8*)(lds + MB_KP + (bb) * 8192 + KPSWZ(pr, pc * 2)) = kp0; } while (0)
#define RESC(a) do { if (__any((a) < 1.f)) { if (hi == 0) al_l[r32] = (a); WAIT_L0(); \
    _Pragma("unroll") for (int d = 0; d < 4; ++d) _Pragma("unroll") for (int r = 0; r < 16; ++r) o[d][r] *= al_l[crow(r, hi)]; } } while (0)
    f32x16 pA0, pA1, pB0, pB1; float mnA, mnB, alA, alB; bf16x8 pa0, pa1, pa2, pa3; constexpr int NT = SEQ / 64;
    SLOAD(0); SWRITE(0); __syncthreads();
    mla_qkt(pA0, pA1, lds + MB_KN, lds + MB_KP, qr, qp, r32, hi); mla_partialSM(pA0, pA1, m_reg, mnA, alA);
    SLOAD(64); SWRITE(1); __syncthreads();
    for (int j = 1; j + 1 < NT; j += 2) {
        SBAR(); mla_qkt(pB0, pB1, lds + MB_KN + 16384, lds + MB_KP + 8192, qr, qp, r32, hi);
        mla_finishSM(pA0, pA1, alA, l_reg, pa0, pa1, pa2, pa3); SBAR();
        SLOAD((j + 1) * 64); SBAR();
        mla_pv(o, vb0, pa0, pa1, pa2, pa3); mla_partialSM(pB0, pB1, m_reg, mnB, alB);
        __syncthreads(); SWRITE(0);
        RESC(alB); __syncthreads();
        SBAR(); mla_qkt(pA0, pA1, lds + MB_KN, lds + MB_KP, qr, qp, r32, hi);
        mla_finishSM(pB0, pB1, alB, l_reg, pa0, pa1, pa2, pa3); SBAR();
        SLOAD((j + 2) * 64); SBAR();
        mla_pv(o, vb0 + 16384, pa0, pa1, pa2, pa3); mla_partialSM(pA0, pA1, m_reg, mnA, alA);
        __syncthreads(); SWRITE(1);
        RESC(alA); __syncthreads();
    }
    SBAR(); mla_qkt(pB0, pB1, lds + MB_KN + 16384, lds + MB_KP + 8192, qr, qp, r32, hi);
    mla_finishSM(pA0, pA1, alA, l_reg, pa0, pa1, pa2, pa3); SBAR();
    mla_pv(o, vb0, pa0, pa1, pa2, pa3); mla_partialSM(pB0, pB1, m_reg, mnB, alB);
    __syncthreads(); RESC(alB);
    mla_finishSM(pB0, pB1, alB, l_reg, pa0, pa1, pa2, pa3); SBAR();
    mla_pv(o, vb0 + 16384, pa0, pa1, pa2, pa3);
    if (hi == 0) li_l[r32] = l_reg; WAIT_L0();
    bf16_t* Y = (bf16_t*)(p.ws + WS_Y); float* ssqb = (float*)(p.ws + WS_SSQP);
    const float* gb = p.out_norm_b + h * 128;
    float g[4];
#pragma unroll
    for (int d0 = 0; d0 < 4; ++d0) g[d0] = gb[d0 * 32 + r32];
#pragma unroll
    for (int r = 0; r < 16; ++r) { const int orow = crow(r, hi); const float il = __builtin_amdgcn_rcpf(li_l[orow]);
        const size_t tok = (size_t)(b * SEQ + qb * 256 + wid * 32 + orow); bf16_t* yp = Y + tok * 2048 + 1024 + h * 128; float ss = 0.f;
#pragma unroll
        for (int d0 = 0; d0 < 4; ++d0) { const float v = o[d0][r] * il; ss += v * v; yp[d0 * 32 + r32] = (bf16_t)(pk_bf16(v * g[d0], 0.f) & 0xffffu); }
#pragma unroll
        for (int s = 16; s >= 1; s >>= 1) ss += __shfl_xor(ss, s, 64);
        if (r32 == 0) ssqb[tok * 24 + 16 + h] = ss; }
#undef SLOAD
#undef SWRITE
#undef RESC
}

__device__ __forceinline__ void phase_router(const Params& p, LAS char* lds) {
    const int tid = threadIdx.x, wid = __builtin_amdgcn_readfirstlane(tid >> 6), lane = tid & 63;
    const float* x2 = (const float*)(p.ws + WS_X2); const float* wg = (const float*)(p.ws + WS_WRT);
    unsigned char* xn8 = p.ws + WS_XN; unsigned* cnt = (unsigned*)(p.ws + WS_CTL + CTL_CNT);
    int* tokl = (int*)(p.ws + WS_TOKL); int* sel_e = (int*)(p.ws + WS_SEL); int* sel_r = sel_e + NTOK * 4; float* sel_g = (float*)(sel_r + NTOK * 4);
    LAS float* part = (LAS float*)lds;
    LAS float* rsv = (LAS float*)(lds + 32768);
    LAS unsigned* hist = (LAS unsigned*)(lds + 32768 + 128); LAS unsigned* hbase = hist + 32;
    for (int t0 = blockIdx.x * 32; t0 < NTOK; t0 += gridDim.x * 32) {
        __syncthreads();
        if (tid < N_EXP) hist[tid] = 0u;
#pragma unroll 1
        for (int j = 0; j < 4; ++j) { const int t = t0 + 4 * wid + j; f32x4 xr[8]; float ss = 0.f;
#pragma unroll
            for (int i = 0; i < 8; ++i) { xr[i] = ((const f32x4*)(x2 + (size_t)t * D_MODEL))[lane + 64 * i]; ss += xr[i][0] * xr[i][0] + xr[i][1] * xr[i][1] + xr[i][2] * xr[i][2] + xr[i][3] * xr[i][3]; }
            const float rs = rsqrtf(wave_sum(ss) * (1.f / D_MODEL) + EPS);
            if (lane == 0) rsv[4 * wid + j] = rs;
#pragma unroll
            for (int i = 0; i < 8; ++i) { const f32x4 v = xr[i]; const f32x4 g = ((const f32x4*)p.mlp_norm)[lane + 64 * i]; const float s16 = 16.f * rs;
                *(unsigned*)(xn8 + (size_t)t * D_MODEL + 4 * (lane + 64 * i)) = pk4_fp8(s16 * v[0] * g[0], s16 * v[1] * g[1], s16 * v[2] * g[2], s16 * v[3] * g[3]); } }
        { f32x16 acc;
#pragma unroll
          for (int r = 0; r < 16; ++r) acc[r] = 0.f;
          const float* ap = x2 + (size_t)(t0 + (lane & 31)) * D_MODEL + 256 * wid + 4 * (lane >> 5);
          const float* bp = wg + (size_t)(256 * wid + 4 * (lane >> 5)) * N_EXP + (lane & 31);
#pragma unroll 4
          for (int c = 0; c < 32; ++c) { const f32x4 a4 = *(const f32x4*)(ap + 8 * c);
#pragma unroll
              for (int q = 0; q < 4; ++q) acc = __builtin_amdgcn_mfma_f32_32x32x2f32(a4[q], bp[(size_t)(8 * c + q) * N_EXP], acc, 0, 0, 0); }
#pragma unroll
          for (int r = 0; r < 16; ++r) part[wid * 1024 + crow(r, lane >> 5) * 32 + (lane & 31)] = acc[r]; }
        __syncthreads();
        int my_e[4]; unsigned my_lr[4]; float my_g[4];
#pragma unroll
        for (int j = 0; j < 4; ++j) { const int tl = 4 * wid + j;
            float v = -3.0e38f;
            if (lane < 32) { float s = 0.f;
#pragma unroll
                for (int w = 0; w < 8; ++w) s += part[w * 1024 + tl * 32 + lane];
                v = s * rsv[tl] + p.b_router[lane]; }
            float tv[4]; int ti[4];
#pragma unroll
            for (int r = 0; r < 4; ++r) {
                float bv = v; int bi = lane;
#pragma unroll
                for (int o = 32; o >= 1; o >>= 1) { const float ov = __shfl_xor(bv, o, 64); const int oi = __shfl_xor(bi, o, 64); if (ov > bv || (ov == bv && oi < bi)) { bv = ov; bi = oi; } }
                tv[r] = bv; ti[r] = bi; if (lane == bi) v = -3.0e38f;
            }
            const float e0 = 1.f, e1 = __expf(tv[1] - tv[0]), e2 = __expf(tv[2] - tv[0]), e3 = __expf(tv[3] - tv[0]); const float inv = 1.f / (e0 + e1 + e2 + e3);
            const float gts[4] = {e0 * inv, e1 * inv, e2 * inv, e3 * inv};
            my_e[j] = ti[lane & 3]; my_g[j] = gts[lane & 3]; my_lr[j] = 0u;
            if (lane < 4) my_lr[j] = __hip_atomic_fetch_add(hist + my_e[j], 1u, __ATOMIC_RELAXED, __HIP_MEMORY_SCOPE_WORKGROUP);
        }
        __syncthreads();
        if (tid < N_EXP) hbase[tid] = atomicAdd(cnt + tid * 16, hist[tid]);
        __syncthreads();
        if (lane < 4) {
#pragma unroll
            for (int j = 0; j < 4; ++j) { const int t = t0 + 4 * wid + j; const int e = my_e[j]; const unsigned rk = hbase[e] + my_lr[j];
                tokl[e * NTOK + rk] = t; sel_e[t * 4 + lane] = e; sel_r[t * 4 + lane] = (int)rk; sel_g[t * 4 + lane] = my_g[j]; }
        }
    }
}

__device__ __forceinline__ void phase_combine(const Params& p, const LAS int* s_roff) {
    const int tid = threadIdx.x, wid = tid >> 6, lane = tid & 63;
    const float* x2 = (const float*)(p.ws + WS_X2); const bf16_t* ys = (const bf16_t*)(p.ws + WS_YS);
    const int* sel_e = (const int*)(p.ws + WS_SEL); const int* sel_r = sel_e + NTOK * 4; const float* sel_g = (const float*)(sel_r + NTOK * 4);
    for (int t = blockIdx.x * 8 + wid; t < NTOK; t += gridDim.x * 8) {
        f32x4 v[8];
#pragma unroll
        for (int i = 0; i < 8; ++i) v[i] = ((const f32x4*)(x2 + (size_t)t * D_MODEL))[lane + 64 * i];
#pragma unroll
        for (int k = 0; k < 4; ++k) { const int e = sel_e[t * 4 + k]; const size_t slot = (size_t)(s_roff[e] + sel_r[t * 4 + k]); const float g = sel_g[t * 4 + k];
            const u32x2* yr = (const u32x2*)(ys + slot * D_MODEL);
#pragma unroll
            for (int i = 0; i < 8; ++i) { const u32x2 w = yr[lane + 64 * i]; v[i][0] += g * bf_lo(w[0]); v[i][1] += g * bf_hi(w[0]); v[i][2] += g * bf_lo(w[1]); v[i][3] += g * bf_hi(w[1]); } }
        float ss = 0.f;
#pragma unroll
        for (int i = 0; i < 8; ++i) ss += v[i][0] * v[i][0] + v[i][1] * v[i][1] + v[i][2] * v[i][2] + v[i][3] * v[i][3];
        ss = wave_sum(ss); const float rs = rsqrtf(ss * (1.f / D_MODEL) + EPS);
#pragma unroll
        for (int i = 0; i < 8; ++i) { const f32x4 g = ((const f32x4*)p.final_norm)[lane + 64 * i];
            ((f32x4*)(p.out + (size_t)t * D_MODEL))[lane + 64 * i] = (f32x4){v[i][0] * rs * g[0], v[i][1] * rs * g[1], v[i][2] * rs * g[2], v[i][3] * rs * g[3]}; }
    }
}

constexpr int NPHASE = 9;
__global__ void __launch_bounds__(512, 2) mega_fwd(Params p) {
    extern __shared__ __attribute__((aligned(1024))) char smem_raw[];
    LAS char* lds = (LAS char*)smem_raw;
    LAS unsigned* misc = (LAS unsigned*)(lds + LDS_MISC);
    const int tid = threadIdx.x;
    if (tid < 4) misc[tid] = 0u;
    __syncthreads();
    unsigned* bar = (unsigned*)(p.ws + WS_CTL + CTL_BAR);
    XcdBarrier xb = xcd_barrier_post(bar, (volatile LAS unsigned*)misc);
    const int lo = p.ph_lo, hi = p.ph_hi;
    const int G = gridDim.x, bid = blockIdx.x;
    const int xperm = (bid & 7) * (G >> 3) + (bid >> 3);
#ifdef PH_ONLY
#define IN(k) ((k)==PH_ONLY)
#else
#define IN(k) (lo <= (k) && (k) < hi)
#endif
#define SEAM(k) do { if (IN(k) && IN((k) + 1)) xcd_barrier(xb); } while (0)
    if (IN(0)) phase_prologue(p);
    SEAM(0);
    if (IN(1)) {
        for (int u = xperm; u < 32 * 8; u += G) {
            const int pn = u / 32, pm = u % 32;
            ARows af{(const bf16_t*)(p.ws + WS_XN) + (size_t)pm * 256 * D_MODEL, (unsigned)D_MODEL};
            BPlain bf{p.w_in + pn * 256, (size_t)IN_COLS, 256};
            EpiProj ep{pn, pm * 256, p.ws, p.b_q_norm, p.b_kv_norm};
            gemm_unit<false>(lds, D_MODEL / 64, af, bf, ep);
        }
    }
    SEAM(1);
    if (IN(2)) {
        { const int b0 = bid;
            if ((b0 & 3) == 0) {
                const int h = b0 >> 2, pn = 8 + (h >> 5), pm = h & 31;
                ARows af{(const bf16_t*)(p.ws + WS_XN) + (size_t)pm * 256 * D_MODEL, (unsigned)D_MODEL};
                BPlain bf{p.w_in + pn * 256, (size_t)IN_COLS, pn == 9 ? 64 : 256};
                EpiProj ep{pn, pm * 256, p.ws, p.b_q_norm, p.b_kv_norm};
                gemm_unit<false>(lds, D_MODEL / 64, af, bf, ep);
            } else {
                const int v = (b0 >> 2) * 3 + (b0 & 3) - 1;
                { const int pn = v / 32, pm = v % 32;
                  ARows af{(const bf16_t*)(p.ws + WS_CQ) + (size_t)pm * 256 * 512, 512u};
                  BPlain bf{p.b_w_uq + pn * 256, (size_t)1536, 256};
                  EpiQUp ep{pn, pm * 256, p.ws};
                  gemm_unit<false>(lds, 512 / 64, af, bf, ep); }
                attn_a_unit(p, lds, v);
                if (v < 64) attn_a_unit(p, lds, 192 + v);
            }
        }
        xcd_barrier(xb);
        for (int u = xperm; u < 32 * 8; u += G) {
            const int pn = u / 32, pm = u % 32;
            ARows af{(const bf16_t*)(p.ws + WS_CKV) + (size_t)pm * 256 * 256, 256u};
            BPlain bf{p.b_w_ukv + pn * 256, (size_t)2048, 256};
            EpiKvUp ep{pn, pm * 256, p.ws};
            gemm_unit<false>(lds, 256 / 64, af, bf, ep);
        }
    }
    SEAM(2);
    if (IN(3)) { for (int u = xperm; u < 256; u += G) mla_unit(p, lds, u); }
    SEAM(3);
    if (IN(4)) {
        __syncthreads();
        for (int u = xperm; u < 32 * 8; u += G) {
            const int pn = u / 32, pm = u % 32;
            ARows af{(const bf16_t*)(p.ws + WS_Y) + (size_t)pm * 256 * D_MODEL, (unsigned)D_MODEL};
            BPlain bf{p.w_o + pn * 256, (size_t)D_MODEL, 256};
            LAS float* tab = (LAS float*)(lds + 2 * G_STAGE_B);
            __syncthreads();
            if (tid < 256) { const f32x4* pp = (const f32x4*)((const float*)(p.ws + WS_SSQP) + (size_t)(pm * 256 + tid) * 24); float sa = 0.f, sb2 = 0.f;
#pragma unroll
                for (int q = 0; q < 4; ++q) { const f32x4 v = pp[q]; sa += (v[0] + v[1]) + (v[2] + v[3]); }
#pragma unroll
                for (int q = 4; q < 6; ++q) { const f32x4 v = pp[q]; sb2 += (v[0] + v[1]) + (v[2] + v[3]); }
                tab[tid] = sa * (1.f / 1024.f); tab[256 + tid] = sb2 * (1.f / 1024.f); }
            __syncthreads();
            EpiWo ep{pn, pm * 256, p.ws, p.x, tab};
            gemm_unit<true>(lds, D_MODEL / 64, af, bf, ep);
        }
    }
    SEAM(4);
    if (IN(5)) phase_router(p, lds);
    SEAM(5);
    LAS int* s_cnt = (LAS int*)(misc + 16); LAS int* s_toff = (LAS int*)(misc + 48); LAS int* s_roff = (LAS int*)(misc + 96);
    if (IN(6) || IN(7) || IN(8)) {
        if (tid == 0) { const unsigned* cnt = (const unsigned*)(p.ws + WS_CTL + CTL_CNT); int to = 0;
            for (int e = 0; e < N_EXP; ++e) { const int c = (int)xb_ld((unsigned*)cnt + e * 16); s_cnt[e] = c; s_toff[e] = to; s_roff[e] = to * 256; to += (c + 255) >> 8; }
            s_toff[N_EXP] = to; }
        __syncthreads();
    }
    if (IN(6)) {
        const int TM = s_toff[N_EXP];
#ifdef PROBE_P6
        for (int rep = 0; rep < 2; ++rep)
#endif
        for (int L = xperm; L < TM * 16; L += G) {
            int e = 0; while (s_toff[e + 1] * 16 <= L) ++e;
            const int w = L - s_toff[e] * 16, nte = s_toff[e + 1] - s_toff[e], ntile = w / nte, mt = w - ntile * nte, cntE = s_cnt[e];
            AGather8 af{p.ws + WS_XN, (const int*)(p.ws + WS_TOKL) + (size_t)e * NTOK, mt * 256, cntE};
            BGateUp bf{p.w_up + (size_t)e * D_MODEL * (2 * D_FF) + ntile * 128, (size_t)(2 * D_FF)};
            EpiUp8 ep{ntile * 128, mt * 256, cntE, p.ws + WS_ACT + ((size_t)s_roff[e] + mt * 256) * D_FF, p.b_up + (size_t)e * (2 * D_FF)};
            gemm_unit8<0x7B7B7B7B>(lds, (LAS unsigned*)(misc + 8), D_MODEL / 64, af, bf, ep);
        }
    }
    SEAM(6);
    if (IN(7)) {
        const int TM = s_toff[N_EXP];
#ifdef PROBE_P7
        for (int rep = 0; rep < 2; ++rep)
#endif
        for (int L = xperm; L < TM * 8; L += G) {
            int e = 0; while (s_toff[e + 1] * 8 <= L) ++e;
            const int w = L - s_toff[e] * 8, nte = s_toff[e + 1] - s_toff[e], ntile = w / nte, mt = w - ntile * nte, cntE = s_cnt[e];
            ARows8 af{p.ws + WS_ACT + ((size_t)s_roff[e] + mt * 256) * D_FF, (unsigned)D_FF};
            BPlain bf{p.w_down + (size_t)e * D_FF * D_MODEL + ntile * 256, (size_t)D_MODEL, 256};
            EpiDown8 ep{ntile * 256, mt * 256, cntE, (bf16_t*)(p.ws + WS_YS) + ((size_t)s_roff[e] + mt * 256) * D_MODEL, p.b_down + (size_t)e * D_MODEL};
            gemm_unit8<0x7D7D7D7D>(lds, (LAS unsigned*)(misc + 8), D_FF / 64, af, bf, ep);
        }
    }
    SEAM(7);
    if (IN(8)) phase_combine(p, s_roff);
}

extern "C" void kernel_launch(void* const* d_in, const int* in_sizes, int n_in, void* d_out, int out_size, void* d_ws, size_t ws_size, hipStream_t stream) {
    static int ready = 0;
    if (!ready) {
        if (hipFuncSetAttribute((const void*)mega_fwd, hipFuncAttributeMaxDynamicSharedMemorySize, LDS_BYTES) != hipSuccess) { fprintf(stderr, "kernel_launch: hipFuncSetAttribute failed\n"); return; }
        int per_cu = 0; hipOccupancyMaxActiveBlocksPerMultiprocessor(&per_cu, (const void*)mega_fwd, 512, LDS_BYTES);
        if (per_cu < 1) { fprintf(stderr, "kernel_launch: occupancy query says 0 blocks per CU\n"); return; }
        ready = 1;
    }
    if (ws_size < WS_END) { fprintf(stderr, "kernel_launch: workspace too small\n"); return; }
    hipMemsetAsync((unsigned char*)d_ws + WS_CTL, 0, CTL_BYTES, stream);
    Params p{};
    const float** f = (const float**)&p;
    for (int i = 0; i < 19; ++i) f[i] = (const float*)d_in[i];
    p.out = (float*)d_out; p.ws = (unsigned char*)d_ws; p.ph_lo = 0; p.ph_hi = NPHASE;
    hipLaunchKernelGGL(mega_fwd, dim3(256), dim3(512), LDS_BYTES, stream, p);
}
```

```cpp
#include <hip/hip_runtime.h>
#include <stdint.h>
#include <stdio.h>

#define LAS __attribute__((address_space(3)))
typedef unsigned short bf16_t;
typedef short bf16x8 __attribute__((ext_vector_type(8)));
typedef short s16x4 __attribute__((ext_vector_type(4)));
typedef short v4i16_t __attribute__((ext_vector_type(4)));
typedef float f32x2 __attribute__((ext_vector_type(2)));
typedef float f32x4 __attribute__((ext_vector_type(4)));
typedef float f32x16 __attribute__((ext_vector_type(16)));
typedef int i32x4 __attribute__((ext_vector_type(4)));
typedef unsigned u32x2 __attribute__((ext_vector_type(2)));
typedef unsigned u32x4 __attribute__((ext_vector_type(4)));
typedef __bf16 bf16x2_t __attribute__((ext_vector_type(2)));
typedef int v8i __attribute__((ext_vector_type(8)));
typedef int v2i __attribute__((ext_vector_type(2)));
typedef short v2s __attribute__((ext_vector_type(2)));

constexpr int D_MODEL = 2048, SEQ = 4096, BATCH = 2, NTOK = BATCH * SEQ;
constexpr int IN_COLS = 2368;
constexpr int N_EXP = 32, TOP_K = 4, D_FF = 2048;
constexpr float EPS = 1e-5f;
constexpr float LOG2E = 1.4426950408889634f;

constexpr size_t MiB = 1u << 20;
constexpr size_t WS_CTL = 0, CTL_BYTES = 1 * MiB;
constexpr size_t WS_XN = 1 * MiB, WS_QA = 33 * MiB, WS_KA = 49 * MiB, WS_VA = 53 * MiB, WS_CQ = 57 * MiB, WS_CKV = 65 * MiB, WS_KPE = 69 * MiB;
constexpr size_t WS_QB = 70 * MiB, WS_KVB = 94 * MiB, WS_Y = 126 * MiB, WS_X2 = 158 * MiB, WS_ROPE = 222 * MiB, WS_WRT = 223 * MiB;
constexpr size_t WS_TOKL = 224 * MiB, WS_SEL = 225 * MiB, WS_ACT = 226 * MiB, WS_YS = 386 * MiB, WS_BT_IN = 546 * MiB, WS_BT_UQ = 558 * MiB, WS_BT_UKV = 560 * MiB, WS_BT_WO = 562 * MiB, WS_SSQ2 = 570 * MiB, WS_END = 571 * MiB;
constexpr size_t WS_SSQP = WS_WRT + 262144;
constexpr size_t WS_SSQC = WS_SSQ2;
constexpr size_t WS_SSQK = WS_SSQ2 + 524288;
constexpr size_t CTL_BAR = 0, CTL_CNT = 16384, CTL_SSQ_CQ = 65536, CTL_SSQ_CKV = 98304, CTL_SSQ_A = 131072, CTL_SSQ_B = 163840, CTL_SSQ_X2 = 196608;

__device__ __forceinline__ unsigned pk_bf16(float lo, float hi) { f32x2 v = {lo, hi}; bf16x2_t b = __builtin_convertvector(v, bf16x2_t); return __builtin_bit_cast(unsigned, b); }
__device__ __forceinline__ unsigned pk4_fp8(float a, float b, float c, float d) { int w = __builtin_amdgcn_cvt_pk_fp8_f32(a, b, 0, false); w = __builtin_amdgcn_cvt_pk_fp8_f32(c, d, w, true); return (unsigned)w; }
__device__ __forceinline__ unsigned pk4_fp8_x64(f32x4 v) { v2s r; asm("" : "=v"(r));
    r = __builtin_amdgcn_cvt_scalef32_pk_fp8_f32(r, v[0], v[1], 0.015625f, false); r = __builtin_amdgcn_cvt_scalef32_pk_fp8_f32(r, v[2], v[3], 0.015625f, true); return __builtin_bit_cast(unsigned, r); }
__device__ __forceinline__ float bf_lo(unsigned u) { return __uint_as_float(u << 16); }
__device__ __forceinline__ float bf_hi(unsigned u) { return __uint_as_float(u & 0xffff0000u); }
__device__ __forceinline__ float wave_sum(float v) {
#pragma unroll
    for (int o = 32; o >= 1; o >>= 1) v += __shfl_xor(v, o, 64);
    return v;
}
__device__ __forceinline__ int crow(int r, int hi) { return (r & 3) + 8 * (r >> 2) + 4 * hi; }
__device__ __forceinline__ s16x4 vtr(const LAS char* p) { return __builtin_bit_cast(s16x4, __builtin_amdgcn_ds_read_tr16_b64_v4i16((LAS v4i16_t*)p)); }
#define SBAR() __builtin_amdgcn_sched_barrier(0)

#define XB_TMO      128
#define XB_XCNT(j)  (256  + 64 * (j))
#define XB_XSUB(j)  (1280 + 64 * (j))
#define XB_XGEN(j)  (2304 + 64 * (j))
#define XB_TOP      3328
#define XB_TOPGEN   3392
#define XCD_BAR_WORDS 3456
#define XB_SPIN_CAP (1u << 18)
__device__ __forceinline__ unsigned xb_ld(unsigned* p)              { return __hip_atomic_load(p, __ATOMIC_RELAXED, __HIP_MEMORY_SCOPE_AGENT); }
__device__ __forceinline__ unsigned xb_add(unsigned* p, unsigned v) { return __hip_atomic_fetch_add(p, v, __ATOMIC_RELAXED, __HIP_MEMORY_SCOPE_AGENT); }
__device__ __forceinline__ unsigned xb_xcc_id() { return (unsigned)__builtin_amdgcn_s_getreg((3 << 11) | 20) & 0xFu; }
#define XB_SPIN(cond, bar) do { unsigned _sp = 0; while (cond) { __builtin_amdgcn_s_sleep(1); \
    if ((++_sp & 255u) == 0u) { if (xb_ld(&(bar)[XB_TMO])) break; if (_sp > XB_SPIN_CAP) { atomicAdd(&(bar)[XB_TMO], 1u); break; } } } } while (0)
struct XcdBarrier { unsigned* bar; unsigned x; volatile LAS unsigned* st; };
__device__ __forceinline__ XcdBarrier xcd_barrier_post(unsigned* bar, volatile LAS unsigned* st) {
    XcdBarrier b; b.bar = bar; b.x = xb_xcc_id(); b.st = st;
    if (threadIdx.x == 0) (void)xb_add(&bar[XB_XCNT(b.x)], 1u);
    return b;
}
__device__ __forceinline__ void xcd_barrier_complete(unsigned* bar, unsigned x, unsigned& nloc, unsigned& nx) {
    const unsigned G = gridDim.x * gridDim.y * gridDim.z;
    unsigned sum, cnt, mine, sp = 0u;
    for (;;) {
        sum = 0u; cnt = 0u; mine = 0u;
#pragma unroll
        for (unsigned j = 0; j < 16; ++j) { const unsigned c = xb_ld(&bar[XB_XCNT(j)]); sum += c; cnt += (c > 0u) ? 1u : 0u; mine = (j == x) ? c : mine; }
        if (sum == G) break;
        __builtin_amdgcn_s_sleep(1);
        if ((++sp & 255u) == 0u) { if (xb_ld(&bar[XB_TMO])) break; if (sp > XB_SPIN_CAP) { atomicAdd(&bar[XB_TMO], 1u); break; } }
    }
    nloc = mine > 0u ? mine : 1u; nx = cnt > 0u ? cnt : 1u;
}
__device__ __forceinline__ void xcd_barrier(const XcdBarrier& b) {
    asm volatile("s_waitcnt vmcnt(0)" ::: "memory");
    __syncthreads();
    if (threadIdx.x == 0) {
        unsigned* bar = b.bar;
        __builtin_amdgcn_s_waitcnt(0);
        unsigned nloc = b.st[0], nx = b.st[1];
        if (nloc == 0u) { xcd_barrier_complete(bar, b.x, nloc, nx); b.st[0] = nloc; b.st[1] = nx; }
        const unsigned old = xb_add(&bar[XB_XSUB(b.x)], 1u);
        const unsigned gen = old / nloc;
        if (old + 1u == (gen + 1u) * nloc) {
            __builtin_amdgcn_fence(__ATOMIC_RELEASE, "agent");
            asm volatile("s_waitcnt vmcnt(0)" ::: "memory");
            const unsigned og = xb_add(&bar[XB_TOP], 1u);
            const unsigned tg = og / nx;
            if (og + 1u == (tg + 1u) * nx) xb_add(&bar[XB_TOPGEN], 1u);
            else XB_SPIN(xb_ld(&bar[XB_TOPGEN]) == tg, bar);
            __builtin_amdgcn_fence(__ATOMIC_ACQUIRE, "agent");
            xb_add(&bar[XB_XGEN(b.x)], 1u);
            asm volatile("s_waitcnt vmcnt(0)" ::: "memory");
        } else {
            XB_SPIN(xb_ld(&bar[XB_XGEN(b.x)]) == gen, bar);
            __builtin_amdgcn_fence(__ATOMIC_ACQUIRE, "agent");
            asm volatile("s_waitcnt vmcnt(0)" ::: "memory");
        }
    }
    __syncthreads();
}

constexpr int A_TILE_B = 256 * 64 * 2;
constexpr int B_PITCH = 544;
constexpr int B_TILE_B = 64 * B_PITCH;
constexpr int G_STAGE_B = A_TILE_B + B_TILE_B;
constexpr int LDS_MISC = 155648;
constexpr int LDS_BYTES = LDS_MISC + 1024;

__device__ __forceinline__ int a_img_byte(int r, int chunk) { return r * 128 + ((chunk ^ ((r >> 1) & 7)) << 4); }
#define WAIT_L0() asm volatile("s_waitcnt lgkmcnt(0)" ::: "memory")
__device__ __forceinline__ void glds16(const void* gsrc, unsigned lds_dst) { unsigned keep;
    asm volatile("s_mov_b32 %0, m0\n\ts_mov_b32 m0, %2\n\ts_nop 0\n\tglobal_load_lds_dwordx4 %1, off\n\ts_mov_b32 m0, %0" : "=&s"(keep) : "v"(gsrc), "s"(lds_dst) : "memory"); }
#define RAW_BARRIER() do { WAIT_L0(); __builtin_amdgcn_s_barrier(); } while (0)

__device__ __forceinline__ const char* uniform_ptr(const void* p) {
    const unsigned long long v = (unsigned long long)p;
    const unsigned lo = __builtin_amdgcn_readfirstlane((unsigned)v), hi = __builtin_amdgcn_readfirstlane((unsigned)(v >> 32));
    return (const char*)(((unsigned long long)hi << 32) | lo);
}
__device__ __forceinline__ void glds16s(const char* sbase, unsigned voff, unsigned lds_dst) { unsigned keep;
    asm volatile("s_mov_b32 %0, m0\n\ts_mov_b32 m0, %3\n\ts_nop 4\n\tglobal_load_lds_dwordx4 %1, %2\n\ts_mov_b32 m0, %0" : "=&s"(keep) : "v"(voff), "s"(sbase), "s"(lds_dst) : "memory"); }
#define WAIT_V4(n, a, b, c, d) asm volatile("s_waitcnt vmcnt(" #n ")" : "+v"(a), "+v"(b), "+v"(c), "+v"(d) :: "memory")
template <bool MID, class AF, class BF, class EPI>
__device__ __forceinline__ void gemm_unit(LAS char* lds, const int nt, const AF& af, const BF& bf, EPI& epi) {
    const int tid = threadIdx.x, wid = __builtin_amdgcn_readfirstlane(tid >> 6), lane = tid & 63, wr = wid >> 2, wc = wid & 3, fr = lane & 15, fq = lane >> 4;
    const char* abase = uniform_ptr(af.base);
    unsigned aoff[4];
#pragma unroll
    for (int i = 0; i < 4; ++i) { const int R = wid * 8 + i * 64 + (lane >> 3), C = ((lane & 7) ^ ((R >> 1) & 7)) * 8; aoff[i] = (af.rowoff(R) + (unsigned)C) * 2u; }
    const int a_ldsw = wid * 1024;
    const unsigned lds_u = (unsigned)__builtin_amdgcn_readfirstlane((int)(unsigned)(size_t)lds);
    const size_t ldb4 = (size_t)bf.ld * 4;
    const char* bbase = uniform_ptr(bf.base) + (size_t)wid * ldb4;
    const unsigned boff = bf.coloff(4 * lane) * 4u;
    const int b_lds0 = A_TILE_B + wid * B_PITCH + 8 * lane, b_lds1 = A_TILE_B + wid * B_PITCH + ((8 * lane) ^ 128);
    const int a_rd0 = a_img_byte(wr * 128 + fr, fq), a_rd1 = a_rd0 ^ 64;
    const int b_rd = A_TILE_B + (8 * fq + ((lane & 15) >> 2)) * B_PITCH + ((wc ^ (fq & 1)) << 7) + 8 * (lane & 3);
    f32x4 acc[8][4];
#pragma unroll
    for (int m = 0; m < 8; ++m)
#pragma unroll
        for (int n = 0; n < 4; ++n) acc[m][n] = (f32x4){0.f, 0.f, 0.f, 0.f};
    f32x4 sb[8];
#define G_STAGE_A(i, kt, buf) glds16s(abase + (size_t)(kt) * 128, aoff[i], lds_u + (unsigned)((buf) * G_STAGE_B + a_ldsw + (i) * 8192))
#define G_ISSUE_B(i, kt) asm volatile("s_nop 4\n\tglobal_load_dwordx4 %0, %1, %2" : "=v"(sb[i]) : "v"(boff), "s"(bbase + ((size_t)(kt) * 64 + (i) * 8) * ldb4) : "memory")
#define G_WRITE_B(i, buf) do { u32x2 w_ = {pk_bf16(sb[i][0], sb[i][1]), pk_bf16(sb[i][2], sb[i][3])}; \
        *(LAS u32x2*)(lds + (buf) * G_STAGE_B + (((i) & 1) ? b_lds1 : b_lds0) + (i) * 8 * B_PITCH) = w_; } while (0)
#define G_KSTEP(buf, ks) do { bf16x8 At[8], Bf[4]; \
        _Pragma("unroll") for (int n = 0; n < 4; ++n) { const s16x4 lo_ = vtr(lds + (buf) * G_STAGE_B + b_rd + (ks) * 32 * B_PITCH + n * 32), hi_ = vtr(lds + (buf) * G_STAGE_B + b_rd + (ks) * 32 * B_PITCH + 4 * B_PITCH + n * 32); \
            Bf[n] = (bf16x8){lo_[0], lo_[1], lo_[2], lo_[3], hi_[0], hi_[1], hi_[2], hi_[3]}; } \
        _Pragma("unroll") for (int m = 0; m < 8; ++m) At[m] = *(const LAS bf16x8*)(lds + (buf) * G_STAGE_B + ((ks) ? a_rd1 : a_rd0) + m * 2048); \
        SBAR(); __builtin_amdgcn_s_setprio(1); \
        _Pragma("unroll") for (int m = 0; m < 8; ++m) _Pragma("unroll") for (int n = 0; n < 4; ++n) \
            acc[m][n] = __builtin_amdgcn_mfma_f32_16x16x32_bf16(Bf[n], At[m], acc[m][n], 0, 0, 0); \
        __builtin_amdgcn_s_setprio(0); SBAR(); } while (0)
#pragma unroll
    for (int i = 0; i < 4; ++i) G_STAGE_A(i, 0, 0);
#pragma unroll
    for (int i = 0; i < 8; ++i) G_ISSUE_B(i, 0);
    WAIT_V4(0, sb[0], sb[1], sb[2], sb[3]); WAIT_V4(0, sb[4], sb[5], sb[6], sb[7]);
#pragma unroll
    for (int i = 0; i < 8; ++i) G_WRITE_B(i, 0);
    SBAR();
#pragma unroll
    for (int i = 0; i < 8; ++i) G_ISSUE_B(i, 1);
    SBAR();
    RAW_BARRIER();
#pragma unroll 1
    for (int t = 0; t < nt; ++t) {
        const int cur = t & 1, nxt = cur ^ 1;
        if constexpr (MID) { if (t == (nt >> 1)) epi.mid(acc, wr, wc, fr, fq); }
        const int k1 = (t + 1 < nt) ? t + 1 : nt - 1, k2 = (t + 2 < nt) ? t + 2 : nt - 1;
        G_STAGE_A(0, k1, nxt); G_STAGE_A(1, k1, nxt); G_STAGE_A(2, k1, nxt); G_STAGE_A(3, k1, nxt);
        G_KSTEP(cur, 0);
        WAIT_V4(8, sb[0], sb[1], sb[2], sb[3]);
        G_WRITE_B(0, nxt); G_WRITE_B(1, nxt); G_WRITE_B(2, nxt); G_WRITE_B(3, nxt); SBAR();
        G_ISSUE_B(0, k2); G_ISSUE_B(1, k2); G_ISSUE_B(2, k2); G_ISSUE_B(3, k2); SBAR();
        G_KSTEP(cur, 1);
        WAIT_V4(8, sb[4], sb[5], sb[6], sb[7]);
        G_WRITE_B(4, nxt); G_WRITE_B(5, nxt); G_WRITE_B(6, nxt); G_WRITE_B(7, nxt); SBAR();
        G_ISSUE_B(4, k2); G_ISSUE_B(5, k2); G_ISSUE_B(6, k2); G_ISSUE_B(7, k2); SBAR();
        asm volatile("s_waitcnt vmcnt(8)" ::: "memory");
        RAW_BARRIER();
    }
    WAIT_V4(0, sb[0], sb[1], sb[2], sb[3]); WAIT_V4(0, sb[4], sb[5], sb[6], sb[7]);
    epi.fin(acc, wr, wc, fr, fq);
#undef G_STAGE_A
#undef G_ISSUE_B
#undef G_WRITE_B
#undef G_KSTEP
}

constexpr int A8_TILE_B = 16384, B8_PITCH = 288, B8_TILE_B = 64 * B8_PITCH;
constexpr int A8_RING = 5, B8_RING = 4, B8_OFF = A8_RING * A8_TILE_B;
static_assert(B8_OFF + B8_RING * B8_TILE_B <= LDS_MISC, "fp8 rings fit below the misc words");
__device__ __forceinline__ v2i vtr8(const LAS char* p) { return __builtin_amdgcn_ds_read_tr8_b64_v2i32((LAS v2i*)p); }
template <int SCALE_X, class AF, class BF, class EPI>
__device__ __forceinline__ void gemm_unit8(LAS char* lds, LAS unsigned* ring_cnt, const int nt, const AF& af, const BF& bf, EPI& epi) {
    const int tid = threadIdx.x, wid = __builtin_amdgcn_readfirstlane(tid >> 6), lane = tid & 63, wr = wid >> 2, wc = wid & 3, r32 = lane & 31, hi = lane >> 5;
    const char* abase = uniform_ptr(af.base);
    unsigned aoff[2];
#pragma unroll
    for (int i = 0; i < 2; ++i) { const int R = wid * 16 + i * 128 + (lane >> 2), C = ((lane & 3) ^ ((lane >> 4) & 3)) * 16; aoff[i] = af.rowoff(R) + (unsigned)C; }
    const unsigned lds_u = (unsigned)__builtin_amdgcn_readfirstlane((int)(unsigned)(size_t)lds) + (unsigned)(wid * 1024);
    const size_t ldb4 = (size_t)bf.ld * 4;
    const char* bbase = uniform_ptr(bf.base) + (size_t)wid * ldb4;
    const unsigned boff = bf.coloff(4 * lane) * 4u;
    const int b_wr = B8_OFF + wid * B8_PITCH + 4 * lane;
    const int a_rd0 = (wr * 128 + r32) * 64 + (((2 * hi) ^ ((r32 >> 2) & 3)) << 4), a_rd1 = a_rd0 ^ 16;
    const int b_rd = B8_OFF + (32 * hi + ((lane & 15) >> 1)) * B8_PITCH + wc * 64 + 16 * ((lane >> 4) & 1) + 8 * (lane & 1);
    f32x16 acc[4][2];
#pragma unroll
    for (int m = 0; m < 4; ++m)
#pragma unroll
        for (int n = 0; n < 2; ++n)
#pragma unroll
            for (int r = 0; r < 16; ++r) acc[m][n][r] = 0.f;
    f32x4 sb[8];
#define H_STAGE_A(i, kt, slot) glds16s(abase + (size_t)(kt) * 64, aoff[i], lds_u + (unsigned)((slot) * A8_TILE_B + (i) * 8192))
#define H_ISSUE_B(i, kt) asm volatile("s_nop 4\n\tglobal_load_dwordx4 %0, %1, %2" : "=v"(sb[i]) : "v"(boff), "s"(bbase + ((size_t)(kt) * 64 + (i) * 8) * ldb4) : "memory")
#define H_WRITE_B(i, slot) *(LAS unsigned*)(lds + (slot) * B8_TILE_B + b_wr + (i) * 8 * B8_PITCH) = pk4_fp8_x64(sb[i])
#define H_KSTEP(sa, sbk) do { v8i Xf[4], Wf[2]; \
        _Pragma("unroll") for (int n = 0; n < 2; ++n) _Pragma("unroll") for (int r = 0; r < 4; ++r) { const v2i t_ = vtr8(lds + (sbk) * B8_TILE_B + b_rd + r * 8 * B8_PITCH + n * 32); Wf[n][2 * r] = t_[0]; Wf[n][2 * r + 1] = t_[1]; } \
        _Pragma("unroll") for (int m = 0; m < 4; ++m) { const i32x4 lo_ = *(const LAS i32x4*)(lds + (sa) * A8_TILE_B + a_rd0 + m * 2048), hi_ = *(const LAS i32x4*)(lds + (sa) * A8_TILE_B + a_rd1 + m * 2048); \
            Xf[m] = (v8i){lo_[0], lo_[1], lo_[2], lo_[3], hi_[0], hi_[1], hi_[2], hi_[3]}; } \
        SBAR(); __builtin_amdgcn_s_setprio(1); \
        _Pragma("unroll") for (int m = 0; m < 4; ++m) _Pragma("unroll") for (int n = 0; n < 2; ++n) \
            acc[m][n] = __builtin_amdgcn_mfma_scale_f32_32x32x64_f8f6f4(Wf[n], Xf[m], acc[m][n], 0, 0, 0, 0x79797979, 0, SCALE_X); \
        __builtin_amdgcn_s_setprio(0); SBAR(); } while (0)
    if (tid < 8) ring_cnt[tid] = 0u;
    H_STAGE_A(0, 0, 0); H_STAGE_A(1, 0, 0); H_STAGE_A(0, 1, 1); H_STAGE_A(1, 1, 1);
#pragma unroll
    for (int i = 0; i < 8; ++i) H_ISSUE_B(i, 0);
    WAIT_V4(0, sb[0], sb[1], sb[2], sb[3]); WAIT_V4(0, sb[4], sb[5], sb[6], sb[7]);
#pragma unroll
    for (int i = 0; i < 8; ++i) H_WRITE_B(i, 0);
    SBAR();
#pragma unroll
    for (int i = 0; i < 8; ++i) H_ISSUE_B(i, 1);
    WAIT_V4(0, sb[0], sb[1], sb[2], sb[3]); WAIT_V4(0, sb[4], sb[5], sb[6], sb[7]);
#pragma unroll
    for (int i = 0; i < 8; ++i) H_WRITE_B(i, 1);
    SBAR();
    H_STAGE_A(0, 2, 2); H_STAGE_A(1, 2, 2);
#pragma unroll
    for (int i = 0; i < 8; ++i) H_ISSUE_B(i, 2);
    SBAR();
    RAW_BARRIER();
    int sa_r = 0, sa_w = 3, sb_r = 0, sb_w = 2;
#pragma unroll 1
    for (int t = 0; t < nt; ++t) {
        if (t >= 2) {
            const unsigned need = (unsigned)(t - 1);
            for (;;) { asm volatile("" ::: "memory"); const unsigned v = *(volatile LAS unsigned*)(ring_cnt + (lane & 7)); if (__all(v >= need)) break; __builtin_amdgcn_s_sleep(1); }
            asm volatile("" ::: "memory");
        }
        const int k3 = (t + 3 < nt) ? t + 3 : nt - 1;
        H_STAGE_A(0, k3, sa_w); H_STAGE_A(1, k3, sa_w);
        H_KSTEP(sa_r, sb_r);
        WAIT_V4(6, sb[0], sb[1], sb[2], sb[3]);
        H_WRITE_B(0, sb_w); H_WRITE_B(1, sb_w); H_WRITE_B(2, sb_w); H_WRITE_B(3, sb_w); SBAR();
        H_ISSUE_B(0, k3); H_ISSUE_B(1, k3); H_ISSUE_B(2, k3); H_ISSUE_B(3, k3); SBAR();
        WAIT_V4(6, sb[4], sb[5], sb[6], sb[7]);
        H_WRITE_B(4, sb_w); H_WRITE_B(5, sb_w); H_WRITE_B(6, sb_w); H_WRITE_B(7, sb_w); SBAR();
        H_ISSUE_B(4, k3); H_ISSUE_B(5, k3); H_ISSUE_B(6, k3); H_ISSUE_B(7, k3); SBAR();
        asm volatile("" ::: "memory");
        if (lane == 0) *(volatile LAS unsigned*)(ring_cnt + wid) = (unsigned)(t + 1);
        asm volatile("" ::: "memory");
        sa_r = (sa_r == A8_RING - 1) ? 0 : sa_r + 1; sa_w = (sa_w == A8_RING - 1) ? 0 : sa_w + 1;
        sb_r = (sb_r == B8_RING - 1) ? 0 : sb_r + 1; sb_w = (sb_w == B8_RING - 1) ? 0 : sb_w + 1;
    }
    WAIT_V4(0, sb[0], sb[1], sb[2], sb[3]); WAIT_V4(0, sb[4], sb[5], sb[6], sb[7]);
    RAW_BARRIER();
    epi.fin(acc, wr, wc, r32, hi);
#undef H_STAGE_A
#undef H_ISSUE_B
#undef H_WRITE_B
#undef H_KSTEP
}

struct Params {
    const float *x, *attn_norm, *w_in, *a_sink, *b_q_norm, *b_w_uq, *b_kv_norm, *b_w_ukv, *out_norm_a, *out_norm_b, *w_o, *mlp_norm, *w_router, *b_router,
        *w_up, *b_up, *w_down, *b_down, *final_norm;
    float* out; unsigned char* ws; int ph_lo, ph_hi;
};

struct ARows { const bf16_t* base; unsigned ld; __device__ __forceinline__ unsigned rowoff(int r) const { return (unsigned)r * ld; } };
struct AGather { const bf16_t* base; const int* tokl; int r0, cnt; __device__ __forceinline__ unsigned rowoff(int r) const { int rk = r0 + r; rk = rk < cnt ? rk : 0; return (unsigned)tokl[rk] * (unsigned)D_MODEL; } };
struct ARows8 { const unsigned char* base; unsigned ld; __device__ __forceinline__ unsigned rowoff(int r) const { return (unsigned)r * ld; } };
struct AGather8 { const unsigned char* base; const int* tokl; int r0, cnt; __device__ __forceinline__ unsigned rowoff(int r) const { int rk = r0 + r; rk = rk < cnt ? rk : 0; return (unsigned)tokl[rk] * (unsigned)D_MODEL; } };
struct BPlain { const float* base; size_t ld; int ncols;
    __device__ __forceinline__ unsigned coloff(int c) const { return (unsigned)(c < ncols ? c : (c & (ncols - 1))); } };
struct BGateUp { const float* base; size_t ld;
    __device__ __forceinline__ unsigned coloff(int c) const { const int wc = c >> 6, w = c & 63; return (unsigned)(wc * 32 + (w & 31) + ((w & 32) ? D_FF : 0)); } };

struct EpiProj {
    int pn, brow; unsigned char* ws; const float *qg, *kvg;
    __device__ __forceinline__ void mid(f32x4 (&)[8][4], int, int, int, int) {}
    __device__ __forceinline__ void fin(f32x4 (&acc)[8][4], int wr, int wc, int fr, int fq) {
        if (pn < 6) {
            bf16_t* dst; int ldd, c0;
            if (pn < 4) { dst = (bf16_t*)(ws + WS_QA); ldd = 1024; c0 = pn * 256; } else if (pn == 4) { dst = (bf16_t*)(ws + WS_KA); ldd = 256; c0 = 0; } else { dst = (bf16_t*)(ws + WS_VA); ldd = 256; c0 = 0; }
#pragma unroll
            for (int m = 0; m < 8; ++m) { const int row = brow + wr * 128 + m * 16 + fr;
#pragma unroll
                for (int n = 0; n < 4; ++n) { const int col = c0 + wc * 64 + n * 16 + fq * 4; const f32x4 v = acc[m][n];
                    *(u32x2*)(dst + (size_t)row * ldd + col) = (u32x2){pk_bf16(v[0], v[1]), pk_bf16(v[2], v[3])}; } }
        } else if (pn < 9) {
            bf16_t* dst; int ldd, c0; const float* g; float* ssq; int nsl, sl;
            if (pn < 8) { dst = (bf16_t*)(ws + WS_CQ); ldd = 512; c0 = (pn - 6) * 256; g = qg; ssq = (float*)(ws + WS_SSQC); nsl = 8; sl = (pn - 6) * 4 + wc; }
            else { dst = (bf16_t*)(ws + WS_CKV); ldd = 256; c0 = 0; g = kvg; ssq = (float*)(ws + WS_SSQK); nsl = 4; sl = wc; }
            f32x4 gvv[4];
#pragma unroll
            for (int n = 0; n < 4; ++n) gvv[n] = *(const f32x4*)(g + c0 + wc * 64 + n * 16 + fq * 4);
#pragma unroll
            for (int m = 0; m < 8; ++m) { const int row = brow + wr * 128 + m * 16 + fr; float ss = 0.f;
#pragma unroll
                for (int n = 0; n < 4; ++n) { const int col = c0 + wc * 64 + n * 16 + fq * 4; const f32x4 v = acc[m][n]; const f32x4 gv = gvv[n];
                    ss += v[0] * v[0] + v[1] * v[1] + v[2] * v[2] + v[3] * v[3];
                    *(u32x2*)(dst + (size_t)row * ldd + col) = (u32x2){pk_bf16(v[0] * gv[0], v[1] * gv[1]), pk_bf16(v[2] * gv[2], v[3] * gv[3])}; }
                ss += __shfl_xor(ss, 16, 64); ss += __shfl_xor(ss, 32, 64);
                if (fq == 0) ssq[(size_t)row * nsl + sl] = ss; }
        } else {
            if (wc == 0) {
                bf16_t* dst = (bf16_t*)(ws + WS_KPE); const float* rope = (const float*)(ws + WS_ROPE);
#pragma unroll
                for (int m = 0; m < 8; ++m) { const int row = brow + wr * 128 + m * 16 + fr; const int pos = row & (SEQ - 1);
#pragma unroll
                    for (int n = 0; n < 2; ++n) { const int i0 = n * 16 + fq * 4; const f32x4 x1 = acc[m][n], x2 = acc[m][n + 2];
                        const f32x4 cs0 = *(const f32x4*)(rope + ((size_t)pos * 32 + i0) * 2), cs1 = *(const f32x4*)(rope + ((size_t)pos * 32 + i0) * 2 + 4);
                        const float c[4] = {cs0[0], cs0[2], cs1[0], cs1[2]}, s[4] = {cs0[1], cs0[3], cs1[1], cs1[3]};
                        float o1[4], o2[4];
#pragma unroll
                        for (int j = 0; j < 4; ++j) { o1[j] = x1[j] * c[j] - x2[j] * s[j]; o2[j] = x1[j] * s[j] + x2[j] * c[j]; }
                        *(u32x2*)(dst + (size_t)row * 64 + i0) = (u32x2){pk_bf16(o1[0], o1[1]), pk_bf16(o1[2], o1[3])};
                        *(u32x2*)(dst + (size_t)row * 64 + 32 + i0) = (u32x2){pk_bf16(o2[0], o2[1]), pk_bf16(o2[2], o2[3])}; } }
            }
        }
    }
};
struct EpiQUp {
    int pn, brow; unsigned char* ws;
    __device__ __forceinline__ void mid(f32x4 (&)[8][4], int, int, int, int) {}
    __device__ __forceinline__ void fin(f32x4 (&acc)[8][4], int wr, int wc, int fr, int fq) {
        bf16_t* dst = (bf16_t*)(ws + WS_QB); const float* rope = (const float*)(ws + WS_ROPE); const float* ssq = (const float*)(ws + WS_CTL + CTL_SSQ_CQ);
        const int seg = pn * 4 + wc, head = seg / 3, part = seg - head * 3;
        float sq[8];
#pragma unroll
        for (int m = 0; m < 8; ++m) { const f32x4* pp = (const f32x4*)((const float*)(ws + WS_SSQC) + (size_t)(brow + wr * 128 + m * 16 + fr) * 8); const f32x4 p0 = pp[0], p1 = pp[1];
            sq[m] = ((p0[0] + p0[1]) + (p0[2] + p0[3])) + ((p1[0] + p1[1]) + (p1[2] + p1[3])); }
#pragma unroll
        for (int m = 0; m < 8; ++m) { const int row = brow + wr * 128 + m * 16 + fr; const float rs = rsqrtf(sq[m] * (1.f / 512.f) + EPS);
            bf16_t* drow = dst + (size_t)row * 1536 + head * 192 + part * 64;
            if (part < 2) {
#pragma unroll
                for (int n = 0; n < 4; ++n) { const f32x4 v = acc[m][n]; *(u32x2*)(drow + n * 16 + fq * 4) = (u32x2){pk_bf16(v[0] * rs, v[1] * rs), pk_bf16(v[2] * rs, v[3] * rs)}; }
            } else { const int pos = row & (SEQ - 1);
#pragma unroll
                for (int n = 0; n < 2; ++n) { const int i0 = n * 16 + fq * 4; const f32x4 x1 = acc[m][n], x2 = acc[m][n + 2];
                    const f32x4 cs0 = *(const f32x4*)(rope + ((size_t)pos * 32 + i0) * 2), cs1 = *(const f32x4*)(rope + ((size_t)pos * 32 + i0) * 2 + 4);
                    const float c[4] = {cs0[0], cs0[2], cs1[0], cs1[2]}, s[4] = {cs0[1], cs0[3], cs1[1], cs1[3]};
                    float o1[4], o2[4];
#pragma unroll
                    for (int j = 0; j < 4; ++j) { o1[j] = (x1[j] * c[j] - x2[j] * s[j]) * rs; o2[j] = (x1[j] * s[j] + x2[j] * c[j]) * rs; }
                    *(u32x2*)(drow + i0) = (u32x2){pk_bf16(o1[0], o1[1]), pk_bf16(o1[2], o1[3])};
                    *(u32x2*)(drow + 32 + i0) = (u32x2){pk_bf16(o2[0], o2[1]), pk_bf16(o2[2], o2[3])}; } }
        }
    }
};
struct EpiKvUp {
    int pn, brow; unsigned char* ws;
    __device__ __forceinline__ void mid(f32x4 (&)[8][4], int, int, int, int) {}
    __device__ __forceinline__ void fin(f32x4 (&acc)[8][4], int wr, int wc, int fr, int fq) {
        bf16_t* dst = (bf16_t*)(ws + WS_KVB);
        float sq[8];
#pragma unroll
        for (int m = 0; m < 8; ++m) { const f32x4 p0 = *(const f32x4*)((const float*)(ws + WS_SSQK) + (size_t)(brow + wr * 128 + m * 16 + fr) * 4); sq[m] = (p0[0] + p0[1]) + (p0[2] + p0[3]); }
#pragma unroll
        for (int m = 0; m < 8; ++m) { const int row = brow + wr * 128 + m * 16 + fr; const float rs = rsqrtf(sq[m] * (1.f / 256.f) + EPS);
#pragma unroll
            for (int n = 0; n < 4; ++n) { const int col = pn * 256 + wc * 64 + n * 16 + fq * 4; const f32x4 v = acc[m][n];
                *(u32x2*)(dst + (size_t)row * 2048 + col) = (u32x2){pk_bf16(v[0] * rs, v[1] * rs), pk_bf16(v[2] * rs, v[3] * rs)}; } }
    }
};
struct EpiWo {
    int pn, brow; unsigned char* ws; const float* x; const LAS float* tab;
    __device__ __forceinline__ void mid(f32x4 (&acc)[8][4], int wr, int wc, int fr, int fq) {
#pragma unroll
        for (int m = 0; m < 8; ++m) { const int r = wr * 128 + m * 16 + fr;
            const float f = __builtin_amdgcn_sqrtf((tab[256 + r] + EPS) * __builtin_amdgcn_rcpf(tab[r] + EPS));
#pragma unroll
            for (int n = 0; n < 4; ++n) acc[m][n] *= f;
            SBAR(); }
    }
    __device__ __forceinline__ void fin(f32x4 (&acc)[8][4], int wr, int wc, int fr, int fq) {
        float* x2 = (float*)(ws + WS_X2);
#pragma unroll
        for (int m = 0; m < 8; ++m) { const int r = wr * 128 + m * 16 + fr, row = brow + r; const float rbm = rsqrtf(tab[256 + r] + EPS); f32x4 xv[4];
#pragma unroll
            for (int n = 0; n < 4; ++n) xv[n] = *(const f32x4*)(x + (size_t)row * D_MODEL + pn * 256 + wc * 64 + n * 16 + fq * 4);
#pragma unroll
            for (int n = 0; n < 4; ++n) { const int col = pn * 256 + wc * 64 + n * 16 + fq * 4;
                const f32x4 v = acc[m][n] * rbm + xv[n];
                *(f32x4*)(x2 + (size_t)row * D_MODEL + col) = v; } }
    }
};
struct EpiUp8 {
    int j0, r0, cnt; unsigned char* dst; const float* bias;
    __device__ __forceinline__ void fin(f32x16 (&acc)[4][2], int wr, int wc, int r32, int hi) {
        f32x4 bg[4], bu[4];
#pragma unroll
        for (int rg = 0; rg < 4; ++rg) { const int j = j0 + wc * 32 + 8 * rg + 4 * hi; bg[rg] = *(const f32x4*)(bias + j); bu[rg] = *(const f32x4*)(bias + D_FF + j); }
#pragma unroll
        for (int m = 0; m < 4; ++m) { const int r = wr * 128 + m * 32 + r32; unsigned o8[4];
#pragma unroll
            for (int rg = 0; rg < 4; ++rg) { float o[4];
#pragma unroll
                for (int q = 0; q < 4; ++q) { const float g = fminf(acc[m][0][4 * rg + q] + bg[rg][q], 7.f), u = fminf(fmaxf(acc[m][1][4 * rg + q] + bu[rg][q], -7.f), 7.f);
                    const float sg = __builtin_amdgcn_rcpf(1.f + __builtin_amdgcn_exp2f(-1.702f * LOG2E * g)); o[q] = 4.f * (u + 1.f) * (g * sg); }
                o8[rg] = pk4_fp8(o[0], o[1], o[2], o[3]); }
            if (r0 + r < cnt) {
#pragma unroll
                for (int rg = 0; rg < 4; ++rg) *(unsigned*)(dst + (size_t)r * D_FF + j0 + wc * 32 + 8 * rg + 4 * hi) = o8[rg]; }
        }
    }
};
struct EpiDown8 {
    int c0, r0, cnt; bf16_t* dst; const float* bias;
    __device__ __forceinline__ void fin(f32x16 (&acc)[4][2], int wr, int wc, int r32, int hi) {
        f32x4 b[2][4];
#pragma unroll
        for (int n = 0; n < 2; ++n)
#pragma unroll
            for (int rg = 0; rg < 4; ++rg) b[n][rg] = *(const f32x4*)(bias + c0 + wc * 64 + n * 32 + 8 * rg + 4 * hi);
#pragma unroll
        for (int m = 0; m < 4; ++m) { const int r = wr * 128 + m * 32 + r32;
            if (r0 + r < cnt) {
#pragma unroll
                for (int n = 0; n < 2; ++n)
#pragma unroll
                    for (int rg = 0; rg < 4; ++rg) { const int col = c0 + wc * 64 + n * 32 + 8 * rg + 4 * hi;
                        *(u32x2*)(dst + (size_t)r * D_MODEL + col) = (u32x2){pk_bf16(acc[m][n][4 * rg] + b[n][rg][0], acc[m][n][4 * rg + 1] + b[n][rg][1]), pk_bf16(acc[m][n][4 * rg + 2] + b[n][rg][2], acc[m][n][4 * rg + 3] + b[n][rg][3])}; } }
        }
    }
};

constexpr int PG_HTB = 128 * 64 * 2;
__host__ __device__ __forceinline__ int pg_lds_byte(int r, int c) { const int st = (r >> 4) * 2 + (c >> 5), rr = r & 15, cc = c & 31, ob = rr * 64 + cc * 2; return st * 1024 + (ob ^ (((ob >> 9) & 1) << 5)); }
__host__ __device__ __forceinline__ void pg_stage_rc(int b, int& R, int& C) { const int st = b / 1024, sb = b % 1024, swz = sb ^ (((sb >> 9) & 1) << 5); R = (st >> 1) * 16 + swz / 64; C = (st & 1) * 32 + (swz % 64) / 2; }
__host__ __device__ __forceinline__ int pg_tcol(int rho) { return (rho & ~0x30) | ((rho & 0x10) << 1) | ((rho & 0x20) >> 1); }
template <bool MID, class EPI>
__device__ __forceinline__ void gemm_unit_pg(LAS char* lds, const bf16_t* A, const bf16_t* Bt, const int K, EPI& E) {
    const int tid = threadIdx.x, wid = __builtin_amdgcn_readfirstlane(tid >> 6), lane = tid & 63, wr = wid >> 2, wc = wid & 3, fr = lane & 15, fq = lane >> 4;
    const int nt = K / 64;
    unsigned voff[2];
#pragma unroll
    for (int i = 0; i < 2; ++i) { int R, C; pg_stage_rc(tid * 16 + i * 8192, R, C); voff[i] = (unsigned)(R * K + C) * 2u; }
    const size_t kstep = (size_t)(64 * 2), hstep = (size_t)128 * K * 2;
    const unsigned ldsw = (unsigned)wid * 1024u;
    const int aoff = pg_lds_byte(wr * 64 + fr, fq * 8), boff = pg_lds_byte(wc * 32 + fr, fq * 8);
#define PG_SA(b, h) (((b) * 2 + (h)) * PG_HTB)
#define PG_SB(b, h) ((4 + (b) * 2 + (h)) * PG_HTB)
#define PG_STAGE(bufoff, gbase) do { _Pragma("unroll") for (int _i = 0; _i < 2; ++_i) \
        __builtin_amdgcn_global_load_lds((const unsigned*)((const char*)(gbase) + voff[_i]), (LAS unsigned*)(lds + (bufoff) + ldsw + _i * 8192), 16, 0, 0); } while (0)
#define PG_LDA(dst, b, h) do { _Pragma("unroll") for (int m = 0; m < 4; ++m) _Pragma("unroll") for (int k = 0; k < 2; ++k) dst[m][k] = *(const LAS bf16x8*)(lds + PG_SA(b, h) + aoff + m * 2048 + k * 1024); } while (0)
#define PG_LDB(dst, b, h) do { _Pragma("unroll") for (int n = 0; n < 2; ++n) _Pragma("unroll") for (int k = 0; k < 2; ++k) dst[n][k] = *(const LAS bf16x8*)(lds + PG_SB(b, h) + boff + n * 2048 + k * 1024); } while (0)
#define PG_MMA(ai, bj, At_, Bt_) do { __builtin_amdgcn_s_setprio(1); _Pragma("unroll") for (int m = 0; m < 4; ++m) _Pragma("unroll") for (int n = 0; n < 2; ++n) _Pragma("unroll") for (int k = 0; k < 2; ++k) \
        acc[ai][bj][m][n] = __builtin_amdgcn_mfma_f32_16x16x32_bf16(Bt_[n][k], At_[m][k], acc[ai][bj][m][n], 0, 0, 0); __builtin_amdgcn_s_setprio(0); } while (0)
#define PG_WAIT_V(n) asm volatile("s_waitcnt vmcnt(" #n ")" ::: "memory")
#define PG_WAIT_L(n) asm volatile("s_waitcnt lgkmcnt(" #n ")" ::: "memory")
#define PG_BAR __builtin_amdgcn_s_barrier()
    f32x4 acc[2][2][4][2];
#pragma unroll
    for (int a = 0; a < 2; ++a)
#pragma unroll
        for (int b = 0; b < 2; ++b)
#pragma unroll
            for (int m = 0; m < 4; ++m)
#pragma unroll
                for (int n = 0; n < 2; ++n) acc[a][b][m][n] = (f32x4){0.f, 0.f, 0.f, 0.f};
    bf16x8 At[4][2], B0[2][2], B1[2][2];
    const char* cA = (const char*)A; const char* cB = (const char*)Bt;
    PG_STAGE(PG_SB(0, 0), cB); PG_STAGE(PG_SA(0, 0), cA); PG_STAGE(PG_SB(0, 1), cB + hstep); PG_STAGE(PG_SA(0, 1), cA + hstep);
    if (wr == 1) PG_BAR;
    PG_WAIT_V(4); PG_BAR;
    PG_STAGE(PG_SB(1, 0), cB + kstep); PG_STAGE(PG_SA(1, 0), cA + kstep); PG_STAGE(PG_SB(1, 1), cB + hstep + kstep);
    PG_WAIT_V(6); PG_BAR;
    for (int t = 0; t < nt; t += 2) {
        const bool last = (t == nt - 2);
        const char* a1 = cA + (size_t)(t + 1) * kstep;
        const char* a2 = last ? cA : cA + (size_t)(t + 2) * kstep; const char* b2 = last ? cB : cB + (size_t)(t + 2) * kstep;
        const char* a3 = a2 + kstep; const char* b3 = b2 + kstep;
        if (MID && t == (nt >> 1)) E.mid(acc, wr, wc, fr, fq);
        PG_LDB(B0, 0, 0); SBAR(); PG_LDA(At, 0, 0); PG_STAGE(PG_SA(1, 1), a1 + hstep);
        PG_WAIT_L(8); PG_BAR; PG_WAIT_L(0); PG_MMA(0, 0, At, B0); PG_BAR; SBAR();
        PG_LDB(B1, 0, 1); PG_STAGE(PG_SB(0, 0), b2);
        PG_BAR; PG_WAIT_L(0); PG_MMA(0, 1, At, B1); PG_BAR;
        PG_LDA(At, 0, 1); PG_STAGE(PG_SA(0, 0), a2);
        PG_BAR; PG_WAIT_L(0); PG_MMA(1, 0, At, B0); PG_BAR; SBAR();
        PG_STAGE(PG_SB(0, 1), b2 + hstep);
        PG_WAIT_V(6); PG_BAR; PG_MMA(1, 1, At, B1); PG_BAR;
        PG_LDB(B0, 1, 0); SBAR(); PG_LDA(At, 1, 0); PG_STAGE(PG_SA(0, 1), a2 + hstep);
        PG_WAIT_L(8); PG_BAR; PG_WAIT_L(0); PG_MMA(0, 0, At, B0); PG_BAR; SBAR();
        PG_LDB(B1, 1, 1); PG_STAGE(PG_SB(1, 0), b3);
        PG_BAR; PG_WAIT_L(0); PG_MMA(0, 1, At, B1); PG_BAR;
        PG_LDA(At, 1, 1); PG_STAGE(PG_SA(1, 0), a3);
        PG_BAR; PG_WAIT_L(0); PG_MMA(1, 0, At, B0); PG_BAR; SBAR();
        PG_STAGE(PG_SB(1, 1), b3 + hstep);
        PG_WAIT_V(6); PG_BAR; PG_MMA(1, 1, At, B1); PG_BAR;
    }
    E.fin(acc, wr, wc, fr, fq);
    PG_WAIT_V(0);
    if (wr == 0) PG_BAR;
    PG_BAR;
#undef PG_SA
#undef PG_SB
#undef PG_STAGE
#undef PG_LDA
#undef PG_LDB
#undef PG_MMA
#undef PG_WAIT_V
#undef PG_WAIT_L
#undef PG_BAR
}

#define PG_ROW(ai, m) (128 * (ai) + 64 * wr + 16 * (m) + fr)
#define PG_COL(bj, n) (128 * (bj) + 64 * (wc >> 1) + 32 * (n) + 16 * (wc & 1) + 4 * fq)
struct PEpiProj {
    int pn, brow; unsigned char* ws; const float *qg, *kvg;
    __device__ __forceinline__ void mid(f32x4 (&)[2][2][4][2], int, int, int, int) {}
    __device__ __forceinline__ void fin(f32x4 (&acc)[2][2][4][2], int wr, int wc, int fr, int fq) {
        if (pn < 6) {
            bf16_t* dst; int ldd, c0;
            if (pn < 4) { dst = (bf16_t*)(ws + WS_QA); ldd = 1024; c0 = pn * 256; } else if (pn == 4) { dst = (bf16_t*)(ws + WS_KA); ldd = 256; c0 = 0; } else { dst = (bf16_t*)(ws + WS_VA); ldd = 256; c0 = 0; }
#pragma unroll
            for (int ai = 0; ai < 2; ++ai)
#pragma unroll
                for (int m = 0; m < 4; ++m) { bf16_t* rowp = dst + (size_t)(brow + PG_ROW(ai, m)) * ldd + c0;
#pragma unroll
                    for (int bj = 0; bj < 2; ++bj)
#pragma unroll
                        for (int n = 0; n < 2; ++n) { const f32x4 v = acc[ai][bj][m][n]; *(u32x2*)(rowp + PG_COL(bj, n)) = (u32x2){pk_bf16(v[0], v[1]), pk_bf16(v[2], v[3])}; } }
        } else if (pn < 9) {
            bf16_t* dst; int ldd, c0; const float* g; float* ssq; int nsl, sl0;
            if (pn < 8) { dst = (bf16_t*)(ws + WS_CQ); ldd = 512; c0 = (pn - 6) * 256; g = qg; ssq = (float*)(ws + WS_SSQC); nsl = 16; sl0 = (pn - 6) * 8 + wc; }
            else { dst = (bf16_t*)(ws + WS_CKV); ldd = 256; c0 = 0; g = kvg; ssq = (float*)(ws + WS_SSQK); nsl = 8; sl0 = wc; }
            f32x4 gvv[2][2];
#pragma unroll
            for (int bj = 0; bj < 2; ++bj)
#pragma unroll
                for (int n = 0; n < 2; ++n) gvv[bj][n] = *(const f32x4*)(g + c0 + PG_COL(bj, n));
#pragma unroll
            for (int ai = 0; ai < 2; ++ai)
#pragma unroll
                for (int m = 0; m < 4; ++m) { const int row = brow + PG_ROW(ai, m);
#pragma unroll
                    for (int bj = 0; bj < 2; ++bj) { float ss = 0.f;
#pragma unroll
                        for (int n = 0; n < 2; ++n) { const f32x4 v = acc[ai][bj][m][n]; const f32x4 gv = gvv[bj][n];
                            ss += v[0] * v[0] + v[1] * v[1] + v[2] * v[2] + v[3] * v[3];
                            *(u32x2*)(dst + (size_t)row * ldd + c0 + PG_COL(bj, n)) = (u32x2){pk_bf16(v[0] * gv[0], v[1] * gv[1]), pk_bf16(v[2] * gv[2], v[3] * gv[3])}; }
                        ss += __shfl_xor(ss, 16, 64); ss += __shfl_xor(ss, 32, 64);
                        if (fq == 0) ssq[(size_t)row * nsl + sl0 + 4 * bj] = ss; } }
        } else {
            if (wc < 2) {
                bf16_t* dst = (bf16_t*)(ws + WS_KPE); const float* rope = (const float*)(ws + WS_ROPE); const int i0 = 16 * wc + 4 * fq;
#pragma unroll
                for (int ai = 0; ai < 2; ++ai)
#pragma unroll
                    for (int m = 0; m < 4; ++m) { const int row = brow + PG_ROW(ai, m); const int pos = row & (SEQ - 1); const f32x4 x1 = acc[ai][0][m][0], x2 = acc[ai][0][m][1];
                        const f32x4 cs0 = *(const f32x4*)(rope + ((size_t)pos * 32 + i0) * 2), cs1 = *(const f32x4*)(rope + ((size_t)pos * 32 + i0) * 2 + 4);
                        const float c[4] = {cs0[0], cs0[2], cs1[0], cs1[2]}, s[4] = {cs0[1], cs0[3], cs1[1], cs1[3]};
                        float o1[4], o2[4];
#pragma unroll
                        for (int j = 0; j < 4; ++j) { o1[j] = x1[j] * c[j] - x2[j] * s[j]; o2[j] = x1[j] * s[j] + x2[j] * c[j]; }
                        *(u32x2*)(dst + (size_t)row * 64 + i0) = (u32x2){pk_bf16(o1[0], o1[1]), pk_bf16(o1[2], o1[3])};
                        *(u32x2*)(dst + (size_t)row * 64 + 32 + i0) = (u32x2){pk_bf16(o2[0], o2[1]), pk_bf16(o2[2], o2[3])}; }
            }
        }
    }
};
struct PEpiQUp {
    int pn, brow; unsigned char* ws;
    __device__ __forceinline__ void mid(f32x4 (&)[2][2][4][2], int, int, int, int) {}
    __device__ __forceinline__ void fin(f32x4 (&acc)[2][2][4][2], int wr, int wc, int fr, int fq) {
        bf16_t* dst = (bf16_t*)(ws + WS_QB); const float* rope = (const float*)(ws + WS_ROPE);
        float rs[2][4];
#pragma unroll
        for (int ai = 0; ai < 2; ++ai)
#pragma unroll
            for (int m = 0; m < 4; ++m) { const f32x4* pp = (const f32x4*)((const float*)(ws + WS_SSQC) + (size_t)(brow + PG_ROW(ai, m)) * 16); const f32x4 p0 = pp[0], p1 = pp[1], p2 = pp[2], p3 = pp[3];
                const float sq = (((p0[0] + p0[1]) + (p0[2] + p0[3])) + ((p1[0] + p1[1]) + (p1[2] + p1[3]))) + (((p2[0] + p2[1]) + (p2[2] + p2[3])) + ((p3[0] + p3[1]) + (p3[2] + p3[3])));
                rs[ai][m] = rsqrtf(sq * (1.f / 512.f) + EPS); }
#pragma unroll
        for (int bj = 0; bj < 2; ++bj) { const int seg = pn * 4 + 2 * bj + (wc >> 1), head = seg / 3, part = seg - head * 3; const int i0 = 16 * (wc & 1) + 4 * fq;
#pragma unroll
            for (int ai = 0; ai < 2; ++ai)
#pragma unroll
                for (int m = 0; m < 4; ++m) { const int row = brow + PG_ROW(ai, m); const float r = rs[ai][m]; bf16_t* drow = dst + (size_t)row * 1536 + head * 192 + part * 64;
                    const f32x4 x1 = acc[ai][bj][m][0], x2 = acc[ai][bj][m][1];
                    if (part < 2) {
                        *(u32x2*)(drow + i0) = (u32x2){pk_bf16(x1[0] * r, x1[1] * r), pk_bf16(x1[2] * r, x1[3] * r)};
                        *(u32x2*)(drow + 32 + i0) = (u32x2){pk_bf16(x2[0] * r, x2[1] * r), pk_bf16(x2[2] * r, x2[3] * r)};
                    } else { const int pos = row & (SEQ - 1);
                        const f32x4 cs0 = *(const f32x4*)(rope + ((size_t)pos * 32 + i0) * 2), cs1 = *(const f32x4*)(rope + ((size_t)pos * 32 + i0) * 2 + 4);
                        const float c[4] = {cs0[0], cs0[2], cs1[0], cs1[2]}, s[4] = {cs0[1], cs0[3], cs1[1], cs1[3]};
                        float o1[4], o2[4];
#pragma unroll
                        for (int j = 0; j < 4; ++j) { o1[j] = (x1[j] * c[j] - x2[j] * s[j]) * r; o2[j] = (x1[j] * s[j] + x2[j] * c[j]) * r; }
                        *(u32x2*)(drow + i0) = (u32x2){pk_bf16(o1[0], o1[1]), pk_bf16(o1[2], o1[3])};
                        *(u32x2*)(drow + 32 + i0) = (u32x2){pk_bf16(o2[0], o2[1]), pk_bf16(o2[2], o2[3])}; } } }
    }
};
struct PEpiKvUp {
    int pn, brow; unsigned char* ws;
    __device__ __forceinline__ void mid(f32x4 (&)[2][2][4][2], int, int, int, int) {}
    __device__ __forceinline__ void fin(f32x4 (&acc)[2][2][4][2], int wr, int wc, int fr, int fq) {
        bf16_t* dst = (bf16_t*)(ws + WS_KVB);
#pragma unroll
        for (int ai = 0; ai < 2; ++ai)
#pragma unroll
            for (int m = 0; m < 4; ++m) { const int row = brow + PG_ROW(ai, m); const f32x4* pp = (const f32x4*)((const float*)(ws + WS_SSQK) + (size_t)row * 8); const f32x4 p0 = pp[0], p1 = pp[1];
                const float r = rsqrtf((((p0[0] + p0[1]) + (p0[2] + p0[3])) + ((p1[0] + p1[1]) + (p1[2] + p1[3]))) * (1.f / 256.f) + EPS);
#pragma unroll
                for (int bj = 0; bj < 2; ++bj)
#pragma unroll
                    for (int n = 0; n < 2; ++n) { const f32x4 v = acc[ai][bj][m][n];
                        *(u32x2*)(dst + (size_t)row * 2048 + pn * 256 + PG_COL(bj, n)) = (u32x2){pk_bf16(v[0] * r, v[1] * r), pk_bf16(v[2] * r, v[3] * r)}; } }
    }
};
struct PEpiWo {
    int pn, brow; unsigned char* ws; const float* x; const LAS float* tab;
    __device__ __forceinline__ void mid(f32x4 (&acc)[2][2][4][2], int wr, int wc, int fr, int fq) {
#pragma unroll
        for (int ai = 0; ai < 2; ++ai)
#pragma unroll
            for (int m = 0; m < 4; ++m) { const int r = PG_ROW(ai, m);
                const float f = __builtin_amdgcn_sqrtf((tab[256 + r] + EPS) * __builtin_amdgcn_rcpf(tab[r] + EPS));
#pragma unroll
                for (int bj = 0; bj < 2; ++bj)
#pragma unroll
                    for (int n = 0; n < 2; ++n) acc[ai][bj][m][n] *= f; }
        asm volatile("s_waitcnt lgkmcnt(0)" ::: "memory"); SBAR();
    }
    __device__ __forceinline__ void fin(f32x4 (&acc)[2][2][4][2], int wr, int wc, int fr, int fq) {
        float* x2 = (float*)(ws + WS_X2);
#pragma unroll
        for (int ai = 0; ai < 2; ++ai)
#pragma unroll
            for (int m = 0; m < 4; ++m) { const int r = PG_ROW(ai, m); const size_t o = (size_t)(brow + r) * D_MODEL + pn * 256; const float rbm = rsqrtf(tab[256 + r] + EPS); f32x4 xv[2][2];
#pragma unroll
                for (int bj = 0; bj < 2; ++bj)
#pragma unroll
                    for (int n = 0; n < 2; ++n) xv[bj][n] = *(const f32x4*)(x + o + PG_COL(bj, n));
#pragma unroll
                for (int bj = 0; bj < 2; ++bj)
#pragma unroll
                    for (int n = 0; n < 2; ++n) *(f32x4*)(x2 + o + PG_COL(bj, n)) = acc[ai][bj][m][n] * rbm + xv[bj][n]; }
    }
};
__device__ __forceinline__ void pg_convert(const float* W, int K, int ld, int ncols, int nrows, bf16_t* Bt, int item0, int nitems_stride) {
    const int total = nrows * (K >> 3);
    for (int it0 = item0; it0 < total; it0 += 4 * nitems_stride) { float v[4][8]; int row[4], k0[4]; bool ok[4];
#pragma unroll
        for (int b = 0; b < 4; ++b) { const int it = it0 + b * nitems_stride; const int itc = it < total ? it : item0; const int kc = itc / nrows; row[b] = itc - kc * nrows; k0[b] = kc << 3; ok[b] = it < total;
            const int col = (row[b] & ~255) + pg_tcol(row[b] & 255); const int colc = col < ncols ? col : 0; const float s = col < ncols ? 1.f : 0.f;
#pragma unroll
            for (int q = 0; q < 8; ++q) v[b][q] = W[(size_t)(k0[b] + q) * ld + colc] * s; }
#pragma unroll
        for (int b = 0; b < 4; ++b) if (ok[b])
            *(u32x4*)(Bt + (size_t)row[b] * K + k0[b]) = (u32x4){pk_bf16(v[b][0], v[b][1]), pk_bf16(v[b][2], v[b][3]), pk_bf16(v[b][4], v[b][5]), pk_bf16(v[b][6], v[b][7])}; }
}
__device__ __forceinline__ void sincos_d(double x, double& s, double& c) {
    const double k = __builtin_rint(x * 0.63661977236758134308);
    double r = __builtin_fma(-k, 1.57079632679489655800e+00, x); r = __builtin_fma(-k, 6.12323399573676603587e-17, r);
    const double r2 = r * r;
    double sp = -7.6471637318198164759e-13; sp = sp * r2 + 1.6059043836821614599e-10; sp = sp * r2 - 2.5052108385441718775e-08; sp = sp * r2 + 2.7557319223985890653e-06;
    sp = sp * r2 - 1.9841269841269841270e-04; sp = sp * r2 + 8.3333333333333333333e-03; sp = sp * r2 - 1.6666666666666666667e-01; const double sn = r + r * r2 * sp;
    double cp = 4.7794773323873852974e-14; cp = cp * r2 - 1.1470745597729724714e-11; cp = cp * r2 + 2.0876756987868098979e-09; cp = cp * r2 - 2.7557319223985890653e-07;
    cp = cp * r2 + 2.4801587301587301587e-05; cp = cp * r2 - 1.3888888888888888889e-03; cp = cp * r2 + 4.1666666666666666667e-02; cp = cp * r2 - 0.5; const double cn = 1.0 + r2 * cp;
    const int q = ((int)k) & 3;
    s = (q == 0) ? sn : (q == 1) ? cn : (q == 2) ? -sn : -cn;
    c = (q == 0) ? cn : (q == 1) ? -sn : (q == 2) ? -cn : sn;
}

__device__ __forceinline__ void phase_prologue(const Params& p) {
    const int tid = threadIdx.x, wid = tid >> 6, lane = tid & 63;
    bf16_t* xn = (bf16_t*)(p.ws + WS_XN);
    for (int row = blockIdx.x * 8 + wid; row < NTOK; row += gridDim.x * 8) {
        const f32x4* xr = (const f32x4*)(p.x + (size_t)row * D_MODEL); f32x4 v[8]; float ss = 0.f;
#pragma unroll
        for (int i = 0; i < 8; ++i) { v[i] = xr[lane + 64 * i]; ss += v[i][0] * v[i][0] + v[i][1] * v[i][1] + v[i][2] * v[i][2] + v[i][3] * v[i][3]; }
        ss = wave_sum(ss); const float rs = rsqrtf(ss * (1.f / D_MODEL) + EPS);
#pragma unroll
        for (int i = 0; i < 8; ++i) { const f32x4 g = ((const f32x4*)p.attn_norm)[lane + 64 * i];
            *(u32x2*)(xn + (size_t)row * D_MODEL + 4 * (lane + 64 * i)) = (u32x2){pk_bf16(v[i][0] * rs * g[0], v[i][1] * rs * g[1]), pk_bf16(v[i][2] * rs * g[2], v[i][3] * rs * g[3])}; }
    }
    const int gtid = blockIdx.x * 512 + tid;
    if (gtid < SEQ * 32) {
        const int pos = gtid >> 5, i = gtid & 31;
        double b = 10000.0; for (int q = 0; q < 5; ++q) b = __builtin_sqrt(b);
        double f = 1.0; for (int q = 0; q < i; ++q) f *= b;
        const float inv_freq = (float)(1.0 / f); const float ang = (float)pos * inv_freq;
        double s, c; sincos_d((double)ang, s, c);
        float* rope = (float*)(p.ws + WS_ROPE); rope[(size_t)gtid * 2] = (float)c; rope[(size_t)gtid * 2 + 1] = (float)s;
    }
    {
        const int nth = gridDim.x * 512;
        pg_convert(p.w_in, D_MODEL, IN_COLS, IN_COLS, 2560, (bf16_t*)(p.ws + WS_BT_IN), gtid, nth);
        pg_convert(p.b_w_uq, 512, 1536, 1536, 1536, (bf16_t*)(p.ws + WS_BT_UQ), gtid, nth);
    }
    if (gtid < N_EXP * D_MODEL) {
        ((float*)(p.ws + WS_WRT))[gtid] = p.w_router[gtid] * p.mlp_norm[gtid >> 5];
    }
}

constexpr int AA_PITCH = 144;
constexpr int AA_K = 0, AA_V = 384 * AA_PITCH;
constexpr int AA_WS = 2 * 384 * AA_PITCH;
__device__ __forceinline__ void attn_a_unit(const Params& p, LAS char* lds, int u) {
    const int tid = threadIdx.x, wid = __builtin_amdgcn_readfirstlane(tid >> 6), lane = tid & 63, r32 = lane & 31, hi = lane >> 5;
    const int b = u >> 7, nq = (u >> 2) & 31, kvh = u & 3;
    const bf16_t* QA = (const bf16_t*)(p.ws + WS_QA); const bf16_t* KA = (const bf16_t*)(p.ws + WS_KA); const bf16_t* VA = (const bf16_t*)(p.ws + WS_VA);
    const int P0 = (nq - 1) * 128;
    __syncthreads();
    for (int c = tid; c < 384 * 8; c += 512) { const int r = c >> 3, ch = c & 7; const int pos = P0 + r;
        i32x4 kv = {0, 0, 0, 0}, vv = {0, 0, 0, 0};
        if (pos >= 0 && pos < SEQ) { const size_t g = ((size_t)(b * SEQ + pos)) * 256 + kvh * 64 + ch * 8; kv = *(const i32x4*)(KA + g); vv = *(const i32x4*)(VA + g); }
        *(LAS i32x4*)(lds + AA_K + r * AA_PITCH + ch * 16) = kv; *(LAS i32x4*)(lds + AA_V + r * AA_PITCH + ch * 16) = vv; }
    __syncthreads();
    LAS float* wsf = (LAS float*)(lds + AA_WS) + wid * 64;
    const int hq = kvh * 4 + (wid >> 1);
    const float slope2 = __builtin_amdgcn_exp2f(-8.f * (float)(hq + 1) / 16.f) * LOG2E;
    const float sink2 = p.a_sink[hq] * LOG2E;
    const float C = 0.125f * LOG2E;
    const float* ga = p.out_norm_a + hq * 64;
    bf16_t* Y = (bf16_t*)(p.ws + WS_Y); float* ssqa = (float*)(p.ws + WS_SSQP);
    for (int blk = 0; blk < 2; ++blk) {
        const int q0 = nq * 128 + (wid & 1) * 64 + blk * 32;
        const int tq = q0 + r32;
        bf16x8 qr[4];
        { const bf16_t* qp = QA + ((size_t)(b * SEQ + tq)) * 1024 + hq * 64 + hi * 8;
#pragma unroll
          for (int d0 = 0; d0 < 4; ++d0) qr[d0] = *(const bf16x8*)(qp + d0 * 16); }
        float m_reg = sink2, l_reg = 1.f; f32x16 o[2] = {};
        for (int jt = 0; jt < 6; ++jt) {
            const int kp0 = P0 + jt * 64;
            if (kp0 + 63 < q0 - 128 || kp0 > q0 + 31 + 128 || kp0 + 63 < 0 || kp0 >= SEQ) continue;
            f32x16 p0 = {}, p1 = {};
#pragma unroll
            for (int d0 = 0; d0 < 4; ++d0) {
                const bf16x8 k0 = *(const LAS bf16x8*)(lds + AA_K + (jt * 64 + r32) * AA_PITCH + (d0 * 16 + hi * 8) * 2);
                const bf16x8 k1 = *(const LAS bf16x8*)(lds + AA_K + (jt * 64 + 32 + r32) * AA_PITCH + (d0 * 16 + hi * 8) * 2);
                p0 = __builtin_amdgcn_mfma_f32_32x32x16_bf16(k0, qr[d0], p0, 0, 0, 0);
                p1 = __builtin_amdgcn_mfma_f32_32x32x16_bf16(k1, qr[d0], p1, 0, 0, 0);
            }
            float pmax = -1e30f;
#pragma unroll
            for (int r = 0; r < 16; ++r) {
                { const int kp = kp0 + crow(r, hi); const int dist = tq > kp ? tq - kp : kp - tq; const bool ok = dist <= 128 && kp >= 0 && kp < SEQ;
                  p0[r] = ok ? p0[r] * C - slope2 * (float)dist : -1e30f; pmax = fmaxf(pmax, p0[r]); }
                { const int kp = kp0 + 32 + crow(r, hi); const int dist = tq > kp ? tq - kp : kp - tq; const bool ok = dist <= 128 && kp >= 0 && kp < SEQ;
                  p1[r] = ok ? p1[r] * C - slope2 * (float)dist : -1e30f; pmax = fmaxf(pmax, p1[r]); }
            }
            { auto rr = __builtin_amdgcn_permlane32_swap(__float_as_uint(pmax), __float_as_uint(pmax), false, false); pmax = fmaxf(__uint_as_float(rr[0]), __uint_as_float(rr[1])); }
            const float mn = fmaxf(m_reg, pmax); const float alpha = __builtin_amdgcn_exp2f(m_reg - mn); m_reg = mn;
            float ps = 0.f;
#pragma unroll
            for (int r = 0; r < 16; ++r) { p0[r] = __builtin_amdgcn_exp2f(p0[r] - mn); p1[r] = __builtin_amdgcn_exp2f(p1[r] - mn); ps += p0[r] + p1[r]; }
            { auto rr = __builtin_amdgcn_permlane32_swap(__float_as_uint(ps), __float_as_uint(ps), false, false); ps = __uint_as_float(rr[0]) + __uint_as_float(rr[1]); }
            l_reg = l_reg * alpha + ps;
            if (hi == 0) wsf[r32] = alpha;
            WAIT_L0();
#pragma unroll
            for (int r = 0; r < 16; ++r) { const float a = wsf[crow(r, hi)]; o[0][r] *= a; o[1][r] *= a; }
            bf16x8 pa[4];
#define PK4(P, BASE, OUT) do { unsigned a0 = pk_bf16(P[BASE + 0], P[BASE + 1]), a1 = pk_bf16(P[BASE + 2], P[BASE + 3]); \
    unsigned b0 = pk_bf16(P[BASE + 4], P[BASE + 5]), b1 = pk_bf16(P[BASE + 6], P[BASE + 7]); \
    auto r0_ = __builtin_amdgcn_permlane32_swap(a0, b0, false, false); auto r1_ = __builtin_amdgcn_permlane32_swap(a1, b1, false, false); \
    u32x4 w_ = {r0_[0], r1_[0], r0_[1], r1_[1]}; OUT = __builtin_bit_cast(bf16x8, w_); } while (0)
            PK4(p0, 0, pa[0]); PK4(p0, 8, pa[1]); PK4(p1, 0, pa[2]); PK4(p1, 8, pa[3]);
            const int g16 = (lane >> 4) & 1, qq = (lane & 15) >> 2, pp = lane & 3;
#pragma unroll
            for (int db = 0; db < 2; ++db) {
#pragma unroll
                for (int ks = 0; ks < 4; ++ks) {
                    const LAS char* vp = lds + AA_V + (jt * 64 + ks * 16 + 8 * hi + qq) * AA_PITCH + (db * 32 + 16 * g16 + 4 * pp) * 2;
                    const s16x4 lo = vtr(vp), hh = vtr(vp + 4 * AA_PITCH);
                    const bf16x8 vb = (bf16x8){lo[0], lo[1], lo[2], lo[3], hh[0], hh[1], hh[2], hh[3]};
                    o[db] = __builtin_amdgcn_mfma_f32_32x32x16_bf16(pa[ks], vb, o[db], 0, 0, 0);
                }
            }
            WAIT_L0();
        }
        if (hi == 0) wsf[r32] = 1.f / l_reg;
        WAIT_L0();
        const float g0 = ga[r32], g1 = ga[32 + r32];
#pragma unroll
        for (int r = 0; r < 16; ++r) { const int qrow = crow(r, hi); const float il = wsf[qrow]; const float v0 = o[0][r] * il, v1 = o[1][r] * il;
            const size_t tok = (size_t)(b * SEQ + q0 + qrow);
            bf16_t* yp = Y + tok * 2048 + hq * 64;
            yp[r32] = (bf16_t)(pk_bf16(v0 * g0, 0.f) & 0xffffu); yp[32 + r32] = (bf16_t)(pk_bf16(v1 * g1, 0.f) & 0xffffu);
            float ss = v0 * v0 + v1 * v1;
#pragma unroll
            for (int s = 16; s >= 1; s >>= 1) ss += __shfl_xor(ss, s, 64);
            if (r32 == 0) ssqa[tok * 24 + hq] = ss; }
        WAIT_L0();
    }
}

constexpr int MB_V = 0, MB_KN = 32768, MB_KP = 65536, MB_WS = 81920, MB_QP = 83968;
#define KSWZ(row, colB) ((row) * 256 + ((colB) ^ (((row) & 7) << 4)))
#define KPSWZ(row, colB) ((row) * 128 + ((colB) ^ (((row) & 7) << 4)))
constexpr float MLA_SCALE = 0.07216878364870322f;
constexpr float MLA_THR = 8.f;
__device__ __forceinline__ void mla_partialSM(f32x16& p0, f32x16& p1, float& m_reg, float& mn, float& alpha) {
    constexpr float C = MLA_SCALE * LOG2E;
    float pmax = p0[0];
#pragma unroll
    for (int r = 1; r < 16; ++r) pmax = fmaxf(pmax, p0[r]);
#pragma unroll
    for (int r = 0; r < 16; ++r) pmax = fmaxf(pmax, p1[r]);
    { auto rr = __builtin_amdgcn_permlane32_swap(__float_as_uint(pmax), __float_as_uint(pmax), false, false); pmax = fmaxf(__uint_as_float(rr[0]), __uint_as_float(rr[1])); }
    if (__builtin_expect(__all(pmax - m_reg <= MLA_THR / MLA_SCALE), 1)) { mn = m_reg; alpha = 1.f; }
    else { mn = fmaxf(m_reg, pmax); alpha = __builtin_amdgcn_exp2f((m_reg - mn) * C); m_reg = mn; }
    const float mnC = -mn * C;
#pragma unroll
    for (int r = 0; r < 16; ++r) p0[r] = fmaf(p0[r], C, mnC);
#pragma unroll
    for (int r = 0; r < 16; ++r) p1[r] = fmaf(p1[r], C, mnC);
#pragma unroll
    for (int r = 0; r < 16; ++r) p0[r] = __builtin_amdgcn_exp2f(p0[r]);
}
__device__ __forceinline__ void mla_finishSM(f32x16& p0, f32x16& p1, float alpha, float& l_reg, bf16x8& pa0, bf16x8& pa1, bf16x8& pa2, bf16x8& pa3) {
#pragma unroll
    for (int r = 0; r < 16; ++r) p1[r] = __builtin_amdgcn_exp2f(p1[r]);
    float ps = 0;
#pragma unroll
    for (int r = 0; r < 16; ++r) ps += p0[r];
#pragma unroll
    for (int r = 0; r < 16; ++r) ps += p1[r];
    { auto rr = __builtin_amdgcn_permlane32_swap(__float_as_uint(ps), __float_as_uint(ps), false, false); ps = __uint_as_float(rr[0]) + __uint_as_float(rr[1]); }
    l_reg = l_reg * alpha + ps;
    PK4(p0, 0, pa0); PK4(p0, 8, pa1); PK4(p1, 0, pa2); PK4(p1, 8, pa3);
}
__device__ __forceinline__ void mla_qkt(f32x16& p0, f32x16& p1, const LAS char* Kn, const LAS char* Kp, const bf16x8* qr, const LAS char* qp, int r32, int hi) {
    p0 = f32x16{}; p1 = f32x16{};
#pragma unroll
    for (int d0 = 0; d0 < 8; ++d0) { const int cb = (d0 * 16 + hi * 8) * 2;
        const bf16x8 b0 = *(const LAS bf16x8*)(Kn + KSWZ(r32, cb)); const bf16x8 b1 = *(const LAS bf16x8*)(Kn + KSWZ(32 + r32, cb));
        p0 = __builtin_amdgcn_mfma_f32_32x32x16_bf16(b0, qr[d0], p0, 0, 0, 0); p1 = __builtin_amdgcn_mfma_f32_32x32x16_bf16(b1, qr[d0], p1, 0, 0, 0); }
#pragma unroll
    for (int d0 = 0; d0 < 4; ++d0) { const int cb = (d0 * 16 + hi * 8) * 2;
        const bf16x8 b0 = *(const LAS bf16x8*)(Kp + KPSWZ(r32, cb)); const bf16x8 b1 = *(const LAS bf16x8*)(Kp + KPSWZ(32 + r32, cb));
        const bf16x8 q = *(const LAS bf16x8*)(qp + d0 * 1024);
        p0 = __builtin_amdgcn_mfma_f32_32x32x16_bf16(b0, q, p0, 0, 0, 0); p1 = __builtin_amdgcn_mfma_f32_32x32x16_bf16(b1, q, p1, 0, 0, 0); }
}
__device__ __forceinline__ int v_st(int k, int c) { const int kk = (k & ~0xC) | ((k & 4) << 1) | ((k & 8) >> 1); return ((kk >> 3) * 4 + (c >> 5)) * 512 + ((kk & 7) * 32 + (c & 31)) * 2; }
__device__ __forceinline__ int v_rd_base(int lane) { return ((lane & 3) << 3) | (((lane >> 2) & 3) << 6) | (((lane >> 4) & 1) << 5) | (((lane >> 5) & 1) << 8); }
constexpr int v_rd_off(int d0, int ks, int half) { return d0 * 512 + ks * 4096 + half * 2048; }
template <int D0> __device__ __forceinline__ void mla_pv_one(f32x16& od, const LAS char* vb, bf16x8 pa0, bf16x8 pa1, bf16x8 pa2, bf16x8 pa3) {
    const s16x4 l0 = vtr(vb + v_rd_off(D0, 0, 0)), h0 = vtr(vb + v_rd_off(D0, 0, 1)), l1 = vtr(vb + v_rd_off(D0, 1, 0)), h1 = vtr(vb + v_rd_off(D0, 1, 1));
    const s16x4 l2 = vtr(vb + v_rd_off(D0, 2, 0)), h2 = vtr(vb + v_rd_off(D0, 2, 1)), l3 = vtr(vb + v_rd_off(D0, 3, 0)), h3 = vtr(vb + v_rd_off(D0, 3, 1));
#define PKV(L, H) (bf16x8){L[0], L[1], L[2], L[3], H[0], H[1], H[2], H[3]}
    od = __builtin_amdgcn_mfma_f32_32x32x16_bf16(pa0, PKV(l0, h0), od, 0, 0, 0);
    od = __builtin_amdgcn_mfma_f32_32x32x16_bf16(pa1, PKV(l1, h1), od, 0, 0, 0);
    od = __builtin_amdgcn_mfma_f32_32x32x16_bf16(pa2, PKV(l2, h2), od, 0, 0, 0);
    od = __builtin_amdgcn_mfma_f32_32x32x16_bf16(pa3, PKV(l3, h3), od, 0, 0, 0);
#undef PKV
}
__device__ __forceinline__ void mla_pv(f32x16* o, const LAS char* vb, bf16x8 pa0, bf16x8 pa1, bf16x8 pa2, bf16x8 pa3) {
    mla_pv_one<0>(o[0], vb, pa0, pa1, pa2, pa3); mla_pv_one<1>(o[1], vb, pa0, pa1, pa2, pa3); mla_pv_one<2>(o[2], vb, pa0, pa1, pa2, pa3); mla_pv_one<3>(o[3], vb, pa0, pa1, pa2, pa3);
}
__device__ __forceinline__ void mla_unit(const Params& p, LAS char* lds, int u) {
    const int tid = threadIdx.x, wid = __builtin_amdgcn_readfirstlane(tid >> 6), lane = tid & 63, r32 = lane & 31, hi = lane >> 5;
    const int bh = u >> 4, qb = u & 15, b = bh >> 3, h = bh & 7;
    const bf16_t* QB = (const bf16_t*)(p.ws + WS_QB); const bf16_t* KVB = (const bf16_t*)(p.ws + WS_KVB); const bf16_t* KPE = (const bf16_t*)(p.ws + WS_KPE);
    const bf16_t* Kh = KVB + (size_t)b * SEQ * 2048 + h * 256;
    const bf16_t* Ph = KPE + (size_t)b * SEQ * 64;
    LAS float* wsf = (LAS float*)(lds + MB_WS) + wid * 64; LAS float* li_l = wsf; LAS float* al_l = wsf + 32;
    float m_reg = -1e30f, l_reg = 0; f32x16 o[4] = {}; bf16x8 qr[8];
    LAS char* qp = lds + MB_QP + wid * 4096 + lane * 16;
    { const bf16_t* Qw = QB + ((size_t)(b * SEQ + qb * 256 + wid * 32 + r32)) * 1536 + h * 192 + hi * 8;
#pragma unroll
      for (int d0 = 0; d0 < 8; ++d0) qr[d0] = *(const bf16x8*)(Qw + d0 * 16);
      __syncthreads();
#pragma unroll
      for (int d0 = 0; d0 < 4; ++d0) *(LAS bf16x8*)(qp + d0 * 1024) = *(const bf16x8*)(Qw + (8 + d0) * 16); }
    const int sr = tid >> 4, sc = (tid & 15) * 8, vst0 = v_st(sr, sc), vst1 = v_st(32 + sr, sc);
    const int pr = tid >> 3, pc = (tid & 7) * 8;
    const LAS char* vb0 = lds + MB_V + v_rd_base(lane);
    bf16x8 vs0, vs1, ks0, ks1, kp0;
#define SLOAD(k0) do { vs0 = *(const bf16x8*)(Kh + (size_t)((k0) + sr) * 2048 + 128 + sc); vs1 = *(const bf16x8*)(Kh + (size_t)((k0) + 32 + sr) * 2048 + 128 + sc); \
    ks0 = *(const bf16x8*)(Kh + (size_t)((k0) + sr) * 2048 + sc); ks1 = *(const bf16x8*)(Kh + (size_t)((k0) + 32 + sr) * 2048 + sc); \
    kp0 = *(const bf16x8*)(Ph + (size_t)((k0) + pr) * 64 + pc); } while (0)
#define SWRITE(bb) do { *(LAS bf16x8*)(lds + MB_V + (bb) * 16384 + vst0) = vs0; *(LAS bf16x8*)(lds + MB_V + (bb) * 16384 + vst1) = vs1; \
    *(LAS bf16x8*)(lds + MB_KN + (bb) * 16384 + KSWZ(sr, sc * 2)) = ks0; *(LAS bf16x8*)(lds + MB_KN + (bb) * 16384 + KSWZ(32 + sr, sc * 2)) = ks1; \
    *(LAS bf16x8*)(lds + MB_KP + (bb) * 8192 + KPSWZ(pr, pc * 2)) = kp0; } while (0)
#define RESC(a) do { if (__any((a) < 1.f)) { if (hi == 0) al_l[r32] = (a); WAIT_L0(); \
    _Pragma("unroll") for (int d = 0; d < 4; ++d) _Pragma("unroll") for (int r = 0; r < 16; ++r) o[d][r] *= al_l[crow(r, hi)]; } } while (0)
    f32x16 pA0, pA1, pB0, pB1; float mnA, mnB, alA, alB; bf16x8 pa0, pa1, pa2, pa3; constexpr int NT = SEQ / 64;
    SLOAD(0); SWRITE(0); __syncthreads();
    mla_qkt(pA0, pA1, lds + MB_KN, lds + MB_KP, qr, qp, r32, hi); mla_partialSM(pA0, pA1, m_reg, mnA, alA);
    SLOAD(64); SWRITE(1); __syncthreads();
    for (int j = 1; j + 1 < NT; j += 2) {
        SBAR(); mla_qkt(pB0, pB1, lds + MB_KN + 16384, lds + MB_KP + 8192, qr, qp, r32, hi);
        mla_finishSM(pA0, pA1, alA, l_reg, pa0, pa1, pa2, pa3); SBAR();
        SLOAD((j + 1) * 64); SBAR();
        mla_pv(o, vb0, pa0, pa1, pa2, pa3); mla_partialSM(pB0, pB1, m_reg, mnB, alB);
        __syncthreads(); SWRITE(0);
        RESC(alB); __syncthreads();
        SBAR(); mla_qkt(pA0, pA1, lds + MB_KN, lds + MB_KP, qr, qp, r32, hi);
        mla_finishSM(pB0, pB1, alB, l_reg, pa0, pa1, pa2, pa3); SBAR();
        SLOAD((j + 2) * 64); SBAR();
        mla_pv(o, vb0 + 16384, pa0, pa1, pa2, pa3); mla_partialSM(pA0, pA1, m_reg, mnA, alA);
        __syncthreads(); SWRITE(1);
        RESC(alA); __syncthreads();
    }
    SBAR(); mla_qkt(pB0, pB1, lds + MB_KN + 16384, lds + MB_KP + 8192, qr, qp, r32, hi);
    mla_finishSM(pA0, pA1, alA, l_reg, pa0, pa1, pa2, pa3); SBAR();
    mla_pv(o, vb0, pa0, pa1, pa2, pa3); mla_partialSM(pB0, pB1, m_reg, mnB, alB);
    __syncthreads(); RESC(alB);
    mla_finishSM(pB0, pB1, alB, l_reg, pa0, pa1, pa2, pa3); SBAR();
    mla_pv(o, vb0 + 16384, pa0, pa1, pa2, pa3);
    if (hi == 0) li_l[r32] = l_reg; WAIT_L0();
    bf16_t* Y = (bf16_t*)(p.ws + WS_Y); float* ssqb = (float*)(p.ws + WS_SSQP);
    const float* gb = p.out_norm_b + h * 128;
    float g[4];
#pragma unroll
    for (int d0 = 0; d0 < 4; ++d0) g[d0] = gb[d0 * 32 + r32];
#pragma unroll
    for (int r = 0; r < 16; ++r) { const int orow = crow(r, hi); const float il = __builtin_amdgcn_rcpf(li_l[orow]);
        const size_t tok = (size_t)(b * SEQ + qb * 256 + wid * 32 + orow); bf16_t* yp = Y + tok * 2048 + 1024 + h * 128; float ss = 0.f;
#pragma unroll
        for (int d0 = 0; d0 < 4; ++d0) { const float v = o[d0][r] * il; ss += v * v; yp[d0 * 32 + r32] = (bf16_t)(pk_bf16(v * g[d0], 0.f) & 0xffffu); }
#pragma unroll
        for (int s = 16; s >= 1; s >>= 1) ss += __shfl_xor(ss, s, 64);
        if (r32 == 0) ssqb[tok * 24 + 16 + h] = ss; }
#undef SLOAD
#undef SWRITE
#undef RESC
}

__device__ __forceinline__ void phase_router(const Params& p, LAS char* lds) {
    const int tid = threadIdx.x, wid = __builtin_amdgcn_readfirstlane(tid >> 6), lane = tid & 63;
    const float* x2 = (const float*)(p.ws + WS_X2); const float* wg = (const float*)(p.ws + WS_WRT);
    unsigned char* xn8 = p.ws + WS_XN; unsigned* cnt = (unsigned*)(p.ws + WS_CTL + CTL_CNT);
    int* tokl = (int*)(p.ws + WS_TOKL); int* sel_e = (int*)(p.ws + WS_SEL); int* sel_r = sel_e + NTOK * 4; float* sel_g = (float*)(sel_r + NTOK * 4);
    LAS float* part = (LAS float*)lds;
    LAS float* rsv = (LAS float*)(lds + 32768);
    LAS unsigned* hist = (LAS unsigned*)(lds + 32768 + 128); LAS unsigned* hbase = hist + 32;
    for (int t0 = blockIdx.x * 32; t0 < NTOK; t0 += gridDim.x * 32) {
        __syncthreads();
        if (tid < N_EXP) hist[tid] = 0u;
#pragma unroll 1
        for (int j = 0; j < 4; ++j) { const int t = t0 + 4 * wid + j; f32x4 xr[8]; float ss = 0.f;
#pragma unroll
            for (int i = 0; i < 8; ++i) { xr[i] = ((const f32x4*)(x2 + (size_t)t * D_MODEL))[lane + 64 * i]; ss += xr[i][0] * xr[i][0] + xr[i][1] * xr[i][1] + xr[i][2] * xr[i][2] + xr[i][3] * xr[i][3]; }
            const float rs = rsqrtf(wave_sum(ss) * (1.f / D_MODEL) + EPS);
            if (lane == 0) rsv[4 * wid + j] = rs;
#pragma unroll
            for (int i = 0; i < 8; ++i) { const f32x4 v = xr[i]; const f32x4 g = ((const f32x4*)p.mlp_norm)[lane + 64 * i]; const float s16 = 16.f * rs;
                *(unsigned*)(xn8 + (size_t)t * D_MODEL + 4 * (lane + 64 * i)) = pk4_fp8(s16 * v[0] * g[0], s16 * v[1] * g[1], s16 * v[2] * g[2], s16 * v[3] * g[3]); } }
        { f32x16 acc;
#pragma unroll
          for (int r = 0; r < 16; ++r) acc[r] = 0.f;
          const float* ap = x2 + (size_t)(t0 + (lane & 31)) * D_MODEL + 256 * wid + 4 * (lane >> 5);
          const float* bp = wg + (size_t)(256 * wid + 4 * (lane >> 5)) * N_EXP + (lane & 31);
#pragma unroll 4
          for (int c = 0; c < 32; ++c) { const f32x4 a4 = *(const f32x4*)(ap + 8 * c);
#pragma unroll
              for (int q = 0; q < 4; ++q) acc = __builtin_amdgcn_mfma_f32_32x32x2f32(a4[q], bp[(size_t)(8 * c + q) * N_EXP], acc, 0, 0, 0); }
#pragma unroll
          for (int r = 0; r < 16; ++r) part[wid * 1024 + crow(r, lane >> 5) * 32 + (lane & 31)] = acc[r]; }
        __syncthreads();
        int my_e[4]; unsigned my_lr[4]; float my_g[4];
#pragma unroll
        for (int j = 0; j < 4; ++j) { const int tl = 4 * wid + j;
            float v = -3.0e38f;
            if (lane < 32) { float s = 0.f;
#pragma unroll
                for (int w = 0; w < 8; ++w) s += part[w * 1024 + tl * 32 + lane];
                v = s * rsv[tl] + p.b_router[lane]; }
            float tv[4]; int ti[4];
#pragma unroll
            for (int r = 0; r < 4; ++r) {
                float bv = v; int bi = lane;
#pragma unroll
                for (int o = 32; o >= 1; o >>= 1) { const float ov = __shfl_xor(bv, o, 64); const int oi = __shfl_xor(bi, o, 64); if (ov > bv || (ov == bv && oi < bi)) { bv = ov; bi = oi; } }
                tv[r] = bv; ti[r] = bi; if (lane == bi) v = -3.0e38f;
            }
            const float e0 = 1.f, e1 = __expf(tv[1] - tv[0]), e2 = __expf(tv[2] - tv[0]), e3 = __expf(tv[3] - tv[0]); const float inv = 1.f / (e0 + e1 + e2 + e3);
            const float gts[4] = {e0 * inv, e1 * inv, e2 * inv, e3 * inv};
            my_e[j] = ti[lane & 3]; my_g[j] = gts[lane & 3]; my_lr[j] = 0u;
            if (lane < 4) my_lr[j] = __hip_atomic_fetch_add(hist + my_e[j], 1u, __ATOMIC_RELAXED, __HIP_MEMORY_SCOPE_WORKGROUP);
        }
        __syncthreads();
        if (tid < N_EXP) hbase[tid] = atomicAdd(cnt + tid * 16, hist[tid]);
        __syncthreads();
        if (lane < 4) {
#pragma unroll
            for (int j = 0; j < 4; ++j) { const int t = t0 + 4 * wid + j; const int e = my_e[j]; const unsigned rk = hbase[e] + my_lr[j];
                tokl[e * NTOK + rk] = t; sel_e[t * 4 + lane] = e; sel_r[t * 4 + lane] = (int)rk; sel_g[t * 4 + lane] = my_g[j]; }
        }
    }
}

__device__ __forceinline__ void phase_combine(const Params& p, const LAS int* s_roff) {
    const int tid = threadIdx.x, wid = tid >> 6, lane = tid & 63;
    const float* x2 = (const float*)(p.ws + WS_X2); const bf16_t* ys = (const bf16_t*)(p.ws + WS_YS);
    const int* sel_e = (const int*)(p.ws + WS_SEL); const int* sel_r = sel_e + NTOK * 4; const float* sel_g = (const float*)(sel_r + NTOK * 4);
    for (int t = blockIdx.x * 8 + wid; t < NTOK; t += gridDim.x * 8) {
        f32x4 v[8];
#pragma unroll
        for (int i = 0; i < 8; ++i) v[i] = ((const f32x4*)(x2 + (size_t)t * D_MODEL))[lane + 64 * i];
#pragma unroll
        for (int k = 0; k < 4; ++k) { const int e = sel_e[t * 4 + k]; const size_t slot = (size_t)(s_roff[e] + sel_r[t * 4 + k]); const float g = sel_g[t * 4 + k];
            const u32x2* yr = (const u32x2*)(ys + slot * D_MODEL);
#pragma unroll
            for (int i = 0; i < 8; ++i) { const u32x2 w = yr[lane + 64 * i]; v[i][0] += g * bf_lo(w[0]); v[i][1] += g * bf_hi(w[0]); v[i][2] += g * bf_lo(w[1]); v[i][3] += g * bf_hi(w[1]); } }
        float ss = 0.f;
#pragma unroll
        for (int i = 0; i < 8; ++i) ss += v[i][0] * v[i][0] + v[i][1] * v[i][1] + v[i][2] * v[i][2] + v[i][3] * v[i][3];
        ss = wave_sum(ss); const float rs = rsqrtf(ss * (1.f / D_MODEL) + EPS);
#pragma unroll
        for (int i = 0; i < 8; ++i) { const f32x4 g = ((const f32x4*)p.final_norm)[lane + 64 * i];
            ((f32x4*)(p.out + (size_t)t * D_MODEL))[lane + 64 * i] = (f32x4){v[i][0] * rs * g[0], v[i][1] * rs * g[1], v[i][2] * rs * g[2], v[i][3] * rs * g[3]}; }
    }
}

constexpr int NPHASE = 9;
__global__ void __launch_bounds__(512, 2) mega_fwd(Params p) {
    extern __shared__ __attribute__((aligned(1024))) char smem_raw[];
    LAS char* lds = (LAS char*)smem_raw;
    LAS unsigned* misc = (LAS unsigned*)(lds + LDS_MISC);
    const int tid = threadIdx.x;
    if (tid < 4) misc[tid] = 0u;
    __syncthreads();
    unsigned* bar = (unsigned*)(p.ws + WS_CTL + CTL_BAR);
    XcdBarrier xb = xcd_barrier_post(bar, (volatile LAS unsigned*)misc);
    const int lo = p.ph_lo, hi = p.ph_hi;
    const int G = gridDim.x, bid = blockIdx.x;
    const int xperm = (bid & 7) * (G >> 3) + (bid >> 3);
#ifdef PH_ONLY
#define IN(k) ((k)==PH_ONLY)
#else
#define IN(k) (lo <= (k) && (k) < hi)
#endif
#define SEAM(k) do { if (IN(k) && IN((k) + 1)) xcd_barrier(xb); } while (0)
    if (IN(0)) phase_prologue(p);
    SEAM(0);
    if (IN(1)) {
        for (int u = xperm; u < 32 * 8; u += G) {
            const int pn = u / 32, pm = u % 32;
            PEpiProj ep{pn, pm * 256, p.ws, p.b_q_norm, p.b_kv_norm};
            __syncthreads();
            gemm_unit_pg<false>(lds, (const bf16_t*)(p.ws + WS_XN) + (size_t)pm * 256 * D_MODEL, (const bf16_t*)(p.ws + WS_BT_IN) + (size_t)pn * 256 * D_MODEL, D_MODEL, ep);
        }
    }
    SEAM(1);
    if (IN(2)) {
        { const int b0 = bid;
            int qv;
            if ((b0 & 3) == 0) {
                const int h = b0 >> 2, pn = 8 + (h >> 5), pm = h & 31;
                PEpiProj ep{pn, pm * 256, p.ws, p.b_q_norm, p.b_kv_norm};
                __syncthreads();
                gemm_unit_pg<false>(lds, (const bf16_t*)(p.ws + WS_XN) + (size_t)pm * 256 * D_MODEL, (const bf16_t*)(p.ws + WS_BT_IN) + (size_t)pn * 256 * D_MODEL, D_MODEL, ep);
                qv = 128 + h;
            } else {
                const int v = (b0 >> 2) * 3 + (b0 & 3) - 1;
                if (v < 128) {
                    attn_a_unit(p, lds, v); qv = v;
                    pg_convert(p.w_o, D_MODEL, D_MODEL, D_MODEL, 2048, (bf16_t*)(p.ws + WS_BT_WO), v * 1024 + tid, 128 * 1024);
                    pg_convert(p.w_o, D_MODEL, D_MODEL, D_MODEL, 2048, (bf16_t*)(p.ws + WS_BT_WO), v * 1024 + 512 + tid, 128 * 1024);
                } else {
                    const int w = v - 128; qv = -1;
                    attn_a_unit(p, lds, 128 + 2 * w); attn_a_unit(p, lds, 129 + 2 * w);
                    if (w < 32) pg_convert(p.b_w_ukv, 256, 2048, 2048, 2048, (bf16_t*)(p.ws + WS_BT_UKV), w * 512 + tid, 32 * 512);
                }
            }
            if (qv >= 0) { const int pn = qv / 32, pm = qv % 32;
                PEpiQUp ep{pn, pm * 256, p.ws};
                __syncthreads();
                gemm_unit_pg<false>(lds, (const bf16_t*)(p.ws + WS_CQ) + (size_t)pm * 256 * 512, (const bf16_t*)(p.ws + WS_BT_UQ) + (size_t)pn * 256 * 512, 512, ep);
                __syncthreads(); }
        }
        xcd_barrier(xb);
        for (int u = xperm; u < 32 * 8; u += G) {
            const int pn = u / 32, pm = u % 32;
            PEpiKvUp ep{pn, pm * 256, p.ws};
            __syncthreads();
            gemm_unit_pg<false>(lds, (const bf16_t*)(p.ws + WS_CKV) + (size_t)pm * 256 * 256, (const bf16_t*)(p.ws + WS_BT_UKV) + (size_t)pn * 256 * 256, 256, ep);
        }
    }
    SEAM(2);
    if (IN(3)) { for (int u = xperm; u < 256; u += G) mla_unit(p, lds, u); }
    SEAM(3);
    if (IN(4)) {
        __syncthreads();
        for (int u = xperm; u < 32 * 8; u += G) {
            const int pn = u / 32, pm = u % 32;
            LAS float* tab = (LAS float*)(lds + 2 * G_STAGE_B);
            __syncthreads();
            if (tid < 256) { const f32x4* pp = (const f32x4*)((const float*)(p.ws + WS_SSQP) + (size_t)(pm * 256 + tid) * 24); float sa = 0.f, sb2 = 0.f;
#pragma unroll
                for (int q = 0; q < 4; ++q) { const f32x4 v = pp[q]; sa += (v[0] + v[1]) + (v[2] + v[3]); }
#pragma unroll
                for (int q = 4; q < 6; ++q) { const f32x4 v = pp[q]; sb2 += (v[0] + v[1]) + (v[2] + v[3]); }
                tab[tid] = sa * (1.f / 1024.f); tab[256 + tid] = sb2 * (1.f / 1024.f); }
            __syncthreads();
            PEpiWo ep{pn, pm * 256, p.ws, p.x, tab};
            gemm_unit_pg<true>(lds, (const bf16_t*)(p.ws + WS_Y) + (size_t)pm * 256 * D_MODEL, (const bf16_t*)(p.ws + WS_BT_WO) + (size_t)pn * 256 * D_MODEL, D_MODEL, ep);
        }
    }
    SEAM(4);
    if (IN(5)) phase_router(p, lds);
    SEAM(5);
    LAS int* s_cnt = (LAS int*)(misc + 16); LAS int* s_toff = (LAS int*)(misc + 48); LAS int* s_roff = (LAS int*)(misc + 96);
    if (IN(6) || IN(7) || IN(8)) {
        if (tid == 0) { const unsigned* cnt = (const unsigned*)(p.ws + WS_CTL + CTL_CNT); int to = 0;
            for (int e = 0; e < N_EXP; ++e) { const int c = (int)xb_ld((unsigned*)cnt + e * 16); s_cnt[e] = c; s_toff[e] = to; s_roff[e] = to * 256; to += (c + 255) >> 8; }
            s_toff[N_EXP] = to; }
        __syncthreads();
    }
    if (IN(6)) {
        const int TM = s_toff[N_EXP];
#ifdef PROBE_P6
        for (int rep = 0; rep < 2; ++rep)
#endif
        for (int L = xperm; L < TM * 16; L += G) {
            int e = 0; while (s_toff[e + 1] * 16 <= L) ++e;
            const int w = L - s_toff[e] * 16, nte = s_toff[e + 1] - s_toff[e], ntile = w / nte, mt = w - ntile * nte, cntE = s_cnt[e];
            AGather8 af{p.ws + WS_XN, (const int*)(p.ws + WS_TOKL) + (size_t)e * NTOK, mt * 256, cntE};
            BGateUp bf{p.w_up + (size_t)e * D_MODEL * (2 * D_FF) + ntile * 128, (size_t)(2 * D_FF)};
            EpiUp8 ep{ntile * 128, mt * 256, cntE, p.ws + WS_ACT + ((size_t)s_roff[e] + mt * 256) * D_FF, p.b_up + (size_t)e * (2 * D_FF)};
            gemm_unit8<0x7B7B7B7B>(lds, (LAS unsigned*)(misc + 8), D_MODEL / 64, af, bf, ep);
        }
    }
    SEAM(6);
    if (IN(7)) {
        const int TM = s_toff[N_EXP];
#ifdef PROBE_P7
        for (int rep = 0; rep < 2; ++rep)
#endif
        for (int L = xperm; L < TM * 8; L += G) {
            int e = 0; while (s_toff[e + 1] * 8 <= L) ++e;
            const int w = L - s_toff[e] * 8, nte = s_toff[e + 1] - s_toff[e], ntile = w / nte, mt = w - ntile * nte, cntE = s_cnt[e];
            ARows8 af{p.ws + WS_ACT + ((size_t)s_roff[e] + mt * 256) * D_FF, (unsigned)D_FF};
            BPlain bf{p.w_down + (size_t)e * D_FF * D_MODEL + ntile * 256, (size_t)D_MODEL, 256};
            EpiDown8 ep{ntile * 256, mt * 256, cntE, (bf16_t*)(p.ws + WS_YS) + ((size_t)s_roff[e] + mt * 256) * D_MODEL, p.b_down + (size_t)e * D_MODEL};
            gemm_unit8<0x7D7D7D7D>(lds, (LAS unsigned*)(misc + 8), D_FF / 64, af, bf, ep);
        }
    }
    SEAM(7);
    if (IN(8)) phase_combine(p, s_roff);
}

extern "C" void kernel_launch(void* const* d_in, const int* in_sizes, int n_in, void* d_out, int out_size, void* d_ws, size_t ws_size, hipStream_t stream) {
    static int ready = 0;
    if (!ready) {
        if (hipFuncSetAttribute((const void*)mega_fwd, hipFuncAttributeMaxDynamicSharedMemorySize, LDS_BYTES) != hipSuccess) { fprintf(stderr, "kernel_launch: hipFuncSetAttribute failed\n"); return; }
        int per_cu = 0; hipOccupancyMaxActiveBlocksPerMultiprocessor(&per_cu, (const void*)mega_fwd, 512, LDS_BYTES);
        if (per_cu < 1) { fprintf(stderr, "kernel_launch: occupancy query says 0 blocks per CU\n"); return; }
        ready = 1;
    }
    if (ws_size < WS_END) { fprintf(stderr, "kernel_launch: workspace too small\n"); return; }
    hipMemsetAsync((unsigned char*)d_ws + WS_CTL, 0, CTL_BYTES, stream);
    Params p{};
    const float** f = (const float**)&p;
    for (int i = 0; i < 19; ++i) f[i] = (const float*)d_in[i];
    p.out = (float*)d_out; p.ws = (unsigned char*)d_ws; p.ph_lo = 0; p.ph_hi = NPHASE;
    hipLaunchKernelGGL(mega_fwd, dim3(256), dim3(512), LDS_BYTES, stream, p);
}
```

```cpp
#include <hip/hip_runtime.h>
#include <stdint.h>
#include <stdio.h>

#define LAS __attribute__((address_space(3)))
typedef unsigned short bf16_t;
typedef short bf16x8 __attribute__((ext_vector_type(8)));
typedef short s16x4 __attribute__((ext_vector_type(4)));
typedef short v4i16_t __attribute__((ext_vector_type(4)));
typedef float f32x2 __attribute__((ext_vector_type(2)));
typedef float f32x4 __attribute__((ext_vector_type(4)));
typedef float f32x16 __attribute__((ext_vector_type(16)));
typedef int i32x4 __attribute__((ext_vector_type(4)));
typedef unsigned u32x2 __attribute__((ext_vector_type(2)));
typedef unsigned u32x4 __attribute__((ext_vector_type(4)));
typedef __bf16 bf16x2_t __attribute__((ext_vector_type(2)));
typedef int v8i __attribute__((ext_vector_type(8)));
typedef int v2i __attribute__((ext_vector_type(2)));
typedef short v2s __attribute__((ext_vector_type(2)));

constexpr int D_MODEL = 2048, SEQ = 4096, BATCH = 2, NTOK = BATCH * SEQ;
constexpr int IN_COLS = 2368;
constexpr int N_EXP = 32, TOP_K = 4, D_FF = 2048;
constexpr float EPS = 1e-5f;
constexpr float LOG2E = 1.4426950408889634f;

constexpr size_t MiB = 1u << 20;
constexpr size_t WS_CTL = 0, CTL_BYTES = 1 * MiB;
constexpr size_t WS_XN = 1 * MiB, WS_QA = 33 * MiB, WS_KA = 49 * MiB, WS_VA = 53 * MiB, WS_CQ = 57 * MiB, WS_CKV = 65 * MiB, WS_KPE = 69 * MiB;
constexpr size_t WS_QB = 70 * MiB, WS_KVB = 94 * MiB, WS_Y = 126 * MiB, WS_X2 = 158 * MiB, WS_ROPE = 222 * MiB, WS_WRT = 223 * MiB;
constexpr size_t WS_TOKL = 224 * MiB, WS_SEL = 225 * MiB, WS_ACT = 226 * MiB, WS_YS = 386 * MiB, WS_BT_IN = 546 * MiB, WS_BT_UQ = 558 * MiB, WS_BT_UKV = 560 * MiB, WS_BT_WO = 562 * MiB, WS_SSQ2 = 570 * MiB, WS_END = 571 * MiB;
constexpr size_t WS_SSQP = WS_WRT + 262144;
constexpr size_t WS_SSQC = WS_SSQ2;
constexpr size_t WS_SSQK = WS_SSQ2 + 524288;
constexpr size_t CTL_BAR = 0, CTL_CNT = 16384, CTL_SSQ_CQ = 65536, CTL_SSQ_CKV = 98304, CTL_SSQ_A = 131072, CTL_SSQ_B = 163840, CTL_SSQ_X2 = 196608;

__device__ __forceinline__ unsigned pk_bf16(float lo, float hi) { f32x2 v = {lo, hi}; bf16x2_t b = __builtin_convertvector(v, bf16x2_t); return __builtin_bit_cast(unsigned, b); }
__device__ __forceinline__ unsigned pk4_fp8(float a, float b, float c, float d) { int w = __builtin_amdgcn_cvt_pk_fp8_f32(a, b, 0, false); w = __builtin_amdgcn_cvt_pk_fp8_f32(c, d, w, true); return (unsigned)w; }
__device__ __forceinline__ unsigned pk4_fp8_x64(f32x4 v) { v2s r; asm("" : "=v"(r));
    r = __builtin_amdgcn_cvt_scalef32_pk_fp8_f32(r, v[0], v[1], 0.015625f, false); r = __builtin_amdgcn_cvt_scalef32_pk_fp8_f32(r, v[2], v[3], 0.015625f, true); return __builtin_bit_cast(unsigned, r); }
__device__ __forceinline__ float bf_lo(unsigned u) { return __uint_as_float(u << 16); }
__device__ __forceinline__ float bf_hi(unsigned u) { return __uint_as_float(u & 0xffff0000u); }
__device__ __forceinline__ float wave_sum(float v) {
#pragma unroll
    for (int o = 32; o >= 1; o >>= 1) v += __shfl_xor(v, o, 64);
    return v;
}
__device__ __forceinline__ int crow(int r, int hi) { return (r & 3) + 8 * (r >> 2) + 4 * hi; }
__device__ __forceinline__ s16x4 vtr(const LAS char* p) { return __builtin_bit_cast(s16x4, __builtin_amdgcn_ds_read_tr16_b64_v4i16((LAS v4i16_t*)p)); }
#define SBAR() __builtin_amdgcn_sched_barrier(0)

#define XB_TMO      128
#define XB_XCNT(j)  (256  + 64 * (j))
#define XB_XSUB(j)  (1280 + 64 * (j))
#define XB_XGEN(j)  (2304 + 64 * (j))
#define XB_TOP      3328
#define XB_TOPGEN   3392
#define XCD_BAR_WORDS 3456
#define XB_SPIN_CAP (1u << 18)
__device__ __forceinline__ unsigned xb_ld(unsigned* p)              { return __hip_atomic_load(p, __ATOMIC_RELAXED, __HIP_MEMORY_SCOPE_AGENT); }
__device__ __forceinline__ unsigned xb_add(unsigned* p, unsigned v) { return __hip_atomic_fetch_add(p, v, __ATOMIC_RELAXED, __HIP_MEMORY_SCOPE_AGENT); }
__device__ __forceinline__ unsigned xb_xcc_id() { return (unsigned)__builtin_amdgcn_s_getreg((3 << 11) | 20) & 0xFu; }
#define XB_SPIN(cond, bar) do { unsigned _sp = 0; while (cond) { __builtin_amdgcn_s_sleep(1); \
    if ((++_sp & 255u) == 0u) { if (xb_ld(&(bar)[XB_TMO])) break; if (_sp > XB_SPIN_CAP) { atomicAdd(&(bar)[XB_TMO], 1u); break; } } } } while (0)
struct XcdBarrier { unsigned* bar; unsigned x; volatile LAS unsigned* st; };
__device__ __forceinline__ XcdBarrier xcd_barrier_post(unsigned* bar, volatile LAS unsigned* st) {
    XcdBarrier b; b.bar = bar; b.x = xb_xcc_id(); b.st = st;
    if (threadIdx.x == 0) (void)xb_add(&bar[XB_XCNT(b.x)], 1u);
    return b;
}
__device__ __forceinline__ void xcd_barrier_complete(unsigned* bar, unsigned x, unsigned& nloc, unsigned& nx) {
    const unsigned G = gridDim.x * gridDim.y * gridDim.z;
    unsigned sum, cnt, mine, sp = 0u;
    for (;;) {
        sum = 0u; cnt = 0u; mine = 0u;
#pragma unroll
        for (unsigned j = 0; j < 16; ++j) { const unsigned c = xb_ld(&bar[XB_XCNT(j)]); sum += c; cnt += (c > 0u) ? 1u : 0u; mine = (j == x) ? c : mine; }
        if (sum == G) break;
        __builtin_amdgcn_s_sleep(1);
        if ((++sp & 255u) == 0u) { if (xb_ld(&bar[XB_TMO])) break; if (sp > XB_SPIN_CAP) { atomicAdd(&bar[XB_TMO], 1u); break; } }
    }
    nloc = mine > 0u ? mine : 1u; nx = cnt > 0u ? cnt : 1u;
}
__device__ __forceinline__ void xcd_barrier(const XcdBarrier& b) {
    asm volatile("s_waitcnt vmcnt(0)" ::: "memory");
    __syncthreads();
    if (threadIdx.x == 0) {
        unsigned* bar = b.bar;
        __builtin_amdgcn_s_waitcnt(0);
        unsigned nloc = b.st[0], nx = b.st[1];
        if (nloc == 0u) { xcd_barrier_complete(bar, b.x, nloc, nx); b.st[0] = nloc; b.st[1] = nx; }
        const unsigned old = xb_add(&bar[XB_XSUB(b.x)], 1u);
        const unsigned gen = old / nloc;
        if (old + 1u == (gen + 1u) * nloc) {
            __builtin_amdgcn_fence(__ATOMIC_RELEASE, "agent");
            asm volatile("s_waitcnt vmcnt(0)" ::: "memory");
            const unsigned og = xb_add(&bar[XB_TOP], 1u);
            const unsigned tg = og / nx;
            if (og + 1u == (tg + 1u) * nx) xb_add(&bar[XB_TOPGEN], 1u);
            else XB_SPIN(xb_ld(&bar[XB_TOPGEN]) == tg, bar);
            __builtin_amdgcn_fence(__ATOMIC_ACQUIRE, "agent");
            xb_add(&bar[XB_XGEN(b.x)], 1u);
            asm volatile("s_waitcnt vmcnt(0)" ::: "memory");
        } else {
            XB_SPIN(xb_ld(&bar[XB_XGEN(b.x)]) == gen, bar);
            __builtin_amdgcn_fence(__ATOMIC_ACQUIRE, "agent");
            asm volatile("s_waitcnt vmcnt(0)" ::: "memory");
        }
    }
    __syncthreads();
}

constexpr int A_TILE_B = 256 * 64 * 2;
constexpr int B_PITCH = 544;
constexpr int B_TILE_B = 64 * B_PITCH;
constexpr int G_STAGE_B = A_TILE_B + B_TILE_B;
constexpr int LDS_MISC = 155648;
constexpr int LDS_BYTES = LDS_MISC + 1024;

__device__ __forceinline__ int a_img_byte(int r, int chunk) { return r * 128 + ((chunk ^ ((r >> 1) & 7)) << 4); }
#define WAIT_L0() asm volatile("s_waitcnt lgkmcnt(0)" ::: "memory")
__device__ __forceinline__ void glds16(const void* gsrc, unsigned lds_dst) { unsigned keep;
    asm volatile("s_mov_b32 %0, m0\n\ts_mov_b32 m0, %2\n\ts_nop 0\n\tglobal_load_lds_dwordx4 %1, off\n\ts_mov_b32 m0, %0" : "=&s"(keep) : "v"(gsrc), "s"(lds_dst) : "memory"); }
#define RAW_BARRIER() do { WAIT_L0(); __builtin_amdgcn_s_barrier(); } while (0)

__device__ __forceinline__ const char* uniform_ptr(const void* p) {
    const unsigned long long v = (unsigned long long)p;
    const unsigned lo = __builtin_amdgcn_readfirstlane((unsigned)v), hi = __builtin_amdgcn_readfirstlane((unsigned)(v >> 32));
    return (const char*)(((unsigned long long)hi << 32) | lo);
}
__device__ __forceinline__ void glds16s(const char* sbase, unsigned voff, unsigned lds_dst) { unsigned keep;
    asm volatile("s_mov_b32 %0, m0\n\ts_mov_b32 m0, %3\n\ts_nop 4\n\tglobal_load_lds_dwordx4 %1, %2\n\ts_mov_b32 m0, %0" : "=&s"(keep) : "v"(voff), "s"(sbase), "s"(lds_dst) : "memory"); }
#define WAIT_V4(n, a, b, c, d) asm volatile("s_waitcnt vmcnt(" #n ")" : "+v"(a), "+v"(b), "+v"(c), "+v"(d) :: "memory")
template <bool MID, class AF, class BF, class EPI>
__device__ __forceinline__ void gemm_unit(LAS char* lds, const int nt, const AF& af, const BF& bf, EPI& epi) {
    const int tid = threadIdx.x, wid = __builtin_amdgcn_readfirstlane(tid >> 6), lane = tid & 63, wr = wid >> 2, wc = wid & 3, fr = lane & 15, fq = lane >> 4;
    const char* abase = uniform_ptr(af.base);
    unsigned aoff[4];
#pragma unroll
    for (int i = 0; i < 4; ++i) { const int R = wid * 8 + i * 64 + (lane >> 3), C = ((lane & 7) ^ ((R >> 1) & 7)) * 8; aoff[i] = (af.rowoff(R) + (unsigned)C) * 2u; }
    const int a_ldsw = wid * 1024;
    const unsigned lds_u = (unsigned)__builtin_amdgcn_readfirstlane((int)(unsigned)(size_t)lds);
    const size_t ldb4 = (size_t)bf.ld * 4;
    const char* bbase = uniform_ptr(bf.base) + (size_t)wid * ldb4;
    const unsigned boff = bf.coloff(4 * lane) * 4u;
    const int b_lds0 = A_TILE_B + wid * B_PITCH + 8 * lane, b_lds1 = A_TILE_B + wid * B_PITCH + ((8 * lane) ^ 128);
    const int a_rd0 = a_img_byte(wr * 128 + fr, fq), a_rd1 = a_rd0 ^ 64;
    const int b_rd = A_TILE_B + (8 * fq + ((lane & 15) >> 2)) * B_PITCH + ((wc ^ (fq & 1)) << 7) + 8 * (lane & 3);
    f32x4 acc[8][4];
#pragma unroll
    for (int m = 0; m < 8; ++m)
#pragma unroll
        for (int n = 0; n < 4; ++n) acc[m][n] = (f32x4){0.f, 0.f, 0.f, 0.f};
    f32x4 sb[8];
#define G_STAGE_A(i, kt, buf) glds16s(abase + (size_t)(kt) * 128, aoff[i], lds_u + (unsigned)((buf) * G_STAGE_B + a_ldsw + (i) * 8192))
#define G_ISSUE_B(i, kt) asm volatile("s_nop 4\n\tglobal_load_dwordx4 %0, %1, %2" : "=v"(sb[i]) : "v"(boff), "s"(bbase + ((size_t)(kt) * 64 + (i) * 8) * ldb4) : "memory")
#define G_WRITE_B(i, buf) do { u32x2 w_ = {pk_bf16(sb[i][0], sb[i][1]), pk_bf16(sb[i][2], sb[i][3])}; \
        *(LAS u32x2*)(lds + (buf) * G_STAGE_B + (((i) & 1) ? b_lds1 : b_lds0) + (i) * 8 * B_PITCH) = w_; } while (0)
#define G_KSTEP(buf, ks) do { bf16x8 At[8], Bf[4]; \
        _Pragma("unroll") for (int n = 0; n < 4; ++n) { const s16x4 lo_ = vtr(lds + (buf) * G_STAGE_B + b_rd + (ks) * 32 * B_PITCH + n * 32), hi_ = vtr(lds + (buf) * G_STAGE_B + b_rd + (ks) * 32 * B_PITCH + 4 * B_PITCH + n * 32); \
            Bf[n] = (bf16x8){lo_[0], lo_[1], lo_[2], lo_[3], hi_[0], hi_[1], hi_[2], hi_[3]}; } \
        _Pragma("unroll") for (int m = 0; m < 8; ++m) At[m] = *(const LAS bf16x8*)(lds + (buf) * G_STAGE_B + ((ks) ? a_rd1 : a_rd0) + m * 2048); \
        SBAR(); __builtin_amdgcn_s_setprio(1); \
        _Pragma("unroll") for (int m = 0; m < 8; ++m) _Pragma("unroll") for (int n = 0; n < 4; ++n) \
            acc[m][n] = __builtin_amdgcn_mfma_f32_16x16x32_bf16(Bf[n], At[m], acc[m][n], 0, 0, 0); \
        __builtin_amdgcn_s_setprio(0); SBAR(); } while (0)
#pragma unroll
    for (int i = 0; i < 4; ++i) G_STAGE_A(i, 0, 0);
#pragma unroll
    for (int i = 0; i < 8; ++i) G_ISSUE_B(i, 0);
    WAIT_V4(0, sb[0], sb[1], sb[2], sb[3]); WAIT_V4(0, sb[4], sb[5], sb[6], sb[7]);
#pragma unroll
    for (int i = 0; i < 8; ++i) G_WRITE_B(i, 0);
    SBAR();
#pragma unroll
    for (int i = 0; i < 8; ++i) G_ISSUE_B(i, 1);
    SBAR();
    RAW_BARRIER();
#pragma unroll 1
    for (int t = 0; t < nt; ++t) {
        const int cur = t & 1, nxt = cur ^ 1;
        if constexpr (MID) { if (t == (nt >> 1)) epi.mid(acc, wr, wc, fr, fq); }
        const int k1 = (t + 1 < nt) ? t + 1 : nt - 1, k2 = (t + 2 < nt) ? t + 2 : nt - 1;
        G_STAGE_A(0, k1, nxt); G_STAGE_A(1, k1, nxt); G_STAGE_A(2, k1, nxt); G_STAGE_A(3, k1, nxt);
        G_KSTEP(cur, 0);
        WAIT_V4(8, sb[0], sb[1], sb[2], sb[3]);
        G_WRITE_B(0, nxt); G_WRITE_B(1, nxt); G_WRITE_B(2, nxt); G_WRITE_B(3, nxt); SBAR();
        G_ISSUE_B(0, k2); G_ISSUE_B(1, k2); G_ISSUE_B(2, k2); G_ISSUE_B(3, k2); SBAR();
        G_KSTEP(cur, 1);
        WAIT_V4(8, sb[4], sb[5], sb[6], sb[7]);
        G_WRITE_B(4, nxt); G_WRITE_B(5, nxt); G_WRITE_B(6, nxt); G_WRITE_B(7, nxt); SBAR();
        G_ISSUE_B(4, k2); G_ISSUE_B(5, k2); G_ISSUE_B(6, k2); G_ISSUE_B(7, k2); SBAR();
        asm volatile("s_waitcnt vmcnt(8)" ::: "memory");
        RAW_BARRIER();
    }
    WAIT_V4(0, sb[0], sb[1], sb[2], sb[3]); WAIT_V4(0, sb[4], sb[5], sb[6], sb[7]);
    epi.fin(acc, wr, wc, fr, fq);
#undef G_STAGE_A
#undef G_ISSUE_B
#undef G_WRITE_B
#undef G_KSTEP
}

constexpr int A8_TILE_B = 16384, B8_PITCH = 288, B8_TILE_B = 64 * B8_PITCH;
constexpr int A8_RING = 5, B8_RING = 4, B8_OFF = A8_RING * A8_TILE_B;
static_assert(B8_OFF + B8_RING * B8_TILE_B <= LDS_MISC, "fp8 rings fit below the misc words");
__device__ __forceinline__ v2i vtr8(const LAS char* p) { return __builtin_amdgcn_ds_read_tr8_b64_v2i32((LAS v2i*)p); }
template <int SCALE_X, class AF, class BF, class EPI>
__device__ __forceinline__ void gemm_unit8(LAS char* lds, LAS unsigned* ring_cnt, const int nt, const AF& af, const BF& bf, EPI& epi) {
    const int tid = threadIdx.x, wid = __builtin_amdgcn_readfirstlane(tid >> 6), lane = tid & 63, wr = wid >> 2, wc = wid & 3, r32 = lane & 31, hi = lane >> 5;
    const char* abase = uniform_ptr(af.base);
    unsigned aoff[2];
#pragma unroll
    for (int i = 0; i < 2; ++i) { const int R = wid * 16 + i * 128 + (lane >> 2), C = ((lane & 3) ^ ((lane >> 4) & 3)) * 16; aoff[i] = af.rowoff(R) + (unsigned)C; }
    const unsigned lds_u = (unsigned)__builtin_amdgcn_readfirstlane((int)(unsigned)(size_t)lds) + (unsigned)(wid * 1024);
    const size_t ldb4 = (size_t)bf.ld * 4;
    const char* bbase = uniform_ptr(bf.base) + (size_t)wid * ldb4;
    const unsigned boff = bf.coloff(4 * lane) * 4u;
    const int b_wr = B8_OFF + wid * B8_PITCH + 4 * lane;
    const int a_rd0 = (wr * 128 + r32) * 64 + (((2 * hi) ^ ((r32 >> 2) & 3)) << 4), a_rd1 = a_rd0 ^ 16;
    const int b_rd = B8_OFF + (32 * hi + ((lane & 15) >> 1)) * B8_PITCH + wc * 64 + 16 * ((lane >> 4) & 1) + 8 * (lane & 1);
    f32x16 acc[4][2];
#pragma unroll
    for (int m = 0; m < 4; ++m)
#pragma unroll
        for (int n = 0; n < 2; ++n)
#pragma unroll
            for (int r = 0; r < 16; ++r) acc[m][n][r] = 0.f;
    f32x4 sb[8];
#define H_STAGE_A(i, kt, slot) glds16s(abase + (size_t)(kt) * 64, aoff[i], lds_u + (unsigned)((slot) * A8_TILE_B + (i) * 8192))
#define H_ISSUE_B(i, kt) asm volatile("s_nop 4\n\tglobal_load_dwordx4 %0, %1, %2" : "=v"(sb[i]) : "v"(boff), "s"(bbase + ((size_t)(kt) * 64 + (i) * 8) * ldb4) : "memory")
#define H_WRITE_B(i, slot) *(LAS unsigned*)(lds + (slot) * B8_TILE_B + b_wr + (i) * 8 * B8_PITCH) = pk4_fp8_x64(sb[i])
#define H_KSTEP(sa, sbk) do { v8i Xf[4], Wf[2]; \
        _Pragma("unroll") for (int n = 0; n < 2; ++n) _Pragma("unroll") for (int r = 0; r < 4; ++r) { const v2i t_ = vtr8(lds + (sbk) * B8_TILE_B + b_rd + r * 8 * B8_PITCH + n * 32); Wf[n][2 * r] = t_[0]; Wf[n][2 * r + 1] = t_[1]; } \
        _Pragma("unroll") for (int m = 0; m < 4; ++m) { const i32x4 lo_ = *(const LAS i32x4*)(lds + (sa) * A8_TILE_B + a_rd0 + m * 2048), hi_ = *(const LAS i32x4*)(lds + (sa) * A8_TILE_B + a_rd1 + m * 2048); \
            Xf[m] = (v8i){lo_[0], lo_[1], lo_[2], lo_[3], hi_[0], hi_[1], hi_[2], hi_[3]}; } \
        SBAR(); __builtin_amdgcn_s_setprio(1); \
        _Pragma("unroll") for (int m = 0; m < 4; ++m) _Pragma("unroll") for (int n = 0; n < 2; ++n) \
            acc[m][n] = __builtin_amdgcn_mfma_scale_f32_32x32x64_f8f6f4(Wf[n], Xf[m], acc[m][n], 0, 0, 0, 0x79797979, 0, SCALE_X); \
        __builtin_amdgcn_s_setprio(0); SBAR(); } while (0)
    if (tid < 8) ring_cnt[tid] = 0u;
    H_STAGE_A(0, 0, 0); H_STAGE_A(1, 0, 0); H_STAGE_A(0, 1, 1); H_STAGE_A(1, 1, 1);
#pragma unroll
    for (int i = 0; i < 8; ++i) H_ISSUE_B(i, 0);
    WAIT_V4(0, sb[0], sb[1], sb[2], sb[3]); WAIT_V4(0, sb[4], sb[5], sb[6], sb[7]);
#pragma unroll
    for (int i = 0; i < 8; ++i) H_WRITE_B(i, 0);
    SBAR();
#pragma unroll
    for (int i = 0; i < 8; ++i) H_ISSUE_B(i, 1);
    WAIT_V4(0, sb[0], sb[1], sb[2], sb[3]); WAIT_V4(0, sb[4], sb[5], sb[6], sb[7]);
#pragma unroll
    for (int i = 0; i < 8; ++i) H_WRITE_B(i, 1);
    SBAR();
    H_STAGE_A(0, 2, 2); H_STAGE_A(1, 2, 2);
#pragma unroll
    for (int i = 0; i < 8; ++i) H_ISSUE_B(i, 2);
    SBAR();
    RAW_BARRIER();
    int sa_r = 0, sa_w = 3, sb_r = 0, sb_w = 2;
#pragma unroll 1
    for (int t = 0; t < nt; ++t) {
        if (t >= 2) {
            const unsigned need = (unsigned)(t - 1);
            for (;;) { asm volatile("" ::: "memory"); const unsigned v = *(volatile LAS unsigned*)(ring_cnt + (lane & 7)); if (__all(v >= need)) break; __builtin_amdgcn_s_sleep(1); }
            asm volatile("" ::: "memory");
        }
        const int k3 = (t + 3 < nt) ? t + 3 : nt - 1;
        H_STAGE_A(0, k3, sa_w); H_STAGE_A(1, k3, sa_w);
        H_KSTEP(sa_r, sb_r);
        WAIT_V4(6, sb[0], sb[1], sb[2], sb[3]);
        H_WRITE_B(0, sb_w); H_WRITE_B(1, sb_w); H_WRITE_B(2, sb_w); H_WRITE_B(3, sb_w); SBAR();
        H_ISSUE_B(0, k3); H_ISSUE_B(1, k3); H_ISSUE_B(2, k3); H_ISSUE_B(3, k3); SBAR();
        WAIT_V4(6, sb[4], sb[5], sb[6], sb[7]);
        H_WRITE_B(4, sb_w); H_WRITE_B(5, sb_w); H_WRITE_B(6, sb_w); H_WRITE_B(7, sb_w); SBAR();
        H_ISSUE_B(4, k3); H_ISSUE_B(5, k3); H_ISSUE_B(6, k3); H_ISSUE_B(7, k3); SBAR();
        asm volatile("" ::: "memory");
        if (lane == 0) *(volatile LAS unsigned*)(ring_cnt + wid) = (unsigned)(t + 1);
        asm volatile("" ::: "memory");
        sa_r = (sa_r == A8_RING - 1) ? 0 : sa_r + 1; sa_w = (sa_w == A8_RING - 1) ? 0 : sa_w + 1;
        sb_r = (sb_r == B8_RING - 1) ? 0 : sb_r + 1; sb_w = (sb_w == B8_RING - 1) ? 0 : sb_w + 1;
    }
    WAIT_V4(0, sb[0], sb[1], sb[2], sb[3]); WAIT_V4(0, sb[4], sb[5], sb[6], sb[7]);
    RAW_BARRIER();
    epi.fin(acc, wr, wc, r32, hi);
#undef H_STAGE_A
#undef H_ISSUE_B
#undef H_WRITE_B
#undef H_KSTEP
}

struct Params {
    const float *x, *attn_norm, *w_in, *a_sink, *b_q_norm, *b_w_uq, *b_kv_norm, *b_w_ukv, *out_norm_a, *out_norm_b, *w_o, *mlp_norm, *w_router, *b_router,
        *w_up, *b_up, *w_down, *b_down, *final_norm;
    float* out; unsigned char* ws; int ph_lo, ph_hi;
};

struct ARows { const bf16_t* base; unsigned ld; __device__ __forceinline__ unsigned rowoff(int r) const { return (unsigned)r * ld; } };
struct AGather { const bf16_t* base; const int* tokl; int r0, cnt; __device__ __forceinline__ unsigned rowoff(int r) const { int rk = r0 + r; rk = rk < cnt ? rk : 0; return (unsigned)tokl[rk] * (unsigned)D_MODEL; } };
struct ARows8 { const unsigned char* base; unsigned ld; __device__ __forceinline__ unsigned rowoff(int r) const { return (unsigned)r * ld; } };
struct AGather8 { const unsigned char* base; const int* tokl; int r0, cnt; __device__ __forceinline__ unsigned rowoff(int r) const { int rk = r0 + r; rk = rk < cnt ? rk : 0; return (unsigned)tokl[rk] * (unsigned)D_MODEL; } };
struct BPlain { const float* base; size_t ld; int ncols;
    __device__ __forceinline__ unsigned coloff(int c) const { return (unsigned)(c < ncols ? c : (c & (ncols - 1))); } };
struct BGateUp { const float* base; size_t ld;
    __device__ __forceinline__ unsigned coloff(int c) const { const int wc = c >> 6, w = c & 63; return (unsigned)(wc * 32 + (w & 31) + ((w & 32) ? D_FF : 0)); } };

struct EpiProj {
    int pn, brow; unsigned char* ws; const float *qg, *kvg;
    __device__ __forceinline__ void mid(f32x4 (&)[8][4], int, int, int, int) {}
    __device__ __forceinline__ void fin(f32x4 (&acc)[8][4], int wr, int wc, int fr, int fq) {
        if (pn < 6) {
            bf16_t* dst; int ldd, c0;
            if (pn < 4) { dst = (bf16_t*)(ws + WS_QA); ldd = 1024; c0 = pn * 256; } else if (pn == 4) { dst = (bf16_t*)(ws + WS_KA); ldd = 256; c0 = 0; } else { dst = (bf16_t*)(ws + WS_VA); ldd = 256; c0 = 0; }
#pragma unroll
            for (int m = 0; m < 8; ++m) { const int row = brow + wr * 128 + m * 16 + fr;
#pragma unroll
                for (int n = 0; n < 4; ++n) { const int col = c0 + wc * 64 + n * 16 + fq * 4; const f32x4 v = acc[m][n];
                    *(u32x2*)(dst + (size_t)row * ldd + col) = (u32x2){pk_bf16(v[0], v[1]), pk_bf16(v[2], v[3])}; } }
        } else if (pn < 9) {
            bf16_t* dst; int ldd, c0; const float* g; float* ssq; int nsl, sl;
            if (pn < 8) { dst = (bf16_t*)(ws + WS_CQ); ldd = 512; c0 = (pn - 6) * 256; g = qg; ssq = (float*)(ws + WS_SSQC); nsl = 8; sl = (pn - 6) * 4 + wc; }
            else { dst = (bf16_t*)(ws + WS_CKV); ldd = 256; c0 = 0; g = kvg; ssq = (float*)(ws + WS_SSQK); nsl = 4; sl = wc; }
            f32x4 gvv[4];
#pragma unroll
            for (int n = 0; n < 4; ++n) gvv[n] = *(const f32x4*)(g + c0 + wc * 64 + n * 16 + fq * 4);
#pragma unroll
            for (int m = 0; m < 8; ++m) { const int row = brow + wr * 128 + m * 16 + fr; float ss = 0.f;
#pragma unroll
                for (int n = 0; n < 4; ++n) { const int col = c0 + wc * 64 + n * 16 + fq * 4; const f32x4 v = acc[m][n]; const f32x4 gv = gvv[n];
                    ss += v[0] * v[0] + v[1] * v[1] + v[2] * v[2] + v[3] * v[3];
                    *(u32x2*)(dst + (size_t)row * ldd + col) = (u32x2){pk_bf16(v[0] * gv[0], v[1] * gv[1]), pk_bf16(v[2] * gv[2], v[3] * gv[3])}; }
                ss += __shfl_xor(ss, 16, 64); ss += __shfl_xor(ss, 32, 64);
                if (fq == 0) ssq[(size_t)row * nsl + sl] = ss; }
        } else {
            if (wc == 0) {
                bf16_t* dst = (bf16_t*)(ws + WS_KPE); const float* rope = (const float*)(ws + WS_ROPE);
#pragma unroll
                for (int m = 0; m < 8; ++m) { const int row = brow + wr * 128 + m * 16 + fr; const int pos = row & (SEQ - 1);
#pragma unroll
                    for (int n = 0; n < 2; ++n) { const int i0 = n * 16 + fq * 4; const f32x4 x1 = acc[m][n], x2 = acc[m][n + 2];
                        const f32x4 cs0 = *(const f32x4*)(rope + ((size_t)pos * 32 + i0) * 2), cs1 = *(const f32x4*)(rope + ((size_t)pos * 32 + i0) * 2 + 4);
                        const float c[4] = {cs0[0], cs0[2], cs1[0], cs1[2]}, s[4] = {cs0[1], cs0[3], cs1[1], cs1[3]};
                        float o1[4], o2[4];
#pragma unroll
                        for (int j = 0; j < 4; ++j) { o1[j] = x1[j] * c[j] - x2[j] * s[j]; o2[j] = x1[j] * s[j] + x2[j] * c[j]; }
                        *(u32x2*)(dst + (size_t)row * 64 + i0) = (u32x2){pk_bf16(o1[0], o1[1]), pk_bf16(o1[2], o1[3])};
                        *(u32x2*)(dst + (size_t)row * 64 + 32 + i0) = (u32x2){pk_bf16(o2[0], o2[1]), pk_bf16(o2[2], o2[3])}; } }
            }
        }
    }
};
struct EpiQUp {
    int pn, brow; unsigned char* ws;
    __device__ __forceinline__ void mid(f32x4 (&)[8][4], int, int, int, int) {}
    __device__ __forceinline__ void fin(f32x4 (&acc)[8][4], int wr, int wc, int fr, int fq) {
        bf16_t* dst = (bf16_t*)(ws + WS_QB); const float* rope = (const float*)(ws + WS_ROPE); const float* ssq = (const float*)(ws + WS_CTL + CTL_SSQ_CQ);
        const int seg = pn * 4 + wc, head = seg / 3, part = seg - head * 3;
        float sq[8];
#pragma unroll
        for (int m = 0; m < 8; ++m) { const f32x4* pp = (const f32x4*)((const float*)(ws + WS_SSQC) + (size_t)(brow + wr * 128 + m * 16 + fr) * 8); const f32x4 p0 = pp[0], p1 = pp[1];
            sq[m] = ((p0[0] + p0[1]) + (p0[2] + p0[3])) + ((p1[0] + p1[1]) + (p1[2] + p1[3])); }
#pragma unroll
        for (int m = 0; m < 8; ++m) { const int row = brow + wr * 128 + m * 16 + fr; const float rs = rsqrtf(sq[m] * (1.f / 512.f) + EPS);
            bf16_t* drow = dst + (size_t)row * 1536 + head * 192 + part * 64;
            if (part < 2) {
#pragma unroll
                for (int n = 0; n < 4; ++n) { const f32x4 v = acc[m][n]; *(u32x2*)(drow + n * 16 + fq * 4) = (u32x2){pk_bf16(v[0] * rs, v[1] * rs), pk_bf16(v[2] * rs, v[3] * rs)}; }
            } else { const int pos = row & (SEQ - 1);
#pragma unroll
                for (int n = 0; n < 2; ++n) { const int i0 = n * 16 + fq * 4; const f32x4 x1 = acc[m][n], x2 = acc[m][n + 2];
                    const f32x4 cs0 = *(const f32x4*)(rope + ((size_t)pos * 32 + i0) * 2), cs1 = *(const f32x4*)(rope + ((size_t)pos * 32 + i0) * 2 + 4);
                    const float c[4] = {cs0[0], cs0[2], cs1[0], cs1[2]}, s[4] = {cs0[1], cs0[3], cs1[1], cs1[3]};
                    float o1[4], o2[4];
#pragma unroll
                    for (int j = 0; j < 4; ++j) { o1[j] = (x1[j] * c[j] - x2[j] * s[j]) * rs; o2[j] = (x1[j] * s[j] + x2[j] * c[j]) * rs; }
                    *(u32x2*)(drow + i0) = (u32x2){pk_bf16(o1[0], o1[1]), pk_bf16(o1[2], o1[3])};
                    *(u32x2*)(drow + 32 + i0) = (u32x2){pk_bf16(o2[0], o2[1]), pk_bf16(o2[2], o2[3])}; } }
        }
    }
};
struct EpiKvUp {
    int pn, brow; unsigned char* ws;
    __device__ __forceinline__ void mid(f32x4 (&)[8][4], int, int, int, int) {}
    __device__ __forceinline__ void fin(f32x4 (&acc)[8][4], int wr, int wc, int fr, int fq) {
        bf16_t* dst = (bf16_t*)(ws + WS_KVB);
        float sq[8];
#pragma unroll
        for (int m = 0; m < 8; ++m) { const f32x4 p0 = *(const f32x4*)((const float*)(ws + WS_SSQK) + (size_t)(brow + wr * 128 + m * 16 + fr) * 4); sq[m] = (p0[0] + p0[1]) + (p0[2] + p0[3]); }
#pragma unroll
        for (int m = 0; m < 8; ++m) { const int row = brow + wr * 128 + m * 16 + fr; const float rs = rsqrtf(sq[m] * (1.f / 256.f) + EPS);
#pragma unroll
            for (int n = 0; n < 4; ++n) { const int col = pn * 256 + wc * 64 + n * 16 + fq * 4; const f32x4 v = acc[m][n];
                *(u32x2*)(dst + (size_t)row * 2048 + col) = (u32x2){pk_bf16(v[0] * rs, v[1] * rs), pk_bf16(v[2] * rs, v[3] * rs)}; } }
    }
};
struct EpiWo {
    int pn, brow; unsigned char* ws; const float* x; const LAS float* tab;
    __device__ __forceinline__ void mid(f32x4 (&acc)[8][4], int wr, int wc, int fr, int fq) {
#pragma unroll
        for (int m = 0; m < 8; ++m) { const int r = wr * 128 + m * 16 + fr;
            const float f = __builtin_amdgcn_sqrtf((tab[256 + r] + EPS) * __builtin_amdgcn_rcpf(tab[r] + EPS));
#pragma unroll
            for (int n = 0; n < 4; ++n) acc[m][n] *= f;
            SBAR(); }
    }
    __device__ __forceinline__ void fin(f32x4 (&acc)[8][4], int wr, int wc, int fr, int fq) {
        float* x2 = (float*)(ws + WS_X2);
#pragma unroll
        for (int m = 0; m < 8; ++m) { const int r = wr * 128 + m * 16 + fr, row = brow + r; const float rbm = rsqrtf(tab[256 + r] + EPS); f32x4 xv[4];
#pragma unroll
            for (int n = 0; n < 4; ++n) xv[n] = *(const f32x4*)(x + (size_t)row * D_MODEL + pn * 256 + wc * 64 + n * 16 + fq * 4);
#pragma unroll
            for (int n = 0; n < 4; ++n) { const int col = pn * 256 + wc * 64 + n * 16 + fq * 4;
                const f32x4 v = acc[m][n] * rbm + xv[n];
                *(f32x4*)(x2 + (size_t)row * D_MODEL + col) = v; } }
    }
};
struct EpiUp8 {
    int j0, r0, cnt; unsigned char* dst; const float* bias;
    __device__ __forceinline__ void fin(f32x16 (&acc)[4][2], int wr, int wc, int r32, int hi) {
        f32x4 bg[4], bu[4];
#pragma unroll
        for (int rg = 0; rg < 4; ++rg) { const int j = j0 + wc * 32 + 8 * rg + 4 * hi; bg[rg] = *(const f32x4*)(bias + j); bu[rg] = *(const f32x4*)(bias + D_FF + j); }
#pragma unroll
        for (int m = 0; m < 4; ++m) { const int r = wr * 128 + m * 32 + r32; unsigned o8[4];
#pragma unroll
            for (int rg = 0; rg < 4; ++rg) { float o[4];
#pragma unroll
                for (int q = 0; q < 4; ++q) { const float g = fminf(acc[m][0][4 * rg + q] + bg[rg][q], 7.f), u = fminf(fmaxf(acc[m][1][4 * rg + q] + bu[rg][q], -7.f), 7.f);
                    const float sg = __builtin_amdgcn_rcpf(1.f + __builtin_amdgcn_exp2f(-1.702f * LOG2E * g)); o[q] = 4.f * (u + 1.f) * (g * sg); }
                o8[rg] = pk4_fp8(o[0], o[1], o[2], o[3]); }
            if (r0 + r < cnt) {
#pragma unroll
                for (int rg = 0; rg < 4; ++rg) *(unsigned*)(dst + (size_t)r * D_FF + j0 + wc * 32 + 8 * rg + 4 * hi) = o8[rg]; }
        }
    }
};
struct EpiDown8 {
    int c0, r0, cnt; bf16_t* dst; const float* bias;
    __device__ __forceinline__ void fin(f32x16 (&acc)[4][2], int wr, int wc, int r32, int hi) {
        f32x4 b[2][4];
#pragma unroll
        for (int n = 0; n < 2; ++n)
#pragma unroll
            for (int rg = 0; rg < 4; ++rg) b[n][rg] = *(const f32x4*)(bias + c0 + wc * 64 + n * 32 + 8 * rg + 4 * hi);
#pragma unroll
        for (int m = 0; m < 4; ++m) { const int r = wr * 128 + m * 32 + r32;
            if (r0 + r < cnt) {
#pragma unroll
                for (int n = 0; n < 2; ++n)
#pragma unroll
                    for (int rg = 0; rg < 4; ++rg) { const int col = c0 + wc * 64 + n * 32 + 8 * rg + 4 * hi;
                        *(u32x2*)(dst + (size_t)r * D_MODEL + col) = (u32x2){pk_bf16(acc[m][n][4 * rg] + b[n][rg][0], acc[m][n][4 * rg + 1] + b[n][rg][1]), pk_bf16(acc[m][n][4 * rg + 2] + b[n][rg][2], acc[m][n][4 * rg + 3] + b[n][rg][3])}; } }
        }
    }
};

constexpr int PG_HTB = 128 * 64 * 2;
__host__ __device__ __forceinline__ int pg_lds_byte(int r, int c) { const int st = (r >> 4) * 2 + (c >> 5), rr = r & 15, cc = c & 31, ob = rr * 64 + cc * 2; return st * 1024 + (ob ^ (((ob >> 9) & 1) << 5)); }
__host__ __device__ __forceinline__ void pg_stage_rc(int b, int& R, int& C) { const int st = b / 1024, sb = b % 1024, swz = sb ^ (((sb >> 9) & 1) << 5); R = (st >> 1) * 16 + swz / 64; C = (st & 1) * 32 + (swz % 64) / 2; }
__host__ __device__ __forceinline__ int pg_tcol(int rho) { return (rho & ~0x30) | ((rho & 0x10) << 1) | ((rho & 0x20) >> 1); }
template <bool MID, class EPI>
__device__ __forceinline__ void gemm_unit_pg(LAS char* lds, const bf16_t* A, const bf16_t* Bt, const int K, EPI& E) {
    const int tid = threadIdx.x, wid = __builtin_amdgcn_readfirstlane(tid >> 6), lane = tid & 63, wr = wid >> 2, wc = wid & 3, fr = lane & 15, fq = lane >> 4;
    const int nt = K / 64;
    unsigned voff[2];
#pragma unroll
    for (int i = 0; i < 2; ++i) { int R, C; pg_stage_rc(tid * 16 + i * 8192, R, C); voff[i] = (unsigned)(R * K + C) * 2u; }
    const size_t kstep = (size_t)(64 * 2), hstep = (size_t)128 * K * 2;
    const unsigned ldsw = (unsigned)wid * 1024u;
    const int aoff = pg_lds_byte(wr * 64 + fr, fq * 8), boff = pg_lds_byte(wc * 32 + fr, fq * 8);
#define PG_SA(b, h) (((b) * 2 + (h)) * PG_HTB)
#define PG_SB(b, h) ((4 + (b) * 2 + (h)) * PG_HTB)
#define PG_STAGE(bufoff, gbase) do { _Pragma("unroll") for (int _i = 0; _i < 2; ++_i) \
        __builtin_amdgcn_global_load_lds((const unsigned*)((const char*)(gbase) + voff[_i]), (LAS unsigned*)(lds + (bufoff) + ldsw + _i * 8192), 16, 0, 0); } while (0)
#define PG_LDA(dst, b, h) do { _Pragma("unroll") for (int m = 0; m < 4; ++m) _Pragma("unroll") for (int k = 0; k < 2; ++k) dst[m][k] = *(const LAS bf16x8*)(lds + PG_SA(b, h) + aoff + m * 2048 + k * 1024); } while (0)
#define PG_LDB(dst, b, h) do { _Pragma("unroll") for (int n = 0; n < 2; ++n) _Pragma("unroll") for (int k = 0; k < 2; ++k) dst[n][k] = *(const LAS bf16x8*)(lds + PG_SB(b, h) + boff + n * 2048 + k * 1024); } while (0)
#define PG_MMA(ai, bj, At_, Bt_) do { __builtin_amdgcn_s_setprio(1); _Pragma("unroll") for (int m = 0; m < 4; ++m) _Pragma("unroll") for (int n = 0; n < 2; ++n) _Pragma("unroll") for (int k = 0; k < 2; ++k) \
        acc[ai][bj][m][n] = __builtin_amdgcn_mfma_f32_16x16x32_bf16(Bt_[n][k], At_[m][k], acc[ai][bj][m][n], 0, 0, 0); __builtin_amdgcn_s_setprio(0); } while (0)
#define PG_WAIT_V(n) asm volatile("s_waitcnt vmcnt(" #n ")" ::: "memory")
#define PG_WAIT_L(n) asm volatile("s_waitcnt lgkmcnt(" #n ")" ::: "memory")
#define PG_BAR __builtin_amdgcn_s_barrier()
    f32x4 acc[2][2][4][2];
#pragma unroll
    for (int a = 0; a < 2; ++a)
#pragma unroll
        for (int b = 0; b < 2; ++b)
#pragma unroll
            for (int m = 0; m < 4; ++m)
#pragma unroll
                for (int n = 0; n < 2; ++n) acc[a][b][m][n] = (f32x4){0.f, 0.f, 0.f, 0.f};
    bf16x8 At[4][2], B0[2][2], B1[2][2];
    const char* cA = (const char*)A; const char* cB = (const char*)Bt;
    PG_STAGE(PG_SB(0, 0), cB); PG_STAGE(PG_SA(0, 0), cA); PG_STAGE(PG_SB(0, 1), cB + hstep); PG_STAGE(PG_SA(0, 1), cA + hstep);
    if (wr == 1) PG_BAR;
    PG_WAIT_V(4); PG_BAR;
    PG_STAGE(PG_SB(1, 0), cB + kstep); PG_STAGE(PG_SA(1, 0), cA + kstep); PG_STAGE(PG_SB(1, 1), cB + hstep + kstep);
    PG_WAIT_V(6); PG_BAR;
    for (int t = 0; t < nt; t += 2) {
        const bool last = (t == nt - 2);
        const char* a1 = cA + (size_t)(t + 1) * kstep;
        const char* a2 = cA + (size_t)(t + 2) * kstep; const char* b2 = cB + (size_t)(t + 2) * kstep;
        const char* a3 = a2 + kstep; const char* b3 = b2 + kstep;
        if (MID && t == (nt >> 1)) E.mid(acc, wr, wc, fr, fq);
        PG_LDB(B0, 0, 0); SBAR(); PG_LDA(At, 0, 0); PG_STAGE(PG_SA(1, 1), a1 + hstep);
        PG_WAIT_L(8); PG_BAR; PG_WAIT_L(0); PG_MMA(0, 0, At, B0); PG_BAR; SBAR();
        PG_LDB(B1, 0, 1); if (!last) PG_STAGE(PG_SB(0, 0), b2);
        PG_BAR; PG_WAIT_L(0); PG_MMA(0, 1, At, B1); PG_BAR;
        PG_LDA(At, 0, 1); if (!last) PG_STAGE(PG_SA(0, 0), a2);
        PG_BAR; PG_WAIT_L(0); PG_MMA(1, 0, At, B0); PG_BAR; SBAR();
        if (!last) { PG_STAGE(PG_SB(0, 1), b2 + hstep); PG_WAIT_V(6); } else PG_WAIT_V(0);
        PG_BAR; PG_MMA(1, 1, At, B1); PG_BAR;
        PG_LDB(B0, 1, 0); SBAR(); PG_LDA(At, 1, 0); if (!last) PG_STAGE(PG_SA(0, 1), a2 + hstep);
        PG_WAIT_L(8); PG_BAR; PG_WAIT_L(0); PG_MMA(0, 0, At, B0); PG_BAR; SBAR();
        PG_LDB(B1, 1, 1); if (!last) PG_STAGE(PG_SB(1, 0), b3);
        PG_BAR; PG_WAIT_L(0); PG_MMA(0, 1, At, B1); PG_BAR;
        PG_LDA(At, 1, 1); if (!last) PG_STAGE(PG_SA(1, 0), a3);
        PG_BAR; PG_WAIT_L(0); PG_MMA(1, 0, At, B0); PG_BAR; SBAR();
        if (!last) { PG_STAGE(PG_SB(1, 1), b3 + hstep); PG_WAIT_V(6); }
        PG_BAR; PG_MMA(1, 1, At, B1); PG_BAR;
    }
    E.fin(acc, wr, wc, fr, fq);
    PG_WAIT_V(0);
    if (wr == 0) PG_BAR;
    PG_BAR;
#undef PG_SA
#undef PG_SB
#undef PG_STAGE
#undef PG_LDA
#undef PG_LDB
#undef PG_MMA
#undef PG_WAIT_V
#undef PG_WAIT_L
#undef PG_BAR
}

#define PG_ROW(ai, m) (128 * (ai) + 64 * wr + 16 * (m) + fr)
#define PG_COL(bj, n) (128 * (bj) + 64 * (wc >> 1) + 32 * (n) + 16 * (wc & 1) + 4 * fq)
struct PEpiProj {
    int pn, brow; unsigned char* ws; const float *qg, *kvg;
    __device__ __forceinline__ void mid(f32x4 (&)[2][2][4][2], int, int, int, int) {}
    __device__ __forceinline__ void fin(f32x4 (&acc)[2][2][4][2], int wr, int wc, int fr, int fq) {
        if (pn < 6) {
            bf16_t* dst; int ldd, c0;
            if (pn < 4) { dst = (bf16_t*)(ws + WS_QA); ldd = 1024; c0 = pn * 256; } else if (pn == 4) { dst = (bf16_t*)(ws + WS_KA); ldd = 256; c0 = 0; } else { dst = (bf16_t*)(ws + WS_VA); ldd = 256; c0 = 0; }
#pragma unroll
            for (int ai = 0; ai < 2; ++ai)
#pragma unroll
                for (int m = 0; m < 4; ++m) { bf16_t* rowp = dst + (size_t)(brow + PG_ROW(ai, m)) * ldd + c0;
#pragma unroll
                    for (int bj = 0; bj < 2; ++bj)
#pragma unroll
                        for (int n = 0; n < 2; ++n) { const f32x4 v = acc[ai][bj][m][n]; *(u32x2*)(rowp + PG_COL(bj, n)) = (u32x2){pk_bf16(v[0], v[1]), pk_bf16(v[2], v[3])}; } }
        } else if (pn < 9) {
            bf16_t* dst; int ldd, c0; const float* g; float* ssq; int nsl, sl0;
            if (pn < 8) { dst = (bf16_t*)(ws + WS_CQ); ldd = 512; c0 = (pn - 6) * 256; g = qg; ssq = (float*)(ws + WS_SSQC); nsl = 16; sl0 = (pn - 6) * 8 + wc; }
            else { dst = (bf16_t*)(ws + WS_CKV); ldd = 256; c0 = 0; g = kvg; ssq = (float*)(ws + WS_SSQK); nsl = 8; sl0 = wc; }
            f32x4 gvv[2][2];
#pragma unroll
            for (int bj = 0; bj < 2; ++bj)
#pragma unroll
                for (int n = 0; n < 2; ++n) gvv[bj][n] = *(const f32x4*)(g + c0 + PG_COL(bj, n));
#pragma unroll
            for (int ai = 0; ai < 2; ++ai)
#pragma unroll
                for (int m = 0; m < 4; ++m) { const int row = brow + PG_ROW(ai, m);
#pragma unroll
                    for (int bj = 0; bj < 2; ++bj) { float ss = 0.f;
#pragma unroll
                        for (int n = 0; n < 2; ++n) { const f32x4 v = acc[ai][bj][m][n]; const f32x4 gv = gvv[bj][n];
                            ss += v[0] * v[0] + v[1] * v[1] + v[2] * v[2] + v[3] * v[3];
                            *(u32x2*)(dst + (size_t)row * ldd + c0 + PG_COL(bj, n)) = (u32x2){pk_bf16(v[0] * gv[0], v[1] * gv[1]), pk_bf16(v[2] * gv[2], v[3] * gv[3])}; }
                        ss += __shfl_xor(ss, 16, 64); ss += __shfl_xor(ss, 32, 64);
                        if (fq == 0) ssq[(size_t)row * nsl + sl0 + 4 * bj] = ss; } }
        } else {
            if (wc < 2) {
                bf16_t* dst = (bf16_t*)(ws + WS_KPE); const float* rope = (const float*)(ws + WS_ROPE); const int i0 = 16 * wc + 4 * fq;
#pragma unroll
                for (int ai = 0; ai < 2; ++ai)
#pragma unroll
                    for (int m = 0; m < 4; ++m) { const int row = brow + PG_ROW(ai, m); const int pos = row & (SEQ - 1); const f32x4 x1 = acc[ai][0][m][0], x2 = acc[ai][0][m][1];
                        const f32x4 cs0 = *(const f32x4*)(rope + ((size_t)pos * 32 + i0) * 2), cs1 = *(const f32x4*)(rope + ((size_t)pos * 32 + i0) * 2 + 4);
                        const float c[4] = {cs0[0], cs0[2], cs1[0], cs1[2]}, s[4] = {cs0[1], cs0[3], cs1[1], cs1[3]};
                        float o1[4], o2[4];
#pragma unroll
                        for (int j = 0; j < 4; ++j) { o1[j] = x1[j] * c[j] - x2[j] * s[j]; o2[j] = x1[j] * s[j] + x2[j] * c[j]; }
                        *(u32x2*)(dst + (size_t)row * 64 + i0) = (u32x2){pk_bf16(o1[0], o1[1]), pk_bf16(o1[2], o1[3])};
                        *(u32x2*)(dst + (size_t)row * 64 + 32 + i0) = (u32x2){pk_bf16(o2[0], o2[1]), pk_bf16(o2[2], o2[3])}; }
            }
        }
    }
};
struct PEpiQUp {
    int pn, brow; unsigned char* ws;
    __device__ __forceinline__ void mid(f32x4 (&)[2][2][4][2], int, int, int, int) {}
    __device__ __forceinline__ void fin(f32x4 (&acc)[2][2][4][2], int wr, int wc, int fr, int fq) {
        bf16_t* dst = (bf16_t*)(ws + WS_QB); const float* rope = (const float*)(ws + WS_ROPE);
        float rs[2][4];
#pragma unroll
        for (int ai = 0; ai < 2; ++ai)
#pragma unroll
            for (int m = 0; m < 4; ++m) { const f32x4* pp = (const f32x4*)((const float*)(ws + WS_SSQC) + (size_t)(brow + PG_ROW(ai, m)) * 16); const f32x4 p0 = pp[0], p1 = pp[1], p2 = pp[2], p3 = pp[3];
                const float sq = (((p0[0] + p0[1]) + (p0[2] + p0[3])) + ((p1[0] + p1[1]) + (p1[2] + p1[3]))) + (((p2[0] + p2[1]) + (p2[2] + p2[3])) + ((p3[0] + p3[1]) + (p3[2] + p3[3])));
                rs[ai][m] = rsqrtf(sq * (1.f / 512.f) + EPS); }
#pragma unroll
        for (int bj = 0; bj < 2; ++bj) { const int seg = pn * 4 + 2 * bj + (wc >> 1), head = seg / 3, part = seg - head * 3; const int i0 = 16 * (wc & 1) + 4 * fq;
#pragma unroll
            for (int ai = 0; ai < 2; ++ai)
#pragma unroll
                for (int m = 0; m < 4; ++m) { const int row = brow + PG_ROW(ai, m); const float r = rs[ai][m]; bf16_t* drow = dst + (size_t)row * 1536 + head * 192 + part * 64;
                    const f32x4 x1 = acc[ai][bj][m][0], x2 = acc[ai][bj][m][1];
                    if (part < 2) {
                        *(u32x2*)(drow + i0) = (u32x2){pk_bf16(x1[0] * r, x1[1] * r), pk_bf16(x1[2] * r, x1[3] * r)};
                        *(u32x2*)(drow + 32 + i0) = (u32x2){pk_bf16(x2[0] * r, x2[1] * r), pk_bf16(x2[2] * r, x2[3] * r)};
                    } else { const int pos = row & (SEQ - 1);
                        const f32x4 cs0 = *(const f32x4*)(rope + ((size_t)pos * 32 + i0) * 2), cs1 = *(const f32x4*)(rope + ((size_t)pos * 32 + i0) * 2 + 4);
                        const float c[4] = {cs0[0], cs0[2], cs1[0], cs1[2]}, s[4] = {cs0[1], cs0[3], cs1[1], cs1[3]};
                        float o1[4], o2[4];
#pragma unroll
                        for (int j = 0; j < 4; ++j) { o1[j] = (x1[j] * c[j] - x2[j] * s[j]) * r; o2[j] = (x1[j] * s[j] + x2[j] * c[j]) * r; }
                        *(u32x2*)(drow + i0) = (u32x2){pk_bf16(o1[0], o1[1]), pk_bf16(o1[2], o1[3])};
                        *(u32x2*)(drow + 32 + i0) = (u32x2){pk_bf16(o2[0], o2[1]), pk_bf16(o2[2], o2[3])}; } } }
    }
};
struct PEpiKvUp {
    int pn, brow; unsigned char* ws;
    __device__ __forceinline__ void mid(f32x4 (&)[2][2][4][2], int, int, int, int) {}
    __device__ __forceinline__ void fin(f32x4 (&acc)[2][2][4][2], int wr, int wc, int fr, int fq) {
        bf16_t* dst = (bf16_t*)(ws + WS_KVB);
#pragma unroll
        for (int ai = 0; ai < 2; ++ai)
#pragma unroll
            for (int m = 0; m < 4; ++m) { const int row = brow + PG_ROW(ai, m); const f32x4* pp = (const f32x4*)((const float*)(ws + WS_SSQK) + (size_t)row * 8); const f32x4 p0 = pp[0], p1 = pp[1];
                const float r = rsqrtf((((p0[0] + p0[1]) + (p0[2] + p0[3])) + ((p1[0] + p1[1]) + (p1[2] + p1[3]))) * (1.f / 256.f) + EPS);
#pragma unroll
                for (int bj = 0; bj < 2; ++bj)
#pragma unroll
                    for (int n = 0; n < 2; ++n) { const f32x4 v = acc[ai][bj][m][n];
                        *(u32x2*)(dst + (size_t)row * 2048 + pn * 256 + PG_COL(bj, n)) = (u32x2){pk_bf16(v[0] * r, v[1] * r), pk_bf16(v[2] * r, v[3] * r)}; } }
    }
};
struct PEpiWo {
    int pn, brow; unsigned char* ws; const float* x; const LAS float* tab;
    __device__ __forceinline__ void mid(f32x4 (&acc)[2][2][4][2], int wr, int wc, int fr, int fq) {
#pragma unroll
        for (int ai = 0; ai < 2; ++ai)
#pragma unroll
            for (int m = 0; m < 4; ++m) { const int r = PG_ROW(ai, m);
                const float f = __builtin_amdgcn_sqrtf((tab[256 + r] + EPS) * __builtin_amdgcn_rcpf(tab[r] + EPS));
#pragma unroll
                for (int bj = 0; bj < 2; ++bj)
#pragma unroll
                    for (int n = 0; n < 2; ++n) acc[ai][bj][m][n] *= f; }
        asm volatile("s_waitcnt lgkmcnt(0)" ::: "memory"); SBAR();
    }
    __device__ __forceinline__ void fin(f32x4 (&acc)[2][2][4][2], int wr, int wc, int fr, int fq) {
        float* x2 = (float*)(ws + WS_X2);
#pragma unroll
        for (int ai = 0; ai < 2; ++ai)
#pragma unroll
            for (int m = 0; m < 4; ++m) { const int r = PG_ROW(ai, m); const size_t o = (size_t)(brow + r) * D_MODEL + pn * 256; const float rbm = rsqrtf(tab[256 + r] + EPS); f32x4 xv[2][2];
#pragma unroll
                for (int bj = 0; bj < 2; ++bj)
#pragma unroll
                    for (int n = 0; n < 2; ++n) xv[bj][n] = *(const f32x4*)(x + o + PG_COL(bj, n));
#pragma unroll
                for (int bj = 0; bj < 2; ++bj)
#pragma unroll
                    for (int n = 0; n < 2; ++n) *(f32x4*)(x2 + o + PG_COL(bj, n)) = acc[ai][bj][m][n] * rbm + xv[bj][n]; }
    }
};
__device__ __forceinline__ void pg_convert(const float* W, int K, int ld, int ncols, int nrows, bf16_t* Bt, int item0, int nitems_stride) {
    const int total = nrows * (K >> 3);
    for (int it0 = item0; it0 < total; it0 += 4 * nitems_stride) { float v[4][8]; int row[4], k0[4]; bool ok[4];
#pragma unroll
        for (int b = 0; b < 4; ++b) { const int it = it0 + b * nitems_stride; const int itc = it < total ? it : item0; const int kc = itc / nrows; row[b] = itc - kc * nrows; k0[b] = kc << 3; ok[b] = it < total;
            const int col = (row[b] & ~255) + pg_tcol(row[b] & 255); const int colc = col < ncols ? col : 0; const float s = col < ncols ? 1.f : 0.f;
#pragma unroll
            for (int q = 0; q < 8; ++q) v[b][q] = W[(size_t)(k0[b] + q) * ld + colc] * s; }
#pragma unroll
        for (int b = 0; b < 4; ++b) if (ok[b])
            *(u32x4*)(Bt + (size_t)row[b] * K + k0[b]) = (u32x4){pk_bf16(v[b][0], v[b][1]), pk_bf16(v[b][2], v[b][3]), pk_bf16(v[b][4], v[b][5]), pk_bf16(v[b][6], v[b][7])}; }
}
__device__ __forceinline__ void sincos_d(double x, double& s, double& c) {
    const double k = __builtin_rint(x * 0.63661977236758134308);
    double r = __builtin_fma(-k, 1.57079632679489655800e+00, x); r = __builtin_fma(-k, 6.12323399573676603587e-17, r);
    const double r2 = r * r;
    double sp = -7.6471637318198164759e-13; sp = sp * r2 + 1.6059043836821614599e-10; sp = sp * r2 - 2.5052108385441718775e-08; sp = sp * r2 + 2.7557319223985890653e-06;
    sp = sp * r2 - 1.9841269841269841270e-04; sp = sp * r2 + 8.3333333333333333333e-03; sp = sp * r2 - 1.6666666666666666667e-01; const double sn = r + r * r2 * sp;
    double cp = 4.7794773323873852974e-14; cp = cp * r2 - 1.1470745597729724714e-11; cp = cp * r2 + 2.0876756987868098979e-09; cp = cp * r2 - 2.7557319223985890653e-07;
    cp = cp * r2 + 2.4801587301587301587e-05; cp = cp * r2 - 1.3888888888888888889e-03; cp = cp * r2 + 4.1666666666666666667e-02; cp = cp * r2 - 0.5; const double cn = 1.0 + r2 * cp;
    const int q = ((int)k) & 3;
    s = (q == 0) ? sn : (q == 1) ? cn : (q == 2) ? -sn : -cn;
    c = (q == 0) ? cn : (q == 1) ? -sn : (q == 2) ? -cn : sn;
}

__device__ __forceinline__ void phase_prologue(const Params& p) {
    const int tid = threadIdx.x, wid = tid >> 6, lane = tid & 63;
    bf16_t* xn = (bf16_t*)(p.ws + WS_XN);
    for (int row = blockIdx.x * 8 + wid; row < NTOK; row += gridDim.x * 8) {
        const f32x4* xr = (const f32x4*)(p.x + (size_t)row * D_MODEL); f32x4 v[8]; float ss = 0.f;
#pragma unroll
        for (int i = 0; i < 8; ++i) { v[i] = xr[lane + 64 * i]; ss += v[i][0] * v[i][0] + v[i][1] * v[i][1] + v[i][2] * v[i][2] + v[i][3] * v[i][3]; }
        ss = wave_sum(ss); const float rs = rsqrtf(ss * (1.f / D_MODEL) + EPS);
#pragma unroll
        for (int i = 0; i < 8; ++i) { const f32x4 g = ((const f32x4*)p.attn_norm)[lane + 64 * i];
            *(u32x2*)(xn + (size_t)row * D_MODEL + 4 * (lane + 64 * i)) = (u32x2){pk_bf16(v[i][0] * rs * g[0], v[i][1] * rs * g[1]), pk_bf16(v[i][2] * rs * g[2], v[i][3] * rs * g[3])}; }
    }
    const int gtid = blockIdx.x * 512 + tid;
    if (gtid < SEQ * 32) {
        const int pos = gtid >> 5, i = gtid & 31;
        double b = 10000.0; for (int q = 0; q < 5; ++q) b = __builtin_sqrt(b);
        double f = 1.0; for (int q = 0; q < i; ++q) f *= b;
        const float inv_freq = (float)(1.0 / f); const float ang = (float)pos * inv_freq;
        double s, c; sincos_d((double)ang, s, c);
        float* rope = (float*)(p.ws + WS_ROPE); rope[(size_t)gtid * 2] = (float)c; rope[(size_t)gtid * 2 + 1] = (float)s;
    }
    {
        const int nth = gridDim.x * 512;
        pg_convert(p.w_in, D_MODEL, IN_COLS, IN_COLS, 2560, (bf16_t*)(p.ws + WS_BT_IN), gtid, nth);
        pg_convert(p.b_w_uq, 512, 1536, 1536, 1536, (bf16_t*)(p.ws + WS_BT_UQ), gtid, nth);
    }
    if (gtid < N_EXP * D_MODEL) {
        ((float*)(p.ws + WS_WRT))[gtid] = p.w_router[gtid] * p.mlp_norm[gtid >> 5];
    }
}

constexpr int AA_PITCH = 144;
constexpr int AA_K = 0, AA_V = 384 * AA_PITCH;
constexpr int AA_WS = 2 * 384 * AA_PITCH;
__device__ __forceinline__ void attn_a_unit(const Params& p, LAS char* lds, int u) {
    const int tid = threadIdx.x, wid = __builtin_amdgcn_readfirstlane(tid >> 6), lane = tid & 63, r32 = lane & 31, hi = lane >> 5;
    const int b = u >> 7, nq = (u >> 2) & 31, kvh = u & 3;
    const bf16_t* QA = (const bf16_t*)(p.ws + WS_QA); const bf16_t* KA = (const bf16_t*)(p.ws + WS_KA); const bf16_t* VA = (const bf16_t*)(p.ws + WS_VA);
    const int P0 = (nq - 1) * 128;
    __syncthreads();
    for (int c = tid; c < 384 * 8; c += 512) { const int r = c >> 3, ch = c & 7; const int pos = P0 + r;
        i32x4 kv = {0, 0, 0, 0}, vv = {0, 0, 0, 0};
        if (pos >= 0 && pos < SEQ) { const size_t g = ((size_t)(b * SEQ + pos)) * 256 + kvh * 64 + ch * 8; kv = *(const i32x4*)(KA + g); vv = *(const i32x4*)(VA + g); }
        *(LAS i32x4*)(lds + AA_K + r * AA_PITCH + ch * 16) = kv; *(LAS i32x4*)(lds + AA_V + r * AA_PITCH + ch * 16) = vv; }
    __syncthreads();
    LAS float* wsf = (LAS float*)(lds + AA_WS) + wid * 64;
    const int hq = kvh * 4 + (wid >> 1);
    const float slope2 = __builtin_amdgcn_exp2f(-8.f * (float)(hq + 1) / 16.f) * LOG2E;
    const float sink2 = p.a_sink[hq] * LOG2E;
    const float C = 0.125f * LOG2E;
    const float* ga = p.out_norm_a + hq * 64;
    bf16_t* Y = (bf16_t*)(p.ws + WS_Y); float* ssqa = (float*)(p.ws + WS_SSQP);
    for (int blk = 0; blk < 2; ++blk) {
        const int q0 = nq * 128 + (wid & 1) * 64 + blk * 32;
        const int tq = q0 + r32;
        bf16x8 qr[4];
        { const bf16_t* qp = QA + ((size_t)(b * SEQ + tq)) * 1024 + hq * 64 + hi * 8;
#pragma unroll
          for (int d0 = 0; d0 < 4; ++d0) qr[d0] = *(const bf16x8*)(qp + d0 * 16); }
        float m_reg = sink2, l_reg = 1.f; f32x16 o[2] = {};
        for (int jt = 0; jt < 6; ++jt) {
            const int kp0 = P0 + jt * 64;
            if (kp0 + 63 < q0 - 128 || kp0 > q0 + 31 + 128 || kp0 + 63 < 0 || kp0 >= SEQ) continue;
            f32x16 p0 = {}, p1 = {};
#pragma unroll
            for (int d0 = 0; d0 < 4; ++d0) {
                const bf16x8 k0 = *(const LAS bf16x8*)(lds + AA_K + (jt * 64 + r32) * AA_PITCH + (d0 * 16 + hi * 8) * 2);
                const bf16x8 k1 = *(const LAS bf16x8*)(lds + AA_K + (jt * 64 + 32 + r32) * AA_PITCH + (d0 * 16 + hi * 8) * 2);
                p0 = __builtin_amdgcn_mfma_f32_32x32x16_bf16(k0, qr[d0], p0, 0, 0, 0);
                p1 = __builtin_amdgcn_mfma_f32_32x32x16_bf16(k1, qr[d0], p1, 0, 0, 0);
            }
            float pmax = -1e30f;
#pragma unroll
            for (int r = 0; r < 16; ++r) {
                { const int kp = kp0 + crow(r, hi); const int dist = tq > kp ? tq - kp : kp - tq; const bool ok = dist <= 128 && kp >= 0 && kp < SEQ;
                  p0[r] = ok ? p0[r] * C - slope2 * (float)dist : -1e30f; pmax = fmaxf(pmax, p0[r]); }
                { const int kp = kp0 + 32 + crow(r, hi); const int dist = tq > kp ? tq - kp : kp - tq; const bool ok = dist <= 128 && kp >= 0 && kp < SEQ;
                  p1[r] = ok ? p1[r] * C - slope2 * (float)dist : -1e30f; pmax = fmaxf(pmax, p1[r]); }
            }
            { auto rr = __builtin_amdgcn_permlane32_swap(__float_as_uint(pmax), __float_as_uint(pmax), false, false); pmax = fmaxf(__uint_as_float(rr[0]), __uint_as_float(rr[1])); }
            const float mn = fmaxf(m_reg, pmax); const float alpha = __builtin_amdgcn_exp2f(m_reg - mn); m_reg = mn;
            float ps = 0.f;
#pragma unroll
            for (int r = 0; r < 16; ++r) { p0[r] = __builtin_amdgcn_exp2f(p0[r] - mn); p1[r] = __builtin_amdgcn_exp2f(p1[r] - mn); ps += p0[r] + p1[r]; }
            { auto rr = __builtin_amdgcn_permlane32_swap(__float_as_uint(ps), __float_as_uint(ps), false, false); ps = __uint_as_float(rr[0]) + __uint_as_float(rr[1]); }
            l_reg = l_reg * alpha + ps;
            if (hi == 0) wsf[r32] = alpha;
            WAIT_L0();
#pragma unroll
            for (int r = 0; r < 16; ++r) { const float a = wsf[crow(r, hi)]; o[0][r] *= a; o[1][r] *= a; }
            bf16x8 pa[4];
#define PK4(P, BASE, OUT) do { unsigned a0 = pk_bf16(P[BASE + 0], P[BASE + 1]), a1 = pk_bf16(P[BASE + 2], P[BASE + 3]); \
    unsigned b0 = pk_bf16(P[BASE + 4], P[BASE + 5]), b1 = pk_bf16(P[BASE + 6], P[BASE + 7]); \
    auto r0_ = __builtin_amdgcn_permlane32_swap(a0, b0, false, false); auto r1_ = __builtin_amdgcn_permlane32_swap(a1, b1, false, false); \
    u32x4 w_ = {r0_[0], r1_[0], r0_[1], r1_[1]}; OUT = __builtin_bit_cast(bf16x8, w_); } while (0)
            PK4(p0, 0, pa[0]); PK4(p0, 8, pa[1]); PK4(p1, 0, pa[2]); PK4(p1, 8, pa[3]);
            const int g16 = (lane >> 4) & 1, qq = (lane & 15) >> 2, pp = lane & 3;
#pragma unroll
            for (int db = 0; db < 2; ++db) {
#pragma unroll
                for (int ks = 0; ks < 4; ++ks) {
                    const LAS char* vp = lds + AA_V + (jt * 64 + ks * 16 + 8 * hi + qq) * AA_PITCH + (db * 32 + 16 * g16 + 4 * pp) * 2;
                    const s16x4 lo = vtr(vp), hh = vtr(vp + 4 * AA_PITCH);
                    const bf16x8 vb = (bf16x8){lo[0], lo[1], lo[2], lo[3], hh[0], hh[1], hh[2], hh[3]};
                    o[db] = __builtin_amdgcn_mfma_f32_32x32x16_bf16(pa[ks], vb, o[db], 0, 0, 0);
                }
            }
            WAIT_L0();
        }
        if (hi == 0) wsf[r32] = 1.f / l_reg;
        WAIT_L0();
        const float g0 = ga[r32], g1 = ga[32 + r32];
#pragma unroll
        for (int r = 0; r < 16; ++r) { const int qrow = crow(r, hi); const float il = wsf[qrow]; const float v0 = o[0][r] * il, v1 = o[1][r] * il;
            const size_t tok = (size_t)(b * SEQ + q0 + qrow);
            bf16_t* yp = Y + tok * 2048 + hq * 64;
            yp[r32] = (bf16_t)(pk_bf16(v0 * g0, 0.f) & 0xffffu); yp[32 + r32] = (bf16_t)(pk_bf16(v1 * g1, 0.f) & 0xffffu);
            float ss = v0 * v0 + v1 * v1;
#pragma unroll
            for (int s = 16; s >= 1; s >>= 1) ss += __shfl_xor(ss, s, 64);
            if (r32 == 0) ssqa[tok * 24 + hq] = ss; }
        WAIT_L0();
    }
}

constexpr int MB_V = 0, MB_KN = 32768, MB_KP = 65536, MB_WS = 81920, MB_QP = 83968;
#define KSWZ(row, colB) ((row) * 256 + ((colB) ^ (((row) & 7) << 4)))
#define KPSWZ(row, colB) ((row) * 128 + ((colB) ^ (((row) & 7) << 4)))
constexpr float MLA_SCALE = 0.07216878364870322f;
constexpr float MLA_THR = 8.f;
__device__ __forceinline__ void mla_partialSM(f32x16& p0, f32x16& p1, float& m_reg, float& mn, float& alpha) {
    constexpr float C = MLA_SCALE * LOG2E;
    float pmax = p0[0];
#pragma unroll
    for (int r = 1; r < 16; ++r) pmax = fmaxf(pmax, p0[r]);
#pragma unroll
    for (int r = 0; r < 16; ++r) pmax = fmaxf(pmax, p1[r]);
    { auto rr = __builtin_amdgcn_permlane32_swap(__float_as_uint(pmax), __float_as_uint(pmax), false, false); pmax = fmaxf(__uint_as_float(rr[0]), __uint_as_float(rr[1])); }
    if (__builtin_expect(__all(pmax - m_reg <= MLA_THR / MLA_SCALE), 1)) { mn = m_reg; alpha = 1.f; }
    else { mn = fmaxf(m_reg, pmax); alpha = __builtin_amdgcn_exp2f((m_reg - mn) * C); m_reg = mn; }
    const float mnC = -mn * C;
#pragma unroll
    for (int r = 0; r < 16; ++r) p0[r] = fmaf(p0[r], C, mnC);
#pragma unroll
    for (int r = 0; r < 16; ++r) p1[r] = fmaf(p1[r], C, mnC);
#pragma unroll
    for (int r = 0; r < 16; ++r) p0[r] = __builtin_amdgcn_exp2f(p0[r]);
}
__device__ __forceinline__ void mla_finishSM(f32x16& p0, f32x16& p1, float alpha, float& l_reg, bf16x8& pa0, bf16x8& pa1, bf16x8& pa2, bf16x8& pa3) {
#pragma unroll
    for (int r = 0; r < 16; ++r) p1[r] = __builtin_amdgcn_exp2f(p1[r]);
    float ps = 0;
#pragma unroll
    for (int r = 0; r < 16; ++r) ps += p0[r];
#pragma unroll
    for (int r = 0; r < 16; ++r) ps += p1[r];
    { auto rr = __builtin_amdgcn_permlane32_swap(__float_as_uint(ps), __float_as_uint(ps), false, false); ps = __uint_as_float(rr[0]) + __uint_as_float(rr[1]); }
    l_reg = l_reg * alpha + ps;
    PK4(p0, 0, pa0); PK4(p0, 8, pa1); PK4(p1, 0, pa2); PK4(p1, 8, pa3);
}
__device__ __forceinline__ void mla_qkt(f32x16& p0, f32x16& p1, const LAS char* Kn, const LAS char* Kp, const bf16x8* qr, const LAS char* qp, int r32, int hi) {
    p0 = f32x16{}; p1 = f32x16{};
#pragma unroll
    for (int d0 = 0; d0 < 8; ++d0) { const int cb = (d0 * 16 + hi * 8) * 2;
        const bf16x8 b0 = *(const LAS bf16x8*)(Kn + KSWZ(r32, cb)); const bf16x8 b1 = *(const LAS bf16x8*)(Kn + KSWZ(32 + r32, cb));
        p0 = __builtin_amdgcn_mfma_f32_32x32x16_bf16(b0, qr[d0], p0, 0, 0, 0); p1 = __builtin_amdgcn_mfma_f32_32x32x16_bf16(b1, qr[d0], p1, 0, 0, 0); }
#pragma unroll
    for (int d0 = 0; d0 < 4; ++d0) { const int cb = (d0 * 16 + hi * 8) * 2;
        const bf16x8 b0 = *(const LAS bf16x8*)(Kp + KPSWZ(r32, cb)); const bf16x8 b1 = *(const LAS bf16x8*)(Kp + KPSWZ(32 + r32, cb));
        const bf16x8 q = *(const LAS bf16x8*)(qp + d0 * 1024);
        p0 = __builtin_amdgcn_mfma_f32_32x32x16_bf16(b0, q, p0, 0, 0, 0); p1 = __builtin_amdgcn_mfma_f32_32x32x16_bf16(b1, q, p1, 0, 0, 0); }
}
__device__ __forceinline__ int v_st(int k, int c) { const int kk = (k & ~0xC) | ((k & 4) << 1) | ((k & 8) >> 1); return ((kk >> 3) * 4 + (c >> 5)) * 512 + ((kk & 7) * 32 + (c & 31)) * 2; }
__device__ __forceinline__ int v_rd_base(int lane) { return ((lane & 3) << 3) | (((lane >> 2) & 3) << 6) | (((lane >> 4) & 1) << 5) | (((lane >> 5) & 1) << 8); }
constexpr int v_rd_off(int d0, int ks, int half) { return d0 * 512 + ks * 4096 + half * 2048; }
template <int D0> __device__ __forceinline__ void mla_pv_one(f32x16& od, const LAS char* vb, bf16x8 pa0, bf16x8 pa1, bf16x8 pa2, bf16x8 pa3) {
    const s16x4 l0 = vtr(vb + v_rd_off(D0, 0, 0)), h0 = vtr(vb + v_rd_off(D0, 0, 1)), l1 = vtr(vb + v_rd_off(D0, 1, 0)), h1 = vtr(vb + v_rd_off(D0, 1, 1));
    const s16x4 l2 = vtr(vb + v_rd_off(D0, 2, 0)), h2 = vtr(vb + v_rd_off(D0, 2, 1)), l3 = vtr(vb + v_rd_off(D0, 3, 0)), h3 = vtr(vb + v_rd_off(D0, 3, 1));
#define PKV(L, H) (bf16x8){L[0], L[1], L[2], L[3], H[0], H[1], H[2], H[3]}
    od = __builtin_amdgcn_mfma_f32_32x32x16_bf16(pa0, PKV(l0, h0), od, 0, 0, 0);
    od = __builtin_amdgcn_mfma_f32_32x32x16_bf16(pa1, PKV(l1, h1), od, 0, 0, 0);
    od = __builtin_amdgcn_mfma_f32_32x32x16_bf16(pa2, PKV(l2, h2), od, 0, 0, 0);
    od = __builtin_amdgcn_mfma_f32_32x32x16_bf16(pa3, PKV(l3, h3), od, 0, 0, 0);
#undef PKV
}
__device__ __forceinline__ void mla_pv(f32x16* o, const LAS char* vb, bf16x8 pa0, bf16x8 pa1, bf16x8 pa2, bf16x8 pa3) {
    mla_pv_one<0>(o[0], vb, pa0, pa1, pa2, pa3); mla_pv_one<1>(o[1], vb, pa0, pa1, pa2, pa3); mla_pv_one<2>(o[2], vb, pa0, pa1, pa2, pa3); mla_pv_one<3>(o[3], vb, pa0, pa1, pa2, pa3);
}
__device__ __forceinline__ void mla_unit(const Params& p, LAS char* lds, int u) {
    const int tid = threadIdx.x, wid = __builtin_amdgcn_readfirstlane(tid >> 6), lane = tid & 63, r32 = lane & 31, hi = lane >> 5;
    const int bh = u >> 4, qb = u & 15, b = bh >> 3, h = bh & 7;
    const bf16_t* QB = (const bf16_t*)(p.ws + WS_QB); const bf16_t* KVB = (const bf16_t*)(p.ws + WS_KVB); const bf16_t* KPE = (const bf16_t*)(p.ws + WS_KPE);
    const bf16_t* Kh = KVB + (size_t)b * SEQ * 2048 + h * 256;
    const bf16_t* Ph = KPE + (size_t)b * SEQ * 64;
    LAS float* wsf = (LAS float*)(lds + MB_WS) + wid * 64; LAS float* li_l = wsf; LAS float* al_l = wsf + 32;
    float m_reg = -1e30f, l_reg = 0; f32x16 o[4] = {}; bf16x8 qr[8];
    LAS char* qp = lds + MB_QP + wid * 4096 + lane * 16;
    { const bf16_t* Qw = QB + ((size_t)(b * SEQ + qb * 256 + wid * 32 + r32)) * 1536 + h * 192 + hi * 8;
#pragma unroll
      for (int d0 = 0; d0 < 8; ++d0) qr[d0] = *(const bf16x8*)(Qw + d0 * 16);
      __syncthreads();
#pragma unroll
      for (int d0 = 0; d0 < 4; ++d0) *(LAS bf16x8*)(qp + d0 * 1024) = *(const bf16x8*)(Qw + (8 + d0) * 16); }
    const int sr = tid >> 4, sc = (tid & 15) * 8, vst0 = v_st(sr, sc), vst1 = v_st(32 + sr, sc);
    const int pr = tid >> 3, pc = (tid & 7) * 8;
    const LAS char* vb0 = lds + MB_V + v_rd_base(lane);
    bf16x8 vs0, vs1, ks0, ks1, kp0;
#define SLOAD(k0) do { vs0 = *(const bf16x8*)(Kh + (size_t)((k0) + sr) * 2048 + 128 + sc); vs1 = *(const bf16x8*)(Kh + (size_t)((k0) + 32 + sr) * 2048 + 128 + sc); \
    ks0 = *(const bf16x8*)(Kh + (size_t)((k0) + sr) * 2048 + sc); ks1 = *(const bf16x8*)(Kh + (size_t)((k0) + 32 + sr) * 2048 + sc); \
    kp0 = *(const bf16x8*)(Ph + (size_t)((k0) + pr) * 64 + pc); } while (0)
#define SWRITE(bb) do { *(LAS bf16x8*)(lds + MB_V + (bb) * 16384 + vst0) = vs0; *(LAS bf16x8*)(lds + MB_V + (bb) * 16384 + vst1) = vs1; \
    *(LAS bf16x8*)(lds + MB_KN + (bb) * 16384 + KSWZ(sr, sc * 2)) = ks0; *(LAS bf16x8*)(lds + MB_KN + (bb) * 16384 + KSWZ(32 + sr, sc * 2)) = ks1; \
    *(LAS bf16x8*)(lds + MB_KP + (bb) * 8192 + KPSWZ(pr, pc * 2)) = kp0; } while (0)
#define RESC(a) do { if (__any((a) < 1.f)) { if (hi == 0) al_l[r32] = (a); WAIT_L0(); \
    _Pragma("unroll") for (int d = 0; d < 4; ++d) _Pragma("unroll") for (int r = 0; r < 16; ++r) o[d][r] *= al_l[crow(r, hi)]; } } while (0)
    f32x16 pA0, pA1, pB0, pB1; float mnA, mnB, alA, alB; bf16x8 pa0, pa1, pa2, pa3; constexpr int NT = SEQ / 64;
    SLOAD(0); SWRITE(0); __syncthreads();
    mla_qkt(pA0, pA1, lds + MB_KN, lds + MB_KP, qr, qp, r32, hi); mla_partialSM(pA0, pA1, m_reg, mnA, alA);
    SLOAD(64); SWRITE(1); __syncthreads();
    for (int j = 1; j + 1 < NT; j += 2) {
        SBAR(); mla_qkt(pB0, pB1, lds + MB_KN + 16384, lds + MB_KP + 8192, qr, qp, r32, hi);
        mla_finishSM(pA0, pA1, alA, l_reg, pa0, pa1, pa2, pa3); SBAR();
        SLOAD((j + 1) * 64); SBAR();
        mla_pv(o, vb0, pa0, pa1, pa2, pa3); mla_partialSM(pB0, pB1, m_reg, mnB, alB);
        __syncthreads(); SWRITE(0);
        RESC(alB); __syncthreads();
        SBAR(); mla_qkt(pA0, pA1, lds + MB_KN, lds + MB_KP, qr, qp, r32, hi);
        mla_finishSM(pB0, pB1, alB, l_reg, pa0, pa1, pa2, pa3); SBAR();
        SLOAD((j + 2) * 64); SBAR();
        mla_pv(o, vb0 + 16384, pa0, pa1, pa2, pa3); mla_partialSM(pA0, pA1, m_reg, mnA, alA);
        __syncthreads(); SWRITE(1);
        RESC(alA); __syncthreads();
    }
    SBAR(); mla_qkt(pB0, pB1, lds + MB_KN + 16384, lds + MB_KP + 8192, qr, qp, r32, hi);
    mla_finishSM(pA0, pA1, alA, l_reg, pa0, pa1, pa2, pa3); SBAR();
    mla_pv(o, vb0, pa0, pa1, pa2, pa3); mla_partialSM(pB0, pB1, m_reg, mnB, alB);
    __syncthreads(); RESC(alB);
    mla_finishSM(pB0, pB1, alB, l_reg, pa0, pa1, pa2, pa3); SBAR();
    mla_pv(o, vb0 + 16384, pa0, pa1, pa2, pa3);
    if (hi == 0) li_l[r32] = l_reg; WAIT_L0();
    bf16_t* Y = (bf16_t*)(p.ws + WS_Y); float* ssqb = (float*)(p.ws + WS_SSQP);
    const float* gb = p.out_norm_b + h * 128;
    float g[4];
#pragma unroll
    for (int d0 = 0; d0 < 4; ++d0) g[d0] = gb[d0 * 32 + r32];
#pragma unroll
    for (int r = 0; r < 16; ++r) { const int orow = crow(r, hi); const float il = __builtin_amdgcn_rcpf(li_l[orow]);
        const size_t tok = (size_t)(b * SEQ + qb * 256 + wid * 32 + orow); bf16_t* yp = Y + tok * 2048 + 1024 + h * 128; float ss = 0.f;
#pragma unroll
        for (int d0 = 0; d0 < 4; ++d0) { const float v = o[d0][r] * il; ss += v * v; yp[d0 * 32 + r32] = (bf16_t)(pk_bf16(v * g[d0], 0.f) & 0xffffu); }
#pragma unroll
        for (int s = 16; s >= 1; s >>= 1) ss += __shfl_xor(ss, s, 64);
        if (r32 == 0) ssqb[tok * 24 + 16 + h] = ss; }
#undef SLOAD
#undef SWRITE
#undef RESC
}

__device__ __forceinline__ void phase_router(const Params& p, LAS char* lds) {
    const int tid = threadIdx.x, wid = __builtin_amdgcn_readfirstlane(tid >> 6), lane = tid & 63;
    const float* x2 = (const float*)(p.ws + WS_X2); const float* wg = (const float*)(p.ws + WS_WRT);
    unsigned char* xn8 = p.ws + WS_XN; unsigned* cnt = (unsigned*)(p.ws + WS_CTL + CTL_CNT);
    int* tokl = (int*)(p.ws + WS_TOKL); int* sel_e = (int*)(p.ws + WS_SEL); int* sel_r = sel_e + NTOK * 4; float* sel_g = (float*)(sel_r + NTOK * 4);
    LAS float* part = (LAS float*)lds;
    LAS float* rsv = (LAS float*)(lds + 32768);
    LAS unsigned* hist = (LAS unsigned*)(lds + 32768 + 128); LAS unsigned* hbase = hist + 32;
    for (int t0 = blockIdx.x * 32; t0 < NTOK; t0 += gridDim.x * 32) {
        __syncthreads();
        if (tid < N_EXP) hist[tid] = 0u;
#pragma unroll 1
        for (int j = 0; j < 4; ++j) { const int t = t0 + 4 * wid + j; f32x4 xr[8]; float ss = 0.f;
#pragma unroll
            for (int i = 0; i < 8; ++i) { xr[i] = ((const f32x4*)(x2 + (size_t)t * D_MODEL))[lane + 64 * i]; ss += xr[i][0] * xr[i][0] + xr[i][1] * xr[i][1] + xr[i][2] * xr[i][2] + xr[i][3] * xr[i][3]; }
            const float rs = rsqrtf(wave_sum(ss) * (1.f / D_MODEL) + EPS);
            if (lane == 0) rsv[4 * wid + j] = rs;
#pragma unroll
            for (int i = 0; i < 8; ++i) { const f32x4 v = xr[i]; const f32x4 g = ((const f32x4*)p.mlp_norm)[lane + 64 * i]; const float s16 = 16.f * rs;
                *(unsigned*)(xn8 + (size_t)t * D_MODEL + 4 * (lane + 64 * i)) = pk4_fp8(s16 * v[0] * g[0], s16 * v[1] * g[1], s16 * v[2] * g[2], s16 * v[3] * g[3]); } }
        { f32x16 acc;
#pragma unroll
          for (int r = 0; r < 16; ++r) acc[r] = 0.f;
          const float* ap = x2 + (size_t)(t0 + (lane & 31)) * D_MODEL + 256 * wid + 4 * (lane >> 5);
          const float* bp = wg + (size_t)(256 * wid + 4 * (lane >> 5)) * N_EXP + (lane & 31);
#pragma unroll 4
          for (int c = 0; c < 32; ++c) { const f32x4 a4 = *(const f32x4*)(ap + 8 * c);
#pragma unroll
              for (int q = 0; q < 4; ++q) acc = __builtin_amdgcn_mfma_f32_32x32x2f32(a4[q], bp[(size_t)(8 * c + q) * N_EXP], acc, 0, 0, 0); }
#pragma unroll
          for (int r = 0; r < 16; ++r) part[wid * 1024 + crow(r, lane >> 5) * 32 + (lane & 31)] = acc[r]; }
        __syncthreads();
        int my_e[4]; unsigned my_lr[4]; float my_g[4];
#pragma unroll
        for (int j = 0; j < 4; ++j) { const int tl = 4 * wid + j;
            float v = -3.0e38f;
            if (lane < 32) { float s = 0.f;
#pragma unroll
                for (int w = 0; w < 8; ++w) s += part[w * 1024 + tl * 32 + lane];
                v = s * rsv[tl] + p.b_router[lane]; }
            float tv[4]; int ti[4];
#pragma unroll
            for (int r = 0; r < 4; ++r) {
                float bv = v; int bi = lane;
#pragma unroll
                for (int o = 32; o >= 1; o >>= 1) { const float ov = __shfl_xor(bv, o, 64); const int oi = __shfl_xor(bi, o, 64); if (ov > bv || (ov == bv && oi < bi)) { bv = ov; bi = oi; } }
                tv[r] = bv; ti[r] = bi; if (lane == bi) v = -3.0e38f;
            }
            const float e0 = 1.f, e1 = __expf(tv[1] - tv[0]), e2 = __expf(tv[2] - tv[0]), e3 = __expf(tv[3] - tv[0]); const float inv = 1.f / (e0 + e1 + e2 + e3);
            const float gts[4] = {e0 * inv, e1 * inv, e2 * inv, e3 * inv};
            my_e[j] = ti[lane & 3]; my_g[j] = gts[lane & 3]; my_lr[j] = 0u;
            if (lane < 4) my_lr[j] = __hip_atomic_fetch_add(hist + my_e[j], 1u, __ATOMIC_RELAXED, __HIP_MEMORY_SCOPE_WORKGROUP);
        }
        __syncthreads();
        if (tid < N_EXP) hbase[tid] = atomicAdd(cnt + tid * 16, hist[tid]);
        __syncthreads();
        if (lane < 4) {
#pragma unroll
            for (int j = 0; j < 4; ++j) { const int t = t0 + 4 * wid + j; const int e = my_e[j]; const unsigned rk = hbase[e] + my_lr[j];
                tokl[e * NTOK + rk] = t; sel_e[t * 4 + lane] = e; sel_r[t * 4 + lane] = (int)rk; sel_g[t * 4 + lane] = my_g[j]; }
        }
    }
}

__device__ __forceinline__ void phase_combine(const Params& p, const LAS int* s_roff) {
    const int tid = threadIdx.x, wid = tid >> 6, lane = tid & 63;
    const float* x2 = (const float*)(p.ws + WS_X2); const bf16_t* ys = (const bf16_t*)(p.ws + WS_YS);
    const int* sel_e = (const int*)(p.ws + WS_SEL); const int* sel_r = sel_e + NTOK * 4; const float* sel_g = (const float*)(sel_r + NTOK * 4);
    for (int t = blockIdx.x * 8 + wid; t < NTOK; t += gridDim.x * 8) {
        f32x4 v[8];
#pragma unroll
        for (int i = 0; i < 8; ++i) v[i] = ((const f32x4*)(x2 + (size_t)t * D_MODEL))[lane + 64 * i];
#pragma unroll
        for (int k = 0; k < 4; ++k) { const int e = sel_e[t * 4 + k]; const size_t slot = (size_t)(s_roff[e] + sel_r[t * 4 + k]); const float g = sel_g[t * 4 + k];
            const u32x2* yr = (const u32x2*)(ys + slot * D_MODEL);
#pragma unroll
            for (int i = 0; i < 8; ++i) { const u32x2 w = yr[lane + 64 * i]; v[i][0] += g * bf_lo(w[0]); v[i][1] += g * bf_hi(w[0]); v[i][2] += g * bf_lo(w[1]); v[i][3] += g * bf_hi(w[1]); } }
        float ss = 0.f;
#pragma unroll
        for (int i = 0; i < 8; ++i) ss += v[i][0] * v[i][0] + v[i][1] * v[i][1] + v[i][2] * v[i][2] + v[i][3] * v[i][3];
        ss = wave_sum(ss); const float rs = rsqrtf(ss * (1.f / D_MODEL) + EPS);
#pragma unroll
        for (int i = 0; i < 8; ++i) { const f32x4 g = ((const f32x4*)p.final_norm)[lane + 64 * i];
            ((f32x4*)(p.out + (size_t)t * D_MODEL))[lane + 64 * i] = (f32x4){v[i][0] * rs * g[0], v[i][1] * rs * g[1], v[i][2] * rs * g[2], v[i][3] * rs * g[3]}; }
    }
}

constexpr int NPHASE = 9;
__global__ void __launch_bounds__(512, 2) mega_fwd(Params p) {
    extern __shared__ __attribute__((aligned(1024))) char smem_raw[];
    LAS char* lds = (LAS char*)smem_raw;
    LAS unsigned* misc = (LAS unsigned*)(lds + LDS_MISC);
    const int tid = threadIdx.x;
    if (tid < 4) misc[tid] = 0u;
    __syncthreads();
    unsigned* bar = (unsigned*)(p.ws + WS_CTL + CTL_BAR);
    XcdBarrier xb = xcd_barrier_post(bar, (volatile LAS unsigned*)misc);
    const int lo = p.ph_lo, hi = p.ph_hi;
    const int G = gridDim.x, bid = blockIdx.x;
    const int xperm = (bid & 7) * (G >> 3) + (bid >> 3);
#ifdef PH_ONLY
#define IN(k) ((k)==PH_ONLY)
#else
#define IN(k) (lo <= (k) && (k) < hi)
#endif
#define SEAM(k) do { if (IN(k) && IN((k) + 1)) xcd_barrier(xb); } while (0)
    if (IN(0)) phase_prologue(p);
    SEAM(0);
    if (IN(1)) {
        for (int u = xperm; u < 32 * 8; u += G) {
            const int pn = u / 32, pm = u % 32;
            PEpiProj ep{pn, pm * 256, p.ws, p.b_q_norm, p.b_kv_norm};
            __syncthreads();
            gemm_unit_pg<false>(lds, (const bf16_t*)(p.ws + WS_XN) + (size_t)pm * 256 * D_MODEL, (const bf16_t*)(p.ws + WS_BT_IN) + (size_t)pn * 256 * D_MODEL, D_MODEL, ep);
        }
    }
    SEAM(1);
    if (IN(2)) {
        { const int b0 = bid;
            int qv;
            if ((b0 & 3) == 0) {
                const int h = b0 >> 2, pn = 8 + (h >> 5), pm = h & 31;
                PEpiProj ep{pn, pm * 256, p.ws, p.b_q_norm, p.b_kv_norm};
                __syncthreads();
                gemm_unit_pg<false>(lds, (const bf16_t*)(p.ws + WS_XN) + (size_t)pm * 256 * D_MODEL, (const bf16_t*)(p.ws + WS_BT_IN) + (size_t)pn * 256 * D_MODEL, D_MODEL, ep);
                qv = 128 + h;
            } else {
                const int v = (b0 >> 2) * 3 + (b0 & 3) - 1;
                if (v < 128) {
                    attn_a_unit(p, lds, v); qv = v;
                    pg_convert(p.w_o, D_MODEL, D_MODEL, D_MODEL, 2048, (bf16_t*)(p.ws + WS_BT_WO), v * 1024 + tid, 128 * 1024);
                    pg_convert(p.w_o, D_MODEL, D_MODEL, D_MODEL, 2048, (bf16_t*)(p.ws + WS_BT_WO), v * 1024 + 512 + tid, 128 * 1024);
                } else {
                    const int w = v - 128; qv = -1;
                    attn_a_unit(p, lds, 128 + 2 * w); attn_a_unit(p, lds, 129 + 2 * w);
                    if (w < 32) pg_convert(p.b_w_ukv, 256, 2048, 2048, 2048, (bf16_t*)(p.ws + WS_BT_UKV), w * 512 + tid, 32 * 512);
                }
            }
            if (qv >= 0) { const int pn = qv / 32, pm = qv % 32;
                PEpiQUp ep{pn, pm * 256, p.ws};
                __syncthreads();
                gemm_unit_pg<false>(lds, (const bf16_t*)(p.ws + WS_CQ) + (size_t)pm * 256 * 512, (const bf16_t*)(p.ws + WS_BT_UQ) + (size_t)pn * 256 * 512, 512, ep);
                __syncthreads(); }
        }
        xcd_barrier(xb);
        for (int u = xperm; u < 32 * 8; u += G) {
            const int pn = u / 32, pm = u % 32;
            PEpiKvUp ep{pn, pm * 256, p.ws};
            __syncthreads();
            gemm_unit_pg<false>(lds, (const bf16_t*)(p.ws + WS_CKV) + (size_t)pm * 256 * 256, (const bf16_t*)(p.ws + WS_BT_UKV) + (size_t)pn * 256 * 256, 256, ep);
        }
    }
    SEAM(2);
    if (IN(3)) { for (int u = xperm; u < 256; u += G) mla_unit(p, lds, u); }
    SEAM(3);
    if (IN(4)) {
        __syncthreads();
        for (int u = xperm; u < 32 * 8; u += G) {
            const int pn = u / 32, pm = u % 32;
            LAS float* tab = (LAS float*)(lds + 2 * G_STAGE_B);
            __syncthreads();
            if (tid < 256) { const f32x4* pp = (const f32x4*)((const float*)(p.ws + WS_SSQP) + (size_t)(pm * 256 + tid) * 24); float sa = 0.f, sb2 = 0.f;
#pragma unroll
                for (int q = 0; q < 4; ++q) { const f32x4 v = pp[q]; sa += (v[0] + v[1]) + (v[2] + v[3]); }
#pragma unroll
                for (int q = 4; q < 6; ++q) { const f32x4 v = pp[q]; sb2 += (v[0] + v[1]) + (v[2] + v[3]); }
                tab[tid] = sa * (1.f / 1024.f); tab[256 + tid] = sb2 * (1.f / 1024.f); }
            __syncthreads();
            PEpiWo ep{pn, pm * 256, p.ws, p.x, tab};
            gemm_unit_pg<true>(lds, (const bf16_t*)(p.ws + WS_Y) + (size_t)pm * 256 * D_MODEL, (const bf16_t*)(p.ws + WS_BT_WO) + (size_t)pn * 256 * D_MODEL, D_MODEL, ep);
        }
    }
    SEAM(4);
    if (IN(5)) phase_router(p, lds);
    SEAM(5);
    LAS int* s_cnt = (LAS int*)(misc + 16); LAS int* s_toff = (LAS int*)(misc + 48); LAS int* s_roff = (LAS int*)(misc + 96);
    if (IN(6) || IN(7) || IN(8)) {
        if (tid == 0) { const unsigned* cnt = (const unsigned*)(p.ws + WS_CTL + CTL_CNT); int to = 0;
            for (int e = 0; e < N_EXP; ++e) { const int c = (int)xb_ld((unsigned*)cnt + e * 16); s_cnt[e] = c; s_toff[e] = to; s_roff[e] = to * 256; to += (c + 255) >> 8; }
            s_toff[N_EXP] = to; }
        __syncthreads();
    }
    if (IN(6)) {
        const int TM = s_toff[N_EXP];
#ifdef PROBE_P6
        for (int rep = 0; rep < 2; ++rep)
#endif
        for (int L = xperm; L < TM * 16; L += G) {
            int e = 0; while (s_toff[e + 1] * 16 <= L) ++e;
            const int w = L - s_toff[e] * 16, nte = s_toff[e + 1] - s_toff[e], ntile = w / nte, mt = w - ntile * nte, cntE = s_cnt[e];
            AGather8 af{p.ws + WS_XN, (const int*)(p.ws + WS_TOKL) + (size_t)e * NTOK, mt * 256, cntE};
            BGateUp bf{p.w_up + (size_t)e * D_MODEL * (2 * D_FF) + ntile * 128, (size_t)(2 * D_FF)};
            EpiUp8 ep{ntile * 128, mt * 256, cntE, p.ws + WS_ACT + ((size_t)s_roff[e] + mt * 256) * D_FF, p.b_up + (size_t)e * (2 * D_FF)};
            gemm_unit8<0x7B7B7B7B>(lds, (LAS unsigned*)(misc + 8), D_MODEL / 64, af, bf, ep);
        }
    }
    SEAM(6);
    if (IN(7)) {
        const int TM = s_toff[N_EXP];
#ifdef PROBE_P7
        for (int rep = 0; rep < 2; ++rep)
#endif
        for (int L = xperm; L < TM * 8; L += G) {
            int e = 0; while (s_toff[e + 1] * 8 <= L) ++e;
            const int w = L - s_toff[e] * 8, nte = s_toff[e + 1] - s_toff[e], ntile = w / nte, mt = w - ntile * nte, cntE = s_cnt[e];
            ARows8 af{p.ws + WS_ACT + ((size_t)s_roff[e] + mt * 256) * D_FF, (unsigned)D_FF};
            BPlain bf{p.w_down + (size_t)e * D_FF * D_MODEL + ntile * 256, (size_t)D_MODEL, 256};
            EpiDown8 ep{ntile * 256, mt * 256, cntE, (bf16_t*)(p.ws + WS_YS) + ((size_t)s_roff[e] + mt * 256) * D_MODEL, p.b_down + (size_t)e * D_MODEL};
            gemm_unit8<0x7D7D7D7D>(lds, (LAS unsigned*)(misc + 8), D_FF / 64, af, bf, ep);
        }
    }
    SEAM(7);
    if (IN(8)) phase_combine(p, s_roff);
}

extern "C" void kernel_launch(void* const* d_in, const int* in_sizes, int n_in, void* d_out, int out_size, void* d_ws, size_t ws_size, hipStream_t stream) {
    static int ready = 0;
    if (!ready) {
        if (hipFuncSetAttribute((const void*)mega_fwd, hipFuncAttributeMaxDynamicSharedMemorySize, LDS_BYTES) != hipSuccess) { fprintf(stderr, "kernel_launch: hipFuncSetAttribute failed\n"); return; }
        int per_cu = 0; hipOccupancyMaxActiveBlocksPerMultiprocessor(&per_cu, (const void*)mega_fwd, 512, LDS_BYTES);
        if (per_cu < 1) { fprintf(stderr, "kernel_launch: occupancy query says 0 blocks per CU\n"); return; }
        ready = 1;
    }
    if (ws_size < WS_END) { fprintf(stderr, "kernel_launch: workspace too small\n"); return; }
    hipMemsetAsync((unsigned char*)d_ws + WS_CTL, 0, CTL_BYTES, stream);
    Params p{};
    const float** f = (const float**)&p;
    for (int i = 0; i < 19; ++i) f[i] = (const float*)d_in[i];
    p.out = (float*)d_out; p.ws = (unsigned char*)d_ws; p.ph_lo = 0; p.ph_hi = NPHASE;
    hipLaunchKernelGGL(mega_fwd, dim3(256), dim3(512), LDS_BYTES, stream, p);
}
```

```cpp
#include <hip/hip_runtime.h>
#include <stdint.h>
#include <stdio.h>

#define LAS __attribute__((address_space(3)))
typedef unsigned short bf16_t;
typedef short bf16x8 __attribute__((ext_vector_type(8)));
typedef short s16x4 __attribute__((ext_vector_type(4)));
typedef short v4i16_t __attribute__((ext_vector_type(4)));
typedef float f32x2 __attribute__((ext_vector_type(2)));
typedef float f32x4 __attribute__((ext_vector_type(4)));
typedef float f32x16 __attribute__((ext_vector_type(16)));
typedef int i32x4 __attribute__((ext_vector_type(4)));
typedef unsigned u32x2 __attribute__((ext_vector_type(2)));
typedef unsigned u32x4 __attribute__((ext_vector_type(4)));
typedef __bf16 bf16x2_t __attribute__((ext_vector_type(2)));
typedef int v8i __attribute__((ext_vector_type(8)));
typedef int v2i __attribute__((ext_vector_type(2)));
typedef short v2s __attribute__((ext_vector_type(2)));

constexpr int D_MODEL = 2048, SEQ = 4096, BATCH = 2, NTOK = BATCH * SEQ;
constexpr int IN_COLS = 2368;
constexpr int N_EXP = 32, TOP_K = 4, D_FF = 2048;
constexpr float EPS = 1e-5f;
constexpr float LOG2E = 1.4426950408889634f;

constexpr size_t MiB = 1u << 20;
constexpr size_t WS_CTL = 0, CTL_BYTES = 1 * MiB;
constexpr size_t WS_XN = 1 * MiB, WS_QA = 33 * MiB, WS_KA = 49 * MiB, WS_VA = 53 * MiB, WS_CQ = 57 * MiB, WS_CKV = 65 * MiB, WS_KPE = 69 * MiB;
constexpr size_t WS_QB = 70 * MiB, WS_KVB = 94 * MiB, WS_Y = 126 * MiB, WS_X2 = 158 * MiB, WS_ROPE = 222 * MiB, WS_WRT = 223 * MiB;
constexpr size_t WS_TOKL = 224 * MiB, WS_SEL = 225 * MiB, WS_ACT = 226 * MiB, WS_YS = 386 * MiB, WS_BT_IN = 546 * MiB, WS_BT_UQ = 558 * MiB, WS_BT_UKV = 560 * MiB, WS_BT_WO = 562 * MiB, WS_SSQ2 = 570 * MiB, WS_END = 571 * MiB;
constexpr size_t WS_SSQP = WS_WRT + 262144;
constexpr size_t WS_SSQC = WS_SSQ2;
constexpr size_t WS_SSQK = WS_SSQ2 + 524288;
constexpr size_t CTL_BAR = 0, CTL_CNT = 16384, CTL_SSQ_CQ = 65536, CTL_SSQ_CKV = 98304, CTL_SSQ_A = 131072, CTL_SSQ_B = 163840, CTL_SSQ_X2 = 196608;

__device__ __forceinline__ unsigned pk_bf16(float lo, float hi) { f32x2 v = {lo, hi}; bf16x2_t b = __builtin_convertvector(v, bf16x2_t); return __builtin_bit_cast(unsigned, b); }
__device__ __forceinline__ unsigned pk4_fp8(float a, float b, float c, float d) { int w = __builtin_amdgcn_cvt_pk_fp8_f32(a, b, 0, false); w = __builtin_amdgcn_cvt_pk_fp8_f32(c, d, w, true); return (unsigned)w; }
__device__ __forceinline__ unsigned pk4_fp8_x64(f32x4 v) { v2s r; asm("" : "=v"(r));
    r = __builtin_amdgcn_cvt_scalef32_pk_fp8_f32(r, v[0], v[1], 0.015625f, false); r = __builtin_amdgcn_cvt_scalef32_pk_fp8_f32(r, v[2], v[3], 0.015625f, true); return __builtin_bit_cast(unsigned, r); }
__device__ __forceinline__ float bf_lo(unsigned u) { return __uint_as_float(u << 16); }
__device__ __forceinline__ float bf_hi(unsigned u) { return __uint_as_float(u & 0xffff0000u); }
__device__ __forceinline__ float wave_sum(float v) {
#pragma unroll
    for (int o = 32; o >= 1; o >>= 1) v += __shfl_xor(v, o, 64);
    return v;
}
__device__ __forceinline__ int crow(int r, int hi) { return (r & 3) + 8 * (r >> 2) + 4 * hi; }
__device__ __forceinline__ s16x4 vtr(const LAS char* p) { return __builtin_bit_cast(s16x4, __builtin_amdgcn_ds_read_tr16_b64_v4i16((LAS v4i16_t*)p)); }
#define SBAR() __builtin_amdgcn_sched_barrier(0)

#define XB_TMO      128
#define XB_XCNT(j)  (256  + 64 * (j))
#define XB_XSUB(j)  (1280 + 64 * (j))
#define XB_XGEN(j)  (2304 + 64 * (j))
#define XB_TOP      3328
#define XB_TOPGEN   3392
#define XCD_BAR_WORDS 3456
#define XB_SPIN_CAP (1u << 18)
__device__ __forceinline__ unsigned xb_ld(unsigned* p)              { return __hip_atomic_load(p, __ATOMIC_RELAXED, __HIP_MEMORY_SCOPE_AGENT); }
__device__ __forceinline__ unsigned xb_add(unsigned* p, unsigned v) { return __hip_atomic_fetch_add(p, v, __ATOMIC_RELAXED, __HIP_MEMORY_SCOPE_AGENT); }
__device__ __forceinline__ unsigned xb_xcc_id() { return (unsigned)__builtin_amdgcn_s_getreg((3 << 11) | 20) & 0xFu; }
#define XB_SPIN(cond, bar) do { unsigned _sp = 0; while (cond) { __builtin_amdgcn_s_sleep(1); \
    if ((++_sp & 255u) == 0u) { if (xb_ld(&(bar)[XB_TMO])) break; if (_sp > XB_SPIN_CAP) { atomicAdd(&(bar)[XB_TMO], 1u); break; } } } } while (0)
struct XcdBarrier { unsigned* bar; unsigned x; volatile LAS unsigned* st; };
__device__ __forceinline__ XcdBarrier xcd_barrier_post(unsigned* bar, volatile LAS unsigned* st) {
    XcdBarrier b; b.bar = bar; b.x = xb_xcc_id(); b.st = st;
    if (threadIdx.x == 0) (void)xb_add(&bar[XB_XCNT(b.x)], 1u);
    return b;
}
__device__ __forceinline__ void xcd_barrier_complete(unsigned* bar, unsigned x, unsigned& nloc, unsigned& nx) {
    const unsigned G = gridDim.x * gridDim.y * gridDim.z;
    unsigned sum, cnt, mine, sp = 0u;
    for (;;) {
        sum = 0u; cnt = 0u; mine = 0u;
#pragma unroll
        for (unsigned j = 0; j < 16; ++j) { const unsigned c = xb_ld(&bar[XB_XCNT(j)]); sum += c; cnt += (c > 0u) ? 1u : 0u; mine = (j == x) ? c : mine; }
        if (sum == G) break;
        __builtin_amdgcn_s_sleep(1);
        if ((++sp & 255u) == 0u) { if (xb_ld(&bar[XB_TMO])) break; if (sp > XB_SPIN_CAP) { atomicAdd(&bar[XB_TMO], 1u); break; } }
    }
    nloc = mine > 0u ? mine : 1u; nx = cnt > 0u ? cnt : 1u;
}
__device__ __forceinline__ void xcd_barrier(const XcdBarrier& b) {
    asm volatile("s_waitcnt vmcnt(0)" ::: "memory");
    __syncthreads();
    if (threadIdx.x == 0) {
        unsigned* bar = b.bar;
        __builtin_amdgcn_s_waitcnt(0);
        unsigned nloc = b.st[0], nx = b.st[1];
        if (nloc == 0u) { xcd_barrier_complete(bar, b.x, nloc, nx); b.st[0] = nloc; b.st[1] = nx; }
        const unsigned old = xb_add(&bar[XB_XSUB(b.x)], 1u);
        const unsigned gen = old / nloc;
        if (old + 1u == (gen + 1u) * nloc) {
            __builtin_amdgcn_fence(__ATOMIC_RELEASE, "agent");
            asm volatile("s_waitcnt vmcnt(0)" ::: "memory");
            const unsigned og = xb_add(&bar[XB_TOP], 1u);
            const unsigned tg = og / nx;
            if (og + 1u == (tg + 1u) * nx) xb_add(&bar[XB_TOPGEN], 1u);
            else XB_SPIN(xb_ld(&bar[XB_TOPGEN]) == tg, bar);
            __builtin_amdgcn_fence(__ATOMIC_ACQUIRE, "agent");
            xb_add(&bar[XB_XGEN(b.x)], 1u);
            asm volatile("s_waitcnt vmcnt(0)" ::: "memory");
        } else {
            XB_SPIN(xb_ld(&bar[XB_XGEN(b.x)]) == gen, bar);
            __builtin_amdgcn_fence(__ATOMIC_ACQUIRE, "agent");
            asm volatile("s_waitcnt vmcnt(0)" ::: "memory");
        }
    }
    __syncthreads();
}

constexpr int A_TILE_B = 256 * 64 * 2;
constexpr int B_PITCH = 544;
constexpr int B_TILE_B = 64 * B_PITCH;
constexpr int G_STAGE_B = A_TILE_B + B_TILE_B;
constexpr int LDS_MISC = 155648;
constexpr int LDS_BYTES = LDS_MISC + 1024;

__device__ __forceinline__ int a_img_byte(int r, int chunk) { return r * 128 + ((chunk ^ ((r >> 1) & 7)) << 4); }
#define WAIT_L0() asm volatile("s_waitcnt lgkmcnt(0)" ::: "memory")
__device__ __forceinline__ void glds16(const void* gsrc, unsigned lds_dst) { unsigned keep;
    asm volatile("s_mov_b32 %0, m0\n\ts_mov_b32 m0, %2\n\ts_nop 0\n\tglobal_load_lds_dwordx4 %1, off\n\ts_mov_b32 m0, %0" : "=&s"(keep) : "v"(gsrc), "s"(lds_dst) : "memory"); }
#define RAW_BARRIER() do { WAIT_L0(); __builtin_amdgcn_s_barrier(); } while (0)

__device__ __forceinline__ const char* uniform_ptr(const void* p) {
    const unsigned long long v = (unsigned long long)p;
    const unsigned lo = __builtin_amdgcn_readfirstlane((unsigned)v), hi = __builtin_amdgcn_readfirstlane((unsigned)(v >> 32));
    return (const char*)(((unsigned long long)hi << 32) | lo);
}
__device__ __forceinline__ void glds16s(const char* sbase, unsigned voff, unsigned lds_dst) { unsigned keep;
    asm volatile("s_mov_b32 %0, m0\n\ts_mov_b32 m0, %3\n\ts_nop 4\n\tglobal_load_lds_dwordx4 %1, %2\n\ts_mov_b32 m0, %0" : "=&s"(keep) : "v"(voff), "s"(sbase), "s"(lds_dst) : "memory"); }
#define WAIT_V4(n, a, b, c, d) asm volatile("s_waitcnt vmcnt(" #n ")" : "+v"(a), "+v"(b), "+v"(c), "+v"(d) :: "memory")
template <bool MID, class AF, class BF, class EPI>
__device__ __forceinline__ void gemm_unit(LAS char* lds, const int nt, const AF& af, const BF& bf, EPI& epi) {
    const int tid = threadIdx.x, wid = __builtin_amdgcn_readfirstlane(tid >> 6), lane = tid & 63, wr = wid >> 2, wc = wid & 3, fr = lane & 15, fq = lane >> 4;
    const char* abase = uniform_ptr(af.base);
    unsigned aoff[4];
#pragma unroll
    for (int i = 0; i < 4; ++i) { const int R = wid * 8 + i * 64 + (lane >> 3), C = ((lane & 7) ^ ((R >> 1) & 7)) * 8; aoff[i] = (af.rowoff(R) + (unsigned)C) * 2u; }
    const int a_ldsw = wid * 1024;
    const unsigned lds_u = (unsigned)__builtin_amdgcn_readfirstlane((int)(unsigned)(size_t)lds);
    const size_t ldb4 = (size_t)bf.ld * 4;
    const char* bbase = uniform_ptr(bf.base) + (size_t)wid * ldb4;
    const unsigned boff = bf.coloff(4 * lane) * 4u;
    const int b_lds0 = A_TILE_B + wid * B_PITCH + 8 * lane, b_lds1 = A_TILE_B + wid * B_PITCH + ((8 * lane) ^ 128);
    const int a_rd0 = a_img_byte(wr * 128 + fr, fq), a_rd1 = a_rd0 ^ 64;
    const int b_rd = A_TILE_B + (8 * fq + ((lane & 15) >> 2)) * B_PITCH + ((wc ^ (fq & 1)) << 7) + 8 * (lane & 3);
    f32x4 acc[8][4];
#pragma unroll
    for (int m = 0; m < 8; ++m)
#pragma unroll
        for (int n = 0; n < 4; ++n) acc[m][n] = (f32x4){0.f, 0.f, 0.f, 0.f};
    f32x4 sb[8];
#define G_STAGE_A(i, kt, buf) glds16s(abase + (size_t)(kt) * 128, aoff[i], lds_u + (unsigned)((buf) * G_STAGE_B + a_ldsw + (i) * 8192))
#define G_ISSUE_B(i, kt) asm volatile("s_nop 4\n\tglobal_load_dwordx4 %0, %1, %2" : "=v"(sb[i]) : "v"(boff), "s"(bbase + ((size_t)(kt) * 64 + (i) * 8) * ldb4) : "memory")
#define G_WRITE_B(i, buf) do { u32x2 w_ = {pk_bf16(sb[i][0], sb[i][1]), pk_bf16(sb[i][2], sb[i][3])}; \
        *(LAS u32x2*)(lds + (buf) * G_STAGE_B + (((i) & 1) ? b_lds1 : b_lds0) + (i) * 8 * B_PITCH) = w_; } while (0)
#define G_KSTEP(buf, ks) do { bf16x8 At[8], Bf[4]; \
        _Pragma("unroll") for (int n = 0; n < 4; ++n) { const s16x4 lo_ = vtr(lds + (buf) * G_STAGE_B + b_rd + (ks) * 32 * B_PITCH + n * 32), hi_ = vtr(lds + (buf) * G_STAGE_B + b_rd + (ks) * 32 * B_PITCH + 4 * B_PITCH + n * 32); \
            Bf[n] = (bf16x8){lo_[0], lo_[1], lo_[2], lo_[3], hi_[0], hi_[1], hi_[2], hi_[3]}; } \
        _Pragma("unroll") for (int m = 0; m < 8; ++m) At[m] = *(const LAS bf16x8*)(lds + (buf) * G_STAGE_B + ((ks) ? a_rd1 : a_rd0) + m * 2048); \
        SBAR(); __builtin_amdgcn_s_setprio(1); \
        _Pragma("unroll") for (int m = 0; m < 8; ++m) _Pragma("unroll") for (int n = 0; n < 4; ++n) \
            acc[m][n] = __builtin_amdgcn_mfma_f32_16x16x32_bf16(Bf[n], At[m], acc[m][n], 0, 0, 0); \
        __builtin_amdgcn_s_setprio(0); SBAR(); } while (0)
#pragma unroll
    for (int i = 0; i < 4; ++i) G_STAGE_A(i, 0, 0);
#pragma unroll
    for (int i = 0; i < 8; ++i) G_ISSUE_B(i, 0);
    WAIT_V4(0, sb[0], sb[1], sb[2], sb[3]); WAIT_V4(0, sb[4], sb[5], sb[6], sb[7]);
#pragma unroll
    for (int i = 0; i < 8; ++i) G_WRITE_B(i, 0);
    SBAR();
#pragma unroll
    for (int i = 0; i < 8; ++i) G_ISSUE_B(i, 1);
    SBAR();
    RAW_BARRIER();
#pragma unroll 1
    for (int t = 0; t < nt; ++t) {
        const int cur = t & 1, nxt = cur ^ 1;
        if constexpr (MID) { if (t == (nt >> 1)) epi.mid(acc, wr, wc, fr, fq); }
        const int k1 = (t + 1 < nt) ? t + 1 : nt - 1, k2 = (t + 2 < nt) ? t + 2 : nt - 1;
        G_STAGE_A(0, k1, nxt); G_STAGE_A(1, k1, nxt); G_STAGE_A(2, k1, nxt); G_STAGE_A(3, k1, nxt);
        G_KSTEP(cur, 0);
        WAIT_V4(8, sb[0], sb[1], sb[2], sb[3]);
        G_WRITE_B(0, nxt); G_WRITE_B(1, nxt); G_WRITE_B(2, nxt); G_WRITE_B(3, nxt); SBAR();
        G_ISSUE_B(0, k2); G_ISSUE_B(1, k2); G_ISSUE_B(2, k2); G_ISSUE_B(3, k2); SBAR();
        G_KSTEP(cur, 1);
        WAIT_V4(8, sb[4], sb[5], sb[6], sb[7]);
        G_WRITE_B(4, nxt); G_WRITE_B(5, nxt); G_WRITE_B(6, nxt); G_WRITE_B(7, nxt); SBAR();
        G_ISSUE_B(4, k2); G_ISSUE_B(5, k2); G_ISSUE_B(6, k2); G_ISSUE_B(7, k2); SBAR();
        asm volatile("s_waitcnt vmcnt(8)" ::: "memory");
        RAW_BARRIER();
    }
    WAIT_V4(0, sb[0], sb[1], sb[2], sb[3]); WAIT_V4(0, sb[4], sb[5], sb[6], sb[7]);
    epi.fin(acc, wr, wc, fr, fq);
#undef G_STAGE_A
#undef G_ISSUE_B
#undef G_WRITE_B
#undef G_KSTEP
}

constexpr int A8_TILE_B = 16384, B8_PITCH = 288, B8_TILE_B = 64 * B8_PITCH;
constexpr int A8_RING = 5, B8_RING = 4, B8_OFF = A8_RING * A8_TILE_B;
static_assert(B8_OFF + B8_RING * B8_TILE_B <= LDS_MISC, "fp8 rings fit below the misc words");
__device__ __forceinline__ v2i vtr8(const LAS char* p) { return __builtin_amdgcn_ds_read_tr8_b64_v2i32((LAS v2i*)p); }
template <int SCALE_X, class AF, class BF, class EPI>
__device__ __forceinline__ void gemm_unit8(LAS char* lds, LAS unsigned* ring_cnt, const int nt, const AF& af, const BF& bf, EPI& epi) {
    const int tid = threadIdx.x, wid = __builtin_amdgcn_readfirstlane(tid >> 6), lane = tid & 63, wr = wid >> 2, wc = wid & 3, r32 = lane & 31, hi = lane >> 5;
    const char* abase = uniform_ptr(af.base);
    unsigned aoff[2];
#pragma unroll
    for (int i = 0; i < 2; ++i) { const int R = wid * 16 + i * 128 + (lane >> 2), C = ((lane & 3) ^ ((lane >> 4) & 3)) * 16; aoff[i] = af.rowoff(R) + (unsigned)C; }
    const unsigned lds_u = (unsigned)__builtin_amdgcn_readfirstlane((int)(unsigned)(size_t)lds) + (unsigned)(wid * 1024);
    const size_t ldb4 = (size_t)bf.ld * 4;
    const char* bbase = uniform_ptr(bf.base) + (size_t)wid * ldb4;
    const unsigned boff = bf.coloff(4 * lane) * 4u;
    const int b_wr = B8_OFF + wid * B8_PITCH + 4 * lane;
    const int a_rd0 = (wr * 128 + r32) * 64 + (((2 * hi) ^ ((r32 >> 2) & 3)) << 4), a_rd1 = a_rd0 ^ 16;
    const int b_rd = B8_OFF + (32 * hi + ((lane & 15) >> 1)) * B8_PITCH + wc * 64 + 16 * ((lane >> 4) & 1) + 8 * (lane & 1);
    f32x16 acc[4][2];
#pragma unroll
    for (int m = 0; m < 4; ++m)
#pragma unroll
        for (int n = 0; n < 2; ++n)
#pragma unroll
            for (int r = 0; r < 16; ++r) acc[m][n][r] = 0.f;
    f32x4 sb[8];
#define H_STAGE_A(i, kt, slot) glds16s(abase + (size_t)(kt) * 64, aoff[i], lds_u + (unsigned)((slot) * A8_TILE_B + (i) * 8192))
#define H_ISSUE_B(i, kt) asm volatile("s_nop 4\n\tglobal_load_dwordx4 %0, %1, %2" : "=v"(sb[i]) : "v"(boff), "s"(bbase + ((size_t)(kt) * 64 + (i) * 8) * ldb4) : "memory")
#define H_WRITE_B(i, slot) *(LAS unsigned*)(lds + (slot) * B8_TILE_B + b_wr + (i) * 8 * B8_PITCH) = pk4_fp8_x64(sb[i])
#define H_KSTEP(sa, sbk) do { v8i Xf[4], Wf[2]; \
        _Pragma("unroll") for (int n = 0; n < 2; ++n) _Pragma("unroll") for (int r = 0; r < 4; ++r) { const v2i t_ = vtr8(lds + (sbk) * B8_TILE_B + b_rd + r * 8 * B8_PITCH + n * 32); Wf[n][2 * r] = t_[0]; Wf[n][2 * r + 1] = t_[1]; } \
        _Pragma("unroll") for (int m = 0; m < 4; ++m) { const i32x4 lo_ = *(const LAS i32x4*)(lds + (sa) * A8_TILE_B + a_rd0 + m * 2048), hi_ = *(const LAS i32x4*)(lds + (sa) * A8_TILE_B + a_rd1 + m * 2048); \
            Xf[m] = (v8i){lo_[0], lo_[1], lo_[2], lo_[3], hi_[0], hi_[1], hi_[2], hi_[3]}; } \
        SBAR(); __builtin_amdgcn_s_setprio(1); \
        _Pragma("unroll") for (int m = 0; m < 4; ++m) _Pragma("unroll") for (int n = 0; n < 2; ++n) \
            acc[m][n] = __builtin_amdgcn_mfma_scale_f32_32x32x64_f8f6f4(Wf[n], Xf[m], acc[m][n], 0, 0, 0, 0x79797979, 0, SCALE_X); \
        __builtin_amdgcn_s_setprio(0); SBAR(); } while (0)
    if (tid < 8) ring_cnt[tid] = 0u;
    H_STAGE_A(0, 0, 0); H_STAGE_A(1, 0, 0); H_STAGE_A(0, 1, 1); H_STAGE_A(1, 1, 1);
#pragma unroll
    for (int i = 0; i < 8; ++i) H_ISSUE_B(i, 0);
    WAIT_V4(0, sb[0], sb[1], sb[2], sb[3]); WAIT_V4(0, sb[4], sb[5], sb[6], sb[7]);
#pragma unroll
    for (int i = 0; i < 8; ++i) H_WRITE_B(i, 0);
    SBAR();
#pragma unroll
    for (int i = 0; i < 8; ++i) H_ISSUE_B(i, 1);
    WAIT_V4(0, sb[0], sb[1], sb[2], sb[3]); WAIT_V4(0, sb[4], sb[5], sb[6], sb[7]);
#pragma unroll
    for (int i = 0; i < 8; ++i) H_WRITE_B(i, 1);
    SBAR();
    H_STAGE_A(0, 2, 2); H_STAGE_A(1, 2, 2);
#pragma unroll
    for (int i = 0; i < 8; ++i) H_ISSUE_B(i, 2);
    SBAR();
    RAW_BARRIER();
    int sa_r = 0, sa_w = 3, sb_r = 0, sb_w = 2;
#pragma unroll 1
    for (int t = 0; t < nt; ++t) {
        if (t >= 2) {
            const unsigned need = (unsigned)(t - 1);
            for (;;) { asm volatile("" ::: "memory"); const unsigned v = *(volatile LAS unsigned*)(ring_cnt + (lane & 7)); if (__all(v >= need)) break; __builtin_amdgcn_s_sleep(1); }
            asm volatile("" ::: "memory");
        }
        const int k3 = (t + 3 < nt) ? t + 3 : nt - 1;
        H_STAGE_A(0, k3, sa_w); H_STAGE_A(1, k3, sa_w);
        H_KSTEP(sa_r, sb_r);
        WAIT_V4(6, sb[0], sb[1], sb[2], sb[3]);
        H_WRITE_B(0, sb_w); H_WRITE_B(1, sb_w); H_WRITE_B(2, sb_w); H_WRITE_B(3, sb_w); SBAR();
        H_ISSUE_B(0, k3); H_ISSUE_B(1, k3); H_ISSUE_B(2, k3); H_ISSUE_B(3, k3); SBAR();
        WAIT_V4(6, sb[4], sb[5], sb[6], sb[7]);
        H_WRITE_B(4, sb_w); H_WRITE_B(5, sb_w); H_WRITE_B(6, sb_w); H_WRITE_B(7, sb_w); SBAR();
        H_ISSUE_B(4, k3); H_ISSUE_B(5, k3); H_ISSUE_B(6, k3); H_ISSUE_B(7, k3); SBAR();
        asm volatile("" ::: "memory");
        if (lane == 0) *(volatile LAS unsigned*)(ring_cnt + wid) = (unsigned)(t + 1);
        asm volatile("" ::: "memory");
        sa_r = (sa_r == A8_RING - 1) ? 0 : sa_r + 1; sa_w = (sa_w == A8_RING - 1) ? 0 : sa_w + 1;
        sb_r = (sb_r == B8_RING - 1) ? 0 : sb_r + 1; sb_w = (sb_w == B8_RING - 1) ? 0 : sb_w + 1;
    }
    WAIT_V4(0, sb[0], sb[1], sb[2], sb[3]); WAIT_V4(0, sb[4], sb[5], sb[6], sb[7]);
    RAW_BARRIER();
    epi.fin(acc, wr, wc, r32, hi);
#undef H_STAGE_A
#undef H_ISSUE_B
#undef H_WRITE_B
#undef H_KSTEP
}

template <int SCALE_X, class AF, class BF, class EPI>
__device__ __forceinline__ void gemm_unit8h(LAS char* lds, LAS unsigned* ring_cnt, const int nt, const AF& af, const BF& bf, EPI& epi) {
    const int tid = threadIdx.x, wid = __builtin_amdgcn_readfirstlane(tid >> 6), lane = tid & 63, wr = wid >> 2, wc = wid & 3, r32 = lane & 31, hi = lane >> 5;
    const char* abase = uniform_ptr(af.base);
    unsigned aoff[2];
#pragma unroll
    for (int i = 0; i < 2; ++i) { const int R = wid * 16 + i * 128 + (lane >> 2), C = ((lane & 3) ^ ((lane >> 4) & 3)) * 16; aoff[i] = af.rowoff(R) + (unsigned)C; }
    const unsigned lds_u = (unsigned)__builtin_amdgcn_readfirstlane((int)(unsigned)(size_t)lds) + (unsigned)(wid * 1024);
    const size_t ldb4 = (size_t)bf.ld * 4;
    const char* bbase = uniform_ptr(bf.base) + (size_t)wid * ldb4;
    const unsigned boff = (unsigned)(lane >> 5) * 8u * (unsigned)ldb4 + bf.coloff(4 * (lane & 31)) * 4u;
    const int b_wr = B8_OFF + (wid + 8 * (lane >> 5)) * B8_PITCH + 4 * (lane & 31);
    const int a_rd0 = (wr * 128 + r32) * 64 + (((2 * hi) ^ ((r32 >> 2) & 3)) << 4), a_rd1 = a_rd0 ^ 16;
    const int b_rd = B8_OFF + (32 * hi + ((lane & 15) >> 1)) * B8_PITCH + wc * 32 + 16 * ((lane >> 4) & 1) + 8 * (lane & 1);
    f32x16 acc[4][1];
#pragma unroll
    for (int m = 0; m < 4; ++m)
#pragma unroll
        for (int n = 0; n < 1; ++n)
#pragma unroll
            for (int r = 0; r < 16; ++r) acc[m][n][r] = 0.f;
    f32x4 sb[4];
#define H_STAGE_A(i, kt, slot) glds16s(abase + (size_t)(kt) * 64, aoff[i], lds_u + (unsigned)((slot) * A8_TILE_B + (i) * 8192))
#define H_ISSUE_B(i, kt) asm volatile("s_nop 4\n\tglobal_load_dwordx4 %0, %1, %2" : "=v"(sb[i]) : "v"(boff), "s"(bbase + ((size_t)(kt) * 64 + (i) * 16) * ldb4) : "memory")
#define H_WRITE_B(i, slot) *(LAS unsigned*)(lds + (slot) * B8_TILE_B + b_wr + (i) * 16 * B8_PITCH) = pk4_fp8_x64(sb[i])
#define H_KSTEP(sa, sbk) do { v8i Xf[4], Wf[1]; \
        _Pragma("unroll") for (int n = 0; n < 1; ++n) _Pragma("unroll") for (int r = 0; r < 4; ++r) { const v2i t_ = vtr8(lds + (sbk) * B8_TILE_B + b_rd + r * 8 * B8_PITCH + n * 32); Wf[n][2 * r] = t_[0]; Wf[n][2 * r + 1] = t_[1]; } \
        _Pragma("unroll") for (int m = 0; m < 4; ++m) { const i32x4 lo_ = *(const LAS i32x4*)(lds + (sa) * A8_TILE_B + a_rd0 + m * 2048), hi_ = *(const LAS i32x4*)(lds + (sa) * A8_TILE_B + a_rd1 + m * 2048); \
            Xf[m] = (v8i){lo_[0], lo_[1], lo_[2], lo_[3], hi_[0], hi_[1], hi_[2], hi_[3]}; } \
        SBAR(); __builtin_amdgcn_s_setprio(1); \
        _Pragma("unroll") for (int m = 0; m < 4; ++m) _Pragma("unroll") for (int n = 0; n < 1; ++n) \
            acc[m][n] = __builtin_amdgcn_mfma_scale_f32_32x32x64_f8f6f4(Wf[n], Xf[m], acc[m][n], 0, 0, 0, 0x79797979, 0, SCALE_X); \
        __builtin_amdgcn_s_setprio(0); SBAR(); } while (0)
    if (tid < 8) ring_cnt[tid] = 0u;
    H_STAGE_A(0, 0, 0); H_STAGE_A(1, 0, 0); H_STAGE_A(0, 1, 1); H_STAGE_A(1, 1, 1);
#pragma unroll
    for (int i = 0; i < 4; ++i) H_ISSUE_B(i, 0);
    WAIT_V4(0, sb[0], sb[1], sb[2], sb[3]);
#pragma unroll
    for (int i = 0; i < 4; ++i) H_WRITE_B(i, 0);
    SBAR();
#pragma unroll
    for (int i = 0; i < 4; ++i) H_ISSUE_B(i, 1);
    WAIT_V4(0, sb[0], sb[1], sb[2], sb[3]);
#pragma unroll
    for (int i = 0; i < 4; ++i) H_WRITE_B(i, 1);
    SBAR();
    H_STAGE_A(0, 2, 2); H_STAGE_A(1, 2, 2);
#pragma unroll
    for (int i = 0; i < 4; ++i) H_ISSUE_B(i, 2);
    SBAR();
    RAW_BARRIER();
    int sa_r = 0, sa_w = 3, sb_r = 0, sb_w = 2;
#pragma unroll 1
    for (int t = 0; t < nt; ++t) {
        if (t >= 2) {
            const unsigned need = (unsigned)(t - 1);
            for (;;) { asm volatile("" ::: "memory"); const unsigned v = *(volatile LAS unsigned*)(ring_cnt + (lane & 7)); if (__all(v >= need)) break; __builtin_amdgcn_s_sleep(1); }
            asm volatile("" ::: "memory");
        }
        const int k3 = (t + 3 < nt) ? t + 3 : nt - 1;
        H_STAGE_A(0, k3, sa_w); H_STAGE_A(1, k3, sa_w);
        H_KSTEP(sa_r, sb_r);
        WAIT_V4(2, sb[0], sb[1], sb[2], sb[3]);
        H_WRITE_B(0, sb_w); H_WRITE_B(1, sb_w); H_WRITE_B(2, sb_w); H_WRITE_B(3, sb_w); SBAR();
        H_ISSUE_B(0, k3); H_ISSUE_B(1, k3); H_ISSUE_B(2, k3); H_ISSUE_B(3, k3); SBAR();
        asm volatile("" ::: "memory");
        if (lane == 0) *(volatile LAS unsigned*)(ring_cnt + wid) = (unsigned)(t + 1);
        asm volatile("" ::: "memory");
        sa_r = (sa_r == A8_RING - 1) ? 0 : sa_r + 1; sa_w = (sa_w == A8_RING - 1) ? 0 : sa_w + 1;
        sb_r = (sb_r == B8_RING - 1) ? 0 : sb_r + 1; sb_w = (sb_w == B8_RING - 1) ? 0 : sb_w + 1;
    }
    WAIT_V4(0, sb[0], sb[1], sb[2], sb[3]);
    RAW_BARRIER();
    epi.fin(acc, wr, wc, r32, hi);
#undef H_STAGE_A
#undef H_ISSUE_B
#undef H_WRITE_B
#undef H_KSTEP
}

struct Params {
    const float *x, *attn_norm, *w_in, *a_sink, *b_q_norm, *b_w_uq, *b_kv_norm, *b_w_ukv, *out_norm_a, *out_norm_b, *w_o, *mlp_norm, *w_router, *b_router,
        *w_up, *b_up, *w_down, *b_down, *final_norm;
    float* out; unsigned char* ws; int ph_lo, ph_hi;
};

struct ARows { const bf16_t* base; unsigned ld; __device__ __forceinline__ unsigned rowoff(int r) const { return (unsigned)r * ld; } };
struct AGather { const bf16_t* base; const int* tokl; int r0, cnt; __device__ __forceinline__ unsigned rowoff(int r) const { int rk = r0 + r; rk = rk < cnt ? rk : 0; return (unsigned)tokl[rk] * (unsigned)D_MODEL; } };
struct ARows8 { const unsigned char* base; unsigned ld; __device__ __forceinline__ unsigned rowoff(int r) const { return (unsigned)r * ld; } };
struct AGather8 { const unsigned char* base; const int* tokl; int r0, cnt; __device__ __forceinline__ unsigned rowoff(int r) const { int rk = r0 + r; rk = rk < cnt ? rk : 0; return (unsigned)tokl[rk] * (unsigned)D_MODEL; } };
struct BPlain { const float* base; size_t ld; int ncols;
    __device__ __forceinline__ unsigned coloff(int c) const { return (unsigned)(c < ncols ? c : (c & (ncols - 1))); } };
struct BGateUp { const float* base; size_t ld;
    __device__ __forceinline__ unsigned coloff(int c) const { const int wc = c >> 6, w = c & 63; return (unsigned)(wc * 32 + (w & 31) + ((w & 32) ? D_FF : 0)); } };

struct EpiProj {
    int pn, brow; unsigned char* ws; const float *qg, *kvg;
    __device__ __forceinline__ void mid(f32x4 (&)[8][4], int, int, int, int) {}
    __device__ __forceinline__ void fin(f32x4 (&acc)[8][4], int wr, int wc, int fr, int fq) {
        if (pn < 6) {
            bf16_t* dst; int ldd, c0;
            if (pn < 4) { dst = (bf16_t*)(ws + WS_QA); ldd = 1024; c0 = pn * 256; } else if (pn == 4) { dst = (bf16_t*)(ws + WS_KA); ldd = 256; c0 = 0; } else { dst = (bf16_t*)(ws + WS_VA); ldd = 256; c0 = 0; }
#pragma unroll
            for (int m = 0; m < 8; ++m) { const int row = brow + wr * 128 + m * 16 + fr;
#pragma unroll
                for (int n = 0; n < 4; ++n) { const int col = c0 + wc * 64 + n * 16 + fq * 4; const f32x4 v = acc[m][n];
                    *(u32x2*)(dst + (size_t)row * ldd + col) = (u32x2){pk_bf16(v[0], v[1]), pk_bf16(v[2], v[3])}; } }
        } else if (pn < 9) {
            bf16_t* dst; int ldd, c0; const float* g; float* ssq; int nsl, sl;
            if (pn < 8) { dst = (bf16_t*)(ws + WS_CQ); ldd = 512; c0 = (pn - 6) * 256; g = qg; ssq = (float*)(ws + WS_SSQC); nsl = 8; sl = (pn - 6) * 4 + wc; }
            else { dst = (bf16_t*)(ws + WS_CKV); ldd = 256; c0 = 0; g = kvg; ssq = (float*)(ws + WS_SSQK); nsl = 4; sl = wc; }
            f32x4 gvv[4];
#pragma unroll
            for (int n = 0; n < 4; ++n) gvv[n] = *(const f32x4*)(g + c0 + wc * 64 + n * 16 + fq * 4);
#pragma unroll
            for (int m = 0; m < 8; ++m) { const int row = brow + wr * 128 + m * 16 + fr; float ss = 0.f;
#pragma unroll
                for (int n = 0; n < 4; ++n) { const int col = c0 + wc * 64 + n * 16 + fq * 4; const f32x4 v = acc[m][n]; const f32x4 gv = gvv[n];
                    ss += v[0] * v[0] + v[1] * v[1] + v[2] * v[2] + v[3] * v[3];
                    *(u32x2*)(dst + (size_t)row * ldd + col) = (u32x2){pk_bf16(v[0] * gv[0], v[1] * gv[1]), pk_bf16(v[2] * gv[2], v[3] * gv[3])}; }
                ss += __shfl_xor(ss, 16, 64); ss += __shfl_xor(ss, 32, 64);
                if (fq == 0) ssq[(size_t)row * nsl + sl] = ss; }
        } else {
            if (wc == 0) {
                bf16_t* dst = (bf16_t*)(ws + WS_KPE); const float* rope = (const float*)(ws + WS_ROPE);
#pragma unroll
                for (int m = 0; m < 8; ++m) { const int row = brow + wr * 128 + m * 16 + fr; const int pos = row & (SEQ - 1);
#pragma unroll
                    for (int n = 0; n < 2; ++n) { const int i0 = n * 16 + fq * 4; const f32x4 x1 = acc[m][n], x2 = acc[m][n + 2];
                        const f32x4 cs0 = *(const f32x4*)(rope + ((size_t)pos * 32 + i0) * 2), cs1 = *(const f32x4*)(rope + ((size_t)pos * 32 + i0) * 2 + 4);
                        const float c[4] = {cs0[0], cs0[2], cs1[0], cs1[2]}, s[4] = {cs0[1], cs0[3], cs1[1], cs1[3]};
                        float o1[4], o2[4];
#pragma unroll
                        for (int j = 0; j < 4; ++j) { o1[j] = x1[j] * c[j] - x2[j] * s[j]; o2[j] = x1[j] * s[j] + x2[j] * c[j]; }
                        *(u32x2*)(dst + (size_t)row * 64 + i0) = (u32x2){pk_bf16(o1[0], o1[1]), pk_bf16(o1[2], o1[3])};
                        *(u32x2*)(dst + (size_t)row * 64 + 32 + i0) = (u32x2){pk_bf16(o2[0], o2[1]), pk_bf16(o2[2], o2[3])}; } }
            }
        }
    }
};
struct EpiQUp {
    int pn, brow; unsigned char* ws;
    __device__ __forceinline__ void mid(f32x4 (&)[8][4], int, int, int, int) {}
    __device__ __forceinline__ void fin(f32x4 (&acc)[8][4], int wr, int wc, int fr, int fq) {
        bf16_t* dst = (bf16_t*)(ws + WS_QB); const float* rope = (const float*)(ws + WS_ROPE); const float* ssq = (const float*)(ws + WS_CTL + CTL_SSQ_CQ);
        const int seg = pn * 4 + wc, head = seg / 3, part = seg - head * 3;
        float sq[8];
#pragma unroll
        for (int m = 0; m < 8; ++m) { const f32x4* pp = (const f32x4*)((const float*)(ws + WS_SSQC) + (size_t)(brow + wr * 128 + m * 16 + fr) * 8); const f32x4 p0 = pp[0], p1 = pp[1];
            sq[m] = ((p0[0] + p0[1]) + (p0[2] + p0[3])) + ((p1[0] + p1[1]) + (p1[2] + p1[3])); }
#pragma unroll
        for (int m = 0; m < 8; ++m) { const int row = brow + wr * 128 + m * 16 + fr; const float rs = rsqrtf(sq[m] * (1.f / 512.f) + EPS);
            bf16_t* drow = dst + (size_t)row * 1536 + head * 192 + part * 64;
            if (part < 2) {
#pragma unroll
                for (int n = 0; n < 4; ++n) { const f32x4 v = acc[m][n]; *(u32x2*)(drow + n * 16 + fq * 4) = (u32x2){pk_bf16(v[0] * rs, v[1] * rs), pk_bf16(v[2] * rs, v[3] * rs)}; }
            } else { const int pos = row & (SEQ - 1);
#pragma unroll
                for (int n = 0; n < 2; ++n) { const int i0 = n * 16 + fq * 4; const f32x4 x1 = acc[m][n], x2 = acc[m][n + 2];
                    const f32x4 cs0 = *(const f32x4*)(rope + ((size_t)pos * 32 + i0) * 2), cs1 = *(const f32x4*)(rope + ((size_t)pos * 32 + i0) * 2 + 4);
                    const float c[4] = {cs0[0], cs0[2], cs1[0], cs1[2]}, s[4] = {cs0[1], cs0[3], cs1[1], cs1[3]};
                    float o1[4], o2[4];
#pragma unroll
                    for (int j = 0; j < 4; ++j) { o1[j] = (x1[j] * c[j] - x2[j] * s[j]) * rs; o2[j] = (x1[j] * s[j] + x2[j] * c[j]) * rs; }
                    *(u32x2*)(drow + i0) = (u32x2){pk_bf16(o1[0], o1[1]), pk_bf16(o1[2], o1[3])};
                    *(u32x2*)(drow + 32 + i0) = (u32x2){pk_bf16(o2[0], o2[1]), pk_bf16(o2[2], o2[3])}; } }
        }
    }
};
struct EpiKvUp {
    int pn, brow; unsigned char* ws;
    __device__ __forceinline__ void mid(f32x4 (&)[8][4], int, int, int, int) {}
    __device__ __forceinline__ void fin(f32x4 (&acc)[8][4], int wr, int wc, int fr, int fq) {
        bf16_t* dst = (bf16_t*)(ws + WS_KVB);
        float sq[8];
#pragma unroll
        for (int m = 0; m < 8; ++m) { const f32x4 p0 = *(const f32x4*)((const float*)(ws + WS_SSQK) + (size_t)(brow + wr * 128 + m * 16 + fr) * 4); sq[m] = (p0[0] + p0[1]) + (p0[2] + p0[3]); }
#pragma unroll
        for (int m = 0; m < 8; ++m) { const int row = brow + wr * 128 + m * 16 + fr; const float rs = rsqrtf(sq[m] * (1.f / 256.f) + EPS);
#pragma unroll
            for (int n = 0; n < 4; ++n) { const int col = pn * 256 + wc * 64 + n * 16 + fq * 4; const f32x4 v = acc[m][n];
                *(u32x2*)(dst + (size_t)row * 2048 + col) = (u32x2){pk_bf16(v[0] * rs, v[1] * rs), pk_bf16(v[2] * rs, v[3] * rs)}; } }
    }
};
struct EpiWo {
    int pn, brow; unsigned char* ws; const float* x; const LAS float* tab;
    __device__ __forceinline__ void mid(f32x4 (&acc)[8][4], int wr, int wc, int fr, int fq) {
#pragma unroll
        for (int m = 0; m < 8; ++m) { const int r = wr * 128 + m * 16 + fr;
            const float f = __builtin_amdgcn_sqrtf((tab[256 + r] + EPS) * __builtin_amdgcn_rcpf(tab[r] + EPS));
#pragma unroll
            for (int n = 0; n < 4; ++n) acc[m][n] *= f;
            SBAR(); }
    }
    __device__ __forceinline__ void fin(f32x4 (&acc)[8][4], int wr, int wc, int fr, int fq) {
        float* x2 = (float*)(ws + WS_X2);
#pragma unroll
        for (int m = 0; m < 8; ++m) { const int r = wr * 128 + m * 16 + fr, row = brow + r; const float rbm = rsqrtf(tab[256 + r] + EPS); f32x4 xv[4];
#pragma unroll
            for (int n = 0; n < 4; ++n) xv[n] = *(const f32x4*)(x + (size_t)row * D_MODEL + pn * 256 + wc * 64 + n * 16 + fq * 4);
#pragma unroll
            for (int n = 0; n < 4; ++n) { const int col = pn * 256 + wc * 64 + n * 16 + fq * 4;
                const f32x4 v = acc[m][n] * rbm + xv[n];
                *(f32x4*)(x2 + (size_t)row * D_MODEL + col) = v; } }
    }
};
struct EpiUp8 {
    int j0, r0, cnt; unsigned char* dst; const float* bias;
    __device__ __forceinline__ void fin(f32x16 (&acc)[4][2], int wr, int wc, int r32, int hi) {
        f32x4 bg[4], bu[4];
#pragma unroll
        for (int rg = 0; rg < 4; ++rg) { const int j = j0 + wc * 32 + 8 * rg + 4 * hi; bg[rg] = *(const f32x4*)(bias + j); bu[rg] = *(const f32x4*)(bias + D_FF + j); }
#pragma unroll
        for (int m = 0; m < 4; ++m) { const int r = wr * 128 + m * 32 + r32; unsigned o8[4];
#pragma unroll
            for (int rg = 0; rg < 4; ++rg) { float o[4];
#pragma unroll
                for (int q = 0; q < 4; ++q) { const float g = fminf(acc[m][0][4 * rg + q] + bg[rg][q], 7.f), u = fminf(fmaxf(acc[m][1][4 * rg + q] + bu[rg][q], -7.f), 7.f);
                    const float sg = __builtin_amdgcn_rcpf(1.f + __builtin_amdgcn_exp2f(-1.702f * LOG2E * g)); o[q] = 4.f * (u + 1.f) * (g * sg); }
                o8[rg] = pk4_fp8(o[0], o[1], o[2], o[3]); }
            if (r0 + r < cnt) {
#pragma unroll
                for (int rg = 0; rg < 4; ++rg) *(unsigned*)(dst + (size_t)r * D_FF + j0 + wc * 32 + 8 * rg + 4 * hi) = o8[rg]; }
        }
    }
};
struct EpiDown8 {
    int c0, r0, cnt; bf16_t* dst; const float* bias;
    __device__ __forceinline__ void fin(f32x16 (&acc)[4][2], int wr, int wc, int r32, int hi) {
        f32x4 b[2][4];
#pragma unroll
        for (int n = 0; n < 2; ++n)
#pragma unroll
            for (int rg = 0; rg < 4; ++rg) b[n][rg] = *(const f32x4*)(bias + c0 + wc * 64 + n * 32 + 8 * rg + 4 * hi);
#pragma unroll
        for (int m = 0; m < 4; ++m) { const int r = wr * 128 + m * 32 + r32;
            if (r0 + r < cnt) {
#pragma unroll
                for (int n = 0; n < 2; ++n)
#pragma unroll
                    for (int rg = 0; rg < 4; ++rg) { const int col = c0 + wc * 64 + n * 32 + 8 * rg + 4 * hi;
                        *(u32x2*)(dst + (size_t)r * D_MODEL + col) = (u32x2){pk_bf16(acc[m][n][4 * rg] + b[n][rg][0], acc[m][n][4 * rg + 1] + b[n][rg][1]), pk_bf16(acc[m][n][4 * rg + 2] + b[n][rg][2], acc[m][n][4 * rg + 3] + b[n][rg][3])}; } }
        }
    }
};
struct EpiDown8h {
    int c0, r0, cnt; bf16_t* dst; const float* bias;
    __device__ __forceinline__ void fin(f32x16 (&acc)[4][1], int wr, int wc, int r32, int hi) {
        f32x4 b[1][4];
#pragma unroll
        for (int n = 0; n < 1; ++n)
#pragma unroll
            for (int rg = 0; rg < 4; ++rg) b[n][rg] = *(const f32x4*)(bias + c0 + wc * 32 + n * 32 + 8 * rg + 4 * hi);
#pragma unroll
        for (int m = 0; m < 4; ++m) { const int r = wr * 128 + m * 32 + r32;
            if (r0 + r < cnt) {
#pragma unroll
                for (int n = 0; n < 1; ++n)
#pragma unroll
                    for (int rg = 0; rg < 4; ++rg) { const int col = c0 + wc * 32 + n * 32 + 8 * rg + 4 * hi;
                        *(u32x2*)(dst + (size_t)r * D_MODEL + col) = (u32x2){pk_bf16(acc[m][n][4 * rg] + b[n][rg][0], acc[m][n][4 * rg + 1] + b[n][rg][1]), pk_bf16(acc[m][n][4 * rg + 2] + b[n][rg][2], acc[m][n][4 * rg + 3] + b[n][rg][3])}; } }
        }
    }
};

constexpr int PG_HTB = 128 * 64 * 2;
__host__ __device__ __forceinline__ int pg_lds_byte(int r, int c) { const int st = (r >> 4) * 2 + (c >> 5), rr = r & 15, cc = c & 31, ob = rr * 64 + cc * 2; return st * 1024 + (ob ^ (((ob >> 9) & 1) << 5)); }
__host__ __device__ __forceinline__ void pg_stage_rc(int b, int& R, int& C) { const int st = b / 1024, sb = b % 1024, swz = sb ^ (((sb >> 9) & 1) << 5); R = (st >> 1) * 16 + swz / 64; C = (st & 1) * 32 + (swz % 64) / 2; }
__host__ __device__ __forceinline__ int pg_tcol(int rho) { return (rho & ~0x30) | ((rho & 0x10) << 1) | ((rho & 0x20) >> 1); }
template <bool MID, class EPI>
__device__ __forceinline__ void gemm_unit_pg(LAS char* lds, const bf16_t* A, const bf16_t* Bt, const int K, EPI& E) {
    const int tid = threadIdx.x, wid = __builtin_amdgcn_readfirstlane(tid >> 6), lane = tid & 63, wr = wid >> 2, wc = wid & 3, fr = lane & 15, fq = lane >> 4;
    const int nt = K / 64;
    unsigned voff[2];
#pragma unroll
    for (int i = 0; i < 2; ++i) { int R, C; pg_stage_rc(tid * 16 + i * 8192, R, C); voff[i] = (unsigned)(R * K + C) * 2u; }
    const size_t kstep = (size_t)(64 * 2), hstep = (size_t)128 * K * 2;
    const unsigned ldsw = (unsigned)wid * 1024u;
    const int aoff = pg_lds_byte(wr * 64 + fr, fq * 8), boff = pg_lds_byte(wc * 32 + fr, fq * 8);
#define PG_SA(b, h) (((b) * 2 + (h)) * PG_HTB)
#define PG_SB(b, h) ((4 + (b) * 2 + (h)) * PG_HTB)
#define PG_STAGE(bufoff, gbase) do { _Pragma("unroll") for (int _i = 0; _i < 2; ++_i) \
        __builtin_amdgcn_global_load_lds((const unsigned*)((const char*)(gbase) + voff[_i]), (LAS unsigned*)(lds + (bufoff) + ldsw + _i * 8192), 16, 0, 0); } while (0)
#define PG_LDA(dst, b, h) do { _Pragma("unroll") for (int m = 0; m < 4; ++m) _Pragma("unroll") for (int k = 0; k < 2; ++k) dst[m][k] = *(const LAS bf16x8*)(lds + PG_SA(b, h) + aoff + m * 2048 + k * 1024); } while (0)
#define PG_LDB(dst, b, h) do { _Pragma("unroll") for (int n = 0; n < 2; ++n) _Pragma("unroll") for (int k = 0; k < 2; ++k) dst[n][k] = *(const LAS bf16x8*)(lds + PG_SB(b, h) + boff + n * 2048 + k * 1024); } while (0)
#define PG_MMA(ai, bj, At_, Bt_) do { __builtin_amdgcn_s_setprio(1); _Pragma("unroll") for (int m = 0; m < 4; ++m) _Pragma("unroll") for (int n = 0; n < 2; ++n) _Pragma("unroll") for (int k = 0; k < 2; ++k) \
        acc[ai][bj][m][n] = __builtin_amdgcn_mfma_f32_16x16x32_bf16(Bt_[n][k], At_[m][k], acc[ai][bj][m][n], 0, 0, 0); __builtin_amdgcn_s_setprio(0); } while (0)
#define PG_WAIT_V(n) asm volatile("s_waitcnt vmcnt(" #n ")" ::: "memory")
#define PG_WAIT_L(n) asm volatile("s_waitcnt lgkmcnt(" #n ")" ::: "memory")
#define PG_BAR __builtin_amdgcn_s_barrier()
    f32x4 acc[2][2][4][2];
#pragma unroll
    for (int a = 0; a < 2; ++a)
#pragma unroll
        for (int b = 0; b < 2; ++b)
#pragma unroll
            for (int m = 0; m < 4; ++m)
#pragma unroll
                for (int n = 0; n < 2; ++n) acc[a][b][m][n] = (f32x4){0.f, 0.f, 0.f, 0.f};
    bf16x8 At[4][2], B0[2][2], B1[2][2];
    const char* cA = (const char*)A; const char* cB = (const char*)Bt;
    PG_STAGE(PG_SB(0, 0), cB); PG_STAGE(PG_SA(0, 0), cA); PG_STAGE(PG_SB(0, 1), cB + hstep); PG_STAGE(PG_SA(0, 1), cA + hstep);
    if (wr == 1) PG_BAR;
    PG_WAIT_V(4); PG_BAR;
    PG_STAGE(PG_SB(1, 0), cB + kstep); PG_STAGE(PG_SA(1, 0), cA + kstep); PG_STAGE(PG_SB(1, 1), cB + hstep + kstep);
    PG_WAIT_V(6); PG_BAR;
    for (int t = 0; t < nt; t += 2) {
        const bool last = (t == nt - 2);
        const char* a1 = cA + (size_t)(t + 1) * kstep;
        const char* a2 = cA + (size_t)(t + 2) * kstep; const char* b2 = cB + (size_t)(t + 2) * kstep;
        const char* a3 = a2 + kstep; const char* b3 = b2 + kstep;
        if (MID && t == (nt >> 1)) E.mid(acc, wr, wc, fr, fq);
        PG_LDB(B0, 0, 0); SBAR(); PG_LDA(At, 0, 0); PG_STAGE(PG_SA(1, 1), a1 + hstep);
        PG_WAIT_L(8); PG_BAR; PG_WAIT_L(0); PG_MMA(0, 0, At, B0); PG_BAR; SBAR();
        PG_LDB(B1, 0, 1); if (!last) PG_STAGE(PG_SB(0, 0), b2);
        PG_BAR; PG_WAIT_L(0); PG_MMA(0, 1, At, B1); PG_BAR;
        PG_LDA(At, 0, 1); if (!last) PG_STAGE(PG_SA(0, 0), a2);
        PG_BAR; PG_WAIT_L(0); PG_MMA(1, 0, At, B0); PG_BAR; SBAR();
        if (!last) { PG_STAGE(PG_SB(0, 1), b2 + hstep); PG_WAIT_V(6); } else PG_WAIT_V(0);
        PG_BAR; PG_MMA(1, 1, At, B1); PG_BAR;
        PG_LDB(B0, 1, 0); SBAR(); PG_LDA(At, 1, 0); if (!last) PG_STAGE(PG_SA(0, 1), a2 + hstep);
        PG_WAIT_L(8); PG_BAR; PG_WAIT_L(0); PG_MMA(0, 0, At, B0); PG_BAR; SBAR();
        PG_LDB(B1, 1, 1); if (!last) PG_STAGE(PG_SB(1, 0), b3);
        PG_BAR; PG_WAIT_L(0); PG_MMA(0, 1, At, B1); PG_BAR;
        PG_LDA(At, 1, 1); if (!last) PG_STAGE(PG_SA(1, 0), a3);
        PG_BAR; PG_WAIT_L(0); PG_MMA(1, 0, At, B0); PG_BAR; SBAR();
        if (!last) { PG_STAGE(PG_SB(1, 1), b3 + hstep); PG_WAIT_V(6); }
        PG_BAR; PG_MMA(1, 1, At, B1); PG_BAR;
    }
    E.fin(acc, wr, wc, fr, fq);
    PG_WAIT_V(0);
    if (wr == 0) PG_BAR;
    PG_BAR;
#undef PG_SA
#undef PG_SB
#undef PG_STAGE
#undef PG_LDA
#undef PG_LDB
#undef PG_MMA
#undef PG_WAIT_V
#undef PG_WAIT_L
#undef PG_BAR
}

#define PG_ROW(ai, m) (128 * (ai) + 64 * wr + 16 * (m) + fr)
#define PG_COL(bj, n) (128 * (bj) + 64 * (wc >> 1) + 32 * (n) + 16 * (wc & 1) + 4 * fq)
struct PEpiProj {
    int pn, brow; unsigned char* ws; const float *qg, *kvg;
    __device__ __forceinline__ void mid(f32x4 (&)[2][2][4][2], int, int, int, int) {}
    __device__ __forceinline__ void fin(f32x4 (&acc)[2][2][4][2], int wr, int wc, int fr, int fq) {
        if (pn < 6) {
            bf16_t* dst; int ldd, c0;
            if (pn < 4) { dst = (bf16_t*)(ws + WS_QA); ldd = 1024; c0 = pn * 256; } else if (pn == 4) { dst = (bf16_t*)(ws + WS_KA); ldd = 256; c0 = 0; } else { dst = (bf16_t*)(ws + WS_VA); ldd = 256; c0 = 0; }
#pragma unroll
            for (int ai = 0; ai < 2; ++ai)
#pragma unroll
                for (int m = 0; m < 4; ++m) { bf16_t* rowp = dst + (size_t)(brow + PG_ROW(ai, m)) * ldd + c0;
#pragma unroll
                    for (int bj = 0; bj < 2; ++bj)
#pragma unroll
                        for (int n = 0; n < 2; ++n) { const f32x4 v = acc[ai][bj][m][n]; *(u32x2*)(rowp + PG_COL(bj, n)) = (u32x2){pk_bf16(v[0], v[1]), pk_bf16(v[2], v[3])}; } }
        } else if (pn < 9) {
            bf16_t* dst; int ldd, c0; const float* g; float* ssq; int nsl, sl0;
            if (pn < 8) { dst = (bf16_t*)(ws + WS_CQ); ldd = 512; c0 = (pn - 6) * 256; g = qg; ssq = (float*)(ws + WS_SSQC); nsl = 16; sl0 = (pn - 6) * 8 + wc; }
            else { dst = (bf16_t*)(ws + WS_CKV); ldd = 256; c0 = 0; g = kvg; ssq = (float*)(ws + WS_SSQK); nsl = 8; sl0 = wc; }
            f32x4 gvv[2][2];
#pragma unroll
            for (int bj = 0; bj < 2; ++bj)
#pragma unroll
                for (int n = 0; n < 2; ++n) gvv[bj][n] = *(const f32x4*)(g + c0 + PG_COL(bj, n));
#pragma unroll
            for (int ai = 0; ai < 2; ++ai)
#pragma unroll
                for (int m = 0; m < 4; ++m) { const int row = brow + PG_ROW(ai, m);
#pragma unroll
                    for (int bj = 0; bj < 2; ++bj) { float ss = 0.f;
#pragma unroll
                        for (int n = 0; n < 2; ++n) { const f32x4 v = acc[ai][bj][m][n]; const f32x4 gv = gvv[bj][n];
                            ss += v[0] * v[0] + v[1] * v[1] + v[2] * v[2] + v[3] * v[3];
                            *(u32x2*)(dst + (size_t)row * ldd + c0 + PG_COL(bj, n)) = (u32x2){pk_bf16(v[0] * gv[0], v[1] * gv[1]), pk_bf16(v[2] * gv[2], v[3] * gv[3])}; }
                        ss += __shfl_xor(ss, 16, 64); ss += __shfl_xor(ss, 32, 64);
                        if (fq == 0) ssq[(size_t)row * nsl + sl0 + 4 * bj] = ss; } }
        } else {
            if (wc < 2) {
                bf16_t* dst = (bf16_t*)(ws + WS_KPE); const float* rope = (const float*)(ws + WS_ROPE); const int i0 = 16 * wc + 4 * fq;
#pragma unroll
                for (int ai = 0; ai < 2; ++ai)
#pragma unroll
                    for (int m = 0; m < 4; ++m) { const int row = brow + PG_ROW(ai, m); const int pos = row & (SEQ - 1); const f32x4 x1 = acc[ai][0][m][0], x2 = acc[ai][0][m][1];
                        const f32x4 cs0 = *(const f32x4*)(rope + ((size_t)pos * 32 + i0) * 2), cs1 = *(const f32x4*)(rope + ((size_t)pos * 32 + i0) * 2 + 4);
                        const float c[4] = {cs0[0], cs0[2], cs1[0], cs1[2]}, s[4] = {cs0[1], cs0[3], cs1[1], cs1[3]};
                        float o1[4], o2[4];
#pragma unroll
                        for (int j = 0; j < 4; ++j) { o1[j] = x1[j] * c[j] - x2[j] * s[j]; o2[j] = x1[j] * s[j] + x2[j] * c[j]; }
                        *(u32x2*)(dst + (size_t)row * 64 + i0) = (u32x2){pk_bf16(o1[0], o1[1]), pk_bf16(o1[2], o1[3])};
                        *(u32x2*)(dst + (size_t)row * 64 + 32 + i0) = (u32x2){pk_bf16(o2[0], o2[1]), pk_bf16(o2[2], o2[3])}; }
            }
        }
    }
};
struct PEpiQUp {
    int pn, brow; unsigned char* ws;
    __device__ __forceinline__ void mid(f32x4 (&)[2][2][4][2], int, int, int, int) {}
    __device__ __forceinline__ void fin(f32x4 (&acc)[2][2][4][2], int wr, int wc, int fr, int fq) {
        bf16_t* dst = (bf16_t*)(ws + WS_QB); const float* rope = (const float*)(ws + WS_ROPE);
        float rs[2][4];
#pragma unroll
        for (int ai = 0; ai < 2; ++ai)
#pragma unroll
            for (int m = 0; m < 4; ++m) { const f32x4* pp = (const f32x4*)((const float*)(ws + WS_SSQC) + (size_t)(brow + PG_ROW(ai, m)) * 16); const f32x4 p0 = pp[0], p1 = pp[1], p2 = pp[2], p3 = pp[3];
                const float sq = (((p0[0] + p0[1]) + (p0[2] + p0[3])) + ((p1[0] + p1[1]) + (p1[2] + p1[3]))) + (((p2[0] + p2[1]) + (p2[2] + p2[3])) + ((p3[0] + p3[1]) + (p3[2] + p3[3])));
                rs[ai][m] = rsqrtf(sq * (1.f / 512.f) + EPS); }
#pragma unroll
        for (int bj = 0; bj < 2; ++bj) { const int seg = pn * 4 + 2 * bj + (wc >> 1), head = seg / 3, part = seg - head * 3; const int i0 = 16 * (wc & 1) + 4 * fq;
#pragma unroll
            for (int ai = 0; ai < 2; ++ai)
#pragma unroll
                for (int m = 0; m < 4; ++m) { const int row = brow + PG_ROW(ai, m); const float r = rs[ai][m]; bf16_t* drow = dst + (size_t)row * 1536 + head * 192 + part * 64;
                    const f32x4 x1 = acc[ai][bj][m][0], x2 = acc[ai][bj][m][1];
                    if (part < 2) {
                        *(u32x2*)(drow + i0) = (u32x2){pk_bf16(x1[0] * r, x1[1] * r), pk_bf16(x1[2] * r, x1[3] * r)};
                        *(u32x2*)(drow + 32 + i0) = (u32x2){pk_bf16(x2[0] * r, x2[1] * r), pk_bf16(x2[2] * r, x2[3] * r)};
                    } else { const int pos = row & (SEQ - 1);
                        const f32x4 cs0 = *(const f32x4*)(rope + ((size_t)pos * 32 + i0) * 2), cs1 = *(const f32x4*)(rope + ((size_t)pos * 32 + i0) * 2 + 4);
                        const float c[4] = {cs0[0], cs0[2], cs1[0], cs1[2]}, s[4] = {cs0[1], cs0[3], cs1[1], cs1[3]};
                        float o1[4], o2[4];
#pragma unroll
                        for (int j = 0; j < 4; ++j) { o1[j] = (x1[j] * c[j] - x2[j] * s[j]) * r; o2[j] = (x1[j] * s[j] + x2[j] * c[j]) * r; }
                        *(u32x2*)(drow + i0) = (u32x2){pk_bf16(o1[0], o1[1]), pk_bf16(o1[2], o1[3])};
                        *(u32x2*)(drow + 32 + i0) = (u32x2){pk_bf16(o2[0], o2[1]), pk_bf16(o2[2], o2[3])}; } } }
    }
};
struct PEpiKvUp {
    int pn, brow; unsigned char* ws;
    __device__ __forceinline__ void mid(f32x4 (&)[2][2][4][2], int, int, int, int) {}
    __device__ __forceinline__ void fin(f32x4 (&acc)[2][2][4][2], int wr, int wc, int fr, int fq) {
        bf16_t* dst = (bf16_t*)(ws + WS_KVB);
#pragma unroll
        for (int ai = 0; ai < 2; ++ai)
#pragma unroll
            for (int m = 0; m < 4; ++m) { const int row = brow + PG_ROW(ai, m); const f32x4* pp = (const f32x4*)((const float*)(ws + WS_SSQK) + (size_t)row * 8); const f32x4 p0 = pp[0], p1 = pp[1];
                const float r = rsqrtf((((p0[0] + p0[1]) + (p0[2] + p0[3])) + ((p1[0] + p1[1]) + (p1[2] + p1[3]))) * (1.f / 256.f) + EPS);
#pragma unroll
                for (int bj = 0; bj < 2; ++bj)
#pragma unroll
                    for (int n = 0; n < 2; ++n) { const f32x4 v = acc[ai][bj][m][n];
                        *(u32x2*)(dst + (size_t)row * 2048 + pn * 256 + PG_COL(bj, n)) = (u32x2){pk_bf16(v[0] * r, v[1] * r), pk_bf16(v[2] * r, v[3] * r)}; } }
    }
};
struct PEpiWo {
    int pn, brow; unsigned char* ws; const float* x; const LAS float* tab;
    __device__ __forceinline__ void mid(f32x4 (&acc)[2][2][4][2], int wr, int wc, int fr, int fq) {
#pragma unroll
        for (int ai = 0; ai < 2; ++ai)
#pragma unroll
            for (int m = 0; m < 4; ++m) { const int r = PG_ROW(ai, m);
                const float f = __builtin_amdgcn_sqrtf((tab[256 + r] + EPS) * __builtin_amdgcn_rcpf(tab[r] + EPS));
#pragma unroll
                for (int bj = 0; bj < 2; ++bj)
#pragma unroll
                    for (int n = 0; n < 2; ++n) acc[ai][bj][m][n] *= f; }
        asm volatile("s_waitcnt lgkmcnt(0)" ::: "memory"); SBAR();
    }
    __device__ __forceinline__ void fin(f32x4 (&acc)[2][2][4][2], int wr, int wc, int fr, int fq) {
        float* x2 = (float*)(ws + WS_X2);
#pragma unroll
        for (int ai = 0; ai < 2; ++ai)
#pragma unroll
            for (int m = 0; m < 4; ++m) { const int r = PG_ROW(ai, m); const size_t o = (size_t)(brow + r) * D_MODEL + pn * 256; const float rbm = rsqrtf(tab[256 + r] + EPS); f32x4 xv[2][2];
#pragma unroll
                for (int bj = 0; bj < 2; ++bj)
#pragma unroll
                    for (int n = 0; n < 2; ++n) xv[bj][n] = *(const f32x4*)(x + o + PG_COL(bj, n));
#pragma unroll
                for (int bj = 0; bj < 2; ++bj)
#pragma unroll
                    for (int n = 0; n < 2; ++n) *(f32x4*)(x2 + o + PG_COL(bj, n)) = acc[ai][bj][m][n] * rbm + xv[bj][n]; }
    }
};
__device__ __forceinline__ void pg_convert(const float* W, int K, int ld, int ncols, int nrows, bf16_t* Bt, int item0, int nitems_stride) {
    const int total = nrows * (K >> 3);
    for (int it0 = item0; it0 < total; it0 += 4 * nitems_stride) { float v[4][8]; int row[4], k0[4]; bool ok[4];
#pragma unroll
        for (int b = 0; b < 4; ++b) { const int it = it0 + b * nitems_stride; const int itc = it < total ? it : item0; const int kc = itc / nrows; row[b] = itc - kc * nrows; k0[b] = kc << 3; ok[b] = it < total;
            const int col = (row[b] & ~255) + pg_tcol(row[b] & 255); const int colc = col < ncols ? col : 0; const float s = col < ncols ? 1.f : 0.f;
#pragma unroll
            for (int q = 0; q < 8; ++q) v[b][q] = W[(size_t)(k0[b] + q) * ld + colc] * s; }
#pragma unroll
        for (int b = 0; b < 4; ++b) if (ok[b])
            *(u32x4*)(Bt + (size_t)row[b] * K + k0[b]) = (u32x4){pk_bf16(v[b][0], v[b][1]), pk_bf16(v[b][2], v[b][3]), pk_bf16(v[b][4], v[b][5]), pk_bf16(v[b][6], v[b][7])}; }
}
__device__ __forceinline__ void sincos_d(double x, double& s, double& c) {
    const double k = __builtin_rint(x * 0.63661977236758134308);
    double r = __builtin_fma(-k, 1.57079632679489655800e+00, x); r = __builtin_fma(-k, 6.12323399573676603587e-17, r);
    const double r2 = r * r;
    double sp = -7.6471637318198164759e-13; sp = sp * r2 + 1.6059043836821614599e-10; sp = sp * r2 - 2.5052108385441718775e-08; sp = sp * r2 + 2.7557319223985890653e-06;
    sp = sp * r2 - 1.9841269841269841270e-04; sp = sp * r2 + 8.3333333333333333333e-03; sp = sp * r2 - 1.6666666666666666667e-01; const double sn = r + r * r2 * sp;
    double cp = 4.7794773323873852974e-14; cp = cp * r2 - 1.1470745597729724714e-11; cp = cp * r2 + 2.0876756987868098979e-09; cp = cp * r2 - 2.7557319223985890653e-07;
    cp = cp * r2 + 2.4801587301587301587e-05; cp = cp * r2 - 1.3888888888888888889e-03; cp = cp * r2 + 4.1666666666666666667e-02; cp = cp * r2 - 0.5; const double cn = 1.0 + r2 * cp;
    const int q = ((int)k) & 3;
    s = (q == 0) ? sn : (q == 1) ? cn : (q == 2) ? -sn : -cn;
    c = (q == 0) ? cn : (q == 1) ? -sn : (q == 2) ? -cn : sn;
}

__device__ __forceinline__ void phase_prologue(const Params& p) {
    const int tid = threadIdx.x, wid = tid >> 6, lane = tid & 63;
    bf16_t* xn = (bf16_t*)(p.ws + WS_XN);
    for (int row = blockIdx.x * 8 + wid; row < NTOK; row += gridDim.x * 8) {
        const f32x4* xr = (const f32x4*)(p.x + (size_t)row * D_MODEL); f32x4 v[8]; float ss = 0.f;
#pragma unroll
        for (int i = 0; i < 8; ++i) { v[i] = xr[lane + 64 * i]; ss += v[i][0] * v[i][0] + v[i][1] * v[i][1] + v[i][2] * v[i][2] + v[i][3] * v[i][3]; }
        ss = wave_sum(ss); const float rs = rsqrtf(ss * (1.f / D_MODEL) + EPS);
#pragma unroll
        for (int i = 0; i < 8; ++i) { const f32x4 g = ((const f32x4*)p.attn_norm)[lane + 64 * i];
            *(u32x2*)(xn + (size_t)row * D_MODEL + 4 * (lane + 64 * i)) = (u32x2){pk_bf16(v[i][0] * rs * g[0], v[i][1] * rs * g[1]), pk_bf16(v[i][2] * rs * g[2], v[i][3] * rs * g[3])}; }
    }
    const int gtid = blockIdx.x * 512 + tid;
    if (gtid < SEQ * 32) {
        const int pos = gtid >> 5, i = gtid & 31;
        double b = 10000.0; for (int q = 0; q < 5; ++q) b = __builtin_sqrt(b);
        double f = 1.0; for (int q = 0; q < i; ++q) f *= b;
        const float inv_freq = (float)(1.0 / f); const float ang = (float)pos * inv_freq;
        double s, c; sincos_d((double)ang, s, c);
        float* rope = (float*)(p.ws + WS_ROPE); rope[(size_t)gtid * 2] = (float)c; rope[(size_t)gtid * 2 + 1] = (float)s;
    }
    {
        const int nth = gridDim.x * 512;
        pg_convert(p.w_in, D_MODEL, IN_COLS, IN_COLS, 2560, (bf16_t*)(p.ws + WS_BT_IN), gtid, nth);
        pg_convert(p.b_w_uq, 512, 1536, 1536, 1536, (bf16_t*)(p.ws + WS_BT_UQ), gtid, nth);
    }
    if (gtid < N_EXP * D_MODEL) {
        ((float*)(p.ws + WS_WRT))[gtid] = p.w_router[gtid] * p.mlp_norm[gtid >> 5];
    }
}

constexpr int AA_PITCH = 144;
constexpr int AA_K = 0, AA_V = 384 * AA_PITCH;
constexpr int AA_WS = 2 * 384 * AA_PITCH;
__device__ __forceinline__ void attn_a_unit(const Params& p, LAS char* lds, int u) {
    const int tid = threadIdx.x, wid = __builtin_amdgcn_readfirstlane(tid >> 6), lane = tid & 63, r32 = lane & 31, hi = lane >> 5;
    const int b = u >> 7, nq = (u >> 2) & 31, kvh = u & 3;
    const bf16_t* QA = (const bf16_t*)(p.ws + WS_QA); const bf16_t* KA = (const bf16_t*)(p.ws + WS_KA); const bf16_t* VA = (const bf16_t*)(p.ws + WS_VA);
    const int P0 = (nq - 1) * 128;
    __syncthreads();
    for (int c = tid; c < 384 * 8; c += 512) { const int r = c >> 3, ch = c & 7; const int pos = P0 + r;
        i32x4 kv = {0, 0, 0, 0}, vv = {0, 0, 0, 0};
        if (pos >= 0 && pos < SEQ) { const size_t g = ((size_t)(b * SEQ + pos)) * 256 + kvh * 64 + ch * 8; kv = *(const i32x4*)(KA + g); vv = *(const i32x4*)(VA + g); }
        *(LAS i32x4*)(lds + AA_K + r * AA_PITCH + ch * 16) = kv; *(LAS i32x4*)(lds + AA_V + r * AA_PITCH + ch * 16) = vv; }
    __syncthreads();
    LAS float* wsf = (LAS float*)(lds + AA_WS) + wid * 64;
    const int hq = kvh * 4 + (wid >> 1);
    const float slope2 = __builtin_amdgcn_exp2f(-8.f * (float)(hq + 1) / 16.f) * LOG2E;
    const float sink2 = p.a_sink[hq] * LOG2E;
    const float C = 0.125f * LOG2E;
    const float* ga = p.out_norm_a + hq * 64;
    bf16_t* Y = (bf16_t*)(p.ws + WS_Y); float* ssqa = (float*)(p.ws + WS_SSQP);
    for (int blk = 0; blk < 2; ++blk) {
        const int q0 = nq * 128 + (wid & 1) * 64 + blk * 32;
        const int tq = q0 + r32;
        bf16x8 qr[4];
        { const bf16_t* qp = QA + ((size_t)(b * SEQ + tq)) * 1024 + hq * 64 + hi * 8;
#pragma unroll
          for (int d0 = 0; d0 < 4; ++d0) qr[d0] = *(const bf16x8*)(qp + d0 * 16); }
        float m_reg = sink2, l_reg = 1.f; f32x16 o[2] = {};
        for (int jt = 0; jt < 6; ++jt) {
            const int kp0 = P0 + jt * 64;
            if (kp0 + 63 < q0 - 128 || kp0 > q0 + 31 + 128 || kp0 + 63 < 0 || kp0 >= SEQ) continue;
            f32x16 p0 = {}, p1 = {};
#pragma unroll
            for (int d0 = 0; d0 < 4; ++d0) {
                const bf16x8 k0 = *(const LAS bf16x8*)(lds + AA_K + (jt * 64 + r32) * AA_PITCH + (d0 * 16 + hi * 8) * 2);
                const bf16x8 k1 = *(const LAS bf16x8*)(lds + AA_K + (jt * 64 + 32 + r32) * AA_PITCH + (d0 * 16 + hi * 8) * 2);
                p0 = __builtin_amdgcn_mfma_f32_32x32x16_bf16(k0, qr[d0], p0, 0, 0, 0);
                p1 = __builtin_amdgcn_mfma_f32_32x32x16_bf16(k1, qr[d0], p1, 0, 0, 0);
            }
            float pmax = -1e30f;
#pragma unroll
            for (int r = 0; r < 16; ++r) {
                { const int kp = kp0 + crow(r, hi); const int dist = tq > kp ? tq - kp : kp - tq; const bool ok = dist <= 128 && kp >= 0 && kp < SEQ;
                  p0[r] = ok ? p0[r] * C - slope2 * (float)dist : -1e30f; pmax = fmaxf(pmax, p0[r]); }
                { const int kp = kp0 + 32 + crow(r, hi); const int dist = tq > kp ? tq - kp : kp - tq; const bool ok = dist <= 128 && kp >= 0 && kp < SEQ;
                  p1[r] = ok ? p1[r] * C - slope2 * (float)dist : -1e30f; pmax = fmaxf(pmax, p1[r]); }
            }
            { auto rr = __builtin_amdgcn_permlane32_swap(__float_as_uint(pmax), __float_as_uint(pmax), false, false); pmax = fmaxf(__uint_as_float(rr[0]), __uint_as_float(rr[1])); }
            const float mn = fmaxf(m_reg, pmax); const float alpha = __builtin_amdgcn_exp2f(m_reg - mn); m_reg = mn;
            float ps = 0.f;
#pragma unroll
            for (int r = 0; r < 16; ++r) { p0[r] = __builtin_amdgcn_exp2f(p0[r] - mn); p1[r] = __builtin_amdgcn_exp2f(p1[r] - mn); ps += p0[r] + p1[r]; }
            { auto rr = __builtin_amdgcn_permlane32_swap(__float_as_uint(ps), __float_as_uint(ps), false, false); ps = __uint_as_float(rr[0]) + __uint_as_float(rr[1]); }
            l_reg = l_reg * alpha + ps;
            if (hi == 0) wsf[r32] = alpha;
            WAIT_L0();
#pragma unroll
            for (int r = 0; r < 16; ++r) { const float a = wsf[crow(r, hi)]; o[0][r] *= a; o[1][r] *= a; }
            bf16x8 pa[4];
#define PK4(P, BASE, OUT) do { unsigned a0 = pk_bf16(P[BASE + 0], P[BASE + 1]), a1 = pk_bf16(P[BASE + 2], P[BASE + 3]); \
    unsigned b0 = pk_bf16(P[BASE + 4], P[BASE + 5]), b1 = pk_bf16(P[BASE + 6], P[BASE + 7]); \
    auto r0_ = __builtin_amdgcn_permlane32_swap(a0, b0, false, false); auto r1_ = __builtin_amdgcn_permlane32_swap(a1, b1, false, false); \
    u32x4 w_ = {r0_[0], r1_[0], r0_[1], r1_[1]}; OUT = __builtin_bit_cast(bf16x8, w_); } while (0)
            PK4(p0, 0, pa[0]); PK4(p0, 8, pa[1]); PK4(p1, 0, pa[2]); PK4(p1, 8, pa[3]);
            const int g16 = (lane >> 4) & 1, qq = (lane & 15) >> 2, pp = lane & 3;
#pragma unroll
            for (int db = 0; db < 2; ++db) {
#pragma unroll
                for (int ks = 0; ks < 4; ++ks) {
                    const LAS char* vp = lds + AA_V + (jt * 64 + ks * 16 + 8 * hi + qq) * AA_PITCH + (db * 32 + 16 * g16 + 4 * pp) * 2;
                    const s16x4 lo = vtr(vp), hh = vtr(vp + 4 * AA_PITCH);
                    const bf16x8 vb = (bf16x8){lo[0], lo[1], lo[2], lo[3], hh[0], hh[1], hh[2], hh[3]};
                    o[db] = __builtin_amdgcn_mfma_f32_32x32x16_bf16(pa[ks], vb, o[db], 0, 0, 0);
                }
            }
            WAIT_L0();
        }
        if (hi == 0) wsf[r32] = 1.f / l_reg;
        WAIT_L0();
        const float g0 = ga[r32], g1 = ga[32 + r32];
#pragma unroll
        for (int r = 0; r < 16; ++r) { const int qrow = crow(r, hi); const float il = wsf[qrow]; const float v0 = o[0][r] * il, v1 = o[1][r] * il;
            const size_t tok = (size_t)(b * SEQ + q0 + qrow);
            bf16_t* yp = Y + tok * 2048 + hq * 64;
            yp[r32] = (bf16_t)(pk_bf16(v0 * g0, 0.f) & 0xffffu); yp[32 + r32] = (bf16_t)(pk_bf16(v1 * g1, 0.f) & 0xffffu);
            float ss = v0 * v0 + v1 * v1;
#pragma unroll
            for (int s = 16; s >= 1; s >>= 1) ss += __shfl_xor(ss, s, 64);
            if (r32 == 0) ssqa[tok * 24 + hq] = ss; }
        WAIT_L0();
    }
}

constexpr int MB_V = 0, MB_KN = 32768, MB_KP = 65536, MB_WS = 81920, MB_QP = 83968;
#define KSWZ(row, colB) ((row) * 256 + ((colB) ^ (((row) & 7) << 4)))
#define KPSWZ(row, colB) ((row) * 128 + ((colB) ^ (((row) & 7) << 4)))
constexpr float MLA_SCALE = 0.07216878364870322f;
constexpr float MLA_THR = 8.f;
__device__ __forceinline__ void mla_partialSM(f32x16& p0, f32x16& p1, float& m_reg, float& mn, float& alpha) {
    constexpr float C = MLA_SCALE * LOG2E;
    float pmax = p0[0];
#pragma unroll
    for (int r = 1; r < 16; ++r) pmax = fmaxf(pmax, p0[r]);
#pragma unroll
    for (int r = 0; r < 16; ++r) pmax = fmaxf(pmax, p1[r]);
    { auto rr = __builtin_amdgcn_permlane32_swap(__float_as_uint(pmax), __float_as_uint(pmax), false, false); pmax = fmaxf(__uint_as_float(rr[0]), __uint_as_float(rr[1])); }
    if (__builtin_expect(__all(pmax - m_reg <= MLA_THR / MLA_SCALE), 1)) { mn = m_reg; alpha = 1.f; }
    else { mn = fmaxf(m_reg, pmax); alpha = __builtin_amdgcn_exp2f((m_reg - mn) * C); m_reg = mn; }
    const float mnC = -mn * C;
#pragma unroll
    for (int r = 0; r < 16; ++r) p0[r] = fmaf(p0[r], C, mnC);
#pragma unroll
    for (int r = 0; r < 16; ++r) p1[r] = fmaf(p1[r], C, mnC);
#pragma unroll
    for (int r = 0; r < 16; ++r) p0[r] = __builtin_amdgcn_exp2f(p0[r]);
}
__device__ __forceinline__ void mla_finishSM(f32x16& p0, f32x16& p1, float alpha, float& l_reg, bf16x8& pa0, bf16x8& pa1, bf16x8& pa2, bf16x8& pa3) {
#pragma unroll
    for (int r = 0; r < 16; ++r) p1[r] = __builtin_amdgcn_exp2f(p1[r]);
    float ps = 0;
#pragma unroll
    for (int r = 0; r < 16; ++r) ps += p0[r];
#pragma unroll
    for (int r = 0; r < 16; ++r) ps += p1[r];
    { auto rr = __builtin_amdgcn_permlane32_swap(__float_as_uint(ps), __float_as_uint(ps), false, false); ps = __uint_as_float(rr[0]) + __uint_as_float(rr[1]); }
    l_reg = l_reg * alpha + ps;
    PK4(p0, 0, pa0); PK4(p0, 8, pa1); PK4(p1, 0, pa2); PK4(p1, 8, pa3);
}
__device__ __forceinline__ void mla_qkt(f32x16& p0, f32x16& p1, const LAS char* Kn, const LAS char* Kp, const bf16x8* qr, const LAS char* qp, int r32, int hi) {
    p0 = f32x16{}; p1 = f32x16{};
#pragma unroll
    for (int d0 = 0; d0 < 8; ++d0) { const int cb = (d0 * 16 + hi * 8) * 2;
        const bf16x8 b0 = *(const LAS bf16x8*)(Kn + KSWZ(r32, cb)); const bf16x8 b1 = *(const LAS bf16x8*)(Kn + KSWZ(32 + r32, cb));
        p0 = __builtin_amdgcn_mfma_f32_32x32x16_bf16(b0, qr[d0], p0, 0, 0, 0); p1 = __builtin_amdgcn_mfma_f32_32x32x16_bf16(b1, qr[d0], p1, 0, 0, 0); }
#pragma unroll
    for (int d0 = 0; d0 < 4; ++d0) { const int cb = (d0 * 16 + hi * 8) * 2;
        const bf16x8 b0 = *(const LAS bf16x8*)(Kp + KPSWZ(r32, cb)); const bf16x8 b1 = *(const LAS bf16x8*)(Kp + KPSWZ(32 + r32, cb));
        const bf16x8 q = *(const LAS bf16x8*)(qp + d0 * 1024);
        p0 = __builtin_amdgcn_mfma_f32_32x32x16_bf16(b0, q, p0, 0, 0, 0); p1 = __builtin_amdgcn_mfma_f32_32x32x16_bf16(b1, q, p1, 0, 0, 0); }
}
__device__ __forceinline__ int v_st(int k, int c) { const int kk = (k & ~0xC) | ((k & 4) << 1) | ((k & 8) >> 1); return ((kk >> 3) * 4 + (c >> 5)) * 512 + ((kk & 7) * 32 + (c & 31)) * 2; }
__device__ __forceinline__ int v_rd_base(int lane) { return ((lane & 3) << 3) | (((lane >> 2) & 3) << 6) | (((lane >> 4) & 1) << 5) | (((lane >> 5) & 1) << 8); }
constexpr int v_rd_off(int d0, int ks, int half) { return d0 * 512 + ks * 4096 + half * 2048; }
template <int D0> __device__ __forceinline__ void mla_pv_one(f32x16& od, const LAS char* vb, bf16x8 pa0, bf16x8 pa1, bf16x8 pa2, bf16x8 pa3) {
    const s16x4 l0 = vtr(vb + v_rd_off(D0, 0, 0)), h0 = vtr(vb + v_rd_off(D0, 0, 1)), l1 = vtr(vb + v_rd_off(D0, 1, 0)), h1 = vtr(vb + v_rd_off(D0, 1, 1));
    const s16x4 l2 = vtr(vb + v_rd_off(D0, 2, 0)), h2 = vtr(vb + v_rd_off(D0, 2, 1)), l3 = vtr(vb + v_rd_off(D0, 3, 0)), h3 = vtr(vb + v_rd_off(D0, 3, 1));
#define PKV(L, H) (bf16x8){L[0], L[1], L[2], L[3], H[0], H[1], H[2], H[3]}
    od = __builtin_amdgcn_mfma_f32_32x32x16_bf16(pa0, PKV(l0, h0), od, 0, 0, 0);
    od = __builtin_amdgcn_mfma_f32_32x32x16_bf16(pa1, PKV(l1, h1), od, 0, 0, 0);
    od = __builtin_amdgcn_mfma_f32_32x32x16_bf16(pa2, PKV(l2, h2), od, 0, 0, 0);
    od = __builtin_amdgcn_mfma_f32_32x32x16_bf16(pa3, PKV(l3, h3), od, 0, 0, 0);
#undef PKV
}
__device__ __forceinline__ void mla_pv(f32x16* o, const LAS char* vb, bf16x8 pa0, bf16x8 pa1, bf16x8 pa2, bf16x8 pa3) {
    mla_pv_one<0>(o[0], vb, pa0, pa1, pa2, pa3); mla_pv_one<1>(o[1], vb, pa0, pa1, pa2, pa3); mla_pv_one<2>(o[2], vb, pa0, pa1, pa2, pa3); mla_pv_one<3>(o[3], vb, pa0, pa1, pa2, pa3);
}
__device__ __forceinline__ void mla_unit(const Params& p, LAS char* lds, int u) {
    const int tid = threadIdx.x, wid = __builtin_amdgcn_readfirstlane(tid >> 6), lane = tid & 63, r32 = lane & 31, hi = lane >> 5;
    const int bh = u >> 4, qb = u & 15, b = bh >> 3, h = bh & 7;
    const bf16_t* QB = (const bf16_t*)(p.ws + WS_QB); const bf16_t* KVB = (const bf16_t*)(p.ws + WS_KVB); const bf16_t* KPE = (const bf16_t*)(p.ws + WS_KPE);
    const bf16_t* Kh = KVB + (size_t)b * SEQ * 2048 + h * 256;
    const bf16_t* Ph = KPE + (size_t)b * SEQ * 64;
    LAS float* wsf = (LAS float*)(lds + MB_WS) + wid * 64; LAS float* li_l = wsf; LAS float* al_l = wsf + 32;
    float m_reg = -1e30f, l_reg = 0; f32x16 o[4] = {}; bf16x8 qr[8];
    LAS char* qp = lds + MB_QP + wid * 4096 + lane * 16;
    { const bf16_t* Qw = QB + ((size_t)(b * SEQ + qb * 256 + wid * 32 + r32)) * 1536 + h * 192 + hi * 8;
#pragma unroll
      for (int d0 = 0; d0 < 8; ++d0) qr[d0] = *(const bf16x8*)(Qw + d0 * 16);
      __syncthreads();
#pragma unroll
      for (int d0 = 0; d0 < 4; ++d0) *(LAS bf16x8*)(qp + d0 * 1024) = *(const bf16x8*)(Qw + (8 + d0) * 16); }
    const int sr = tid >> 4, sc = (tid & 15) * 8, vst0 = v_st(sr, sc), vst1 = v_st(32 + sr, sc);
    const int pr = tid >> 3, pc = (tid & 7) * 8;
    const LAS char* vb0 = lds + MB_V + v_rd_base(lane);
    bf16x8 vs0, vs1, ks0, ks1, kp0;
#define SLOAD(k0) do { vs0 = *(const bf16x8*)(Kh + (size_t)((k0) + sr) * 2048 + 128 + sc); vs1 = *(const bf16x8*)(Kh + (size_t)((k0) + 32 + sr) * 2048 + 128 + sc); \
    ks0 = *(const bf16x8*)(Kh + (size_t)((k0) + sr) * 2048 + sc); ks1 = *(const bf16x8*)(Kh + (size_t)((k0) + 32 + sr) * 2048 + sc); \
    kp0 = *(const bf16x8*)(Ph + (size_t)((k0) + pr) * 64 + pc); } while (0)
#define SWRITE(bb) do { *(LAS bf16x8*)(lds + MB_V + (bb) * 16384 + vst0) = vs0; *(LAS bf16x8*)(lds + MB_V + (bb) * 16384 + vst1) = vs1; \
    *(LAS bf16x8*)(lds + MB_KN + (bb) * 16384 + KSWZ(sr, sc * 2)) = ks0; *(LAS bf16x8*)(lds + MB_KN + (bb) * 16384 + KSWZ(32 + sr, sc * 2)) = ks1; \
    *(LAS bf16x8*)(lds + MB_KP + (bb) * 8192 + KPSWZ(pr, pc * 2)) = kp0; } while (0)
#define RESC(a) do { if (__any((a) < 1.f)) { if (hi == 0) al_l[r32] = (a); WAIT_L0(); \
    _Pragma("unroll") for (int d = 0; d < 4; ++d) _Pragma("unroll") for (int r = 0; r < 16; ++r) o[d][r] *= al_l[crow(r, hi)]; } } while (0)
    f32x16 pA0, pA1, pB0, pB1; float mnA, mnB, alA, alB; bf16x8 pa0, pa1, pa2, pa3; constexpr int NT = SEQ / 64;
    SLOAD(0); SWRITE(0); __syncthreads();
    mla_qkt(pA0, pA1, lds + MB_KN, lds + MB_KP, qr, qp, r32, hi); mla_partialSM(pA0, pA1, m_reg, mnA, alA);
    SLOAD(64); SWRITE(1); __syncthreads();
    for (int j = 1; j + 1 < NT; j += 2) {
        SBAR(); mla_qkt(pB0, pB1, lds + MB_KN + 16384, lds + MB_KP + 8192, qr, qp, r32, hi);
        mla_finishSM(pA0, pA1, alA, l_reg, pa0, pa1, pa2, pa3); SBAR();
        SLOAD((j + 1) * 64); SBAR();
        mla_pv(o, vb0, pa0, pa1, pa2, pa3); mla_partialSM(pB0, pB1, m_reg, mnB, alB);
        __syncthreads(); SWRITE(0);
        RESC(alB); __syncthreads();
        SBAR(); mla_qkt(pA0, pA1, lds + MB_KN, lds + MB_KP, qr, qp, r32, hi);
        mla_finishSM(pB0, pB1, alB, l_reg, pa0, pa1, pa2, pa3); SBAR();
        SLOAD((j + 2) * 64); SBAR();
        mla_pv(o, vb0 + 16384, pa0, pa1, pa2, pa3); mla_partialSM(pA0, pA1, m_reg, mnA, alA);
        __syncthreads(); SWRITE(1);
        RESC(alA); __syncthreads();
    }
    SBAR(); mla_qkt(pB0, pB1, lds + MB_KN + 16384, lds + MB_KP + 8192, qr, qp, r32, hi);
    mla_finishSM(pA0, pA1, alA, l_reg, pa0, pa1, pa2, pa3); SBAR();
    mla_pv(o, vb0, pa0, pa1, pa2, pa3); mla_partialSM(pB0, pB1, m_reg, mnB, alB);
    __syncthreads(); RESC(alB);
    mla_finishSM(pB0, pB1, alB, l_reg, pa0, pa1, pa2, pa3); SBAR();
    mla_pv(o, vb0 + 16384, pa0, pa1, pa2, pa3);
    if (hi == 0) li_l[r32] = l_reg; WAIT_L0();
    bf16_t* Y = (bf16_t*)(p.ws + WS_Y); float* ssqb = (float*)(p.ws + WS_SSQP);
    const float* gb = p.out_norm_b + h * 128;
    float g[4];
#pragma unroll
    for (int d0 = 0; d0 < 4; ++d0) g[d0] = gb[d0 * 32 + r32];
#pragma unroll
    for (int r = 0; r < 16; ++r) { const int orow = crow(r, hi); const float il = __builtin_amdgcn_rcpf(li_l[orow]);
        const size_t tok = (size_t)(b * SEQ + qb * 256 + wid * 32 + orow); bf16_t* yp = Y + tok * 2048 + 1024 + h * 128; float ss = 0.f;
#pragma unroll
        for (int d0 = 0; d0 < 4; ++d0) { const float v = o[d0][r] * il; ss += v * v; yp[d0 * 32 + r32] = (bf16_t)(pk_bf16(v * g[d0], 0.f) & 0xffffu); }
#pragma unroll
        for (int s = 16; s >= 1; s >>= 1) ss += __shfl_xor(ss, s, 64);
        if (r32 == 0) ssqb[tok * 24 + 16 + h] = ss; }
#undef SLOAD
#undef SWRITE
#undef RESC
}

__device__ __forceinline__ void phase_router(const Params& p, LAS char* lds) {
    const int tid = threadIdx.x, wid = __builtin_amdgcn_readfirstlane(tid >> 6), lane = tid & 63;
    const float* x2 = (const float*)(p.ws + WS_X2); const float* wg = (const float*)(p.ws + WS_WRT);
    unsigned char* xn8 = p.ws + WS_XN; unsigned* cnt = (unsigned*)(p.ws + WS_CTL + CTL_CNT);
    int* tokl = (int*)(p.ws + WS_TOKL); int* sel_e = (int*)(p.ws + WS_SEL); int* sel_r = sel_e + NTOK * 4; float* sel_g = (float*)(sel_r + NTOK * 4);
    LAS float* part = (LAS float*)lds;
    LAS float* rsv = (LAS float*)(lds + 32768);
    LAS unsigned* hist = (LAS unsigned*)(lds + 32768 + 128); LAS unsigned* hbase = hist + 32;
    for (int t0 = blockIdx.x * 32; t0 < NTOK; t0 += gridDim.x * 32) {
        __syncthreads();
        if (tid < N_EXP) hist[tid] = 0u;
#pragma unroll 1
        for (int j = 0; j < 4; ++j) { const int t = t0 + 4 * wid + j; f32x4 xr[8]; float ss = 0.f;
#pragma unroll
            for (int i = 0; i < 8; ++i) { xr[i] = ((const f32x4*)(x2 + (size_t)t * D_MODEL))[lane + 64 * i]; ss += xr[i][0] * xr[i][0] + xr[i][1] * xr[i][1] + xr[i][2] * xr[i][2] + xr[i][3] * xr[i][3]; }
            const float rs = rsqrtf(wave_sum(ss) * (1.f / D_MODEL) + EPS);
            if (lane == 0) rsv[4 * wid + j] = rs;
#pragma unroll
            for (int i = 0; i < 8; ++i) { const f32x4 v = xr[i]; const f32x4 g = ((const f32x4*)p.mlp_norm)[lane + 64 * i]; const float s16 = 16.f * rs;
                *(unsigned*)(xn8 + (size_t)t * D_MODEL + 4 * (lane + 64 * i)) = pk4_fp8(s16 * v[0] * g[0], s16 * v[1] * g[1], s16 * v[2] * g[2], s16 * v[3] * g[3]); } }
        { f32x16 acc;
#pragma unroll
          for (int r = 0; r < 16; ++r) acc[r] = 0.f;
          const float* ap = x2 + (size_t)(t0 + (lane & 31)) * D_MODEL + 256 * wid + 4 * (lane >> 5);
          const float* bp = wg + (size_t)(256 * wid + 4 * (lane >> 5)) * N_EXP + (lane & 31);
#pragma unroll 4
          for (int c = 0; c < 32; ++c) { const f32x4 a4 = *(const f32x4*)(ap + 8 * c);
#pragma unroll
              for (int q = 0; q < 4; ++q) acc = __builtin_amdgcn_mfma_f32_32x32x2f32(a4[q], bp[(size_t)(8 * c + q) * N_EXP], acc, 0, 0, 0); }
#pragma unroll
          for (int r = 0; r < 16; ++r) part[wid * 1024 + crow(r, lane >> 5) * 32 + (lane & 31)] = acc[r]; }
        __syncthreads();
        int my_e[4]; unsigned my_lr[4]; float my_g[4];
#pragma unroll
        for (int j = 0; j < 4; ++j) { const int tl = 4 * wid + j;
            float v = -3.0e38f;
            if (lane < 32) { float s = 0.f;
#pragma unroll
                for (int w = 0; w < 8; ++w) s += part[w * 1024 + tl * 32 + lane];
                v = s * rsv[tl] + p.b_router[lane]; }
            float tv[4]; int ti[4];
#pragma unroll
            for (int r = 0; r < 4; ++r) {
                float bv = v; int bi = lane;
#pragma unroll
                for (int o = 32; o >= 1; o >>= 1) { const float ov = __shfl_xor(bv, o, 64); const int oi = __shfl_xor(bi, o, 64); if (ov > bv || (ov == bv && oi < bi)) { bv = ov; bi = oi; } }
                tv[r] = bv; ti[r] = bi; if (lane == bi) v = -3.0e38f;
            }
            const float e0 = 1.f, e1 = __expf(tv[1] - tv[0]), e2 = __expf(tv[2] - tv[0]), e3 = __expf(tv[3] - tv[0]); const float inv = 1.f / (e0 + e1 + e2 + e3);
            const float gts[4] = {e0 * inv, e1 * inv, e2 * inv, e3 * inv};
            my_e[j] = ti[lane & 3]; my_g[j] = gts[lane & 3]; my_lr[j] = 0u;
            if (lane < 4) my_lr[j] = __hip_atomic_fetch_add(hist + my_e[j], 1u, __ATOMIC_RELAXED, __HIP_MEMORY_SCOPE_WORKGROUP);
        }
        __syncthreads();
        if (tid < N_EXP) hbase[tid] = atomicAdd(cnt + tid * 16, hist[tid]);
        __syncthreads();
        if (lane < 4) {
#pragma unroll
            for (int j = 0; j < 4; ++j) { const int t = t0 + 4 * wid + j; const int e = my_e[j]; const unsigned rk = hbase[e] + my_lr[j];
                tokl[e * NTOK + rk] = t; sel_e[t * 4 + lane] = e; sel_r[t * 4 + lane] = (int)rk; sel_g[t * 4 + lane] = my_g[j]; }
        }
    }
}

__device__ __forceinline__ void phase_combine(const Params& p, const LAS int* s_roff) {
    const int tid = threadIdx.x, wid = tid >> 6, lane = tid & 63;
    const float* x2 = (const float*)(p.ws + WS_X2); const bf16_t* ys = (const bf16_t*)(p.ws + WS_YS);
    const int* sel_e = (const int*)(p.ws + WS_SEL); const int* sel_r = sel_e + NTOK * 4; const float* sel_g = (const float*)(sel_r + NTOK * 4);
    for (int t = blockIdx.x * 8 + wid; t < NTOK; t += gridDim.x * 8) {
        f32x4 v[8];
#pragma unroll
        for (int i = 0; i < 8; ++i) v[i] = ((const f32x4*)(x2 + (size_t)t * D_MODEL))[lane + 64 * i];
#pragma unroll
        for (int k = 0; k < 4; ++k) { const int e = sel_e[t * 4 + k]; const size_t slot = (size_t)(s_roff[e] + sel_r[t * 4 + k]); const float g = sel_g[t * 4 + k];
            const u32x2* yr = (const u32x2*)(ys + slot * D_MODEL);
#pragma unroll
            for (int i = 0; i < 8; ++i) { const u32x2 w = yr[lane + 64 * i]; v[i][0] += g * bf_lo(w[0]); v[i][1] += g * bf_hi(w[0]); v[i][2] += g * bf_lo(w[1]); v[i][3] += g * bf_hi(w[1]); } }
        float ss = 0.f;
#pragma unroll
        for (int i = 0; i < 8; ++i) ss += v[i][0] * v[i][0] + v[i][1] * v[i][1] + v[i][2] * v[i][2] + v[i][3] * v[i][3];
        ss = wave_sum(ss); const float rs = rsqrtf(ss * (1.f / D_MODEL) + EPS);
#pragma unroll
        for (int i = 0; i < 8; ++i) { const f32x4 g = ((const f32x4*)p.final_norm)[lane + 64 * i];
            ((f32x4*)(p.out + (size_t)t * D_MODEL))[lane + 64 * i] = (f32x4){v[i][0] * rs * g[0], v[i][1] * rs * g[1], v[i][2] * rs * g[2], v[i][3] * rs * g[3]}; }
    }
}

constexpr int NPHASE = 9;
__global__ void __launch_bounds__(512, 2) mega_fwd(Params p) {
    extern __shared__ __attribute__((aligned(1024))) char smem_raw[];
    LAS char* lds = (LAS char*)smem_raw;
    LAS unsigned* misc = (LAS unsigned*)(lds + LDS_MISC);
    const int tid = threadIdx.x;
    if (tid < 4) misc[tid] = 0u;
    __syncthreads();
    unsigned* bar = (unsigned*)(p.ws + WS_CTL + CTL_BAR);
    XcdBarrier xb = xcd_barrier_post(bar, (volatile LAS unsigned*)misc);
    const int lo = p.ph_lo, hi = p.ph_hi;
    const int G = gridDim.x, bid = blockIdx.x;
    const int xperm = (bid & 7) * (G >> 3) + (bid >> 3);
#ifdef PH_ONLY
#define IN(k) ((k)==PH_ONLY)
#else
#define IN(k) (lo <= (k) && (k) < hi)
#endif
#define SEAM(k) do { if (IN(k) && IN((k) + 1)) xcd_barrier(xb); } while (0)
    if (IN(0)) phase_prologue(p);
    SEAM(0);
    if (IN(1)) {
        for (int u = xperm; u < 32 * 8; u += G) {
            const int pn = u / 32, pm = u % 32;
            PEpiProj ep{pn, pm * 256, p.ws, p.b_q_norm, p.b_kv_norm};
            __syncthreads();
            gemm_unit_pg<false>(lds, (const bf16_t*)(p.ws + WS_XN) + (size_t)pm * 256 * D_MODEL, (const bf16_t*)(p.ws + WS_BT_IN) + (size_t)pn * 256 * D_MODEL, D_MODEL, ep);
        }
    }
    SEAM(1);
    if (IN(2)) {
        { const int b0 = bid;
            int qv;
            if ((b0 & 3) == 0) {
                const int h = b0 >> 2, pn = 8 + (h >> 5), pm = h & 31;
                PEpiProj ep{pn, pm * 256, p.ws, p.b_q_norm, p.b_kv_norm};
                __syncthreads();
                gemm_unit_pg<false>(lds, (const bf16_t*)(p.ws + WS_XN) + (size_t)pm * 256 * D_MODEL, (const bf16_t*)(p.ws + WS_BT_IN) + (size_t)pn * 256 * D_MODEL, D_MODEL, ep);
                qv = 128 + h;
            } else {
                const int v = (b0 >> 2) * 3 + (b0 & 3) - 1;
                if (v < 128) {
                    attn_a_unit(p, lds, v); qv = v;
                    pg_convert(p.w_o, D_MODEL, D_MODEL, D_MODEL, 2048, (bf16_t*)(p.ws + WS_BT_WO), v * 1024 + tid, 128 * 1024);
                    pg_convert(p.w_o, D_MODEL, D_MODEL, D_MODEL, 2048, (bf16_t*)(p.ws + WS_BT_WO), v * 1024 + 512 + tid, 128 * 1024);
                } else {
                    const int w = v - 128; qv = -1;
                    attn_a_unit(p, lds, 128 + 2 * w); attn_a_unit(p, lds, 129 + 2 * w);
                    if (w < 32) pg_convert(p.b_w_ukv, 256, 2048, 2048, 2048, (bf16_t*)(p.ws + WS_BT_UKV), w * 512 + tid, 32 * 512);
                }
            }
            if (qv >= 0) { const int pn = qv / 32, pm = qv % 32;
                PEpiQUp ep{pn, pm * 256, p.ws};
                __syncthreads();
                gemm_unit_pg<false>(lds, (const bf16_t*)(p.ws + WS_CQ) + (size_t)pm * 256 * 512, (const bf16_t*)(p.ws + WS_BT_UQ) + (size_t)pn * 256 * 512, 512, ep);
                __syncthreads(); }
        }
        xcd_barrier(xb);
        for (int u = xperm; u < 32 * 8; u += G) {
            const int pn = u / 32, pm = u % 32;
            PEpiKvUp ep{pn, pm * 256, p.ws};
            __syncthreads();
            gemm_unit_pg<false>(lds, (const bf16_t*)(p.ws + WS_CKV) + (size_t)pm * 256 * 256, (const bf16_t*)(p.ws + WS_BT_UKV) + (size_t)pn * 256 * 256, 256, ep);
        }
    }
    SEAM(2);
    if (IN(3)) { for (int u = xperm; u < 256; u += G) mla_unit(p, lds, u); }
    SEAM(3);
    if (IN(4)) {
        __syncthreads();
        for (int u = xperm; u < 32 * 8; u += G) {
            const int pn = u / 32, pm = u % 32;
            LAS float* tab = (LAS float*)(lds + 2 * G_STAGE_B);
            __syncthreads();
            if (tid < 256) { const f32x4* pp = (const f32x4*)((const float*)(p.ws + WS_SSQP) + (size_t)(pm * 256 + tid) * 24); float sa = 0.f, sb2 = 0.f;
#pragma unroll
                for (int q = 0; q < 4; ++q) { const f32x4 v = pp[q]; sa += (v[0] + v[1]) + (v[2] + v[3]); }
#pragma unroll
                for (int q = 4; q < 6; ++q) { const f32x4 v = pp[q]; sb2 += (v[0] + v[1]) + (v[2] + v[3]); }
                tab[tid] = sa * (1.f / 1024.f); tab[256 + tid] = sb2 * (1.f / 1024.f); }
            __syncthreads();
            PEpiWo ep{pn, pm * 256, p.ws, p.x, tab};
            gemm_unit_pg<true>(lds, (const bf16_t*)(p.ws + WS_Y) + (size_t)pm * 256 * D_MODEL, (const bf16_t*)(p.ws + WS_BT_WO) + (size_t)pn * 256 * D_MODEL, D_MODEL, ep);
        }
    }
    SEAM(4);
    if (IN(5)) phase_router(p, lds);
    SEAM(5);
    LAS int* s_cnt = (LAS int*)(misc + 16); LAS int* s_toff = (LAS int*)(misc + 48); LAS int* s_roff = (LAS int*)(misc + 96);
    if (IN(6) || IN(7) || IN(8)) {
        if (tid == 0) { const unsigned* cnt = (const unsigned*)(p.ws + WS_CTL + CTL_CNT); int to = 0;
            for (int e = 0; e < N_EXP; ++e) { const int c = (int)xb_ld((unsigned*)cnt + e * 16); s_cnt[e] = c; s_toff[e] = to; s_roff[e] = to * 256; to += (c + 255) >> 8; }
            s_toff[N_EXP] = to; }
        __syncthreads();
    }
    if (IN(6)) {
        const int TM = s_toff[N_EXP];
#ifdef PROBE_P6
        for (int rep = 0; rep < 2; ++rep)
#endif
        for (int L = xperm; L < TM * 16; L += G) {
            int e = 0; while (s_toff[e + 1] * 16 <= L) ++e;
            const int w = L - s_toff[e] * 16, nte = s_toff[e + 1] - s_toff[e], ntile = w / nte, mt = w - ntile * nte, cntE = s_cnt[e];
            AGather8 af{p.ws + WS_XN, (const int*)(p.ws + WS_TOKL) + (size_t)e * NTOK, mt * 256, cntE};
            BGateUp bf{p.w_up + (size_t)e * D_MODEL * (2 * D_FF) + ntile * 128, (size_t)(2 * D_FF)};
            EpiUp8 ep{ntile * 128, mt * 256, cntE, p.ws + WS_ACT + ((size_t)s_roff[e] + mt * 256) * D_FF, p.b_up + (size_t)e * (2 * D_FF)};
            gemm_unit8<0x7B7B7B7B>(lds, (LAS unsigned*)(misc + 8), D_MODEL / 64, af, bf, ep);
        }
    }
    SEAM(6);
    if (IN(7)) {
        const int TM = s_toff[N_EXP];
        const int T8 = TM * 8, NF = T8 & ~255, R = T8 - NF;
        const bool halves = R > 0 && R <= 128;
        for (int L = xperm; L < (halves ? NF : T8); L += G) {
            int e = 0; while (s_toff[e + 1] * 8 <= L) ++e;
            const int w = L - s_toff[e] * 8, nte = s_toff[e + 1] - s_toff[e], ntile = w / nte, mt = w - ntile * nte, cntE = s_cnt[e];
            ARows8 af{p.ws + WS_ACT + ((size_t)s_roff[e] + mt * 256) * D_FF, (unsigned)D_FF};
            BPlain bf{p.w_down + (size_t)e * D_FF * D_MODEL + ntile * 256, (size_t)D_MODEL, 256};
            EpiDown8 ep{ntile * 256, mt * 256, cntE, (bf16_t*)(p.ws + WS_YS) + ((size_t)s_roff[e] + mt * 256) * D_MODEL, p.b_down + (size_t)e * D_MODEL};
            gemm_unit8<0x7D7D7D7D>(lds, (LAS unsigned*)(misc + 8), D_FF / 64, af, bf, ep);
        }
        if (halves && xperm < 2 * R) {
            const int L = NF + (xperm >> 1), hf = xperm & 1;
            int e = 0; while (s_toff[e + 1] * 8 <= L) ++e;
            const int w = L - s_toff[e] * 8, nte = s_toff[e + 1] - s_toff[e], ntile = w / nte, mt = w - ntile * nte, cntE = s_cnt[e];
            ARows8 af{p.ws + WS_ACT + ((size_t)s_roff[e] + mt * 256) * D_FF, (unsigned)D_FF};
            BPlain bf{p.w_down + (size_t)e * D_FF * D_MODEL + ntile * 256 + hf * 128, (size_t)D_MODEL, 128};
            EpiDown8h ep{ntile * 256 + hf * 128, mt * 256, cntE, (bf16_t*)(p.ws + WS_YS) + ((size_t)s_roff[e] + mt * 256) * D_MODEL, p.b_down + (size_t)e * D_MODEL};
            gemm_unit8h<0x7D7D7D7D>(lds, (LAS unsigned*)(misc + 8), D_FF / 64, af, bf, ep);
        }
    }
    SEAM(7);
    if (IN(8)) phase_combine(p, s_roff);
}

extern "C" void kernel_launch(void* const* d_in, const int* in_sizes, int n_in, void* d_out, int out_size, void* d_ws, size_t ws_size, hipStream_t stream) {
    static int ready = 0;
    if (!ready) {
        if (hipFuncSetAttribute((const void*)mega_fwd, hipFuncAttributeMaxDynamicSharedMemorySize, LDS_BYTES) != hipSuccess) { fprintf(stderr, "kernel_launch: hipFuncSetAttribute failed\n"); return; }
        int per_cu = 0; hipOccupancyMaxActiveBlocksPerMultiprocessor(&per_cu, (const void*)mega_fwd, 512, LDS_BYTES);
        if (per_cu < 1) { fprintf(stderr, "kernel_launch: occupancy query says 0 blocks per CU\n"); return; }
        ready = 1;
    }
    if (ws_size < WS_END) { fprintf(stderr, "kernel_launch: workspace too small\n"); return; }
    hipMemsetAsync((unsigned char*)d_ws + WS_CTL, 0, CTL_BYTES, stream);
    Params p{};
    const float** f = (const float**)&p;
    for (int i = 0; i < 19; ++i) f[i] = (const float*)d_in[i];
    p.out = (float*)d_out; p.ws = (unsigned char*)d_ws; p.ph_lo = 0; p.ph_hi = NPHASE;
    hipLaunchKernelGGL(mega_fwd, dim3(256), dim3(512), LDS_BYTES, stream, p);
}
```

```cpp
#include <hip/hip_runtime.h>
#include <stdint.h>
#include <stdio.h>

#define LAS __attribute__((address_space(3)))
typedef unsigned short bf16_t;
typedef short bf16x8 __attribute__((ext_vector_type(8)));
typedef short s16x4 __attribute__((ext_vector_type(4)));
typedef short v4i16_t __attribute__((ext_vector_type(4)));
typedef float f32x2 __attribute__((ext_vector_type(2)));
typedef float f32x4 __attribute__((ext_vector_type(4)));
typedef float f32x16 __attribute__((ext_vector_type(16)));
typedef int i32x4 __attribute__((ext_vector_type(4)));
typedef unsigned u32x2 __attribute__((ext_vector_type(2)));
typedef unsigned u32x4 __attribute__((ext_vector_type(4)));
typedef __bf16 bf16x2_t __attribute__((ext_vector_type(2)));
typedef int v8i __attribute__((ext_vector_type(8)));
typedef int v2i __attribute__((ext_vector_type(2)));
typedef short v2s __attribute__((ext_vector_type(2)));

constexpr int D_MODEL = 2048, SEQ = 4096, BATCH = 2, NTOK = BATCH * SEQ;
constexpr int IN_COLS = 2368;
constexpr int N_EXP = 32, TOP_K = 4, D_FF = 2048;
constexpr float EPS = 1e-5f;
constexpr float LOG2E = 1.4426950408889634f;

constexpr size_t MiB = 1u << 20;
constexpr size_t WS_CTL = 0, CTL_BYTES = 1 * MiB;
constexpr size_t WS_XN = 1 * MiB, WS_QA = 33 * MiB, WS_KA = 49 * MiB, WS_VA = 53 * MiB, WS_CQ = 57 * MiB, WS_CKV = 65 * MiB, WS_KPE = 69 * MiB;
constexpr size_t WS_QB = 70 * MiB, WS_KVB = 94 * MiB, WS_Y = 126 * MiB, WS_X2 = 158 * MiB, WS_ROPE = 222 * MiB, WS_WRT = 223 * MiB;
constexpr size_t WS_TOKL = 224 * MiB, WS_SEL = 225 * MiB, WS_ACT = 226 * MiB, WS_YS = 386 * MiB, WS_BT_IN = 546 * MiB, WS_BT_UQ = 558 * MiB, WS_BT_UKV = 560 * MiB, WS_BT_WO = 562 * MiB, WS_SSQ2 = 570 * MiB, WS_END = 571 * MiB;
constexpr size_t WS_SSQP = WS_WRT + 262144;
constexpr size_t WS_SSQC = WS_SSQ2;
constexpr size_t WS_SSQK = WS_SSQ2 + 524288;
constexpr size_t CTL_BAR = 0, CTL_CNT = 16384, CTL_SSQ_CQ = 65536, CTL_SSQ_CKV = 98304, CTL_SSQ_A = 131072, CTL_SSQ_B = 163840, CTL_SSQ_X2 = 196608;

__device__ __forceinline__ unsigned pk_bf16(float lo, float hi) { f32x2 v = {lo, hi}; bf16x2_t b = __builtin_convertvector(v, bf16x2_t); return __builtin_bit_cast(unsigned, b); }
__device__ __forceinline__ unsigned pk4_fp8(float a, float b, float c, float d) { int w = __builtin_amdgcn_cvt_pk_fp8_f32(a, b, 0, false); w = __builtin_amdgcn_cvt_pk_fp8_f32(c, d, w, true); return (unsigned)w; }
__device__ __forceinline__ unsigned pk4_fp8_x64(f32x4 v) { v2s r; asm("" : "=v"(r));
    r = __builtin_amdgcn_cvt_scalef32_pk_fp8_f32(r, v[0], v[1], 0.015625f, false); r = __builtin_amdgcn_cvt_scalef32_pk_fp8_f32(r, v[2], v[3], 0.015625f, true); return __builtin_bit_cast(unsigned, r); }
__device__ __forceinline__ float bf_lo(unsigned u) { return __uint_as_float(u << 16); }
__device__ __forceinline__ float bf_hi(unsigned u) { return __uint_as_float(u & 0xffff0000u); }
__device__ __forceinline__ float wave_sum(float v) {
#pragma unroll
    for (int o = 32; o >= 1; o >>= 1) v += __shfl_xor(v, o, 64);
    return v;
}
__device__ __forceinline__ int crow(int r, int hi) { return (r & 3) + 8 * (r >> 2) + 4 * hi; }
__device__ __forceinline__ s16x4 vtr(const LAS char* p) { return __builtin_bit_cast(s16x4, __builtin_amdgcn_ds_read_tr16_b64_v4i16((LAS v4i16_t*)p)); }
#define SBAR() __builtin_amdgcn_sched_barrier(0)

#define XB_TMO      128
#define XB_XCNT(j)  (256  + 64 * (j))
#define XB_XSUB(j)  (1280 + 64 * (j))
#define XB_XGEN(j)  (2304 + 64 * (j))
#define XB_TOP      3328
#define XB_TOPGEN   3392
#define XCD_BAR_WORDS 3456
#define XB_SPIN_CAP (1u << 18)
__device__ __forceinline__ unsigned xb_ld(unsigned* p)              { return __hip_atomic_load(p, __ATOMIC_RELAXED, __HIP_MEMORY_SCOPE_AGENT); }
__device__ __forceinline__ unsigned xb_add(unsigned* p, unsigned v) { return __hip_atomic_fetch_add(p, v, __ATOMIC_RELAXED, __HIP_MEMORY_SCOPE_AGENT); }
__device__ __forceinline__ unsigned xb_xcc_id() { return (unsigned)__builtin_amdgcn_s_getreg((3 << 11) | 20) & 0xFu; }
#define XB_SPIN(cond, bar) do { unsigned _sp = 0; while (cond) { __builtin_amdgcn_s_sleep(1); \
    if ((++_sp & 255u) == 0u) { if (xb_ld(&(bar)[XB_TMO])) break; if (_sp > XB_SPIN_CAP) { atomicAdd(&(bar)[XB_TMO], 1u); break; } } } } while (0)
struct XcdBarrier { unsigned* bar; unsigned x; volatile LAS unsigned* st; };
__device__ __forceinline__ XcdBarrier xcd_barrier_post(unsigned* bar, volatile LAS unsigned* st) {
    XcdBarrier b; b.bar = bar; b.x = xb_xcc_id(); b.st = st;
    if (threadIdx.x == 0) (void)xb_add(&bar[XB_XCNT(b.x)], 1u);
    return b;
}
__device__ __forceinline__ void xcd_barrier_complete(unsigned* bar, unsigned x, unsigned& nloc, unsigned& nx) {
    const unsigned G = gridDim.x * gridDim.y * gridDim.z;
    unsigned sum, cnt, mine, sp = 0u;
    for (;;) {
        sum = 0u; cnt = 0u; mine = 0u;
#pragma unroll
        for (unsigned j = 0; j < 16; ++j) { const unsigned c = xb_ld(&bar[XB_XCNT(j)]); sum += c; cnt += (c > 0u) ? 1u : 0u; mine = (j == x) ? c : mine; }
        if (sum == G) break;
        __builtin_amdgcn_s_sleep(1);
        if ((++sp & 255u) == 0u) { if (xb_ld(&bar[XB_TMO])) break; if (sp > XB_SPIN_CAP) { atomicAdd(&bar[XB_TMO], 1u); break; } }
    }
    nloc = mine > 0u ? mine : 1u; nx = cnt > 0u ? cnt : 1u;
}
__device__ __forceinline__ void xcd_barrier(const XcdBarrier& b) {
    asm volatile("s_waitcnt vmcnt(0)" ::: "memory");
    __syncthreads();
    if (threadIdx.x == 0) {
        unsigned* bar = b.bar;
        __builtin_amdgcn_s_waitcnt(0);
        unsigned nloc = b.st[0], nx = b.st[1];
        if (nloc == 0u) { xcd_barrier_complete(bar, b.x, nloc, nx); b.st[0] = nloc; b.st[1] = nx; }
        const unsigned old = xb_add(&bar[XB_XSUB(b.x)], 1u);
        const unsigned gen = old / nloc;
        if (old + 1u == (gen + 1u) * nloc) {
            __builtin_amdgcn_fence(__ATOMIC_RELEASE, "agent");
            asm volatile("s_waitcnt vmcnt(0)" ::: "memory");
            const unsigned og = xb_add(&bar[XB_TOP], 1u);
            const unsigned tg = og / nx;
            if (og + 1u == (tg + 1u) * nx) xb_add(&bar[XB_TOPGEN], 1u);
            else XB_SPIN(xb_ld(&bar[XB_TOPGEN]) == tg, bar);
            __builtin_amdgcn_fence(__ATOMIC_ACQUIRE, "agent");
            xb_add(&bar[XB_XGEN(b.x)], 1u);
            asm volatile("s_waitcnt vmcnt(0)" ::: "memory");
        } else {
            XB_SPIN(xb_ld(&bar[XB_XGEN(b.x)]) == gen, bar);
            __builtin_amdgcn_fence(__ATOMIC_ACQUIRE, "agent");
            asm volatile("s_waitcnt vmcnt(0)" ::: "memory");
        }
    }
    __syncthreads();
}

constexpr int A_TILE_B = 256 * 64 * 2;
constexpr int B_PITCH = 544;
constexpr int B_TILE_B = 64 * B_PITCH;
constexpr int G_STAGE_B = A_TILE_B + B_TILE_B;
constexpr int LDS_MISC = 155648;
constexpr int LDS_BYTES = LDS_MISC + 1024;

__device__ __forceinline__ int a_img_byte(int r, int chunk) { return r * 128 + ((chunk ^ ((r >> 1) & 7)) << 4); }
#define WAIT_L0() asm volatile("s_waitcnt lgkmcnt(0)" ::: "memory")
__device__ __forceinline__ void glds16(const void* gsrc, unsigned lds_dst) { unsigned keep;
    asm volatile("s_mov_b32 %0, m0\n\ts_mov_b32 m0, %2\n\ts_nop 0\n\tglobal_load_lds_dwordx4 %1, off\n\ts_mov_b32 m0, %0" : "=&s"(keep) : "v"(gsrc), "s"(lds_dst) : "memory"); }
#define RAW_BARRIER() do { WAIT_L0(); __builtin_amdgcn_s_barrier(); } while (0)

__device__ __forceinline__ const char* uniform_ptr(const void* p) {
    const unsigned long long v = (unsigned long long)p;
    const unsigned lo = __builtin_amdgcn_readfirstlane((unsigned)v), hi = __builtin_amdgcn_readfirstlane((unsigned)(v >> 32));
    return (const char*)(((unsigned long long)hi << 32) | lo);
}
__device__ __forceinline__ void glds16s(const char* sbase, unsigned voff, unsigned lds_dst) { unsigned keep;
    asm volatile("s_mov_b32 %0, m0\n\ts_mov_b32 m0, %3\n\ts_nop 4\n\tglobal_load_lds_dwordx4 %1, %2\n\ts_mov_b32 m0, %0" : "=&s"(keep) : "v"(voff), "s"(sbase), "s"(lds_dst) : "memory"); }
#define WAIT_V4(n, a, b, c, d) asm volatile("s_waitcnt vmcnt(" #n ")" : "+v"(a), "+v"(b), "+v"(c), "+v"(d) :: "memory")
template <bool MID, class AF, class BF, class EPI>
__device__ __forceinline__ void gemm_unit(LAS char* lds, const int nt, const AF& af, const BF& bf, EPI& epi) {
    const int tid = threadIdx.x, wid = __builtin_amdgcn_readfirstlane(tid >> 6), lane = tid & 63, wr = wid >> 2, wc = wid & 3, fr = lane & 15, fq = lane >> 4;
    const char* abase = uniform_ptr(af.base);
    unsigned aoff[4];
#pragma unroll
    for (int i = 0; i < 4; ++i) { const int R = wid * 8 + i * 64 + (lane >> 3), C = ((lane & 7) ^ ((R >> 1) & 7)) * 8; aoff[i] = (af.rowoff(R) + (unsigned)C) * 2u; }
    const int a_ldsw = wid * 1024;
    const unsigned lds_u = (unsigned)__builtin_amdgcn_readfirstlane((int)(unsigned)(size_t)lds);
    const size_t ldb4 = (size_t)bf.ld * 4;
    const char* bbase = uniform_ptr(bf.base) + (size_t)wid * ldb4;
    const unsigned boff = bf.coloff(4 * lane) * 4u;
    const int b_lds0 = A_TILE_B + wid * B_PITCH + 8 * lane, b_lds1 = A_TILE_B + wid * B_PITCH + ((8 * lane) ^ 128);
    const int a_rd0 = a_img_byte(wr * 128 + fr, fq), a_rd1 = a_rd0 ^ 64;
    const int b_rd = A_TILE_B + (8 * fq + ((lane & 15) >> 2)) * B_PITCH + ((wc ^ (fq & 1)) << 7) + 8 * (lane & 3);
    f32x4 acc[8][4];
#pragma unroll
    for (int m = 0; m < 8; ++m)
#pragma unroll
        for (int n = 0; n < 4; ++n) acc[m][n] = (f32x4){0.f, 0.f, 0.f, 0.f};
    f32x4 sb[8];
#define G_STAGE_A(i, kt, buf) glds16s(abase + (size_t)(kt) * 128, aoff[i], lds_u + (unsigned)((buf) * G_STAGE_B + a_ldsw + (i) * 8192))
#define G_ISSUE_B(i, kt) asm volatile("s_nop 4\n\tglobal_load_dwordx4 %0, %1, %2" : "=v"(sb[i]) : "v"(boff), "s"(bbase + ((size_t)(kt) * 64 + (i) * 8) * ldb4) : "memory")
#define G_WRITE_B(i, buf) do { u32x2 w_ = {pk_bf16(sb[i][0], sb[i][1]), pk_bf16(sb[i][2], sb[i][3])}; \
        *(LAS u32x2*)(lds + (buf) * G_STAGE_B + (((i) & 1) ? b_lds1 : b_lds0) + (i) * 8 * B_PITCH) = w_; } while (0)
#define G_KSTEP(buf, ks) do { bf16x8 At[8], Bf[4]; \
        _Pragma("unroll") for (int n = 0; n < 4; ++n) { const s16x4 lo_ = vtr(lds + (buf) * G_STAGE_B + b_rd + (ks) * 32 * B_PITCH + n * 32), hi_ = vtr(lds + (buf) * G_STAGE_B + b_rd + (ks) * 32 * B_PITCH + 4 * B_PITCH + n * 32); \
            Bf[n] = (bf16x8){lo_[0], lo_[1], lo_[2], lo_[3], hi_[0], hi_[1], hi_[2], hi_[3]}; } \
        _Pragma("unroll") for (int m = 0; m < 8; ++m) At[m] = *(const LAS bf16x8*)(lds + (buf) * G_STAGE_B + ((ks) ? a_rd1 : a_rd0) + m * 2048); \
        SBAR(); __builtin_amdgcn_s_setprio(1); \
        _Pragma("unroll") for (int m = 0; m < 8; ++m) _Pragma("unroll") for (int n = 0; n < 4; ++n) \
            acc[m][n] = __builtin_amdgcn_mfma_f32_16x16x32_bf16(Bf[n], At[m], acc[m][n], 0, 0, 0); \
        __builtin_amdgcn_s_setprio(0); SBAR(); } while (0)
#pragma unroll
    for (int i = 0; i < 4; ++i) G_STAGE_A(i, 0, 0);
#pragma unroll
    for (int i = 0; i < 8; ++i) G_ISSUE_B(i, 0);
    WAIT_V4(0, sb[0], sb[1], sb[2], sb[3]); WAIT_V4(0, sb[4], sb[5], sb[6], sb[7]);
#pragma unroll
    for (int i = 0; i < 8; ++i) G_WRITE_B(i, 0);
    SBAR();
#pragma unroll
    for (int i = 0; i < 8; ++i) G_ISSUE_B(i, 1);
    SBAR();
    RAW_BARRIER();
#pragma unroll 1
    for (int t = 0; t < nt; ++t) {
        const int cur = t & 1, nxt = cur ^ 1;
        if constexpr (MID) { if (t == (nt >> 1)) epi.mid(acc, wr, wc, fr, fq); }
        const int k1 = (t + 1 < nt) ? t + 1 : nt - 1, k2 = (t + 2 < nt) ? t + 2 : nt - 1;
        G_STAGE_A(0, k1, nxt); G_STAGE_A(1, k1, nxt); G_STAGE_A(2, k1, nxt); G_STAGE_A(3, k1, nxt);
        G_KSTEP(cur, 0);
        WAIT_V4(8, sb[0], sb[1], sb[2], sb[3]);
        G_WRITE_B(0, nxt); G_WRITE_B(1, nxt); G_WRITE_B(2, nxt); G_WRITE_B(3, nxt); SBAR();
        G_ISSUE_B(0, k2); G_ISSUE_B(1, k2); G_ISSUE_B(2, k2); G_ISSUE_B(3, k2); SBAR();
        G_KSTEP(cur, 1);
        WAIT_V4(8, sb[4], sb[5], sb[6], sb[7]);
        G_WRITE_B(4, nxt); G_WRITE_B(5, nxt); G_WRITE_B(6, nxt); G_WRITE_B(7, nxt); SBAR();
        G_ISSUE_B(4, k2); G_ISSUE_B(5, k2); G_ISSUE_B(6, k2); G_ISSUE_B(7, k2); SBAR();
        asm volatile("s_waitcnt vmcnt(8)" ::: "memory");
        RAW_BARRIER();
    }
    WAIT_V4(0, sb[0], sb[1], sb[2], sb[3]); WAIT_V4(0, sb[4], sb[5], sb[6], sb[7]);
    epi.fin(acc, wr, wc, fr, fq);
#undef G_STAGE_A
#undef G_ISSUE_B
#undef G_WRITE_B
#undef G_KSTEP
}

constexpr int A8_TILE_B = 16384, B8_PITCH = 288, B8_TILE_B = 64 * B8_PITCH;
constexpr int A8_RING = 5, B8_RING = 4, B8_OFF = A8_RING * A8_TILE_B;
static_assert(B8_OFF + B8_RING * B8_TILE_B <= LDS_MISC, "fp8 rings fit below the misc words");
__device__ __forceinline__ v2i vtr8(const LAS char* p) { return __builtin_amdgcn_ds_read_tr8_b64_v2i32((LAS v2i*)p); }
template <int SCALE_X, class AF, class BF, class EPI>
__device__ __forceinline__ void gemm_unit8(LAS char* lds, LAS unsigned* ring_cnt, const int nt, const AF& af, const BF& bf, EPI& epi) {
    const int tid = threadIdx.x, wid = __builtin_amdgcn_readfirstlane(tid >> 6), lane = tid & 63, wr = wid >> 2, wc = wid & 3, r32 = lane & 31, hi = lane >> 5;
    const char* abase = uniform_ptr(af.base);
    unsigned aoff[2];
#pragma unroll
    for (int i = 0; i < 2; ++i) { const int R = wid * 16 + i * 128 + (lane >> 2), C = ((lane & 3) ^ ((lane >> 4) & 3)) * 16; aoff[i] = af.rowoff(R) + (unsigned)C; }
    const unsigned lds_u = (unsigned)__builtin_amdgcn_readfirstlane((int)(unsigned)(size_t)lds) + (unsigned)(wid * 1024);
    const size_t ldb4 = (size_t)bf.ld * 4;
    const char* bbase = uniform_ptr(bf.base) + (size_t)wid * ldb4;
    const unsigned boff = bf.coloff(4 * lane) * 4u;
    const int b_wr = B8_OFF + wid * B8_PITCH + 4 * lane;
    const int a_rd0 = (wr * 128 + r32) * 64 + (((2 * hi) ^ ((r32 >> 2) & 3)) << 4), a_rd1 = a_rd0 ^ 16;
    const int b_rd = B8_OFF + (32 * hi + ((lane & 15) >> 1)) * B8_PITCH + wc * 64 + 16 * ((lane >> 4) & 1) + 8 * (lane & 1);
    f32x16 acc[4][2];
#pragma unroll
    for (int m = 0; m < 4; ++m)
#pragma unroll
        for (int n = 0; n < 2; ++n)
#pragma unroll
            for (int r = 0; r < 16; ++r) acc[m][n][r] = 0.f;
    f32x4 sb[8];
#define H_STAGE_A(i, kt, slot) glds16s(abase + (size_t)(kt) * 64, aoff[i], lds_u + (unsigned)((slot) * A8_TILE_B + (i) * 8192))
#define H_ISSUE_B(i, kt) asm volatile("s_nop 4\n\tglobal_load_dwordx4 %0, %1, %2" : "=v"(sb[i]) : "v"(boff), "s"(bbase + ((size_t)(kt) * 64 + (i) * 8) * ldb4) : "memory")
#define H_WRITE_B(i, slot) *(LAS unsigned*)(lds + (slot) * B8_TILE_B + b_wr + (i) * 8 * B8_PITCH) = pk4_fp8_x64(sb[i])
#define H_KSTEP(sa, sbk) do { v8i Xf[4], Wf[2]; \
        _Pragma("unroll") for (int n = 0; n < 2; ++n) _Pragma("unroll") for (int r = 0; r < 4; ++r) { const v2i t_ = vtr8(lds + (sbk) * B8_TILE_B + b_rd + r * 8 * B8_PITCH + n * 32); Wf[n][2 * r] = t_[0]; Wf[n][2 * r + 1] = t_[1]; } \
        _Pragma("unroll") for (int m = 0; m < 4; ++m) { const i32x4 lo_ = *(const LAS i32x4*)(lds + (sa) * A8_TILE_B + a_rd0 + m * 2048), hi_ = *(const LAS i32x4*)(lds + (sa) * A8_TILE_B + a_rd1 + m * 2048); \
            Xf[m] = (v8i){lo_[0], lo_[1], lo_[2], lo_[3], hi_[0], hi_[1], hi_[2], hi_[3]}; } \
        SBAR(); __builtin_amdgcn_s_setprio(1); \
        _Pragma("unroll") for (int m = 0; m < 4; ++m) _Pragma("unroll") for (int n = 0; n < 2; ++n) \
            acc[m][n] = __builtin_amdgcn_mfma_scale_f32_32x32x64_f8f6f4(Wf[n], Xf[m], acc[m][n], 0, 0, 0, 0x79797979, 0, SCALE_X); \
        __builtin_amdgcn_s_setprio(0); SBAR(); } while (0)
    if (tid < 8) ring_cnt[tid] = 0u;
    H_STAGE_A(0, 0, 0); H_STAGE_A(1, 0, 0); H_STAGE_A(0, 1, 1); H_STAGE_A(1, 1, 1);
#pragma unroll
    for (int i = 0; i < 8; ++i) H_ISSUE_B(i, 0);
    WAIT_V4(0, sb[0], sb[1], sb[2], sb[3]); WAIT_V4(0, sb[4], sb[5], sb[6], sb[7]);
#pragma unroll
    for (int i = 0; i < 8; ++i) H_WRITE_B(i, 0);
    SBAR();
#pragma unroll
    for (int i = 0; i < 8; ++i) H_ISSUE_B(i, 1);
    WAIT_V4(0, sb[0], sb[1], sb[2], sb[3]); WAIT_V4(0, sb[4], sb[5], sb[6], sb[7]);
#pragma unroll
    for (int i = 0; i < 8; ++i) H_WRITE_B(i, 1);
    SBAR();
    H_STAGE_A(0, 2, 2); H_STAGE_A(1, 2, 2);
#pragma unroll
    for (int i = 0; i < 8; ++i) H_ISSUE_B(i, 2);
    SBAR();
    RAW_BARRIER();
    int sa_r = 0, sa_w = 3, sb_r = 0, sb_w = 2;
#pragma unroll 1
    for (int t = 0; t < nt; ++t) {
        if (t >= 2) {
            const unsigned need = (unsigned)(t - 1);
            for (;;) { asm volatile("" ::: "memory"); const unsigned v = *(volatile LAS unsigned*)(ring_cnt + (lane & 7)); if (__all(v >= need)) break; __builtin_amdgcn_s_sleep(1); }
            asm volatile("" ::: "memory");
        }
        const int k3 = (t + 3 < nt) ? t + 3 : nt - 1;
        H_STAGE_A(0, k3, sa_w); H_STAGE_A(1, k3, sa_w);
        H_KSTEP(sa_r, sb_r);
        WAIT_V4(6, sb[0], sb[1], sb[2], sb[3]);
        H_WRITE_B(0, sb_w); H_WRITE_B(1, sb_w); H_WRITE_B(2, sb_w); H_WRITE_B(3, sb_w); SBAR();
        H_ISSUE_B(0, k3); H_ISSUE_B(1, k3); H_ISSUE_B(2, k3); H_ISSUE_B(3, k3); SBAR();
        WAIT_V4(6, sb[4], sb[5], sb[6], sb[7]);
        H_WRITE_B(4, sb_w); H_WRITE_B(5, sb_w); H_WRITE_B(6, sb_w); H_WRITE_B(7, sb_w); SBAR();
        H_ISSUE_B(4, k3); H_ISSUE_B(5, k3); H_ISSUE_B(6, k3); H_ISSUE_B(7, k3); SBAR();
        asm volatile("" ::: "memory");
        if (lane == 0) *(volatile LAS unsigned*)(ring_cnt + wid) = (unsigned)(t + 1);
        asm volatile("" ::: "memory");
        sa_r = (sa_r == A8_RING - 1) ? 0 : sa_r + 1; sa_w = (sa_w == A8_RING - 1) ? 0 : sa_w + 1;
        sb_r = (sb_r == B8_RING - 1) ? 0 : sb_r + 1; sb_w = (sb_w == B8_RING - 1) ? 0 : sb_w + 1;
    }
    WAIT_V4(0, sb[0], sb[1], sb[2], sb[3]); WAIT_V4(0, sb[4], sb[5], sb[6], sb[7]);
    RAW_BARRIER();
    epi.fin(acc, wr, wc, r32, hi);
#undef H_STAGE_A
#undef H_ISSUE_B
#undef H_WRITE_B
#undef H_KSTEP
}

template <int SCALE_X, class AF, class BF, class EPI>
__device__ __forceinline__ void gemm_unit8h(LAS char* lds, LAS unsigned* ring_cnt, const int nt, const AF& af, const BF& bf, EPI& epi) {
    const int tid = threadIdx.x, wid = __builtin_amdgcn_readfirstlane(tid >> 6), lane = tid & 63, wr = wid >> 2, wc = wid & 3, r32 = lane & 31, hi = lane >> 5;
    const char* abase = uniform_ptr(af.base);
    unsigned aoff[2];
#pragma unroll
    for (int i = 0; i < 2; ++i) { const int R = wid * 16 + i * 128 + (lane >> 2), C = ((lane & 3) ^ ((lane >> 4) & 3)) * 16; aoff[i] = af.rowoff(R) + (unsigned)C; }
    const unsigned lds_u = (unsigned)__builtin_amdgcn_readfirstlane((int)(unsigned)(size_t)lds) + (unsigned)(wid * 1024);
    const size_t ldb4 = (size_t)bf.ld * 4;
    const char* bbase = uniform_ptr(bf.base) + (size_t)wid * ldb4;
    const unsigned boff = (unsigned)(lane >> 5) * 8u * (unsigned)ldb4 + bf.coloff(4 * (lane & 31)) * 4u;
    const int b_wr = B8_OFF + (wid + 8 * (lane >> 5)) * B8_PITCH + 4 * (lane & 31);
    const int a_rd0 = (wr * 128 + r32) * 64 + (((2 * hi) ^ ((r32 >> 2) & 3)) << 4), a_rd1 = a_rd0 ^ 16;
    const int b_rd = B8_OFF + (32 * hi + ((lane & 15) >> 1)) * B8_PITCH + wc * 32 + 16 * ((lane >> 4) & 1) + 8 * (lane & 1);
    f32x16 acc[4][1];
#pragma unroll
    for (int m = 0; m < 4; ++m)
#pragma unroll
        for (int n = 0; n < 1; ++n)
#pragma unroll
            for (int r = 0; r < 16; ++r) acc[m][n][r] = 0.f;
    f32x4 sb[4];
#define H_STAGE_A(i, kt, slot) glds16s(abase + (size_t)(kt) * 64, aoff[i], lds_u + (unsigned)((slot) * A8_TILE_B + (i) * 8192))
#define H_ISSUE_B(i, kt) asm volatile("s_nop 4\n\tglobal_load_dwordx4 %0, %1, %2" : "=v"(sb[i]) : "v"(boff), "s"(bbase + ((size_t)(kt) * 64 + (i) * 16) * ldb4) : "memory")
#define H_WRITE_B(i, slot) *(LAS unsigned*)(lds + (slot) * B8_TILE_B + b_wr + (i) * 16 * B8_PITCH) = pk4_fp8_x64(sb[i])
#define H_KSTEP(sa, sbk) do { v8i Xf[4], Wf[1]; \
        _Pragma("unroll") for (int n = 0; n < 1; ++n) _Pragma("unroll") for (int r = 0; r < 4; ++r) { const v2i t_ = vtr8(lds + (sbk) * B8_TILE_B + b_rd + r * 8 * B8_PITCH + n * 32); Wf[n][2 * r] = t_[0]; Wf[n][2 * r + 1] = t_[1]; } \
        _Pragma("unroll") for (int m = 0; m < 4; ++m) { const i32x4 lo_ = *(const LAS i32x4*)(lds + (sa) * A8_TILE_B + a_rd0 + m * 2048), hi_ = *(const LAS i32x4*)(lds + (sa) * A8_TILE_B + a_rd1 + m * 2048); \
            Xf[m] = (v8i){lo_[0], lo_[1], lo_[2], lo_[3], hi_[0], hi_[1], hi_[2], hi_[3]}; } \
        SBAR(); __builtin_amdgcn_s_setprio(1); \
        _Pragma("unroll") for (int m = 0; m < 4; ++m) _Pragma("unroll") for (int n = 0; n < 1; ++n) \
            acc[m][n] = __builtin_amdgcn_mfma_scale_f32_32x32x64_f8f6f4(Wf[n], Xf[m], acc[m][n], 0, 0, 0, 0x79797979, 0, SCALE_X); \
        __builtin_amdgcn_s_setprio(0); SBAR(); } while (0)
    if (tid < 8) ring_cnt[tid] = 0u;
    H_STAGE_A(0, 0, 0); H_STAGE_A(1, 0, 0); H_STAGE_A(0, 1, 1); H_STAGE_A(1, 1, 1);
#pragma unroll
    for (int i = 0; i < 4; ++i) H_ISSUE_B(i, 0);
    WAIT_V4(0, sb[0], sb[1], sb[2], sb[3]);
#pragma unroll
    for (int i = 0; i < 4; ++i) H_WRITE_B(i, 0);
    SBAR();
#pragma unroll
    for (int i = 0; i < 4; ++i) H_ISSUE_B(i, 1);
    WAIT_V4(0, sb[0], sb[1], sb[2], sb[3]);
#pragma unroll
    for (int i = 0; i < 4; ++i) H_WRITE_B(i, 1);
    SBAR();
    H_STAGE_A(0, 2, 2); H_STAGE_A(1, 2, 2);
#pragma unroll
    for (int i = 0; i < 4; ++i) H_ISSUE_B(i, 2);
    SBAR();
    RAW_BARRIER();
    int sa_r = 0, sa_w = 3, sb_r = 0, sb_w = 2;
#pragma unroll 1
    for (int t = 0; t < nt; ++t) {
        if (t >= 2) {
            const unsigned need = (unsigned)(t - 1);
            for (;;) { asm volatile("" ::: "memory"); const unsigned v = *(volatile LAS unsigned*)(ring_cnt + (lane & 7)); if (__all(v >= need)) break; __builtin_amdgcn_s_sleep(1); }
            asm volatile("" ::: "memory");
        }
        const int k3 = (t + 3 < nt) ? t + 3 : nt - 1;
        H_STAGE_A(0, k3, sa_w); H_STAGE_A(1, k3, sa_w);
        H_KSTEP(sa_r, sb_r);
        WAIT_V4(2, sb[0], sb[1], sb[2], sb[3]);
        H_WRITE_B(0, sb_w); H_WRITE_B(1, sb_w); H_WRITE_B(2, sb_w); H_WRITE_B(3, sb_w); SBAR();
        H_ISSUE_B(0, k3); H_ISSUE_B(1, k3); H_ISSUE_B(2, k3); H_ISSUE_B(3, k3); SBAR();
        asm volatile("" ::: "memory");
        if (lane == 0) *(volatile LAS unsigned*)(ring_cnt + wid) = (unsigned)(t + 1);
        asm volatile("" ::: "memory");
        sa_r = (sa_r == A8_RING - 1) ? 0 : sa_r + 1; sa_w = (sa_w == A8_RING - 1) ? 0 : sa_w + 1;
        sb_r = (sb_r == B8_RING - 1) ? 0 : sb_r + 1; sb_w = (sb_w == B8_RING - 1) ? 0 : sb_w + 1;
    }
    WAIT_V4(0, sb[0], sb[1], sb[2], sb[3]);
    RAW_BARRIER();
    epi.fin(acc, wr, wc, r32, hi);
#undef H_STAGE_A
#undef H_ISSUE_B
#undef H_WRITE_B
#undef H_KSTEP
}

template <int SCALE_X, class AF, class BF, class EPI>
__device__ __forceinline__ void gemm_unit8q(LAS char* lds, LAS unsigned* ring_cnt, const int nt, const AF& af, const BF& bf, EPI& epi) {
    const int tid = threadIdx.x, wid = __builtin_amdgcn_readfirstlane(tid >> 6), lane = tid & 63, wr = wid >> 1, wc = wid & 1, r32 = lane & 31, hi = lane >> 5;
    const char* abase = uniform_ptr(af.base);
    unsigned aoff[2];
#pragma unroll
    for (int i = 0; i < 2; ++i) { const int R = wid * 16 + i * 128 + (lane >> 2), C = ((lane & 3) ^ ((lane >> 4) & 3)) * 16; aoff[i] = af.rowoff(R) + (unsigned)C; }
    const unsigned lds_u = (unsigned)__builtin_amdgcn_readfirstlane((int)(unsigned)(size_t)lds) + (unsigned)(wid * 1024);
    const size_t ldb4 = (size_t)bf.ld * 4;
    const char* bbase = uniform_ptr(bf.base) + (size_t)wid * ldb4;
    const unsigned boff = (unsigned)(lane >> 5) * 8u * (unsigned)ldb4 + bf.coloff(4 * (lane & 31)) * 4u;
    const int b_wr = B8_OFF + (wid + 8 * (lane >> 5)) * B8_PITCH + 4 * (lane & 31);
    const int a_rd0 = (wr * 64 + r32) * 64 + (((2 * hi) ^ ((r32 >> 2) & 3)) << 4), a_rd1 = a_rd0 ^ 16;
    const int b_rd = B8_OFF + (32 * hi + ((lane & 15) >> 1)) * B8_PITCH + wc * 64 + 16 * ((lane >> 4) & 1) + 8 * (lane & 1);
    f32x16 acc[2][2];
#pragma unroll
    for (int m = 0; m < 2; ++m)
#pragma unroll
        for (int n = 0; n < 2; ++n)
#pragma unroll
            for (int r = 0; r < 16; ++r) acc[m][n][r] = 0.f;
    f32x4 sb[4];
#define H_STAGE_A(i, kt, slot) glds16s(abase + (size_t)(kt) * 64, aoff[i], lds_u + (unsigned)((slot) * A8_TILE_B + (i) * 8192))
#define H_ISSUE_B(i, kt) asm volatile("s_nop 4\n\tglobal_load_dwordx4 %0, %1, %2" : "=v"(sb[i]) : "v"(boff), "s"(bbase + ((size_t)(kt) * 64 + (i) * 16) * ldb4) : "memory")
#define H_WRITE_B(i, slot) *(LAS unsigned*)(lds + (slot) * B8_TILE_B + b_wr + (i) * 16 * B8_PITCH) = pk4_fp8_x64(sb[i])
#define H_KSTEP(sa, sbk) do { v8i Xf[2], Wf[2]; \
        _Pragma("unroll") for (int n = 0; n < 2; ++n) _Pragma("unroll") for (int r = 0; r < 4; ++r) { const v2i t_ = vtr8(lds + (sbk) * B8_TILE_B + b_rd + r * 8 * B8_PITCH + n * 32); Wf[n][2 * r] = t_[0]; Wf[n][2 * r + 1] = t_[1]; } \
        _Pragma("unroll") for (int m = 0; m < 2; ++m) { const i32x4 lo_ = *(const LAS i32x4*)(lds + (sa) * A8_TILE_B + a_rd0 + m * 2048), hi_ = *(const LAS i32x4*)(lds + (sa) * A8_TILE_B + a_rd1 + m * 2048); \
            Xf[m] = (v8i){lo_[0], lo_[1], lo_[2], lo_[3], hi_[0], hi_[1], hi_[2], hi_[3]}; } \
        SBAR(); __builtin_amdgcn_s_setprio(1); \
        _Pragma("unroll") for (int m = 0; m < 2; ++m) _Pragma("unroll") for (int n = 0; n < 2; ++n) \
            acc[m][n] = __builtin_amdgcn_mfma_scale_f32_32x32x64_f8f6f4(Wf[n], Xf[m], acc[m][n], 0, 0, 0, 0x79797979, 0, SCALE_X); \
        __builtin_amdgcn_s_setprio(0); SBAR(); } while (0)
    if (tid < 8) ring_cnt[tid] = 0u;
    H_STAGE_A(0, 0, 0); H_STAGE_A(1, 0, 0); H_STAGE_A(0, 1, 1); H_STAGE_A(1, 1, 1);
#pragma unroll
    for (int i = 0; i < 4; ++i) H_ISSUE_B(i, 0);
    WAIT_V4(0, sb[0], sb[1], sb[2], sb[3]);
#pragma unroll
    for (int i = 0; i < 4; ++i) H_WRITE_B(i, 0);
    SBAR();
#pragma unroll
    for (int i = 0; i < 4; ++i) H_ISSUE_B(i, 1);
    WAIT_V4(0, sb[0], sb[1], sb[2], sb[3]);
#pragma unroll
    for (int i = 0; i < 4; ++i) H_WRITE_B(i, 1);
    SBAR();
    H_STAGE_A(0, 2, 2); H_STAGE_A(1, 2, 2);
#pragma unroll
    for (int i = 0; i < 4; ++i) H_ISSUE_B(i, 2);
    SBAR();
    RAW_BARRIER();
    int sa_r = 0, sa_w = 3, sb_r = 0, sb_w = 2;
#pragma unroll 1
    for (int t = 0; t < nt; ++t) {
        if (t >= 2) {
            const unsigned need = (unsigned)(t - 1);
            for (;;) { asm volatile("" ::: "memory"); const unsigned v = *(volatile LAS unsigned*)(ring_cnt + (lane & 7)); if (__all(v >= need)) break; __builtin_amdgcn_s_sleep(1); }
            asm volatile("" ::: "memory");
        }
        const int k3 = (t + 3 < nt) ? t + 3 : nt - 1;
        H_STAGE_A(0, k3, sa_w); H_STAGE_A(1, k3, sa_w);
        H_KSTEP(sa_r, sb_r);
        WAIT_V4(2, sb[0], sb[1], sb[2], sb[3]);
        H_WRITE_B(0, sb_w); H_WRITE_B(1, sb_w); H_WRITE_B(2, sb_w); H_WRITE_B(3, sb_w); SBAR();
        H_ISSUE_B(0, k3); H_ISSUE_B(1, k3); H_ISSUE_B(2, k3); H_ISSUE_B(3, k3); SBAR();
        asm volatile("" ::: "memory");
        if (lane == 0) *(volatile LAS unsigned*)(ring_cnt + wid) = (unsigned)(t + 1);
        asm volatile("" ::: "memory");
        sa_r = (sa_r == A8_RING - 1) ? 0 : sa_r + 1; sa_w = (sa_w == A8_RING - 1) ? 0 : sa_w + 1;
        sb_r = (sb_r == B8_RING - 1) ? 0 : sb_r + 1; sb_w = (sb_w == B8_RING - 1) ? 0 : sb_w + 1;
    }
    WAIT_V4(0, sb[0], sb[1], sb[2], sb[3]);
    RAW_BARRIER();
    epi.fin(acc, wr, wc, r32, hi);
#undef H_STAGE_A
#undef H_ISSUE_B
#undef H_WRITE_B
#undef H_KSTEP
}

struct Params {
    const float *x, *attn_norm, *w_in, *a_sink, *b_q_norm, *b_w_uq, *b_kv_norm, *b_w_ukv, *out_norm_a, *out_norm_b, *w_o, *mlp_norm, *w_router, *b_router,
        *w_up, *b_up, *w_down, *b_down, *final_norm;
    float* out; unsigned char* ws; int ph_lo, ph_hi;
};

struct ARows { const bf16_t* base; unsigned ld; __device__ __forceinline__ unsigned rowoff(int r) const { return (unsigned)r * ld; } };
struct AGather { const bf16_t* base; const int* tokl; int r0, cnt; __device__ __forceinline__ unsigned rowoff(int r) const { int rk = r0 + r; rk = rk < cnt ? rk : 0; return (unsigned)tokl[rk] * (unsigned)D_MODEL; } };
struct ARows8 { const unsigned char* base; unsigned ld; __device__ __forceinline__ unsigned rowoff(int r) const { return (unsigned)r * ld; } };
struct AGather8 { const unsigned char* base; const int* tokl; int r0, cnt; __device__ __forceinline__ unsigned rowoff(int r) const { int rk = r0 + r; rk = rk < cnt ? rk : 0; return (unsigned)tokl[rk] * (unsigned)D_MODEL; } };
struct BPlain { const float* base; size_t ld; int ncols;
    __device__ __forceinline__ unsigned coloff(int c) const { return (unsigned)(c < ncols ? c : (c & (ncols - 1))); } };
struct BGateUp { const float* base; size_t ld;
    __device__ __forceinline__ unsigned coloff(int c) const { const int wc = c >> 6, w = c & 63; return (unsigned)(wc * 32 + (w & 31) + ((w & 32) ? D_FF : 0)); } };

struct EpiProj {
    int pn, brow; unsigned char* ws; const float *qg, *kvg;
    __device__ __forceinline__ void mid(f32x4 (&)[8][4], int, int, int, int) {}
    __device__ __forceinline__ void fin(f32x4 (&acc)[8][4], int wr, int wc, int fr, int fq) {
        if (pn < 6) {
            bf16_t* dst; int ldd, c0;
            if (pn < 4) { dst = (bf16_t*)(ws + WS_QA); ldd = 1024; c0 = pn * 256; } else if (pn == 4) { dst = (bf16_t*)(ws + WS_KA); ldd = 256; c0 = 0; } else { dst = (bf16_t*)(ws + WS_VA); ldd = 256; c0 = 0; }
#pragma unroll
            for (int m = 0; m < 8; ++m) { const int row = brow + wr * 128 + m * 16 + fr;
#pragma unroll
                for (int n = 0; n < 4; ++n) { const int col = c0 + wc * 64 + n * 16 + fq * 4; const f32x4 v = acc[m][n];
                    *(u32x2*)(dst + (size_t)row * ldd + col) = (u32x2){pk_bf16(v[0], v[1]), pk_bf16(v[2], v[3])}; } }
        } else if (pn < 9) {
            bf16_t* dst; int ldd, c0; const float* g; float* ssq; int nsl, sl;
            if (pn < 8) { dst = (bf16_t*)(ws + WS_CQ); ldd = 512; c0 = (pn - 6) * 256; g = qg; ssq = (float*)(ws + WS_SSQC); nsl = 8; sl = (pn - 6) * 4 + wc; }
            else { dst = (bf16_t*)(ws + WS_CKV); ldd = 256; c0 = 0; g = kvg; ssq = (float*)(ws + WS_SSQK); nsl = 4; sl = wc; }
            f32x4 gvv[4];
#pragma unroll
            for (int n = 0; n < 4; ++n) gvv[n] = *(const f32x4*)(g + c0 + wc * 64 + n * 16 + fq * 4);
#pragma unroll
            for (int m = 0; m < 8; ++m) { const int row = brow + wr * 128 + m * 16 + fr; float ss = 0.f;
#pragma unroll
                for (int n = 0; n < 4; ++n) { const int col = c0 + wc * 64 + n * 16 + fq * 4; const f32x4 v = acc[m][n]; const f32x4 gv = gvv[n];
                    ss += v[0] * v[0] + v[1] * v[1] + v[2] * v[2] + v[3] * v[3];
                    *(u32x2*)(dst + (size_t)row * ldd + col) = (u32x2){pk_bf16(v[0] * gv[0], v[1] * gv[1]), pk_bf16(v[2] * gv[2], v[3] * gv[3])}; }
                ss += __shfl_xor(ss, 16, 64); ss += __shfl_xor(ss, 32, 64);
                if (fq == 0) ssq[(size_t)row * nsl + sl] = ss; }
        } else {
            if (wc == 0) {
                bf16_t* dst = (bf16_t*)(ws + WS_KPE); const float* rope = (const float*)(ws + WS_ROPE);
#pragma unroll
                for (int m = 0; m < 8; ++m) { const int row = brow + wr * 128 + m * 16 + fr; const int pos = row & (SEQ - 1);
#pragma unroll
                    for (int n = 0; n < 2; ++n) { const int i0 = n * 16 + fq * 4; const f32x4 x1 = acc[m][n], x2 = acc[m][n + 2];
                        const f32x4 cs0 = *(const f32x4*)(rope + ((size_t)pos * 32 + i0) * 2), cs1 = *(const f32x4*)(rope + ((size_t)pos * 32 + i0) * 2 + 4);
                        const float c[4] = {cs0[0], cs0[2], cs1[0], cs1[2]}, s[4] = {cs0[1], cs0[3], cs1[1], cs1[3]};
                        float o1[4], o2[4];
#pragma unroll
                        for (int j = 0; j < 4; ++j) { o1[j] = x1[j] * c[j] - x2[j] * s[j]; o2[j] = x1[j] * s[j] + x2[j] * c[j]; }
                        *(u32x2*)(dst + (size_t)row * 64 + i0) = (u32x2){pk_bf16(o1[0], o1[1]), pk_bf16(o1[2], o1[3])};
                        *(u32x2*)(dst + (size_t)row * 64 + 32 + i0) = (u32x2){pk_bf16(o2[0], o2[1]), pk_bf16(o2[2], o2[3])}; } }
            }
        }
    }
};
struct EpiQUp {
    int pn, brow; unsigned char* ws;
    __device__ __forceinline__ void mid(f32x4 (&)[8][4], int, int, int, int) {}
    __device__ __forceinline__ void fin(f32x4 (&acc)[8][4], int wr, int wc, int fr, int fq) {
        bf16_t* dst = (bf16_t*)(ws + WS_QB); const float* rope = (const float*)(ws + WS_ROPE); const float* ssq = (const float*)(ws + WS_CTL + CTL_SSQ_CQ);
        const int seg = pn * 4 + wc, head = seg / 3, part = seg - head * 3;
        float sq[8];
#pragma unroll
        for (int m = 0; m < 8; ++m) { const f32x4* pp = (const f32x4*)((const float*)(ws + WS_SSQC) + (size_t)(brow + wr * 128 + m * 16 + fr) * 8); const f32x4 p0 = pp[0], p1 = pp[1];
            sq[m] = ((p0[0] + p0[1]) + (p0[2] + p0[3])) + ((p1[0] + p1[1]) + (p1[2] + p1[3])); }
#pragma unroll
        for (int m = 0; m < 8; ++m) { const int row = brow + wr * 128 + m * 16 + fr; const float rs = rsqrtf(sq[m] * (1.f / 512.f) + EPS);
            bf16_t* drow = dst + (size_t)row * 1536 + head * 192 + part * 64;
            if (part < 2) {
#pragma unroll
                for (int n = 0; n < 4; ++n) { const f32x4 v = acc[m][n]; *(u32x2*)(drow + n * 16 + fq * 4) = (u32x2){pk_bf16(v[0] * rs, v[1] * rs), pk_bf16(v[2] * rs, v[3] * rs)}; }
            } else { const int pos = row & (SEQ - 1);
#pragma unroll
                for (int n = 0; n < 2; ++n) { const int i0 = n * 16 + fq * 4; const f32x4 x1 = acc[m][n], x2 = acc[m][n + 2];
                    const f32x4 cs0 = *(const f32x4*)(rope + ((size_t)pos * 32 + i0) * 2), cs1 = *(const f32x4*)(rope + ((size_t)pos * 32 + i0) * 2 + 4);
                    const float c[4] = {cs0[0], cs0[2], cs1[0], cs1[2]}, s[4] = {cs0[1], cs0[3], cs1[1], cs1[3]};
                    float o1[4], o2[4];
#pragma unroll
                    for (int j = 0; j < 4; ++j) { o1[j] = (x1[j] * c[j] - x2[j] * s[j]) * rs; o2[j] = (x1[j] * s[j] + x2[j] * c[j]) * rs; }
                    *(u32x2*)(drow + i0) = (u32x2){pk_bf16(o1[0], o1[1]), pk_bf16(o1[2], o1[3])};
                    *(u32x2*)(drow + 32 + i0) = (u32x2){pk_bf16(o2[0], o2[1]), pk_bf16(o2[2], o2[3])}; } }
        }
    }
};
struct EpiKvUp {
    int pn, brow; unsigned char* ws;
    __device__ __forceinline__ void mid(f32x4 (&)[8][4], int, int, int, int) {}
    __device__ __forceinline__ void fin(f32x4 (&acc)[8][4], int wr, int wc, int fr, int fq) {
        bf16_t* dst = (bf16_t*)(ws + WS_KVB);
        float sq[8];
#pragma unroll
        for (int m = 0; m < 8; ++m) { const f32x4 p0 = *(const f32x4*)((const float*)(ws + WS_SSQK) + (size_t)(brow + wr * 128 + m * 16 + fr) * 4); sq[m] = (p0[0] + p0[1]) + (p0[2] + p0[3]); }
#pragma unroll
        for (int m = 0; m < 8; ++m) { const int row = brow + wr * 128 + m * 16 + fr; const float rs = rsqrtf(sq[m] * (1.f / 256.f) + EPS);
#pragma unroll
            for (int n = 0; n < 4; ++n) { const int col = pn * 256 + wc * 64 + n * 16 + fq * 4; const f32x4 v = acc[m][n];
                *(u32x2*)(dst + (size_t)row * 2048 + col) = (u32x2){pk_bf16(v[0] * rs, v[1] * rs), pk_bf16(v[2] * rs, v[3] * rs)}; } }
    }
};
struct EpiWo {
    int pn, brow; unsigned char* ws; const float* x; const LAS float* tab;
    __device__ __forceinline__ void mid(f32x4 (&acc)[8][4], int wr, int wc, int fr, int fq) {
#pragma unroll
        for (int m = 0; m < 8; ++m) { const int r = wr * 128 + m * 16 + fr;
            const float f = __builtin_amdgcn_sqrtf((tab[256 + r] + EPS) * __builtin_amdgcn_rcpf(tab[r] + EPS));
#pragma unroll
            for (int n = 0; n < 4; ++n) acc[m][n] *= f;
            SBAR(); }
    }
    __device__ __forceinline__ void fin(f32x4 (&acc)[8][4], int wr, int wc, int fr, int fq) {
        float* x2 = (float*)(ws + WS_X2);
#pragma unroll
        for (int m = 0; m < 8; ++m) { const int r = wr * 128 + m * 16 + fr, row = brow + r; const float rbm = rsqrtf(tab[256 + r] + EPS); f32x4 xv[4];
#pragma unroll
            for (int n = 0; n < 4; ++n) xv[n] = *(const f32x4*)(x + (size_t)row * D_MODEL + pn * 256 + wc * 64 + n * 16 + fq * 4);
#pragma unroll
            for (int n = 0; n < 4; ++n) { const int col = pn * 256 + wc * 64 + n * 16 + fq * 4;
                const f32x4 v = acc[m][n] * rbm + xv[n];
                *(f32x4*)(x2 + (size_t)row * D_MODEL + col) = v; } }
    }
};
struct EpiUp8 {
    int j0, r0, cnt; unsigned char* dst; const float* bias;
    __device__ __forceinline__ void fin(f32x16 (&acc)[4][2], int wr, int wc, int r32, int hi) {
        f32x4 bg[4], bu[4];
#pragma unroll
        for (int rg = 0; rg < 4; ++rg) { const int j = j0 + wc * 32 + 8 * rg + 4 * hi; bg[rg] = *(const f32x4*)(bias + j); bu[rg] = *(const f32x4*)(bias + D_FF + j); }
#pragma unroll
        for (int m = 0; m < 4; ++m) { const int r = wr * 128 + m * 32 + r32; unsigned o8[4];
#pragma unroll
            for (int rg = 0; rg < 4; ++rg) { float o[4];
#pragma unroll
                for (int q = 0; q < 4; ++q) { const float g = fminf(acc[m][0][4 * rg + q] + bg[rg][q], 7.f), u = fminf(fmaxf(acc[m][1][4 * rg + q] + bu[rg][q], -7.f), 7.f);
                    const float sg = __builtin_amdgcn_rcpf(1.f + __builtin_amdgcn_exp2f(-1.702f * LOG2E * g)); o[q] = 4.f * (u + 1.f) * (g * sg); }
                o8[rg] = pk4_fp8(o[0], o[1], o[2], o[3]); }
            if (r0 + r < cnt) {
#pragma unroll
                for (int rg = 0; rg < 4; ++rg) *(unsigned*)(dst + (size_t)r * D_FF + j0 + wc * 32 + 8 * rg + 4 * hi) = o8[rg]; }
        }
    }
};
struct EpiUp8q {
    int j0, r0, cnt; unsigned char* dst; const float* bias;
    __device__ __forceinline__ void fin(f32x16 (&acc)[2][2], int wr, int wc, int r32, int hi) {
        f32x4 bg[4], bu[4];
#pragma unroll
        for (int rg = 0; rg < 4; ++rg) { const int j = j0 + wc * 32 + 8 * rg + 4 * hi; bg[rg] = *(const f32x4*)(bias + j); bu[rg] = *(const f32x4*)(bias + D_FF + j); }
#pragma unroll
        for (int m = 0; m < 2; ++m) { const int r = wr * 64 + m * 32 + r32; unsigned o8[4];
#pragma unroll
            for (int rg = 0; rg < 4; ++rg) { float o[4];
#pragma unroll
                for (int q = 0; q < 4; ++q) { const float g = fminf(acc[m][0][4 * rg + q] + bg[rg][q], 7.f), u = fminf(fmaxf(acc[m][1][4 * rg + q] + bu[rg][q], -7.f), 7.f);
                    const float sg = __builtin_amdgcn_rcpf(1.f + __builtin_amdgcn_exp2f(-1.702f * LOG2E * g)); o[q] = 4.f * (u + 1.f) * (g * sg); }
                o8[rg] = pk4_fp8(o[0], o[1], o[2], o[3]); }
            if (r0 + r < cnt) {
#pragma unroll
                for (int rg = 0; rg < 4; ++rg) *(unsigned*)(dst + (size_t)r * D_FF + j0 + wc * 32 + 8 * rg + 4 * hi) = o8[rg]; }
        }
    }
};
struct EpiDown8 {
    int c0, r0, cnt; bf16_t* dst; const float* bias;
    __device__ __forceinline__ void fin(f32x16 (&acc)[4][2], int wr, int wc, int r32, int hi) {
        f32x4 b[2][4];
#pragma unroll
        for (int n = 0; n < 2; ++n)
#pragma unroll
            for (int rg = 0; rg < 4; ++rg) b[n][rg] = *(const f32x4*)(bias + c0 + wc * 64 + n * 32 + 8 * rg + 4 * hi);
#pragma unroll
        for (int m = 0; m < 4; ++m) { const int r = wr * 128 + m * 32 + r32;
            if (r0 + r < cnt) {
#pragma unroll
                for (int n = 0; n < 2; ++n)
#pragma unroll
                    for (int rg = 0; rg < 4; ++rg) { const int col = c0 + wc * 64 + n * 32 + 8 * rg + 4 * hi;
                        *(u32x2*)(dst + (size_t)r * D_MODEL + col) = (u32x2){pk_bf16(acc[m][n][4 * rg] + b[n][rg][0], acc[m][n][4 * rg + 1] + b[n][rg][1]), pk_bf16(acc[m][n][4 * rg + 2] + b[n][rg][2], acc[m][n][4 * rg + 3] + b[n][rg][3])}; } }
        }
    }
};
struct EpiDown8h {
    int c0, r0, cnt; bf16_t* dst; const float* bias;
    __device__ __forceinline__ void fin(f32x16 (&acc)[4][1], int wr, int wc, int r32, int hi) {
        f32x4 b[1][4];
#pragma unroll
        for (int n = 0; n < 1; ++n)
#pragma unroll
            for (int rg = 0; rg < 4; ++rg) b[n][rg] = *(const f32x4*)(bias + c0 + wc * 32 + n * 32 + 8 * rg + 4 * hi);
#pragma unroll
        for (int m = 0; m < 4; ++m) { const int r = wr * 128 + m * 32 + r32;
            if (r0 + r < cnt) {
#pragma unroll
                for (int n = 0; n < 1; ++n)
#pragma unroll
                    for (int rg = 0; rg < 4; ++rg) { const int col = c0 + wc * 32 + n * 32 + 8 * rg + 4 * hi;
                        *(u32x2*)(dst + (size_t)r * D_MODEL + col) = (u32x2){pk_bf16(acc[m][n][4 * rg] + b[n][rg][0], acc[m][n][4 * rg + 1] + b[n][rg][1]), pk_bf16(acc[m][n][4 * rg + 2] + b[n][rg][2], acc[m][n][4 * rg + 3] + b[n][rg][3])}; } }
        }
    }
};

constexpr int PG_HTB = 128 * 64 * 2;
__host__ __device__ __forceinline__ int pg_lds_byte(int r, int c) { const int st = (r >> 4) * 2 + (c >> 5), rr = r & 15, cc = c & 31, ob = rr * 64 + cc * 2; return st * 1024 + (ob ^ (((ob >> 9) & 1) << 5)); }
__host__ __device__ __forceinline__ void pg_stage_rc(int b, int& R, int& C) { const int st = b / 1024, sb = b % 1024, swz = sb ^ (((sb >> 9) & 1) << 5); R = (st >> 1) * 16 + swz / 64; C = (st & 1) * 32 + (swz % 64) / 2; }
__host__ __device__ __forceinline__ int pg_tcol(int rho) { return (rho & ~0x30) | ((rho & 0x10) << 1) | ((rho & 0x20) >> 1); }
template <bool MID, class EPI>
__device__ __forceinline__ void gemm_unit_pg(LAS char* lds, const bf16_t* A, const bf16_t* Bt, const int K, EPI& E) {
    const int tid = threadIdx.x, wid = __builtin_amdgcn_readfirstlane(tid >> 6), lane = tid & 63, wr = wid >> 2, wc = wid & 3, fr = lane & 15, fq = lane >> 4;
    const int nt = K / 64;
    unsigned voff[2];
#pragma unroll
    for (int i = 0; i < 2; ++i) { int R, C; pg_stage_rc(tid * 16 + i * 8192, R, C); voff[i] = (unsigned)(R * K + C) * 2u; }
    const size_t kstep = (size_t)(64 * 2), hstep = (size_t)128 * K * 2;
    const unsigned ldsw = (unsigned)wid * 1024u;
    const int aoff = pg_lds_byte(wr * 64 + fr, fq * 8), boff = pg_lds_byte(wc * 32 + fr, fq * 8);
#define PG_SA(b, h) (((b) * 2 + (h)) * PG_HTB)
#define PG_SB(b, h) ((4 + (b) * 2 + (h)) * PG_HTB)
#define PG_STAGE(bufoff, gbase) do { _Pragma("unroll") for (int _i = 0; _i < 2; ++_i) \
        __builtin_amdgcn_global_load_lds((const unsigned*)((const char*)(gbase) + voff[_i]), (LAS unsigned*)(lds + (bufoff) + ldsw + _i * 8192), 16, 0, 0); } while (0)
#define PG_LDA(dst, b, h) do { _Pragma("unroll") for (int m = 0; m < 4; ++m) _Pragma("unroll") for (int k = 0; k < 2; ++k) dst[m][k] = *(const LAS bf16x8*)(lds + PG_SA(b, h) + aoff + m * 2048 + k * 1024); } while (0)
#define PG_LDB(dst, b, h) do { _Pragma("unroll") for (int n = 0; n < 2; ++n) _Pragma("unroll") for (int k = 0; k < 2; ++k) dst[n][k] = *(const LAS bf16x8*)(lds + PG_SB(b, h) + boff + n * 2048 + k * 1024); } while (0)
#define PG_MMA(ai, bj, At_, Bt_) do { __builtin_amdgcn_s_setprio(1); _Pragma("unroll") for (int m = 0; m < 4; ++m) _Pragma("unroll") for (int n = 0; n < 2; ++n) _Pragma("unroll") for (int k = 0; k < 2; ++k) \
        acc[ai][bj][m][n] = __builtin_amdgcn_mfma_f32_16x16x32_bf16(Bt_[n][k], At_[m][k], acc[ai][bj][m][n], 0, 0, 0); __builtin_amdgcn_s_setprio(0); } while (0)
#define PG_WAIT_V(n) asm volatile("s_waitcnt vmcnt(" #n ")" ::: "memory")
#define PG_WAIT_L(n) asm volatile("s_waitcnt lgkmcnt(" #n ")" ::: "memory")
#define PG_BAR __builtin_amdgcn_s_barrier()
    f32x4 acc[2][2][4][2];
#pragma unroll
    for (int a = 0; a < 2; ++a)
#pragma unroll
        for (int b = 0; b < 2; ++b)
#pragma unroll
            for (int m = 0; m < 4; ++m)
#pragma unroll
                for (int n = 0; n < 2; ++n) acc[a][b][m][n] = (f32x4){0.f, 0.f, 0.f, 0.f};
    bf16x8 At[4][2], B0[2][2], B1[2][2];
    const char* cA = (const char*)A; const char* cB = (const char*)Bt;
    PG_STAGE(PG_SB(0, 0), cB); PG_STAGE(PG_SA(0, 0), cA); PG_STAGE(PG_SB(0, 1), cB + hstep); PG_STAGE(PG_SA(0, 1), cA + hstep);
    if (wr == 1) PG_BAR;
    PG_WAIT_V(4); PG_BAR;
    PG_STAGE(PG_SB(1, 0), cB + kstep); PG_STAGE(PG_SA(1, 0), cA + kstep); PG_STAGE(PG_SB(1, 1), cB + hstep + kstep);
    PG_WAIT_V(6); PG_BAR;
    for (int t = 0; t < nt; t += 2) {
        const bool last = (t == nt - 2);
        const char* a1 = cA + (size_t)(t + 1) * kstep;
        const char* a2 = cA + (size_t)(t + 2) * kstep; const char* b2 = cB + (size_t)(t + 2) * kstep;
        const char* a3 = a2 + kstep; const char* b3 = b2 + kstep;
        if (MID && t == (nt >> 1)) E.mid(acc, wr, wc, fr, fq);
        PG_LDB(B0, 0, 0); SBAR(); PG_LDA(At, 0, 0); PG_STAGE(PG_SA(1, 1), a1 + hstep);
        PG_WAIT_L(8); PG_BAR; PG_WAIT_L(0); PG_MMA(0, 0, At, B0); PG_BAR; SBAR();
        PG_LDB(B1, 0, 1); if (!last) PG_STAGE(PG_SB(0, 0), b2);
        PG_BAR; PG_WAIT_L(0); PG_MMA(0, 1, At, B1); PG_BAR;
        PG_LDA(At, 0, 1); if (!last) PG_STAGE(PG_SA(0, 0), a2);
        PG_BAR; PG_WAIT_L(0); PG_MMA(1, 0, At, B0); PG_BAR; SBAR();
        if (!last) { PG_STAGE(PG_SB(0, 1), b2 + hstep); PG_WAIT_V(6); } else PG_WAIT_V(0);
        PG_BAR; PG_MMA(1, 1, At, B1); PG_BAR;
        PG_LDB(B0, 1, 0); SBAR(); PG_LDA(At, 1, 0); if (!last) PG_STAGE(PG_SA(0, 1), a2 + hstep);
        PG_WAIT_L(8); PG_BAR; PG_WAIT_L(0); PG_MMA(0, 0, At, B0); PG_BAR; SBAR();
        PG_LDB(B1, 1, 1); if (!last) PG_STAGE(PG_SB(1, 0), b3);
        PG_BAR; PG_WAIT_L(0); PG_MMA(0, 1, At, B1); PG_BAR;
        PG_LDA(At, 1, 1); if (!last) PG_STAGE(PG_SA(1, 0), a3);
        PG_BAR; PG_WAIT_L(0); PG_MMA(1, 0, At, B0); PG_BAR; SBAR();
        if (!last) { PG_STAGE(PG_SB(1, 1), b3 + hstep); PG_WAIT_V(6); }
        PG_BAR; PG_MMA(1, 1, At, B1); PG_BAR;
    }
    E.fin(acc, wr, wc, fr, fq);
    PG_WAIT_V(0);
    if (wr == 0) PG_BAR;
    PG_BAR;
#undef PG_SA
#undef PG_SB
#undef PG_STAGE
#undef PG_LDA
#undef PG_LDB
#undef PG_MMA
#undef PG_WAIT_V
#undef PG_WAIT_L
#undef PG_BAR
}

#define PG_ROW(ai, m) (128 * (ai) + 64 * wr + 16 * (m) + fr)
#define PG_COL(bj, n) (128 * (bj) + 64 * (wc >> 1) + 32 * (n) + 16 * (wc & 1) + 4 * fq)
struct PEpiProj {
    int pn, brow; unsigned char* ws; const float *qg, *kvg;
    __device__ __forceinline__ void mid(f32x4 (&)[2][2][4][2], int, int, int, int) {}
    __device__ __forceinline__ void fin(f32x4 (&acc)[2][2][4][2], int wr, int wc, int fr, int fq) {
        if (pn < 6) {
            bf16_t* dst; int ldd, c0;
            if (pn < 4) { dst = (bf16_t*)(ws + WS_QA); ldd = 1024; c0 = pn * 256; } else if (pn == 4) { dst = (bf16_t*)(ws + WS_KA); ldd = 256; c0 = 0; } else { dst = (bf16_t*)(ws + WS_VA); ldd = 256; c0 = 0; }
#pragma unroll
            for (int ai = 0; ai < 2; ++ai)
#pragma unroll
                for (int m = 0; m < 4; ++m) { bf16_t* rowp = dst + (size_t)(brow + PG_ROW(ai, m)) * ldd + c0;
#pragma unroll
                    for (int bj = 0; bj < 2; ++bj)
#pragma unroll
                        for (int n = 0; n < 2; ++n) { const f32x4 v = acc[ai][bj][m][n]; *(u32x2*)(rowp + PG_COL(bj, n)) = (u32x2){pk_bf16(v[0], v[1]), pk_bf16(v[2], v[3])}; } }
        } else if (pn < 9) {
            bf16_t* dst; int ldd, c0; const float* g; float* ssq; int nsl, sl0;
            if (pn < 8) { dst = (bf16_t*)(ws + WS_CQ); ldd = 512; c0 = (pn - 6) * 256; g = qg; ssq = (float*)(ws + WS_SSQC); nsl = 16; sl0 = (pn - 6) * 8 + wc; }
            else { dst = (bf16_t*)(ws + WS_CKV); ldd = 256; c0 = 0; g = kvg; ssq = (float*)(ws + WS_SSQK); nsl = 8; sl0 = wc; }
            f32x4 gvv[2][2];
#pragma unroll
            for (int bj = 0; bj < 2; ++bj)
#pragma unroll
                for (int n = 0; n < 2; ++n) gvv[bj][n] = *(const f32x4*)(g + c0 + PG_COL(bj, n));
#pragma unroll
            for (int ai = 0; ai < 2; ++ai)
#pragma unroll
                for (int m = 0; m < 4; ++m) { const int row = brow + PG_ROW(ai, m);
#pragma unroll
                    for (int bj = 0; bj < 2; ++bj) { float ss = 0.f;
#pragma unroll
                        for (int n = 0; n < 2; ++n) { const f32x4 v = acc[ai][bj][m][n]; const f32x4 gv = gvv[bj][n];
                            ss += v[0] * v[0] + v[1] * v[1] + v[2] * v[2] + v[3] * v[3];
                            *(u32x2*)(dst + (size_t)row * ldd + c0 + PG_COL(bj, n)) = (u32x2){pk_bf16(v[0] * gv[0], v[1] * gv[1]), pk_bf16(v[2] * gv[2], v[3] * gv[3])}; }
                        ss += __shfl_xor(ss, 16, 64); ss += __shfl_xor(ss, 32, 64);
                        if (fq == 0) ssq[(size_t)row * nsl + sl0 + 4 * bj] = ss; } }
        } else {
            if (wc < 2) {
                bf16_t* dst = (bf16_t*)(ws + WS_KPE); const float* rope = (const float*)(ws + WS_ROPE); const int i0 = 16 * wc + 4 * fq;
#pragma unroll
                for (int ai = 0; ai < 2; ++ai)
#pragma unroll
                    for (int m = 0; m < 4; ++m) { const int row = brow + PG_ROW(ai, m); const int pos = row & (SEQ - 1); const f32x4 x1 = acc[ai][0][m][0], x2 = acc[ai][0][m][1];
                        const f32x4 cs0 = *(const f32x4*)(rope + ((size_t)pos * 32 + i0) * 2), cs1 = *(const f32x4*)(rope + ((size_t)pos * 32 + i0) * 2 + 4);
                        const float c[4] = {cs0[0], cs0[2], cs1[0], cs1[2]}, s[4] = {cs0[1], cs0[3], cs1[1], cs1[3]};
                        float o1[4], o2[4];
#pragma unroll
                        for (int j = 0; j < 4; ++j) { o1[j] = x1[j] * c[j] - x2[j] * s[j]; o2[j] = x1[j] * s[j] + x2[j] * c[j]; }
                        *(u32x2*)(dst + (size_t)row * 64 + i0) = (u32x2){pk_bf16(o1[0], o1[1]), pk_bf16(o1[2], o1[3])};
                        *(u32x2*)(dst + (size_t)row * 64 + 32 + i0) = (u32x2){pk_bf16(o2[0], o2[1]), pk_bf16(o2[2], o2[3])}; }
            }
        }
    }
};
struct PEpiQUp {
    int pn, brow; unsigned char* ws;
    __device__ __forceinline__ void mid(f32x4 (&)[2][2][4][2], int, int, int, int) {}
    __device__ __forceinline__ void fin(f32x4 (&acc)[2][2][4][2], int wr, int wc, int fr, int fq) {
        bf16_t* dst = (bf16_t*)(ws + WS_QB); const float* rope = (const float*)(ws + WS_ROPE);
        float rs[2][4];
#pragma unroll
        for (int ai = 0; ai < 2; ++ai)
#pragma unroll
            for (int m = 0; m < 4; ++m) { const f32x4* pp = (const f32x4*)((const float*)(ws + WS_SSQC) + (size_t)(brow + PG_ROW(ai, m)) * 16); const f32x4 p0 = pp[0], p1 = pp[1], p2 = pp[2], p3 = pp[3];
                const float sq = (((p0[0] + p0[1]) + (p0[2] + p0[3])) + ((p1[0] + p1[1]) + (p1[2] + p1[3]))) + (((p2[0] + p2[1]) + (p2[2] + p2[3])) + ((p3[0] + p3[1]) + (p3[2] + p3[3])));
                rs[ai][m] = rsqrtf(sq * (1.f / 512.f) + EPS); }
#pragma unroll
        for (int bj = 0; bj < 2; ++bj) { const int seg = pn * 4 + 2 * bj + (wc >> 1), head = seg / 3, part = seg - head * 3; const int i0 = 16 * (wc & 1) + 4 * fq;
#pragma unroll
            for (int ai = 0; ai < 2; ++ai)
#pragma unroll
                for (int m = 0; m < 4; ++m) { const int row = brow + PG_ROW(ai, m); const float r = rs[ai][m]; bf16_t* drow = dst + (size_t)row * 1536 + head * 192 + part * 64;
                    const f32x4 x1 = acc[ai][bj][m][0], x2 = acc[ai][bj][m][1];
                    if (part < 2) {
                        *(u32x2*)(drow + i0) = (u32x2){pk_bf16(x1[0] * r, x1[1] * r), pk_bf16(x1[2] * r, x1[3] * r)};
                        *(u32x2*)(drow + 32 + i0) = (u32x2){pk_bf16(x2[0] * r, x2[1] * r), pk_bf16(x2[2] * r, x2[3] * r)};
                    } else { const int pos = row & (SEQ - 1);
                        const f32x4 cs0 = *(const f32x4*)(rope + ((size_t)pos * 32 + i0) * 2), cs1 = *(const f32x4*)(rope + ((size_t)pos * 32 + i0) * 2 + 4);
                        const float c[4] = {cs0[0], cs0[2], cs1[0], cs1[2]}, s[4] = {cs0[1], cs0[3], cs1[1], cs1[3]};
                        float o1[4], o2[4];
#pragma unroll
                        for (int j = 0; j < 4; ++j) { o1[j] = (x1[j] * c[j] - x2[j] * s[j]) * r; o2[j] = (x1[j] * s[j] + x2[j] * c[j]) * r; }
                        *(u32x2*)(drow + i0) = (u32x2){pk_bf16(o1[0], o1[1]), pk_bf16(o1[2], o1[3])};
                        *(u32x2*)(drow + 32 + i0) = (u32x2){pk_bf16(o2[0], o2[1]), pk_bf16(o2[2], o2[3])}; } } }
    }
};
struct PEpiKvUp {
    int pn, brow; unsigned char* ws;
    __device__ __forceinline__ void mid(f32x4 (&)[2][2][4][2], int, int, int, int) {}
    __device__ __forceinline__ void fin(f32x4 (&acc)[2][2][4][2], int wr, int wc, int fr, int fq) {
        bf16_t* dst = (bf16_t*)(ws + WS_KVB);
#pragma unroll
        for (int ai = 0; ai < 2; ++ai)
#pragma unroll
            for (int m = 0; m < 4; ++m) { const int row = brow + PG_ROW(ai, m); const f32x4* pp = (const f32x4*)((const float*)(ws + WS_SSQK) + (size_t)row * 8); const f32x4 p0 = pp[0], p1 = pp[1];
                const float r = rsqrtf((((p0[0] + p0[1]) + (p0[2] + p0[3])) + ((p1[0] + p1[1]) + (p1[2] + p1[3]))) * (1.f / 256.f) + EPS);
#pragma unroll
                for (int bj = 0; bj < 2; ++bj)
#pragma unroll
                    for (int n = 0; n < 2; ++n) { const f32x4 v = acc[ai][bj][m][n];
                        *(u32x2*)(dst + (size_t)row * 2048 + pn * 256 + PG_COL(bj, n)) = (u32x2){pk_bf16(v[0] * r, v[1] * r), pk_bf16(v[2] * r, v[3] * r)}; } }
    }
};
struct PEpiWo {
    int pn, brow; unsigned char* ws; const float* x; const LAS float* tab;
    __device__ __forceinline__ void mid(f32x4 (&acc)[2][2][4][2], int wr, int wc, int fr, int fq) {
#pragma unroll
        for (int ai = 0; ai < 2; ++ai)
#pragma unroll
            for (int m = 0; m < 4; ++m) { const int r = PG_ROW(ai, m);
                const float f = __builtin_amdgcn_sqrtf((tab[256 + r] + EPS) * __builtin_amdgcn_rcpf(tab[r] + EPS));
#pragma unroll
                for (int bj = 0; bj < 2; ++bj)
#pragma unroll
                    for (int n = 0; n < 2; ++n) acc[ai][bj][m][n] *= f; }
        asm volatile("s_waitcnt lgkmcnt(0)" ::: "memory"); SBAR();
    }
    __device__ __forceinline__ void fin(f32x4 (&acc)[2][2][4][2], int wr, int wc, int fr, int fq) {
        float* x2 = (float*)(ws + WS_X2);
#pragma unroll
        for (int ai = 0; ai < 2; ++ai)
#pragma unroll
            for (int m = 0; m < 4; ++m) { const int r = PG_ROW(ai, m); const size_t o = (size_t)(brow + r) * D_MODEL + pn * 256; const float rbm = rsqrtf(tab[256 + r] + EPS); f32x4 xv[2][2];
#pragma unroll
                for (int bj = 0; bj < 2; ++bj)
#pragma unroll
                    for (int n = 0; n < 2; ++n) xv[bj][n] = *(const f32x4*)(x + o + PG_COL(bj, n));
#pragma unroll
                for (int bj = 0; bj < 2; ++bj)
#pragma unroll
                    for (int n = 0; n < 2; ++n) *(f32x4*)(x2 + o + PG_COL(bj, n)) = acc[ai][bj][m][n] * rbm + xv[bj][n]; }
    }
};
__device__ __forceinline__ void pg_convert(const float* W, int K, int ld, int ncols, int nrows, bf16_t* Bt, int item0, int nitems_stride) {
    const int total = nrows * (K >> 3);
    for (int it0 = item0; it0 < total; it0 += 4 * nitems_stride) { float v[4][8]; int row[4], k0[4]; bool ok[4];
#pragma unroll
        for (int b = 0; b < 4; ++b) { const int it = it0 + b * nitems_stride; const int itc = it < total ? it : item0; const int kc = itc / nrows; row[b] = itc - kc * nrows; k0[b] = kc << 3; ok[b] = it < total;
            const int col = (row[b] & ~255) + pg_tcol(row[b] & 255); const int colc = col < ncols ? col : 0; const float s = col < ncols ? 1.f : 0.f;
#pragma unroll
            for (int q = 0; q < 8; ++q) v[b][q] = W[(size_t)(k0[b] + q) * ld + colc] * s; }
#pragma unroll
        for (int b = 0; b < 4; ++b) if (ok[b])
            *(u32x4*)(Bt + (size_t)row[b] * K + k0[b]) = (u32x4){pk_bf16(v[b][0], v[b][1]), pk_bf16(v[b][2], v[b][3]), pk_bf16(v[b][4], v[b][5]), pk_bf16(v[b][6], v[b][7])}; }
}
__device__ __forceinline__ void sincos_d(double x, double& s, double& c) {
    const double k = __builtin_rint(x * 0.63661977236758134308);
    double r = __builtin_fma(-k, 1.57079632679489655800e+00, x); r = __builtin_fma(-k, 6.12323399573676603587e-17, r);
    const double r2 = r * r;
    double sp = -7.6471637318198164759e-13; sp = sp * r2 + 1.6059043836821614599e-10; sp = sp * r2 - 2.5052108385441718775e-08; sp = sp * r2 + 2.7557319223985890653e-06;
    sp = sp * r2 - 1.9841269841269841270e-04; sp = sp * r2 + 8.3333333333333333333e-03; sp = sp * r2 - 1.6666666666666666667e-01; const double sn = r + r * r2 * sp;
    double cp = 4.7794773323873852974e-14; cp = cp * r2 - 1.1470745597729724714e-11; cp = cp * r2 + 2.0876756987868098979e-09; cp = cp * r2 - 2.7557319223985890653e-07;
    cp = cp * r2 + 2.4801587301587301587e-05; cp = cp * r2 - 1.3888888888888888889e-03; cp = cp * r2 + 4.1666666666666666667e-02; cp = cp * r2 - 0.5; const double cn = 1.0 + r2 * cp;
    const int q = ((int)k) & 3;
    s = (q == 0) ? sn : (q == 1) ? cn : (q == 2) ? -sn : -cn;
    c = (q == 0) ? cn : (q == 1) ? -sn : (q == 2) ? -cn : sn;
}

__device__ __forceinline__ void phase_prologue(const Params& p) {
    const int tid = threadIdx.x, wid = tid >> 6, lane = tid & 63;
    bf16_t* xn = (bf16_t*)(p.ws + WS_XN);
    for (int row = blockIdx.x * 8 + wid; row < NTOK; row += gridDim.x * 8) {
        const f32x4* xr = (const f32x4*)(p.x + (size_t)row * D_MODEL); f32x4 v[8]; float ss = 0.f;
#pragma unroll
        for (int i = 0; i < 8; ++i) { v[i] = xr[lane + 64 * i]; ss += v[i][0] * v[i][0] + v[i][1] * v[i][1] + v[i][2] * v[i][2] + v[i][3] * v[i][3]; }
        ss = wave_sum(ss); const float rs = rsqrtf(ss * (1.f / D_MODEL) + EPS);
#pragma unroll
        for (int i = 0; i < 8; ++i) { const f32x4 g = ((const f32x4*)p.attn_norm)[lane + 64 * i];
            *(u32x2*)(xn + (size_t)row * D_MODEL + 4 * (lane + 64 * i)) = (u32x2){pk_bf16(v[i][0] * rs * g[0], v[i][1] * rs * g[1]), pk_bf16(v[i][2] * rs * g[2], v[i][3] * rs * g[3])}; }
    }
    const int gtid = blockIdx.x * 512 + tid;
    if (gtid < SEQ * 32) {
        const int pos = gtid >> 5, i = gtid & 31;
        double b = 10000.0; for (int q = 0; q < 5; ++q) b = __builtin_sqrt(b);
        double f = 1.0; for (int q = 0; q < i; ++q) f *= b;
        const float inv_freq = (float)(1.0 / f); const float ang = (float)pos * inv_freq;
        double s, c; sincos_d((double)ang, s, c);
        float* rope = (float*)(p.ws + WS_ROPE); rope[(size_t)gtid * 2] = (float)c; rope[(size_t)gtid * 2 + 1] = (float)s;
    }
    {
        const int nth = gridDim.x * 512;
        pg_convert(p.w_in, D_MODEL, IN_COLS, IN_COLS, 2560, (bf16_t*)(p.ws + WS_BT_IN), gtid, nth);
        pg_convert(p.b_w_uq, 512, 1536, 1536, 1536, (bf16_t*)(p.ws + WS_BT_UQ), gtid, nth);
    }
    if (gtid < N_EXP * D_MODEL) {
        ((float*)(p.ws + WS_WRT))[gtid] = p.w_router[gtid] * p.mlp_norm[gtid >> 5];
    }
}

constexpr int AA_PITCH = 144;
constexpr int AA_K = 0, AA_V = 384 * AA_PITCH;
constexpr int AA_WS = 2 * 384 * AA_PITCH;
__device__ __forceinline__ void attn_a_unit(const Params& p, LAS char* lds, int u) {
    const int tid = threadIdx.x, wid = __builtin_amdgcn_readfirstlane(tid >> 6), lane = tid & 63, r32 = lane & 31, hi = lane >> 5;
    const int b = u >> 7, nq = (u >> 2) & 31, kvh = u & 3;
    const bf16_t* QA = (const bf16_t*)(p.ws + WS_QA); const bf16_t* KA = (const bf16_t*)(p.ws + WS_KA); const bf16_t* VA = (const bf16_t*)(p.ws + WS_VA);
    const int P0 = (nq - 1) * 128;
    __syncthreads();
    for (int c = tid; c < 384 * 8; c += 512) { const int r = c >> 3, ch = c & 7; const int pos = P0 + r;
        i32x4 kv = {0, 0, 0, 0}, vv = {0, 0, 0, 0};
        if (pos >= 0 && pos < SEQ) { const size_t g = ((size_t)(b * SEQ + pos)) * 256 + kvh * 64 + ch * 8; kv = *(const i32x4*)(KA + g); vv = *(const i32x4*)(VA + g); }
        *(LAS i32x4*)(lds + AA_K + r * AA_PITCH + ch * 16) = kv; *(LAS i32x4*)(lds + AA_V + r * AA_PITCH + ch * 16) = vv; }
    __syncthreads();
    LAS float* wsf = (LAS float*)(lds + AA_WS) + wid * 64;
    const int hq = kvh * 4 + (wid >> 1);
    const float slope2 = __builtin_amdgcn_exp2f(-8.f * (float)(hq + 1) / 16.f) * LOG2E;
    const float sink2 = p.a_sink[hq] * LOG2E;
    const float C = 0.125f * LOG2E;
    const float* ga = p.out_norm_a + hq * 64;
    bf16_t* Y = (bf16_t*)(p.ws + WS_Y); float* ssqa = (float*)(p.ws + WS_SSQP);
    for (int blk = 0; blk < 2; ++blk) {
        const int q0 = nq * 128 + (wid & 1) * 64 + blk * 32;
        const int tq = q0 + r32;
        bf16x8 qr[4];
        { const bf16_t* qp = QA + ((size_t)(b * SEQ + tq)) * 1024 + hq * 64 + hi * 8;
#pragma unroll
          for (int d0 = 0; d0 < 4; ++d0) qr[d0] = *(const bf16x8*)(qp + d0 * 16); }
        float m_reg = sink2, l_reg = 1.f; f32x16 o[2] = {};
        for (int jt = 0; jt < 6; ++jt) {
            const int kp0 = P0 + jt * 64;
            if (kp0 + 63 < q0 - 128 || kp0 > q0 + 31 + 128 || kp0 + 63 < 0 || kp0 >= SEQ) continue;
            f32x16 p0 = {}, p1 = {};
#pragma unroll
            for (int d0 = 0; d0 < 4; ++d0) {
                const bf16x8 k0 = *(const LAS bf16x8*)(lds + AA_K + (jt * 64 + r32) * AA_PITCH + (d0 * 16 + hi * 8) * 2);
                const bf16x8 k1 = *(const LAS bf16x8*)(lds + AA_K + (jt * 64 + 32 + r32) * AA_PITCH + (d0 * 16 + hi * 8) * 2);
                p0 = __builtin_amdgcn_mfma_f32_32x32x16_bf16(k0, qr[d0], p0, 0, 0, 0);
                p1 = __builtin_amdgcn_mfma_f32_32x32x16_bf16(k1, qr[d0], p1, 0, 0, 0);
            }
            float pmax = -1e30f;
#pragma unroll
            for (int r = 0; r < 16; ++r) {
                { const int kp = kp0 + crow(r, hi); const int dist = tq > kp ? tq - kp : kp - tq; const bool ok = dist <= 128 && kp >= 0 && kp < SEQ;
                  p0[r] = ok ? p0[r] * C - slope2 * (float)dist : -1e30f; pmax = fmaxf(pmax, p0[r]); }
                { const int kp = kp0 + 32 + crow(r, hi); const int dist = tq > kp ? tq - kp : kp - tq; const bool ok = dist <= 128 && kp >= 0 && kp < SEQ;
                  p1[r] = ok ? p1[r] * C - slope2 * (float)dist : -1e30f; pmax = fmaxf(pmax, p1[r]); }
            }
            { auto rr = __builtin_amdgcn_permlane32_swap(__float_as_uint(pmax), __float_as_uint(pmax), false, false); pmax = fmaxf(__uint_as_float(rr[0]), __uint_as_float(rr[1])); }
            const float mn = fmaxf(m_reg, pmax); const float alpha = __builtin_amdgcn_exp2f(m_reg - mn); m_reg = mn;
            float ps = 0.f;
#pragma unroll
            for (int r = 0; r < 16; ++r) { p0[r] = __builtin_amdgcn_exp2f(p0[r] - mn); p1[r] = __builtin_amdgcn_exp2f(p1[r] - mn); ps += p0[r] + p1[r]; }
            { auto rr = __builtin_amdgcn_permlane32_swap(__float_as_uint(ps), __float_as_uint(ps), false, false); ps = __uint_as_float(rr[0]) + __uint_as_float(rr[1]); }
            l_reg = l_reg * alpha + ps;
            if (hi == 0) wsf[r32] = alpha;
            WAIT_L0();
#pragma unroll
            for (int r = 0; r < 16; ++r) { const float a = wsf[crow(r, hi)]; o[0][r] *= a; o[1][r] *= a; }
            bf16x8 pa[4];
#define PK4(P, BASE, OUT) do { unsigned a0 = pk_bf16(P[BASE + 0], P[BASE + 1]), a1 = pk_bf16(P[BASE + 2], P[BASE + 3]); \
    unsigned b0 = pk_bf16(P[BASE + 4], P[BASE + 5]), b1 = pk_bf16(P[BASE + 6], P[BASE + 7]); \
    auto r0_ = __builtin_amdgcn_permlane32_swap(a0, b0, false, false); auto r1_ = __builtin_amdgcn_permlane32_swap(a1, b1, false, false); \
    u32x4 w_ = {r0_[0], r1_[0], r0_[1], r1_[1]}; OUT = __builtin_bit_cast(bf16x8, w_); } while (0)
            PK4(p0, 0, pa[0]); PK4(p0, 8, pa[1]); PK4(p1, 0, pa[2]); PK4(p1, 8, pa[3]);
            const int g16 = (lane >> 4) & 1, qq = (lane & 15) >> 2, pp = lane & 3;
#pragma unroll
            for (int db = 0; db < 2; ++db) {
#pragma unroll
                for (int ks = 0; ks < 4; ++ks) {
                    const LAS char* vp = lds + AA_V + (jt * 64 + ks * 16 + 8 * hi + qq) * AA_PITCH + (db * 32 + 16 * g16 + 4 * pp) * 2;
                    const s16x4 lo = vtr(vp), hh = vtr(vp + 4 * AA_PITCH);
                    const bf16x8 vb = (bf16x8){lo[0], lo[1], lo[2], lo[3], hh[0], hh[1], hh[2], hh[3]};
                    o[db] = __builtin_amdgcn_mfma_f32_32x32x16_bf16(pa[ks], vb, o[db], 0, 0, 0);
                }
            }
            WAIT_L0();
        }
        if (hi == 0) wsf[r32] = 1.f / l_reg;
        WAIT_L0();
        const float g0 = ga[r32], g1 = ga[32 + r32];
#pragma unroll
        for (int r = 0; r < 16; ++r) { const int qrow = crow(r, hi); const float il = wsf[qrow]; const float v0 = o[0][r] * il, v1 = o[1][r] * il;
            const size_t tok = (size_t)(b * SEQ + q0 + qrow);
            bf16_t* yp = Y + tok * 2048 + hq * 64;
            yp[r32] = (bf16_t)(pk_bf16(v0 * g0, 0.f) & 0xffffu); yp[32 + r32] = (bf16_t)(pk_bf16(v1 * g1, 0.f) & 0xffffu);
            float ss = v0 * v0 + v1 * v1;
#pragma unroll
            for (int s = 16; s >= 1; s >>= 1) ss += __shfl_xor(ss, s, 64);
            if (r32 == 0) ssqa[tok * 24 + hq] = ss; }
        WAIT_L0();
    }
}

constexpr int MB_V = 0, MB_KN = 32768, MB_KP = 65536, MB_WS = 81920, MB_QP = 83968;
#define KSWZ(row, colB) ((row) * 256 + ((colB) ^ (((row) & 7) << 4)))
#define KPSWZ(row, colB) ((row) * 128 + ((colB) ^ (((row) & 7) << 4)))
constexpr float MLA_SCALE = 0.07216878364870322f;
constexpr float MLA_THR = 8.f;
__device__ __forceinline__ void mla_partialSM(f32x16& p0, f32x16& p1, float& m_reg, float& mn, float& alpha) {
    constexpr float C = MLA_SCALE * LOG2E;
    float pmax = p0[0];
#pragma unroll
    for (int r = 1; r < 16; ++r) pmax = fmaxf(pmax, p0[r]);
#pragma unroll
    for (int r = 0; r < 16; ++r) pmax = fmaxf(pmax, p1[r]);
    { auto rr = __builtin_amdgcn_permlane32_swap(__float_as_uint(pmax), __float_as_uint(pmax), false, false); pmax = fmaxf(__uint_as_float(rr[0]), __uint_as_float(rr[1])); }
    if (__builtin_expect(__all(pmax - m_reg <= MLA_THR / MLA_SCALE), 1)) { mn = m_reg; alpha = 1.f; }
    else { mn = fmaxf(m_reg, pmax); alpha = __builtin_amdgcn_exp2f((m_reg - mn) * C); m_reg = mn; }
    const float mnC = -mn * C;
#pragma unroll
    for (int r = 0; r < 16; ++r) p0[r] = fmaf(p0[r], C, mnC);
#pragma unroll
    for (int r = 0; r < 16; ++r) p1[r] = fmaf(p1[r], C, mnC);
#pragma unroll
    for (int r = 0; r < 16; ++r) p0[r] = __builtin_amdgcn_exp2f(p0[r]);
}
__device__ __forceinline__ void mla_finishSM(f32x16& p0, f32x16& p1, float alpha, float& l_reg, bf16x8& pa0, bf16x8& pa1, bf16x8& pa2, bf16x8& pa3) {
#pragma unroll
    for (int r = 0; r < 16; ++r) p1[r] = __builtin_amdgcn_exp2f(p1[r]);
    float ps = 0;
#pragma unroll
    for (int r = 0; r < 16; ++r) ps += p0[r];
#pragma unroll
    for (int r = 0; r < 16; ++r) ps += p1[r];
    { auto rr = __builtin_amdgcn_permlane32_swap(__float_as_uint(ps), __float_as_uint(ps), false, false); ps = __uint_as_float(rr[0]) + __uint_as_float(rr[1]); }
    l_reg = l_reg * alpha + ps;
    PK4(p0, 0, pa0); PK4(p0, 8, pa1); PK4(p1, 0, pa2); PK4(p1, 8, pa3);
}
__device__ __forceinline__ void mla_qkt(f32x16& p0, f32x16& p1, const LAS char* Kn, const LAS char* Kp, const bf16x8* qr, const LAS char* qp, int r32, int hi) {
    p0 = f32x16{}; p1 = f32x16{};
#pragma unroll
    for (int d0 = 0; d0 < 8; ++d0) { const int cb = (d0 * 16 + hi * 8) * 2;
        const bf16x8 b0 = *(const LAS bf16x8*)(Kn + KSWZ(r32, cb)); const bf16x8 b1 = *(const LAS bf16x8*)(Kn + KSWZ(32 + r32, cb));
        p0 = __builtin_amdgcn_mfma_f32_32x32x16_bf16(b0, qr[d0], p0, 0, 0, 0); p1 = __builtin_amdgcn_mfma_f32_32x32x16_bf16(b1, qr[d0], p1, 0, 0, 0); }
#pragma unroll
    for (int d0 = 0; d0 < 4; ++d0) { const int cb = (d0 * 16 + hi * 8) * 2;
        const bf16x8 b0 = *(const LAS bf16x8*)(Kp + KPSWZ(r32, cb)); const bf16x8 b1 = *(const LAS bf16x8*)(Kp + KPSWZ(32 + r32, cb));
        const bf16x8 q = *(const LAS bf16x8*)(qp + d0 * 1024);
        p0 = __builtin_amdgcn_mfma_f32_32x32x16_bf16(b0, q, p0, 0, 0, 0); p1 = __builtin_amdgcn_mfma_f32_32x32x16_bf16(b1, q, p1, 0, 0, 0); }
}
__device__ __forceinline__ int v_st(int k, int c) { const int kk = (k & ~0xC) | ((k & 4) << 1) | ((k & 8) >> 1); return ((kk >> 3) * 4 + (c >> 5)) * 512 + ((kk & 7) * 32 + (c & 31)) * 2; }
__device__ __forceinline__ int v_rd_base(int lane) { return ((lane & 3) << 3) | (((lane >> 2) & 3) << 6) | (((lane >> 4) & 1) << 5) | (((lane >> 5) & 1) << 8); }
constexpr int v_rd_off(int d0, int ks, int half) { return d0 * 512 + ks * 4096 + half * 2048; }
template <int D0> __device__ __forceinline__ void mla_pv_one(f32x16& od, const LAS char* vb, bf16x8 pa0, bf16x8 pa1, bf16x8 pa2, bf16x8 pa3) {
    const s16x4 l0 = vtr(vb + v_rd_off(D0, 0, 0)), h0 = vtr(vb + v_rd_off(D0, 0, 1)), l1 = vtr(vb + v_rd_off(D0, 1, 0)), h1 = vtr(vb + v_rd_off(D0, 1, 1));
    const s16x4 l2 = vtr(vb + v_rd_off(D0, 2, 0)), h2 = vtr(vb + v_rd_off(D0, 2, 1)), l3 = vtr(vb + v_rd_off(D0, 3, 0)), h3 = vtr(vb + v_rd_off(D0, 3, 1));
#define PKV(L, H) (bf16x8){L[0], L[1], L[2], L[3], H[0], H[1], H[2], H[3]}
    od = __builtin_amdgcn_mfma_f32_32x32x16_bf16(pa0, PKV(l0, h0), od, 0, 0, 0);
    od = __builtin_amdgcn_mfma_f32_32x32x16_bf16(pa1, PKV(l1, h1), od, 0, 0, 0);
    od = __builtin_amdgcn_mfma_f32_32x32x16_bf16(pa2, PKV(l2, h2), od, 0, 0, 0);
    od = __builtin_amdgcn_mfma_f32_32x32x16_bf16(pa3, PKV(l3, h3), od, 0, 0, 0);
#undef PKV
}
__device__ __forceinline__ void mla_pv(f32x16* o, const LAS char* vb, bf16x8 pa0, bf16x8 pa1, bf16x8 pa2, bf16x8 pa3) {
    mla_pv_one<0>(o[0], vb, pa0, pa1, pa2, pa3); mla_pv_one<1>(o[1], vb, pa0, pa1, pa2, pa3); mla_pv_one<2>(o[2], vb, pa0, pa1, pa2, pa3); mla_pv_one<3>(o[3], vb, pa0, pa1, pa2, pa3);
}
__device__ __forceinline__ void mla_unit(const Params& p, LAS char* lds, int u) {
    const int tid = threadIdx.x, wid = __builtin_amdgcn_readfirstlane(tid >> 6), lane = tid & 63, r32 = lane & 31, hi = lane >> 5;
    const int bh = u >> 4, qb = u & 15, b = bh >> 3, h = bh & 7;
    const bf16_t* QB = (const bf16_t*)(p.ws + WS_QB); const bf16_t* KVB = (const bf16_t*)(p.ws + WS_KVB); const bf16_t* KPE = (const bf16_t*)(p.ws + WS_KPE);
    const bf16_t* Kh = KVB + (size_t)b * SEQ * 2048 + h * 256;
    const bf16_t* Ph = KPE + (size_t)b * SEQ * 64;
    LAS float* wsf = (LAS float*)(lds + MB_WS) + wid * 64; LAS float* li_l = wsf; LAS float* al_l = wsf + 32;
    float m_reg = -1e30f, l_reg = 0; f32x16 o[4] = {}; bf16x8 qr[8];
    LAS char* qp = lds + MB_QP + wid * 4096 + lane * 16;
    { const bf16_t* Qw = QB + ((size_t)(b * SEQ + qb * 256 + wid * 32 + r32)) * 1536 + h * 192 + hi * 8;
#pragma unroll
      for (int d0 = 0; d0 < 8; ++d0) qr[d0] = *(const bf16x8*)(Qw + d0 * 16);
      __syncthreads();
#pragma unroll
      for (int d0 = 0; d0 < 4; ++d0) *(LAS bf16x8*)(qp + d0 * 1024) = *(const bf16x8*)(Qw + (8 + d0) * 16); }
    const int sr = tid >> 4, sc = (tid & 15) * 8, vst0 = v_st(sr, sc), vst1 = v_st(32 + sr, sc);
    const int pr = tid >> 3, pc = (tid & 7) * 8;
    const LAS char* vb0 = lds + MB_V + v_rd_base(lane);
    bf16x8 vs0, vs1, ks0, ks1, kp0;
#define SLOAD(k0) do { vs0 = *(const bf16x8*)(Kh + (size_t)((k0) + sr) * 2048 + 128 + sc); vs1 = *(const bf16x8*)(Kh + (size_t)((k0) + 32 + sr) * 2048 + 128 + sc); \
    ks0 = *(const bf16x8*)(Kh + (size_t)((k0) + sr) * 2048 + sc); ks1 = *(const bf16x8*)(Kh + (size_t)((k0) + 32 + sr) * 2048 + sc); \
    kp0 = *(const bf16x8*)(Ph + (size_t)((k0) + pr) * 64 + pc); } while (0)
#define SWRITE(bb) do { *(LAS bf16x8*)(lds + MB_V + (bb) * 16384 + vst0) = vs0; *(LAS bf16x8*)(lds + MB_V + (bb) * 16384 + vst1) = vs1; \
    *(LAS bf16x8*)(lds + MB_KN + (bb) * 16384 + KSWZ(sr, sc * 2)) = ks0; *(LAS bf16x8*)(lds + MB_KN + (bb) * 16384 + KSWZ(32 + sr, sc * 2)) = ks1; \
    *(LAS bf16x8*)(lds + MB_KP + (bb) * 8192 + KPSWZ(pr, pc * 2)) = kp0; } while (0)
#define RESC(a) do { if (__any((a) < 1.f)) { if (hi == 0) al_l[r32] = (a); WAIT_L0(); \
    _Pragma("unroll") for (int d = 0; d < 4; ++d) _Pragma("unroll") for (int r = 0; r < 16; ++r) o[d][r] *= al_l[crow(r, hi)]; } } while (0)
    f32x16 pA0, pA1, pB0, pB1; float mnA, mnB, alA, alB; bf16x8 pa0, pa1, pa2, pa3; constexpr int NT = SEQ / 64;
    SLOAD(0); SWRITE(0); __syncthreads();
    mla_qkt(pA0, pA1, lds + MB_KN, lds + MB_KP, qr, qp, r32, hi); mla_partialSM(pA0, pA1, m_reg, mnA, alA);
    SLOAD(64); SWRITE(1); __syncthreads();
    for (int j = 1; j + 1 < NT; j += 2) {
        SBAR(); mla_qkt(pB0, pB1, lds + MB_KN + 16384, lds + MB_KP + 8192, qr, qp, r32, hi);
        mla_finishSM(pA0, pA1, alA, l_reg, pa0, pa1, pa2, pa3); SBAR();
        SLOAD((j + 1) * 64); SBAR();
        mla_pv(o, vb0, pa0, pa1, pa2, pa3); mla_partialSM(pB0, pB1, m_reg, mnB, alB);
        __syncthreads(); SWRITE(0);
        RESC(alB); __syncthreads();
        SBAR(); mla_qkt(pA0, pA1, lds + MB_KN, lds + MB_KP, qr, qp, r32, hi);
        mla_finishSM(pB0, pB1, alB, l_reg, pa0, pa1, pa2, pa3); SBAR();
        SLOAD((j + 2) * 64); SBAR();
        mla_pv(o, vb0 + 16384, pa0, pa1, pa2, pa3); mla_partialSM(pA0, pA1, m_reg, mnA, alA);
        __syncthreads(); SWRITE(1);
        RESC(alA); __syncthreads();
    }
    SBAR(); mla_qkt(pB0, pB1, lds + MB_KN + 16384, lds + MB_KP + 8192, qr, qp, r32, hi);
    mla_finishSM(pA0, pA1, alA, l_reg, pa0, pa1, pa2, pa3); SBAR();
    mla_pv(o, vb0, pa0, pa1, pa2, pa3); mla_partialSM(pB0, pB1, m_reg, mnB, alB);
    __syncthreads(); RESC(alB);
    mla_finishSM(pB0, pB1, alB, l_reg, pa0, pa1, pa2, pa3); SBAR();
    mla_pv(o, vb0 + 16384, pa0, pa1, pa2, pa3);
    if (hi == 0) li_l[r32] = l_reg; WAIT_L0();
    bf16_t* Y = (bf16_t*)(p.ws + WS_Y); float* ssqb = (float*)(p.ws + WS_SSQP);
    const float* gb = p.out_norm_b + h * 128;
    float g[4];
#pragma unroll
    for (int d0 = 0; d0 < 4; ++d0) g[d0] = gb[d0 * 32 + r32];
#pragma unroll
    for (int r = 0; r < 16; ++r) { const int orow = crow(r, hi); const float il = __builtin_amdgcn_rcpf(li_l[orow]);
        const size_t tok = (size_t)(b * SEQ + qb * 256 + wid * 32 + orow); bf16_t* yp = Y + tok * 2048 + 1024 + h * 128; float ss = 0.f;
#pragma unroll
        for (int d0 = 0; d0 < 4; ++d0) { const float v = o[d0][r] * il; ss += v * v; yp[d0 * 32 + r32] = (bf16_t)(pk_bf16(v * g[d0], 0.f) & 0xffffu); }
#pragma unroll
        for (int s = 16; s >= 1; s >>= 1) ss += __shfl_xor(ss, s, 64);
        if (r32 == 0) ssqb[tok * 24 + 16 + h] = ss; }
#undef SLOAD
#undef SWRITE
#undef RESC
}

__device__ __forceinline__ void phase_router(const Params& p, LAS char* lds) {
    const int tid = threadIdx.x, wid = __builtin_amdgcn_readfirstlane(tid >> 6), lane = tid & 63;
    const float* x2 = (const float*)(p.ws + WS_X2); const float* wg = (const float*)(p.ws + WS_WRT);
    unsigned char* xn8 = p.ws + WS_XN; unsigned* cnt = (unsigned*)(p.ws + WS_CTL + CTL_CNT);
    int* tokl = (int*)(p.ws + WS_TOKL); int* sel_e = (int*)(p.ws + WS_SEL); int* sel_r = sel_e + NTOK * 4; float* sel_g = (float*)(sel_r + NTOK * 4);
    LAS float* part = (LAS float*)lds;
    LAS float* rsv = (LAS float*)(lds + 32768);
    LAS unsigned* hist = (LAS unsigned*)(lds + 32768 + 128); LAS unsigned* hbase = hist + 32;
    for (int t0 = blockIdx.x * 32; t0 < NTOK; t0 += gridDim.x * 32) {
        __syncthreads();
        if (tid < N_EXP) hist[tid] = 0u;
#pragma unroll 1
        for (int j = 0; j < 4; ++j) { const int t = t0 + 4 * wid + j; f32x4 xr[8]; float ss = 0.f;
#pragma unroll
            for (int i = 0; i < 8; ++i) { xr[i] = ((const f32x4*)(x2 + (size_t)t * D_MODEL))[lane + 64 * i]; ss += xr[i][0] * xr[i][0] + xr[i][1] * xr[i][1] + xr[i][2] * xr[i][2] + xr[i][3] * xr[i][3]; }
            const float rs = rsqrtf(wave_sum(ss) * (1.f / D_MODEL) + EPS);
            if (lane == 0) rsv[4 * wid + j] = rs;
#pragma unroll
            for (int i = 0; i < 8; ++i) { const f32x4 v = xr[i]; const f32x4 g = ((const f32x4*)p.mlp_norm)[lane + 64 * i]; const float s16 = 16.f * rs;
                *(unsigned*)(xn8 + (size_t)t * D_MODEL + 4 * (lane + 64 * i)) = pk4_fp8(s16 * v[0] * g[0], s16 * v[1] * g[1], s16 * v[2] * g[2], s16 * v[3] * g[3]); } }
        { f32x16 acc;
#pragma unroll
          for (int r = 0; r < 16; ++r) acc[r] = 0.f;
          const float* ap = x2 + (size_t)(t0 + (lane & 31)) * D_MODEL + 256 * wid + 4 * (lane >> 5);
          const float* bp = wg + (size_t)(256 * wid + 4 * (lane >> 5)) * N_EXP + (lane & 31);
#pragma unroll 4
          for (int c = 0; c < 32; ++c) { const f32x4 a4 = *(const f32x4*)(ap + 8 * c);
#pragma unroll
              for (int q = 0; q < 4; ++q) acc = __builtin_amdgcn_mfma_f32_32x32x2f32(a4[q], bp[(size_t)(8 * c + q) * N_EXP], acc, 0, 0, 0); }
#pragma unroll
          for (int r = 0; r < 16; ++r) part[wid * 1024 + crow(r, lane >> 5) * 32 + (lane & 31)] = acc[r]; }
        __syncthreads();
        int my_e[4]; unsigned my_lr[4]; float my_g[4];
#pragma unroll
        for (int j = 0; j < 4; ++j) { const int tl = 4 * wid + j;
            float v = -3.0e38f;
            if (lane < 32) { float s = 0.f;
#pragma unroll
                for (int w = 0; w < 8; ++w) s += part[w * 1024 + tl * 32 + lane];
                v = s * rsv[tl] + p.b_router[lane]; }
            float tv[4]; int ti[4];
#pragma unroll
            for (int r = 0; r < 4; ++r) {
                float bv = v; int bi = lane;
#pragma unroll
                for (int o = 32; o >= 1; o >>= 1) { const float ov = __shfl_xor(bv, o, 64); const int oi = __shfl_xor(bi, o, 64); if (ov > bv || (ov == bv && oi < bi)) { bv = ov; bi = oi; } }
                tv[r] = bv; ti[r] = bi; if (lane == bi) v = -3.0e38f;
            }
            const float e0 = 1.f, e1 = __expf(tv[1] - tv[0]), e2 = __expf(tv[2] - tv[0]), e3 = __expf(tv[3] - tv[0]); const float inv = 1.f / (e0 + e1 + e2 + e3);
            const float gts[4] = {e0 * inv, e1 * inv, e2 * inv, e3 * inv};
            my_e[j] = ti[lane & 3]; my_g[j] = gts[lane & 3]; my_lr[j] = 0u;
            if (lane < 4) my_lr[j] = __hip_atomic_fetch_add(hist + my_e[j], 1u, __ATOMIC_RELAXED, __HIP_MEMORY_SCOPE_WORKGROUP);
        }
        __syncthreads();
        if (tid < N_EXP) hbase[tid] = atomicAdd(cnt + tid * 16, hist[tid]);
        __syncthreads();
        if (lane < 4) {
#pragma unroll
            for (int j = 0; j < 4; ++j) { const int t = t0 + 4 * wid + j; const int e = my_e[j]; const unsigned rk = hbase[e] + my_lr[j];
                tokl[e * NTOK + rk] = t; sel_e[t * 4 + lane] = e; sel_r[t * 4 + lane] = (int)rk; sel_g[t * 4 + lane] = my_g[j]; }
        }
    }
}

__device__ __forceinline__ void phase_combine(const Params& p, const LAS int* s_roff) {
    const int tid = threadIdx.x, wid = tid >> 6, lane = tid & 63;
    const float* x2 = (const float*)(p.ws + WS_X2); const bf16_t* ys = (const bf16_t*)(p.ws + WS_YS);
    const int* sel_e = (const int*)(p.ws + WS_SEL); const int* sel_r = sel_e + NTOK * 4; const float* sel_g = (const float*)(sel_r + NTOK * 4);
    for (int t = blockIdx.x * 8 + wid; t < NTOK; t += gridDim.x * 8) {
        f32x4 v[8];
#pragma unroll
        for (int i = 0; i < 8; ++i) v[i] = ((const f32x4*)(x2 + (size_t)t * D_MODEL))[lane + 64 * i];
#pragma unroll
        for (int k = 0; k < 4; ++k) { const int e = sel_e[t * 4 + k]; const size_t slot = (size_t)(s_roff[e] + sel_r[t * 4 + k]); const float g = sel_g[t * 4 + k];
            const u32x2* yr = (const u32x2*)(ys + slot * D_MODEL);
#pragma unroll
            for (int i = 0; i < 8; ++i) { const u32x2 w = yr[lane + 64 * i]; v[i][0] += g * bf_lo(w[0]); v[i][1] += g * bf_hi(w[0]); v[i][2] += g * bf_lo(w[1]); v[i][3] += g * bf_hi(w[1]); } }
        float ss = 0.f;
#pragma unroll
        for (int i = 0; i < 8; ++i) ss += v[i][0] * v[i][0] + v[i][1] * v[i][1] + v[i][2] * v[i][2] + v[i][3] * v[i][3];
        ss = wave_sum(ss); const float rs = rsqrtf(ss * (1.f / D_MODEL) + EPS);
#pragma unroll
        for (int i = 0; i < 8; ++i) { const f32x4 g = ((const f32x4*)p.final_norm)[lane + 64 * i];
            ((f32x4*)(p.out + (size_t)t * D_MODEL))[lane + 64 * i] = (f32x4){v[i][0] * rs * g[0], v[i][1] * rs * g[1], v[i][2] * rs * g[2], v[i][3] * rs * g[3]}; }
    }
}

constexpr int NPHASE = 9;
__global__ void __launch_bounds__(512, 2) mega_fwd(Params p) {
    extern __shared__ __attribute__((aligned(1024))) char smem_raw[];
    LAS char* lds = (LAS char*)smem_raw;
    LAS unsigned* misc = (LAS unsigned*)(lds + LDS_MISC);
    const int tid = threadIdx.x;
    if (tid < 4) misc[tid] = 0u;
    __syncthreads();
    unsigned* bar = (unsigned*)(p.ws + WS_CTL + CTL_BAR);
    XcdBarrier xb = xcd_barrier_post(bar, (volatile LAS unsigned*)misc);
    const int lo = p.ph_lo, hi = p.ph_hi;
    const int G = gridDim.x, bid = blockIdx.x;
    const int xperm = (bid & 7) * (G >> 3) + (bid >> 3);
#ifdef PH_ONLY
#define IN(k) ((k)==PH_ONLY)
#else
#define IN(k) (lo <= (k) && (k) < hi)
#endif
#define SEAM(k) do { if (IN(k) && IN((k) + 1)) xcd_barrier(xb); } while (0)
    if (IN(0)) phase_prologue(p);
    SEAM(0);
    if (IN(1)) {
        for (int u = xperm; u < 32 * 8; u += G) {
            const int pn = u / 32, pm = u % 32;
            PEpiProj ep{pn, pm * 256, p.ws, p.b_q_norm, p.b_kv_norm};
            __syncthreads();
            gemm_unit_pg<false>(lds, (const bf16_t*)(p.ws + WS_XN) + (size_t)pm * 256 * D_MODEL, (const bf16_t*)(p.ws + WS_BT_IN) + (size_t)pn * 256 * D_MODEL, D_MODEL, ep);
        }
    }
    SEAM(1);
    if (IN(2)) {
        { const int b0 = bid;
            int qv;
            if ((b0 & 3) == 0) {
                const int h = b0 >> 2, pn = 8 + (h >> 5), pm = h & 31;
                PEpiProj ep{pn, pm * 256, p.ws, p.b_q_norm, p.b_kv_norm};
                __syncthreads();
                gemm_unit_pg<false>(lds, (const bf16_t*)(p.ws + WS_XN) + (size_t)pm * 256 * D_MODEL, (const bf16_t*)(p.ws + WS_BT_IN) + (size_t)pn * 256 * D_MODEL, D_MODEL, ep);
                qv = 128 + h;
            } else {
                const int v = (b0 >> 2) * 3 + (b0 & 3) - 1;
                if (v < 128) {
                    attn_a_unit(p, lds, v); qv = v;
                    pg_convert(p.w_o, D_MODEL, D_MODEL, D_MODEL, 2048, (bf16_t*)(p.ws + WS_BT_WO), v * 1024 + tid, 128 * 1024);
                    pg_convert(p.w_o, D_MODEL, D_MODEL, D_MODEL, 2048, (bf16_t*)(p.ws + WS_BT_WO), v * 1024 + 512 + tid, 128 * 1024);
                } else {
                    const int w = v - 128; qv = -1;
                    attn_a_unit(p, lds, 128 + 2 * w); attn_a_unit(p, lds, 129 + 2 * w);
                    if (w < 32) pg_convert(p.b_w_ukv, 256, 2048, 2048, 2048, (bf16_t*)(p.ws + WS_BT_UKV), w * 512 + tid, 32 * 512);
                }
            }
            if (qv >= 0) { const int pn = qv / 32, pm = qv % 32;
                PEpiQUp ep{pn, pm * 256, p.ws};
                __syncthreads();
                gemm_unit_pg<false>(lds, (const bf16_t*)(p.ws + WS_CQ) + (size_t)pm * 256 * 512, (const bf16_t*)(p.ws + WS_BT_UQ) + (size_t)pn * 256 * 512, 512, ep);
                __syncthreads(); }
        }
        xcd_barrier(xb);
        for (int u = xperm; u < 32 * 8; u += G) {
            const int pn = u / 32, pm = u % 32;
            PEpiKvUp ep{pn, pm * 256, p.ws};
            __syncthreads();
            gemm_unit_pg<false>(lds, (const bf16_t*)(p.ws + WS_CKV) + (size_t)pm * 256 * 256, (const bf16_t*)(p.ws + WS_BT_UKV) + (size_t)pn * 256 * 256, 256, ep);
        }
    }
    SEAM(2);
    if (IN(3)) { for (int u = xperm; u < 256; u += G) mla_unit(p, lds, u); }
    SEAM(3);
    if (IN(4)) {
        __syncthreads();
        for (int u = xperm; u < 32 * 8; u += G) {
            const int pn = u / 32, pm = u % 32;
            LAS float* tab = (LAS float*)(lds + 2 * G_STAGE_B);
            __syncthreads();
            if (tid < 256) { const f32x4* pp = (const f32x4*)((const float*)(p.ws + WS_SSQP) + (size_t)(pm * 256 + tid) * 24); float sa = 0.f, sb2 = 0.f;
#pragma unroll
                for (int q = 0; q < 4; ++q) { const f32x4 v = pp[q]; sa += (v[0] + v[1]) + (v[2] + v[3]); }
#pragma unroll
                for (int q = 4; q < 6; ++q) { const f32x4 v = pp[q]; sb2 += (v[0] + v[1]) + (v[2] + v[3]); }
                tab[tid] = sa * (1.f / 1024.f); tab[256 + tid] = sb2 * (1.f / 1024.f); }
            __syncthreads();
            PEpiWo ep{pn, pm * 256, p.ws, p.x, tab};
            gemm_unit_pg<true>(lds, (const bf16_t*)(p.ws + WS_Y) + (size_t)pm * 256 * D_MODEL, (const bf16_t*)(p.ws + WS_BT_WO) + (size_t)pn * 256 * D_MODEL, D_MODEL, ep);
        }
    }
    SEAM(4);
    if (IN(5)) phase_router(p, lds);
    SEAM(5);
    LAS int* s_cnt = (LAS int*)(misc + 16); LAS int* s_toff = (LAS int*)(misc + 48); LAS int* s_roff = (LAS int*)(misc + 96);
    if (IN(6) || IN(7) || IN(8)) {
        if (tid == 0) { const unsigned* cnt = (const unsigned*)(p.ws + WS_CTL + CTL_CNT); int to = 0;
            for (int e = 0; e < N_EXP; ++e) { const int c = (int)xb_ld((unsigned*)cnt + e * 16); s_cnt[e] = c; s_toff[e] = to; s_roff[e] = to * 256; to += (c + 255) >> 8; }
            s_toff[N_EXP] = to; }
        __syncthreads();
    }
    if (IN(6)) {
        const int TM = s_toff[N_EXP];
        const int T16 = TM * 16, NF = (T16 & ~255), R = T16 - NF;
        const bool halves = R > 0 && R <= 128;
        for (int L = xperm; L < (halves ? NF : T16); L += G) {
            int e = 0; while (s_toff[e + 1] * 16 <= L) ++e;
            const int w = L - s_toff[e] * 16, nte = s_toff[e + 1] - s_toff[e], ntile = w / nte, mt = w - ntile * nte, cntE = s_cnt[e];
            AGather8 af{p.ws + WS_XN, (const int*)(p.ws + WS_TOKL) + (size_t)e * NTOK, mt * 256, cntE};
            BGateUp bf{p.w_up + (size_t)e * D_MODEL * (2 * D_FF) + ntile * 128, (size_t)(2 * D_FF)};
            EpiUp8 ep{ntile * 128, mt * 256, cntE, p.ws + WS_ACT + ((size_t)s_roff[e] + mt * 256) * D_FF, p.b_up + (size_t)e * (2 * D_FF)};
            gemm_unit8<0x7B7B7B7B>(lds, (LAS unsigned*)(misc + 8), D_MODEL / 64, af, bf, ep);
        }
        if (halves && xperm < 2 * R) {
            const int L = NF + (xperm >> 1), hf = xperm & 1;
            int e = 0; while (s_toff[e + 1] * 16 <= L) ++e;
            const int w = L - s_toff[e] * 16, nte = s_toff[e + 1] - s_toff[e], ntile = w / nte, mt = w - ntile * nte, cntE = s_cnt[e];
            AGather8 af{p.ws + WS_XN, (const int*)(p.ws + WS_TOKL) + (size_t)e * NTOK, mt * 256, cntE};
            BGateUp bf{p.w_up + (size_t)e * D_MODEL * (2 * D_FF) + ntile * 128 + hf * 64, (size_t)(2 * D_FF)};
            EpiUp8q ep{ntile * 128 + hf * 64, mt * 256, cntE, p.ws + WS_ACT + ((size_t)s_roff[e] + mt * 256) * D_FF, p.b_up + (size_t)e * (2 * D_FF)};
            gemm_unit8q<0x7B7B7B7B>(lds, (LAS unsigned*)(misc + 8), D_MODEL / 64, af, bf, ep);
        }
    }
    SEAM(6);
    if (IN(7)) {
        const int TM = s_toff[N_EXP];
        const int T8 = TM * 8, NF = T8 & ~255, R = T8 - NF;
        const bool halves = R > 0 && R <= 128;
        for (int L = xperm; L < (halves ? NF : T8); L += G) {
            int e = 0; while (s_toff[e + 1] * 8 <= L) ++e;
            const int w = L - s_toff[e] * 8, nte = s_toff[e + 1] - s_toff[e], ntile = w / nte, mt = w - ntile * nte, cntE = s_cnt[e];
            ARows8 af{p.ws + WS_ACT + ((size_t)s_roff[e] + mt * 256) * D_FF, (unsigned)D_FF};
            BPlain bf{p.w_down + (size_t)e * D_FF * D_MODEL + ntile * 256, (size_t)D_MODEL, 256};
            EpiDown8 ep{ntile * 256, mt * 256, cntE, (bf16_t*)(p.ws + WS_YS) + ((size_t)s_roff[e] + mt * 256) * D_MODEL, p.b_down + (size_t)e * D_MODEL};
            gemm_unit8<0x7D7D7D7D>(lds, (LAS unsigned*)(misc + 8), D_FF / 64, af, bf, ep);
        }
        if (halves && xperm < 2 * R) {
            const int L = NF + (xperm >> 1), hf = xperm & 1;
            int e = 0; while (s_toff[e + 1] * 8 <= L) ++e;
            const int w = L - s_toff[e] * 8, nte = s_toff[e + 1] - s_toff[e], ntile = w / nte, mt = w - ntile * nte, cntE = s_cnt[e];
            ARows8 af{p.ws + WS_ACT + ((size_t)s_roff[e] + mt * 256) * D_FF, (unsigned)D_FF};
            BPlain bf{p.w_down + (size_t)e * D_FF * D_MODEL + ntile * 256 + hf * 128, (size_t)D_MODEL, 128};
            EpiDown8h ep{ntile * 256 + hf * 128, mt * 256, cntE, (bf16_t*)(p.ws + WS_YS) + ((size_t)s_roff[e] + mt * 256) * D_MODEL, p.b_down + (size_t)e * D_MODEL};
            gemm_unit8h<0x7D7D7D7D>(lds, (LAS unsigned*)(misc + 8), D_FF / 64, af, bf, ep);
        }
    }
    SEAM(7);
    if (IN(8)) phase_combine(p, s_roff);
}

extern "C" void kernel_launch(void* const* d_in, const int* in_sizes, int n_in, void* d_out, int out_size, void* d_ws, size_t ws_size, hipStream_t stream) {
    static int ready = 0;
    if (!ready) {
        if (hipFuncSetAttribute((const void*)mega_fwd, hipFuncAttributeMaxDynamicSharedMemorySize, LDS_BYTES) != hipSuccess) { fprintf(stderr, "kernel_launch: hipFuncSetAttribute failed\n"); return; }
        int per_cu = 0; hipOccupancyMaxActiveBlocksPerMultiprocessor(&per_cu, (const void*)mega_fwd, 512, LDS_BYTES);
        if (per_cu < 1) { fprintf(stderr, "kernel_launch: occupancy query says 0 blocks per CU\n"); return; }
        ready = 1;
    }
    if (ws_size < WS_END) { fprintf(stderr, "kernel_launch: workspace too small\n"); return; }
    hipMemsetAsync((unsigned char*)d_ws + WS_CTL, 0, CTL_BYTES, stream);
    Params p{};
    const float** f = (const float**)&p;
    for (int i = 0; i < 19; ++i) f[i] = (const float*)d_in[i];
    p.out = (float*)d_out; p.ws = (unsigned char*)d_ws; p.ph_lo = 0; p.ph_hi = NPHASE;
    hipLaunchKernelGGL(mega_fwd, dim3(256), dim3(512), LDS_BYTES, stream, p);
}
```

```cpp
#include <hip/hip_runtime.h>
#include <stdint.h>
#include <stdio.h>

#define LAS __attribute__((address_space(3)))
typedef unsigned short bf16_t;
typedef short bf16x8 __attribute__((ext_vector_type(8)));
typedef short s16x4 __attribute__((ext_vector_type(4)));
typedef short v4i16_t __attribute__((ext_vector_type(4)));
typedef float f32x2 __attribute__((ext_vector_type(2)));
typedef float f32x4 __attribute__((ext_vector_type(4)));
typedef float f32x16 __attribute__((ext_vector_type(16)));
typedef int i32x4 __attribute__((ext_vector_type(4)));
typedef unsigned u32x2 __attribute__((ext_vector_type(2)));
typedef unsigned u32x4 __attribute__((ext_vector_type(4)));
typedef __bf16 bf16x2_t __attribute__((ext_vector_type(2)));
typedef int v8i __attribute__((ext_vector_type(8)));
typedef int v2i __attribute__((ext_vector_type(2)));
typedef short v2s __attribute__((ext_vector_type(2)));

constexpr int D_MODEL = 2048, SEQ = 4096, BATCH = 2, NTOK = BATCH * SEQ;
constexpr int IN_COLS = 2368;
constexpr int N_EXP = 32, TOP_K = 4, D_FF = 2048;
constexpr float EPS = 1e-5f;
constexpr float LOG2E = 1.4426950408889634f;

constexpr size_t MiB = 1u << 20;
constexpr size_t WS_CTL = 0, CTL_BYTES = 1 * MiB;
constexpr size_t WS_XN = 1 * MiB, WS_QA = 33 * MiB, WS_KA = 49 * MiB, WS_VA = 53 * MiB, WS_CQ = 57 * MiB, WS_CKV = 65 * MiB, WS_KPE = 69 * MiB;
constexpr size_t WS_QB = 70 * MiB, WS_KVB = 94 * MiB, WS_Y = 126 * MiB, WS_X2 = 158 * MiB, WS_ROPE = 222 * MiB, WS_WRT = 223 * MiB;
constexpr size_t WS_TOKL = 224 * MiB, WS_SEL = 225 * MiB, WS_ACT = 226 * MiB, WS_YS = 386 * MiB, WS_BT_IN = 546 * MiB, WS_BT_UQ = 558 * MiB, WS_BT_UKV = 560 * MiB, WS_BT_WO = 562 * MiB, WS_SSQ2 = 570 * MiB, WS_IMG_DN = 571 * MiB, WS_END = 699 * MiB;
constexpr size_t WS_SSQP = WS_WRT + 262144;
constexpr size_t WS_SSQC = WS_SSQ2;
constexpr size_t WS_SSQK = WS_SSQ2 + 524288;
constexpr size_t CTL_BAR = 0, CTL_CNT = 16384, CTL_SSQ_CQ = 65536, CTL_SSQ_CKV = 98304, CTL_SSQ_A = 131072, CTL_SSQ_B = 163840, CTL_SSQ_X2 = 196608;

__device__ __forceinline__ unsigned pk_bf16(float lo, float hi) { f32x2 v = {lo, hi}; bf16x2_t b = __builtin_convertvector(v, bf16x2_t); return __builtin_bit_cast(unsigned, b); }
__device__ __forceinline__ unsigned pk4_fp8(float a, float b, float c, float d) { int w = __builtin_amdgcn_cvt_pk_fp8_f32(a, b, 0, false); w = __builtin_amdgcn_cvt_pk_fp8_f32(c, d, w, true); return (unsigned)w; }
__device__ __forceinline__ unsigned pk4_fp8_x64(f32x4 v) { v2s r; asm("" : "=v"(r));
    r = __builtin_amdgcn_cvt_scalef32_pk_fp8_f32(r, v[0], v[1], 0.015625f, false); r = __builtin_amdgcn_cvt_scalef32_pk_fp8_f32(r, v[2], v[3], 0.015625f, true); return __builtin_bit_cast(unsigned, r); }
__device__ __forceinline__ float bf_lo(unsigned u) { return __uint_as_float(u << 16); }
__device__ __forceinline__ float bf_hi(unsigned u) { return __uint_as_float(u & 0xffff0000u); }
__device__ __forceinline__ float wave_sum(float v) {
#pragma unroll
    for (int o = 32; o >= 1; o >>= 1) v += __shfl_xor(v, o, 64);
    return v;
}
__device__ __forceinline__ int crow(int r, int hi) { return (r & 3) + 8 * (r >> 2) + 4 * hi; }
__device__ __forceinline__ s16x4 vtr(const LAS char* p) { return __builtin_bit_cast(s16x4, __builtin_amdgcn_ds_read_tr16_b64_v4i16((LAS v4i16_t*)p)); }
#define SBAR() __builtin_amdgcn_sched_barrier(0)

#define XB_TMO      128
#define XB_XCNT(j)  (256  + 64 * (j))
#define XB_XSUB(j)  (1280 + 64 * (j))
#define XB_XGEN(j)  (2304 + 64 * (j))
#define XB_TOP      3328
#define XB_TOPGEN   3392
#define XCD_BAR_WORDS 3456
#define XB_SPIN_CAP (1u << 18)
__device__ __forceinline__ unsigned xb_ld(unsigned* p)              { return __hip_atomic_load(p, __ATOMIC_RELAXED, __HIP_MEMORY_SCOPE_AGENT); }
__device__ __forceinline__ unsigned xb_add(unsigned* p, unsigned v) { return __hip_atomic_fetch_add(p, v, __ATOMIC_RELAXED, __HIP_MEMORY_SCOPE_AGENT); }
__device__ __forceinline__ unsigned xb_xcc_id() { return (unsigned)__builtin_amdgcn_s_getreg((3 << 11) | 20) & 0xFu; }
#define XB_SPIN(cond, bar) do { unsigned _sp = 0; while (cond) { __builtin_amdgcn_s_sleep(1); \
    if ((++_sp & 255u) == 0u) { if (xb_ld(&(bar)[XB_TMO])) break; if (_sp > XB_SPIN_CAP) { atomicAdd(&(bar)[XB_TMO], 1u); break; } } } } while (0)
struct XcdBarrier { unsigned* bar; unsigned x; volatile LAS unsigned* st; };
__device__ __forceinline__ XcdBarrier xcd_barrier_post(unsigned* bar, volatile LAS unsigned* st) {
    XcdBarrier b; b.bar = bar; b.x = xb_xcc_id(); b.st = st;
    if (threadIdx.x == 0) (void)xb_add(&bar[XB_XCNT(b.x)], 1u);
    return b;
}
__device__ __forceinline__ void xcd_barrier_complete(unsigned* bar, unsigned x, unsigned& nloc, unsigned& nx) {
    const unsigned G = gridDim.x * gridDim.y * gridDim.z;
    unsigned sum, cnt, mine, sp = 0u;
    for (;;) {
        sum = 0u; cnt = 0u; mine = 0u;
#pragma unroll
        for (unsigned j = 0; j < 16; ++j) { const unsigned c = xb_ld(&bar[XB_XCNT(j)]); sum += c; cnt += (c > 0u) ? 1u : 0u; mine = (j == x) ? c : mine; }
        if (sum == G) break;
        __builtin_amdgcn_s_sleep(1);
        if ((++sp & 255u) == 0u) { if (xb_ld(&bar[XB_TMO])) break; if (sp > XB_SPIN_CAP) { atomicAdd(&bar[XB_TMO], 1u); break; } }
    }
    nloc = mine > 0u ? mine : 1u; nx = cnt > 0u ? cnt : 1u;
}
__device__ __forceinline__ void xcd_barrier(const XcdBarrier& b) {
    asm volatile("s_waitcnt vmcnt(0)" ::: "memory");
    __syncthreads();
    if (threadIdx.x == 0) {
        unsigned* bar = b.bar;
        __builtin_amdgcn_s_waitcnt(0);
        unsigned nloc = b.st[0], nx = b.st[1];
        if (nloc == 0u) { xcd_barrier_complete(bar, b.x, nloc, nx); b.st[0] = nloc; b.st[1] = nx; }
        const unsigned old = xb_add(&bar[XB_XSUB(b.x)], 1u);
        const unsigned gen = old / nloc;
        if (old + 1u == (gen + 1u) * nloc) {
            __builtin_amdgcn_fence(__ATOMIC_RELEASE, "agent");
            asm volatile("s_waitcnt vmcnt(0)" ::: "memory");
            const unsigned og = xb_add(&bar[XB_TOP], 1u);
            const unsigned tg = og / nx;
            if (og + 1u == (tg + 1u) * nx) xb_add(&bar[XB_TOPGEN], 1u);
            else XB_SPIN(xb_ld(&bar[XB_TOPGEN]) == tg, bar);
            __builtin_amdgcn_fence(__ATOMIC_ACQUIRE, "agent");
            xb_add(&bar[XB_XGEN(b.x)], 1u);
            asm volatile("s_waitcnt vmcnt(0)" ::: "memory");
        } else {
            XB_SPIN(xb_ld(&bar[XB_XGEN(b.x)]) == gen, bar);
            __builtin_amdgcn_fence(__ATOMIC_ACQUIRE, "agent");
            asm volatile("s_waitcnt vmcnt(0)" ::: "memory");
        }
    }
    __syncthreads();
}

constexpr int A_TILE_B = 256 * 64 * 2;
constexpr int B_PITCH = 544;
constexpr int B_TILE_B = 64 * B_PITCH;
constexpr int G_STAGE_B = A_TILE_B + B_TILE_B;
constexpr int LDS_MISC = 155648;
constexpr int LDS_BYTES = LDS_MISC + 1024;

__device__ __forceinline__ int a_img_byte(int r, int chunk) { return r * 128 + ((chunk ^ ((r >> 1) & 7)) << 4); }
#define WAIT_L0() asm volatile("s_waitcnt lgkmcnt(0)" ::: "memory")
__device__ __forceinline__ void glds16(const void* gsrc, unsigned lds_dst) { unsigned keep;
    asm volatile("s_mov_b32 %0, m0\n\ts_mov_b32 m0, %2\n\ts_nop 0\n\tglobal_load_lds_dwordx4 %1, off\n\ts_mov_b32 m0, %0" : "=&s"(keep) : "v"(gsrc), "s"(lds_dst) : "memory"); }
#define RAW_BARRIER() do { WAIT_L0(); __builtin_amdgcn_s_barrier(); } while (0)

__device__ __forceinline__ const char* uniform_ptr(const void* p) {
    const unsigned long long v = (unsigned long long)p;
    const unsigned lo = __builtin_amdgcn_readfirstlane((unsigned)v), hi = __builtin_amdgcn_readfirstlane((unsigned)(v >> 32));
    return (const char*)(((unsigned long long)hi << 32) | lo);
}
__device__ __forceinline__ void glds16s(const char* sbase, unsigned voff, unsigned lds_dst) { unsigned keep;
    asm volatile("s_mov_b32 %0, m0\n\ts_mov_b32 m0, %3\n\ts_nop 4\n\tglobal_load_lds_dwordx4 %1, %2\n\ts_mov_b32 m0, %0" : "=&s"(keep) : "v"(voff), "s"(sbase), "s"(lds_dst) : "memory"); }
#define WAIT_V4(n, a, b, c, d) asm volatile("s_waitcnt vmcnt(" #n ")" : "+v"(a), "+v"(b), "+v"(c), "+v"(d) :: "memory")
template <bool MID, class AF, class BF, class EPI>
__device__ __forceinline__ void gemm_unit(LAS char* lds, const int nt, const AF& af, const BF& bf, EPI& epi) {
    const int tid = threadIdx.x, wid = __builtin_amdgcn_readfirstlane(tid >> 6), lane = tid & 63, wr = wid >> 2, wc = wid & 3, fr = lane & 15, fq = lane >> 4;
    const char* abase = uniform_ptr(af.base);
    unsigned aoff[4];
#pragma unroll
    for (int i = 0; i < 4; ++i) { const int R = wid * 8 + i * 64 + (lane >> 3), C = ((lane & 7) ^ ((R >> 1) & 7)) * 8; aoff[i] = (af.rowoff(R) + (unsigned)C) * 2u; }
    const int a_ldsw = wid * 1024;
    const unsigned lds_u = (unsigned)__builtin_amdgcn_readfirstlane((int)(unsigned)(size_t)lds);
    const size_t ldb4 = (size_t)bf.ld * 4;
    const char* bbase = uniform_ptr(bf.base) + (size_t)wid * ldb4;
    const unsigned boff = bf.coloff(4 * lane) * 4u;
    const int b_lds0 = A_TILE_B + wid * B_PITCH + 8 * lane, b_lds1 = A_TILE_B + wid * B_PITCH + ((8 * lane) ^ 128);
    const int a_rd0 = a_img_byte(wr * 128 + fr, fq), a_rd1 = a_rd0 ^ 64;
    const int b_rd = A_TILE_B + (8 * fq + ((lane & 15) >> 2)) * B_PITCH + ((wc ^ (fq & 1)) << 7) + 8 * (lane & 3);
    f32x4 acc[8][4];
#pragma unroll
    for (int m = 0; m < 8; ++m)
#pragma unroll
        for (int n = 0; n < 4; ++n) acc[m][n] = (f32x4){0.f, 0.f, 0.f, 0.f};
    f32x4 sb[8];
#define G_STAGE_A(i, kt, buf) glds16s(abase + (size_t)(kt) * 128, aoff[i], lds_u + (unsigned)((buf) * G_STAGE_B + a_ldsw + (i) * 8192))
#define G_ISSUE_B(i, kt) asm volatile("s_nop 4\n\tglobal_load_dwordx4 %0, %1, %2" : "=v"(sb[i]) : "v"(boff), "s"(bbase + ((size_t)(kt) * 64 + (i) * 8) * ldb4) : "memory")
#define G_WRITE_B(i, buf) do { u32x2 w_ = {pk_bf16(sb[i][0], sb[i][1]), pk_bf16(sb[i][2], sb[i][3])}; \
        *(LAS u32x2*)(lds + (buf) * G_STAGE_B + (((i) & 1) ? b_lds1 : b_lds0) + (i) * 8 * B_PITCH) = w_; } while (0)
#define G_KSTEP(buf, ks) do { bf16x8 At[8], Bf[4]; \
        _Pragma("unroll") for (int n = 0; n < 4; ++n) { const s16x4 lo_ = vtr(lds + (buf) * G_STAGE_B + b_rd + (ks) * 32 * B_PITCH + n * 32), hi_ = vtr(lds + (buf) * G_STAGE_B + b_rd + (ks) * 32 * B_PITCH + 4 * B_PITCH + n * 32); \
            Bf[n] = (bf16x8){lo_[0], lo_[1], lo_[2], lo_[3], hi_[0], hi_[1], hi_[2], hi_[3]}; } \
        _Pragma("unroll") for (int m = 0; m < 8; ++m) At[m] = *(const LAS bf16x8*)(lds + (buf) * G_STAGE_B + ((ks) ? a_rd1 : a_rd0) + m * 2048); \
        SBAR(); __builtin_amdgcn_s_setprio(1); \
        _Pragma("unroll") for (int m = 0; m < 8; ++m) _Pragma("unroll") for (int n = 0; n < 4; ++n) \
            acc[m][n] = __builtin_amdgcn_mfma_f32_16x16x32_bf16(Bf[n], At[m], acc[m][n], 0, 0, 0); \
        __builtin_amdgcn_s_setprio(0); SBAR(); } while (0)
#pragma unroll
    for (int i = 0; i < 4; ++i) G_STAGE_A(i, 0, 0);
#pragma unroll
    for (int i = 0; i < 8; ++i) G_ISSUE_B(i, 0);
    WAIT_V4(0, sb[0], sb[1], sb[2], sb[3]); WAIT_V4(0, sb[4], sb[5], sb[6], sb[7]);
#pragma unroll
    for (int i = 0; i < 8; ++i) G_WRITE_B(i, 0);
    SBAR();
#pragma unroll
    for (int i = 0; i < 8; ++i) G_ISSUE_B(i, 1);
    SBAR();
    RAW_BARRIER();
#pragma unroll 1
    for (int t = 0; t < nt; ++t) {
        const int cur = t & 1, nxt = cur ^ 1;
        if constexpr (MID) { if (t == (nt >> 1)) epi.mid(acc, wr, wc, fr, fq); }
        const int k1 = (t + 1 < nt) ? t + 1 : nt - 1, k2 = (t + 2 < nt) ? t + 2 : nt - 1;
        G_STAGE_A(0, k1, nxt); G_STAGE_A(1, k1, nxt); G_STAGE_A(2, k1, nxt); G_STAGE_A(3, k1, nxt);
        G_KSTEP(cur, 0);
        WAIT_V4(8, sb[0], sb[1], sb[2], sb[3]);
        G_WRITE_B(0, nxt); G_WRITE_B(1, nxt); G_WRITE_B(2, nxt); G_WRITE_B(3, nxt); SBAR();
        G_ISSUE_B(0, k2); G_ISSUE_B(1, k2); G_ISSUE_B(2, k2); G_ISSUE_B(3, k2); SBAR();
        G_KSTEP(cur, 1);
        WAIT_V4(8, sb[4], sb[5], sb[6], sb[7]);
        G_WRITE_B(4, nxt); G_WRITE_B(5, nxt); G_WRITE_B(6, nxt); G_WRITE_B(7, nxt); SBAR();
        G_ISSUE_B(4, k2); G_ISSUE_B(5, k2); G_ISSUE_B(6, k2); G_ISSUE_B(7, k2); SBAR();
        asm volatile("s_waitcnt vmcnt(8)" ::: "memory");
        RAW_BARRIER();
    }
    WAIT_V4(0, sb[0], sb[1], sb[2], sb[3]); WAIT_V4(0, sb[4], sb[5], sb[6], sb[7]);
    epi.fin(acc, wr, wc, fr, fq);
#undef G_STAGE_A
#undef G_ISSUE_B
#undef G_WRITE_B
#undef G_KSTEP
}

constexpr int A8_TILE_B = 16384, B8_PITCH = 288, B8_TILE_B = 64 * B8_PITCH;
constexpr int A8_RING = 5, B8_RING = 4, B8_OFF = A8_RING * A8_TILE_B;
static_assert(B8_OFF + B8_RING * B8_TILE_B <= LDS_MISC, "fp8 rings fit below the misc words");
__device__ __forceinline__ v2i vtr8(const LAS char* p) { return __builtin_amdgcn_ds_read_tr8_b64_v2i32((LAS v2i*)p); }
template <int SCALE_X, class AF, class BF, class EPI>
__device__ __forceinline__ void gemm_unit8(LAS char* lds, LAS unsigned* ring_cnt, const int nt, const AF& af, const BF& bf, EPI& epi) {
    const int tid = threadIdx.x, wid = __builtin_amdgcn_readfirstlane(tid >> 6), lane = tid & 63, wr = wid >> 2, wc = wid & 3, r32 = lane & 31, hi = lane >> 5;
    const char* abase = uniform_ptr(af.base);
    unsigned aoff[2];
#pragma unroll
    for (int i = 0; i < 2; ++i) { const int R = wid * 16 + i * 128 + (lane >> 2), C = ((lane & 3) ^ ((lane >> 4) & 3)) * 16; aoff[i] = af.rowoff(R) + (unsigned)C; }
    const unsigned lds_u = (unsigned)__builtin_amdgcn_readfirstlane((int)(unsigned)(size_t)lds) + (unsigned)(wid * 1024);
    const size_t ldb4 = (size_t)bf.ld * 4;
    const char* bbase = uniform_ptr(bf.base) + (size_t)wid * ldb4;
    const unsigned boff = bf.coloff(4 * lane) * 4u;
    const int b_wr = B8_OFF + wid * B8_PITCH + 4 * lane;
    const int a_rd0 = (wr * 128 + r32) * 64 + (((2 * hi) ^ ((r32 >> 2) & 3)) << 4), a_rd1 = a_rd0 ^ 16;
    const int b_rd = B8_OFF + (32 * hi + ((lane & 15) >> 1)) * B8_PITCH + wc * 64 + 16 * ((lane >> 4) & 1) + 8 * (lane & 1);
    f32x16 acc[4][2];
#pragma unroll
    for (int m = 0; m < 4; ++m)
#pragma unroll
        for (int n = 0; n < 2; ++n)
#pragma unroll
            for (int r = 0; r < 16; ++r) acc[m][n][r] = 0.f;
    f32x4 sb[8];
#define H_STAGE_A(i, kt, slot) glds16s(abase + (size_t)(kt) * 64, aoff[i], lds_u + (unsigned)((slot) * A8_TILE_B + (i) * 8192))
#define H_ISSUE_B(i, kt) asm volatile("s_nop 4\n\tglobal_load_dwordx4 %0, %1, %2" : "=v"(sb[i]) : "v"(boff), "s"(bbase + ((size_t)(kt) * 64 + (i) * 8) * ldb4) : "memory")
#define H_WRITE_B(i, slot) *(LAS unsigned*)(lds + (slot) * B8_TILE_B + b_wr + (i) * 8 * B8_PITCH) = pk4_fp8_x64(sb[i])
#define H_KSTEP(sa, sbk) do { v8i Xf[4], Wf[2]; \
        _Pragma("unroll") for (int n = 0; n < 2; ++n) _Pragma("unroll") for (int r = 0; r < 4; ++r) { const v2i t_ = vtr8(lds + (sbk) * B8_TILE_B + b_rd + r * 8 * B8_PITCH + n * 32); Wf[n][2 * r] = t_[0]; Wf[n][2 * r + 1] = t_[1]; } \
        _Pragma("unroll") for (int m = 0; m < 4; ++m) { const i32x4 lo_ = *(const LAS i32x4*)(lds + (sa) * A8_TILE_B + a_rd0 + m * 2048), hi_ = *(const LAS i32x4*)(lds + (sa) * A8_TILE_B + a_rd1 + m * 2048); \
            Xf[m] = (v8i){lo_[0], lo_[1], lo_[2], lo_[3], hi_[0], hi_[1], hi_[2], hi_[3]}; } \
        SBAR(); __builtin_amdgcn_s_setprio(1); \
        _Pragma("unroll") for (int m = 0; m < 4; ++m) _Pragma("unroll") for (int n = 0; n < 2; ++n) \
            acc[m][n] = __builtin_amdgcn_mfma_scale_f32_32x32x64_f8f6f4(Wf[n], Xf[m], acc[m][n], 0, 0, 0, 0x79797979, 0, SCALE_X); \
        __builtin_amdgcn_s_setprio(0); SBAR(); } while (0)
    if (tid < 8) ring_cnt[tid] = 0u;
    H_STAGE_A(0, 0, 0); H_STAGE_A(1, 0, 0); H_STAGE_A(0, 1, 1); H_STAGE_A(1, 1, 1);
#pragma unroll
    for (int i = 0; i < 8; ++i) H_ISSUE_B(i, 0);
    WAIT_V4(0, sb[0], sb[1], sb[2], sb[3]); WAIT_V4(0, sb[4], sb[5], sb[6], sb[7]);
#pragma unroll
    for (int i = 0; i < 8; ++i) H_WRITE_B(i, 0);
    SBAR();
#pragma unroll
    for (int i = 0; i < 8; ++i) H_ISSUE_B(i, 1);
    WAIT_V4(0, sb[0], sb[1], sb[2], sb[3]); WAIT_V4(0, sb[4], sb[5], sb[6], sb[7]);
#pragma unroll
    for (int i = 0; i < 8; ++i) H_WRITE_B(i, 1);
    SBAR();
    H_STAGE_A(0, 2, 2); H_STAGE_A(1, 2, 2);
#pragma unroll
    for (int i = 0; i < 8; ++i) H_ISSUE_B(i, 2);
    SBAR();
    RAW_BARRIER();
    int sa_r = 0, sa_w = 3, sb_r = 0, sb_w = 2;
#pragma unroll 1
    for (int t = 0; t < nt; ++t) {
        if (t >= 2) {
            const unsigned need = (unsigned)(t - 1);
            for (;;) { asm volatile("" ::: "memory"); const unsigned v = *(volatile LAS unsigned*)(ring_cnt + (lane & 7)); if (__all(v >= need)) break; __builtin_amdgcn_s_sleep(1); }
            asm volatile("" ::: "memory");
        }
        const int k3 = (t + 3 < nt) ? t + 3 : nt - 1;
        H_STAGE_A(0, k3, sa_w); H_STAGE_A(1, k3, sa_w);
        H_KSTEP(sa_r, sb_r);
        WAIT_V4(6, sb[0], sb[1], sb[2], sb[3]);
        H_WRITE_B(0, sb_w); H_WRITE_B(1, sb_w); H_WRITE_B(2, sb_w); H_WRITE_B(3, sb_w); SBAR();
        H_ISSUE_B(0, k3); H_ISSUE_B(1, k3); H_ISSUE_B(2, k3); H_ISSUE_B(3, k3); SBAR();
        WAIT_V4(6, sb[4], sb[5], sb[6], sb[7]);
        H_WRITE_B(4, sb_w); H_WRITE_B(5, sb_w); H_WRITE_B(6, sb_w); H_WRITE_B(7, sb_w); SBAR();
        H_ISSUE_B(4, k3); H_ISSUE_B(5, k3); H_ISSUE_B(6, k3); H_ISSUE_B(7, k3); SBAR();
        asm volatile("" ::: "memory");
        if (lane == 0) *(volatile LAS unsigned*)(ring_cnt + wid) = (unsigned)(t + 1);
        asm volatile("" ::: "memory");
        sa_r = (sa_r == A8_RING - 1) ? 0 : sa_r + 1; sa_w = (sa_w == A8_RING - 1) ? 0 : sa_w + 1;
        sb_r = (sb_r == B8_RING - 1) ? 0 : sb_r + 1; sb_w = (sb_w == B8_RING - 1) ? 0 : sb_w + 1;
    }
    WAIT_V4(0, sb[0], sb[1], sb[2], sb[3]); WAIT_V4(0, sb[4], sb[5], sb[6], sb[7]);
    RAW_BARRIER();
    epi.fin(acc, wr, wc, r32, hi);
#undef H_STAGE_A
#undef H_ISSUE_B
#undef H_WRITE_B
#undef H_KSTEP
}

template <int SCALE_X, class AF, class BF, class EPI>
__device__ __forceinline__ void gemm_unit8h(LAS char* lds, LAS unsigned* ring_cnt, const int nt, const AF& af, const BF& bf, EPI& epi) {
    const int tid = threadIdx.x, wid = __builtin_amdgcn_readfirstlane(tid >> 6), lane = tid & 63, wr = wid >> 2, wc = wid & 3, r32 = lane & 31, hi = lane >> 5;
    const char* abase = uniform_ptr(af.base);
    unsigned aoff[2];
#pragma unroll
    for (int i = 0; i < 2; ++i) { const int R = wid * 16 + i * 128 + (lane >> 2), C = ((lane & 3) ^ ((lane >> 4) & 3)) * 16; aoff[i] = af.rowoff(R) + (unsigned)C; }
    const unsigned lds_u = (unsigned)__builtin_amdgcn_readfirstlane((int)(unsigned)(size_t)lds) + (unsigned)(wid * 1024);
    const size_t ldb4 = (size_t)bf.ld * 4;
    const char* bbase = uniform_ptr(bf.base) + (size_t)wid * ldb4;
    const unsigned boff = (unsigned)(lane >> 5) * 8u * (unsigned)ldb4 + bf.coloff(4 * (lane & 31)) * 4u;
    const int b_wr = B8_OFF + (wid + 8 * (lane >> 5)) * B8_PITCH + 4 * (lane & 31);
    const int a_rd0 = (wr * 128 + r32) * 64 + (((2 * hi) ^ ((r32 >> 2) & 3)) << 4), a_rd1 = a_rd0 ^ 16;
    const int b_rd = B8_OFF + (32 * hi + ((lane & 15) >> 1)) * B8_PITCH + wc * 32 + 16 * ((lane >> 4) & 1) + 8 * (lane & 1);
    f32x16 acc[4][1];
#pragma unroll
    for (int m = 0; m < 4; ++m)
#pragma unroll
        for (int n = 0; n < 1; ++n)
#pragma unroll
            for (int r = 0; r < 16; ++r) acc[m][n][r] = 0.f;
    f32x4 sb[4];
#define H_STAGE_A(i, kt, slot) glds16s(abase + (size_t)(kt) * 64, aoff[i], lds_u + (unsigned)((slot) * A8_TILE_B + (i) * 8192))
#define H_ISSUE_B(i, kt) asm volatile("s_nop 4\n\tglobal_load_dwordx4 %0, %1, %2" : "=v"(sb[i]) : "v"(boff), "s"(bbase + ((size_t)(kt) * 64 + (i) * 16) * ldb4) : "memory")
#define H_WRITE_B(i, slot) *(LAS unsigned*)(lds + (slot) * B8_TILE_B + b_wr + (i) * 16 * B8_PITCH) = pk4_fp8_x64(sb[i])
#define H_KSTEP(sa, sbk) do { v8i Xf[4], Wf[1]; \
        _Pragma("unroll") for (int n = 0; n < 1; ++n) _Pragma("unroll") for (int r = 0; r < 4; ++r) { const v2i t_ = vtr8(lds + (sbk) * B8_TILE_B + b_rd + r * 8 * B8_PITCH + n * 32); Wf[n][2 * r] = t_[0]; Wf[n][2 * r + 1] = t_[1]; } \
        _Pragma("unroll") for (int m = 0; m < 4; ++m) { const i32x4 lo_ = *(const LAS i32x4*)(lds + (sa) * A8_TILE_B + a_rd0 + m * 2048), hi_ = *(const LAS i32x4*)(lds + (sa) * A8_TILE_B + a_rd1 + m * 2048); \
            Xf[m] = (v8i){lo_[0], lo_[1], lo_[2], lo_[3], hi_[0], hi_[1], hi_[2], hi_[3]}; } \
        SBAR(); __builtin_amdgcn_s_setprio(1); \
        _Pragma("unroll") for (int m = 0; m < 4; ++m) _Pragma("unroll") for (int n = 0; n < 1; ++n) \
            acc[m][n] = __builtin_amdgcn_mfma_scale_f32_32x32x64_f8f6f4(Wf[n], Xf[m], acc[m][n], 0, 0, 0, 0x79797979, 0, SCALE_X); \
        __builtin_amdgcn_s_setprio(0); SBAR(); } while (0)
    if (tid < 8) ring_cnt[tid] = 0u;
    H_STAGE_A(0, 0, 0); H_STAGE_A(1, 0, 0); H_STAGE_A(0, 1, 1); H_STAGE_A(1, 1, 1);
#pragma unroll
    for (int i = 0; i < 4; ++i) H_ISSUE_B(i, 0);
    WAIT_V4(0, sb[0], sb[1], sb[2], sb[3]);
#pragma unroll
    for (int i = 0; i < 4; ++i) H_WRITE_B(i, 0);
    SBAR();
#pragma unroll
    for (int i = 0; i < 4; ++i) H_ISSUE_B(i, 1);
    WAIT_V4(0, sb[0], sb[1], sb[2], sb[3]);
#pragma unroll
    for (int i = 0; i < 4; ++i) H_WRITE_B(i, 1);
    SBAR();
    H_STAGE_A(0, 2, 2); H_STAGE_A(1, 2, 2);
#pragma unroll
    for (int i = 0; i < 4; ++i) H_ISSUE_B(i, 2);
    SBAR();
    RAW_BARRIER();
    int sa_r = 0, sa_w = 3, sb_r = 0, sb_w = 2;
#pragma unroll 1
    for (int t = 0; t < nt; ++t) {
        if (t >= 2) {
            const unsigned need = (unsigned)(t - 1);
            for (;;) { asm volatile("" ::: "memory"); const unsigned v = *(volatile LAS unsigned*)(ring_cnt + (lane & 7)); if (__all(v >= need)) break; __builtin_amdgcn_s_sleep(1); }
            asm volatile("" ::: "memory");
        }
        const int k3 = (t + 3 < nt) ? t + 3 : nt - 1;
        H_STAGE_A(0, k3, sa_w); H_STAGE_A(1, k3, sa_w);
        H_KSTEP(sa_r, sb_r);
        WAIT_V4(2, sb[0], sb[1], sb[2], sb[3]);
        H_WRITE_B(0, sb_w); H_WRITE_B(1, sb_w); H_WRITE_B(2, sb_w); H_WRITE_B(3, sb_w); SBAR();
        H_ISSUE_B(0, k3); H_ISSUE_B(1, k3); H_ISSUE_B(2, k3); H_ISSUE_B(3, k3); SBAR();
        asm volatile("" ::: "memory");
        if (lane == 0) *(volatile LAS unsigned*)(ring_cnt + wid) = (unsigned)(t + 1);
        asm volatile("" ::: "memory");
        sa_r = (sa_r == A8_RING - 1) ? 0 : sa_r + 1; sa_w = (sa_w == A8_RING - 1) ? 0 : sa_w + 1;
        sb_r = (sb_r == B8_RING - 1) ? 0 : sb_r + 1; sb_w = (sb_w == B8_RING - 1) ? 0 : sb_w + 1;
    }
    WAIT_V4(0, sb[0], sb[1], sb[2], sb[3]);
    RAW_BARRIER();
    epi.fin(acc, wr, wc, r32, hi);
#undef H_STAGE_A
#undef H_ISSUE_B
#undef H_WRITE_B
#undef H_KSTEP
}

template <int SCALE_X, class AF, class BF, class EPI>
__device__ __forceinline__ void gemm_unit8q(LAS char* lds, LAS unsigned* ring_cnt, const int nt, const AF& af, const BF& bf, EPI& epi) {
    const int tid = threadIdx.x, wid = __builtin_amdgcn_readfirstlane(tid >> 6), lane = tid & 63, wr = wid >> 1, wc = wid & 1, r32 = lane & 31, hi = lane >> 5;
    const char* abase = uniform_ptr(af.base);
    unsigned aoff[2];
#pragma unroll
    for (int i = 0; i < 2; ++i) { const int R = wid * 16 + i * 128 + (lane >> 2), C = ((lane & 3) ^ ((lane >> 4) & 3)) * 16; aoff[i] = af.rowoff(R) + (unsigned)C; }
    const unsigned lds_u = (unsigned)__builtin_amdgcn_readfirstlane((int)(unsigned)(size_t)lds) + (unsigned)(wid * 1024);
    const size_t ldb4 = (size_t)bf.ld * 4;
    const char* bbase = uniform_ptr(bf.base) + (size_t)wid * ldb4;
    const unsigned boff = (unsigned)(lane >> 5) * 8u * (unsigned)ldb4 + bf.coloff(4 * (lane & 31)) * 4u;
    const int b_wr = B8_OFF + (wid + 8 * (lane >> 5)) * B8_PITCH + 4 * (lane & 31);
    const int a_rd0 = (wr * 64 + r32) * 64 + (((2 * hi) ^ ((r32 >> 2) & 3)) << 4), a_rd1 = a_rd0 ^ 16;
    const int b_rd = B8_OFF + (32 * hi + ((lane & 15) >> 1)) * B8_PITCH + wc * 64 + 16 * ((lane >> 4) & 1) + 8 * (lane & 1);
    f32x16 acc[2][2];
#pragma unroll
    for (int m = 0; m < 2; ++m)
#pragma unroll
        for (int n = 0; n < 2; ++n)
#pragma unroll
            for (int r = 0; r < 16; ++r) acc[m][n][r] = 0.f;
    f32x4 sb[4];
#define H_STAGE_A(i, kt, slot) glds16s(abase + (size_t)(kt) * 64, aoff[i], lds_u + (unsigned)((slot) * A8_TILE_B + (i) * 8192))
#define H_ISSUE_B(i, kt) asm volatile("s_nop 4\n\tglobal_load_dwordx4 %0, %1, %2" : "=v"(sb[i]) : "v"(boff), "s"(bbase + ((size_t)(kt) * 64 + (i) * 16) * ldb4) : "memory")
#define H_WRITE_B(i, slot) *(LAS unsigned*)(lds + (slot) * B8_TILE_B + b_wr + (i) * 16 * B8_PITCH) = pk4_fp8_x64(sb[i])
#define H_KSTEP(sa, sbk) do { v8i Xf[2], Wf[2]; \
        _Pragma("unroll") for (int n = 0; n < 2; ++n) _Pragma("unroll") for (int r = 0; r < 4; ++r) { const v2i t_ = vtr8(lds + (sbk) * B8_TILE_B + b_rd + r * 8 * B8_PITCH + n * 32); Wf[n][2 * r] = t_[0]; Wf[n][2 * r + 1] = t_[1]; } \
        _Pragma("unroll") for (int m = 0; m < 2; ++m) { const i32x4 lo_ = *(const LAS i32x4*)(lds + (sa) * A8_TILE_B + a_rd0 + m * 2048), hi_ = *(const LAS i32x4*)(lds + (sa) * A8_TILE_B + a_rd1 + m * 2048); \
            Xf[m] = (v8i){lo_[0], lo_[1], lo_[2], lo_[3], hi_[0], hi_[1], hi_[2], hi_[3]}; } \
        SBAR(); __builtin_amdgcn_s_setprio(1); \
        _Pragma("unroll") for (int m = 0; m < 2; ++m) _Pragma("unroll") for (int n = 0; n < 2; ++n) \
            acc[m][n] = __builtin_amdgcn_mfma_scale_f32_32x32x64_f8f6f4(Wf[n], Xf[m], acc[m][n], 0, 0, 0, 0x79797979, 0, SCALE_X); \
        __builtin_amdgcn_s_setprio(0); SBAR(); } while (0)
    if (tid < 8) ring_cnt[tid] = 0u;
    H_STAGE_A(0, 0, 0); H_STAGE_A(1, 0, 0); H_STAGE_A(0, 1, 1); H_STAGE_A(1, 1, 1);
#pragma unroll
    for (int i = 0; i < 4; ++i) H_ISSUE_B(i, 0);
    WAIT_V4(0, sb[0], sb[1], sb[2], sb[3]);
#pragma unroll
    for (int i = 0; i < 4; ++i) H_WRITE_B(i, 0);
    SBAR();
#pragma unroll
    for (int i = 0; i < 4; ++i) H_ISSUE_B(i, 1);
    WAIT_V4(0, sb[0], sb[1], sb[2], sb[3]);
#pragma unroll
    for (int i = 0; i < 4; ++i) H_WRITE_B(i, 1);
    SBAR();
    H_STAGE_A(0, 2, 2); H_STAGE_A(1, 2, 2);
#pragma unroll
    for (int i = 0; i < 4; ++i) H_ISSUE_B(i, 2);
    SBAR();
    RAW_BARRIER();
    int sa_r = 0, sa_w = 3, sb_r = 0, sb_w = 2;
#pragma unroll 1
    for (int t = 0; t < nt; ++t) {
        if (t >= 2) {
            const unsigned need = (unsigned)(t - 1);
            for (;;) { asm volatile("" ::: "memory"); const unsigned v = *(volatile LAS unsigned*)(ring_cnt + (lane & 7)); if (__all(v >= need)) break; __builtin_amdgcn_s_sleep(1); }
            asm volatile("" ::: "memory");
        }
        const int k3 = (t + 3 < nt) ? t + 3 : nt - 1;
        H_STAGE_A(0, k3, sa_w); H_STAGE_A(1, k3, sa_w);
        H_KSTEP(sa_r, sb_r);
        WAIT_V4(2, sb[0], sb[1], sb[2], sb[3]);
        H_WRITE_B(0, sb_w); H_WRITE_B(1, sb_w); H_WRITE_B(2, sb_w); H_WRITE_B(3, sb_w); SBAR();
        H_ISSUE_B(0, k3); H_ISSUE_B(1, k3); H_ISSUE_B(2, k3); H_ISSUE_B(3, k3); SBAR();
        asm volatile("" ::: "memory");
        if (lane == 0) *(volatile LAS unsigned*)(ring_cnt + wid) = (unsigned)(t + 1);
        asm volatile("" ::: "memory");
        sa_r = (sa_r == A8_RING - 1) ? 0 : sa_r + 1; sa_w = (sa_w == A8_RING - 1) ? 0 : sa_w + 1;
        sb_r = (sb_r == B8_RING - 1) ? 0 : sb_r + 1; sb_w = (sb_w == B8_RING - 1) ? 0 : sb_w + 1;
    }
    WAIT_V4(0, sb[0], sb[1], sb[2], sb[3]);
    RAW_BARRIER();
    epi.fin(acc, wr, wc, r32, hi);
#undef H_STAGE_A
#undef H_ISSUE_B
#undef H_WRITE_B
#undef H_KSTEP
}

constexpr int C8_B_TILE = 16384, C8_B_OFF = A8_RING * A8_TILE_B;
template <int SCALE_X, class AF, class EPI>
__device__ __forceinline__ void gemm_unit8b(LAS char* lds, LAS unsigned* ring_cnt, const int nt, const AF& af, const unsigned char* img, EPI& epi) {
    const int tid = threadIdx.x, wid = __builtin_amdgcn_readfirstlane(tid >> 6), lane = tid & 63, wr = wid >> 2, wc = wid & 3, r32 = lane & 31, hi = lane >> 5;
    const char* abase = uniform_ptr(af.base);
    unsigned aoff[2];
#pragma unroll
    for (int i = 0; i < 2; ++i) { const int R = wid * 16 + i * 128 + (lane >> 2), C = ((lane & 3) ^ ((lane >> 4) & 3)) * 16; aoff[i] = af.rowoff(R) + (unsigned)C; }
    const unsigned lds_u = (unsigned)__builtin_amdgcn_readfirstlane((int)(unsigned)(size_t)lds) + (unsigned)(wid * 1024);
    const char* ibase = uniform_ptr(img);
    const unsigned ioff = (unsigned)(wid * 1024 + lane * 16);
    const int b_wr = C8_B_OFF + wid * 1024 + lane * 16;
    const int a_rd0 = (wr * 128 + r32) * 64 + (((2 * hi) ^ ((r32 >> 2) & 3)) << 4), a_rd1 = a_rd0 ^ 16;
    const int q8 = (lane & 15) >> 1;
    const int b_rd0 = C8_B_OFF + (32 * hi + q8) * 256 + ((wc * 64 + 16 * ((lane >> 4) & 1) + 8 * (lane & 1)) ^ (q8 << 5)), b_rd1 = b_rd0 ^ 32;
    i32x4 sv[2];
#define C_STAGE_A(i, kt, slot) glds16s(abase + (size_t)(kt) * 64, aoff[i], lds_u + (unsigned)((slot) * A8_TILE_B + (i) * 8192))
#define C_ISSUE_B(i, kt) asm volatile("s_nop 4\n\tglobal_load_dwordx4 %0, %1, %2" : "=v"(sv[i]) : "v"(ioff), "s"(ibase + (size_t)(kt) * 16384 + (i) * 8192) : "memory")
#define C_WRITE_B(i, slot) *(LAS i32x4*)(lds + (slot) * C8_B_TILE + b_wr + (i) * 8192) = sv[i]
#define C_WAIT(n) asm volatile("s_waitcnt vmcnt(" #n ")" : "+v"(sv[0]), "+v"(sv[1]) :: "memory")
    if (tid < 8) ring_cnt[tid] = 0u;
    C_STAGE_A(0, 0, 0); C_STAGE_A(1, 0, 0); C_STAGE_A(0, 1, 1); C_STAGE_A(1, 1, 1);
    C_ISSUE_B(0, 0); C_ISSUE_B(1, 0); C_WAIT(0); C_WRITE_B(0, 0); C_WRITE_B(1, 0); SBAR();
    C_ISSUE_B(0, 1); C_ISSUE_B(1, 1); C_WAIT(0); C_WRITE_B(0, 1); C_WRITE_B(1, 1); SBAR();
    C_STAGE_A(0, 2, 2); C_STAGE_A(1, 2, 2);
    C_ISSUE_B(0, 2); C_ISSUE_B(1, 2);
    SBAR();
    f32x16 acc[4][2];
#pragma unroll
    for (int m = 0; m < 4; ++m)
#pragma unroll
        for (int n = 0; n < 2; ++n)
#pragma unroll
            for (int r = 0; r < 16; ++r) acc[m][n][r] = 0.f;
    RAW_BARRIER();
    int sa_r = 0, sa_w = 3, sb_r = 0, sb_w = 2;
#pragma unroll 1
    for (int t = 0; t < nt; ++t) {
        if (t >= 2) { const unsigned need = (unsigned)(t - 1);
            for (;;) { asm volatile("" ::: "memory"); const unsigned v = *(volatile LAS unsigned*)(ring_cnt + (lane & 7)); if (__all(v >= need)) break; __builtin_amdgcn_s_sleep(1); }
            asm volatile("" ::: "memory"); }
        const int k3 = (t + 3 < nt) ? t + 3 : nt - 1;
        C_STAGE_A(0, k3, sa_w); C_STAGE_A(1, k3, sa_w);
        { v8i Xf[4], Wf[2];
#pragma unroll
          for (int r = 0; r < 4; ++r) { const v2i t0_ = vtr8(lds + sb_r * C8_B_TILE + b_rd0 + r * 2048), t1_ = vtr8(lds + sb_r * C8_B_TILE + b_rd1 + r * 2048); Wf[0][2 * r] = t0_[0]; Wf[0][2 * r + 1] = t0_[1]; Wf[1][2 * r] = t1_[0]; Wf[1][2 * r + 1] = t1_[1]; }
#pragma unroll
          for (int m = 0; m < 4; ++m) { const i32x4 lo_ = *(const LAS i32x4*)(lds + sa_r * A8_TILE_B + a_rd0 + m * 2048), hi_ = *(const LAS i32x4*)(lds + sa_r * A8_TILE_B + a_rd1 + m * 2048);
              Xf[m] = (v8i){lo_[0], lo_[1], lo_[2], lo_[3], hi_[0], hi_[1], hi_[2], hi_[3]}; }
          SBAR(); __builtin_amdgcn_s_setprio(1);
#pragma unroll
          for (int m = 0; m < 4; ++m)
#pragma unroll
              for (int n = 0; n < 2; ++n) acc[m][n] = __builtin_amdgcn_mfma_scale_f32_32x32x64_f8f6f4(Wf[n], Xf[m], acc[m][n], 0, 0, 0, 0x79797979, 0, SCALE_X);
          __builtin_amdgcn_s_setprio(0); SBAR(); }
        C_WAIT(2);
        C_WRITE_B(0, sb_w); C_WRITE_B(1, sb_w); SBAR();
        C_ISSUE_B(0, k3); C_ISSUE_B(1, k3); SBAR();
        asm volatile("" ::: "memory");
        if (lane == 0) *(volatile LAS unsigned*)(ring_cnt + wid) = (unsigned)(t + 1);
        asm volatile("" ::: "memory");
        sa_r = (sa_r == A8_RING - 1) ? 0 : sa_r + 1; sa_w = (sa_w == A8_RING - 1) ? 0 : sa_w + 1;
        sb_r = (sb_r == B8_RING - 1) ? 0 : sb_r + 1; sb_w = (sb_w == B8_RING - 1) ? 0 : sb_w + 1;
    }
    C_WAIT(0);
    RAW_BARRIER();
    epi.fin(acc, wr, wc, r32, hi);
#undef C_STAGE_A
#undef C_ISSUE_B
#undef C_WRITE_B
#undef C_WAIT
}
template <int SCALE_X, class AF, class EPI>
__device__ __forceinline__ void gemm_unit8bh(LAS char* lds, LAS unsigned* ring_cnt, const int nt, const AF& af, const unsigned char* img, const int hf, EPI& epi) {
    const int tid = threadIdx.x, wid = __builtin_amdgcn_readfirstlane(tid >> 6), lane = tid & 63, wr = wid >> 2, wc = wid & 3, r32 = lane & 31, hi = lane >> 5;
    const char* abase = uniform_ptr(af.base);
    unsigned aoff[2];
#pragma unroll
    for (int i = 0; i < 2; ++i) { const int R = wid * 16 + i * 128 + (lane >> 2), C = ((lane & 3) ^ ((lane >> 4) & 3)) * 16; aoff[i] = af.rowoff(R) + (unsigned)C; }
    const unsigned lds_u = (unsigned)__builtin_amdgcn_readfirstlane((int)(unsigned)(size_t)lds) + (unsigned)(wid * 1024);
    const char* ibase = uniform_ptr(img);
    const unsigned ioff = (unsigned)(wid * 1024 + lane * 16);
    const int b_wr = C8_B_OFF + wid * 1024 + lane * 16;
    const int a_rd0 = (wr * 128 + r32) * 64 + (((2 * hi) ^ ((r32 >> 2) & 3)) << 4), a_rd1 = a_rd0 ^ 16;
    const int q8 = (lane & 15) >> 1;
    const int b_rd0 = C8_B_OFF + (32 * hi + q8) * 256 + ((hf * 128 + wc * 32 + 16 * ((lane >> 4) & 1) + 8 * (lane & 1)) ^ (q8 << 5));
    i32x4 sv[2];
#define C_STAGE_A(i, kt, slot) glds16s(abase + (size_t)(kt) * 64, aoff[i], lds_u + (unsigned)((slot) * A8_TILE_B + (i) * 8192))
#define C_ISSUE_B(i, kt) asm volatile("s_nop 4\n\tglobal_load_dwordx4 %0, %1, %2" : "=v"(sv[i]) : "v"(ioff), "s"(ibase + (size_t)(kt) * 16384 + (i) * 8192) : "memory")
#define C_WRITE_B(i, slot) *(LAS i32x4*)(lds + (slot) * C8_B_TILE + b_wr + (i) * 8192) = sv[i]
#define C_WAIT(n) asm volatile("s_waitcnt vmcnt(" #n ")" : "+v"(sv[0]), "+v"(sv[1]) :: "memory")
    if (tid < 8) ring_cnt[tid] = 0u;
    C_STAGE_A(0, 0, 0); C_STAGE_A(1, 0, 0); C_STAGE_A(0, 1, 1); C_STAGE_A(1, 1, 1);
    C_ISSUE_B(0, 0); C_ISSUE_B(1, 0); C_WAIT(0); C_WRITE_B(0, 0); C_WRITE_B(1, 0); SBAR();
    C_ISSUE_B(0, 1); C_ISSUE_B(1, 1); C_WAIT(0); C_WRITE_B(0, 1); C_WRITE_B(1, 1); SBAR();
    C_STAGE_A(0, 2, 2); C_STAGE_A(1, 2, 2);
    C_ISSUE_B(0, 2); C_ISSUE_B(1, 2);
    SBAR();
    f32x16 acc[4][1];
#pragma unroll
    for (int m = 0; m < 4; ++m)
#pragma unroll
        for (int n = 0; n < 1; ++n)
#pragma unroll
            for (int r = 0; r < 16; ++r) acc[m][n][r] = 0.f;
    RAW_BARRIER();
    int sa_r = 0, sa_w = 3, sb_r = 0, sb_w = 2;
#pragma unroll 1
    for (int t = 0; t < nt; ++t) {
        if (t >= 2) { const unsigned need = (unsigned)(t - 1);
            for (;;) { asm volatile("" ::: "memory"); const unsigned v = *(volatile LAS unsigned*)(ring_cnt + (lane & 7)); if (__all(v >= need)) break; __builtin_amdgcn_s_sleep(1); }
            asm volatile("" ::: "memory"); }
        const int k3 = (t + 3 < nt) ? t + 3 : nt - 1;
        C_STAGE_A(0, k3, sa_w); C_STAGE_A(1, k3, sa_w);
        { v8i Xf[4], Wf[1];
#pragma unroll
          for (int r = 0; r < 4; ++r) { const v2i t0_ = vtr8(lds + sb_r * C8_B_TILE + b_rd0 + r * 2048); Wf[0][2 * r] = t0_[0]; Wf[0][2 * r + 1] = t0_[1]; }
#pragma unroll
          for (int m = 0; m < 4; ++m) { const i32x4 lo_ = *(const LAS i32x4*)(lds + sa_r * A8_TILE_B + a_rd0 + m * 2048), hi_ = *(const LAS i32x4*)(lds + sa_r * A8_TILE_B + a_rd1 + m * 2048);
              Xf[m] = (v8i){lo_[0], lo_[1], lo_[2], lo_[3], hi_[0], hi_[1], hi_[2], hi_[3]}; }
          SBAR(); __builtin_amdgcn_s_setprio(1);
#pragma unroll
          for (int m = 0; m < 4; ++m)
#pragma unroll
              for (int n = 0; n < 1; ++n) acc[m][n] = __builtin_amdgcn_mfma_scale_f32_32x32x64_f8f6f4(Wf[n], Xf[m], acc[m][n], 0, 0, 0, 0x79797979, 0, SCALE_X);
          __builtin_amdgcn_s_setprio(0); SBAR(); }
        C_WAIT(2);
        C_WRITE_B(0, sb_w); C_WRITE_B(1, sb_w); SBAR();
        C_ISSUE_B(0, k3); C_ISSUE_B(1, k3); SBAR();
        asm volatile("" ::: "memory");
        if (lane == 0) *(volatile LAS unsigned*)(ring_cnt + wid) = (unsigned)(t + 1);
        asm volatile("" ::: "memory");
        sa_r = (sa_r == A8_RING - 1) ? 0 : sa_r + 1; sa_w = (sa_w == A8_RING - 1) ? 0 : sa_w + 1;
        sb_r = (sb_r == B8_RING - 1) ? 0 : sb_r + 1; sb_w = (sb_w == B8_RING - 1) ? 0 : sb_w + 1;
    }
    C_WAIT(0);
    RAW_BARRIER();
    epi.fin(acc, wr, wc, r32, hi);
#undef C_STAGE_A
#undef C_ISSUE_B
#undef C_WRITE_B
#undef C_WAIT
}

__device__ __forceinline__ void conv_image(const float* W, size_t ld, unsigned char* img, int t0, int t1) {
    const int tid = threadIdx.x, wid = tid >> 6, lane = tid & 63;
    const float* wp = W + (size_t)wid * ld + 4 * lane;
    unsigned char* ip = img + wid * 256 + ((4 * lane) ^ (wid << 5));
    for (int t = t0; t < t1; t += 2) { f32x4 v[2][8];
#pragma unroll
        for (int u = 0; u < 2; ++u)
#pragma unroll
            for (int i = 0; i < 8; ++i) v[u][i] = *(const f32x4*)(wp + ((size_t)(t + u) * 64 + i * 8) * ld);
#pragma unroll
        for (int u = 0; u < 2; ++u)
#pragma unroll
            for (int i = 0; i < 8; ++i) *(unsigned*)(ip + (size_t)(t + u) * 16384 + i * 2048) = pk4_fp8_x64(v[u][i]); }
}

struct Params {
    const float *x, *attn_norm, *w_in, *a_sink, *b_q_norm, *b_w_uq, *b_kv_norm, *b_w_ukv, *out_norm_a, *out_norm_b, *w_o, *mlp_norm, *w_router, *b_router,
        *w_up, *b_up, *w_down, *b_down, *final_norm;
    float* out; unsigned char* ws; int ph_lo, ph_hi;
};

struct ARows { const bf16_t* base; unsigned ld; __device__ __forceinline__ unsigned rowoff(int r) const { return (unsigned)r * ld; } };
struct AGather { const bf16_t* base; const int* tokl; int r0, cnt; __device__ __forceinline__ unsigned rowoff(int r) const { int rk = r0 + r; rk = rk < cnt ? rk : 0; return (unsigned)tokl[rk] * (unsigned)D_MODEL; } };
struct ARows8 { const unsigned char* base; unsigned ld; __device__ __forceinline__ unsigned rowoff(int r) const { return (unsigned)r * ld; } };
struct AGather8 { const unsigned char* base; const int* tokl; int r0, cnt; __device__ __forceinline__ unsigned rowoff(int r) const { int rk = r0 + r; rk = rk < cnt ? rk : 0; return (unsigned)tokl[rk] * (unsigned)D_MODEL; } };
struct BPlain { const float* base; size_t ld; int ncols;
    __device__ __forceinline__ unsigned coloff(int c) const { return (unsigned)(c < ncols ? c : (c & (ncols - 1))); } };
struct BGateUp { const float* base; size_t ld;
    __device__ __forceinline__ unsigned coloff(int c) const { const int wc = c >> 6, w = c & 63; return (unsigned)(wc * 32 + (w & 31) + ((w & 32) ? D_FF : 0)); } };

struct EpiProj {
    int pn, brow; unsigned char* ws; const float *qg, *kvg;
    __device__ __forceinline__ void mid(f32x4 (&)[8][4], int, int, int, int) {}
    __device__ __forceinline__ void fin(f32x4 (&acc)[8][4], int wr, int wc, int fr, int fq) {
        if (pn < 6) {
            bf16_t* dst; int ldd, c0;
            if (pn < 4) { dst = (bf16_t*)(ws + WS_QA); ldd = 1024; c0 = pn * 256; } else if (pn == 4) { dst = (bf16_t*)(ws + WS_KA); ldd = 256; c0 = 0; } else { dst = (bf16_t*)(ws + WS_VA); ldd = 256; c0 = 0; }
#pragma unroll
            for (int m = 0; m < 8; ++m) { const int row = brow + wr * 128 + m * 16 + fr;
#pragma unroll
                for (int n = 0; n < 4; ++n) { const int col = c0 + wc * 64 + n * 16 + fq * 4; const f32x4 v = acc[m][n];
                    *(u32x2*)(dst + (size_t)row * ldd + col) = (u32x2){pk_bf16(v[0], v[1]), pk_bf16(v[2], v[3])}; } }
        } else if (pn < 9) {
            bf16_t* dst; int ldd, c0; const float* g; float* ssq; int nsl, sl;
            if (pn < 8) { dst = (bf16_t*)(ws + WS_CQ); ldd = 512; c0 = (pn - 6) * 256; g = qg; ssq = (float*)(ws + WS_SSQC); nsl = 8; sl = (pn - 6) * 4 + wc; }
            else { dst = (bf16_t*)(ws + WS_CKV); ldd = 256; c0 = 0; g = kvg; ssq = (float*)(ws + WS_SSQK); nsl = 4; sl = wc; }
            f32x4 gvv[4];
#pragma unroll
            for (int n = 0; n < 4; ++n) gvv[n] = *(const f32x4*)(g + c0 + wc * 64 + n * 16 + fq * 4);
#pragma unroll
            for (int m = 0; m < 8; ++m) { const int row = brow + wr * 128 + m * 16 + fr; float ss = 0.f;
#pragma unroll
                for (int n = 0; n < 4; ++n) { const int col = c0 + wc * 64 + n * 16 + fq * 4; const f32x4 v = acc[m][n]; const f32x4 gv = gvv[n];
                    ss += v[0] * v[0] + v[1] * v[1] + v[2] * v[2] + v[3] * v[3];
                    *(u32x2*)(dst + (size_t)row * ldd + col) = (u32x2){pk_bf16(v[0] * gv[0], v[1] * gv[1]), pk_bf16(v[2] * gv[2], v[3] * gv[3])}; }
                ss += __shfl_xor(ss, 16, 64); ss += __shfl_xor(ss, 32, 64);
                if (fq == 0) ssq[(size_t)row * nsl + sl] = ss; }
        } else {
            if (wc == 0) {
                bf16_t* dst = (bf16_t*)(ws + WS_KPE); const float* rope = (const float*)(ws + WS_ROPE);
#pragma unroll
                for (int m = 0; m < 8; ++m) { const int row = brow + wr * 128 + m * 16 + fr; const int pos = row & (SEQ - 1);
#pragma unroll
                    for (int n = 0; n < 2; ++n) { const int i0 = n * 16 + fq * 4; const f32x4 x1 = acc[m][n], x2 = acc[m][n + 2];
                        const f32x4 cs0 = *(const f32x4*)(rope + ((size_t)pos * 32 + i0) * 2), cs1 = *(const f32x4*)(rope + ((size_t)pos * 32 + i0) * 2 + 4);
                        const float c[4] = {cs0[0], cs0[2], cs1[0], cs1[2]}, s[4] = {cs0[1], cs0[3], cs1[1], cs1[3]};
                        float o1[4], o2[4];
#pragma unroll
                        for (int j = 0; j < 4; ++j) { o1[j] = x1[j] * c[j] - x2[j] * s[j]; o2[j] = x1[j] * s[j] + x2[j] * c[j]; }
                        *(u32x2*)(dst + (size_t)row * 64 + i0) = (u32x2){pk_bf16(o1[0], o1[1]), pk_bf16(o1[2], o1[3])};
                        *(u32x2*)(dst + (size_t)row * 64 + 32 + i0) = (u32x2){pk_bf16(o2[0], o2[1]), pk_bf16(o2[2], o2[3])}; } }
            }
        }
    }
};
struct EpiQUp {
    int pn, brow; unsigned char* ws;
    __device__ __forceinline__ void mid(f32x4 (&)[8][4], int, int, int, int) {}
    __device__ __forceinline__ void fin(f32x4 (&acc)[8][4], int wr, int wc, int fr, int fq) {
        bf16_t* dst = (bf16_t*)(ws + WS_QB); const float* rope = (const float*)(ws + WS_ROPE); const float* ssq = (const float*)(ws + WS_CTL + CTL_SSQ_CQ);
        const int seg = pn * 4 + wc, head = seg / 3, part = seg - head * 3;
        float sq[8];
#pragma unroll
        for (int m = 0; m < 8; ++m) { const f32x4* pp = (const f32x4*)((const float*)(ws + WS_SSQC) + (size_t)(brow + wr * 128 + m * 16 + fr) * 8); const f32x4 p0 = pp[0], p1 = pp[1];
            sq[m] = ((p0[0] + p0[1]) + (p0[2] + p0[3])) + ((p1[0] + p1[1]) + (p1[2] + p1[3])); }
#pragma unroll
        for (int m = 0; m < 8; ++m) { const int row = brow + wr * 128 + m * 16 + fr; const float rs = rsqrtf(sq[m] * (1.f / 512.f) + EPS);
            bf16_t* drow = dst + (size_t)row * 1536 + head * 192 + part * 64;
            if (part < 2) {
#pragma unroll
                for (int n = 0; n < 4; ++n) { const f32x4 v = acc[m][n]; *(u32x2*)(drow + n * 16 + fq * 4) = (u32x2){pk_bf16(v[0] * rs, v[1] * rs), pk_bf16(v[2] * rs, v[3] * rs)}; }
            } else { const int pos = row & (SEQ - 1);
#pragma unroll
                for (int n = 0; n < 2; ++n) { const int i0 = n * 16 + fq * 4; const f32x4 x1 = acc[m][n], x2 = acc[m][n + 2];
                    const f32x4 cs0 = *(const f32x4*)(rope + ((size_t)pos * 32 + i0) * 2), cs1 = *(const f32x4*)(rope + ((size_t)pos * 32 + i0) * 2 + 4);
                    const float c[4] = {cs0[0], cs0[2], cs1[0], cs1[2]}, s[4] = {cs0[1], cs0[3], cs1[1], cs1[3]};
                    float o1[4], o2[4];
#pragma unroll
                    for (int j = 0; j < 4; ++j) { o1[j] = (x1[j] * c[j] - x2[j] * s[j]) * rs; o2[j] = (x1[j] * s[j] + x2[j] * c[j]) * rs; }
                    *(u32x2*)(drow + i0) = (u32x2){pk_bf16(o1[0], o1[1]), pk_bf16(o1[2], o1[3])};
                    *(u32x2*)(drow + 32 + i0) = (u32x2){pk_bf16(o2[0], o2[1]), pk_bf16(o2[2], o2[3])}; } }
        }
    }
};
struct EpiKvUp {
    int pn, brow; unsigned char* ws;
    __device__ __forceinline__ void mid(f32x4 (&)[8][4], int, int, int, int) {}
    __device__ __forceinline__ void fin(f32x4 (&acc)[8][4], int wr, int wc, int fr, int fq) {
        bf16_t* dst = (bf16_t*)(ws + WS_KVB);
        float sq[8];
#pragma unroll
        for (int m = 0; m < 8; ++m) { const f32x4 p0 = *(const f32x4*)((const float*)(ws + WS_SSQK) + (size_t)(brow + wr * 128 + m * 16 + fr) * 4); sq[m] = (p0[0] + p0[1]) + (p0[2] + p0[3]); }
#pragma unroll
        for (int m = 0; m < 8; ++m) { const int row = brow + wr * 128 + m * 16 + fr; const float rs = rsqrtf(sq[m] * (1.f / 256.f) + EPS);
#pragma unroll
            for (int n = 0; n < 4; ++n) { const int col = pn * 256 + wc * 64 + n * 16 + fq * 4; const f32x4 v = acc[m][n];
                *(u32x2*)(dst + (size_t)row * 2048 + col) = (u32x2){pk_bf16(v[0] * rs, v[1] * rs), pk_bf16(v[2] * rs, v[3] * rs)}; } }
    }
};
struct EpiWo {
    int pn, brow; unsigned char* ws; const float* x; const LAS float* tab;
    __device__ __forceinline__ void mid(f32x4 (&acc)[8][4], int wr, int wc, int fr, int fq) {
#pragma unroll
        for (int m = 0; m < 8; ++m) { const int r = wr * 128 + m * 16 + fr;
            const float f = __builtin_amdgcn_sqrtf((tab[256 + r] + EPS) * __builtin_amdgcn_rcpf(tab[r] + EPS));
#pragma unroll
            for (int n = 0; n < 4; ++n) acc[m][n] *= f;
            SBAR(); }
    }
    __device__ __forceinline__ void fin(f32x4 (&acc)[8][4], int wr, int wc, int fr, int fq) {
        float* x2 = (float*)(ws + WS_X2);
#pragma unroll
        for (int m = 0; m < 8; ++m) { const int r = wr * 128 + m * 16 + fr, row = brow + r; const float rbm = rsqrtf(tab[256 + r] + EPS); f32x4 xv[4];
#pragma unroll
            for (int n = 0; n < 4; ++n) xv[n] = *(const f32x4*)(x + (size_t)row * D_MODEL + pn * 256 + wc * 64 + n * 16 + fq * 4);
#pragma unroll
            for (int n = 0; n < 4; ++n) { const int col = pn * 256 + wc * 64 + n * 16 + fq * 4;
                const f32x4 v = acc[m][n] * rbm + xv[n];
                *(f32x4*)(x2 + (size_t)row * D_MODEL + col) = v; } }
    }
};
struct EpiUp8 {
    int j0, r0, cnt; unsigned char* dst; const float* bias;
    __device__ __forceinline__ void fin(f32x16 (&acc)[4][2], int wr, int wc, int r32, int hi) {
        f32x4 bg[4], bu[4];
#pragma unroll
        for (int rg = 0; rg < 4; ++rg) { const int j = j0 + wc * 32 + 8 * rg + 4 * hi; bg[rg] = *(const f32x4*)(bias + j); bu[rg] = *(const f32x4*)(bias + D_FF + j); }
#pragma unroll
        for (int m = 0; m < 4; ++m) { const int r = wr * 128 + m * 32 + r32; unsigned o8[4];
#pragma unroll
            for (int rg = 0; rg < 4; ++rg) { float o[4];
#pragma unroll
                for (int q = 0; q < 4; ++q) { const float g = fminf(acc[m][0][4 * rg + q] + bg[rg][q], 7.f), u = fminf(fmaxf(acc[m][1][4 * rg + q] + bu[rg][q], -7.f), 7.f);
                    const float sg = __builtin_amdgcn_rcpf(1.f + __builtin_amdgcn_exp2f(-1.702f * LOG2E * g)); o[q] = 4.f * (u + 1.f) * (g * sg); }
                o8[rg] = pk4_fp8(o[0], o[1], o[2], o[3]); }
            if (r0 + r < cnt) {
#pragma unroll
                for (int rg = 0; rg < 4; ++rg) *(unsigned*)(dst + (size_t)r * D_FF + j0 + wc * 32 + 8 * rg + 4 * hi) = o8[rg]; }
        }
    }
};
struct EpiUp8q {
    int j0, r0, cnt; unsigned char* dst; const float* bias;
    __device__ __forceinline__ void fin(f32x16 (&acc)[2][2], int wr, int wc, int r32, int hi) {
        f32x4 bg[4], bu[4];
#pragma unroll
        for (int rg = 0; rg < 4; ++rg) { const int j = j0 + wc * 32 + 8 * rg + 4 * hi; bg[rg] = *(const f32x4*)(bias + j); bu[rg] = *(const f32x4*)(bias + D_FF + j); }
#pragma unroll
        for (int m = 0; m < 2; ++m) { const int r = wr * 64 + m * 32 + r32; unsigned o8[4];
#pragma unroll
            for (int rg = 0; rg < 4; ++rg) { float o[4];
#pragma unroll
                for (int q = 0; q < 4; ++q) { const float g = fminf(acc[m][0][4 * rg + q] + bg[rg][q], 7.f), u = fminf(fmaxf(acc[m][1][4 * rg + q] + bu[rg][q], -7.f), 7.f);
                    const float sg = __builtin_amdgcn_rcpf(1.f + __builtin_amdgcn_exp2f(-1.702f * LOG2E * g)); o[q] = 4.f * (u + 1.f) * (g * sg); }
                o8[rg] = pk4_fp8(o[0], o[1], o[2], o[3]); }
            if (r0 + r < cnt) {
#pragma unroll
                for (int rg = 0; rg < 4; ++rg) *(unsigned*)(dst + (size_t)r * D_FF + j0 + wc * 32 + 8 * rg + 4 * hi) = o8[rg]; }
        }
    }
};
struct EpiDown8 {
    int c0, r0, cnt; bf16_t* dst; const float* bias;
    __device__ __forceinline__ void fin(f32x16 (&acc)[4][2], int wr, int wc, int r32, int hi) {
        f32x4 b[2][4];
#pragma unroll
        for (int n = 0; n < 2; ++n)
#pragma unroll
            for (int rg = 0; rg < 4; ++rg) b[n][rg] = *(const f32x4*)(bias + c0 + wc * 64 + n * 32 + 8 * rg + 4 * hi);
#pragma unroll
        for (int m = 0; m < 4; ++m) { const int r = wr * 128 + m * 32 + r32;
            if (r0 + r < cnt) {
#pragma unroll
                for (int n = 0; n < 2; ++n)
#pragma unroll
                    for (int rg = 0; rg < 4; ++rg) { const int col = c0 + wc * 64 + n * 32 + 8 * rg + 4 * hi;
                        *(u32x2*)(dst + (size_t)r * D_MODEL + col) = (u32x2){pk_bf16(acc[m][n][4 * rg] + b[n][rg][0], acc[m][n][4 * rg + 1] + b[n][rg][1]), pk_bf16(acc[m][n][4 * rg + 2] + b[n][rg][2], acc[m][n][4 * rg + 3] + b[n][rg][3])}; } }
        }
    }
};
struct EpiDown8h {
    int c0, r0, cnt; bf16_t* dst; const float* bias;
    __device__ __forceinline__ void fin(f32x16 (&acc)[4][1], int wr, int wc, int r32, int hi) {
        f32x4 b[1][4];
#pragma unroll
        for (int n = 0; n < 1; ++n)
#pragma unroll
            for (int rg = 0; rg < 4; ++rg) b[n][rg] = *(const f32x4*)(bias + c0 + wc * 32 + n * 32 + 8 * rg + 4 * hi);
#pragma unroll
        for (int m = 0; m < 4; ++m) { const int r = wr * 128 + m * 32 + r32;
            if (r0 + r < cnt) {
#pragma unroll
                for (int n = 0; n < 1; ++n)
#pragma unroll
                    for (int rg = 0; rg < 4; ++rg) { const int col = c0 + wc * 32 + n * 32 + 8 * rg + 4 * hi;
                        *(u32x2*)(dst + (size_t)r * D_MODEL + col) = (u32x2){pk_bf16(acc[m][n][4 * rg] + b[n][rg][0], acc[m][n][4 * rg + 1] + b[n][rg][1]), pk_bf16(acc[m][n][4 * rg + 2] + b[n][rg][2], acc[m][n][4 * rg + 3] + b[n][rg][3])}; } }
        }
    }
};

constexpr int PG_HTB = 128 * 64 * 2;
__host__ __device__ __forceinline__ int pg_lds_byte(int r, int c) { const int st = (r >> 4) * 2 + (c >> 5), rr = r & 15, cc = c & 31, ob = rr * 64 + cc * 2; return st * 1024 + (ob ^ (((ob >> 9) & 1) << 5)); }
__host__ __device__ __forceinline__ void pg_stage_rc(int b, int& R, int& C) { const int st = b / 1024, sb = b % 1024, swz = sb ^ (((sb >> 9) & 1) << 5); R = (st >> 1) * 16 + swz / 64; C = (st & 1) * 32 + (swz % 64) / 2; }
__host__ __device__ __forceinline__ int pg_tcol(int rho) { return (rho & ~0x30) | ((rho & 0x10) << 1) | ((rho & 0x20) >> 1); }
template <bool MID, class EPI>
__device__ __forceinline__ void gemm_unit_pg(LAS char* lds, const bf16_t* A, const bf16_t* Bt, const int K, EPI& E) {
    const int tid = threadIdx.x, wid = __builtin_amdgcn_readfirstlane(tid >> 6), lane = tid & 63, wr = wid >> 2, wc = wid & 3, fr = lane & 15, fq = lane >> 4;
    const int nt = K / 64;
    unsigned voff[2];
#pragma unroll
    for (int i = 0; i < 2; ++i) { int R, C; pg_stage_rc(tid * 16 + i * 8192, R, C); voff[i] = (unsigned)(R * K + C) * 2u; }
    const size_t kstep = (size_t)(64 * 2), hstep = (size_t)128 * K * 2;
    const unsigned ldsw = (unsigned)wid * 1024u;
    const int aoff = pg_lds_byte(wr * 64 + fr, fq * 8), boff = pg_lds_byte(wc * 32 + fr, fq * 8);
#define PG_SA(b, h) (((b) * 2 + (h)) * PG_HTB)
#define PG_SB(b, h) ((4 + (b) * 2 + (h)) * PG_HTB)
#define PG_STAGE(bufoff, gbase) do { _Pragma("unroll") for (int _i = 0; _i < 2; ++_i) \
        __builtin_amdgcn_global_load_lds((const unsigned*)((const char*)(gbase) + voff[_i]), (LAS unsigned*)(lds + (bufoff) + ldsw + _i * 8192), 16, 0, 0); } while (0)
#define PG_LDA(dst, b, h) do { _Pragma("unroll") for (int m = 0; m < 4; ++m) _Pragma("unroll") for (int k = 0; k < 2; ++k) dst[m][k] = *(const LAS bf16x8*)(lds + PG_SA(b, h) + aoff + m * 2048 + k * 1024); } while (0)
#define PG_LDB(dst, b, h) do { _Pragma("unroll") for (int n = 0; n < 2; ++n) _Pragma("unroll") for (int k = 0; k < 2; ++k) dst[n][k] = *(const LAS bf16x8*)(lds + PG_SB(b, h) + boff + n * 2048 + k * 1024); } while (0)
#define PG_MMA(ai, bj, At_, Bt_) do { __builtin_amdgcn_s_setprio(1); _Pragma("unroll") for (int m = 0; m < 4; ++m) _Pragma("unroll") for (int n = 0; n < 2; ++n) _Pragma("unroll") for (int k = 0; k < 2; ++k) \
        acc[ai][bj][m][n] = __builtin_amdgcn_mfma_f32_16x16x32_bf16(Bt_[n][k], At_[m][k], acc[ai][bj][m][n], 0, 0, 0); __builtin_amdgcn_s_setprio(0); } while (0)
#define PG_WAIT_V(n) asm volatile("s_waitcnt vmcnt(" #n ")" ::: "memory")
#define PG_WAIT_L(n) asm volatile("s_waitcnt lgkmcnt(" #n ")" ::: "memory")
#define PG_BAR __builtin_amdgcn_s_barrier()
    f32x4 acc[2][2][4][2];
#pragma unroll
    for (int a = 0; a < 2; ++a)
#pragma unroll
        for (int b = 0; b < 2; ++b)
#pragma unroll
            for (int m = 0; m < 4; ++m)
#pragma unroll
                for (int n = 0; n < 2; ++n) acc[a][b][m][n] = (f32x4){0.f, 0.f, 0.f, 0.f};
    bf16x8 At[4][2], B0[2][2], B1[2][2];
    const char* cA = (const char*)A; const char* cB = (const char*)Bt;
    PG_STAGE(PG_SB(0, 0), cB); PG_STAGE(PG_SA(0, 0), cA); PG_STAGE(PG_SB(0, 1), cB + hstep); PG_STAGE(PG_SA(0, 1), cA + hstep);
    if (wr == 1) PG_BAR;
    PG_WAIT_V(4); PG_BAR;
    PG_STAGE(PG_SB(1, 0), cB + kstep); PG_STAGE(PG_SA(1, 0), cA + kstep); PG_STAGE(PG_SB(1, 1), cB + hstep + kstep);
    PG_WAIT_V(6); PG_BAR;
    for (int t = 0; t < nt; t += 2) {
        const bool last = (t == nt - 2);
        const char* a1 = cA + (size_t)(t + 1) * kstep;
        const char* a2 = cA + (size_t)(t + 2) * kstep; const char* b2 = cB + (size_t)(t + 2) * kstep;
        const char* a3 = a2 + kstep; const char* b3 = b2 + kstep;
        if (MID && t == (nt >> 1)) E.mid(acc, wr, wc, fr, fq);
        PG_LDB(B0, 0, 0); SBAR(); PG_LDA(At, 0, 0); PG_STAGE(PG_SA(1, 1), a1 + hstep);
        PG_WAIT_L(8); PG_BAR; PG_WAIT_L(0); PG_MMA(0, 0, At, B0); PG_BAR; SBAR();
        PG_LDB(B1, 0, 1); if (!last) PG_STAGE(PG_SB(0, 0), b2);
        PG_BAR; PG_WAIT_L(0); PG_MMA(0, 1, At, B1); PG_BAR;
        PG_LDA(At, 0, 1); if (!last) PG_STAGE(PG_SA(0, 0), a2);
        PG_BAR; PG_WAIT_L(0); PG_MMA(1, 0, At, B0); PG_BAR; SBAR();
        if (!last) { PG_STAGE(PG_SB(0, 1), b2 + hstep); PG_WAIT_V(6); } else PG_WAIT_V(0);
        PG_BAR; PG_MMA(1, 1, At, B1); PG_BAR;
        PG_LDB(B0, 1, 0); SBAR(); PG_LDA(At, 1, 0); if (!last) PG_STAGE(PG_SA(0, 1), a2 + hstep);
        PG_WAIT_L(8); PG_BAR; PG_WAIT_L(0); PG_MMA(0, 0, At, B0); PG_BAR; SBAR();
        PG_LDB(B1, 1, 1); if (!last) PG_STAGE(PG_SB(1, 0), b3);
        PG_BAR; PG_WAIT_L(0); PG_MMA(0, 1, At, B1); PG_BAR;
        PG_LDA(At, 1, 1); if (!last) PG_STAGE(PG_SA(1, 0), a3);
        PG_BAR; PG_WAIT_L(0); PG_MMA(1, 0, At, B0); PG_BAR; SBAR();
        if (!last) { PG_STAGE(PG_SB(1, 1), b3 + hstep); PG_WAIT_V(6); }
        PG_BAR; PG_MMA(1, 1, At, B1); PG_BAR;
    }
    E.fin(acc, wr, wc, fr, fq);
    PG_WAIT_V(0);
    if (wr == 0) PG_BAR;
    PG_BAR;
#undef PG_SA
#undef PG_SB
#undef PG_STAGE
#undef PG_LDA
#undef PG_LDB
#undef PG_MMA
#undef PG_WAIT_V
#undef PG_WAIT_L
#undef PG_BAR
}

#define PG_ROW(ai, m) (128 * (ai) + 64 * wr + 16 * (m) + fr)
#define PG_COL(bj, n) (128 * (bj) + 64 * (wc >> 1) + 32 * (n) + 16 * (wc & 1) + 4 * fq)
struct PEpiProj {
    int pn, brow; unsigned char* ws; const float *qg, *kvg;
    __device__ __forceinline__ void mid(f32x4 (&)[2][2][4][2], int, int, int, int) {}
    __device__ __forceinline__ void fin(f32x4 (&acc)[2][2][4][2], int wr, int wc, int fr, int fq) {
        if (pn < 6) {
            bf16_t* dst; int ldd, c0;
            if (pn < 4) { dst = (bf16_t*)(ws + WS_QA); ldd = 1024; c0 = pn * 256; } else if (pn == 4) { dst = (bf16_t*)(ws + WS_KA); ldd = 256; c0 = 0; } else { dst = (bf16_t*)(ws + WS_VA); ldd = 256; c0 = 0; }
#pragma unroll
            for (int ai = 0; ai < 2; ++ai)
#pragma unroll
                for (int m = 0; m < 4; ++m) { bf16_t* rowp = dst + (size_t)(brow + PG_ROW(ai, m)) * ldd + c0;
#pragma unroll
                    for (int bj = 0; bj < 2; ++bj)
#pragma unroll
                        for (int n = 0; n < 2; ++n) { const f32x4 v = acc[ai][bj][m][n]; *(u32x2*)(rowp + PG_COL(bj, n)) = (u32x2){pk_bf16(v[0], v[1]), pk_bf16(v[2], v[3])}; } }
        } else if (pn < 9) {
            bf16_t* dst; int ldd, c0; const float* g; float* ssq; int nsl, sl0;
            if (pn < 8) { dst = (bf16_t*)(ws + WS_CQ); ldd = 512; c0 = (pn - 6) * 256; g = qg; ssq = (float*)(ws + WS_SSQC); nsl = 16; sl0 = (pn - 6) * 8 + wc; }
            else { dst = (bf16_t*)(ws + WS_CKV); ldd = 256; c0 = 0; g = kvg; ssq = (float*)(ws + WS_SSQK); nsl = 8; sl0 = wc; }
            f32x4 gvv[2][2];
#pragma unroll
            for (int bj = 0; bj < 2; ++bj)
#pragma unroll
                for (int n = 0; n < 2; ++n) gvv[bj][n] = *(const f32x4*)(g + c0 + PG_COL(bj, n));
#pragma unroll
            for (int ai = 0; ai < 2; ++ai)
#pragma unroll
                for (int m = 0; m < 4; ++m) { const int row = brow + PG_ROW(ai, m);
#pragma unroll
                    for (int bj = 0; bj < 2; ++bj) { float ss = 0.f;
#pragma unroll
                        for (int n = 0; n < 2; ++n) { const f32x4 v = acc[ai][bj][m][n]; const f32x4 gv = gvv[bj][n];
                            ss += v[0] * v[0] + v[1] * v[1] + v[2] * v[2] + v[3] * v[3];
                            *(u32x2*)(dst + (size_t)row * ldd + c0 + PG_COL(bj, n)) = (u32x2){pk_bf16(v[0] * gv[0], v[1] * gv[1]), pk_bf16(v[2] * gv[2], v[3] * gv[3])}; }
                        ss += __shfl_xor(ss, 16, 64); ss += __shfl_xor(ss, 32, 64);
                        if (fq == 0) ssq[(size_t)row * nsl + sl0 + 4 * bj] = ss; } }
        } else {
            if (wc < 2) {
                bf16_t* dst = (bf16_t*)(ws + WS_KPE); const float* rope = (const float*)(ws + WS_ROPE); const int i0 = 16 * wc + 4 * fq;
#pragma unroll
                for (int ai = 0; ai < 2; ++ai)
#pragma unroll
                    for (int m = 0; m < 4; ++m) { const int row = brow + PG_ROW(ai, m); const int pos = row & (SEQ - 1); const f32x4 x1 = acc[ai][0][m][0], x2 = acc[ai][0][m][1];
                        const f32x4 cs0 = *(const f32x4*)(rope + ((size_t)pos * 32 + i0) * 2), cs1 = *(const f32x4*)(rope + ((size_t)pos * 32 + i0) * 2 + 4);
                        const float c[4] = {cs0[0], cs0[2], cs1[0], cs1[2]}, s[4] = {cs0[1], cs0[3], cs1[1], cs1[3]};
                        float o1[4], o2[4];
#pragma unroll
                        for (int j = 0; j < 4; ++j) { o1[j] = x1[j] * c[j] - x2[j] * s[j]; o2[j] = x1[j] * s[j] + x2[j] * c[j]; }
                        *(u32x2*)(dst + (size_t)row * 64 + i0) = (u32x2){pk_bf16(o1[0], o1[1]), pk_bf16(o1[2], o1[3])};
                        *(u32x2*)(dst + (size_t)row * 64 + 32 + i0) = (u32x2){pk_bf16(o2[0], o2[1]), pk_bf16(o2[2], o2[3])}; }
            }
        }
    }
};
struct PEpiQUp {
    int pn, brow; unsigned char* ws;
    __device__ __forceinline__ void mid(f32x4 (&)[2][2][4][2], int, int, int, int) {}
    __device__ __forceinline__ void fin(f32x4 (&acc)[2][2][4][2], int wr, int wc, int fr, int fq) {
        bf16_t* dst = (bf16_t*)(ws + WS_QB); const float* rope = (const float*)(ws + WS_ROPE);
        float rs[2][4];
#pragma unroll
        for (int ai = 0; ai < 2; ++ai)
#pragma unroll
            for (int m = 0; m < 4; ++m) { const f32x4* pp = (const f32x4*)((const float*)(ws + WS_SSQC) + (size_t)(brow + PG_ROW(ai, m)) * 16); const f32x4 p0 = pp[0], p1 = pp[1], p2 = pp[2], p3 = pp[3];
                const float sq = (((p0[0] + p0[1]) + (p0[2] + p0[3])) + ((p1[0] + p1[1]) + (p1[2] + p1[3]))) + (((p2[0] + p2[1]) + (p2[2] + p2[3])) + ((p3[0] + p3[1]) + (p3[2] + p3[3])));
                rs[ai][m] = rsqrtf(sq * (1.f / 512.f) + EPS); }
#pragma unroll
        for (int bj = 0; bj < 2; ++bj) { const int seg = pn * 4 + 2 * bj + (wc >> 1), head = seg / 3, part = seg - head * 3; const int i0 = 16 * (wc & 1) + 4 * fq;
#pragma unroll
            for (int ai = 0; ai < 2; ++ai)
#pragma unroll
                for (int m = 0; m < 4; ++m) { const int row = brow + PG_ROW(ai, m); const float r = rs[ai][m]; bf16_t* drow = dst + (size_t)row * 1536 + head * 192 + part * 64;
                    const f32x4 x1 = acc[ai][bj][m][0], x2 = acc[ai][bj][m][1];
                    if (part < 2) {
                        *(u32x2*)(drow + i0) = (u32x2){pk_bf16(x1[0] * r, x1[1] * r), pk_bf16(x1[2] * r, x1[3] * r)};
                        *(u32x2*)(drow + 32 + i0) = (u32x2){pk_bf16(x2[0] * r, x2[1] * r), pk_bf16(x2[2] * r, x2[3] * r)};
                    } else { const int pos = row & (SEQ - 1);
                        const f32x4 cs0 = *(const f32x4*)(rope + ((size_t)pos * 32 + i0) * 2), cs1 = *(const f32x4*)(rope + ((size_t)pos * 32 + i0) * 2 + 4);
                        const float c[4] = {cs0[0], cs0[2], cs1[0], cs1[2]}, s[4] = {cs0[1], cs0[3], cs1[1], cs1[3]};
                        float o1[4], o2[4];
#pragma unroll
                        for (int j = 0; j < 4; ++j) { o1[j] = (x1[j] * c[j] - x2[j] * s[j]) * r; o2[j] = (x1[j] * s[j] + x2[j] * c[j]) * r; }
                        *(u32x2*)(drow + i0) = (u32x2){pk_bf16(o1[0], o1[1]), pk_bf16(o1[2], o1[3])};
                        *(u32x2*)(drow + 32 + i0) = (u32x2){pk_bf16(o2[0], o2[1]), pk_bf16(o2[2], o2[3])}; } } }
    }
};
struct PEpiKvUp {
    int pn, brow; unsigned char* ws;
    __device__ __forceinline__ void mid(f32x4 (&)[2][2][4][2], int, int, int, int) {}
    __device__ __forceinline__ void fin(f32x4 (&acc)[2][2][4][2], int wr, int wc, int fr, int fq) {
        bf16_t* dst = (bf16_t*)(ws + WS_KVB);
#pragma unroll
        for (int ai = 0; ai < 2; ++ai)
#pragma unroll
            for (int m = 0; m < 4; ++m) { const int row = brow + PG_ROW(ai, m); const f32x4* pp = (const f32x4*)((const float*)(ws + WS_SSQK) + (size_t)row * 8); const f32x4 p0 = pp[0], p1 = pp[1];
                const float r = rsqrtf((((p0[0] + p0[1]) + (p0[2] + p0[3])) + ((p1[0] + p1[1]) + (p1[2] + p1[3]))) * (1.f / 256.f) + EPS);
#pragma unroll
                for (int bj = 0; bj < 2; ++bj)
#pragma unroll
                    for (int n = 0; n < 2; ++n) { const f32x4 v = acc[ai][bj][m][n];
                        *(u32x2*)(dst + (size_t)row * 2048 + pn * 256 + PG_COL(bj, n)) = (u32x2){pk_bf16(v[0] * r, v[1] * r), pk_bf16(v[2] * r, v[3] * r)}; } }
    }
};
struct PEpiWo {
    int pn, brow; unsigned char* ws; const float* x; const LAS float* tab;
    __device__ __forceinline__ void mid(f32x4 (&acc)[2][2][4][2], int wr, int wc, int fr, int fq) {
#pragma unroll
        for (int ai = 0; ai < 2; ++ai)
#pragma unroll
            for (int m = 0; m < 4; ++m) { const int r = PG_ROW(ai, m);
                const float f = __builtin_amdgcn_sqrtf((tab[256 + r] + EPS) * __builtin_amdgcn_rcpf(tab[r] + EPS));
#pragma unroll
                for (int bj = 0; bj < 2; ++bj)
#pragma unroll
                    for (int n = 0; n < 2; ++n) acc[ai][bj][m][n] *= f; }
        asm volatile("s_waitcnt lgkmcnt(0)" ::: "memory"); SBAR();
    }
    __device__ __forceinline__ void fin(f32x4 (&acc)[2][2][4][2], int wr, int wc, int fr, int fq) {
        float* x2 = (float*)(ws + WS_X2);
#pragma unroll
        for (int ai = 0; ai < 2; ++ai)
#pragma unroll
            for (int m = 0; m < 4; ++m) { const int r = PG_ROW(ai, m); const size_t o = (size_t)(brow + r) * D_MODEL + pn * 256; const float rbm = rsqrtf(tab[256 + r] + EPS); f32x4 xv[2][2];
#pragma unroll
                for (int bj = 0; bj < 2; ++bj)
#pragma unroll
                    for (int n = 0; n < 2; ++n) xv[bj][n] = *(const f32x4*)(x + o + PG_COL(bj, n));
#pragma unroll
                for (int bj = 0; bj < 2; ++bj)
#pragma unroll
                    for (int n = 0; n < 2; ++n) *(f32x4*)(x2 + o + PG_COL(bj, n)) = acc[ai][bj][m][n] * rbm + xv[bj][n]; }
    }
};
__device__ __forceinline__ void pg_convert(const float* W, int K, int ld, int ncols, int nrows, bf16_t* Bt, int item0, int nitems_stride) {
    const int total = nrows * (K >> 3);
    for (int it0 = item0; it0 < total; it0 += 4 * nitems_stride) { float v[4][8]; int row[4], k0[4]; bool ok[4];
#pragma unroll
        for (int b = 0; b < 4; ++b) { const int it = it0 + b * nitems_stride; const int itc = it < total ? it : item0; const int kc = itc / nrows; row[b] = itc - kc * nrows; k0[b] = kc << 3; ok[b] = it < total;
            const int col = (row[b] & ~255) + pg_tcol(row[b] & 255); const int colc = col < ncols ? col : 0; const float s = col < ncols ? 1.f : 0.f;
#pragma unroll
            for (int q = 0; q < 8; ++q) v[b][q] = W[(size_t)(k0[b] + q) * ld + colc] * s; }
#pragma unroll
        for (int b = 0; b < 4; ++b) if (ok[b])
            *(u32x4*)(Bt + (size_t)row[b] * K + k0[b]) = (u32x4){pk_bf16(v[b][0], v[b][1]), pk_bf16(v[b][2], v[b][3]), pk_bf16(v[b][4], v[b][5]), pk_bf16(v[b][6], v[b][7])}; }
}
__device__ __forceinline__ void sincos_d(double x, double& s, double& c) {
    const double k = __builtin_rint(x * 0.63661977236758134308);
    double r = __builtin_fma(-k, 1.57079632679489655800e+00, x); r = __builtin_fma(-k, 6.12323399573676603587e-17, r);
    const double r2 = r * r;
    double sp = -7.6471637318198164759e-13; sp = sp * r2 + 1.6059043836821614599e-10; sp = sp * r2 - 2.5052108385441718775e-08; sp = sp * r2 + 2.7557319223985890653e-06;
    sp = sp * r2 - 1.9841269841269841270e-04; sp = sp * r2 + 8.3333333333333333333e-03; sp = sp * r2 - 1.6666666666666666667e-01; const double sn = r + r * r2 * sp;
    double cp = 4.7794773323873852974e-14; cp = cp * r2 - 1.1470745597729724714e-11; cp = cp * r2 + 2.0876756987868098979e-09; cp = cp * r2 - 2.7557319223985890653e-07;
    cp = cp * r2 + 2.4801587301587301587e-05; cp = cp * r2 - 1.3888888888888888889e-03; cp = cp * r2 + 4.1666666666666666667e-02; cp = cp * r2 - 0.5; const double cn = 1.0 + r2 * cp;
    const int q = ((int)k) & 3;
    s = (q == 0) ? sn : (q == 1) ? cn : (q == 2) ? -sn : -cn;
    c = (q == 0) ? cn : (q == 1) ? -sn : (q == 2) ? -cn : sn;
}

__device__ __forceinline__ void phase_prologue(const Params& p) {
    const int tid = threadIdx.x, wid = tid >> 6, lane = tid & 63;
    bf16_t* xn = (bf16_t*)(p.ws + WS_XN);
    for (int row = blockIdx.x * 8 + wid; row < NTOK; row += gridDim.x * 8) {
        const f32x4* xr = (const f32x4*)(p.x + (size_t)row * D_MODEL); f32x4 v[8]; float ss = 0.f;
#pragma unroll
        for (int i = 0; i < 8; ++i) { v[i] = xr[lane + 64 * i]; ss += v[i][0] * v[i][0] + v[i][1] * v[i][1] + v[i][2] * v[i][2] + v[i][3] * v[i][3]; }
        ss = wave_sum(ss); const float rs = rsqrtf(ss * (1.f / D_MODEL) + EPS);
#pragma unroll
        for (int i = 0; i < 8; ++i) { const f32x4 g = ((const f32x4*)p.attn_norm)[lane + 64 * i];
            *(u32x2*)(xn + (size_t)row * D_MODEL + 4 * (lane + 64 * i)) = (u32x2){pk_bf16(v[i][0] * rs * g[0], v[i][1] * rs * g[1]), pk_bf16(v[i][2] * rs * g[2], v[i][3] * rs * g[3])}; }
    }
    const int gtid = blockIdx.x * 512 + tid;
    if (gtid < SEQ * 32) {
        const int pos = gtid >> 5, i = gtid & 31;
        double b = 10000.0; for (int q = 0; q < 5; ++q) b = __builtin_sqrt(b);
        double f = 1.0; for (int q = 0; q < i; ++q) f *= b;
        const float inv_freq = (float)(1.0 / f); const float ang = (float)pos * inv_freq;
        double s, c; sincos_d((double)ang, s, c);
        float* rope = (float*)(p.ws + WS_ROPE); rope[(size_t)gtid * 2] = (float)c; rope[(size_t)gtid * 2 + 1] = (float)s;
    }
    {
        const int nth = gridDim.x * 512;
        pg_convert(p.w_in, D_MODEL, IN_COLS, IN_COLS, 2560, (bf16_t*)(p.ws + WS_BT_IN), gtid, nth);
        pg_convert(p.b_w_uq, 512, 1536, 1536, 1536, (bf16_t*)(p.ws + WS_BT_UQ), gtid, nth);
    }
    if (gtid < N_EXP * D_MODEL) {
        ((float*)(p.ws + WS_WRT))[gtid] = p.w_router[gtid] * p.mlp_norm[gtid >> 5];
    }
}

constexpr int AA_PITCH = 144;
constexpr int AA_K = 0, AA_V = 384 * AA_PITCH;
constexpr int AA_WS = 2 * 384 * AA_PITCH;
__device__ __forceinline__ void attn_a_unit(const Params& p, LAS char* lds, int u) {
    const int tid = threadIdx.x, wid = __builtin_amdgcn_readfirstlane(tid >> 6), lane = tid & 63, r32 = lane & 31, hi = lane >> 5;
    const int b = u >> 7, nq = (u >> 2) & 31, kvh = u & 3;
    const bf16_t* QA = (const bf16_t*)(p.ws + WS_QA); const bf16_t* KA = (const bf16_t*)(p.ws + WS_KA); const bf16_t* VA = (const bf16_t*)(p.ws + WS_VA);
    const int P0 = (nq - 1) * 128;
    __syncthreads();
    for (int c = tid; c < 384 * 8; c += 512) { const int r = c >> 3, ch = c & 7; const int pos = P0 + r;
        i32x4 kv = {0, 0, 0, 0}, vv = {0, 0, 0, 0};
        if (pos >= 0 && pos < SEQ) { const size_t g = ((size_t)(b * SEQ + pos)) * 256 + kvh * 64 + ch * 8; kv = *(const i32x4*)(KA + g); vv = *(const i32x4*)(VA + g); }
        *(LAS i32x4*)(lds + AA_K + r * AA_PITCH + ch * 16) = kv; *(LAS i32x4*)(lds + AA_V + r * AA_PITCH + ch * 16) = vv; }
    __syncthreads();
    LAS float* wsf = (LAS float*)(lds + AA_WS) + wid * 64;
    const int hq = kvh * 4 + (wid >> 1);
    const float slope2 = __builtin_amdgcn_exp2f(-8.f * (float)(hq + 1) / 16.f) * LOG2E;
    const float sink2 = p.a_sink[hq] * LOG2E;
    const float C = 0.125f * LOG2E;
    const float* ga = p.out_norm_a + hq * 64;
    bf16_t* Y = (bf16_t*)(p.ws + WS_Y); float* ssqa = (float*)(p.ws + WS_SSQP);
    for (int blk = 0; blk < 2; ++blk) {
        const int q0 = nq * 128 + (wid & 1) * 64 + blk * 32;
        const int tq = q0 + r32;
        bf16x8 qr[4];
        { const bf16_t* qp = QA + ((size_t)(b * SEQ + tq)) * 1024 + hq * 64 + hi * 8;
#pragma unroll
          for (int d0 = 0; d0 < 4; ++d0) qr[d0] = *(const bf16x8*)(qp + d0 * 16); }
        float m_reg = sink2, l_reg = 1.f; f32x16 o[2] = {};
        for (int jt = 0; jt < 6; ++jt) {
            const int kp0 = P0 + jt * 64;
            if (kp0 + 63 < q0 - 128 || kp0 > q0 + 31 + 128 || kp0 + 63 < 0 || kp0 >= SEQ) continue;
            f32x16 p0 = {}, p1 = {};
#pragma unroll
            for (int d0 = 0; d0 < 4; ++d0) {
                const bf16x8 k0 = *(const LAS bf16x8*)(lds + AA_K + (jt * 64 + r32) * AA_PITCH + (d0 * 16 + hi * 8) * 2);
                const bf16x8 k1 = *(const LAS bf16x8*)(lds + AA_K + (jt * 64 + 32 + r32) * AA_PITCH + (d0 * 16 + hi * 8) * 2);
                p0 = __builtin_amdgcn_mfma_f32_32x32x16_bf16(k0, qr[d0], p0, 0, 0, 0);
                p1 = __builtin_amdgcn_mfma_f32_32x32x16_bf16(k1, qr[d0], p1, 0, 0, 0);
            }
            float pmax = -1e30f;
#pragma unroll
            for (int r = 0; r < 16; ++r) {
                { const int kp = kp0 + crow(r, hi); const int dist = tq > kp ? tq - kp : kp - tq; const bool ok = dist <= 128 && kp >= 0 && kp < SEQ;
                  p0[r] = ok ? p0[r] * C - slope2 * (float)dist : -1e30f; pmax = fmaxf(pmax, p0[r]); }
                { const int kp = kp0 + 32 + crow(r, hi); const int dist = tq > kp ? tq - kp : kp - tq; const bool ok = dist <= 128 && kp >= 0 && kp < SEQ;
                  p1[r] = ok ? p1[r] * C - slope2 * (float)dist : -1e30f; pmax = fmaxf(pmax, p1[r]); }
            }
            { auto rr = __builtin_amdgcn_permlane32_swap(__float_as_uint(pmax), __float_as_uint(pmax), false, false); pmax = fmaxf(__uint_as_float(rr[0]), __uint_as_float(rr[1])); }
            const float mn = fmaxf(m_reg, pmax); const float alpha = __builtin_amdgcn_exp2f(m_reg - mn); m_reg = mn;
            float ps = 0.f;
#pragma unroll
            for (int r = 0; r < 16; ++r) { p0[r] = __builtin_amdgcn_exp2f(p0[r] - mn); p1[r] = __builtin_amdgcn_exp2f(p1[r] - mn); ps += p0[r] + p1[r]; }
            { auto rr = __builtin_amdgcn_permlane32_swap(__float_as_uint(ps), __float_as_uint(ps), false, false); ps = __uint_as_float(rr[0]) + __uint_as_float(rr[1]); }
            l_reg = l_reg * alpha + ps;
            if (hi == 0) wsf[r32] = alpha;
            WAIT_L0();
#pragma unroll
            for (int r = 0; r < 16; ++r) { const float a = wsf[crow(r, hi)]; o[0][r] *= a; o[1][r] *= a; }
            bf16x8 pa[4];
#define PK4(P, BASE, OUT) do { unsigned a0 = pk_bf16(P[BASE + 0], P[BASE + 1]), a1 = pk_bf16(P[BASE + 2], P[BASE + 3]); \
    unsigned b0 = pk_bf16(P[BASE + 4], P[BASE + 5]), b1 = pk_bf16(P[BASE + 6], P[BASE + 7]); \
    auto r0_ = __builtin_amdgcn_permlane32_swap(a0, b0, false, false); auto r1_ = __builtin_amdgcn_permlane32_swap(a1, b1, false, false); \
    u32x4 w_ = {r0_[0], r1_[0], r0_[1], r1_[1]}; OUT = __builtin_bit_cast(bf16x8, w_); } while (0)
            PK4(p0, 0, pa[0]); PK4(p0, 8, pa[1]); PK4(p1, 0, pa[2]); PK4(p1, 8, pa[3]);
            const int g16 = (lane >> 4) & 1, qq = (lane & 15) >> 2, pp = lane & 3;
#pragma unroll
            for (int db = 0; db < 2; ++db) {
#pragma unroll
                for (int ks = 0; ks < 4; ++ks) {
                    const LAS char* vp = lds + AA_V + (jt * 64 + ks * 16 + 8 * hi + qq) * AA_PITCH + (db * 32 + 16 * g16 + 4 * pp) * 2;
                    const s16x4 lo = vtr(vp), hh = vtr(vp + 4 * AA_PITCH);
                    const bf16x8 vb = (bf16x8){lo[0], lo[1], lo[2], lo[3], hh[0], hh[1], hh[2], hh[3]};
                    o[db] = __builtin_amdgcn_mfma_f32_32x32x16_bf16(pa[ks], vb, o[db], 0, 0, 0);
                }
            }
            WAIT_L0();
        }
        if (hi == 0) wsf[r32] = 1.f / l_reg;
        WAIT_L0();
        const float g0 = ga[r32], g1 = ga[32 + r32];
#pragma unroll
        for (int r = 0; r < 16; ++r) { const int qrow = crow(r, hi); const float il = wsf[qrow]; const float v0 = o[0][r] * il, v1 = o[1][r] * il;
            const size_t tok = (size_t)(b * SEQ + q0 + qrow);
            bf16_t* yp = Y + tok * 2048 + hq * 64;
            yp[r32] = (bf16_t)(pk_bf16(v0 * g0, 0.f) & 0xffffu); yp[32 + r32] = (bf16_t)(pk_bf16(v1 * g1, 0.f) & 0xffffu);
            float ss = v0 * v0 + v1 * v1;
#pragma unroll
            for (int s = 16; s >= 1; s >>= 1) ss += __shfl_xor(ss, s, 64);
            if (r32 == 0) ssqa[tok * 24 + hq] = ss; }
        WAIT_L0();
    }
}

constexpr int MB_V = 0, MB_KN = 32768, MB_KP = 65536, MB_WS = 81920, MB_QP = 83968;
#define KSWZ(row, colB) ((row) * 256 + ((colB) ^ (((row) & 7) << 4)))
#define KPSWZ(row, colB) ((row) * 128 + ((colB) ^ (((row) & 7) << 4)))
constexpr float MLA_SCALE = 0.07216878364870322f;
constexpr float MLA_THR = 8.f;
__device__ __forceinline__ void mla_partialSM(f32x16& p0, f32x16& p1, float& m_reg, float& mn, float& alpha) {
    constexpr float C = MLA_SCALE * LOG2E;
    float pmax = p0[0];
#pragma unroll
    for (int r = 1; r < 16; ++r) pmax = fmaxf(pmax, p0[r]);
#pragma unroll
    for (int r = 0; r < 16; ++r) pmax = fmaxf(pmax, p1[r]);
    { auto rr = __builtin_amdgcn_permlane32_swap(__float_as_uint(pmax), __float_as_uint(pmax), false, false); pmax = fmaxf(__uint_as_float(rr[0]), __uint_as_float(rr[1])); }
    if (__builtin_expect(__all(pmax - m_reg <= MLA_THR / MLA_SCALE), 1)) { mn = m_reg; alpha = 1.f; }
    else { mn = fmaxf(m_reg, pmax); alpha = __builtin_amdgcn_exp2f((m_reg - mn) * C); m_reg = mn; }
    const float mnC = -mn * C;
#pragma unroll
    for (int r = 0; r < 16; ++r) p0[r] = fmaf(p0[r], C, mnC);
#pragma unroll
    for (int r = 0; r < 16; ++r) p1[r] = fmaf(p1[r], C, mnC);
#pragma unroll
    for (int r = 0; r < 16; ++r) p0[r] = __builtin_amdgcn_exp2f(p0[r]);
}
__device__ __forceinline__ void mla_finishSM(f32x16& p0, f32x16& p1, float alpha, float& l_reg, bf16x8& pa0, bf16x8& pa1, bf16x8& pa2, bf16x8& pa3) {
#pragma unroll
    for (int r = 0; r < 16; ++r) p1[r] = __builtin_amdgcn_exp2f(p1[r]);
    float ps = 0;
#pragma unroll
    for (int r = 0; r < 16; ++r) ps += p0[r];
#pragma unroll
    for (int r = 0; r < 16; ++r) ps += p1[r];
    { auto rr = __builtin_amdgcn_permlane32_swap(__float_as_uint(ps), __float_as_uint(ps), false, false); ps = __uint_as_float(rr[0]) + __uint_as_float(rr[1]); }
    l_reg = l_reg * alpha + ps;
    PK4(p0, 0, pa0); PK4(p0, 8, pa1); PK4(p1, 0, pa2); PK4(p1, 8, pa3);
}
__device__ __forceinline__ void mla_qkt(f32x16& p0, f32x16& p1, const LAS char* Kn, const LAS char* Kp, const bf16x8* qr, const LAS char* qp, int r32, int hi) {
    p0 = f32x16{}; p1 = f32x16{};
#pragma unroll
    for (int d0 = 0; d0 < 8; ++d0) { const int cb = (d0 * 16 + hi * 8) * 2;
        const bf16x8 b0 = *(const LAS bf16x8*)(Kn + KSWZ(r32, cb)); const bf16x8 b1 = *(const LAS bf16x8*)(Kn + KSWZ(32 + r32, cb));
        p0 = __builtin_amdgcn_mfma_f32_32x32x16_bf16(b0, qr[d0], p0, 0, 0, 0); p1 = __builtin_amdgcn_mfma_f32_32x32x16_bf16(b1, qr[d0], p1, 0, 0, 0); }
#pragma unroll
    for (int d0 = 0; d0 < 4; ++d0) { const int cb = (d0 * 16 + hi * 8) * 2;
        const bf16x8 b0 = *(const LAS bf16x8*)(Kp + KPSWZ(r32, cb)); const bf16x8 b1 = *(const LAS bf16x8*)(Kp + KPSWZ(32 + r32, cb));
        const bf16x8 q = *(const LAS bf16x8*)(qp + d0 * 1024);
        p0 = __builtin_amdgcn_mfma_f32_32x32x16_bf16(b0, q, p0, 0, 0, 0); p1 = __builtin_amdgcn_mfma_f32_32x32x16_bf16(b1, q, p1, 0, 0, 0); }
}
__device__ __forceinline__ int v_st(int k, int c) { const int kk = (k & ~0xC) | ((k & 4) << 1) | ((k & 8) >> 1); return ((kk >> 3) * 4 + (c >> 5)) * 512 + ((kk & 7) * 32 + (c & 31)) * 2; }
__device__ __forceinline__ int v_rd_base(int lane) { return ((lane & 3) << 3) | (((lane >> 2) & 3) << 6) | (((lane >> 4) & 1) << 5) | (((lane >> 5) & 1) << 8); }
constexpr int v_rd_off(int d0, int ks, int half) { return d0 * 512 + ks * 4096 + half * 2048; }
template <int D0> __device__ __forceinline__ void mla_pv_one(f32x16& od, const LAS char* vb, bf16x8 pa0, bf16x8 pa1, bf16x8 pa2, bf16x8 pa3) {
    const s16x4 l0 = vtr(vb + v_rd_off(D0, 0, 0)), h0 = vtr(vb + v_rd_off(D0, 0, 1)), l1 = vtr(vb + v_rd_off(D0, 1, 0)), h1 = vtr(vb + v_rd_off(D0, 1, 1));
    const s16x4 l2 = vtr(vb + v_rd_off(D0, 2, 0)), h2 = vtr(vb + v_rd_off(D0, 2, 1)), l3 = vtr(vb + v_rd_off(D0, 3, 0)), h3 = vtr(vb + v_rd_off(D0, 3, 1));
#define PKV(L, H) (bf16x8){L[0], L[1], L[2], L[3], H[0], H[1], H[2], H[3]}
    od = __builtin_amdgcn_mfma_f32_32x32x16_bf16(pa0, PKV(l0, h0), od, 0, 0, 0);
    od = __builtin_amdgcn_mfma_f32_32x32x16_bf16(pa1, PKV(l1, h1), od, 0, 0, 0);
    od = __builtin_amdgcn_mfma_f32_32x32x16_bf16(pa2, PKV(l2, h2), od, 0, 0, 0);
    od = __builtin_amdgcn_mfma_f32_32x32x16_bf16(pa3, PKV(l3, h3), od, 0, 0, 0);
#undef PKV
}
__device__ __forceinline__ void mla_pv(f32x16* o, const LAS char* vb, bf16x8 pa0, bf16x8 pa1, bf16x8 pa2, bf16x8 pa3) {
    mla_pv_one<0>(o[0], vb, pa0, pa1, pa2, pa3); mla_pv_one<1>(o[1], vb, pa0, pa1, pa2, pa3); mla_pv_one<2>(o[2], vb, pa0, pa1, pa2, pa3); mla_pv_one<3>(o[3], vb, pa0, pa1, pa2, pa3);
}
__device__ __forceinline__ void mla_unit(const Params& p, LAS char* lds, int u) {
    const int tid = threadIdx.x, wid = __builtin_amdgcn_readfirstlane(tid >> 6), lane = tid & 63, r32 = lane & 31, hi = lane >> 5;
    const int bh = u >> 4, qb = u & 15, b = bh >> 3, h = bh & 7;
    const bf16_t* QB = (const bf16_t*)(p.ws + WS_QB); const bf16_t* KVB = (const bf16_t*)(p.ws + WS_KVB); const bf16_t* KPE = (const bf16_t*)(p.ws + WS_KPE);
    const bf16_t* Kh = KVB + (size_t)b * SEQ * 2048 + h * 256;
    const bf16_t* Ph = KPE + (size_t)b * SEQ * 64;
    LAS float* wsf = (LAS float*)(lds + MB_WS) + wid * 64; LAS float* li_l = wsf; LAS float* al_l = wsf + 32;
    float m_reg = -1e30f, l_reg = 0; f32x16 o[4] = {}; bf16x8 qr[8];
    LAS char* qp = lds + MB_QP + wid * 4096 + lane * 16;
    { const bf16_t* Qw = QB + ((size_t)(b * SEQ + qb * 256 + wid * 32 + r32)) * 1536 + h * 192 + hi * 8;
#pragma unroll
      for (int d0 = 0; d0 < 8; ++d0) qr[d0] = *(const bf16x8*)(Qw + d0 * 16);
      __syncthreads();
#pragma unroll
      for (int d0 = 0; d0 < 4; ++d0) *(LAS bf16x8*)(qp + d0 * 1024) = *(const bf16x8*)(Qw + (8 + d0) * 16); }
    const int sr = tid >> 4, sc = (tid & 15) * 8, vst0 = v_st(sr, sc), vst1 = v_st(32 + sr, sc);
    const int pr = tid >> 3, pc = (tid & 7) * 8;
    const LAS char* vb0 = lds + MB_V + v_rd_base(lane);
    bf16x8 vs0, vs1, ks0, ks1, kp0;
#define SLOAD(k0) do { vs0 = *(const bf16x8*)(Kh + (size_t)((k0) + sr) * 2048 + 128 + sc); vs1 = *(const bf16x8*)(Kh + (size_t)((k0) + 32 + sr) * 2048 + 128 + sc); \
    ks0 = *(const bf16x8*)(Kh + (size_t)((k0) + sr) * 2048 + sc); ks1 = *(const bf16x8*)(Kh + (size_t)((k0) + 32 + sr) * 2048 + sc); \
    kp0 = *(const bf16x8*)(Ph + (size_t)((k0) + pr) * 64 + pc); } while (0)
#define SWRITE(bb) do { *(LAS bf16x8*)(lds + MB_V + (bb) * 16384 + vst0) = vs0; *(LAS bf16x8*)(lds + MB_V + (bb) * 16384 + vst1) = vs1; \
    *(LAS bf16x8*)(lds + MB_KN + (bb) * 16384 + KSWZ(sr, sc * 2)) = ks0; *(LAS bf16x8*)(lds + MB_KN + (bb) * 16384 + KSWZ(32 + sr, sc * 2)) = ks1; \
    *(LAS bf16x8*)(lds + MB_KP + (bb) * 8192 + KPSWZ(pr, pc * 2)) = kp0; } while (0)
#define RESC(a) do { if (__any((a) < 1.f)) { if (hi == 0) al_l[r32] = (a); WAIT_L0(); \
    _Pragma("unroll") for (int d = 0; d < 4; ++d) _Pragma("unroll") for (int r = 0; r < 16; ++r) o[d][r] *= al_l[crow(r, hi)]; } } while (0)
    f32x16 pA0, pA1, pB0, pB1; float mnA, mnB, alA, alB; bf16x8 pa0, pa1, pa2, pa3; constexpr int NT = SEQ / 64;
    SLOAD(0); SWRITE(0); __syncthreads();
    mla_qkt(pA0, pA1, lds + MB_KN, lds + MB_KP, qr, qp, r32, hi); mla_partialSM(pA0, pA1, m_reg, mnA, alA);
    SLOAD(64); SWRITE(1); __syncthreads();
    for (int j = 1; j + 1 < NT; j += 2) {
        SBAR(); mla_qkt(pB0, pB1, lds + MB_KN + 16384, lds + MB_KP + 8192, qr, qp, r32, hi);
        mla_finishSM(pA0, pA1, alA, l_reg, pa0, pa1, pa2, pa3); SBAR();
        SLOAD((j + 1) * 64); SBAR();
        mla_pv(o, vb0, pa0, pa1, pa2, pa3); mla_partialSM(pB0, pB1, m_reg, mnB, alB);
        __syncthreads(); SWRITE(0);
        RESC(alB); __syncthreads();
        SBAR(); mla_qkt(pA0, pA1, lds + MB_KN, lds + MB_KP, qr, qp, r32, hi);
        mla_finishSM(pB0, pB1, alB, l_reg, pa0, pa1, pa2, pa3); SBAR();
        SLOAD((j + 2) * 64); SBAR();
        mla_pv(o, vb0 + 16384, pa0, pa1, pa2, pa3); mla_partialSM(pA0, pA1, m_reg, mnA, alA);
        __syncthreads(); SWRITE(1);
        RESC(alA); __syncthreads();
    }
    SBAR(); mla_qkt(pB0, pB1, lds + MB_KN + 16384, lds + MB_KP + 8192, qr, qp, r32, hi);
    mla_finishSM(pA0, pA1, alA, l_reg, pa0, pa1, pa2, pa3); SBAR();
    mla_pv(o, vb0, pa0, pa1, pa2, pa3); mla_partialSM(pB0, pB1, m_reg, mnB, alB);
    __syncthreads(); RESC(alB);
    mla_finishSM(pB0, pB1, alB, l_reg, pa0, pa1, pa2, pa3); SBAR();
    mla_pv(o, vb0 + 16384, pa0, pa1, pa2, pa3);
    if (hi == 0) li_l[r32] = l_reg; WAIT_L0();
    bf16_t* Y = (bf16_t*)(p.ws + WS_Y); float* ssqb = (float*)(p.ws + WS_SSQP);
    const float* gb = p.out_norm_b + h * 128;
    float g[4];
#pragma unroll
    for (int d0 = 0; d0 < 4; ++d0) g[d0] = gb[d0 * 32 + r32];
#pragma unroll
    for (int r = 0; r < 16; ++r) { const int orow = crow(r, hi); const float il = __builtin_amdgcn_rcpf(li_l[orow]);
        const size_t tok = (size_t)(b * SEQ + qb * 256 + wid * 32 + orow); bf16_t* yp = Y + tok * 2048 + 1024 + h * 128; float ss = 0.f;
#pragma unroll
        for (int d0 = 0; d0 < 4; ++d0) { const float v = o[d0][r] * il; ss += v * v; yp[d0 * 32 + r32] = (bf16_t)(pk_bf16(v * g[d0], 0.f) & 0xffffu); }
#pragma unroll
        for (int s = 16; s >= 1; s >>= 1) ss += __shfl_xor(ss, s, 64);
        if (r32 == 0) ssqb[tok * 24 + 16 + h] = ss; }
#undef SLOAD
#undef SWRITE
#undef RESC
}

__device__ __forceinline__ void phase_router(const Params& p, LAS char* lds) {
    const int tid = threadIdx.x, wid = __builtin_amdgcn_readfirstlane(tid >> 6), lane = tid & 63;
    const float* x2 = (const float*)(p.ws + WS_X2); const float* wg = (const float*)(p.ws + WS_WRT);
    unsigned char* xn8 = p.ws + WS_XN; unsigned* cnt = (unsigned*)(p.ws + WS_CTL + CTL_CNT);
    int* tokl = (int*)(p.ws + WS_TOKL); int* sel_e = (int*)(p.ws + WS_SEL); int* sel_r = sel_e + NTOK * 4; float* sel_g = (float*)(sel_r + NTOK * 4);
    LAS float* part = (LAS float*)lds;
    LAS float* rsv = (LAS float*)(lds + 32768);
    LAS unsigned* hist = (LAS unsigned*)(lds + 32768 + 128); LAS unsigned* hbase = hist + 32;
    for (int t0 = blockIdx.x * 32; t0 < NTOK; t0 += gridDim.x * 32) {
        __syncthreads();
        if (tid < N_EXP) hist[tid] = 0u;
#pragma unroll 1
        for (int j = 0; j < 4; ++j) { const int t = t0 + 4 * wid + j; f32x4 xr[8]; float ss = 0.f;
#pragma unroll
            for (int i = 0; i < 8; ++i) { xr[i] = ((const f32x4*)(x2 + (size_t)t * D_MODEL))[lane + 64 * i]; ss += xr[i][0] * xr[i][0] + xr[i][1] * xr[i][1] + xr[i][2] * xr[i][2] + xr[i][3] * xr[i][3]; }
            const float rs = rsqrtf(wave_sum(ss) * (1.f / D_MODEL) + EPS);
            if (lane == 0) rsv[4 * wid + j] = rs;
#pragma unroll
            for (int i = 0; i < 8; ++i) { const f32x4 v = xr[i]; const f32x4 g = ((const f32x4*)p.mlp_norm)[lane + 64 * i]; const float s16 = 16.f * rs;
                *(unsigned*)(xn8 + (size_t)t * D_MODEL + 4 * (lane + 64 * i)) = pk4_fp8(s16 * v[0] * g[0], s16 * v[1] * g[1], s16 * v[2] * g[2], s16 * v[3] * g[3]); } }
        { f32x16 acc;
#pragma unroll
          for (int r = 0; r < 16; ++r) acc[r] = 0.f;
          const float* ap = x2 + (size_t)(t0 + (lane & 31)) * D_MODEL + 256 * wid + 4 * (lane >> 5);
          const float* bp = wg + (size_t)(256 * wid + 4 * (lane >> 5)) * N_EXP + (lane & 31);
#pragma unroll 4
          for (int c = 0; c < 32; ++c) { const f32x4 a4 = *(const f32x4*)(ap + 8 * c);
#pragma unroll
              for (int q = 0; q < 4; ++q) acc = __builtin_amdgcn_mfma_f32_32x32x2f32(a4[q], bp[(size_t)(8 * c + q) * N_EXP], acc, 0, 0, 0); }
#pragma unroll
          for (int r = 0; r < 16; ++r) part[wid * 1024 + crow(r, lane >> 5) * 32 + (lane & 31)] = acc[r]; }
        __syncthreads();
        int my_e[4]; unsigned my_lr[4]; float my_g[4];
#pragma unroll
        for (int j = 0; j < 4; ++j) { const int tl = 4 * wid + j;
            float v = -3.0e38f;
            if (lane < 32) { float s = 0.f;
#pragma unroll
                for (int w = 0; w < 8; ++w) s += part[w * 1024 + tl * 32 + lane];
                v = s * rsv[tl] + p.b_router[lane]; }
            float tv[4]; int ti[4];
#pragma unroll
            for (int r = 0; r < 4; ++r) {
                float bv = v; int bi = lane;
#pragma unroll
                for (int o = 32; o >= 1; o >>= 1) { const float ov = __shfl_xor(bv, o, 64); const int oi = __shfl_xor(bi, o, 64); if (ov > bv || (ov == bv && oi < bi)) { bv = ov; bi = oi; } }
                tv[r] = bv; ti[r] = bi; if (lane == bi) v = -3.0e38f;
            }
            const float e0 = 1.f, e1 = __expf(tv[1] - tv[0]), e2 = __expf(tv[2] - tv[0]), e3 = __expf(tv[3] - tv[0]); const float inv = 1.f / (e0 + e1 + e2 + e3);
            const float gts[4] = {e0 * inv, e1 * inv, e2 * inv, e3 * inv};
            my_e[j] = ti[lane & 3]; my_g[j] = gts[lane & 3]; my_lr[j] = 0u;
            if (lane < 4) my_lr[j] = __hip_atomic_fetch_add(hist + my_e[j], 1u, __ATOMIC_RELAXED, __HIP_MEMORY_SCOPE_WORKGROUP);
        }
        __syncthreads();
        if (tid < N_EXP) hbase[tid] = atomicAdd(cnt + tid * 16, hist[tid]);
        __syncthreads();
        if (lane < 4) {
#pragma unroll
            for (int j = 0; j < 4; ++j) { const int t = t0 + 4 * wid + j; const int e = my_e[j]; const unsigned rk = hbase[e] + my_lr[j];
                tokl[e * NTOK + rk] = t; sel_e[t * 4 + lane] = e; sel_r[t * 4 + lane] = (int)rk; sel_g[t * 4 + lane] = my_g[j]; }
        }
    }
}

__device__ __forceinline__ void phase_combine(const Params& p, const LAS int* s_roff) {
    const int tid = threadIdx.x, wid = tid >> 6, lane = tid & 63;
    const float* x2 = (const float*)(p.ws + WS_X2); const bf16_t* ys = (const bf16_t*)(p.ws + WS_YS);
    const int* sel_e = (const int*)(p.ws + WS_SEL); const int* sel_r = sel_e + NTOK * 4; const float* sel_g = (const float*)(sel_r + NTOK * 4);
    for (int t = blockIdx.x * 8 + wid; t < NTOK; t += gridDim.x * 8) {
        f32x4 v[8];
#pragma unroll
        for (int i = 0; i < 8; ++i) v[i] = ((const f32x4*)(x2 + (size_t)t * D_MODEL))[lane + 64 * i];
#pragma unroll
        for (int k = 0; k < 4; ++k) { const int e = sel_e[t * 4 + k]; const size_t slot = (size_t)(s_roff[e] + sel_r[t * 4 + k]); const float g = sel_g[t * 4 + k];
            const u32x2* yr = (const u32x2*)(ys + slot * D_MODEL);
#pragma unroll
            for (int i = 0; i < 8; ++i) { const u32x2 w = yr[lane + 64 * i]; v[i][0] += g * bf_lo(w[0]); v[i][1] += g * bf_hi(w[0]); v[i][2] += g * bf_lo(w[1]); v[i][3] += g * bf_hi(w[1]); } }
        float ss = 0.f;
#pragma unroll
        for (int i = 0; i < 8; ++i) ss += v[i][0] * v[i][0] + v[i][1] * v[i][1] + v[i][2] * v[i][2] + v[i][3] * v[i][3];
        ss = wave_sum(ss); const float rs = rsqrtf(ss * (1.f / D_MODEL) + EPS);
#pragma unroll
        for (int i = 0; i < 8; ++i) { const f32x4 g = ((const f32x4*)p.final_norm)[lane + 64 * i];
            ((f32x4*)(p.out + (size_t)t * D_MODEL))[lane + 64 * i] = (f32x4){v[i][0] * rs * g[0], v[i][1] * rs * g[1], v[i][2] * rs * g[2], v[i][3] * rs * g[3]}; }
    }
}

constexpr int NPHASE = 9;
__global__ void __launch_bounds__(512, 2) mega_fwd(Params p) {
    extern __shared__ __attribute__((aligned(1024))) char smem_raw[];
    LAS char* lds = (LAS char*)smem_raw;
    LAS unsigned* misc = (LAS unsigned*)(lds + LDS_MISC);
    const int tid = threadIdx.x;
    if (tid < 4) misc[tid] = 0u;
    __syncthreads();
    unsigned* bar = (unsigned*)(p.ws + WS_CTL + CTL_BAR);
    XcdBarrier xb = xcd_barrier_post(bar, (volatile LAS unsigned*)misc);
    const int lo = p.ph_lo, hi = p.ph_hi;
    const int G = gridDim.x, bid = blockIdx.x;
    const int xperm = (bid & 7) * (G >> 3) + (bid >> 3);
#ifdef PH_ONLY
#define IN(k) ((k)==PH_ONLY)
#else
#define IN(k) (lo <= (k) && (k) < hi)
#endif
#define SEAM(k) do { if (IN(k) && IN((k) + 1)) xcd_barrier(xb); } while (0)
    if (IN(0)) phase_prologue(p);
    SEAM(0);
    if (IN(1)) {
        for (int u = xperm; u < 32 * 8; u += G) {
            const int pn = u / 32, pm = u % 32;
            PEpiProj ep{pn, pm * 256, p.ws, p.b_q_norm, p.b_kv_norm};
            __syncthreads();
            gemm_unit_pg<false>(lds, (const bf16_t*)(p.ws + WS_XN) + (size_t)pm * 256 * D_MODEL, (const bf16_t*)(p.ws + WS_BT_IN) + (size_t)pn * 256 * D_MODEL, D_MODEL, ep);
        }
    }
    SEAM(1);
    if (IN(2)) {
        { const int b0 = bid;
            int qv;
            if ((b0 & 3) == 0) {
                const int h = b0 >> 2, pn = 8 + (h >> 5), pm = h & 31;
                PEpiProj ep{pn, pm * 256, p.ws, p.b_q_norm, p.b_kv_norm};
                __syncthreads();
                gemm_unit_pg<false>(lds, (const bf16_t*)(p.ws + WS_XN) + (size_t)pm * 256 * D_MODEL, (const bf16_t*)(p.ws + WS_BT_IN) + (size_t)pn * 256 * D_MODEL, D_MODEL, ep);
                qv = 128 + h;
            } else {
                const int v = (b0 >> 2) * 3 + (b0 & 3) - 1;
                if (v < 128) {
                    attn_a_unit(p, lds, v); qv = v;
                    pg_convert(p.w_o, D_MODEL, D_MODEL, D_MODEL, 2048, (bf16_t*)(p.ws + WS_BT_WO), v * 1024 + tid, 128 * 1024);
                    pg_convert(p.w_o, D_MODEL, D_MODEL, D_MODEL, 2048, (bf16_t*)(p.ws + WS_BT_WO), v * 1024 + 512 + tid, 128 * 1024);
                } else {
                    const int w = v - 128; qv = -1;
                    attn_a_unit(p, lds, 128 + 2 * w); attn_a_unit(p, lds, 129 + 2 * w);
                    if (w < 32) pg_convert(p.b_w_ukv, 256, 2048, 2048, 2048, (bf16_t*)(p.ws + WS_BT_UKV), w * 512 + tid, 32 * 512);
                }
            }
            if (qv >= 0) { const int pn = qv / 32, pm = qv % 32;
                PEpiQUp ep{pn, pm * 256, p.ws};
                __syncthreads();
                gemm_unit_pg<false>(lds, (const bf16_t*)(p.ws + WS_CQ) + (size_t)pm * 256 * 512, (const bf16_t*)(p.ws + WS_BT_UQ) + (size_t)pn * 256 * 512, 512, ep);
                __syncthreads(); }
        }
        xcd_barrier(xb);
        for (int u = xperm; u < 32 * 8; u += G) {
            const int pn = u / 32, pm = u % 32;
            PEpiKvUp ep{pn, pm * 256, p.ws};
            __syncthreads();
            gemm_unit_pg<false>(lds, (const bf16_t*)(p.ws + WS_CKV) + (size_t)pm * 256 * 256, (const bf16_t*)(p.ws + WS_BT_UKV) + (size_t)pn * 256 * 256, 256, ep);
        }
    }
    SEAM(2);
    if (IN(3)) { for (int u = xperm; u < 256; u += G) mla_unit(p, lds, u); }
    SEAM(3);
    if (IN(4)) {
        __syncthreads();
        for (int u = xperm; u < 32 * 8; u += G) {
            const int pn = u / 32, pm = u % 32;
            LAS float* tab = (LAS float*)(lds + 2 * G_STAGE_B);
            __syncthreads();
            if (tid < 256) { const f32x4* pp = (const f32x4*)((const float*)(p.ws + WS_SSQP) + (size_t)(pm * 256 + tid) * 24); float sa = 0.f, sb2 = 0.f;
#pragma unroll
                for (int q = 0; q < 4; ++q) { const f32x4 v = pp[q]; sa += (v[0] + v[1]) + (v[2] + v[3]); }
#pragma unroll
                for (int q = 4; q < 6; ++q) { const f32x4 v = pp[q]; sb2 += (v[0] + v[1]) + (v[2] + v[3]); }
                tab[tid] = sa * (1.f / 1024.f); tab[256 + tid] = sb2 * (1.f / 1024.f); }
            __syncthreads();
            PEpiWo ep{pn, pm * 256, p.ws, p.x, tab};
            gemm_unit_pg<true>(lds, (const bf16_t*)(p.ws + WS_Y) + (size_t)pm * 256 * D_MODEL, (const bf16_t*)(p.ws + WS_BT_WO) + (size_t)pn * 256 * D_MODEL, D_MODEL, ep);
        }
    }
    SEAM(4);
    if (IN(5)) phase_router(p, lds);
    SEAM(5);
    LAS int* s_cnt = (LAS int*)(misc + 16); LAS int* s_toff = (LAS int*)(misc + 48); LAS int* s_roff = (LAS int*)(misc + 96);
    if (IN(6) || IN(7) || IN(8)) {
        if (tid == 0) { const unsigned* cnt = (const unsigned*)(p.ws + WS_CTL + CTL_CNT); int to = 0;
            for (int e = 0; e < N_EXP; ++e) { const int c = (int)xb_ld((unsigned*)cnt + e * 16); s_cnt[e] = c; s_toff[e] = to; s_roff[e] = to * 256; to += (c + 255) >> 8; }
            s_toff[N_EXP] = to; }
        __syncthreads();
    }
    if (IN(6)) {
        const int TM = s_toff[N_EXP];
        const int T16 = TM * 16, NF = (T16 & ~255), R = T16 - NF;
        const bool halves = R > 0 && R <= 128;
        int round = 0;
        for (int L = xperm; L < (halves ? NF : T16); L += G, ++round) {
            if (round == ((xperm >> 3) & 7))
                conv_image(p.w_down + (size_t)(xperm >> 3) * D_FF * D_MODEL + (xperm & 7) * 256, (size_t)D_MODEL, p.ws + WS_IMG_DN + (size_t)xperm * 32 * 16384, 0, 32);
            int e = 0; while (s_toff[e + 1] * 16 <= L) ++e;
            const int w = L - s_toff[e] * 16, nte = s_toff[e + 1] - s_toff[e], ntile = w / nte, mt = w - ntile * nte, cntE = s_cnt[e];
            AGather8 af{p.ws + WS_XN, (const int*)(p.ws + WS_TOKL) + (size_t)e * NTOK, mt * 256, cntE};
            BGateUp bf{p.w_up + (size_t)e * D_MODEL * (2 * D_FF) + ntile * 128, (size_t)(2 * D_FF)};
            EpiUp8 ep{ntile * 128, mt * 256, cntE, p.ws + WS_ACT + ((size_t)s_roff[e] + mt * 256) * D_FF, p.b_up + (size_t)e * (2 * D_FF)};
            gemm_unit8<0x7B7B7B7B>(lds, (LAS unsigned*)(misc + 8), D_MODEL / 64, af, bf, ep);
        }
        if (round <= ((xperm >> 3) & 7))
            conv_image(p.w_down + (size_t)(xperm >> 3) * D_FF * D_MODEL + (xperm & 7) * 256, (size_t)D_MODEL, p.ws + WS_IMG_DN + (size_t)xperm * 32 * 16384, 0, 32);
        if (halves && xperm < 2 * R) {
            const int L = NF + (xperm >> 1), hf = xperm & 1;
            int e = 0; while (s_toff[e + 1] * 16 <= L) ++e;
            const int w = L - s_toff[e] * 16, nte = s_toff[e + 1] - s_toff[e], ntile = w / nte, mt = w - ntile * nte, cntE = s_cnt[e];
            AGather8 af{p.ws + WS_XN, (const int*)(p.ws + WS_TOKL) + (size_t)e * NTOK, mt * 256, cntE};
            BGateUp bf{p.w_up + (size_t)e * D_MODEL * (2 * D_FF) + ntile * 128 + hf * 64, (size_t)(2 * D_FF)};
            EpiUp8q ep{ntile * 128 + hf * 64, mt * 256, cntE, p.ws + WS_ACT + ((size_t)s_roff[e] + mt * 256) * D_FF, p.b_up + (size_t)e * (2 * D_FF)};
            gemm_unit8q<0x7B7B7B7B>(lds, (LAS unsigned*)(misc + 8), D_MODEL / 64, af, bf, ep);
        }
    }
    SEAM(6);
    if (IN(7)) {
        const int TM = s_toff[N_EXP];
        const int T8 = TM * 8, NF = T8 & ~255, R = T8 - NF;
        const bool halves = R > 0 && R <= 128;
        for (int L = xperm; L < (halves ? NF : T8); L += G) {
            int e = 0; while (s_toff[e + 1] * 8 <= L) ++e;
            const int w = L - s_toff[e] * 8, nte = s_toff[e + 1] - s_toff[e], ntile = w / nte, mt = w - ntile * nte, cntE = s_cnt[e];
            ARows8 af{p.ws + WS_ACT + ((size_t)s_roff[e] + mt * 256) * D_FF, (unsigned)D_FF};
            EpiDown8 ep{ntile * 256, mt * 256, cntE, (bf16_t*)(p.ws + WS_YS) + ((size_t)s_roff[e] + mt * 256) * D_MODEL, p.b_down + (size_t)e * D_MODEL};
            gemm_unit8b<0x7D7D7D7D>(lds, (LAS unsigned*)(misc + 8), D_FF / 64, af, p.ws + WS_IMG_DN + (size_t)(e * 8 + ntile) * 32 * 16384, ep);
        }
        if (halves && xperm < 2 * R) {
            const int L = NF + (xperm >> 1), hf = xperm & 1;
            int e = 0; while (s_toff[e + 1] * 8 <= L) ++e;
            const int w = L - s_toff[e] * 8, nte = s_toff[e + 1] - s_toff[e], ntile = w / nte, mt = w - ntile * nte, cntE = s_cnt[e];
            ARows8 af{p.ws + WS_ACT + ((size_t)s_roff[e] + mt * 256) * D_FF, (unsigned)D_FF};
            EpiDown8h ep{ntile * 256 + hf * 128, mt * 256, cntE, (bf16_t*)(p.ws + WS_YS) + ((size_t)s_roff[e] + mt * 256) * D_MODEL, p.b_down + (size_t)e * D_MODEL};
            gemm_unit8bh<0x7D7D7D7D>(lds, (LAS unsigned*)(misc + 8), D_FF / 64, af, p.ws + WS_IMG_DN + (size_t)(e * 8 + ntile) * 32 * 16384, hf, ep);
        }
    }
    SEAM(7);
    if (IN(8)) phase_combine(p, s_roff);
}

extern "C" void kernel_launch(void* const* d_in, const int* in_sizes, int n_in, void* d_out, int out_size, void* d_ws, size_t ws_size, hipStream_t stream) {
    static int ready = 0;
    if (!ready) {
        if (hipFuncSetAttribute((const void*)mega_fwd, hipFuncAttributeMaxDynamicSharedMemorySize, LDS_BYTES) != hipSuccess) { fprintf(stderr, "kernel_launch: hipFuncSetAttribute failed\n"); return; }
        int per_cu = 0; hipOccupancyMaxActiveBlocksPerMultiprocessor(&per_cu, (const void*)mega_fwd, 512, LDS_BYTES);
        if (per_cu < 1) { fprintf(stderr, "kernel_launch: occupancy query says 0 blocks per CU\n"); return; }
        ready = 1;
    }
    if (ws_size < WS_END) { fprintf(stderr, "kernel_launch: workspace too small\n"); return; }
    hipMemsetAsync((unsigned char*)d_ws + WS_CTL, 0, CTL_BYTES, stream);
    Params p{};
    const float** f = (const float**)&p;
    for (int i = 0; i < 19; ++i) f[i] = (const float*)d_in[i];
    p.out = (float*)d_out; p.ws = (unsigned char*)d_ws; p.ph_lo = 0; p.ph_hi = NPHASE;
    hipLaunchKernelGGL(mega_fwd, dim3(256), dim3(512), LDS_BYTES, stream, p);
}
```

```cpp
#include <hip/hip_runtime.h>
#include <stdint.h>
#include <stdio.h>

#define LAS __attribute__((address_space(3)))
typedef unsigned short bf16_t;
typedef short bf16x8 __attribute__((ext_vector_type(8)));
typedef short s16x4 __attribute__((ext_vector_type(4)));
typedef short v4i16_t __attribute__((ext_vector_type(4)));
typedef float f32x2 __attribute__((ext_vector_type(2)));
typedef float f32x4 __attribute__((ext_vector_type(4)));
typedef float f32x16 __attribute__((ext_vector_type(16)));
typedef int i32x4 __attribute__((ext_vector_type(4)));
typedef unsigned u32x2 __attribute__((ext_vector_type(2)));
typedef unsigned u32x4 __attribute__((ext_vector_type(4)));
typedef __bf16 bf16x2_t __attribute__((ext_vector_type(2)));
typedef int v8i __attribute__((ext_vector_type(8)));
typedef int v2i __attribute__((ext_vector_type(2)));
typedef short v2s __attribute__((ext_vector_type(2)));

constexpr int D_MODEL = 2048, SEQ = 4096, BATCH = 2, NTOK = BATCH * SEQ;
constexpr int IN_COLS = 2368;
constexpr int N_EXP = 32, TOP_K = 4, D_FF = 2048;
constexpr float EPS = 1e-5f;
constexpr float LOG2E = 1.4426950408889634f;

constexpr size_t MiB = 1u << 20;
constexpr size_t WS_CTL = 0, CTL_BYTES = 1 * MiB;
constexpr size_t WS_XN = 1 * MiB, WS_QA = 33 * MiB, WS_KA = 49 * MiB, WS_VA = 53 * MiB, WS_CQ = 57 * MiB, WS_CKV = 65 * MiB, WS_KPE = 69 * MiB;
constexpr size_t WS_QB = 70 * MiB, WS_KVB = 94 * MiB, WS_Y = 126 * MiB, WS_X2 = 158 * MiB, WS_ROPE = 222 * MiB, WS_WRT = 223 * MiB;
constexpr size_t WS_TOKL = 224 * MiB, WS_SEL = 225 * MiB, WS_ACT = 226 * MiB, WS_YS = 386 * MiB, WS_BT_IN = 546 * MiB, WS_BT_UQ = 558 * MiB, WS_BT_UKV = 560 * MiB, WS_BT_WO = 562 * MiB, WS_SSQ2 = 570 * MiB, WS_IMG_DN = 571 * MiB, WS_END = 699 * MiB;
constexpr size_t WS_SSQP = WS_WRT + 262144;
constexpr size_t WS_SSQC = WS_SSQ2;
constexpr size_t WS_SSQK = WS_SSQ2 + 524288;
constexpr size_t CTL_BAR = 0, CTL_CNT = 16384, CTL_SSQ_CQ = 65536, CTL_SSQ_CKV = 98304, CTL_SSQ_A = 131072, CTL_SSQ_B = 163840, CTL_SSQ_X2 = 196608;

__device__ __forceinline__ unsigned pk_bf16(float lo, float hi) { f32x2 v = {lo, hi}; bf16x2_t b = __builtin_convertvector(v, bf16x2_t); return __builtin_bit_cast(unsigned, b); }
__device__ __forceinline__ unsigned pk4_fp8(float a, float b, float c, float d) { int w = __builtin_amdgcn_cvt_pk_fp8_f32(a, b, 0, false); w = __builtin_amdgcn_cvt_pk_fp8_f32(c, d, w, true); return (unsigned)w; }
__device__ __forceinline__ unsigned pk4_fp8_x64(f32x4 v) { v2s r; asm("" : "=v"(r));
    r = __builtin_amdgcn_cvt_scalef32_pk_fp8_f32(r, v[0], v[1], 0.015625f, false); r = __builtin_amdgcn_cvt_scalef32_pk_fp8_f32(r, v[2], v[3], 0.015625f, true); return __builtin_bit_cast(unsigned, r); }
__device__ __forceinline__ float bf_lo(unsigned u) { return __uint_as_float(u << 16); }
__device__ __forceinline__ float bf_hi(unsigned u) { return __uint_as_float(u & 0xffff0000u); }
__device__ __forceinline__ float wave_sum(float v) {
#pragma unroll
    for (int o = 32; o >= 1; o >>= 1) v += __shfl_xor(v, o, 64);
    return v;
}
__device__ __forceinline__ int crow(int r, int hi) { return (r & 3) + 8 * (r >> 2) + 4 * hi; }
__device__ __forceinline__ s16x4 vtr(const LAS char* p) { return __builtin_bit_cast(s16x4, __builtin_amdgcn_ds_read_tr16_b64_v4i16((LAS v4i16_t*)p)); }
#define SBAR() __builtin_amdgcn_sched_barrier(0)

#define XB_TMO      128
#define XB_XCNT(j)  (256  + 64 * (j))
#define XB_XSUB(j)  (1280 + 64 * (j))
#define XB_XGEN(j)  (2304 + 64 * (j))
#define XB_TOP      3328
#define XB_TOPGEN   3392
#define XCD_BAR_WORDS 3456
#define XB_SPIN_CAP (1u << 18)
__device__ __forceinline__ unsigned xb_ld(unsigned* p)              { return __hip_atomic_load(p, __ATOMIC_RELAXED, __HIP_MEMORY_SCOPE_AGENT); }
__device__ __forceinline__ unsigned xb_add(unsigned* p, unsigned v) { return __hip_atomic_fetch_add(p, v, __ATOMIC_RELAXED, __HIP_MEMORY_SCOPE_AGENT); }
__device__ __forceinline__ unsigned xb_xcc_id() { return (unsigned)__builtin_amdgcn_s_getreg((3 << 11) | 20) & 0xFu; }
#define XB_SPIN(cond, bar) do { unsigned _sp = 0; while (cond) { __builtin_amdgcn_s_sleep(1); \
    if ((++_sp & 255u) == 0u) { if (xb_ld(&(bar)[XB_TMO])) break; if (_sp > XB_SPIN_CAP) { atomicAdd(&(bar)[XB_TMO], 1u); break; } } } } while (0)
struct XcdBarrier { unsigned* bar; unsigned x; volatile LAS unsigned* st; };
__device__ __forceinline__ XcdBarrier xcd_barrier_post(unsigned* bar, volatile LAS unsigned* st) {
    XcdBarrier b; b.bar = bar; b.x = xb_xcc_id(); b.st = st;
    if (threadIdx.x == 0) (void)xb_add(&bar[XB_XCNT(b.x)], 1u);
    return b;
}
__device__ __forceinline__ void xcd_barrier_complete(unsigned* bar, unsigned x, unsigned& nloc, unsigned& nx) {
    const unsigned G = gridDim.x * gridDim.y * gridDim.z;
    unsigned sum, cnt, mine, sp = 0u;
    for (;;) {
        sum = 0u; cnt = 0u; mine = 0u;
#pragma unroll
        for (unsigned j = 0; j < 16; ++j) { const unsigned c = xb_ld(&bar[XB_XCNT(j)]); sum += c; cnt += (c > 0u) ? 1u : 0u; mine = (j == x) ? c : mine; }
        if (sum == G) break;
        __builtin_amdgcn_s_sleep(1);
        if ((++sp & 255u) == 0u) { if (xb_ld(&bar[XB_TMO])) break; if (sp > XB_SPIN_CAP) { atomicAdd(&bar[XB_TMO], 1u); break; } }
    }
    nloc = mine > 0u ? mine : 1u; nx = cnt > 0u ? cnt : 1u;
}
__device__ __forceinline__ void xcd_barrier(const XcdBarrier& b) {
    asm volatile("s_waitcnt vmcnt(0)" ::: "memory");
    __syncthreads();
    if (threadIdx.x == 0) {
        unsigned* bar = b.bar;
        __builtin_amdgcn_s_waitcnt(0);
        unsigned nloc = b.st[0], nx = b.st[1];
        if (nloc == 0u) { xcd_barrier_complete(bar, b.x, nloc, nx); b.st[0] = nloc; b.st[1] = nx; }
        const unsigned old = xb_add(&bar[XB_XSUB(b.x)], 1u);
        const unsigned gen = old / nloc;
        if (old + 1u == (gen + 1u) * nloc) {
            __builtin_amdgcn_fence(__ATOMIC_RELEASE, "agent");
            asm volatile("s_waitcnt vmcnt(0)" ::: "memory");
            const unsigned og = xb_add(&bar[XB_TOP], 1u);
            const unsigned tg = og / nx;
            if (og + 1u == (tg + 1u) * nx) xb_add(&bar[XB_TOPGEN], 1u);
            else XB_SPIN(xb_ld(&bar[XB_TOPGEN]) == tg, bar);
            __builtin_amdgcn_fence(__ATOMIC_ACQUIRE, "agent");
            xb_add(&bar[XB_XGEN(b.x)], 1u);
            asm volatile("s_waitcnt vmcnt(0)" ::: "memory");
        } else {
            XB_SPIN(xb_ld(&bar[XB_XGEN(b.x)]) == gen, bar);
            __builtin_amdgcn_fence(__ATOMIC_ACQUIRE, "agent");
            asm volatile("s_waitcnt vmcnt(0)" ::: "memory");
        }
    }
    __syncthreads();
}

constexpr int A_TILE_B = 256 * 64 * 2;
constexpr int B_PITCH = 544;
constexpr int B_TILE_B = 64 * B_PITCH;
constexpr int G_STAGE_B = A_TILE_B + B_TILE_B;
constexpr int LDS_MISC = 155648;
constexpr int LDS_BYTES = LDS_MISC + 1024;

__device__ __forceinline__ int a_img_byte(int r, int chunk) { return r * 128 + ((chunk ^ ((r >> 1) & 7)) << 4); }
#define WAIT_L0() asm volatile("s_waitcnt lgkmcnt(0)" ::: "memory")
__device__ __forceinline__ void glds16(const void* gsrc, unsigned lds_dst) { unsigned keep;
    asm volatile("s_mov_b32 %0, m0\n\ts_mov_b32 m0, %2\n\ts_nop 0\n\tglobal_load_lds_dwordx4 %1, off\n\ts_mov_b32 m0, %0" : "=&s"(keep) : "v"(gsrc), "s"(lds_dst) : "memory"); }
#define RAW_BARRIER() do { WAIT_L0(); __builtin_amdgcn_s_barrier(); } while (0)

__device__ __forceinline__ const char* uniform_ptr(const void* p) {
    const unsigned long long v = (unsigned long long)p;
    const unsigned lo = __builtin_amdgcn_readfirstlane((unsigned)v), hi = __builtin_amdgcn_readfirstlane((unsigned)(v >> 32));
    return (const char*)(((unsigned long long)hi << 32) | lo);
}
__device__ __forceinline__ void glds16s(const char* sbase, unsigned voff, unsigned lds_dst) { unsigned keep;
    asm volatile("s_mov_b32 %0, m0\n\ts_mov_b32 m0, %3\n\ts_nop 4\n\tglobal_load_lds_dwordx4 %1, %2\n\ts_mov_b32 m0, %0" : "=&s"(keep) : "v"(voff), "s"(sbase), "s"(lds_dst) : "memory"); }
#define WAIT_V4(n, a, b, c, d) asm volatile("s_waitcnt vmcnt(" #n ")" : "+v"(a), "+v"(b), "+v"(c), "+v"(d) :: "memory")
template <bool MID, class AF, class BF, class EPI>
__device__ __forceinline__ void gemm_unit(LAS char* lds, const int nt, const AF& af, const BF& bf, EPI& epi) {
    const int tid = threadIdx.x, wid = __builtin_amdgcn_readfirstlane(tid >> 6), lane = tid & 63, wr = wid >> 2, wc = wid & 3, fr = lane & 15, fq = lane >> 4;
    const char* abase = uniform_ptr(af.base);
    unsigned aoff[4];
#pragma unroll
    for (int i = 0; i < 4; ++i) { const int R = wid * 8 + i * 64 + (lane >> 3), C = ((lane & 7) ^ ((R >> 1) & 7)) * 8; aoff[i] = (af.rowoff(R) + (unsigned)C) * 2u; }
    const int a_ldsw = wid * 1024;
    const unsigned lds_u = (unsigned)__builtin_amdgcn_readfirstlane((int)(unsigned)(size_t)lds);
    const size_t ldb4 = (size_t)bf.ld * 4;
    const char* bbase = uniform_ptr(bf.base) + (size_t)wid * ldb4;
    const unsigned boff = bf.coloff(4 * lane) * 4u;
    const int b_lds0 = A_TILE_B + wid * B_PITCH + 8 * lane, b_lds1 = A_TILE_B + wid * B_PITCH + ((8 * lane) ^ 128);
    const int a_rd0 = a_img_byte(wr * 128 + fr, fq), a_rd1 = a_rd0 ^ 64;
    const int b_rd = A_TILE_B + (8 * fq + ((lane & 15) >> 2)) * B_PITCH + ((wc ^ (fq & 1)) << 7) + 8 * (lane & 3);
    f32x4 acc[8][4];
#pragma unroll
    for (int m = 0; m < 8; ++m)
#pragma unroll
        for (int n = 0; n < 4; ++n) acc[m][n] = (f32x4){0.f, 0.f, 0.f, 0.f};
    f32x4 sb[8];
#define G_STAGE_A(i, kt, buf) glds16s(abase + (size_t)(kt) * 128, aoff[i], lds_u + (unsigned)((buf) * G_STAGE_B + a_ldsw + (i) * 8192))
#define G_ISSUE_B(i, kt) asm volatile("s_nop 4\n\tglobal_load_dwordx4 %0, %1, %2" : "=v"(sb[i]) : "v"(boff), "s"(bbase + ((size_t)(kt) * 64 + (i) * 8) * ldb4) : "memory")
#define G_WRITE_B(i, buf) do { u32x2 w_ = {pk_bf16(sb[i][0], sb[i][1]), pk_bf16(sb[i][2], sb[i][3])}; \
        *(LAS u32x2*)(lds + (buf) * G_STAGE_B + (((i) & 1) ? b_lds1 : b_lds0) + (i) * 8 * B_PITCH) = w_; } while (0)
#define G_KSTEP(buf, ks) do { bf16x8 At[8], Bf[4]; \
        _Pragma("unroll") for (int n = 0; n < 4; ++n) { const s16x4 lo_ = vtr(lds + (buf) * G_STAGE_B + b_rd + (ks) * 32 * B_PITCH + n * 32), hi_ = vtr(lds + (buf) * G_STAGE_B + b_rd + (ks) * 32 * B_PITCH + 4 * B_PITCH + n * 32); \
            Bf[n] = (bf16x8){lo_[0], lo_[1], lo_[2], lo_[3], hi_[0], hi_[1], hi_[2], hi_[3]}; } \
        _Pragma("unroll") for (int m = 0; m < 8; ++m) At[m] = *(const LAS bf16x8*)(lds + (buf) * G_STAGE_B + ((ks) ? a_rd1 : a_rd0) + m * 2048); \
        SBAR(); __builtin_amdgcn_s_setprio(1); \
        _Pragma("unroll") for (int m = 0; m < 8; ++m) _Pragma("unroll") for (int n = 0; n < 4; ++n) \
            acc[m][n] = __builtin_amdgcn_mfma_f32_16x16x32_bf16(Bf[n], At[m], acc[m][n], 0, 0, 0); \
        __builtin_amdgcn_s_setprio(0); SBAR(); } while (0)
#pragma unroll
    for (int i = 0; i < 4; ++i) G_STAGE_A(i, 0, 0);
#pragma unroll
    for (int i = 0; i < 8; ++i) G_ISSUE_B(i, 0);
    WAIT_V4(0, sb[0], sb[1], sb[2], sb[3]); WAIT_V4(0, sb[4], sb[5], sb[6], sb[7]);
#pragma unroll
    for (int i = 0; i < 8; ++i) G_WRITE_B(i, 0);
    SBAR();
#pragma unroll
    for (int i = 0; i < 8; ++i) G_ISSUE_B(i, 1);
    SBAR();
    RAW_BARRIER();
#pragma unroll 1
    for (int t = 0; t < nt; ++t) {
        const int cur = t & 1, nxt = cur ^ 1;
        if constexpr (MID) { if (t == (nt >> 1)) epi.mid(acc, wr, wc, fr, fq); }
        const int k1 = (t + 1 < nt) ? t + 1 : nt - 1, k2 = (t + 2 < nt) ? t + 2 : nt - 1;
        G_STAGE_A(0, k1, nxt); G_STAGE_A(1, k1, nxt); G_STAGE_A(2, k1, nxt); G_STAGE_A(3, k1, nxt);
        G_KSTEP(cur, 0);
        WAIT_V4(8, sb[0], sb[1], sb[2], sb[3]);
        G_WRITE_B(0, nxt); G_WRITE_B(1, nxt); G_WRITE_B(2, nxt); G_WRITE_B(3, nxt); SBAR();
        G_ISSUE_B(0, k2); G_ISSUE_B(1, k2); G_ISSUE_B(2, k2); G_ISSUE_B(3, k2); SBAR();
        G_KSTEP(cur, 1);
        WAIT_V4(8, sb[4], sb[5], sb[6], sb[7]);
        G_WRITE_B(4, nxt); G_WRITE_B(5, nxt); G_WRITE_B(6, nxt); G_WRITE_B(7, nxt); SBAR();
        G_ISSUE_B(4, k2); G_ISSUE_B(5, k2); G_ISSUE_B(6, k2); G_ISSUE_B(7, k2); SBAR();
        asm volatile("s_waitcnt vmcnt(8)" ::: "memory");
        RAW_BARRIER();
    }
    WAIT_V4(0, sb[0], sb[1], sb[2], sb[3]); WAIT_V4(0, sb[4], sb[5], sb[6], sb[7]);
    epi.fin(acc, wr, wc, fr, fq);
#undef G_STAGE_A
#undef G_ISSUE_B
#undef G_WRITE_B
#undef G_KSTEP
}

constexpr int A8_TILE_B = 16384, B8_PITCH = 288, B8_TILE_B = 64 * B8_PITCH;
constexpr int A8_RING = 5, B8_RING = 4, B8_OFF = A8_RING * A8_TILE_B;
static_assert(B8_OFF + B8_RING * B8_TILE_B <= LDS_MISC, "fp8 rings fit below the misc words");
__device__ __forceinline__ v2i vtr8(const LAS char* p) { return __builtin_amdgcn_ds_read_tr8_b64_v2i32((LAS v2i*)p); }
template <int SCALE_X, class AF, class BF, class EPI>
__device__ __forceinline__ void gemm_unit8(LAS char* lds, LAS unsigned* ring_cnt, const int nt, const AF& af, const BF& bf, EPI& epi) {
    const int tid = threadIdx.x, wid = __builtin_amdgcn_readfirstlane(tid >> 6), lane = tid & 63, wr = wid >> 2, wc = wid & 3, r32 = lane & 31, hi = lane >> 5;
    const char* abase = uniform_ptr(af.base);
    unsigned aoff[2];
#pragma unroll
    for (int i = 0; i < 2; ++i) { const int R = wid * 16 + i * 128 + (lane >> 2), C = ((lane & 3) ^ ((lane >> 4) & 3)) * 16; aoff[i] = af.rowoff(R) + (unsigned)C; }
    const unsigned lds_u = (unsigned)__builtin_amdgcn_readfirstlane((int)(unsigned)(size_t)lds) + (unsigned)(wid * 1024);
    const size_t ldb4 = (size_t)bf.ld * 4;
    const char* bbase = uniform_ptr(bf.base) + (size_t)wid * ldb4;
    const unsigned boff = bf.coloff(4 * lane) * 4u;
    const int b_wr = B8_OFF + wid * B8_PITCH + 4 * lane;
    const int a_rd0 = (wr * 128 + r32) * 64 + (((2 * hi) ^ ((r32 >> 2) & 3)) << 4), a_rd1 = a_rd0 ^ 16;
    const int b_rd = B8_OFF + (32 * hi + ((lane & 15) >> 1)) * B8_PITCH + wc * 64 + 16 * ((lane >> 4) & 1) + 8 * (lane & 1);
    f32x16 acc[4][2];
#pragma unroll
    for (int m = 0; m < 4; ++m)
#pragma unroll
        for (int n = 0; n < 2; ++n)
#pragma unroll
            for (int r = 0; r < 16; ++r) acc[m][n][r] = 0.f;
    f32x4 sb[8];
#define H_STAGE_A(i, kt, slot) glds16s(abase + (size_t)(kt) * 64, aoff[i], lds_u + (unsigned)((slot) * A8_TILE_B + (i) * 8192))
#define H_ISSUE_B(i, kt) asm volatile("s_nop 4\n\tglobal_load_dwordx4 %0, %1, %2" : "=v"(sb[i]) : "v"(boff), "s"(bbase + ((size_t)(kt) * 64 + (i) * 8) * ldb4) : "memory")
#define H_WRITE_B(i, slot) *(LAS unsigned*)(lds + (slot) * B8_TILE_B + b_wr + (i) * 8 * B8_PITCH) = pk4_fp8_x64(sb[i])
#define H_KSTEP(sa, sbk) do { v8i Xf[4], Wf[2]; \
        _Pragma("unroll") for (int n = 0; n < 2; ++n) _Pragma("unroll") for (int r = 0; r < 4; ++r) { const v2i t_ = vtr8(lds + (sbk) * B8_TILE_B + b_rd + r * 8 * B8_PITCH + n * 32); Wf[n][2 * r] = t_[0]; Wf[n][2 * r + 1] = t_[1]; } \
        _Pragma("unroll") for (int m = 0; m < 4; ++m) { const i32x4 lo_ = *(const LAS i32x4*)(lds + (sa) * A8_TILE_B + a_rd0 + m * 2048), hi_ = *(const LAS i32x4*)(lds + (sa) * A8_TILE_B + a_rd1 + m * 2048); \
            Xf[m] = (v8i){lo_[0], lo_[1], lo_[2], lo_[3], hi_[0], hi_[1], hi_[2], hi_[3]}; } \
        SBAR(); __builtin_amdgcn_s_setprio(1); \
        _Pragma("unroll") for (int m = 0; m < 4; ++m) _Pragma("unroll") for (int n = 0; n < 2; ++n) \
            acc[m][n] = __builtin_amdgcn_mfma_scale_f32_32x32x64_f8f6f4(Wf[n], Xf[m], acc[m][n], 0, 0, 0, 0x79797979, 0, SCALE_X); \
        __builtin_amdgcn_s_setprio(0); \
        _Pragma("unroll") for (int m = 0; m < 4; ++m) _Pragma("unroll") for (int n = 0; n < 2; ++n) asm volatile("" : "+v"(acc[m][n])); \
        SBAR(); } while (0)
    if (tid < 8) ring_cnt[tid] = 0u;
    H_STAGE_A(0, 0, 0); H_STAGE_A(1, 0, 0); H_STAGE_A(0, 1, 1); H_STAGE_A(1, 1, 1);
#pragma unroll
    for (int i = 0; i < 8; ++i) H_ISSUE_B(i, 0);
    WAIT_V4(0, sb[0], sb[1], sb[2], sb[3]); WAIT_V4(0, sb[4], sb[5], sb[6], sb[7]);
#pragma unroll
    for (int i = 0; i < 8; ++i) H_WRITE_B(i, 0);
    SBAR();
#pragma unroll
    for (int i = 0; i < 8; ++i) H_ISSUE_B(i, 1);
    WAIT_V4(0, sb[0], sb[1], sb[2], sb[3]); WAIT_V4(0, sb[4], sb[5], sb[6], sb[7]);
#pragma unroll
    for (int i = 0; i < 8; ++i) H_WRITE_B(i, 1);
    SBAR();
    H_STAGE_A(0, 2, 2); H_STAGE_A(1, 2, 2);
#pragma unroll
    for (int i = 0; i < 8; ++i) H_ISSUE_B(i, 2);
    SBAR();
    RAW_BARRIER();
    int sa_r = 0, sa_w = 3, sb_r = 0, sb_w = 2;
#pragma unroll 1
    for (int t = 0; t < nt; ++t) {
        if (t >= 2) {
            const unsigned need = (unsigned)(t - 1);
            for (;;) { asm volatile("" ::: "memory"); const unsigned v = *(volatile LAS unsigned*)(ring_cnt + (lane & 7)); if (__all(v >= need)) break; __builtin_amdgcn_s_sleep(1); }
            asm volatile("" ::: "memory");
        }
        const int k3 = (t + 3 < nt) ? t + 3 : nt - 1;
        H_STAGE_A(0, k3, sa_w); H_STAGE_A(1, k3, sa_w);
        H_KSTEP(sa_r, sb_r);
        WAIT_V4(6, sb[0], sb[1], sb[2], sb[3]);
        H_WRITE_B(0, sb_w); H_WRITE_B(1, sb_w); H_WRITE_B(2, sb_w); H_WRITE_B(3, sb_w); SBAR();
        H_ISSUE_B(0, k3); H_ISSUE_B(1, k3); H_ISSUE_B(2, k3); H_ISSUE_B(3, k3); SBAR();
        WAIT_V4(6, sb[4], sb[5], sb[6], sb[7]);
        H_WRITE_B(4, sb_w); H_WRITE_B(5, sb_w); H_WRITE_B(6, sb_w); H_WRITE_B(7, sb_w); SBAR();
        H_ISSUE_B(4, k3); H_ISSUE_B(5, k3); H_ISSUE_B(6, k3); H_ISSUE_B(7, k3); SBAR();
        asm volatile("" ::: "memory");
        if (lane == 0) *(volatile LAS unsigned*)(ring_cnt + wid) = (unsigned)(t + 1);
        asm volatile("" ::: "memory");
        sa_r = (sa_r == A8_RING - 1) ? 0 : sa_r + 1; sa_w = (sa_w == A8_RING - 1) ? 0 : sa_w + 1;
        sb_r = (sb_r == B8_RING - 1) ? 0 : sb_r + 1; sb_w = (sb_w == B8_RING - 1) ? 0 : sb_w + 1;
    }
    WAIT_V4(0, sb[0], sb[1], sb[2], sb[3]); WAIT_V4(0, sb[4], sb[5], sb[6], sb[7]);
    RAW_BARRIER();
    epi.fin(acc, wr, wc, r32, hi);
#undef H_STAGE_A
#undef H_ISSUE_B
#undef H_WRITE_B
#undef H_KSTEP
}

template <int SCALE_X, class AF, class BF, class EPI>
__device__ __forceinline__ void gemm_unit8h(LAS char* lds, LAS unsigned* ring_cnt, const int nt, const AF& af, const BF& bf, EPI& epi) {
    const int tid = threadIdx.x, wid = __builtin_amdgcn_readfirstlane(tid >> 6), lane = tid & 63, wr = wid >> 2, wc = wid & 3, r32 = lane & 31, hi = lane >> 5;
    const char* abase = uniform_ptr(af.base);
    unsigned aoff[2];
#pragma unroll
    for (int i = 0; i < 2; ++i) { const int R = wid * 16 + i * 128 + (lane >> 2), C = ((lane & 3) ^ ((lane >> 4) & 3)) * 16; aoff[i] = af.rowoff(R) + (unsigned)C; }
    const unsigned lds_u = (unsigned)__builtin_amdgcn_readfirstlane((int)(unsigned)(size_t)lds) + (unsigned)(wid * 1024);
    const size_t ldb4 = (size_t)bf.ld * 4;
    const char* bbase = uniform_ptr(bf.base) + (size_t)wid * ldb4;
    const unsigned boff = (unsigned)(lane >> 5) * 8u * (unsigned)ldb4 + bf.coloff(4 * (lane & 31)) * 4u;
    const int b_wr = B8_OFF + (wid + 8 * (lane >> 5)) * B8_PITCH + 4 * (lane & 31);
    const int a_rd0 = (wr * 128 + r32) * 64 + (((2 * hi) ^ ((r32 >> 2) & 3)) << 4), a_rd1 = a_rd0 ^ 16;
    const int b_rd = B8_OFF + (32 * hi + ((lane & 15) >> 1)) * B8_PITCH + wc * 32 + 16 * ((lane >> 4) & 1) + 8 * (lane & 1);
    f32x16 acc[4][1];
#pragma unroll
    for (int m = 0; m < 4; ++m)
#pragma unroll
        for (int n = 0; n < 1; ++n)
#pragma unroll
            for (int r = 0; r < 16; ++r) acc[m][n][r] = 0.f;
    f32x4 sb[4];
#define H_STAGE_A(i, kt, slot) glds16s(abase + (size_t)(kt) * 64, aoff[i], lds_u + (unsigned)((slot) * A8_TILE_B + (i) * 8192))
#define H_ISSUE_B(i, kt) asm volatile("s_nop 4\n\tglobal_load_dwordx4 %0, %1, %2" : "=v"(sb[i]) : "v"(boff), "s"(bbase + ((size_t)(kt) * 64 + (i) * 16) * ldb4) : "memory")
#define H_WRITE_B(i, slot) *(LAS unsigned*)(lds + (slot) * B8_TILE_B + b_wr + (i) * 16 * B8_PITCH) = pk4_fp8_x64(sb[i])
#define H_KSTEP(sa, sbk) do { v8i Xf[4], Wf[1]; \
        _Pragma("unroll") for (int n = 0; n < 1; ++n) _Pragma("unroll") for (int r = 0; r < 4; ++r) { const v2i t_ = vtr8(lds + (sbk) * B8_TILE_B + b_rd + r * 8 * B8_PITCH + n * 32); Wf[n][2 * r] = t_[0]; Wf[n][2 * r + 1] = t_[1]; } \
        _Pragma("unroll") for (int m = 0; m < 4; ++m) { const i32x4 lo_ = *(const LAS i32x4*)(lds + (sa) * A8_TILE_B + a_rd0 + m * 2048), hi_ = *(const LAS i32x4*)(lds + (sa) * A8_TILE_B + a_rd1 + m * 2048); \
            Xf[m] = (v8i){lo_[0], lo_[1], lo_[2], lo_[3], hi_[0], hi_[1], hi_[2], hi_[3]}; } \
        SBAR(); __builtin_amdgcn_s_setprio(1); \
        _Pragma("unroll") for (int m = 0; m < 4; ++m) _Pragma("unroll") for (int n = 0; n < 1; ++n) \
            acc[m][n] = __builtin_amdgcn_mfma_scale_f32_32x32x64_f8f6f4(Wf[n], Xf[m], acc[m][n], 0, 0, 0, 0x79797979, 0, SCALE_X); \
        __builtin_amdgcn_s_setprio(0); SBAR(); } while (0)
    if (tid < 8) ring_cnt[tid] = 0u;
    H_STAGE_A(0, 0, 0); H_STAGE_A(1, 0, 0); H_STAGE_A(0, 1, 1); H_STAGE_A(1, 1, 1);
#pragma unroll
    for (int i = 0; i < 4; ++i) H_ISSUE_B(i, 0);
    WAIT_V4(0, sb[0], sb[1], sb[2], sb[3]);
#pragma unroll
    for (int i = 0; i < 4; ++i) H_WRITE_B(i, 0);
    SBAR();
#pragma unroll
    for (int i = 0; i < 4; ++i) H_ISSUE_B(i, 1);
    WAIT_V4(0, sb[0], sb[1], sb[2], sb[3]);
#pragma unroll
    for (int i = 0; i < 4; ++i) H_WRITE_B(i, 1);
    SBAR();
    H_STAGE_A(0, 2, 2); H_STAGE_A(1, 2, 2);
#pragma unroll
    for (int i = 0; i < 4; ++i) H_ISSUE_B(i, 2);
    SBAR();
    RAW_BARRIER();
    int sa_r = 0, sa_w = 3, sb_r = 0, sb_w = 2;
#pragma unroll 1
    for (int t = 0; t < nt; ++t) {
        if (t >= 2) {
            const unsigned need = (unsigned)(t - 1);
            for (;;) { asm volatile("" ::: "memory"); const unsigned v = *(volatile LAS unsigned*)(ring_cnt + (lane & 7)); if (__all(v >= need)) break; __builtin_amdgcn_s_sleep(1); }
            asm volatile("" ::: "memory");
        }
        const int k3 = (t + 3 < nt) ? t + 3 : nt - 1;
        H_STAGE_A(0, k3, sa_w); H_STAGE_A(1, k3, sa_w);
        H_KSTEP(sa_r, sb_r);
        WAIT_V4(2, sb[0], sb[1], sb[2], sb[3]);
        H_WRITE_B(0, sb_w); H_WRITE_B(1, sb_w); H_WRITE_B(2, sb_w); H_WRITE_B(3, sb_w); SBAR();
        H_ISSUE_B(0, k3); H_ISSUE_B(1, k3); H_ISSUE_B(2, k3); H_ISSUE_B(3, k3); SBAR();
        asm volatile("" ::: "memory");
        if (lane == 0) *(volatile LAS unsigned*)(ring_cnt + wid) = (unsigned)(t + 1);
        asm volatile("" ::: "memory");
        sa_r = (sa_r == A8_RING - 1) ? 0 : sa_r + 1; sa_w = (sa_w == A8_RING - 1) ? 0 : sa_w + 1;
        sb_r = (sb_r == B8_RING - 1) ? 0 : sb_r + 1; sb_w = (sb_w == B8_RING - 1) ? 0 : sb_w + 1;
    }
    WAIT_V4(0, sb[0], sb[1], sb[2], sb[3]);
    RAW_BARRIER();
    epi.fin(acc, wr, wc, r32, hi);
#undef H_STAGE_A
#undef H_ISSUE_B
#undef H_WRITE_B
#undef H_KSTEP
}

template <int SCALE_X, class AF, class BF, class EPI>
__device__ __forceinline__ void gemm_unit8q(LAS char* lds, LAS unsigned* ring_cnt, const int nt, const AF& af, const BF& bf, EPI& epi) {
    const int tid = threadIdx.x, wid = __builtin_amdgcn_readfirstlane(tid >> 6), lane = tid & 63, wr = wid >> 1, wc = wid & 1, r32 = lane & 31, hi = lane >> 5;
    const char* abase = uniform_ptr(af.base);
    unsigned aoff[2];
#pragma unroll
    for (int i = 0; i < 2; ++i) { const int R = wid * 16 + i * 128 + (lane >> 2), C = ((lane & 3) ^ ((lane >> 4) & 3)) * 16; aoff[i] = af.rowoff(R) + (unsigned)C; }
    const unsigned lds_u = (unsigned)__builtin_amdgcn_readfirstlane((int)(unsigned)(size_t)lds) + (unsigned)(wid * 1024);
    const size_t ldb4 = (size_t)bf.ld * 4;
    const char* bbase = uniform_ptr(bf.base) + (size_t)wid * ldb4;
    const unsigned boff = (unsigned)(lane >> 5) * 8u * (unsigned)ldb4 + bf.coloff(4 * (lane & 31)) * 4u;
    const int b_wr = B8_OFF + (wid + 8 * (lane >> 5)) * B8_PITCH + 4 * (lane & 31);
    const int a_rd0 = (wr * 64 + r32) * 64 + (((2 * hi) ^ ((r32 >> 2) & 3)) << 4), a_rd1 = a_rd0 ^ 16;
    const int b_rd = B8_OFF + (32 * hi + ((lane & 15) >> 1)) * B8_PITCH + wc * 64 + 16 * ((lane >> 4) & 1) + 8 * (lane & 1);
    f32x16 acc[2][2];
#pragma unroll
    for (int m = 0; m < 2; ++m)
#pragma unroll
        for (int n = 0; n < 2; ++n)
#pragma unroll
            for (int r = 0; r < 16; ++r) acc[m][n][r] = 0.f;
    f32x4 sb[4];
#define H_STAGE_A(i, kt, slot) glds16s(abase + (size_t)(kt) * 64, aoff[i], lds_u + (unsigned)((slot) * A8_TILE_B + (i) * 8192))
#define H_ISSUE_B(i, kt) asm volatile("s_nop 4\n\tglobal_load_dwordx4 %0, %1, %2" : "=v"(sb[i]) : "v"(boff), "s"(bbase + ((size_t)(kt) * 64 + (i) * 16) * ldb4) : "memory")
#define H_WRITE_B(i, slot) *(LAS unsigned*)(lds + (slot) * B8_TILE_B + b_wr + (i) * 16 * B8_PITCH) = pk4_fp8_x64(sb[i])
#define H_KSTEP(sa, sbk) do { v8i Xf[2], Wf[2]; \
        _Pragma("unroll") for (int n = 0; n < 2; ++n) _Pragma("unroll") for (int r = 0; r < 4; ++r) { const v2i t_ = vtr8(lds + (sbk) * B8_TILE_B + b_rd + r * 8 * B8_PITCH + n * 32); Wf[n][2 * r] = t_[0]; Wf[n][2 * r + 1] = t_[1]; } \
        _Pragma("unroll") for (int m = 0; m < 2; ++m) { const i32x4 lo_ = *(const LAS i32x4*)(lds + (sa) * A8_TILE_B + a_rd0 + m * 2048), hi_ = *(const LAS i32x4*)(lds + (sa) * A8_TILE_B + a_rd1 + m * 2048); \
            Xf[m] = (v8i){lo_[0], lo_[1], lo_[2], lo_[3], hi_[0], hi_[1], hi_[2], hi_[3]}; } \
        SBAR(); __builtin_amdgcn_s_setprio(1); \
        _Pragma("unroll") for (int m = 0; m < 2; ++m) _Pragma("unroll") for (int n = 0; n < 2; ++n) \
            acc[m][n] = __builtin_amdgcn_mfma_scale_f32_32x32x64_f8f6f4(Wf[n], Xf[m], acc[m][n], 0, 0, 0, 0x79797979, 0, SCALE_X); \
        __builtin_amdgcn_s_setprio(0); SBAR(); } while (0)
    if (tid < 8) ring_cnt[tid] = 0u;
    H_STAGE_A(0, 0, 0); H_STAGE_A(1, 0, 0); H_STAGE_A(0, 1, 1); H_STAGE_A(1, 1, 1);
#pragma unroll
    for (int i = 0; i < 4; ++i) H_ISSUE_B(i, 0);
    WAIT_V4(0, sb[0], sb[1], sb[2], sb[3]);
#pragma unroll
    for (int i = 0; i < 4; ++i) H_WRITE_B(i, 0);
    SBAR();
#pragma unroll
    for (int i = 0; i < 4; ++i) H_ISSUE_B(i, 1);
    WAIT_V4(0, sb[0], sb[1], sb[2], sb[3]);
#pragma unroll
    for (int i = 0; i < 4; ++i) H_WRITE_B(i, 1);
    SBAR();
    H_STAGE_A(0, 2, 2); H_STAGE_A(1, 2, 2);
#pragma unroll
    for (int i = 0; i < 4; ++i) H_ISSUE_B(i, 2);
    SBAR();
    RAW_BARRIER();
    int sa_r = 0, sa_w = 3, sb_r = 0, sb_w = 2;
#pragma unroll 1
    for (int t = 0; t < nt; ++t) {
        if (t >= 2) {
            const unsigned need = (unsigned)(t - 1);
            for (;;) { asm volatile("" ::: "memory"); const unsigned v = *(volatile LAS unsigned*)(ring_cnt + (lane & 7)); if (__all(v >= need)) break; __builtin_amdgcn_s_sleep(1); }
            asm volatile("" ::: "memory");
        }
        const int k3 = (t + 3 < nt) ? t + 3 : nt - 1;
        H_STAGE_A(0, k3, sa_w); H_STAGE_A(1, k3, sa_w);
        H_KSTEP(sa_r, sb_r);
        WAIT_V4(2, sb[0], sb[1], sb[2], sb[3]);
        H_WRITE_B(0, sb_w); H_WRITE_B(1, sb_w); H_WRITE_B(2, sb_w); H_WRITE_B(3, sb_w); SBAR();
        H_ISSUE_B(0, k3); H_ISSUE_B(1, k3); H_ISSUE_B(2, k3); H_ISSUE_B(3, k3); SBAR();
        asm volatile("" ::: "memory");
        if (lane == 0) *(volatile LAS unsigned*)(ring_cnt + wid) = (unsigned)(t + 1);
        asm volatile("" ::: "memory");
        sa_r = (sa_r == A8_RING - 1) ? 0 : sa_r + 1; sa_w = (sa_w == A8_RING - 1) ? 0 : sa_w + 1;
        sb_r = (sb_r == B8_RING - 1) ? 0 : sb_r + 1; sb_w = (sb_w == B8_RING - 1) ? 0 : sb_w + 1;
    }
    WAIT_V4(0, sb[0], sb[1], sb[2], sb[3]);
    RAW_BARRIER();
    epi.fin(acc, wr, wc, r32, hi);
#undef H_STAGE_A
#undef H_ISSUE_B
#undef H_WRITE_B
#undef H_KSTEP
}

constexpr int C8_B_TILE = 16384, C8_B_OFF = A8_RING * A8_TILE_B;
template <int SCALE_X, class AF, class EPI>
__device__ __forceinline__ void gemm_unit8b(LAS char* lds, LAS unsigned* ring_cnt, const int nt, const AF& af, const unsigned char* img, EPI& epi) {
    const int tid = threadIdx.x, wid = __builtin_amdgcn_readfirstlane(tid >> 6), lane = tid & 63, wr = wid >> 2, wc = wid & 3, r32 = lane & 31, hi = lane >> 5;
    const char* abase = uniform_ptr(af.base);
    unsigned aoff[2];
#pragma unroll
    for (int i = 0; i < 2; ++i) { const int R = wid * 16 + i * 128 + (lane >> 2), C = ((lane & 3) ^ ((lane >> 4) & 3)) * 16; aoff[i] = af.rowoff(R) + (unsigned)C; }
    const unsigned lds_u = (unsigned)__builtin_amdgcn_readfirstlane((int)(unsigned)(size_t)lds) + (unsigned)(wid * 1024);
    const char* ibase = uniform_ptr(img);
    const unsigned ioff = (unsigned)(wid * 1024 + lane * 16);
    const int b_wr = C8_B_OFF + wid * 1024 + lane * 16;
    const int a_rd0 = (wr * 128 + r32) * 64 + (((2 * hi) ^ ((r32 >> 2) & 3)) << 4), a_rd1 = a_rd0 ^ 16;
    const int q8 = (lane & 15) >> 1;
    const int b_rd0 = C8_B_OFF + (32 * hi + q8) * 256 + ((wc * 64 + 16 * ((lane >> 4) & 1) + 8 * (lane & 1)) ^ (q8 << 5)), b_rd1 = b_rd0 ^ 32;
    i32x4 sv[2];
#define C_STAGE_A(i, kt, slot) glds16s(abase + (size_t)(kt) * 64, aoff[i], lds_u + (unsigned)((slot) * A8_TILE_B + (i) * 8192))
#define C_ISSUE_B(i, kt) asm volatile("s_nop 4\n\tglobal_load_dwordx4 %0, %1, %2" : "=v"(sv[i]) : "v"(ioff), "s"(ibase + (size_t)(kt) * 16384 + (i) * 8192) : "memory")
#define C_WRITE_B(i, slot) *(LAS i32x4*)(lds + (slot) * C8_B_TILE + b_wr + (i) * 8192) = sv[i]
#define C_WAIT(n) asm volatile("s_waitcnt vmcnt(" #n ")" : "+v"(sv[0]), "+v"(sv[1]) :: "memory")
    if (tid < 8) ring_cnt[tid] = 0u;
    C_STAGE_A(0, 0, 0); C_STAGE_A(1, 0, 0); C_STAGE_A(0, 1, 1); C_STAGE_A(1, 1, 1);
    C_ISSUE_B(0, 0); C_ISSUE_B(1, 0); C_WAIT(0); C_WRITE_B(0, 0); C_WRITE_B(1, 0); SBAR();
    C_ISSUE_B(0, 1); C_ISSUE_B(1, 1); C_WAIT(0); C_WRITE_B(0, 1); C_WRITE_B(1, 1); SBAR();
    C_STAGE_A(0, 2, 2); C_STAGE_A(1, 2, 2);
    C_ISSUE_B(0, 2); C_ISSUE_B(1, 2);
    SBAR();
    f32x16 acc[4][2];
#pragma unroll
    for (int m = 0; m < 4; ++m)
#pragma unroll
        for (int n = 0; n < 2; ++n)
#pragma unroll
            for (int r = 0; r < 16; ++r) acc[m][n][r] = 0.f;
    RAW_BARRIER();
    int sa_r = 0, sa_w = 3, sb_r = 0, sb_w = 2;
#pragma unroll 1
    for (int t = 0; t < nt; ++t) {
        if (t >= 2) { const unsigned need = (unsigned)(t - 1);
            for (;;) { asm volatile("" ::: "memory"); const unsigned v = *(volatile LAS unsigned*)(ring_cnt + (lane & 7)); if (__all(v >= need)) break; __builtin_amdgcn_s_sleep(1); }
            asm volatile("" ::: "memory"); }
        const int k3 = (t + 3 < nt) ? t + 3 : nt - 1;
        C_STAGE_A(0, k3, sa_w); C_STAGE_A(1, k3, sa_w);
        { v8i Xf[4], Wf[2];
#pragma unroll
          for (int r = 0; r < 4; ++r) { const v2i t0_ = vtr8(lds + sb_r * C8_B_TILE + b_rd0 + r * 2048), t1_ = vtr8(lds + sb_r * C8_B_TILE + b_rd1 + r * 2048); Wf[0][2 * r] = t0_[0]; Wf[0][2 * r + 1] = t0_[1]; Wf[1][2 * r] = t1_[0]; Wf[1][2 * r + 1] = t1_[1]; }
#pragma unroll
          for (int m = 0; m < 4; ++m) { const i32x4 lo_ = *(const LAS i32x4*)(lds + sa_r * A8_TILE_B + a_rd0 + m * 2048), hi_ = *(const LAS i32x4*)(lds + sa_r * A8_TILE_B + a_rd1 + m * 2048);
              Xf[m] = (v8i){lo_[0], lo_[1], lo_[2], lo_[3], hi_[0], hi_[1], hi_[2], hi_[3]}; }
          SBAR(); __builtin_amdgcn_s_setprio(1);
#pragma unroll
          for (int m = 0; m < 4; ++m)
#pragma unroll
              for (int n = 0; n < 2; ++n) acc[m][n] = __builtin_amdgcn_mfma_scale_f32_32x32x64_f8f6f4(Wf[n], Xf[m], acc[m][n], 0, 0, 0, 0x79797979, 0, SCALE_X);
          __builtin_amdgcn_s_setprio(0); SBAR(); }
        C_WAIT(2);
        C_WRITE_B(0, sb_w); C_WRITE_B(1, sb_w); SBAR();
        C_ISSUE_B(0, k3); C_ISSUE_B(1, k3); SBAR();
        asm volatile("" ::: "memory");
        if (lane == 0) *(volatile LAS unsigned*)(ring_cnt + wid) = (unsigned)(t + 1);
        asm volatile("" ::: "memory");
        sa_r = (sa_r == A8_RING - 1) ? 0 : sa_r + 1; sa_w = (sa_w == A8_RING - 1) ? 0 : sa_w + 1;
        sb_r = (sb_r == B8_RING - 1) ? 0 : sb_r + 1; sb_w = (sb_w == B8_RING - 1) ? 0 : sb_w + 1;
    }
    C_WAIT(0);
    RAW_BARRIER();
    epi.fin(acc, wr, wc, r32, hi);
#undef C_STAGE_A
#undef C_ISSUE_B
#undef C_WRITE_B
#undef C_WAIT
}
template <int SCALE_X, class AF, class EPI>
__device__ __forceinline__ void gemm_unit8bh(LAS char* lds, LAS unsigned* ring_cnt, const int nt, const AF& af, const unsigned char* img, const int hf, EPI& epi) {
    const int tid = threadIdx.x, wid = __builtin_amdgcn_readfirstlane(tid >> 6), lane = tid & 63, wr = wid >> 2, wc = wid & 3, r32 = lane & 31, hi = lane >> 5;
    const char* abase = uniform_ptr(af.base);
    unsigned aoff[2];
#pragma unroll
    for (int i = 0; i < 2; ++i) { const int R = wid * 16 + i * 128 + (lane >> 2), C = ((lane & 3) ^ ((lane >> 4) & 3)) * 16; aoff[i] = af.rowoff(R) + (unsigned)C; }
    const unsigned lds_u = (unsigned)__builtin_amdgcn_readfirstlane((int)(unsigned)(size_t)lds) + (unsigned)(wid * 1024);
    const char* ibase = uniform_ptr(img);
    const unsigned ioff = (unsigned)(wid * 1024 + lane * 16);
    const int b_wr = C8_B_OFF + wid * 1024 + lane * 16;
    const int a_rd0 = (wr * 128 + r32) * 64 + (((2 * hi) ^ ((r32 >> 2) & 3)) << 4), a_rd1 = a_rd0 ^ 16;
    const int q8 = (lane & 15) >> 1;
    const int b_rd0 = C8_B_OFF + (32 * hi + q8) * 256 + ((hf * 128 + wc * 32 + 16 * ((lane >> 4) & 1) + 8 * (lane & 1)) ^ (q8 << 5));
    i32x4 sv[2];
#define C_STAGE_A(i, kt, slot) glds16s(abase + (size_t)(kt) * 64, aoff[i], lds_u + (unsigned)((slot) * A8_TILE_B + (i) * 8192))
#define C_ISSUE_B(i, kt) asm volatile("s_nop 4\n\tglobal_load_dwordx4 %0, %1, %2" : "=v"(sv[i]) : "v"(ioff), "s"(ibase + (size_t)(kt) * 16384 + (i) * 8192) : "memory")
#define C_WRITE_B(i, slot) *(LAS i32x4*)(lds + (slot) * C8_B_TILE + b_wr + (i) * 8192) = sv[i]
#define C_WAIT(n) asm volatile("s_waitcnt vmcnt(" #n ")" : "+v"(sv[0]), "+v"(sv[1]) :: "memory")
    if (tid < 8) ring_cnt[tid] = 0u;
    C_STAGE_A(0, 0, 0); C_STAGE_A(1, 0, 0); C_STAGE_A(0, 1, 1); C_STAGE_A(1, 1, 1);
    C_ISSUE_B(0, 0); C_ISSUE_B(1, 0); C_WAIT(0); C_WRITE_B(0, 0); C_WRITE_B(1, 0); SBAR();
    C_ISSUE_B(0, 1); C_ISSUE_B(1, 1); C_WAIT(0); C_WRITE_B(0, 1); C_WRITE_B(1, 1); SBAR();
    C_STAGE_A(0, 2, 2); C_STAGE_A(1, 2, 2);
    C_ISSUE_B(0, 2); C_ISSUE_B(1, 2);
    SBAR();
    f32x16 acc[4][1];
#pragma unroll
    for (int m = 0; m < 4; ++m)
#pragma unroll
        for (int n = 0; n < 1; ++n)
#pragma unroll
            for (int r = 0; r < 16; ++r) acc[m][n][r] = 0.f;
    RAW_BARRIER();
    int sa_r = 0, sa_w = 3, sb_r = 0, sb_w = 2;
#pragma unroll 1
    for (int t = 0; t < nt; ++t) {
        if (t >= 2) { const unsigned need = (unsigned)(t - 1);
            for (;;) { asm volatile("" ::: "memory"); const unsigned v = *(volatile LAS unsigned*)(ring_cnt + (lane & 7)); if (__all(v >= need)) break; __builtin_amdgcn_s_sleep(1); }
            asm volatile("" ::: "memory"); }
        const int k3 = (t + 3 < nt) ? t + 3 : nt - 1;
        C_STAGE_A(0, k3, sa_w); C_STAGE_A(1, k3, sa_w);
        { v8i Xf[4], Wf[1];
#pragma unroll
          for (int r = 0; r < 4; ++r) { const v2i t0_ = vtr8(lds + sb_r * C8_B_TILE + b_rd0 + r * 2048); Wf[0][2 * r] = t0_[0]; Wf[0][2 * r + 1] = t0_[1]; }
#pragma unroll
          for (int m = 0; m < 4; ++m) { const i32x4 lo_ = *(const LAS i32x4*)(lds + sa_r * A8_TILE_B + a_rd0 + m * 2048), hi_ = *(const LAS i32x4*)(lds + sa_r * A8_TILE_B + a_rd1 + m * 2048);
              Xf[m] = (v8i){lo_[0], lo_[1], lo_[2], lo_[3], hi_[0], hi_[1], hi_[2], hi_[3]}; }
          SBAR(); __builtin_amdgcn_s_setprio(1);
#pragma unroll
          for (int m = 0; m < 4; ++m)
#pragma unroll
              for (int n = 0; n < 1; ++n) acc[m][n] = __builtin_amdgcn_mfma_scale_f32_32x32x64_f8f6f4(Wf[n], Xf[m], acc[m][n], 0, 0, 0, 0x79797979, 0, SCALE_X);
          __builtin_amdgcn_s_setprio(0); SBAR(); }
        C_WAIT(2);
        C_WRITE_B(0, sb_w); C_WRITE_B(1, sb_w); SBAR();
        C_ISSUE_B(0, k3); C_ISSUE_B(1, k3); SBAR();
        asm volatile("" ::: "memory");
        if (lane == 0) *(volatile LAS unsigned*)(ring_cnt + wid) = (unsigned)(t + 1);
        asm volatile("" ::: "memory");
        sa_r = (sa_r == A8_RING - 1) ? 0 : sa_r + 1; sa_w = (sa_w == A8_RING - 1) ? 0 : sa_w + 1;
        sb_r = (sb_r == B8_RING - 1) ? 0 : sb_r + 1; sb_w = (sb_w == B8_RING - 1) ? 0 : sb_w + 1;
    }
    C_WAIT(0);
    RAW_BARRIER();
    epi.fin(acc, wr, wc, r32, hi);
#undef C_STAGE_A
#undef C_ISSUE_B
#undef C_WRITE_B
#undef C_WAIT
}

__device__ __forceinline__ void conv_image(const float* W, size_t ld, unsigned char* img, int t0, int t1) {
    const int tid = threadIdx.x, wid = tid >> 6, lane = tid & 63;
    const float* wp = W + (size_t)wid * ld + 4 * lane;
    unsigned char* ip = img + wid * 256 + ((4 * lane) ^ (wid << 5));
    for (int t = t0; t < t1; t += 2) { f32x4 v[2][8];
#pragma unroll
        for (int u = 0; u < 2; ++u)
#pragma unroll
            for (int i = 0; i < 8; ++i) v[u][i] = *(const f32x4*)(wp + ((size_t)(t + u) * 64 + i * 8) * ld);
#pragma unroll
        for (int u = 0; u < 2; ++u)
#pragma unroll
            for (int i = 0; i < 8; ++i) *(unsigned*)(ip + (size_t)(t + u) * 16384 + i * 2048) = pk4_fp8_x64(v[u][i]); }
}

struct Params {
    const float *x, *attn_norm, *w_in, *a_sink, *b_q_norm, *b_w_uq, *b_kv_norm, *b_w_ukv, *out_norm_a, *out_norm_b, *w_o, *mlp_norm, *w_router, *b_router,
        *w_up, *b_up, *w_down, *b_down, *final_norm;
    float* out; unsigned char* ws; int ph_lo, ph_hi;
};

struct ARows { const bf16_t* base; unsigned ld; __device__ __forceinline__ unsigned rowoff(int r) const { return (unsigned)r * ld; } };
struct AGather { const bf16_t* base; const int* tokl; int r0, cnt; __device__ __forceinline__ unsigned rowoff(int r) const { int rk = r0 + r; rk = rk < cnt ? rk : 0; return (unsigned)tokl[rk] * (unsigned)D_MODEL; } };
struct ARows8 { const unsigned char* base; unsigned ld; __device__ __forceinline__ unsigned rowoff(int r) const { return (unsigned)r * ld; } };
struct AGather8 { const unsigned char* base; const int* tokl; int r0, cnt; __device__ __forceinline__ unsigned rowoff(int r) const { int rk = r0 + r; rk = rk < cnt ? rk : 0; return (unsigned)tokl[rk] * (unsigned)D_MODEL; } };
struct BPlain { const float* base; size_t ld; int ncols;
    __device__ __forceinline__ unsigned coloff(int c) const { return (unsigned)(c < ncols ? c : (c & (ncols - 1))); } };
struct BGateUp { const float* base; size_t ld;
    __device__ __forceinline__ unsigned coloff(int c) const { const int wc = c >> 6, w = c & 63; return (unsigned)(wc * 32 + (w & 31) + ((w & 32) ? D_FF : 0)); } };

struct EpiProj {
    int pn, brow; unsigned char* ws; const float *qg, *kvg;
    __device__ __forceinline__ void mid(f32x4 (&)[8][4], int, int, int, int) {}
    __device__ __forceinline__ void fin(f32x4 (&acc)[8][4], int wr, int wc, int fr, int fq) {
        if (pn < 6) {
            bf16_t* dst; int ldd, c0;
            if (pn < 4) { dst = (bf16_t*)(ws + WS_QA); ldd = 1024; c0 = pn * 256; } else if (pn == 4) { dst = (bf16_t*)(ws + WS_KA); ldd = 256; c0 = 0; } else { dst = (bf16_t*)(ws + WS_VA); ldd = 256; c0 = 0; }
#pragma unroll
            for (int m = 0; m < 8; ++m) { const int row = brow + wr * 128 + m * 16 + fr;
#pragma unroll
                for (int n = 0; n < 4; ++n) { const int col = c0 + wc * 64 + n * 16 + fq * 4; const f32x4 v = acc[m][n];
                    *(u32x2*)(dst + (size_t)row * ldd + col) = (u32x2){pk_bf16(v[0], v[1]), pk_bf16(v[2], v[3])}; } }
        } else if (pn < 9) {
            bf16_t* dst; int ldd, c0; const float* g; float* ssq; int nsl, sl;
            if (pn < 8) { dst = (bf16_t*)(ws + WS_CQ); ldd = 512; c0 = (pn - 6) * 256; g = qg; ssq = (float*)(ws + WS_SSQC); nsl = 8; sl = (pn - 6) * 4 + wc; }
            else { dst = (bf16_t*)(ws + WS_CKV); ldd = 256; c0 = 0; g = kvg; ssq = (float*)(ws + WS_SSQK); nsl = 4; sl = wc; }
            f32x4 gvv[4];
#pragma unroll
            for (int n = 0; n < 4; ++n) gvv[n] = *(const f32x4*)(g + c0 + wc * 64 + n * 16 + fq * 4);
#pragma unroll
            for (int m = 0; m < 8; ++m) { const int row = brow + wr * 128 + m * 16 + fr; float ss = 0.f;
#pragma unroll
                for (int n = 0; n < 4; ++n) { const int col = c0 + wc * 64 + n * 16 + fq * 4; const f32x4 v = acc[m][n]; const f32x4 gv = gvv[n];
                    ss += v[0] * v[0] + v[1] * v[1] + v[2] * v[2] + v[3] * v[3];
                    *(u32x2*)(dst + (size_t)row * ldd + col) = (u32x2){pk_bf16(v[0] * gv[0], v[1] * gv[1]), pk_bf16(v[2] * gv[2], v[3] * gv[3])}; }
                ss += __shfl_xor(ss, 16, 64); ss += __shfl_xor(ss, 32, 64);
                if (fq == 0) ssq[(size_t)row * nsl + sl] = ss; }
        } else {
            if (wc == 0) {
                bf16_t* dst = (bf16_t*)(ws + WS_KPE); const float* rope = (const float*)(ws + WS_ROPE);
#pragma unroll
                for (int m = 0; m < 8; ++m) { const int row = brow + wr * 128 + m * 16 + fr; const int pos = row & (SEQ - 1);
#pragma unroll
                    for (int n = 0; n < 2; ++n) { const int i0 = n * 16 + fq * 4; const f32x4 x1 = acc[m][n], x2 = acc[m][n + 2];
                        const f32x4 cs0 = *(const f32x4*)(rope + ((size_t)pos * 32 + i0) * 2), cs1 = *(const f32x4*)(rope + ((size_t)pos * 32 + i0) * 2 + 4);
                        const float c[4] = {cs0[0], cs0[2], cs1[0], cs1[2]}, s[4] = {cs0[1], cs0[3], cs1[1], cs1[3]};
                        float o1[4], o2[4];
#pragma unroll
                        for (int j = 0; j < 4; ++j) { o1[j] = x1[j] * c[j] - x2[j] * s[j]; o2[j] = x1[j] * s[j] + x2[j] * c[j]; }
                        *(u32x2*)(dst + (size_t)row * 64 + i0) = (u32x2){pk_bf16(o1[0], o1[1]), pk_bf16(o1[2], o1[3])};
                        *(u32x2*)(dst + (size_t)row * 64 + 32 + i0) = (u32x2){pk_bf16(o2[0], o2[1]), pk_bf16(o2[2], o2[3])}; } }
            }
        }
    }
};
struct EpiQUp {
    int pn, brow; unsigned char* ws;
    __device__ __forceinline__ void mid(f32x4 (&)[8][4], int, int, int, int) {}
    __device__ __forceinline__ void fin(f32x4 (&acc)[8][4], int wr, int wc, int fr, int fq) {
        bf16_t* dst = (bf16_t*)(ws + WS_QB); const float* rope = (const float*)(ws + WS_ROPE); const float* ssq = (const float*)(ws + WS_CTL + CTL_SSQ_CQ);
        const int seg = pn * 4 + wc, head = seg / 3, part = seg - head * 3;
        float sq[8];
#pragma unroll
        for (int m = 0; m < 8; ++m) { const f32x4* pp = (const f32x4*)((const float*)(ws + WS_SSQC) + (size_t)(brow + wr * 128 + m * 16 + fr) * 8); const f32x4 p0 = pp[0], p1 = pp[1];
            sq[m] = ((p0[0] + p0[1]) + (p0[2] + p0[3])) + ((p1[0] + p1[1]) + (p1[2] + p1[3])); }
#pragma unroll
        for (int m = 0; m < 8; ++m) { const int row = brow + wr * 128 + m * 16 + fr; const float rs = rsqrtf(sq[m] * (1.f / 512.f) + EPS);
            bf16_t* drow = dst + (size_t)row * 1536 + head * 192 + part * 64;
            if (part < 2) {
#pragma unroll
                for (int n = 0; n < 4; ++n) { const f32x4 v = acc[m][n]; *(u32x2*)(drow + n * 16 + fq * 4) = (u32x2){pk_bf16(v[0] * rs, v[1] * rs), pk_bf16(v[2] * rs, v[3] * rs)}; }
            } else { const int pos = row & (SEQ - 1);
#pragma unroll
                for (int n = 0; n < 2; ++n) { const int i0 = n * 16 + fq * 4; const f32x4 x1 = acc[m][n], x2 = acc[m][n + 2];
                    const f32x4 cs0 = *(const f32x4*)(rope + ((size_t)pos * 32 + i0) * 2), cs1 = *(const f32x4*)(rope + ((size_t)pos * 32 + i0) * 2 + 4);
                    const float c[4] = {cs0[0], cs0[2], cs1[0], cs1[2]}, s[4] = {cs0[1], cs0[3], cs1[1], cs1[3]};
                    float o1[4], o2[4];
#pragma unroll
                    for (int j = 0; j < 4; ++j) { o1[j] = (x1[j] * c[j] - x2[j] * s[j]) * rs; o2[j] = (x1[j] * s[j] + x2[j] * c[j]) * rs; }
                    *(u32x2*)(drow + i0) = (u32x2){pk_bf16(o1[0], o1[1]), pk_bf16(o1[2], o1[3])};
                    *(u32x2*)(drow + 32 + i0) = (u32x2){pk_bf16(o2[0], o2[1]), pk_bf16(o2[2], o2[3])}; } }
        }
    }
};
struct EpiKvUp {
    int pn, brow; unsigned char* ws;
    __device__ __forceinline__ void mid(f32x4 (&)[8][4], int, int, int, int) {}
    __device__ __forceinline__ void fin(f32x4 (&acc)[8][4], int wr, int wc, int fr, int fq) {
        bf16_t* dst = (bf16_t*)(ws + WS_KVB);
        float sq[8];
#pragma unroll
        for (int m = 0; m < 8; ++m) { const f32x4 p0 = *(const f32x4*)((const float*)(ws + WS_SSQK) + (size_t)(brow + wr * 128 + m * 16 + fr) * 4); sq[m] = (p0[0] + p0[1]) + (p0[2] + p0[3]); }
#pragma unroll
        for (int m = 0; m < 8; ++m) { const int row = brow + wr * 128 + m * 16 + fr; const float rs = rsqrtf(sq[m] * (1.f / 256.f) + EPS);
#pragma unroll
            for (int n = 0; n < 4; ++n) { const int col = pn * 256 + wc * 64 + n * 16 + fq * 4; const f32x4 v = acc[m][n];
                *(u32x2*)(dst + (size_t)row * 2048 + col) = (u32x2){pk_bf16(v[0] * rs, v[1] * rs), pk_bf16(v[2] * rs, v[3] * rs)}; } }
    }
};
struct EpiWo {
    int pn, brow; unsigned char* ws; const float* x; const LAS float* tab;
    __device__ __forceinline__ void mid(f32x4 (&acc)[8][4], int wr, int wc, int fr, int fq) {
#pragma unroll
        for (int m = 0; m < 8; ++m) { const int r = wr * 128 + m * 16 + fr;
            const float f = __builtin_amdgcn_sqrtf((tab[256 + r] + EPS) * __builtin_amdgcn_rcpf(tab[r] + EPS));
#pragma unroll
            for (int n = 0; n < 4; ++n) acc[m][n] *= f;
            SBAR(); }
    }
    __device__ __forceinline__ void fin(f32x4 (&acc)[8][4], int wr, int wc, int fr, int fq) {
        float* x2 = (float*)(ws + WS_X2);
#pragma unroll
        for (int m = 0; m < 8; ++m) { const int r = wr * 128 + m * 16 + fr, row = brow + r; const float rbm = rsqrtf(tab[256 + r] + EPS); f32x4 xv[4];
#pragma unroll
            for (int n = 0; n < 4; ++n) xv[n] = *(const f32x4*)(x + (size_t)row * D_MODEL + pn * 256 + wc * 64 + n * 16 + fq * 4);
#pragma unroll
            for (int n = 0; n < 4; ++n) { const int col = pn * 256 + wc * 64 + n * 16 + fq * 4;
                const f32x4 v = acc[m][n] * rbm + xv[n];
                *(f32x4*)(x2 + (size_t)row * D_MODEL + col) = v; } }
    }
};
struct EpiUp8 {
    int j0, r0, cnt; unsigned char* dst; const float* bias;
    __device__ __forceinline__ void fin(f32x16 (&acc)[4][2], int wr, int wc, int r32, int hi) {
        f32x4 bg[4], bu[4];
#pragma unroll
        for (int rg = 0; rg < 4; ++rg) { const int j = j0 + wc * 32 + 8 * rg + 4 * hi; bg[rg] = *(const f32x4*)(bias + j); bu[rg] = *(const f32x4*)(bias + D_FF + j); }
#pragma unroll
        for (int m = 0; m < 4; ++m) { const int r = wr * 128 + m * 32 + r32; unsigned o8[4];
#pragma unroll
            for (int rg = 0; rg < 4; ++rg) { float o[4];
#pragma unroll
                for (int q = 0; q < 4; ++q) { const float g = fminf(acc[m][0][4 * rg + q] + bg[rg][q], 7.f), u = fminf(fmaxf(acc[m][1][4 * rg + q] + bu[rg][q], -7.f), 7.f);
                    const float sg = __builtin_amdgcn_rcpf(1.f + __builtin_amdgcn_exp2f(-1.702f * LOG2E * g)); o[q] = 4.f * (u + 1.f) * (g * sg); }
                o8[rg] = pk4_fp8(o[0], o[1], o[2], o[3]); }
            if (r0 + r < cnt) {
#pragma unroll
                for (int rg = 0; rg < 4; ++rg) *(unsigned*)(dst + (size_t)r * D_FF + j0 + wc * 32 + 8 * rg + 4 * hi) = o8[rg]; }
        }
    }
};
struct EpiUp8q {
    int j0, r0, cnt; unsigned char* dst; const float* bias;
    __device__ __forceinline__ void fin(f32x16 (&acc)[2][2], int wr, int wc, int r32, int hi) {
        f32x4 bg[4], bu[4];
#pragma unroll
        for (int rg = 0; rg < 4; ++rg) { const int j = j0 + wc * 32 + 8 * rg + 4 * hi; bg[rg] = *(const f32x4*)(bias + j); bu[rg] = *(const f32x4*)(bias + D_FF + j); }
#pragma unroll
        for (int m = 0; m < 2; ++m) { const int r = wr * 64 + m * 32 + r32; unsigned o8[4];
#pragma unroll
            for (int rg = 0; rg < 4; ++rg) { float o[4];
#pragma unroll
                for (int q = 0; q < 4; ++q) { const float g = fminf(acc[m][0][4 * rg + q] + bg[rg][q], 7.f), u = fminf(fmaxf(acc[m][1][4 * rg + q] + bu[rg][q], -7.f), 7.f);
                    const float sg = __builtin_amdgcn_rcpf(1.f + __builtin_amdgcn_exp2f(-1.702f * LOG2E * g)); o[q] = 4.f * (u + 1.f) * (g * sg); }
                o8[rg] = pk4_fp8(o[0], o[1], o[2], o[3]); }
            if (r0 + r < cnt) {
#pragma unroll
                for (int rg = 0; rg < 4; ++rg) *(unsigned*)(dst + (size_t)r * D_FF + j0 + wc * 32 + 8 * rg + 4 * hi) = o8[rg]; }
        }
    }
};
struct EpiDown8 {
    int c0, r0, cnt; bf16_t* dst; const float* bias;
    __device__ __forceinline__ void fin(f32x16 (&acc)[4][2], int wr, int wc, int r32, int hi) {
        f32x4 b[2][4];
#pragma unroll
        for (int n = 0; n < 2; ++n)
#pragma unroll
            for (int rg = 0; rg < 4; ++rg) b[n][rg] = *(const f32x4*)(bias + c0 + wc * 64 + n * 32 + 8 * rg + 4 * hi);
#pragma unroll
        for (int m = 0; m < 4; ++m) { const int r = wr * 128 + m * 32 + r32;
            if (r0 + r < cnt) {
#pragma unroll
                for (int n = 0; n < 2; ++n)
#pragma unroll
                    for (int rg = 0; rg < 4; ++rg) { const int col = c0 + wc * 64 + n * 32 + 8 * rg + 4 * hi;
                        *(u32x2*)(dst + (size_t)r * D_MODEL + col) = (u32x2){pk_bf16(acc[m][n][4 * rg] + b[n][rg][0], acc[m][n][4 * rg + 1] + b[n][rg][1]), pk_bf16(acc[m][n][4 * rg + 2] + b[n][rg][2], acc[m][n][4 * rg + 3] + b[n][rg][3])}; } }
        }
    }
};
struct EpiDown8h {
    int c0, r0, cnt; bf16_t* dst; const float* bias;
    __device__ __forceinline__ void fin(f32x16 (&acc)[4][1], int wr, int wc, int r32, int hi) {
        f32x4 b[1][4];
#pragma unroll
        for (int n = 0; n < 1; ++n)
#pragma unroll
            for (int rg = 0; rg < 4; ++rg) b[n][rg] = *(const f32x4*)(bias + c0 + wc * 32 + n * 32 + 8 * rg + 4 * hi);
#pragma unroll
        for (int m = 0; m < 4; ++m) { const int r = wr * 128 + m * 32 + r32;
            if (r0 + r < cnt) {
#pragma unroll
                for (int n = 0; n < 1; ++n)
#pragma unroll
                    for (int rg = 0; rg < 4; ++rg) { const int col = c0 + wc * 32 + n * 32 + 8 * rg + 4 * hi;
                        *(u32x2*)(dst + (size_t)r * D_MODEL + col) = (u32x2){pk_bf16(acc[m][n][4 * rg] + b[n][rg][0], acc[m][n][4 * rg + 1] + b[n][rg][1]), pk_bf16(acc[m][n][4 * rg + 2] + b[n][rg][2], acc[m][n][4 * rg + 3] + b[n][rg][3])}; } }
        }
    }
};

constexpr int PG_HTB = 128 * 64 * 2;
__host__ __device__ __forceinline__ int pg_lds_byte(int r, int c) { const int st = (r >> 4) * 2 + (c >> 5), rr = r & 15, cc = c & 31, ob = rr * 64 + cc * 2; return st * 1024 + (ob ^ (((ob >> 9) & 1) << 5)); }
__host__ __device__ __forceinline__ void pg_stage_rc(int b, int& R, int& C) { const int st = b / 1024, sb = b % 1024, swz = sb ^ (((sb >> 9) & 1) << 5); R = (st >> 1) * 16 + swz / 64; C = (st & 1) * 32 + (swz % 64) / 2; }
__host__ __device__ __forceinline__ int pg_tcol(int rho) { return (rho & ~0x30) | ((rho & 0x10) << 1) | ((rho & 0x20) >> 1); }
template <bool MID, class EPI>
__device__ __forceinline__ void gemm_unit_pg(LAS char* lds, const bf16_t* A, const bf16_t* Bt, const int K, EPI& E) {
    const int tid = threadIdx.x, wid = __builtin_amdgcn_readfirstlane(tid >> 6), lane = tid & 63, wr = wid >> 2, wc = wid & 3, fr = lane & 15, fq = lane >> 4;
    const int nt = K / 64;
    unsigned voff[2];
#pragma unroll
    for (int i = 0; i < 2; ++i) { int R, C; pg_stage_rc(tid * 16 + i * 8192, R, C); voff[i] = (unsigned)(R * K + C) * 2u; }
    const size_t kstep = (size_t)(64 * 2), hstep = (size_t)128 * K * 2;
    const unsigned ldsw = (unsigned)wid * 1024u;
    const int aoff = pg_lds_byte(wr * 64 + fr, fq * 8), boff = pg_lds_byte(wc * 32 + fr, fq * 8);
#define PG_SA(b, h) (((b) * 2 + (h)) * PG_HTB)
#define PG_SB(b, h) ((4 + (b) * 2 + (h)) * PG_HTB)
#define PG_STAGE(bufoff, gbase) do { _Pragma("unroll") for (int _i = 0; _i < 2; ++_i) \
        __builtin_amdgcn_global_load_lds((const unsigned*)((const char*)(gbase) + voff[_i]), (LAS unsigned*)(lds + (bufoff) + ldsw + _i * 8192), 16, 0, 0); } while (0)
#define PG_LDA(dst, b, h) do { _Pragma("unroll") for (int m = 0; m < 4; ++m) _Pragma("unroll") for (int k = 0; k < 2; ++k) dst[m][k] = *(const LAS bf16x8*)(lds + PG_SA(b, h) + aoff + m * 2048 + k * 1024); } while (0)
#define PG_LDB(dst, b, h) do { _Pragma("unroll") for (int n = 0; n < 2; ++n) _Pragma("unroll") for (int k = 0; k < 2; ++k) dst[n][k] = *(const LAS bf16x8*)(lds + PG_SB(b, h) + boff + n * 2048 + k * 1024); } while (0)
#define PG_MMA(ai, bj, At_, Bt_) do { __builtin_amdgcn_s_setprio(1); _Pragma("unroll") for (int m = 0; m < 4; ++m) _Pragma("unroll") for (int n = 0; n < 2; ++n) _Pragma("unroll") for (int k = 0; k < 2; ++k) \
        acc[ai][bj][m][n] = __builtin_amdgcn_mfma_f32_16x16x32_bf16(Bt_[n][k], At_[m][k], acc[ai][bj][m][n], 0, 0, 0); __builtin_amdgcn_s_setprio(0); } while (0)
#define PG_WAIT_V(n) asm volatile("s_waitcnt vmcnt(" #n ")" ::: "memory")
#define PG_WAIT_L(n) asm volatile("s_waitcnt lgkmcnt(" #n ")" ::: "memory")
#define PG_BAR __builtin_amdgcn_s_barrier()
    f32x4 acc[2][2][4][2];
#pragma unroll
    for (int a = 0; a < 2; ++a)
#pragma unroll
        for (int b = 0; b < 2; ++b)
#pragma unroll
            for (int m = 0; m < 4; ++m)
#pragma unroll
                for (int n = 0; n < 2; ++n) acc[a][b][m][n] = (f32x4){0.f, 0.f, 0.f, 0.f};
    bf16x8 At[4][2], B0[2][2], B1[2][2];
    const char* cA = (const char*)A; const char* cB = (const char*)Bt;
    PG_STAGE(PG_SB(0, 0), cB); PG_STAGE(PG_SA(0, 0), cA); PG_STAGE(PG_SB(0, 1), cB + hstep); PG_STAGE(PG_SA(0, 1), cA + hstep);
    if (wr == 1) PG_BAR;
    PG_WAIT_V(4); PG_BAR;
    PG_STAGE(PG_SB(1, 0), cB + kstep); PG_STAGE(PG_SA(1, 0), cA + kstep); PG_STAGE(PG_SB(1, 1), cB + hstep + kstep);
    PG_WAIT_V(6); PG_BAR;
    for (int t = 0; t < nt; t += 2) {
        const bool last = (t == nt - 2);
        const char* a1 = cA + (size_t)(t + 1) * kstep;
        const char* a2 = cA + (size_t)(t + 2) * kstep; const char* b2 = cB + (size_t)(t + 2) * kstep;
        const char* a3 = a2 + kstep; const char* b3 = b2 + kstep;
        if (MID && t == (nt >> 1)) E.mid(acc, wr, wc, fr, fq);
        PG_LDB(B0, 0, 0); SBAR(); PG_LDA(At, 0, 0); PG_STAGE(PG_SA(1, 1), a1 + hstep);
        PG_WAIT_L(8); PG_BAR; PG_WAIT_L(0); PG_MMA(0, 0, At, B0); PG_BAR; SBAR();
        PG_LDB(B1, 0, 1); if (!last) PG_STAGE(PG_SB(0, 0), b2);
        PG_BAR; PG_WAIT_L(0); PG_MMA(0, 1, At, B1); PG_BAR;
        PG_LDA(At, 0, 1); if (!last) PG_STAGE(PG_SA(0, 0), a2);
        PG_BAR; PG_WAIT_L(0); PG_MMA(1, 0, At, B0); PG_BAR; SBAR();
        if (!last) { PG_STAGE(PG_SB(0, 1), b2 + hstep); PG_WAIT_V(6); } else PG_WAIT_V(0);
        PG_BAR; PG_MMA(1, 1, At, B1); PG_BAR;
        PG_LDB(B0, 1, 0); SBAR(); PG_LDA(At, 1, 0); if (!last) PG_STAGE(PG_SA(0, 1), a2 + hstep);
        PG_WAIT_L(8); PG_BAR; PG_WAIT_L(0); PG_MMA(0, 0, At, B0); PG_BAR; SBAR();
        PG_LDB(B1, 1, 1); if (!last) PG_STAGE(PG_SB(1, 0), b3);
        PG_BAR; PG_WAIT_L(0); PG_MMA(0, 1, At, B1); PG_BAR;
        PG_LDA(At, 1, 1); if (!last) PG_STAGE(PG_SA(1, 0), a3);
        PG_BAR; PG_WAIT_L(0); PG_MMA(1, 0, At, B0); PG_BAR; SBAR();
        if (!last) { PG_STAGE(PG_SB(1, 1), b3 + hstep); PG_WAIT_V(6); }
        PG_BAR; PG_MMA(1, 1, At, B1); PG_BAR;
    }
    E.fin(acc, wr, wc, fr, fq);
    PG_WAIT_V(0);
    if (wr == 0) PG_BAR;
    PG_BAR;
#undef PG_SA
#undef PG_SB
#undef PG_STAGE
#undef PG_LDA
#undef PG_LDB
#undef PG_MMA
#undef PG_WAIT_V
#undef PG_WAIT_L
#undef PG_BAR
}

#define PG_ROW(ai, m) (128 * (ai) + 64 * wr + 16 * (m) + fr)
#define PG_COL(bj, n) (128 * (bj) + 64 * (wc >> 1) + 32 * (n) + 16 * (wc & 1) + 4 * fq)
struct PEpiProj {
    int pn, brow; unsigned char* ws; const float *qg, *kvg;
    __device__ __forceinline__ void mid(f32x4 (&)[2][2][4][2], int, int, int, int) {}
    __device__ __forceinline__ void fin(f32x4 (&acc)[2][2][4][2], int wr, int wc, int fr, int fq) {
        if (pn < 6) {
            bf16_t* dst; int ldd, c0;
            if (pn < 4) { dst = (bf16_t*)(ws + WS_QA); ldd = 1024; c0 = pn * 256; } else if (pn == 4) { dst = (bf16_t*)(ws + WS_KA); ldd = 256; c0 = 0; } else { dst = (bf16_t*)(ws + WS_VA); ldd = 256; c0 = 0; }
#pragma unroll
            for (int ai = 0; ai < 2; ++ai)
#pragma unroll
                for (int m = 0; m < 4; ++m) { bf16_t* rowp = dst + (size_t)(brow + PG_ROW(ai, m)) * ldd + c0;
#pragma unroll
                    for (int bj = 0; bj < 2; ++bj)
#pragma unroll
                        for (int n = 0; n < 2; ++n) { const f32x4 v = acc[ai][bj][m][n]; *(u32x2*)(rowp + PG_COL(bj, n)) = (u32x2){pk_bf16(v[0], v[1]), pk_bf16(v[2], v[3])}; } }
        } else if (pn < 9) {
            bf16_t* dst; int ldd, c0; const float* g; float* ssq; int nsl, sl0;
            if (pn < 8) { dst = (bf16_t*)(ws + WS_CQ); ldd = 512; c0 = (pn - 6) * 256; g = qg; ssq = (float*)(ws + WS_SSQC); nsl = 16; sl0 = (pn - 6) * 8 + wc; }
            else { dst = (bf16_t*)(ws + WS_CKV); ldd = 256; c0 = 0; g = kvg; ssq = (float*)(ws + WS_SSQK); nsl = 8; sl0 = wc; }
            f32x4 gvv[2][2];
#pragma unroll
            for (int bj = 0; bj < 2; ++bj)
#pragma unroll
                for (int n = 0; n < 2; ++n) gvv[bj][n] = *(const f32x4*)(g + c0 + PG_COL(bj, n));
#pragma unroll
            for (int ai = 0; ai < 2; ++ai)
#pragma unroll
                for (int m = 0; m < 4; ++m) { const int row = brow + PG_ROW(ai, m);
#pragma unroll
                    for (int bj = 0; bj < 2; ++bj) { float ss = 0.f;
#pragma unroll
                        for (int n = 0; n < 2; ++n) { const f32x4 v = acc[ai][bj][m][n]; const f32x4 gv = gvv[bj][n];
                            ss += v[0] * v[0] + v[1] * v[1] + v[2] * v[2] + v[3] * v[3];
                            *(u32x2*)(dst + (size_t)row * ldd + c0 + PG_COL(bj, n)) = (u32x2){pk_bf16(v[0] * gv[0], v[1] * gv[1]), pk_bf16(v[2] * gv[2], v[3] * gv[3])}; }
                        ss += __shfl_xor(ss, 16, 64); ss += __shfl_xor(ss, 32, 64);
                        if (fq == 0) ssq[(size_t)row * nsl + sl0 + 4 * bj] = ss; } }
        } else {
            if (wc < 2) {
                bf16_t* dst = (bf16_t*)(ws + WS_KPE); const float* rope = (const float*)(ws + WS_ROPE); const int i0 = 16 * wc + 4 * fq;
#pragma unroll
                for (int ai = 0; ai < 2; ++ai)
#pragma unroll
                    for (int m = 0; m < 4; ++m) { const int row = brow + PG_ROW(ai, m); const int pos = row & (SEQ - 1); const f32x4 x1 = acc[ai][0][m][0], x2 = acc[ai][0][m][1];
                        const f32x4 cs0 = *(const f32x4*)(rope + ((size_t)pos * 32 + i0) * 2), cs1 = *(const f32x4*)(rope + ((size_t)pos * 32 + i0) * 2 + 4);
                        const float c[4] = {cs0[0], cs0[2], cs1[0], cs1[2]}, s[4] = {cs0[1], cs0[3], cs1[1], cs1[3]};
                        float o1[4], o2[4];
#pragma unroll
                        for (int j = 0; j < 4; ++j) { o1[j] = x1[j] * c[j] - x2[j] * s[j]; o2[j] = x1[j] * s[j] + x2[j] * c[j]; }
                        *(u32x2*)(dst + (size_t)row * 64 + i0) = (u32x2){pk_bf16(o1[0], o1[1]), pk_bf16(o1[2], o1[3])};
                        *(u32x2*)(dst + (size_t)row * 64 + 32 + i0) = (u32x2){pk_bf16(o2[0], o2[1]), pk_bf16(o2[2], o2[3])}; }
            }
        }
    }
};
struct PEpiQUp {
    int pn, brow; unsigned char* ws;
    __device__ __forceinline__ void mid(f32x4 (&)[2][2][4][2], int, int, int, int) {}
    __device__ __forceinline__ void fin(f32x4 (&acc)[2][2][4][2], int wr, int wc, int fr, int fq) {
        bf16_t* dst = (bf16_t*)(ws + WS_QB); const float* rope = (const float*)(ws + WS_ROPE);
        float rs[2][4];
#pragma unroll
        for (int ai = 0; ai < 2; ++ai)
#pragma unroll
            for (int m = 0; m < 4; ++m) { const f32x4* pp = (const f32x4*)((const float*)(ws + WS_SSQC) + (size_t)(brow + PG_ROW(ai, m)) * 16); const f32x4 p0 = pp[0], p1 = pp[1], p2 = pp[2], p3 = pp[3];
                const float sq = (((p0[0] + p0[1]) + (p0[2] + p0[3])) + ((p1[0] + p1[1]) + (p1[2] + p1[3]))) + (((p2[0] + p2[1]) + (p2[2] + p2[3])) + ((p3[0] + p3[1]) + (p3[2] + p3[3])));
                rs[ai][m] = rsqrtf(sq * (1.f / 512.f) + EPS); }
#pragma unroll
        for (int bj = 0; bj < 2; ++bj) { const int seg = pn * 4 + 2 * bj + (wc >> 1), head = seg / 3, part = seg - head * 3; const int i0 = 16 * (wc & 1) + 4 * fq;
#pragma unroll
            for (int ai = 0; ai < 2; ++ai)
#pragma unroll
                for (int m = 0; m < 4; ++m) { const int row = brow + PG_ROW(ai, m); const float r = rs[ai][m]; bf16_t* drow = dst + (size_t)row * 1536 + head * 192 + part * 64;
                    const f32x4 x1 = acc[ai][bj][m][0], x2 = acc[ai][bj][m][1];
                    if (part < 2) {
                        *(u32x2*)(drow + i0) = (u32x2){pk_bf16(x1[0] * r, x1[1] * r), pk_bf16(x1[2] * r, x1[3] * r)};
                        *(u32x2*)(drow + 32 + i0) = (u32x2){pk_bf16(x2[0] * r, x2[1] * r), pk_bf16(x2[2] * r, x2[3] * r)};
                    } else { const int pos = row & (SEQ - 1);
                        const f32x4 cs0 = *(const f32x4*)(rope + ((size_t)pos * 32 + i0) * 2), cs1 = *(const f32x4*)(rope + ((size_t)pos * 32 + i0) * 2 + 4);
                        const float c[4] = {cs0[0], cs0[2], cs1[0], cs1[2]}, s[4] = {cs0[1], cs0[3], cs1[1], cs1[3]};
                        float o1[4], o2[4];
#pragma unroll
                        for (int j = 0; j < 4; ++j) { o1[j] = (x1[j] * c[j] - x2[j] * s[j]) * r; o2[j] = (x1[j] * s[j] + x2[j] * c[j]) * r; }
                        *(u32x2*)(drow + i0) = (u32x2){pk_bf16(o1[0], o1[1]), pk_bf16(o1[2], o1[3])};
                        *(u32x2*)(drow + 32 + i0) = (u32x2){pk_bf16(o2[0], o2[1]), pk_bf16(o2[2], o2[3])}; } } }
    }
};
struct PEpiKvUp {
    int pn, brow; unsigned char* ws;
    __device__ __forceinline__ void mid(f32x4 (&)[2][2][4][2], int, int, int, int) {}
    __device__ __forceinline__ void fin(f32x4 (&acc)[2][2][4][2], int wr, int wc, int fr, int fq) {
        bf16_t* dst = (bf16_t*)(ws + WS_KVB);
#pragma unroll
        for (int ai = 0; ai < 2; ++ai)
#pragma unroll
            for (int m = 0; m < 4; ++m) { const int row = brow + PG_ROW(ai, m); const f32x4* pp = (const f32x4*)((const float*)(ws + WS_SSQK) + (size_t)row * 8); const f32x4 p0 = pp[0], p1 = pp[1];
                const float r = rsqrtf((((p0[0] + p0[1]) + (p0[2] + p0[3])) + ((p1[0] + p1[1]) + (p1[2] + p1[3]))) * (1.f / 256.f) + EPS);
#pragma unroll
                for (int bj = 0; bj < 2; ++bj)
#pragma unroll
                    for (int n = 0; n < 2; ++n) { const f32x4 v = acc[ai][bj][m][n];
                        *(u32x2*)(dst + (size_t)row * 2048 + pn * 256 + PG_COL(bj, n)) = (u32x2){pk_bf16(v[0] * r, v[1] * r), pk_bf16(v[2] * r, v[3] * r)}; } }
    }
};
struct PEpiWo {
    int pn, brow; unsigned char* ws; const float* x; const LAS float* tab;
    __device__ __forceinline__ void mid(f32x4 (&acc)[2][2][4][2], int wr, int wc, int fr, int fq) {
#pragma unroll
        for (int ai = 0; ai < 2; ++ai)
#pragma unroll
            for (int m = 0; m < 4; ++m) { const int r = PG_ROW(ai, m);
                const float f = __builtin_amdgcn_sqrtf((tab[256 + r] + EPS) * __builtin_amdgcn_rcpf(tab[r] + EPS));
#pragma unroll
                for (int bj = 0; bj < 2; ++bj)
#pragma unroll
                    for (int n = 0; n < 2; ++n) acc[ai][bj][m][n] *= f; }
        asm volatile("s_waitcnt lgkmcnt(0)" ::: "memory"); SBAR();
    }
    __device__ __forceinline__ void fin(f32x4 (&acc)[2][2][4][2], int wr, int wc, int fr, int fq) {
        float* x2 = (float*)(ws + WS_X2);
#pragma unroll
        for (int ai = 0; ai < 2; ++ai)
#pragma unroll
            for (int m = 0; m < 4; ++m) { const int r = PG_ROW(ai, m); const size_t o = (size_t)(brow + r) * D_MODEL + pn * 256; const float rbm = rsqrtf(tab[256 + r] + EPS); f32x4 xv[2][2];
#pragma unroll
                for (int bj = 0; bj < 2; ++bj)
#pragma unroll
                    for (int n = 0; n < 2; ++n) xv[bj][n] = *(const f32x4*)(x + o + PG_COL(bj, n));
#pragma unroll
                for (int bj = 0; bj < 2; ++bj)
#pragma unroll
                    for (int n = 0; n < 2; ++n) *(f32x4*)(x2 + o + PG_COL(bj, n)) = acc[ai][bj][m][n] * rbm + xv[bj][n]; }
    }
};
__device__ __forceinline__ void pg_convert(const float* W, int K, int ld, int ncols, int nrows, bf16_t* Bt, int item0, int nitems_stride) {
    const int total = nrows * (K >> 3);
    for (int it0 = item0; it0 < total; it0 += 4 * nitems_stride) { float v[4][8]; int row[4], k0[4]; bool ok[4];
#pragma unroll
        for (int b = 0; b < 4; ++b) { const int it = it0 + b * nitems_stride; const int itc = it < total ? it : item0; const int kc = itc / nrows; row[b] = itc - kc * nrows; k0[b] = kc << 3; ok[b] = it < total;
            const int col = (row[b] & ~255) + pg_tcol(row[b] & 255); const int colc = col < ncols ? col : 0; const float s = col < ncols ? 1.f : 0.f;
#pragma unroll
            for (int q = 0; q < 8; ++q) v[b][q] = W[(size_t)(k0[b] + q) * ld + colc] * s; }
#pragma unroll
        for (int b = 0; b < 4; ++b) if (ok[b])
            *(u32x4*)(Bt + (size_t)row[b] * K + k0[b]) = (u32x4){pk_bf16(v[b][0], v[b][1]), pk_bf16(v[b][2], v[b][3]), pk_bf16(v[b][4], v[b][5]), pk_bf16(v[b][6], v[b][7])}; }
}
__device__ __forceinline__ void sincos_d(double x, double& s, double& c) {
    const double k = __builtin_rint(x * 0.63661977236758134308);
    double r = __builtin_fma(-k, 1.57079632679489655800e+00, x); r = __builtin_fma(-k, 6.12323399573676603587e-17, r);
    const double r2 = r * r;
    double sp = -7.6471637318198164759e-13; sp = sp * r2 + 1.6059043836821614599e-10; sp = sp * r2 - 2.5052108385441718775e-08; sp = sp * r2 + 2.7557319223985890653e-06;
    sp = sp * r2 - 1.9841269841269841270e-04; sp = sp * r2 + 8.3333333333333333333e-03; sp = sp * r2 - 1.6666666666666666667e-01; const double sn = r + r * r2 * sp;
    double cp = 4.7794773323873852974e-14; cp = cp * r2 - 1.1470745597729724714e-11; cp = cp * r2 + 2.0876756987868098979e-09; cp = cp * r2 - 2.7557319223985890653e-07;
    cp = cp * r2 + 2.4801587301587301587e-05; cp = cp * r2 - 1.3888888888888888889e-03; cp = cp * r2 + 4.1666666666666666667e-02; cp = cp * r2 - 0.5; const double cn = 1.0 + r2 * cp;
    const int q = ((int)k) & 3;
    s = (q == 0) ? sn : (q == 1) ? cn : (q == 2) ? -sn : -cn;
    c = (q == 0) ? cn : (q == 1) ? -sn : (q == 2) ? -cn : sn;
}

__device__ __forceinline__ void phase_prologue(const Params& p) {
    const int tid = threadIdx.x, wid = tid >> 6, lane = tid & 63;
    bf16_t* xn = (bf16_t*)(p.ws + WS_XN);
    for (int row = blockIdx.x * 8 + wid; row < NTOK; row += gridDim.x * 8) {
        const f32x4* xr = (const f32x4*)(p.x + (size_t)row * D_MODEL); f32x4 v[8]; float ss = 0.f;
#pragma unroll
        for (int i = 0; i < 8; ++i) { v[i] = xr[lane + 64 * i]; ss += v[i][0] * v[i][0] + v[i][1] * v[i][1] + v[i][2] * v[i][2] + v[i][3] * v[i][3]; }
        ss = wave_sum(ss); const float rs = rsqrtf(ss * (1.f / D_MODEL) + EPS);
#pragma unroll
        for (int i = 0; i < 8; ++i) { const f32x4 g = ((const f32x4*)p.attn_norm)[lane + 64 * i];
            *(u32x2*)(xn + (size_t)row * D_MODEL + 4 * (lane + 64 * i)) = (u32x2){pk_bf16(v[i][0] * rs * g[0], v[i][1] * rs * g[1]), pk_bf16(v[i][2] * rs * g[2], v[i][3] * rs * g[3])}; }
    }
    const int gtid = blockIdx.x * 512 + tid;
    if (gtid < SEQ * 32) {
        const int pos = gtid >> 5, i = gtid & 31;
        double b = 10000.0; for (int q = 0; q < 5; ++q) b = __builtin_sqrt(b);
        double f = 1.0; for (int q = 0; q < i; ++q) f *= b;
        const float inv_freq = (float)(1.0 / f); const float ang = (float)pos * inv_freq;
        double s, c; sincos_d((double)ang, s, c);
        float* rope = (float*)(p.ws + WS_ROPE); rope[(size_t)gtid * 2] = (float)c; rope[(size_t)gtid * 2 + 1] = (float)s;
    }
    {
        const int nth = gridDim.x * 512;
        pg_convert(p.w_in, D_MODEL, IN_COLS, IN_COLS, 2560, (bf16_t*)(p.ws + WS_BT_IN), gtid, nth);
        pg_convert(p.b_w_uq, 512, 1536, 1536, 1536, (bf16_t*)(p.ws + WS_BT_UQ), gtid, nth);
    }
    if (gtid < N_EXP * D_MODEL) {
        ((float*)(p.ws + WS_WRT))[gtid] = p.w_router[gtid] * p.mlp_norm[gtid >> 5];
    }
}

constexpr int AA_PITCH = 144;
constexpr int AA_K = 0, AA_V = 384 * AA_PITCH;
constexpr int AA_WS = 2 * 384 * AA_PITCH;
__device__ __forceinline__ void attn_a_unit(const Params& p, LAS char* lds, int u) {
    const int tid = threadIdx.x, wid = __builtin_amdgcn_readfirstlane(tid >> 6), lane = tid & 63, r32 = lane & 31, hi = lane >> 5;
    const int b = u >> 7, nq = (u >> 2) & 31, kvh = u & 3;
    const bf16_t* QA = (const bf16_t*)(p.ws + WS_QA); const bf16_t* KA = (const bf16_t*)(p.ws + WS_KA); const bf16_t* VA = (const bf16_t*)(p.ws + WS_VA);
    const int P0 = (nq - 1) * 128;
    __syncthreads();
    for (int c = tid; c < 384 * 8; c += 512) { const int r = c >> 3, ch = c & 7; const int pos = P0 + r;
        i32x4 kv = {0, 0, 0, 0}, vv = {0, 0, 0, 0};
        if (pos >= 0 && pos < SEQ) { const size_t g = ((size_t)(b * SEQ + pos)) * 256 + kvh * 64 + ch * 8; kv = *(const i32x4*)(KA + g); vv = *(const i32x4*)(VA + g); }
        *(LAS i32x4*)(lds + AA_K + r * AA_PITCH + ch * 16) = kv; *(LAS i32x4*)(lds + AA_V + r * AA_PITCH + ch * 16) = vv; }
    __syncthreads();
    LAS float* wsf = (LAS float*)(lds + AA_WS) + wid * 64;
    const int hq = kvh * 4 + (wid >> 1);
    const float slope2 = __builtin_amdgcn_exp2f(-8.f * (float)(hq + 1) / 16.f) * LOG2E;
    const float sink2 = p.a_sink[hq] * LOG2E;
    const float C = 0.125f * LOG2E;
    const float* ga = p.out_norm_a + hq * 64;
    bf16_t* Y = (bf16_t*)(p.ws + WS_Y); float* ssqa = (float*)(p.ws + WS_SSQP);
    for (int blk = 0; blk < 2; ++blk) {
        const int q0 = nq * 128 + (wid & 1) * 64 + blk * 32;
        const int tq = q0 + r32;
        bf16x8 qr[4];
        { const bf16_t* qp = QA + ((size_t)(b * SEQ + tq)) * 1024 + hq * 64 + hi * 8;
#pragma unroll
          for (int d0 = 0; d0 < 4; ++d0) qr[d0] = *(const bf16x8*)(qp + d0 * 16); }
        float m_reg = sink2, l_reg = 1.f; f32x16 o[2] = {};
        for (int jt = 0; jt < 6; ++jt) {
            const int kp0 = P0 + jt * 64;
            if (kp0 + 63 < q0 - 128 || kp0 > q0 + 31 + 128 || kp0 + 63 < 0 || kp0 >= SEQ) continue;
            f32x16 p0 = {}, p1 = {};
#pragma unroll
            for (int d0 = 0; d0 < 4; ++d0) {
                const bf16x8 k0 = *(const LAS bf16x8*)(lds + AA_K + (jt * 64 + r32) * AA_PITCH + (d0 * 16 + hi * 8) * 2);
                const bf16x8 k1 = *(const LAS bf16x8*)(lds + AA_K + (jt * 64 + 32 + r32) * AA_PITCH + (d0 * 16 + hi * 8) * 2);
                p0 = __builtin_amdgcn_mfma_f32_32x32x16_bf16(k0, qr[d0], p0, 0, 0, 0);
                p1 = __builtin_amdgcn_mfma_f32_32x32x16_bf16(k1, qr[d0], p1, 0, 0, 0);
            }
            float pmax = -1e30f;
#pragma unroll
            for (int r = 0; r < 16; ++r) {
                { const int kp = kp0 + crow(r, hi); const int dist = tq > kp ? tq - kp : kp - tq; const bool ok = dist <= 128 && kp >= 0 && kp < SEQ;
                  p0[r] = ok ? p0[r] * C - slope2 * (float)dist : -1e30f; pmax = fmaxf(pmax, p0[r]); }
                { const int kp = kp0 + 32 + crow(r, hi); const int dist = tq > kp ? tq - kp : kp - tq; const bool ok = dist <= 128 && kp >= 0 && kp < SEQ;
                  p1[r] = ok ? p1[r] * C - slope2 * (float)dist : -1e30f; pmax = fmaxf(pmax, p1[r]); }
            }
            { auto rr = __builtin_amdgcn_permlane32_swap(__float_as_uint(pmax), __float_as_uint(pmax), false, false); pmax = fmaxf(__uint_as_float(rr[0]), __uint_as_float(rr[1])); }
            const float mn = fmaxf(m_reg, pmax); const float alpha = __builtin_amdgcn_exp2f(m_reg - mn); m_reg = mn;
            float ps = 0.f;
#pragma unroll
            for (int r = 0; r < 16; ++r) { p0[r] = __builtin_amdgcn_exp2f(p0[r] - mn); p1[r] = __builtin_amdgcn_exp2f(p1[r] - mn); ps += p0[r] + p1[r]; }
            { auto rr = __builtin_amdgcn_permlane32_swap(__float_as_uint(ps), __float_as_uint(ps), false, false); ps = __uint_as_float(rr[0]) + __uint_as_float(rr[1]); }
            l_reg = l_reg * alpha + ps;
            if (hi == 0) wsf[r32] = alpha;
            WAIT_L0();
#pragma unroll
            for (int r = 0; r < 16; ++r) { const float a = wsf[crow(r, hi)]; o[0][r] *= a; o[1][r] *= a; }
            bf16x8 pa[4];
#define PK4(P, BASE, OUT) do { unsigned a0 = pk_bf16(P[BASE + 0], P[BASE + 1]), a1 = pk_bf16(P[BASE + 2], P[BASE + 3]); \
    unsigned b0 = pk_bf16(P[BASE + 4], P[BASE + 5]), b1 = pk_bf16(P[BASE + 6], P[BASE + 7]); \
    auto r0_ = __builtin_amdgcn_permlane32_swap(a0, b0, false, false); auto r1_ = __builtin_amdgcn_permlane32_swap(a1, b1, false, false); \
    u32x4 w_ = {r0_[0], r1_[0], r0_[1], r1_[1]}; OUT = __builtin_bit_cast(bf16x8, w_); } while (0)
            PK4(p0, 0, pa[0]); PK4(p0, 8, pa[1]); PK4(p1, 0, pa[2]); PK4(p1, 8, pa[3]);
            const int g16 = (lane >> 4) & 1, qq = (lane & 15) >> 2, pp = lane & 3;
#pragma unroll
            for (int db = 0; db < 2; ++db) {
#pragma unroll
                for (int ks = 0; ks < 4; ++ks) {
                    const LAS char* vp = lds + AA_V + (jt * 64 + ks * 16 + 8 * hi + qq) * AA_PITCH + (db * 32 + 16 * g16 + 4 * pp) * 2;
                    const s16x4 lo = vtr(vp), hh = vtr(vp + 4 * AA_PITCH);
                    const bf16x8 vb = (bf16x8){lo[0], lo[1], lo[2], lo[3], hh[0], hh[1], hh[2], hh[3]};
                    o[db] = __builtin_amdgcn_mfma_f32_32x32x16_bf16(pa[ks], vb, o[db], 0, 0, 0);
                }
            }
            WAIT_L0();
        }
        if (hi == 0) wsf[r32] = 1.f / l_reg;
        WAIT_L0();
        const float g0 = ga[r32], g1 = ga[32 + r32];
#pragma unroll
        for (int r = 0; r < 16; ++r) { const int qrow = crow(r, hi); const float il = wsf[qrow]; const float v0 = o[0][r] * il, v1 = o[1][r] * il;
            const size_t tok = (size_t)(b * SEQ + q0 + qrow);
            bf16_t* yp = Y + tok * 2048 + hq * 64;
            yp[r32] = (bf16_t)(pk_bf16(v0 * g0, 0.f) & 0xffffu); yp[32 + r32] = (bf16_t)(pk_bf16(v1 * g1, 0.f) & 0xffffu);
            float ss = v0 * v0 + v1 * v1;
#pragma unroll
            for (int s = 16; s >= 1; s >>= 1) ss += __shfl_xor(ss, s, 64);
            if (r32 == 0) ssqa[tok * 24 + hq] = ss; }
        WAIT_L0();
    }
}

constexpr int MB_V = 0, MB_KN = 32768, MB_KP = 65536, MB_WS = 81920, MB_QP = 83968;
#define KSWZ(row, colB) ((row) * 256 + ((colB) ^ (((row) & 7) << 4)))
#define KPSWZ(row, colB) ((row) * 128 + ((colB) ^ (((row) & 7) << 4)))
constexpr float MLA_SCALE = 0.07216878364870322f;
constexpr float MLA_THR = 8.f;
__device__ __forceinline__ void mla_partialSM(f32x16& p0, f32x16& p1, float& m_reg, float& mn, float& alpha) {
    constexpr float C = MLA_SCALE * LOG2E;
    float pmax = p0[0];
#pragma unroll
    for (int r = 1; r < 16; ++r) pmax = fmaxf(pmax, p0[r]);
#pragma unroll
    for (int r = 0; r < 16; ++r) pmax = fmaxf(pmax, p1[r]);
    { auto rr = __builtin_amdgcn_permlane32_swap(__float_as_uint(pmax), __float_as_uint(pmax), false, false); pmax = fmaxf(__uint_as_float(rr[0]), __uint_as_float(rr[1])); }
    if (__builtin_expect(__all(pmax - m_reg <= MLA_THR / MLA_SCALE), 1)) { mn = m_reg; alpha = 1.f; }
    else { mn = fmaxf(m_reg, pmax); alpha = __builtin_amdgcn_exp2f((m_reg - mn) * C); m_reg = mn; }
    const float mnC = -mn * C;
#pragma unroll
    for (int r = 0; r < 16; ++r) p0[r] = fmaf(p0[r], C, mnC);
#pragma unroll
    for (int r = 0; r < 16; ++r) p1[r] = fmaf(p1[r], C, mnC);
#pragma unroll
    for (int r = 0; r < 16; ++r) p0[r] = __builtin_amdgcn_exp2f(p0[r]);
}
__device__ __forceinline__ void mla_finishSM(f32x16& p0, f32x16& p1, float alpha, float& l_reg, bf16x8& pa0, bf16x8& pa1, bf16x8& pa2, bf16x8& pa3) {
#pragma unroll
    for (int r = 0; r < 16; ++r) p1[r] = __builtin_amdgcn_exp2f(p1[r]);
    float ps = 0;
#pragma unroll
    for (int r = 0; r < 16; ++r) ps += p0[r];
#pragma unroll
    for (int r = 0; r < 16; ++r) ps += p1[r];
    { auto rr = __builtin_amdgcn_permlane32_swap(__float_as_uint(ps), __float_as_uint(ps), false, false); ps = __uint_as_float(rr[0]) + __uint_as_float(rr[1]); }
    l_reg = l_reg * alpha + ps;
    PK4(p0, 0, pa0); PK4(p0, 8, pa1); PK4(p1, 0, pa2); PK4(p1, 8, pa3);
}
__device__ __forceinline__ void mla_qkt(f32x16& p0, f32x16& p1, const LAS char* Kn, const LAS char* Kp, const bf16x8* qr, const LAS char* qp, int r32, int hi) {
    p0 = f32x16{}; p1 = f32x16{};
#pragma unroll
    for (int d0 = 0; d0 < 8; ++d0) { const int cb = (d0 * 16 + hi * 8) * 2;
        const bf16x8 b0 = *(const LAS bf16x8*)(Kn + KSWZ(r32, cb)); const bf16x8 b1 = *(const LAS bf16x8*)(Kn + KSWZ(32 + r32, cb));
        p0 = __builtin_amdgcn_mfma_f32_32x32x16_bf16(b0, qr[d0], p0, 0, 0, 0); p1 = __builtin_amdgcn_mfma_f32_32x32x16_bf16(b1, qr[d0], p1, 0, 0, 0); }
#pragma unroll
    for (int d0 = 0; d0 < 4; ++d0) { const int cb = (d0 * 16 + hi * 8) * 2;
        const bf16x8 b0 = *(const LAS bf16x8*)(Kp + KPSWZ(r32, cb)); const bf16x8 b1 = *(const LAS bf16x8*)(Kp + KPSWZ(32 + r32, cb));
        const bf16x8 q = *(const LAS bf16x8*)(qp + d0 * 1024);
        p0 = __builtin_amdgcn_mfma_f32_32x32x16_bf16(b0, q, p0, 0, 0, 0); p1 = __builtin_amdgcn_mfma_f32_32x32x16_bf16(b1, q, p1, 0, 0, 0); }
}
__device__ __forceinline__ int v_st(int k, int c) { const int kk = (k & ~0xC) | ((k & 4) << 1) | ((k & 8) >> 1); return ((kk >> 3) * 4 + (c >> 5)) * 512 + ((kk & 7) * 32 + (c & 31)) * 2; }
__device__ __forceinline__ int v_rd_base(int lane) { return ((lane & 3) << 3) | (((lane >> 2) & 3) << 6) | (((lane >> 4) & 1) << 5) | (((lane >> 5) & 1) << 8); }
constexpr int v_rd_off(int d0, int ks, int half) { return d0 * 512 + ks * 4096 + half * 2048; }
template <int D0> __device__ __forceinline__ void mla_pv_one(f32x16& od, const LAS char* vb, bf16x8 pa0, bf16x8 pa1, bf16x8 pa2, bf16x8 pa3) {
    const s16x4 l0 = vtr(vb + v_rd_off(D0, 0, 0)), h0 = vtr(vb + v_rd_off(D0, 0, 1)), l1 = vtr(vb + v_rd_off(D0, 1, 0)), h1 = vtr(vb + v_rd_off(D0, 1, 1));
    const s16x4 l2 = vtr(vb + v_rd_off(D0, 2, 0)), h2 = vtr(vb + v_rd_off(D0, 2, 1)), l3 = vtr(vb + v_rd_off(D0, 3, 0)), h3 = vtr(vb + v_rd_off(D0, 3, 1));
#define PKV(L, H) (bf16x8){L[0], L[1], L[2], L[3], H[0], H[1], H[2], H[3]}
    od = __builtin_amdgcn_mfma_f32_32x32x16_bf16(pa0, PKV(l0, h0), od, 0, 0, 0);
    od = __builtin_amdgcn_mfma_f32_32x32x16_bf16(pa1, PKV(l1, h1), od, 0, 0, 0);
    od = __builtin_amdgcn_mfma_f32_32x32x16_bf16(pa2, PKV(l2, h2), od, 0, 0, 0);
    od = __builtin_amdgcn_mfma_f32_32x32x16_bf16(pa3, PKV(l3, h3), od, 0, 0, 0);
#undef PKV
}
__device__ __forceinline__ void mla_pv(f32x16* o, const LAS char* vb, bf16x8 pa0, bf16x8 pa1, bf16x8 pa2, bf16x8 pa3) {
    mla_pv_one<0>(o[0], vb, pa0, pa1, pa2, pa3); mla_pv_one<1>(o[1], vb, pa0, pa1, pa2, pa3); mla_pv_one<2>(o[2], vb, pa0, pa1, pa2, pa3); mla_pv_one<3>(o[3], vb, pa0, pa1, pa2, pa3);
}
__device__ __forceinline__ void mla_unit(const Params& p, LAS char* lds, int u) {
    const int tid = threadIdx.x, wid = __builtin_amdgcn_readfirstlane(tid >> 6), lane = tid & 63, r32 = lane & 31, hi = lane >> 5;
    const int bh = u >> 4, qb = u & 15, b = bh >> 3, h = bh & 7;
    const bf16_t* QB = (const bf16_t*)(p.ws + WS_QB); const bf16_t* KVB = (const bf16_t*)(p.ws + WS_KVB); const bf16_t* KPE = (const bf16_t*)(p.ws + WS_KPE);
    const bf16_t* Kh = KVB + (size_t)b * SEQ * 2048 + h * 256;
    const bf16_t* Ph = KPE + (size_t)b * SEQ * 64;
    LAS float* wsf = (LAS float*)(lds + MB_WS) + wid * 64; LAS float* li_l = wsf; LAS float* al_l = wsf + 32;
    float m_reg = -1e30f, l_reg = 0; f32x16 o[4] = {}; bf16x8 qr[8];
    LAS char* qp = lds + MB_QP + wid * 4096 + lane * 16;
    { const bf16_t* Qw = QB + ((size_t)(b * SEQ + qb * 256 + wid * 32 + r32)) * 1536 + h * 192 + hi * 8;
#pragma unroll
      for (int d0 = 0; d0 < 8; ++d0) qr[d0] = *(const bf16x8*)(Qw + d0 * 16);
      __syncthreads();
#pragma unroll
      for (int d0 = 0; d0 < 4; ++d0) *(LAS bf16x8*)(qp + d0 * 1024) = *(const bf16x8*)(Qw + (8 + d0) * 16); }
    const int sr = tid >> 4, sc = (tid & 15) * 8, vst0 = v_st(sr, sc), vst1 = v_st(32 + sr, sc);
    const int pr = tid >> 3, pc = (tid & 7) * 8;
    const LAS char* vb0 = lds + MB_V + v_rd_base(lane);
    bf16x8 vs0, vs1, ks0, ks1, kp0;
#define SLOAD(k0) do { vs0 = *(const bf16x8*)(Kh + (size_t)((k0) + sr) * 2048 + 128 + sc); vs1 = *(const bf16x8*)(Kh + (size_t)((k0) + 32 + sr) * 2048 + 128 + sc); \
    ks0 = *(const bf16x8*)(Kh + (size_t)((k0) + sr) * 2048 + sc); ks1 = *(const bf16x8*)(Kh + (size_t)((k0) + 32 + sr) * 2048 + sc); \
    kp0 = *(const bf16x8*)(Ph + (size_t)((k0) + pr) * 64 + pc); } while (0)
#define SWRITE(bb) do { *(LAS bf16x8*)(lds + MB_V + (bb) * 16384 + vst0) = vs0; *(LAS bf16x8*)(lds + MB_V + (bb) * 16384 + vst1) = vs1; \
    *(LAS bf16x8*)(lds + MB_KN + (bb) * 16384 + KSWZ(sr, sc * 2)) = ks0; *(LAS bf16x8*)(lds + MB_KN + (bb) * 16384 + KSWZ(32 + sr, sc * 2)) = ks1; \
    *(LAS bf16x8*)(lds + MB_KP + (bb) * 8192 + KPSWZ(pr, pc * 2)) = kp0; } while (0)
#define RESC(a) do { if (__any((a) < 1.f)) { if (hi == 0) al_l[r32] = (a); WAIT_L0(); \
    _Pragma("unroll") for (int d = 0; d < 4; ++d) _Pragma("unroll") for (int r = 0; r < 16; ++r) o[d][r] *= al_l[crow(r, hi)]; } } while (0)
    f32x16 pA0, pA1, pB0, pB1; float mnA, mnB, alA, alB; bf16x8 pa0, pa1, pa2, pa3; constexpr int NT = SEQ / 64;
    SLOAD(0); SWRITE(0); __syncthreads();
    mla_qkt(pA0, pA1, lds + MB_KN, lds + MB_KP, qr, qp, r32, hi); mla_partialSM(pA0, pA1, m_reg, mnA, alA);
    SLOAD(64); SWRITE(1); __syncthreads();
    for (int j = 1; j + 1 < NT; j += 2) {
        SBAR(); mla_qkt(pB0, pB1, lds + MB_KN + 16384, lds + MB_KP + 8192, qr, qp, r32, hi);
        mla_finishSM(pA0, pA1, alA, l_reg, pa0, pa1, pa2, pa3); SBAR();
        SLOAD((j + 1) * 64); SBAR();
        mla_pv(o, vb0, pa0, pa1, pa2, pa3); mla_partialSM(pB0, pB1, m_reg, mnB, alB);
        __syncthreads(); SWRITE(0);
        RESC(alB); __syncthreads();
        SBAR(); mla_qkt(pA0, pA1, lds + MB_KN, lds + MB_KP, qr, qp, r32, hi);
        mla_finishSM(pB0, pB1, alB, l_reg, pa0, pa1, pa2, pa3); SBAR();
        SLOAD((j + 2) * 64); SBAR();
        mla_pv(o, vb0 + 16384, pa0, pa1, pa2, pa3); mla_partialSM(pA0, pA1, m_reg, mnA, alA);
        __syncthreads(); SWRITE(1);
        RESC(alA); __syncthreads();
    }
    SBAR(); mla_qkt(pB0, pB1, lds + MB_KN + 16384, lds + MB_KP + 8192, qr, qp, r32, hi);
    mla_finishSM(pA0, pA1, alA, l_reg, pa0, pa1, pa2, pa3); SBAR();
    mla_pv(o, vb0, pa0, pa1, pa2, pa3); mla_partialSM(pB0, pB1, m_reg, mnB, alB);
    __syncthreads(); RESC(alB);
    mla_finishSM(pB0, pB1, alB, l_reg, pa0, pa1, pa2, pa3); SBAR();
    mla_pv(o, vb0 + 16384, pa0, pa1, pa2, pa3);
    if (hi == 0) li_l[r32] = l_reg; WAIT_L0();
    bf16_t* Y = (bf16_t*)(p.ws + WS_Y); float* ssqb = (float*)(p.ws + WS_SSQP);
    const float* gb = p.out_norm_b + h * 128;
    float g[4];
#pragma unroll
    for (int d0 = 0; d0 < 4; ++d0) g[d0] = gb[d0 * 32 + r32];
#pragma unroll
    for (int r = 0; r < 16; ++r) { const int orow = crow(r, hi); const float il = __builtin_amdgcn_rcpf(li_l[orow]);
        const size_t tok = (size_t)(b * SEQ + qb * 256 + wid * 32 + orow); bf16_t* yp = Y + tok * 2048 + 1024 + h * 128; float ss = 0.f;
#pragma unroll
        for (int d0 = 0; d0 < 4; ++d0) { const float v = o[d0][r] * il; ss += v * v; yp[d0 * 32 + r32] = (bf16_t)(pk_bf16(v * g[d0], 0.f) & 0xffffu); }
#pragma unroll
        for (int s = 16; s >= 1; s >>= 1) ss += __shfl_xor(ss, s, 64);
        if (r32 == 0) ssqb[tok * 24 + 16 + h] = ss; }
#undef SLOAD
#undef SWRITE
#undef RESC
}

__device__ __forceinline__ void phase_router(const Params& p, LAS char* lds) {
    const int tid = threadIdx.x, wid = __builtin_amdgcn_readfirstlane(tid >> 6), lane = tid & 63;
    const float* x2 = (const float*)(p.ws + WS_X2); const float* wg = (const float*)(p.ws + WS_WRT);
    unsigned char* xn8 = p.ws + WS_XN; unsigned* cnt = (unsigned*)(p.ws + WS_CTL + CTL_CNT);
    int* tokl = (int*)(p.ws + WS_TOKL); int* sel_e = (int*)(p.ws + WS_SEL); int* sel_r = sel_e + NTOK * 4; float* sel_g = (float*)(sel_r + NTOK * 4);
    LAS float* part = (LAS float*)lds;
    LAS float* rsv = (LAS float*)(lds + 32768);
    LAS unsigned* hist = (LAS unsigned*)(lds + 32768 + 128); LAS unsigned* hbase = hist + 32;
    for (int t0 = blockIdx.x * 32; t0 < NTOK; t0 += gridDim.x * 32) {
        __syncthreads();
        if (tid < N_EXP) hist[tid] = 0u;
#pragma unroll 1
        for (int j = 0; j < 4; ++j) { const int t = t0 + 4 * wid + j; f32x4 xr[8]; float ss = 0.f;
#pragma unroll
            for (int i = 0; i < 8; ++i) { xr[i] = ((const f32x4*)(x2 + (size_t)t * D_MODEL))[lane + 64 * i]; ss += xr[i][0] * xr[i][0] + xr[i][1] * xr[i][1] + xr[i][2] * xr[i][2] + xr[i][3] * xr[i][3]; }
            const float rs = rsqrtf(wave_sum(ss) * (1.f / D_MODEL) + EPS);
            if (lane == 0) rsv[4 * wid + j] = rs;
#pragma unroll
            for (int i = 0; i < 8; ++i) { const f32x4 v = xr[i]; const f32x4 g = ((const f32x4*)p.mlp_norm)[lane + 64 * i]; const float s16 = 16.f * rs;
                *(unsigned*)(xn8 + (size_t)t * D_MODEL + 4 * (lane + 64 * i)) = pk4_fp8(s16 * v[0] * g[0], s16 * v[1] * g[1], s16 * v[2] * g[2], s16 * v[3] * g[3]); } }
        { f32x16 acc;
#pragma unroll
          for (int r = 0; r < 16; ++r) acc[r] = 0.f;
          const float* ap = x2 + (size_t)(t0 + (lane & 31)) * D_MODEL + 256 * wid + 4 * (lane >> 5);
          const float* bp = wg + (size_t)(256 * wid + 4 * (lane >> 5)) * N_EXP + (lane & 31);
#pragma unroll 4
          for (int c = 0; c < 32; ++c) { const f32x4 a4 = *(const f32x4*)(ap + 8 * c);
#pragma unroll
              for (int q = 0; q < 4; ++q) acc = __builtin_amdgcn_mfma_f32_32x32x2f32(a4[q], bp[(size_t)(8 * c + q) * N_EXP], acc, 0, 0, 0); }
#pragma unroll
          for (int r = 0; r < 16; ++r) part[wid * 1024 + crow(r, lane >> 5) * 32 + (lane & 31)] = acc[r]; }
        __syncthreads();
        int my_e[4]; unsigned my_lr[4]; float my_g[4];
#pragma unroll
        for (int j = 0; j < 4; ++j) { const int tl = 4 * wid + j;
            float v = -3.0e38f;
            if (lane < 32) { float s = 0.f;
#pragma unroll
                for (int w = 0; w < 8; ++w) s += part[w * 1024 + tl * 32 + lane];
                v = s * rsv[tl] + p.b_router[lane]; }
            float tv[4]; int ti[4];
#pragma unroll
            for (int r = 0; r < 4; ++r) {
                float bv = v; int bi = lane;
#pragma unroll
                for (int o = 32; o >= 1; o >>= 1) { const float ov = __shfl_xor(bv, o, 64); const int oi = __shfl_xor(bi, o, 64); if (ov > bv || (ov == bv && oi < bi)) { bv = ov; bi = oi; } }
                tv[r] = bv; ti[r] = bi; if (lane == bi) v = -3.0e38f;
            }
            const float e0 = 1.f, e1 = __expf(tv[1] - tv[0]), e2 = __expf(tv[2] - tv[0]), e3 = __expf(tv[3] - tv[0]); const float inv = 1.f / (e0 + e1 + e2 + e3);
            const float gts[4] = {e0 * inv, e1 * inv, e2 * inv, e3 * inv};
            my_e[j] = ti[lane & 3]; my_g[j] = gts[lane & 3]; my_lr[j] = 0u;
            if (lane < 4) my_lr[j] = __hip_atomic_fetch_add(hist + my_e[j], 1u, __ATOMIC_RELAXED, __HIP_MEMORY_SCOPE_WORKGROUP);
        }
        __syncthreads();
        if (tid < N_EXP) hbase[tid] = atomicAdd(cnt + tid * 16, hist[tid]);
        __syncthreads();
        if (lane < 4) {
#pragma unroll
            for (int j = 0; j < 4; ++j) { const int t = t0 + 4 * wid + j; const int e = my_e[j]; const unsigned rk = hbase[e] + my_lr[j];
                tokl[e * NTOK + rk] = t; sel_e[t * 4 + lane] = e; sel_r[t * 4 + lane] = (int)rk; sel_g[t * 4 + lane] = my_g[j]; }
        }
    }
}

__device__ __forceinline__ void phase_combine(const Params& p, const LAS int* s_roff) {
    const int tid = threadIdx.x, wid = tid >> 6, lane = tid & 63;
    const float* x2 = (const float*)(p.ws + WS_X2); const bf16_t* ys = (const bf16_t*)(p.ws + WS_YS);
    const int* sel_e = (const int*)(p.ws + WS_SEL); const int* sel_r = sel_e + NTOK * 4; const float* sel_g = (const float*)(sel_r + NTOK * 4);
    for (int t = blockIdx.x * 8 + wid; t < NTOK; t += gridDim.x * 8) {
        f32x4 v[8];
#pragma unroll
        for (int i = 0; i < 8; ++i) v[i] = ((const f32x4*)(x2 + (size_t)t * D_MODEL))[lane + 64 * i];
#pragma unroll
        for (int k = 0; k < 4; ++k) { const int e = sel_e[t * 4 + k]; const size_t slot = (size_t)(s_roff[e] + sel_r[t * 4 + k]); const float g = sel_g[t * 4 + k];
            const u32x2* yr = (const u32x2*)(ys + slot * D_MODEL);
#pragma unroll
            for (int i = 0; i < 8; ++i) { const u32x2 w = yr[lane + 64 * i]; v[i][0] += g * bf_lo(w[0]); v[i][1] += g * bf_hi(w[0]); v[i][2] += g * bf_lo(w[1]); v[i][3] += g * bf_hi(w[1]); } }
        float ss = 0.f;
#pragma unroll
        for (int i = 0; i < 8; ++i) ss += v[i][0] * v[i][0] + v[i][1] * v[i][1] + v[i][2] * v[i][2] + v[i][3] * v[i][3];
        ss = wave_sum(ss); const float rs = rsqrtf(ss * (1.f / D_MODEL) + EPS);
#pragma unroll
        for (int i = 0; i < 8; ++i) { const f32x4 g = ((const f32x4*)p.final_norm)[lane + 64 * i];
            ((f32x4*)(p.out + (size_t)t * D_MODEL))[lane + 64 * i] = (f32x4){v[i][0] * rs * g[0], v[i][1] * rs * g[1], v[i][2] * rs * g[2], v[i][3] * rs * g[3]}; }
    }
}

constexpr int NPHASE = 9;
__global__ void __launch_bounds__(512, 2) mega_fwd(Params p) {
    extern __shared__ __attribute__((aligned(1024))) char smem_raw[];
    LAS char* lds = (LAS char*)smem_raw;
    LAS unsigned* misc = (LAS unsigned*)(lds + LDS_MISC);
    const int tid = threadIdx.x;
    if (tid < 4) misc[tid] = 0u;
    __syncthreads();
    unsigned* bar = (unsigned*)(p.ws + WS_CTL + CTL_BAR);
    XcdBarrier xb = xcd_barrier_post(bar, (volatile LAS unsigned*)misc);
    const int lo = p.ph_lo, hi = p.ph_hi;
    const int G = gridDim.x, bid = blockIdx.x;
    const int xperm = (bid & 7) * (G >> 3) + (bid >> 3);
#ifdef PH_ONLY
#define IN(k) ((k)==PH_ONLY)
#else
#define IN(k) (lo <= (k) && (k) < hi)
#endif
#define SEAM(k) do { if (IN(k) && IN((k) + 1)) xcd_barrier(xb); } while (0)
    if (IN(0)) phase_prologue(p);
    SEAM(0);
    if (IN(1)) {
        for (int u = xperm; u < 32 * 8; u += G) {
            const int pn = u / 32, pm = u % 32;
            PEpiProj ep{pn, pm * 256, p.ws, p.b_q_norm, p.b_kv_norm};
            __syncthreads();
            gemm_unit_pg<false>(lds, (const bf16_t*)(p.ws + WS_XN) + (size_t)pm * 256 * D_MODEL, (const bf16_t*)(p.ws + WS_BT_IN) + (size_t)pn * 256 * D_MODEL, D_MODEL, ep);
        }
    }
    SEAM(1);
    if (IN(2)) {
        { const int b0 = bid;
            int qv;
            if ((b0 & 3) == 0) {
                const int h = b0 >> 2, pn = 8 + (h >> 5), pm = h & 31;
                PEpiProj ep{pn, pm * 256, p.ws, p.b_q_norm, p.b_kv_norm};
                __syncthreads();
                gemm_unit_pg<false>(lds, (const bf16_t*)(p.ws + WS_XN) + (size_t)pm * 256 * D_MODEL, (const bf16_t*)(p.ws + WS_BT_IN) + (size_t)pn * 256 * D_MODEL, D_MODEL, ep);
                qv = 128 + h;
            } else {
                const int v = (b0 >> 2) * 3 + (b0 & 3) - 1;
                if (v < 128) {
                    attn_a_unit(p, lds, v); qv = v;
                    pg_convert(p.w_o, D_MODEL, D_MODEL, D_MODEL, 2048, (bf16_t*)(p.ws + WS_BT_WO), v * 1024 + tid, 128 * 1024);
                    pg_convert(p.w_o, D_MODEL, D_MODEL, D_MODEL, 2048, (bf16_t*)(p.ws + WS_BT_WO), v * 1024 + 512 + tid, 128 * 1024);
                } else {
                    const int w = v - 128; qv = -1;
                    attn_a_unit(p, lds, 128 + 2 * w); attn_a_unit(p, lds, 129 + 2 * w);
                    if (w < 32) pg_convert(p.b_w_ukv, 256, 2048, 2048, 2048, (bf16_t*)(p.ws + WS_BT_UKV), w * 512 + tid, 32 * 512);
                }
            }
            if (qv >= 0) { const int pn = qv / 32, pm = qv % 32;
                PEpiQUp ep{pn, pm * 256, p.ws};
                __syncthreads();
                gemm_unit_pg<false>(lds, (const bf16_t*)(p.ws + WS_CQ) + (size_t)pm * 256 * 512, (const bf16_t*)(p.ws + WS_BT_UQ) + (size_t)pn * 256 * 512, 512, ep);
                __syncthreads(); }
        }
        xcd_barrier(xb);
        for (int u = xperm; u < 32 * 8; u += G) {
            const int pn = u / 32, pm = u % 32;
            PEpiKvUp ep{pn, pm * 256, p.ws};
            __syncthreads();
            gemm_unit_pg<false>(lds, (const bf16_t*)(p.ws + WS_CKV) + (size_t)pm * 256 * 256, (const bf16_t*)(p.ws + WS_BT_UKV) + (size_t)pn * 256 * 256, 256, ep);
        }
    }
    SEAM(2);
    if (IN(3)) { for (int u = xperm; u < 256; u += G) mla_unit(p, lds, u); }
    SEAM(3);
    if (IN(4)) {
        __syncthreads();
        for (int u = xperm; u < 32 * 8; u += G) {
            const int pn = u / 32, pm = u % 32;
            LAS float* tab = (LAS float*)(lds + 2 * G_STAGE_B);
            __syncthreads();
            if (tid < 256) { const f32x4* pp = (const f32x4*)((const float*)(p.ws + WS_SSQP) + (size_t)(pm * 256 + tid) * 24); float sa = 0.f, sb2 = 0.f;
#pragma unroll
                for (int q = 0; q < 4; ++q) { const f32x4 v = pp[q]; sa += (v[0] + v[1]) + (v[2] + v[3]); }
#pragma unroll
                for (int q = 4; q < 6; ++q) { const f32x4 v = pp[q]; sb2 += (v[0] + v[1]) + (v[2] + v[3]); }
                tab[tid] = sa * (1.f / 1024.f); tab[256 + tid] = sb2 * (1.f / 1024.f); }
            __syncthreads();
            PEpiWo ep{pn, pm * 256, p.ws, p.x, tab};
            gemm_unit_pg<true>(lds, (const bf16_t*)(p.ws + WS_Y) + (size_t)pm * 256 * D_MODEL, (const bf16_t*)(p.ws + WS_BT_WO) + (size_t)pn * 256 * D_MODEL, D_MODEL, ep);
        }
    }
    SEAM(4);
    if (IN(5)) phase_router(p, lds);
    SEAM(5);
    LAS int* s_cnt = (LAS int*)(misc + 16); LAS int* s_toff = (LAS int*)(misc + 48); LAS int* s_roff = (LAS int*)(misc + 96);
    if (IN(6) || IN(7) || IN(8)) {
        if (tid == 0) { const unsigned* cnt = (const unsigned*)(p.ws + WS_CTL + CTL_CNT); int to = 0;
            for (int e = 0; e < N_EXP; ++e) { const int c = (int)xb_ld((unsigned*)cnt + e * 16); s_cnt[e] = c; s_toff[e] = to; s_roff[e] = to * 256; to += (c + 255) >> 8; }
            s_toff[N_EXP] = to; }
        __syncthreads();
    }
    if (IN(6)) {
        const int TM = s_toff[N_EXP];
        const int T16 = TM * 16, NF = (T16 & ~255), R = T16 - NF;
        const bool halves = R > 0 && R <= 128;
        int round = 0;
        for (int L = xperm; L < (halves ? NF : T16); L += G, ++round) {
            if (round == ((xperm >> 3) & 7))
                conv_image(p.w_down + (size_t)(xperm >> 3) * D_FF * D_MODEL + (xperm & 7) * 256, (size_t)D_MODEL, p.ws + WS_IMG_DN + (size_t)xperm * 32 * 16384, 0, 32);
            int e = 0; while (s_toff[e + 1] * 16 <= L) ++e;
            const int w = L - s_toff[e] * 16, nte = s_toff[e + 1] - s_toff[e], ntile = w / nte, mt = w - ntile * nte, cntE = s_cnt[e];
            AGather8 af{p.ws + WS_XN, (const int*)(p.ws + WS_TOKL) + (size_t)e * NTOK, mt * 256, cntE};
            BGateUp bf{p.w_up + (size_t)e * D_MODEL * (2 * D_FF) + ntile * 128, (size_t)(2 * D_FF)};
            EpiUp8 ep{ntile * 128, mt * 256, cntE, p.ws + WS_ACT + ((size_t)s_roff[e] + mt * 256) * D_FF, p.b_up + (size_t)e * (2 * D_FF)};
            gemm_unit8<0x7B7B7B7B>(lds, (LAS unsigned*)(misc + 8), D_MODEL / 64, af, bf, ep);
        }
        if (round <= ((xperm >> 3) & 7))
            conv_image(p.w_down + (size_t)(xperm >> 3) * D_FF * D_MODEL + (xperm & 7) * 256, (size_t)D_MODEL, p.ws + WS_IMG_DN + (size_t)xperm * 32 * 16384, 0, 32);
        if (halves && xperm < 2 * R) {
            const int L = NF + (xperm >> 1), hf = xperm & 1;
            int e = 0; while (s_toff[e + 1] * 16 <= L) ++e;
            const int w = L - s_toff[e] * 16, nte = s_toff[e + 1] - s_toff[e], ntile = w / nte, mt = w - ntile * nte, cntE = s_cnt[e];
            AGather8 af{p.ws + WS_XN, (const int*)(p.ws + WS_TOKL) + (size_t)e * NTOK, mt * 256, cntE};
            BGateUp bf{p.w_up + (size_t)e * D_MODEL * (2 * D_FF) + ntile * 128 + hf * 64, (size_t)(2 * D_FF)};
            EpiUp8q ep{ntile * 128 + hf * 64, mt * 256, cntE, p.ws + WS_ACT + ((size_t)s_roff[e] + mt * 256) * D_FF, p.b_up + (size_t)e * (2 * D_FF)};
            gemm_unit8q<0x7B7B7B7B>(lds, (LAS unsigned*)(misc + 8), D_MODEL / 64, af, bf, ep);
        }
    }
    SEAM(6);
    if (IN(7)) {
        const int TM = s_toff[N_EXP];
        const int T8 = TM * 8, NF = T8 & ~255, R = T8 - NF;
        const bool halves = R > 0 && R <= 128;
        for (int L = xperm; L < (halves ? NF : T8); L += G) {
            int e = 0; while (s_toff[e + 1] * 8 <= L) ++e;
            const int w = L - s_toff[e] * 8, nte = s_toff[e + 1] - s_toff[e], ntile = w / nte, mt = w - ntile * nte, cntE = s_cnt[e];
            ARows8 af{p.ws + WS_ACT + ((size_t)s_roff[e] + mt * 256) * D_FF, (unsigned)D_FF};
            EpiDown8 ep{ntile * 256, mt * 256, cntE, (bf16_t*)(p.ws + WS_YS) + ((size_t)s_roff[e] + mt * 256) * D_MODEL, p.b_down + (size_t)e * D_MODEL};
            gemm_unit8b<0x7D7D7D7D>(lds, (LAS unsigned*)(misc + 8), D_FF / 64, af, p.ws + WS_IMG_DN + (size_t)(e * 8 + ntile) * 32 * 16384, ep);
        }
        if (halves && xperm < 2 * R) {
            const int L = NF + (xperm >> 1), hf = xperm & 1;
            int e = 0; while (s_toff[e + 1] * 8 <= L) ++e;
            const int w = L - s_toff[e] * 8, nte = s_toff[e + 1] - s_toff[e], ntile = w / nte, mt = w - ntile * nte, cntE = s_cnt[e];
            ARows8 af{p.ws + WS_ACT + ((size_t)s_roff[e] + mt * 256) * D_FF, (unsigned)D_FF};
            EpiDown8h ep{ntile * 256 + hf * 128, mt * 256, cntE, (bf16_t*)(p.ws + WS_YS) + ((size_t)s_roff[e] + mt * 256) * D_MODEL, p.b_down + (size_t)e * D_MODEL};
            gemm_unit8bh<0x7D7D7D7D>(lds, (LAS unsigned*)(misc + 8), D_FF / 64, af, p.ws + WS_IMG_DN + (size_t)(e * 8 + ntile) * 32 * 16384, hf, ep);
        }
    }
    SEAM(7);
    if (IN(8)) phase_combine(p, s_roff);
}

extern "C" void kernel_launch(void* const* d_in, const int* in_sizes, int n_in, void* d_out, int out_size, void* d_ws, size_t ws_size, hipStream_t stream) {
    static int ready = 0;
    if (!ready) {
        if (hipFuncSetAttribute((const void*)mega_fwd, hipFuncAttributeMaxDynamicSharedMemorySize, LDS_BYTES) != hipSuccess) { fprintf(stderr, "kernel_launch: hipFuncSetAttribute failed\n"); return; }
        int per_cu = 0; hipOccupancyMaxActiveBlocksPerMultiprocessor(&per_cu, (const void*)mega_fwd, 512, LDS_BYTES);
        if (per_cu < 1) { fprintf(stderr, "kernel_launch: occupancy query says 0 blocks per CU\n"); return; }
        ready = 1;
    }
    if (ws_size < WS_END) { fprintf(stderr, "kernel_launch: workspace too small\n"); return; }
    hipMemsetAsync((unsigned char*)d_ws + WS_CTL, 0, CTL_BYTES, stream);
    Params p{};
    const float** f = (const float**)&p;
    for (int i = 0; i < 19; ++i) f[i] = (const float*)d_in[i];
    p.out = (float*)d_out; p.ws = (unsigned char*)d_ws; p.ph_lo = 0; p.ph_hi = NPHASE;
    hipLaunchKernelGGL(mega_fwd, dim3(256), dim3(512), LDS_BYTES, stream, p);
}
```

```cpp
#include <hip/hip_runtime.h>
#include <stdint.h>
#include <stdio.h>

#define LAS __attribute__((address_space(3)))
typedef unsigned short bf16_t;
typedef short bf16x8 __attribute__((ext_vector_type(8)));
typedef short s16x4 __attribute__((ext_vector_type(4)));
typedef short v4i16_t __attribute__((ext_vector_type(4)));
typedef float f32x2 __attribute__((ext_vector_type(2)));
typedef float f32x4 __attribute__((ext_vector_type(4)));
typedef float f32x16 __attribute__((ext_vector_type(16)));
typedef int i32x4 __attribute__((ext_vector_type(4)));
typedef unsigned u32x2 __attribute__((ext_vector_type(2)));
typedef unsigned u32x4 __attribute__((ext_vector_type(4)));
typedef __bf16 bf16x2_t __attribute__((ext_vector_type(2)));
typedef int v8i __attribute__((ext_vector_type(8)));
typedef int v2i __attribute__((ext_vector_type(2)));
typedef short v2s __attribute__((ext_vector_type(2)));

constexpr int D_MODEL = 2048, SEQ = 4096, BATCH = 2, NTOK = BATCH * SEQ;
constexpr int IN_COLS = 2368;
constexpr int N_EXP = 32, TOP_K = 4, D_FF = 2048;
constexpr float EPS = 1e-5f;
constexpr float LOG2E = 1.4426950408889634f;

constexpr size_t MiB = 1u << 20;
constexpr size_t WS_CTL = 0, CTL_BYTES = 1 * MiB;
constexpr size_t WS_XN = 1 * MiB, WS_QA = 33 * MiB, WS_KA = 49 * MiB, WS_VA = 53 * MiB, WS_CQ = 57 * MiB, WS_CKV = 65 * MiB, WS_KPE = 69 * MiB;
constexpr size_t WS_QB = 70 * MiB, WS_KVB = 94 * MiB, WS_Y = 126 * MiB, WS_X2 = 158 * MiB, WS_ROPE = 222 * MiB, WS_WRT = 223 * MiB;
constexpr size_t WS_TOKL = 224 * MiB, WS_SEL = 225 * MiB, WS_ACT = 226 * MiB, WS_YS = 386 * MiB, WS_BT_IN = 546 * MiB, WS_BT_UQ = 558 * MiB, WS_BT_UKV = 560 * MiB, WS_BT_WO = 562 * MiB, WS_SSQ2 = 570 * MiB, WS_IMG_DN = 571 * MiB, WS_END = 699 * MiB;
constexpr size_t WS_SSQP = WS_WRT + 262144;
constexpr size_t WS_SSQC = WS_SSQ2;
constexpr size_t WS_SSQK = WS_SSQ2 + 524288;
constexpr size_t CTL_BAR = 0, CTL_CNT = 16384, CTL_SSQ_CQ = 65536, CTL_SSQ_CKV = 98304, CTL_SSQ_A = 131072, CTL_SSQ_B = 163840, CTL_SSQ_X2 = 196608;

__device__ __forceinline__ unsigned pk_bf16(float lo, float hi) { f32x2 v = {lo, hi}; bf16x2_t b = __builtin_convertvector(v, bf16x2_t); return __builtin_bit_cast(unsigned, b); }
__device__ __forceinline__ unsigned pk4_fp8(float a, float b, float c, float d) { int w = __builtin_amdgcn_cvt_pk_fp8_f32(a, b, 0, false); w = __builtin_amdgcn_cvt_pk_fp8_f32(c, d, w, true); return (unsigned)w; }
__device__ __forceinline__ unsigned pk4_fp8_x64(f32x4 v) { v2s r; asm("" : "=v"(r));
    r = __builtin_amdgcn_cvt_scalef32_pk_fp8_f32(r, v[0], v[1], 0.015625f, false); r = __builtin_amdgcn_cvt_scalef32_pk_fp8_f32(r, v[2], v[3], 0.015625f, true); return __builtin_bit_cast(unsigned, r); }
__device__ __forceinline__ float bf_lo(unsigned u) { return __uint_as_float(u << 16); }
__device__ __forceinline__ float bf_hi(unsigned u) { return __uint_as_float(u & 0xffff0000u); }
__device__ __forceinline__ float wave_sum(float v) {
#pragma unroll
    for (int o = 32; o >= 1; o >>= 1) v += __shfl_xor(v, o, 64);
    return v;
}
__device__ __forceinline__ int crow(int r, int hi) { return (r & 3) + 8 * (r >> 2) + 4 * hi; }
__device__ __forceinline__ s16x4 vtr(const LAS char* p) { return __builtin_bit_cast(s16x4, __builtin_amdgcn_ds_read_tr16_b64_v4i16((LAS v4i16_t*)p)); }
#define SBAR() __builtin_amdgcn_sched_barrier(0)

#define XB_TMO      128
#define XB_XCNT(j)  (256  + 64 * (j))
#define XB_XSUB(j)  (1280 + 64 * (j))
#define XB_XGEN(j)  (2304 + 64 * (j))
#define XB_TOP      3328
#define XB_TOPGEN   3392
#define XCD_BAR_WORDS 3456
#define XB_SPIN_CAP (1u << 18)
__device__ __forceinline__ unsigned xb_ld(unsigned* p)              { return __hip_atomic_load(p, __ATOMIC_RELAXED, __HIP_MEMORY_SCOPE_AGENT); }
__device__ __forceinline__ unsigned xb_add(unsigned* p, unsigned v) { return __hip_atomic_fetch_add(p, v, __ATOMIC_RELAXED, __HIP_MEMORY_SCOPE_AGENT); }
__device__ __forceinline__ unsigned xb_xcc_id() { return (unsigned)__builtin_amdgcn_s_getreg((3 << 11) | 20) & 0xFu; }
#define XB_SPIN(cond, bar) do { unsigned _sp = 0; while (cond) { __builtin_amdgcn_s_sleep(1); \
    if ((++_sp & 255u) == 0u) { if (xb_ld(&(bar)[XB_TMO])) break; if (_sp > XB_SPIN_CAP) { atomicAdd(&(bar)[XB_TMO], 1u); break; } } } } while (0)
struct XcdBarrier { unsigned* bar; unsigned x; volatile LAS unsigned* st; };
__device__ __forceinline__ XcdBarrier xcd_barrier_post(unsigned* bar, volatile LAS unsigned* st) {
    XcdBarrier b; b.bar = bar; b.x = xb_xcc_id(); b.st = st;
    if (threadIdx.x == 0) (void)xb_add(&bar[XB_XCNT(b.x)], 1u);
    return b;
}
__device__ __forceinline__ void xcd_barrier_complete(unsigned* bar, unsigned x, unsigned& nloc, unsigned& nx) {
    const unsigned G = gridDim.x * gridDim.y * gridDim.z;
    unsigned sum, cnt, mine, sp = 0u;
    for (;;) {
        sum = 0u; cnt = 0u; mine = 0u;
#pragma unroll
        for (unsigned j = 0; j < 16; ++j) { const unsigned c = xb_ld(&bar[XB_XCNT(j)]); sum += c; cnt += (c > 0u) ? 1u : 0u; mine = (j == x) ? c : mine; }
        if (sum == G) break;
        __builtin_amdgcn_s_sleep(1);
        if ((++sp & 255u) == 0u) { if (xb_ld(&bar[XB_TMO])) break; if (sp > XB_SPIN_CAP) { atomicAdd(&bar[XB_TMO], 1u); break; } }
    }
    nloc = mine > 0u ? mine : 1u; nx = cnt > 0u ? cnt : 1u;
}
__device__ __forceinline__ void xcd_barrier(const XcdBarrier& b) {
    asm volatile("s_waitcnt vmcnt(0)" ::: "memory");
    __syncthreads();
    if (threadIdx.x == 0) {
        unsigned* bar = b.bar;
        __builtin_amdgcn_s_waitcnt(0);
        unsigned nloc = b.st[0], nx = b.st[1];
        if (nloc == 0u) { xcd_barrier_complete(bar, b.x, nloc, nx); b.st[0] = nloc; b.st[1] = nx; }
        const unsigned old = xb_add(&bar[XB_XSUB(b.x)], 1u);
        const unsigned gen = old / nloc;
        if (old + 1u == (gen + 1u) * nloc) {
            __builtin_amdgcn_fence(__ATOMIC_RELEASE, "agent");
            asm volatile("s_waitcnt vmcnt(0)" ::: "memory");
            const unsigned og = xb_add(&bar[XB_TOP], 1u);
            const unsigned tg = og / nx;
            if (og + 1u == (tg + 1u) * nx) xb_add(&bar[XB_TOPGEN], 1u);
            else XB_SPIN(xb_ld(&bar[XB_TOPGEN]) == tg, bar);
            __builtin_amdgcn_fence(__ATOMIC_ACQUIRE, "agent");
            xb_add(&bar[XB_XGEN(b.x)], 1u);
            asm volatile("s_waitcnt vmcnt(0)" ::: "memory");
        } else {
            XB_SPIN(xb_ld(&bar[XB_XGEN(b.x)]) == gen, bar);
            __builtin_amdgcn_fence(__ATOMIC_ACQUIRE, "agent");
            asm volatile("s_waitcnt vmcnt(0)" ::: "memory");
        }
    }
    __syncthreads();
}

constexpr int A_TILE_B = 256 * 64 * 2;
constexpr int B_PITCH = 544;
constexpr int B_TILE_B = 64 * B_PITCH;
constexpr int G_STAGE_B = A_TILE_B + B_TILE_B;
constexpr int LDS_MISC = 155648;
constexpr int LDS_BYTES = LDS_MISC + 1024;

__device__ __forceinline__ int a_img_byte(int r, int chunk) { return r * 128 + ((chunk ^ ((r >> 1) & 7)) << 4); }
#define WAIT_L0() asm volatile("s_waitcnt lgkmcnt(0)" ::: "memory")
__device__ __forceinline__ void glds16(const void* gsrc, unsigned lds_dst) { unsigned keep;
    asm volatile("s_mov_b32 %0, m0\n\ts_mov_b32 m0, %2\n\ts_nop 0\n\tglobal_load_lds_dwordx4 %1, off\n\ts_mov_b32 m0, %0" : "=&s"(keep) : "v"(gsrc), "s"(lds_dst) : "memory"); }
#define RAW_BARRIER() do { WAIT_L0(); __builtin_amdgcn_s_barrier(); } while (0)

__device__ __forceinline__ const char* uniform_ptr(const void* p) {
    const unsigned long long v = (unsigned long long)p;
    const unsigned lo = __builtin_amdgcn_readfirstlane((unsigned)v), hi = __builtin_amdgcn_readfirstlane((unsigned)(v >> 32));
    return (const char*)(((unsigned long long)hi << 32) | lo);
}
__device__ __forceinline__ void glds16s(const char* sbase, unsigned voff, unsigned lds_dst) { unsigned keep;
    asm volatile("s_mov_b32 %0, m0\n\ts_mov_b32 m0, %3\n\ts_nop 4\n\tglobal_load_lds_dwordx4 %1, %2\n\ts_mov_b32 m0, %0" : "=&s"(keep) : "v"(voff), "s"(sbase), "s"(lds_dst) : "memory"); }
#define WAIT_V4(n, a, b, c, d) asm volatile("s_waitcnt vmcnt(" #n ")" : "+v"(a), "+v"(b), "+v"(c), "+v"(d) :: "memory")
template <bool MID, class AF, class BF, class EPI>
__device__ __forceinline__ void gemm_unit(LAS char* lds, const int nt, const AF& af, const BF& bf, EPI& epi) {
    const int tid = threadIdx.x, wid = __builtin_amdgcn_readfirstlane(tid >> 6), lane = tid & 63, wr = wid >> 2, wc = wid & 3, fr = lane & 15, fq = lane >> 4;
    const char* abase = uniform_ptr(af.base);
    unsigned aoff[4];
#pragma unroll
    for (int i = 0; i < 4; ++i) { const int R = wid * 8 + i * 64 + (lane >> 3), C = ((lane & 7) ^ ((R >> 1) & 7)) * 8; aoff[i] = (af.rowoff(R) + (unsigned)C) * 2u; }
    const int a_ldsw = wid * 1024;
    const unsigned lds_u = (unsigned)__builtin_amdgcn_readfirstlane((int)(unsigned)(size_t)lds);
    const size_t ldb4 = (size_t)bf.ld * 4;
    const char* bbase = uniform_ptr(bf.base) + (size_t)wid * ldb4;
    const unsigned boff = bf.coloff(4 * lane) * 4u;
    const int b_lds0 = A_TILE_B + wid * B_PITCH + 8 * lane, b_lds1 = A_TILE_B + wid * B_PITCH + ((8 * lane) ^ 128);
    const int a_rd0 = a_img_byte(wr * 128 + fr, fq), a_rd1 = a_rd0 ^ 64;
    const int b_rd = A_TILE_B + (8 * fq + ((lane & 15) >> 2)) * B_PITCH + ((wc ^ (fq & 1)) << 7) + 8 * (lane & 3);
    f32x4 acc[8][4];
#pragma unroll
    for (int m = 0; m < 8; ++m)
#pragma unroll
        for (int n = 0; n < 4; ++n) acc[m][n] = (f32x4){0.f, 0.f, 0.f, 0.f};
    f32x4 sb[8];
#define G_STAGE_A(i, kt, buf) glds16s(abase + (size_t)(kt) * 128, aoff[i], lds_u + (unsigned)((buf) * G_STAGE_B + a_ldsw + (i) * 8192))
#define G_ISSUE_B(i, kt) asm volatile("s_nop 4\n\tglobal_load_dwordx4 %0, %1, %2" : "=v"(sb[i]) : "v"(boff), "s"(bbase + ((size_t)(kt) * 64 + (i) * 8) * ldb4) : "memory")
#define G_WRITE_B(i, buf) do { u32x2 w_ = {pk_bf16(sb[i][0], sb[i][1]), pk_bf16(sb[i][2], sb[i][3])}; \
        *(LAS u32x2*)(lds + (buf) * G_STAGE_B + (((i) & 1) ? b_lds1 : b_lds0) + (i) * 8 * B_PITCH) = w_; } while (0)
#define G_KSTEP(buf, ks) do { bf16x8 At[8], Bf[4]; \
        _Pragma("unroll") for (int n = 0; n < 4; ++n) { const s16x4 lo_ = vtr(lds + (buf) * G_STAGE_B + b_rd + (ks) * 32 * B_PITCH + n * 32), hi_ = vtr(lds + (buf) * G_STAGE_B + b_rd + (ks) * 32 * B_PITCH + 4 * B_PITCH + n * 32); \
            Bf[n] = (bf16x8){lo_[0], lo_[1], lo_[2], lo_[3], hi_[0], hi_[1], hi_[2], hi_[3]}; } \
        _Pragma("unroll") for (int m = 0; m < 8; ++m) At[m] = *(const LAS bf16x8*)(lds + (buf) * G_STAGE_B + ((ks) ? a_rd1 : a_rd0) + m * 2048); \
        SBAR(); __builtin_amdgcn_s_setprio(1); \
        _Pragma("unroll") for (int m = 0; m < 8; ++m) _Pragma("unroll") for (int n = 0; n < 4; ++n) \
            acc[m][n] = __builtin_amdgcn_mfma_f32_16x16x32_bf16(Bf[n], At[m], acc[m][n], 0, 0, 0); \
        __builtin_amdgcn_s_setprio(0); SBAR(); } while (0)
#pragma unroll
    for (int i = 0; i < 4; ++i) G_STAGE_A(i, 0, 0);
#pragma unroll
    for (int i = 0; i < 8; ++i) G_ISSUE_B(i, 0);
    WAIT_V4(0, sb[0], sb[1], sb[2], sb[3]); WAIT_V4(0, sb[4], sb[5], sb[6], sb[7]);
#pragma unroll
    for (int i = 0; i < 8; ++i) G_WRITE_B(i, 0);
    SBAR();
#pragma unroll
    for (int i = 0; i < 8; ++i) G_ISSUE_B(i, 1);
    SBAR();
    RAW_BARRIER();
#pragma unroll 1
    for (int t = 0; t < nt; ++t) {
        const int cur = t & 1, nxt = cur ^ 1;
        if constexpr (MID) { if (t == (nt >> 1)) epi.mid(acc, wr, wc, fr, fq); }
        const int k1 = (t + 1 < nt) ? t + 1 : nt - 1, k2 = (t + 2 < nt) ? t + 2 : nt - 1;
        G_STAGE_A(0, k1, nxt); G_STAGE_A(1, k1, nxt); G_STAGE_A(2, k1, nxt); G_STAGE_A(3, k1, nxt);
        G_KSTEP(cur, 0);
        WAIT_V4(8, sb[0], sb[1], sb[2], sb[3]);
        G_WRITE_B(0, nxt); G_WRITE_B(1, nxt); G_WRITE_B(2, nxt); G_WRITE_B(3, nxt); SBAR();
        G_ISSUE_B(0, k2); G_ISSUE_B(1, k2); G_ISSUE_B(2, k2); G_ISSUE_B(3, k2); SBAR();
        G_KSTEP(cur, 1);
        WAIT_V4(8, sb[4], sb[5], sb[6], sb[7]);
        G_WRITE_B(4, nxt); G_WRITE_B(5, nxt); G_WRITE_B(6, nxt); G_WRITE_B(7, nxt); SBAR();
        G_ISSUE_B(4, k2); G_ISSUE_B(5, k2); G_ISSUE_B(6, k2); G_ISSUE_B(7, k2); SBAR();
        asm volatile("s_waitcnt vmcnt(8)" ::: "memory");
        RAW_BARRIER();
    }
    WAIT_V4(0, sb[0], sb[1], sb[2], sb[3]); WAIT_V4(0, sb[4], sb[5], sb[6], sb[7]);
    epi.fin(acc, wr, wc, fr, fq);
#undef G_STAGE_A
#undef G_ISSUE_B
#undef G_WRITE_B
#undef G_KSTEP
}

constexpr int A8_TILE_B = 16384, B8_PITCH = 288, B8_TILE_B = 64 * B8_PITCH;
constexpr int A8_RING = 5, B8_RING = 4, B8_OFF = A8_RING * A8_TILE_B;
static_assert(B8_OFF + B8_RING * B8_TILE_B <= LDS_MISC, "fp8 rings fit below the misc words");
__device__ __forceinline__ v2i vtr8(const LAS char* p) { return __builtin_amdgcn_ds_read_tr8_b64_v2i32((LAS v2i*)p); }
template <int SCALE_X, class AF, class BF, class EPI>
__device__ __forceinline__ void gemm_unit8(LAS char* lds, LAS unsigned* ring_cnt, const int nt, const AF& af, const BF& bf, EPI& epi) {
    const int tid = threadIdx.x, wid = __builtin_amdgcn_readfirstlane(tid >> 6), lane = tid & 63, wr = wid >> 2, wc = wid & 3, r32 = lane & 31, hi = lane >> 5;
    const char* abase = uniform_ptr(af.base);
    unsigned aoff[2];
#pragma unroll
    for (int i = 0; i < 2; ++i) { const int R = wid * 16 + i * 128 + (lane >> 2), C = ((lane & 3) ^ ((lane >> 4) & 3)) * 16; aoff[i] = af.rowoff(R) + (unsigned)C; }
    const unsigned lds_u = (unsigned)__builtin_amdgcn_readfirstlane((int)(unsigned)(size_t)lds) + (unsigned)(wid * 1024);
    const size_t ldb4 = (size_t)bf.ld * 4;
    const char* bbase = uniform_ptr(bf.base) + (size_t)wid * ldb4;
    const unsigned boff = bf.coloff(4 * lane) * 4u;
    const int b_wr = B8_OFF + wid * B8_PITCH + 4 * lane;
    const int a_rd0 = (wr * 128 + r32) * 64 + (((2 * hi) ^ ((r32 >> 2) & 3)) << 4), a_rd1 = a_rd0 ^ 16;
    const int b_rd = B8_OFF + (32 * hi + ((lane & 15) >> 1)) * B8_PITCH + wc * 64 + 16 * ((lane >> 4) & 1) + 8 * (lane & 1);
    f32x16 acc[4][2];
#pragma unroll
    for (int m = 0; m < 4; ++m)
#pragma unroll
        for (int n = 0; n < 2; ++n)
#pragma unroll
            for (int r = 0; r < 16; ++r) acc[m][n][r] = 0.f;
    f32x4 sb[8];
#define H_STAGE_A(i, kt, slot) glds16s(abase + (size_t)(kt) * 64, aoff[i], lds_u + (unsigned)((slot) * A8_TILE_B + (i) * 8192))
#define H_ISSUE_B(i, kt) asm volatile("s_nop 4\n\tglobal_load_dwordx4 %0, %1, %2" : "=v"(sb[i]) : "v"(boff), "s"(bbase + ((size_t)(kt) * 64 + (i) * 8) * ldb4) : "memory")
#define H_WRITE_B(i, slot) *(LAS unsigned*)(lds + (slot) * B8_TILE_B + b_wr + (i) * 8 * B8_PITCH) = pk4_fp8_x64(sb[i])
#define H_KSTEP(sa, sbk) do { v8i Xf[4], Wf[2]; \
        _Pragma("unroll") for (int n = 0; n < 2; ++n) _Pragma("unroll") for (int r = 0; r < 4; ++r) { const v2i t_ = vtr8(lds + (sbk) * B8_TILE_B + b_rd + r * 8 * B8_PITCH + n * 32); Wf[n][2 * r] = t_[0]; Wf[n][2 * r + 1] = t_[1]; } \
        _Pragma("unroll") for (int m = 0; m < 4; ++m) { const i32x4 lo_ = *(const LAS i32x4*)(lds + (sa) * A8_TILE_B + a_rd0 + m * 2048), hi_ = *(const LAS i32x4*)(lds + (sa) * A8_TILE_B + a_rd1 + m * 2048); \
            Xf[m] = (v8i){lo_[0], lo_[1], lo_[2], lo_[3], hi_[0], hi_[1], hi_[2], hi_[3]}; } \
        SBAR(); __builtin_amdgcn_s_setprio(1); \
        _Pragma("unroll") for (int m = 0; m < 4; ++m) _Pragma("unroll") for (int n = 0; n < 2; ++n) \
            acc[m][n] = __builtin_amdgcn_mfma_scale_f32_32x32x64_f8f6f4(Wf[n], Xf[m], acc[m][n], 0, 0, 0, 0x79797979, 0, SCALE_X); \
        __builtin_amdgcn_s_setprio(0); \
        _Pragma("unroll") for (int m = 0; m < 4; ++m) _Pragma("unroll") for (int n = 0; n < 2; ++n) asm volatile("" : "+v"(acc[m][n])); \
        SBAR(); } while (0)
    if (tid < 8) ring_cnt[tid] = 0u;
    H_STAGE_A(0, 0, 0); H_STAGE_A(1, 0, 0); H_STAGE_A(0, 1, 1); H_STAGE_A(1, 1, 1);
#pragma unroll
    for (int i = 0; i < 8; ++i) H_ISSUE_B(i, 0);
    WAIT_V4(0, sb[0], sb[1], sb[2], sb[3]); WAIT_V4(0, sb[4], sb[5], sb[6], sb[7]);
#pragma unroll
    for (int i = 0; i < 8; ++i) H_WRITE_B(i, 0);
    SBAR();
#pragma unroll
    for (int i = 0; i < 8; ++i) H_ISSUE_B(i, 1);
    WAIT_V4(0, sb[0], sb[1], sb[2], sb[3]); WAIT_V4(0, sb[4], sb[5], sb[6], sb[7]);
#pragma unroll
    for (int i = 0; i < 8; ++i) H_WRITE_B(i, 1);
    SBAR();
    H_STAGE_A(0, 2, 2); H_STAGE_A(1, 2, 2);
#pragma unroll
    for (int i = 0; i < 8; ++i) H_ISSUE_B(i, 2);
    SBAR();
    RAW_BARRIER();
    int sa_r = 0, sa_w = 3, sb_r = 0, sb_w = 2;
#pragma unroll 1
    for (int t = 0; t < nt; ++t) {
        if (t >= 2) {
            const unsigned need = (unsigned)(t - 1);
            for (;;) { asm volatile("" ::: "memory"); const unsigned v = *(volatile LAS unsigned*)(ring_cnt + (lane & 7)); if (__all(v >= need)) break; __builtin_amdgcn_s_sleep(1); }
            asm volatile("" ::: "memory");
        }
        const int k3 = (t + 3 < nt) ? t + 3 : nt - 1;
        H_STAGE_A(0, k3, sa_w); H_STAGE_A(1, k3, sa_w);
        H_KSTEP(sa_r, sb_r);
        WAIT_V4(6, sb[0], sb[1], sb[2], sb[3]);
        H_WRITE_B(0, sb_w); H_WRITE_B(1, sb_w); H_WRITE_B(2, sb_w); H_WRITE_B(3, sb_w); SBAR();
        H_ISSUE_B(0, k3); H_ISSUE_B(1, k3); H_ISSUE_B(2, k3); H_ISSUE_B(3, k3); SBAR();
        WAIT_V4(6, sb[4], sb[5], sb[6], sb[7]);
        H_WRITE_B(4, sb_w); H_WRITE_B(5, sb_w); H_WRITE_B(6, sb_w); H_WRITE_B(7, sb_w); SBAR();
        H_ISSUE_B(4, k3); H_ISSUE_B(5, k3); H_ISSUE_B(6, k3); H_ISSUE_B(7, k3); SBAR();
        asm volatile("" ::: "memory");
        if (lane == 0) *(volatile LAS unsigned*)(ring_cnt + wid) = (unsigned)(t + 1);
        asm volatile("" ::: "memory");
        sa_r = (sa_r == A8_RING - 1) ? 0 : sa_r + 1; sa_w = (sa_w == A8_RING - 1) ? 0 : sa_w + 1;
        sb_r = (sb_r == B8_RING - 1) ? 0 : sb_r + 1; sb_w = (sb_w == B8_RING - 1) ? 0 : sb_w + 1;
    }
    WAIT_V4(0, sb[0], sb[1], sb[2], sb[3]); WAIT_V4(0, sb[4], sb[5], sb[6], sb[7]);
    RAW_BARRIER();
    epi.fin(acc, wr, wc, r32, hi);
#undef H_STAGE_A
#undef H_ISSUE_B
#undef H_WRITE_B
#undef H_KSTEP
}

template <int SCALE_X, class AF, class BF, class EPI>
__device__ __forceinline__ void gemm_unit8h(LAS char* lds, LAS unsigned* ring_cnt, const int nt, const AF& af, const BF& bf, EPI& epi) {
    const int tid = threadIdx.x, wid = __builtin_amdgcn_readfirstlane(tid >> 6), lane = tid & 63, wr = wid >> 2, wc = wid & 3, r32 = lane & 31, hi = lane >> 5;
    const char* abase = uniform_ptr(af.base);
    unsigned aoff[2];
#pragma unroll
    for (int i = 0; i < 2; ++i) { const int R = wid * 16 + i * 128 + (lane >> 2), C = ((lane & 3) ^ ((lane >> 4) & 3)) * 16; aoff[i] = af.rowoff(R) + (unsigned)C; }
    const unsigned lds_u = (unsigned)__builtin_amdgcn_readfirstlane((int)(unsigned)(size_t)lds) + (unsigned)(wid * 1024);
    const size_t ldb4 = (size_t)bf.ld * 4;
    const char* bbase = uniform_ptr(bf.base) + (size_t)wid * ldb4;
    const unsigned boff = (unsigned)(lane >> 5) * 8u * (unsigned)ldb4 + bf.coloff(4 * (lane & 31)) * 4u;
    const int b_wr = B8_OFF + (wid + 8 * (lane >> 5)) * B8_PITCH + 4 * (lane & 31);
    const int a_rd0 = (wr * 128 + r32) * 64 + (((2 * hi) ^ ((r32 >> 2) & 3)) << 4), a_rd1 = a_rd0 ^ 16;
    const int b_rd = B8_OFF + (32 * hi + ((lane & 15) >> 1)) * B8_PITCH + wc * 32 + 16 * ((lane >> 4) & 1) + 8 * (lane & 1);
    f32x16 acc[4][1];
#pragma unroll
    for (int m = 0; m < 4; ++m)
#pragma unroll
        for (int n = 0; n < 1; ++n)
#pragma unroll
            for (int r = 0; r < 16; ++r) acc[m][n][r] = 0.f;
    f32x4 sb[4];
#define H_STAGE_A(i, kt, slot) glds16s(abase + (size_t)(kt) * 64, aoff[i], lds_u + (unsigned)((slot) * A8_TILE_B + (i) * 8192))
#define H_ISSUE_B(i, kt) asm volatile("s_nop 4\n\tglobal_load_dwordx4 %0, %1, %2" : "=v"(sb[i]) : "v"(boff), "s"(bbase + ((size_t)(kt) * 64 + (i) * 16) * ldb4) : "memory")
#define H_WRITE_B(i, slot) *(LAS unsigned*)(lds + (slot) * B8_TILE_B + b_wr + (i) * 16 * B8_PITCH) = pk4_fp8_x64(sb[i])
#define H_KSTEP(sa, sbk) do { v8i Xf[4], Wf[1]; \
        _Pragma("unroll") for (int n = 0; n < 1; ++n) _Pragma("unroll") for (int r = 0; r < 4; ++r) { const v2i t_ = vtr8(lds + (sbk) * B8_TILE_B + b_rd + r * 8 * B8_PITCH + n * 32); Wf[n][2 * r] = t_[0]; Wf[n][2 * r + 1] = t_[1]; } \
        _Pragma("unroll") for (int m = 0; m < 4; ++m) { const i32x4 lo_ = *(const LAS i32x4*)(lds + (sa) * A8_TILE_B + a_rd0 + m * 2048), hi_ = *(const LAS i32x4*)(lds + (sa) * A8_TILE_B + a_rd1 + m * 2048); \
            Xf[m] = (v8i){lo_[0], lo_[1], lo_[2], lo_[3], hi_[0], hi_[1], hi_[2], hi_[3]}; } \
        SBAR(); __builtin_amdgcn_s_setprio(1); \
        _Pragma("unroll") for (int m = 0; m < 4; ++m) _Pragma("unroll") for (int n = 0; n < 1; ++n) \
            acc[m][n] = __builtin_amdgcn_mfma_scale_f32_32x32x64_f8f6f4(Wf[n], Xf[m], acc[m][n], 0, 0, 0, 0x79797979, 0, SCALE_X); \
        __builtin_amdgcn_s_setprio(0); SBAR(); } while (0)
    if (tid < 8) ring_cnt[tid] = 0u;
    H_STAGE_A(0, 0, 0); H_STAGE_A(1, 0, 0); H_STAGE_A(0, 1, 1); H_STAGE_A(1, 1, 1);
#pragma unroll
    for (int i = 0; i < 4; ++i) H_ISSUE_B(i, 0);
    WAIT_V4(0, sb[0], sb[1], sb[2], sb[3]);
#pragma unroll
    for (int i = 0; i < 4; ++i) H_WRITE_B(i, 0);
    SBAR();
#pragma unroll
    for (int i = 0; i < 4; ++i) H_ISSUE_B(i, 1);
    WAIT_V4(0, sb[0], sb[1], sb[2], sb[3]);
#pragma unroll
    for (int i = 0; i < 4; ++i) H_WRITE_B(i, 1);
    SBAR();
    H_STAGE_A(0, 2, 2); H_STAGE_A(1, 2, 2);
#pragma unroll
    for (int i = 0; i < 4; ++i) H_ISSUE_B(i, 2);
    SBAR();
    RAW_BARRIER();
    int sa_r = 0, sa_w = 3, sb_r = 0, sb_w = 2;
#pragma unroll 1
    for (int t = 0; t < nt; ++t) {
        if (t >= 2) {
            const unsigned need = (unsigned)(t - 1);
            for (;;) { asm volatile("" ::: "memory"); const unsigned v = *(volatile LAS unsigned*)(ring_cnt + (lane & 7)); if (__all(v >= need)) break; __builtin_amdgcn_s_sleep(1); }
            asm volatile("" ::: "memory");
        }
        const int k3 = (t + 3 < nt) ? t + 3 : nt - 1;
        H_STAGE_A(0, k3, sa_w); H_STAGE_A(1, k3, sa_w);
        H_KSTEP(sa_r, sb_r);
        WAIT_V4(2, sb[0], sb[1], sb[2], sb[3]);
        H_WRITE_B(0, sb_w); H_WRITE_B(1, sb_w); H_WRITE_B(2, sb_w); H_WRITE_B(3, sb_w); SBAR();
        H_ISSUE_B(0, k3); H_ISSUE_B(1, k3); H_ISSUE_B(2, k3); H_ISSUE_B(3, k3); SBAR();
        asm volatile("" ::: "memory");
        if (lane == 0) *(volatile LAS unsigned*)(ring_cnt + wid) = (unsigned)(t + 1);
        asm volatile("" ::: "memory");
        sa_r = (sa_r == A8_RING - 1) ? 0 : sa_r + 1; sa_w = (sa_w == A8_RING - 1) ? 0 : sa_w + 1;
        sb_r = (sb_r == B8_RING - 1) ? 0 : sb_r + 1; sb_w = (sb_w == B8_RING - 1) ? 0 : sb_w + 1;
    }
    WAIT_V4(0, sb[0], sb[1], sb[2], sb[3]);
    RAW_BARRIER();
    epi.fin(acc, wr, wc, r32, hi);
#undef H_STAGE_A
#undef H_ISSUE_B
#undef H_WRITE_B
#undef H_KSTEP
}

template <int SCALE_X, class AF, class BF, class EPI>
__device__ __forceinline__ void gemm_unit8q(LAS char* lds, LAS unsigned* ring_cnt, const int nt, const AF& af, const BF& bf, EPI& epi) {
    const int tid = threadIdx.x, wid = __builtin_amdgcn_readfirstlane(tid >> 6), lane = tid & 63, wr = wid >> 1, wc = wid & 1, r32 = lane & 31, hi = lane >> 5;
    const char* abase = uniform_ptr(af.base);
    unsigned aoff[2];
#pragma unroll
    for (int i = 0; i < 2; ++i) { const int R = wid * 16 + i * 128 + (lane >> 2), C = ((lane & 3) ^ ((lane >> 4) & 3)) * 16; aoff[i] = af.rowoff(R) + (unsigned)C; }
    const unsigned lds_u = (unsigned)__builtin_amdgcn_readfirstlane((int)(unsigned)(size_t)lds) + (unsigned)(wid * 1024);
    const size_t ldb4 = (size_t)bf.ld * 4;
    const char* bbase = uniform_ptr(bf.base) + (size_t)wid * ldb4;
    const unsigned boff = (unsigned)(lane >> 5) * 8u * (unsigned)ldb4 + bf.coloff(4 * (lane & 31)) * 4u;
    const int b_wr = B8_OFF + (wid + 8 * (lane >> 5)) * B8_PITCH + 4 * (lane & 31);
    const int a_rd0 = (wr * 64 + r32) * 64 + (((2 * hi) ^ ((r32 >> 2) & 3)) << 4), a_rd1 = a_rd0 ^ 16;
    const int b_rd = B8_OFF + (32 * hi + ((lane & 15) >> 1)) * B8_PITCH + wc * 64 + 16 * ((lane >> 4) & 1) + 8 * (lane & 1);
    f32x16 acc[2][2];
#pragma unroll
    for (int m = 0; m < 2; ++m)
#pragma unroll
        for (int n = 0; n < 2; ++n)
#pragma unroll
            for (int r = 0; r < 16; ++r) acc[m][n][r] = 0.f;
    f32x4 sb[4];
#define H_STAGE_A(i, kt, slot) glds16s(abase + (size_t)(kt) * 64, aoff[i], lds_u + (unsigned)((slot) * A8_TILE_B + (i) * 8192))
#define H_ISSUE_B(i, kt) asm volatile("s_nop 4\n\tglobal_load_dwordx4 %0, %1, %2" : "=v"(sb[i]) : "v"(boff), "s"(bbase + ((size_t)(kt) * 64 + (i) * 16) * ldb4) : "memory")
#define H_WRITE_B(i, slot) *(LAS unsigned*)(lds + (slot) * B8_TILE_B + b_wr + (i) * 16 * B8_PITCH) = pk4_fp8_x64(sb[i])
#define H_KSTEP(sa, sbk) do { v8i Xf[2], Wf[2]; \
        _Pragma("unroll") for (int n = 0; n < 2; ++n) _Pragma("unroll") for (int r = 0; r < 4; ++r) { const v2i t_ = vtr8(lds + (sbk) * B8_TILE_B + b_rd + r * 8 * B8_PITCH + n * 32); Wf[n][2 * r] = t_[0]; Wf[n][2 * r + 1] = t_[1]; } \
        _Pragma("unroll") for (int m = 0; m < 2; ++m) { const i32x4 lo_ = *(const LAS i32x4*)(lds + (sa) * A8_TILE_B + a_rd0 + m * 2048), hi_ = *(const LAS i32x4*)(lds + (sa) * A8_TILE_B + a_rd1 + m * 2048); \
            Xf[m] = (v8i){lo_[0], lo_[1], lo_[2], lo_[3], hi_[0], hi_[1], hi_[2], hi_[3]}; } \
        SBAR(); __builtin_amdgcn_s_setprio(1); \
        _Pragma("unroll") for (int m = 0; m < 2; ++m) _Pragma("unroll") for (int n = 0; n < 2; ++n) \
            acc[m][n] = __builtin_amdgcn_mfma_scale_f32_32x32x64_f8f6f4(Wf[n], Xf[m], acc[m][n], 0, 0, 0, 0x79797979, 0, SCALE_X); \
        __builtin_amdgcn_s_setprio(0); SBAR(); } while (0)
    if (tid < 8) ring_cnt[tid] = 0u;
    H_STAGE_A(0, 0, 0); H_STAGE_A(1, 0, 0); H_STAGE_A(0, 1, 1); H_STAGE_A(1, 1, 1);
#pragma unroll
    for (int i = 0; i < 4; ++i) H_ISSUE_B(i, 0);
    WAIT_V4(0, sb[0], sb[1], sb[2], sb[3]);
#pragma unroll
    for (int i = 0; i < 4; ++i) H_WRITE_B(i, 0);
    SBAR();
#pragma unroll
    for (int i = 0; i < 4; ++i) H_ISSUE_B(i, 1);
    WAIT_V4(0, sb[0], sb[1], sb[2], sb[3]);
#pragma unroll
    for (int i = 0; i < 4; ++i) H_WRITE_B(i, 1);
    SBAR();
    H_STAGE_A(0, 2, 2); H_STAGE_A(1, 2, 2);
#pragma unroll
    for (int i = 0; i < 4; ++i) H_ISSUE_B(i, 2);
    SBAR();
    RAW_BARRIER();
    int sa_r = 0, sa_w = 3, sb_r = 0, sb_w = 2;
#pragma unroll 1
    for (int t = 0; t < nt; ++t) {
        if (t >= 2) {
            const unsigned need = (unsigned)(t - 1);
            for (;;) { asm volatile("" ::: "memory"); const unsigned v = *(volatile LAS unsigned*)(ring_cnt + (lane & 7)); if (__all(v >= need)) break; __builtin_amdgcn_s_sleep(1); }
            asm volatile("" ::: "memory");
        }
        const int k3 = (t + 3 < nt) ? t + 3 : nt - 1;
        H_STAGE_A(0, k3, sa_w); H_STAGE_A(1, k3, sa_w);
        H_KSTEP(sa_r, sb_r);
        WAIT_V4(2, sb[0], sb[1], sb[2], sb[3]);
        H_WRITE_B(0, sb_w); H_WRITE_B(1, sb_w); H_WRITE_B(2, sb_w); H_WRITE_B(3, sb_w); SBAR();
        H_ISSUE_B(0, k3); H_ISSUE_B(1, k3); H_ISSUE_B(2, k3); H_ISSUE_B(3, k3); SBAR();
        asm volatile("" ::: "memory");
        if (lane == 0) *(volatile LAS unsigned*)(ring_cnt + wid) = (unsigned)(t + 1);
        asm volatile("" ::: "memory");
        sa_r = (sa_r == A8_RING - 1) ? 0 : sa_r + 1; sa_w = (sa_w == A8_RING - 1) ? 0 : sa_w + 1;
        sb_r = (sb_r == B8_RING - 1) ? 0 : sb_r + 1; sb_w = (sb_w == B8_RING - 1) ? 0 : sb_w + 1;
    }
    WAIT_V4(0, sb[0], sb[1], sb[2], sb[3]);
    RAW_BARRIER();
    epi.fin(acc, wr, wc, r32, hi);
#undef H_STAGE_A
#undef H_ISSUE_B
#undef H_WRITE_B
#undef H_KSTEP
}

constexpr int C8_B_TILE = 16384, C8_B_OFF = A8_RING * A8_TILE_B;
template <int SCALE_X, class AF, class EPI>
__device__ __forceinline__ void gemm_unit8b(LAS char* lds, LAS unsigned* ring_cnt, const int nt, const AF& af, const unsigned char* img, EPI& epi) {
    const int tid = threadIdx.x, wid = __builtin_amdgcn_readfirstlane(tid >> 6), lane = tid & 63, wr = wid >> 2, wc = wid & 3, r32 = lane & 31, hi = lane >> 5;
    const char* abase = uniform_ptr(af.base);
    unsigned aoff[2];
#pragma unroll
    for (int i = 0; i < 2; ++i) { const int R = wid * 16 + i * 128 + (lane >> 2), C = ((lane & 3) ^ ((lane >> 4) & 3)) * 16; aoff[i] = af.rowoff(R) + (unsigned)C; }
    const unsigned lds_u = (unsigned)__builtin_amdgcn_readfirstlane((int)(unsigned)(size_t)lds) + (unsigned)(wid * 1024);
    const char* ibase = uniform_ptr(img);
    const unsigned ioff = (unsigned)(wid * 1024 + lane * 16);
    const int b_wr = C8_B_OFF + wid * 1024 + lane * 16;
    const int a_rd0 = (wr * 128 + r32) * 64 + (((2 * hi) ^ ((r32 >> 2) & 3)) << 4), a_rd1 = a_rd0 ^ 16;
    const int q8 = (lane & 15) >> 1;
    const int b_rd0 = C8_B_OFF + (32 * hi + q8) * 256 + ((wc * 64 + 16 * ((lane >> 4) & 1) + 8 * (lane & 1)) ^ (q8 << 5)), b_rd1 = b_rd0 ^ 32;
    i32x4 sv[2];
#define C_STAGE_A(i, kt, slot) glds16s(abase + (size_t)(kt) * 64, aoff[i], lds_u + (unsigned)((slot) * A8_TILE_B + (i) * 8192))
#define C_ISSUE_B(i, kt) asm volatile("s_nop 4\n\tglobal_load_dwordx4 %0, %1, %2" : "=v"(sv[i]) : "v"(ioff), "s"(ibase + (size_t)(kt) * 16384 + (i) * 8192) : "memory")
#define C_WRITE_B(i, slot) *(LAS i32x4*)(lds + (slot) * C8_B_TILE + b_wr + (i) * 8192) = sv[i]
#define C_WAIT(n) asm volatile("s_waitcnt vmcnt(" #n ")" : "+v"(sv[0]), "+v"(sv[1]) :: "memory")
    if (tid < 8) ring_cnt[tid] = 0u;
    C_STAGE_A(0, 0, 0); C_STAGE_A(1, 0, 0); C_STAGE_A(0, 1, 1); C_STAGE_A(1, 1, 1);
    C_ISSUE_B(0, 0); C_ISSUE_B(1, 0); C_WAIT(0); C_WRITE_B(0, 0); C_WRITE_B(1, 0); SBAR();
    C_ISSUE_B(0, 1); C_ISSUE_B(1, 1); C_WAIT(0); C_WRITE_B(0, 1); C_WRITE_B(1, 1); SBAR();
    C_STAGE_A(0, 2, 2); C_STAGE_A(1, 2, 2);
    C_ISSUE_B(0, 2); C_ISSUE_B(1, 2);
    SBAR();
    f32x16 acc[4][2];
#pragma unroll
    for (int m = 0; m < 4; ++m)
#pragma unroll
        for (int n = 0; n < 2; ++n)
#pragma unroll
            for (int r = 0; r < 16; ++r) acc[m][n][r] = 0.f;
    RAW_BARRIER();
    int sa_r = 0, sa_w = 3, sb_r = 0, sb_w = 2;
#pragma unroll 1
    for (int t = 0; t < nt; ++t) {
        if (t >= 2) { const unsigned need = (unsigned)(t - 1);
            for (;;) { asm volatile("" ::: "memory"); const unsigned v = *(volatile LAS unsigned*)(ring_cnt + (lane & 7)); if (__all(v >= need)) break; __builtin_amdgcn_s_sleep(1); }
            asm volatile("" ::: "memory"); }
        const int k3 = (t + 3 < nt) ? t + 3 : nt - 1;
        C_STAGE_A(0, k3, sa_w); C_STAGE_A(1, k3, sa_w);
        { v8i Xf[4], Wf[2];
#pragma unroll
          for (int r = 0; r < 4; ++r) { const v2i t0_ = vtr8(lds + sb_r * C8_B_TILE + b_rd0 + r * 2048), t1_ = vtr8(lds + sb_r * C8_B_TILE + b_rd1 + r * 2048); Wf[0][2 * r] = t0_[0]; Wf[0][2 * r + 1] = t0_[1]; Wf[1][2 * r] = t1_[0]; Wf[1][2 * r + 1] = t1_[1]; }
#pragma unroll
          for (int m = 0; m < 4; ++m) { const i32x4 lo_ = *(const LAS i32x4*)(lds + sa_r * A8_TILE_B + a_rd0 + m * 2048), hi_ = *(const LAS i32x4*)(lds + sa_r * A8_TILE_B + a_rd1 + m * 2048);
              Xf[m] = (v8i){lo_[0], lo_[1], lo_[2], lo_[3], hi_[0], hi_[1], hi_[2], hi_[3]}; }
          SBAR(); __builtin_amdgcn_s_setprio(1);
#pragma unroll
          for (int m = 0; m < 4; ++m)
#pragma unroll
              for (int n = 0; n < 2; ++n) acc[m][n] = __builtin_amdgcn_mfma_scale_f32_32x32x64_f8f6f4(Wf[n], Xf[m], acc[m][n], 0, 0, 0, 0x79797979, 0, SCALE_X);
          __builtin_amdgcn_s_setprio(0); SBAR(); }
        C_WAIT(2);
        C_WRITE_B(0, sb_w); C_WRITE_B(1, sb_w); SBAR();
        C_ISSUE_B(0, k3); C_ISSUE_B(1, k3); SBAR();
        asm volatile("" ::: "memory");
        if (lane == 0) *(volatile LAS unsigned*)(ring_cnt + wid) = (unsigned)(t + 1);
        asm volatile("" ::: "memory");
        sa_r = (sa_r == A8_RING - 1) ? 0 : sa_r + 1; sa_w = (sa_w == A8_RING - 1) ? 0 : sa_w + 1;
        sb_r = (sb_r == B8_RING - 1) ? 0 : sb_r + 1; sb_w = (sb_w == B8_RING - 1) ? 0 : sb_w + 1;
    }
    C_WAIT(0);
    RAW_BARRIER();
    epi.fin(acc, wr, wc, r32, hi);
#undef C_STAGE_A
#undef C_ISSUE_B
#undef C_WRITE_B
#undef C_WAIT
}
template <int SCALE_X, class AF, class EPI>
__device__ __forceinline__ void gemm_unit8bh(LAS char* lds, LAS unsigned* ring_cnt, const int nt, const AF& af, const unsigned char* img, const int hf, EPI& epi) {
    const int tid = threadIdx.x, wid = __builtin_amdgcn_readfirstlane(tid >> 6), lane = tid & 63, wr = wid >> 2, wc = wid & 3, r32 = lane & 31, hi = lane >> 5;
    const char* abase = uniform_ptr(af.base);
    unsigned aoff[2];
#pragma unroll
    for (int i = 0; i < 2; ++i) { const int R = wid * 16 + i * 128 + (lane >> 2), C = ((lane & 3) ^ ((lane >> 4) & 3)) * 16; aoff[i] = af.rowoff(R) + (unsigned)C; }
    const unsigned lds_u = (unsigned)__builtin_amdgcn_readfirstlane((int)(unsigned)(size_t)lds) + (unsigned)(wid * 1024);
    const char* ibase = uniform_ptr(img);
    const unsigned ioff = (unsigned)(wid * 1024 + lane * 16);
    const int b_wr = C8_B_OFF + wid * 1024 + lane * 16;
    const int a_rd0 = (wr * 128 + r32) * 64 + (((2 * hi) ^ ((r32 >> 2) & 3)) << 4), a_rd1 = a_rd0 ^ 16;
    const int q8 = (lane & 15) >> 1;
    const int b_rd0 = C8_B_OFF + (32 * hi + q8) * 256 + ((hf * 128 + wc * 32 + 16 * ((lane >> 4) & 1) + 8 * (lane & 1)) ^ (q8 << 5));
    i32x4 sv[2];
#define C_STAGE_A(i, kt, slot) glds16s(abase + (size_t)(kt) * 64, aoff[i], lds_u + (unsigned)((slot) * A8_TILE_B + (i) * 8192))
#define C_ISSUE_B(i, kt) asm volatile("s_nop 4\n\tglobal_load_dwordx4 %0, %1, %2" : "=v"(sv[i]) : "v"(ioff), "s"(ibase + (size_t)(kt) * 16384 + (i) * 8192) : "memory")
#define C_WRITE_B(i, slot) *(LAS i32x4*)(lds + (slot) * C8_B_TILE + b_wr + (i) * 8192) = sv[i]
#define C_WAIT(n) asm volatile("s_waitcnt vmcnt(" #n ")" : "+v"(sv[0]), "+v"(sv[1]) :: "memory")
    if (tid < 8) ring_cnt[tid] = 0u;
    C_STAGE_A(0, 0, 0); C_STAGE_A(1, 0, 0); C_STAGE_A(0, 1, 1); C_STAGE_A(1, 1, 1);
    C_ISSUE_B(0, 0); C_ISSUE_B(1, 0); C_WAIT(0); C_WRITE_B(0, 0); C_WRITE_B(1, 0); SBAR();
    C_ISSUE_B(0, 1); C_ISSUE_B(1, 1); C_WAIT(0); C_WRITE_B(0, 1); C_WRITE_B(1, 1); SBAR();
    C_STAGE_A(0, 2, 2); C_STAGE_A(1, 2, 2);
    C_ISSUE_B(0, 2); C_ISSUE_B(1, 2);
    SBAR();
    f32x16 acc[4][1];
#pragma unroll
    for (int m = 0; m < 4; ++m)
#pragma unroll
        for (int n = 0; n < 1; ++n)
#pragma unroll
            for (int r = 0; r < 16; ++r) acc[m][n][r] = 0.f;
    RAW_BARRIER();
    int sa_r = 0, sa_w = 3, sb_r = 0, sb_w = 2;
#pragma unroll 1
    for (int t = 0; t < nt; ++t) {
        if (t >= 2) { const unsigned need = (unsigned)(t - 1);
            for (;;) { asm volatile("" ::: "memory"); const unsigned v = *(volatile LAS unsigned*)(ring_cnt + (lane & 7)); if (__all(v >= need)) break; __builtin_amdgcn_s_sleep(1); }
            asm volatile("" ::: "memory"); }
        const int k3 = (t + 3 < nt) ? t + 3 : nt - 1;
        C_STAGE_A(0, k3, sa_w); C_STAGE_A(1, k3, sa_w);
        { v8i Xf[4], Wf[1];
#pragma unroll
          for (int r = 0; r < 4; ++r) { const v2i t0_ = vtr8(lds + sb_r * C8_B_TILE + b_rd0 + r * 2048); Wf[0][2 * r] = t0_[0]; Wf[0][2 * r + 1] = t0_[1]; }
#pragma unroll
          for (int m = 0; m < 4; ++m) { const i32x4 lo_ = *(const LAS i32x4*)(lds + sa_r * A8_TILE_B + a_rd0 + m * 2048), hi_ = *(const LAS i32x4*)(lds + sa_r * A8_TILE_B + a_rd1 + m * 2048);
              Xf[m] = (v8i){lo_[0], lo_[1], lo_[2], lo_[3], hi_[0], hi_[1], hi_[2], hi_[3]}; }
          SBAR(); __builtin_amdgcn_s_setprio(1);
#pragma unroll
          for (int m = 0; m < 4; ++m)
#pragma unroll
              for (int n = 0; n < 1; ++n) acc[m][n] = __builtin_amdgcn_mfma_scale_f32_32x32x64_f8f6f4(Wf[n], Xf[m], acc[m][n], 0, 0, 0, 0x79797979, 0, SCALE_X);
          __builtin_amdgcn_s_setprio(0); SBAR(); }
        C_WAIT(2);
        C_WRITE_B(0, sb_w); C_WRITE_B(1, sb_w); SBAR();
        C_ISSUE_B(0, k3); C_ISSUE_B(1, k3); SBAR();
        asm volatile("" ::: "memory");
        if (lane == 0) *(volatile LAS unsigned*)(ring_cnt + wid) = (unsigned)(t + 1);
        asm volatile("" ::: "memory");
        sa_r = (sa_r == A8_RING - 1) ? 0 : sa_r + 1; sa_w = (sa_w == A8_RING - 1) ? 0 : sa_w + 1;
        sb_r = (sb_r == B8_RING - 1) ? 0 : sb_r + 1; sb_w = (sb_w == B8_RING - 1) ? 0 : sb_w + 1;
    }
    C_WAIT(0);
    RAW_BARRIER();
    epi.fin(acc, wr, wc, r32, hi);
#undef C_STAGE_A
#undef C_ISSUE_B
#undef C_WRITE_B
#undef C_WAIT
}

__device__ __forceinline__ void conv_image(const float* W, size_t ld, unsigned char* img, int t0, int t1) {
    const int tid = threadIdx.x, wid = tid >> 6, lane = tid & 63;
    const float* wp = W + (size_t)wid * ld + 4 * lane;
    unsigned char* ip = img + wid * 256 + ((4 * lane) ^ (wid << 5));
    for (int t = t0; t < t1; t += 4) { f32x4 v[4][8];
#pragma unroll
        for (int u = 0; u < 4; ++u)
#pragma unroll
            for (int i = 0; i < 8; ++i) v[u][i] = *(const f32x4*)(wp + ((size_t)(t + u) * 64 + i * 8) * ld);
#pragma unroll
        for (int u = 0; u < 4; ++u)
#pragma unroll
            for (int i = 0; i < 8; ++i) *(unsigned*)(ip + (size_t)(t + u) * 16384 + i * 2048) = pk4_fp8_x64(v[u][i]); }
}

struct Params {
    const float *x, *attn_norm, *w_in, *a_sink, *b_q_norm, *b_w_uq, *b_kv_norm, *b_w_ukv, *out_norm_a, *out_norm_b, *w_o, *mlp_norm, *w_router, *b_router,
        *w_up, *b_up, *w_down, *b_down, *final_norm;
    float* out; unsigned char* ws; int ph_lo, ph_hi;
};

struct ARows { const bf16_t* base; unsigned ld; __device__ __forceinline__ unsigned rowoff(int r) const { return (unsigned)r * ld; } };
struct AGather { const bf16_t* base; const int* tokl; int r0, cnt; __device__ __forceinline__ unsigned rowoff(int r) const { int rk = r0 + r; rk = rk < cnt ? rk : 0; return (unsigned)tokl[rk] * (unsigned)D_MODEL; } };
struct ARows8 { const unsigned char* base; unsigned ld; __device__ __forceinline__ unsigned rowoff(int r) const { return (unsigned)r * ld; } };
struct AGather8 { const unsigned char* base; const int* tokl; int r0, cnt; __device__ __forceinline__ unsigned rowoff(int r) const { int rk = r0 + r; rk = rk < cnt ? rk : 0; return (unsigned)tokl[rk] * (unsigned)D_MODEL; } };
struct BPlain { const float* base; size_t ld; int ncols;
    __device__ __forceinline__ unsigned coloff(int c) const { return (unsigned)(c < ncols ? c : (c & (ncols - 1))); } };
struct BGateUp { const float* base; size_t ld;
    __device__ __forceinline__ unsigned coloff(int c) const { const int wc = c >> 6, w = c & 63; return (unsigned)(wc * 32 + (w & 31) + ((w & 32) ? D_FF : 0)); } };

struct EpiProj {
    int pn, brow; unsigned char* ws; const float *qg, *kvg;
    __device__ __forceinline__ void mid(f32x4 (&)[8][4], int, int, int, int) {}
    __device__ __forceinline__ void fin(f32x4 (&acc)[8][4], int wr, int wc, int fr, int fq) {
        if (pn < 6) {
            bf16_t* dst; int ldd, c0;
            if (pn < 4) { dst = (bf16_t*)(ws + WS_QA); ldd = 1024; c0 = pn * 256; } else if (pn == 4) { dst = (bf16_t*)(ws + WS_KA); ldd = 256; c0 = 0; } else { dst = (bf16_t*)(ws + WS_VA); ldd = 256; c0 = 0; }
#pragma unroll
            for (int m = 0; m < 8; ++m) { const int row = brow + wr * 128 + m * 16 + fr;
#pragma unroll
                for (int n = 0; n < 4; ++n) { const int col = c0 + wc * 64 + n * 16 + fq * 4; const f32x4 v = acc[m][n];
                    *(u32x2*)(dst + (size_t)row * ldd + col) = (u32x2){pk_bf16(v[0], v[1]), pk_bf16(v[2], v[3])}; } }
        } else if (pn < 9) {
            bf16_t* dst; int ldd, c0; const float* g; float* ssq; int nsl, sl;
            if (pn < 8) { dst = (bf16_t*)(ws + WS_CQ); ldd = 512; c0 = (pn - 6) * 256; g = qg; ssq = (float*)(ws + WS_SSQC); nsl = 8; sl = (pn - 6) * 4 + wc; }
            else { dst = (bf16_t*)(ws + WS_CKV); ldd = 256; c0 = 0; g = kvg; ssq = (float*)(ws + WS_SSQK); nsl = 4; sl = wc; }
            f32x4 gvv[4];
#pragma unroll
            for (int n = 0; n < 4; ++n) gvv[n] = *(const f32x4*)(g + c0 + wc * 64 + n * 16 + fq * 4);
#pragma unroll
            for (int m = 0; m < 8; ++m) { const int row = brow + wr * 128 + m * 16 + fr; float ss = 0.f;
#pragma unroll
                for (int n = 0; n < 4; ++n) { const int col = c0 + wc * 64 + n * 16 + fq * 4; const f32x4 v = acc[m][n]; const f32x4 gv = gvv[n];
                    ss += v[0] * v[0] + v[1] * v[1] + v[2] * v[2] + v[3] * v[3];
                    *(u32x2*)(dst + (size_t)row * ldd + col) = (u32x2){pk_bf16(v[0] * gv[0], v[1] * gv[1]), pk_bf16(v[2] * gv[2], v[3] * gv[3])}; }
                ss += __shfl_xor(ss, 16, 64); ss += __shfl_xor(ss, 32, 64);
                if (fq == 0) ssq[(size_t)row * nsl + sl] = ss; }
        } else {
            if (wc == 0) {
                bf16_t* dst = (bf16_t*)(ws + WS_KPE); const float* rope = (const float*)(ws + WS_ROPE);
#pragma unroll
                for (int m = 0; m < 8; ++m) { const int row = brow + wr * 128 + m * 16 + fr; const int pos = row & (SEQ - 1);
#pragma unroll
                    for (int n = 0; n < 2; ++n) { const int i0 = n * 16 + fq * 4; const f32x4 x1 = acc[m][n], x2 = acc[m][n + 2];
                        const f32x4 cs0 = *(const f32x4*)(rope + ((size_t)pos * 32 + i0) * 2), cs1 = *(const f32x4*)(rope + ((size_t)pos * 32 + i0) * 2 + 4);
                        const float c[4] = {cs0[0], cs0[2], cs1[0], cs1[2]}, s[4] = {cs0[1], cs0[3], cs1[1], cs1[3]};
                        float o1[4], o2[4];
#pragma unroll
                        for (int j = 0; j < 4; ++j) { o1[j] = x1[j] * c[j] - x2[j] * s[j]; o2[j] = x1[j] * s[j] + x2[j] * c[j]; }
                        *(u32x2*)(dst + (size_t)row * 64 + i0) = (u32x2){pk_bf16(o1[0], o1[1]), pk_bf16(o1[2], o1[3])};
                        *(u32x2*)(dst + (size_t)row * 64 + 32 + i0) = (u32x2){pk_bf16(o2[0], o2[1]), pk_bf16(o2[2], o2[3])}; } }
            }
        }
    }
};
struct EpiQUp {
    int pn, brow; unsigned char* ws;
    __device__ __forceinline__ void mid(f32x4 (&)[8][4], int, int, int, int) {}
    __device__ __forceinline__ void fin(f32x4 (&acc)[8][4], int wr, int wc, int fr, int fq) {
        bf16_t* dst = (bf16_t*)(ws + WS_QB); const float* rope = (const float*)(ws + WS_ROPE); const float* ssq = (const float*)(ws + WS_CTL + CTL_SSQ_CQ);
        const int seg = pn * 4 + wc, head = seg / 3, part = seg - head * 3;
        float sq[8];
#pragma unroll
        for (int m = 0; m < 8; ++m) { const f32x4* pp = (const f32x4*)((const float*)(ws + WS_SSQC) + (size_t)(brow + wr * 128 + m * 16 + fr) * 8); const f32x4 p0 = pp[0], p1 = pp[1];
            sq[m] = ((p0[0] + p0[1]) + (p0[2] + p0[3])) + ((p1[0] + p1[1]) + (p1[2] + p1[3])); }
#pragma unroll
        for (int m = 0; m < 8; ++m) { const int row = brow + wr * 128 + m * 16 + fr; const float rs = rsqrtf(sq[m] * (1.f / 512.f) + EPS);
            bf16_t* drow = dst + (size_t)row * 1536 + head * 192 + part * 64;
            if (part < 2) {
#pragma unroll
                for (int n = 0; n < 4; ++n) { const f32x4 v = acc[m][n]; *(u32x2*)(drow + n * 16 + fq * 4) = (u32x2){pk_bf16(v[0] * rs, v[1] * rs), pk_bf16(v[2] * rs, v[3] * rs)}; }
            } else { const int pos = row & (SEQ - 1);
#pragma unroll
                for (int n = 0; n < 2; ++n) { const int i0 = n * 16 + fq * 4; const f32x4 x1 = acc[m][n], x2 = acc[m][n + 2];
                    const f32x4 cs0 = *(const f32x4*)(rope + ((size_t)pos * 32 + i0) * 2), cs1 = *(const f32x4*)(rope + ((size_t)pos * 32 + i0) * 2 + 4);
                    const float c[4] = {cs0[0], cs0[2], cs1[0], cs1[2]}, s[4] = {cs0[1], cs0[3], cs1[1], cs1[3]};
                    float o1[4], o2[4];
#pragma unroll
                    for (int j = 0; j < 4; ++j) { o1[j] = (x1[j] * c[j] - x2[j] * s[j]) * rs; o2[j] = (x1[j] * s[j] + x2[j] * c[j]) * rs; }
                    *(u32x2*)(drow + i0) = (u32x2){pk_bf16(o1[0], o1[1]), pk_bf16(o1[2], o1[3])};
                    *(u32x2*)(drow + 32 + i0) = (u32x2){pk_bf16(o2[0], o2[1]), pk_bf16(o2[2], o2[3])}; } }
        }
    }
};
struct EpiKvUp {
    int pn, brow; unsigned char* ws;
    __device__ __forceinline__ void mid(f32x4 (&)[8][4], int, int, int, int) {}
    __device__ __forceinline__ void fin(f32x4 (&acc)[8][4], int wr, int wc, int fr, int fq) {
        bf16_t* dst = (bf16_t*)(ws + WS_KVB);
        float sq[8];
#pragma unroll
        for (int m = 0; m < 8; ++m) { const f32x4 p0 = *(const f32x4*)((const float*)(ws + WS_SSQK) + (size_t)(brow + wr * 128 + m * 16 + fr) * 4); sq[m] = (p0[0] + p0[1]) + (p0[2] + p0[3]); }
#pragma unroll
        for (int m = 0; m < 8; ++m) { const int row = brow + wr * 128 + m * 16 + fr; const float rs = rsqrtf(sq[m] * (1.f / 256.f) + EPS);
#pragma unroll
            for (int n = 0; n < 4; ++n) { const int col = pn * 256 + wc * 64 + n * 16 + fq * 4; const f32x4 v = acc[m][n];
                *(u32x2*)(dst + (size_t)row * 2048 + col) = (u32x2){pk_bf16(v[0] * rs, v[1] * rs), pk_bf16(v[2] * rs, v[3] * rs)}; } }
    }
};
struct EpiWo {
    int pn, brow; unsigned char* ws; const float* x; const LAS float* tab;
    __device__ __forceinline__ void mid(f32x4 (&acc)[8][4], int wr, int wc, int fr, int fq) {
#pragma unroll
        for (int m = 0; m < 8; ++m) { const int r = wr * 128 + m * 16 + fr;
            const float f = __builtin_amdgcn_sqrtf((tab[256 + r] + EPS) * __builtin_amdgcn_rcpf(tab[r] + EPS));
#pragma unroll
            for (int n = 0; n < 4; ++n) acc[m][n] *= f;
            SBAR(); }
    }
    __device__ __forceinline__ void fin(f32x4 (&acc)[8][4], int wr, int wc, int fr, int fq) {
        float* x2 = (float*)(ws + WS_X2);
#pragma unroll
        for (int m = 0; m < 8; ++m) { const int r = wr * 128 + m * 16 + fr, row = brow + r; const float rbm = rsqrtf(tab[256 + r] + EPS); f32x4 xv[4];
#pragma unroll
            for (int n = 0; n < 4; ++n) xv[n] = *(const f32x4*)(x + (size_t)row * D_MODEL + pn * 256 + wc * 64 + n * 16 + fq * 4);
#pragma unroll
            for (int n = 0; n < 4; ++n) { const int col = pn * 256 + wc * 64 + n * 16 + fq * 4;
                const f32x4 v = acc[m][n] * rbm + xv[n];
                *(f32x4*)(x2 + (size_t)row * D_MODEL + col) = v; } }
    }
};
struct EpiUp8 {
    int j0, r0, cnt; unsigned char* dst; const float* bias;
    __device__ __forceinline__ void fin(f32x16 (&acc)[4][2], int wr, int wc, int r32, int hi) {
        f32x4 bg[4], bu[4];
#pragma unroll
        for (int rg = 0; rg < 4; ++rg) { const int j = j0 + wc * 32 + 8 * rg + 4 * hi; bg[rg] = *(const f32x4*)(bias + j); bu[rg] = *(const f32x4*)(bias + D_FF + j); }
#pragma unroll
        for (int m = 0; m < 4; ++m) { const int r = wr * 128 + m * 32 + r32; unsigned o8[4];
#pragma unroll
            for (int rg = 0; rg < 4; ++rg) { float o[4];
#pragma unroll
                for (int q = 0; q < 4; ++q) { const float g = fminf(acc[m][0][4 * rg + q] + bg[rg][q], 7.f), u = fminf(fmaxf(acc[m][1][4 * rg + q] + bu[rg][q], -7.f), 7.f);
                    const float sg = __builtin_amdgcn_rcpf(1.f + __builtin_amdgcn_exp2f(-1.702f * LOG2E * g)); o[q] = 4.f * (u + 1.f) * (g * sg); }
                o8[rg] = pk4_fp8(o[0], o[1], o[2], o[3]); }
            if (r0 + r < cnt) {
#pragma unroll
                for (int rg = 0; rg < 4; ++rg) *(unsigned*)(dst + (size_t)r * D_FF + j0 + wc * 32 + 8 * rg + 4 * hi) = o8[rg]; }
        }
    }
};
struct EpiUp8q {
    int j0, r0, cnt; unsigned char* dst; const float* bias;
    __device__ __forceinline__ void fin(f32x16 (&acc)[2][2], int wr, int wc, int r32, int hi) {
        f32x4 bg[4], bu[4];
#pragma unroll
        for (int rg = 0; rg < 4; ++rg) { const int j = j0 + wc * 32 + 8 * rg + 4 * hi; bg[rg] = *(const f32x4*)(bias + j); bu[rg] = *(const f32x4*)(bias + D_FF + j); }
#pragma unroll
        for (int m = 0; m < 2; ++m) { const int r = wr * 64 + m * 32 + r32; unsigned o8[4];
#pragma unroll
            for (int rg = 0; rg < 4; ++rg) { float o[4];
#pragma unroll
                for (int q = 0; q < 4; ++q) { const float g = fminf(acc[m][0][4 * rg + q] + bg[rg][q], 7.f), u = fminf(fmaxf(acc[m][1][4 * rg + q] + bu[rg][q], -7.f), 7.f);
                    const float sg = __builtin_amdgcn_rcpf(1.f + __builtin_amdgcn_exp2f(-1.702f * LOG2E * g)); o[q] = 4.f * (u + 1.f) * (g * sg); }
                o8[rg] = pk4_fp8(o[0], o[1], o[2], o[3]); }
            if (r0 + r < cnt) {
#pragma unroll
                for (int rg = 0; rg < 4; ++rg) *(unsigned*)(dst + (size_t)r * D_FF + j0 + wc * 32 + 8 * rg + 4 * hi) = o8[rg]; }
        }
    }
};
struct EpiDown8 {
    int c0, r0, cnt; bf16_t* dst; const float* bias;
    __device__ __forceinline__ void fin(f32x16 (&acc)[4][2], int wr, int wc, int r32, int hi) {
        f32x4 b[2][4];
#pragma unroll
        for (int n = 0; n < 2; ++n)
#pragma unroll
            for (int rg = 0; rg < 4; ++rg) b[n][rg] = *(const f32x4*)(bias + c0 + wc * 64 + n * 32 + 8 * rg + 4 * hi);
#pragma unroll
        for (int m = 0; m < 4; ++m) { const int r = wr * 128 + m * 32 + r32;
            if (r0 + r < cnt) {
#pragma unroll
                for (int n = 0; n < 2; ++n)
#pragma unroll
                    for (int rg = 0; rg < 4; ++rg) { const int col = c0 + wc * 64 + n * 32 + 8 * rg + 4 * hi;
                        *(u32x2*)(dst + (size_t)r * D_MODEL + col) = (u32x2){pk_bf16(acc[m][n][4 * rg] + b[n][rg][0], acc[m][n][4 * rg + 1] + b[n][rg][1]), pk_bf16(acc[m][n][4 * rg + 2] + b[n][rg][2], acc[m][n][4 * rg + 3] + b[n][rg][3])}; } }
        }
    }
};
struct EpiDown8h {
    int c0, r0, cnt; bf16_t* dst; const float* bias;
    __device__ __forceinline__ void fin(f32x16 (&acc)[4][1], int wr, int wc, int r32, int hi) {
        f32x4 b[1][4];
#pragma unroll
        for (int n = 0; n < 1; ++n)
#pragma unroll
            for (int rg = 0; rg < 4; ++rg) b[n][rg] = *(const f32x4*)(bias + c0 + wc * 32 + n * 32 + 8 * rg + 4 * hi);
#pragma unroll
        for (int m = 0; m < 4; ++m) { const int r = wr * 128 + m * 32 + r32;
            if (r0 + r < cnt) {
#pragma unroll
                for (int n = 0; n < 1; ++n)
#pragma unroll
                    for (int rg = 0; rg < 4; ++rg) { const int col = c0 + wc * 32 + n * 32 + 8 * rg + 4 * hi;
                        *(u32x2*)(dst + (size_t)r * D_MODEL + col) = (u32x2){pk_bf16(acc[m][n][4 * rg] + b[n][rg][0], acc[m][n][4 * rg + 1] + b[n][rg][1]), pk_bf16(acc[m][n][4 * rg + 2] + b[n][rg][2], acc[m][n][4 * rg + 3] + b[n][rg][3])}; } }
        }
    }
};

constexpr int PG_HTB = 128 * 64 * 2;
__host__ __device__ __forceinline__ int pg_lds_byte(int r, int c) { const int st = (r >> 4) * 2 + (c >> 5), rr = r & 15, cc = c & 31, ob = rr * 64 + cc * 2; return st * 1024 + (ob ^ (((ob >> 9) & 1) << 5)); }
__host__ __device__ __forceinline__ void pg_stage_rc(int b, int& R, int& C) { const int st = b / 1024, sb = b % 1024, swz = sb ^ (((sb >> 9) & 1) << 5); R = (st >> 1) * 16 + swz / 64; C = (st & 1) * 32 + (swz % 64) / 2; }
__host__ __device__ __forceinline__ int pg_tcol(int rho) { return (rho & ~0x30) | ((rho & 0x10) << 1) | ((rho & 0x20) >> 1); }
template <bool MID, class EPI>
__device__ __forceinline__ void gemm_unit_pg(LAS char* lds, const bf16_t* A, const bf16_t* Bt, const int K, EPI& E) {
    const int tid = threadIdx.x, wid = __builtin_amdgcn_readfirstlane(tid >> 6), lane = tid & 63, wr = wid >> 2, wc = wid & 3, fr = lane & 15, fq = lane >> 4;
    const int nt = K / 64;
    unsigned voff[2];
#pragma unroll
    for (int i = 0; i < 2; ++i) { int R, C; pg_stage_rc(tid * 16 + i * 8192, R, C); voff[i] = (unsigned)(R * K + C) * 2u; }
    const size_t kstep = (size_t)(64 * 2), hstep = (size_t)128 * K * 2;
    const unsigned ldsw = (unsigned)wid * 1024u;
    const int aoff = pg_lds_byte(wr * 64 + fr, fq * 8), boff = pg_lds_byte(wc * 32 + fr, fq * 8);
#define PG_SA(b, h) (((b) * 2 + (h)) * PG_HTB)
#define PG_SB(b, h) ((4 + (b) * 2 + (h)) * PG_HTB)
#define PG_STAGE(bufoff, gbase) do { _Pragma("unroll") for (int _i = 0; _i < 2; ++_i) \
        __builtin_amdgcn_global_load_lds((const unsigned*)((const char*)(gbase) + voff[_i]), (LAS unsigned*)(lds + (bufoff) + ldsw + _i * 8192), 16, 0, 0); } while (0)
#define PG_LDA(dst, b, h) do { _Pragma("unroll") for (int m = 0; m < 4; ++m) _Pragma("unroll") for (int k = 0; k < 2; ++k) dst[m][k] = *(const LAS bf16x8*)(lds + PG_SA(b, h) + aoff + m * 2048 + k * 1024); } while (0)
#define PG_LDB(dst, b, h) do { _Pragma("unroll") for (int n = 0; n < 2; ++n) _Pragma("unroll") for (int k = 0; k < 2; ++k) dst[n][k] = *(const LAS bf16x8*)(lds + PG_SB(b, h) + boff + n * 2048 + k * 1024); } while (0)
#define PG_MMA(ai, bj, At_, Bt_) do { __builtin_amdgcn_s_setprio(1); _Pragma("unroll") for (int m = 0; m < 4; ++m) _Pragma("unroll") for (int n = 0; n < 2; ++n) _Pragma("unroll") for (int k = 0; k < 2; ++k) \
        acc[ai][bj][m][n] = __builtin_amdgcn_mfma_f32_16x16x32_bf16(Bt_[n][k], At_[m][k], acc[ai][bj][m][n], 0, 0, 0); __builtin_amdgcn_s_setprio(0); } while (0)
#define PG_WAIT_V(n) asm volatile("s_waitcnt vmcnt(" #n ")" ::: "memory")
#define PG_WAIT_L(n) asm volatile("s_waitcnt lgkmcnt(" #n ")" ::: "memory")
#define PG_BAR __builtin_amdgcn_s_barrier()
    f32x4 acc[2][2][4][2];
#pragma unroll
    for (int a = 0; a < 2; ++a)
#pragma unroll
        for (int b = 0; b < 2; ++b)
#pragma unroll
            for (int m = 0; m < 4; ++m)
#pragma unroll
                for (int n = 0; n < 2; ++n) acc[a][b][m][n] = (f32x4){0.f, 0.f, 0.f, 0.f};
    bf16x8 At[4][2], B0[2][2], B1[2][2];
    const char* cA = (const char*)A; const char* cB = (const char*)Bt;
    PG_STAGE(PG_SB(0, 0), cB); PG_STAGE(PG_SA(0, 0), cA); PG_STAGE(PG_SB(0, 1), cB + hstep); PG_STAGE(PG_SA(0, 1), cA + hstep);
    if (wr == 1) PG_BAR;
    PG_WAIT_V(4); PG_BAR;
    PG_STAGE(PG_SB(1, 0), cB + kstep); PG_STAGE(PG_SA(1, 0), cA + kstep); PG_STAGE(PG_SB(1, 1), cB + hstep + kstep);
    PG_WAIT_V(6); PG_BAR;
    for (int t = 0; t < nt; t += 2) {
        const bool last = (t == nt - 2);
        const char* a1 = cA + (size_t)(t + 1) * kstep;
        const char* a2 = cA + (size_t)(t + 2) * kstep; const char* b2 = cB + (size_t)(t + 2) * kstep;
        const char* a3 = a2 + kstep; const char* b3 = b2 + kstep;
        if (MID && t == (nt >> 1)) E.mid(acc, wr, wc, fr, fq);
        PG_LDB(B0, 0, 0); SBAR(); PG_LDA(At, 0, 0); PG_STAGE(PG_SA(1, 1), a1 + hstep);
        PG_WAIT_L(8); PG_BAR; PG_WAIT_L(0); PG_MMA(0, 0, At, B0); PG_BAR; SBAR();
        PG_LDB(B1, 0, 1); if (!last) PG_STAGE(PG_SB(0, 0), b2);
        PG_BAR; PG_WAIT_L(0); PG_MMA(0, 1, At, B1); PG_BAR;
        PG_LDA(At, 0, 1); if (!last) PG_STAGE(PG_SA(0, 0), a2);
        PG_BAR; PG_WAIT_L(0); PG_MMA(1, 0, At, B0); PG_BAR; SBAR();
        if (!last) { PG_STAGE(PG_SB(0, 1), b2 + hstep); PG_WAIT_V(6); } else PG_WAIT_V(0);
        PG_BAR; PG_MMA(1, 1, At, B1); PG_BAR;
        PG_LDB(B0, 1, 0); SBAR(); PG_LDA(At, 1, 0); if (!last) PG_STAGE(PG_SA(0, 1), a2 + hstep);
        PG_WAIT_L(8); PG_BAR; PG_WAIT_L(0); PG_MMA(0, 0, At, B0); PG_BAR; SBAR();
        PG_LDB(B1, 1, 1); if (!last) PG_STAGE(PG_SB(1, 0), b3);
        PG_BAR; PG_WAIT_L(0); PG_MMA(0, 1, At, B1); PG_BAR;
        PG_LDA(At, 1, 1); if (!last) PG_STAGE(PG_SA(1, 0), a3);
        PG_BAR; PG_WAIT_L(0); PG_MMA(1, 0, At, B0); PG_BAR; SBAR();
        if (!last) { PG_STAGE(PG_SB(1, 1), b3 + hstep); PG_WAIT_V(6); }
        PG_BAR; PG_MMA(1, 1, At, B1); PG_BAR;
    }
    E.fin(acc, wr, wc, fr, fq);
    PG_WAIT_V(0);
    if (wr == 0) PG_BAR;
    PG_BAR;
#undef PG_SA
#undef PG_SB
#undef PG_STAGE
#undef PG_LDA
#undef PG_LDB
#undef PG_MMA
#undef PG_WAIT_V
#undef PG_WAIT_L
#undef PG_BAR
}

#define PG_ROW(ai, m) (128 * (ai) + 64 * wr + 16 * (m) + fr)
#define PG_COL(bj, n) (128 * (bj) + 64 * (wc >> 1) + 32 * (n) + 16 * (wc & 1) + 4 * fq)
struct PEpiProj {
    int pn, brow; unsigned char* ws; const float *qg, *kvg;
    __device__ __forceinline__ void mid(f32x4 (&)[2][2][4][2], int, int, int, int) {}
    __device__ __forceinline__ void fin(f32x4 (&acc)[2][2][4][2], int wr, int wc, int fr, int fq) {
        if (pn < 6) {
            bf16_t* dst; int ldd, c0;
            if (pn < 4) { dst = (bf16_t*)(ws + WS_QA); ldd = 1024; c0 = pn * 256; } else if (pn == 4) { dst = (bf16_t*)(ws + WS_KA); ldd = 256; c0 = 0; } else { dst = (bf16_t*)(ws + WS_VA); ldd = 256; c0 = 0; }
#pragma unroll
            for (int ai = 0; ai < 2; ++ai)
#pragma unroll
                for (int m = 0; m < 4; ++m) { bf16_t* rowp = dst + (size_t)(brow + PG_ROW(ai, m)) * ldd + c0;
#pragma unroll
                    for (int bj = 0; bj < 2; ++bj)
#pragma unroll
                        for (int n = 0; n < 2; ++n) { const f32x4 v = acc[ai][bj][m][n]; *(u32x2*)(rowp + PG_COL(bj, n)) = (u32x2){pk_bf16(v[0], v[1]), pk_bf16(v[2], v[3])}; } }
        } else if (pn < 9) {
            bf16_t* dst; int ldd, c0; const float* g; float* ssq; int nsl, sl0;
            if (pn < 8) { dst = (bf16_t*)(ws + WS_CQ); ldd = 512; c0 = (pn - 6) * 256; g = qg; ssq = (float*)(ws + WS_SSQC); nsl = 16; sl0 = (pn - 6) * 8 + wc; }
            else { dst = (bf16_t*)(ws + WS_CKV); ldd = 256; c0 = 0; g = kvg; ssq = (float*)(ws + WS_SSQK); nsl = 8; sl0 = wc; }
            f32x4 gvv[2][2];
#pragma unroll
            for (int bj = 0; bj < 2; ++bj)
#pragma unroll
                for (int n = 0; n < 2; ++n) gvv[bj][n] = *(const f32x4*)(g + c0 + PG_COL(bj, n));
#pragma unroll
            for (int ai = 0; ai < 2; ++ai)
#pragma unroll
                for (int m = 0; m < 4; ++m) { const int row = brow + PG_ROW(ai, m);
#pragma unroll
                    for (int bj = 0; bj < 2; ++bj) { float ss = 0.f;
#pragma unroll
                        for (int n = 0; n < 2; ++n) { const f32x4 v = acc[ai][bj][m][n]; const f32x4 gv = gvv[bj][n];
                            ss += v[0] * v[0] + v[1] * v[1] + v[2] * v[2] + v[3] * v[3];
                            *(u32x2*)(dst + (size_t)row * ldd + c0 + PG_COL(bj, n)) = (u32x2){pk_bf16(v[0] * gv[0], v[1] * gv[1]), pk_bf16(v[2] * gv[2], v[3] * gv[3])}; }
                        ss += __shfl_xor(ss, 16, 64); ss += __shfl_xor(ss, 32, 64);
                        if (fq == 0) ssq[(size_t)row * nsl + sl0 + 4 * bj] = ss; } }
        } else {
            if (wc < 2) {
                bf16_t* dst = (bf16_t*)(ws + WS_KPE); const float* rope = (const float*)(ws + WS_ROPE); const int i0 = 16 * wc + 4 * fq;
#pragma unroll
                for (int ai = 0; ai < 2; ++ai)
#pragma unroll
                    for (int m = 0; m < 4; ++m) { const int row = brow + PG_ROW(ai, m); const int pos = row & (SEQ - 1); const f32x4 x1 = acc[ai][0][m][0], x2 = acc[ai][0][m][1];
                        const f32x4 cs0 = *(const f32x4*)(rope + ((size_t)pos * 32 + i0) * 2), cs1 = *(const f32x4*)(rope + ((size_t)pos * 32 + i0) * 2 + 4);
                        const float c[4] = {cs0[0], cs0[2], cs1[0], cs1[2]}, s[4] = {cs0[1], cs0[3], cs1[1], cs1[3]};
                        float o1[4], o2[4];
#pragma unroll
                        for (int j = 0; j < 4; ++j) { o1[j] = x1[j] * c[j] - x2[j] * s[j]; o2[j] = x1[j] * s[j] + x2[j] * c[j]; }
                        *(u32x2*)(dst + (size_t)row * 64 + i0) = (u32x2){pk_bf16(o1[0], o1[1]), pk_bf16(o1[2], o1[3])};
                        *(u32x2*)(dst + (size_t)row * 64 + 32 + i0) = (u32x2){pk_bf16(o2[0], o2[1]), pk_bf16(o2[2], o2[3])}; }
            }
        }
    }
};
struct PEpiQUp {
    int pn, brow; unsigned char* ws;
    __device__ __forceinline__ void mid(f32x4 (&)[2][2][4][2], int, int, int, int) {}
    __device__ __forceinline__ void fin(f32x4 (&acc)[2][2][4][2], int wr, int wc, int fr, int fq) {
        bf16_t* dst = (bf16_t*)(ws + WS_QB); const float* rope = (const float*)(ws + WS_ROPE);
        float rs[2][4];
#pragma unroll
        for (int ai = 0; ai < 2; ++ai)
#pragma unroll
            for (int m = 0; m < 4; ++m) { const f32x4* pp = (const f32x4*)((const float*)(ws + WS_SSQC) + (size_t)(brow + PG_ROW(ai, m)) * 16); const f32x4 p0 = pp[0], p1 = pp[1], p2 = pp[2], p3 = pp[3];
                const float sq = (((p0[0] + p0[1]) + (p0[2] + p0[3])) + ((p1[0] + p1[1]) + (p1[2] + p1[3]))) + (((p2[0] + p2[1]) + (p2[2] + p2[3])) + ((p3[0] + p3[1]) + (p3[2] + p3[3])));
                rs[ai][m] = rsqrtf(sq * (1.f / 512.f) + EPS); }
#pragma unroll
        for (int bj = 0; bj < 2; ++bj) { const int seg = pn * 4 + 2 * bj + (wc >> 1), head = seg / 3, part = seg - head * 3; const int i0 = 16 * (wc & 1) + 4 * fq;
#pragma unroll
            for (int ai = 0; ai < 2; ++ai)
#pragma unroll
                for (int m = 0; m < 4; ++m) { const int row = brow + PG_ROW(ai, m); const float r = rs[ai][m]; bf16_t* drow = dst + (size_t)row * 1536 + head * 192 + part * 64;
                    const f32x4 x1 = acc[ai][bj][m][0], x2 = acc[ai][bj][m][1];
                    if (part < 2) {
                        *(u32x2*)(drow + i0) = (u32x2){pk_bf16(x1[0] * r, x1[1] * r), pk_bf16(x1[2] * r, x1[3] * r)};
                        *(u32x2*)(drow + 32 + i0) = (u32x2){pk_bf16(x2[0] * r, x2[1] * r), pk_bf16(x2[2] * r, x2[3] * r)};
                    } else { const int pos = row & (SEQ - 1);
                        const f32x4 cs0 = *(const f32x4*)(rope + ((size_t)pos * 32 + i0) * 2), cs1 = *(const f32x4*)(rope + ((size_t)pos * 32 + i0) * 2 + 4);
                        const float c[4] = {cs0[0], cs0[2], cs1[0], cs1[2]}, s[4] = {cs0[1], cs0[3], cs1[1], cs1[3]};
                        float o1[4], o2[4];
#pragma unroll
                        for (int j = 0; j < 4; ++j) { o1[j] = (x1[j] * c[j] - x2[j] * s[j]) * r; o2[j] = (x1[j] * s[j] + x2[j] * c[j]) * r; }
                        *(u32x2*)(drow + i0) = (u32x2){pk_bf16(o1[0], o1[1]), pk_bf16(o1[2], o1[3])};
                        *(u32x2*)(drow + 32 + i0) = (u32x2){pk_bf16(o2[0], o2[1]), pk_bf16(o2[2], o2[3])}; } } }
    }
};
struct PEpiKvUp {
    int pn, brow; unsigned char* ws;
    __device__ __forceinline__ void mid(f32x4 (&)[2][2][4][2], int, int, int, int) {}
    __device__ __forceinline__ void fin(f32x4 (&acc)[2][2][4][2], int wr, int wc, int fr, int fq) {
        bf16_t* dst = (bf16_t*)(ws + WS_KVB);
#pragma unroll
        for (int ai = 0; ai < 2; ++ai)
#pragma unroll
            for (int m = 0; m < 4; ++m) { const int row = brow + PG_ROW(ai, m); const f32x4* pp = (const f32x4*)((const float*)(ws + WS_SSQK) + (size_t)row * 8); const f32x4 p0 = pp[0], p1 = pp[1];
                const float r = rsqrtf((((p0[0] + p0[1]) + (p0[2] + p0[3])) + ((p1[0] + p1[1]) + (p1[2] + p1[3]))) * (1.f / 256.f) + EPS);
#pragma unroll
                for (int bj = 0; bj < 2; ++bj)
#pragma unroll
                    for (int n = 0; n < 2; ++n) { const f32x4 v = acc[ai][bj][m][n];
                        *(u32x2*)(dst + (size_t)row * 2048 + pn * 256 + PG_COL(bj, n)) = (u32x2){pk_bf16(v[0] * r, v[1] * r), pk_bf16(v[2] * r, v[3] * r)}; } }
    }
};
struct PEpiWo {
    int pn, brow; unsigned char* ws; const float* x; const LAS float* tab;
    __device__ __forceinline__ void mid(f32x4 (&acc)[2][2][4][2], int wr, int wc, int fr, int fq) {
#pragma unroll
        for (int ai = 0; ai < 2; ++ai)
#pragma unroll
            for (int m = 0; m < 4; ++m) { const int r = PG_ROW(ai, m);
                const float f = __builtin_amdgcn_sqrtf((tab[256 + r] + EPS) * __builtin_amdgcn_rcpf(tab[r] + EPS));
#pragma unroll
                for (int bj = 0; bj < 2; ++bj)
#pragma unroll
                    for (int n = 0; n < 2; ++n) acc[ai][bj][m][n] *= f; }
        asm volatile("s_waitcnt lgkmcnt(0)" ::: "memory"); SBAR();
    }
    __device__ __forceinline__ void fin(f32x4 (&acc)[2][2][4][2], int wr, int wc, int fr, int fq) {
        float* x2 = (float*)(ws + WS_X2);
#pragma unroll
        for (int ai = 0; ai < 2; ++ai)
#pragma unroll
            for (int m = 0; m < 4; ++m) { const int r = PG_ROW(ai, m); const size_t o = (size_t)(brow + r) * D_MODEL + pn * 256; const float rbm = rsqrtf(tab[256 + r] + EPS); f32x4 xv[2][2];
#pragma unroll
                for (int bj = 0; bj < 2; ++bj)
#pragma unroll
                    for (int n = 0; n < 2; ++n) xv[bj][n] = *(const f32x4*)(x + o + PG_COL(bj, n));
#pragma unroll
                for (int bj = 0; bj < 2; ++bj)
#pragma unroll
                    for (int n = 0; n < 2; ++n) *(f32x4*)(x2 + o + PG_COL(bj, n)) = acc[ai][bj][m][n] * rbm + xv[bj][n]; }
    }
};
__device__ __forceinline__ void pg_convert(const float* W, int K, int ld, int ncols, int nrows, bf16_t* Bt, int item0, int nitems_stride) {
    const int total = nrows * (K >> 3);
    for (int it0 = item0; it0 < total; it0 += 4 * nitems_stride) { float v[4][8]; int row[4], k0[4]; bool ok[4];
#pragma unroll
        for (int b = 0; b < 4; ++b) { const int it = it0 + b * nitems_stride; const int itc = it < total ? it : item0; const int kc = itc / nrows; row[b] = itc - kc * nrows; k0[b] = kc << 3; ok[b] = it < total;
            const int col = (row[b] & ~255) + pg_tcol(row[b] & 255); const int colc = col < ncols ? col : 0; const float s = col < ncols ? 1.f : 0.f;
#pragma unroll
            for (int q = 0; q < 8; ++q) v[b][q] = W[(size_t)(k0[b] + q) * ld + colc] * s; }
#pragma unroll
        for (int b = 0; b < 4; ++b) if (ok[b])
            *(u32x4*)(Bt + (size_t)row[b] * K + k0[b]) = (u32x4){pk_bf16(v[b][0], v[b][1]), pk_bf16(v[b][2], v[b][3]), pk_bf16(v[b][4], v[b][5]), pk_bf16(v[b][6], v[b][7])}; }
}
__device__ __forceinline__ void sincos_d(double x, double& s, double& c) {
    const double k = __builtin_rint(x * 0.63661977236758134308);
    double r = __builtin_fma(-k, 1.57079632679489655800e+00, x); r = __builtin_fma(-k, 6.12323399573676603587e-17, r);
    const double r2 = r * r;
    double sp = -7.6471637318198164759e-13; sp = sp * r2 + 1.6059043836821614599e-10; sp = sp * r2 - 2.5052108385441718775e-08; sp = sp * r2 + 2.7557319223985890653e-06;
    sp = sp * r2 - 1.9841269841269841270e-04; sp = sp * r2 + 8.3333333333333333333e-03; sp = sp * r2 - 1.6666666666666666667e-01; const double sn = r + r * r2 * sp;
    double cp = 4.7794773323873852974e-14; cp = cp * r2 - 1.1470745597729724714e-11; cp = cp * r2 + 2.0876756987868098979e-09; cp = cp * r2 - 2.7557319223985890653e-07;
    cp = cp * r2 + 2.4801587301587301587e-05; cp = cp * r2 - 1.3888888888888888889e-03; cp = cp * r2 + 4.1666666666666666667e-02; cp = cp * r2 - 0.5; const double cn = 1.0 + r2 * cp;
    const int q = ((int)k) & 3;
    s = (q == 0) ? sn : (q == 1) ? cn : (q == 2) ? -sn : -cn;
    c = (q == 0) ? cn : (q == 1) ? -sn : (q == 2) ? -cn : sn;
}

__device__ __forceinline__ void phase_prologue(const Params& p) {
    const int tid = threadIdx.x, wid = tid >> 6, lane = tid & 63;
    bf16_t* xn = (bf16_t*)(p.ws + WS_XN);
    for (int row = blockIdx.x * 8 + wid; row < NTOK; row += gridDim.x * 8) {
        const f32x4* xr = (const f32x4*)(p.x + (size_t)row * D_MODEL); f32x4 v[8]; float ss = 0.f;
#pragma unroll
        for (int i = 0; i < 8; ++i) { v[i] = xr[lane + 64 * i]; ss += v[i][0] * v[i][0] + v[i][1] * v[i][1] + v[i][2] * v[i][2] + v[i][3] * v[i][3]; }
        ss = wave_sum(ss); const float rs = rsqrtf(ss * (1.f / D_MODEL) + EPS);
#pragma unroll
        for (int i = 0; i < 8; ++i) { const f32x4 g = ((const f32x4*)p.attn_norm)[lane + 64 * i];
            *(u32x2*)(xn + (size_t)row * D_MODEL + 4 * (lane + 64 * i)) = (u32x2){pk_bf16(v[i][0] * rs * g[0], v[i][1] * rs * g[1]), pk_bf16(v[i][2] * rs * g[2], v[i][3] * rs * g[3])}; }
    }
    const int gtid = blockIdx.x * 512 + tid;
    if (gtid < SEQ * 32) {
        const int pos = gtid >> 5, i = gtid & 31;
        double b = 10000.0; for (int q = 0; q < 5; ++q) b = __builtin_sqrt(b);
        double f = 1.0; for (int q = 0; q < i; ++q) f *= b;
        const float inv_freq = (float)(1.0 / f); const float ang = (float)pos * inv_freq;
        double s, c; sincos_d((double)ang, s, c);
        float* rope = (float*)(p.ws + WS_ROPE); rope[(size_t)gtid * 2] = (float)c; rope[(size_t)gtid * 2 + 1] = (float)s;
    }
    {
        const int nth = gridDim.x * 512;
        pg_convert(p.w_in, D_MODEL, IN_COLS, IN_COLS, 2560, (bf16_t*)(p.ws + WS_BT_IN), gtid, nth);
        pg_convert(p.b_w_uq, 512, 1536, 1536, 1536, (bf16_t*)(p.ws + WS_BT_UQ), gtid, nth);
    }
    if (gtid < N_EXP * D_MODEL) {
        ((float*)(p.ws + WS_WRT))[gtid] = p.w_router[gtid] * p.mlp_norm[gtid >> 5];
    }
}

constexpr int AA_PITCH = 144;
constexpr int AA_K = 0, AA_V = 384 * AA_PITCH;
constexpr int AA_WS = 2 * 384 * AA_PITCH;
__device__ __forceinline__ void attn_a_unit(const Params& p, LAS char* lds, int u) {
    const int tid = threadIdx.x, wid = __builtin_amdgcn_readfirstlane(tid >> 6), lane = tid & 63, r32 = lane & 31, hi = lane >> 5;
    const int b = u >> 7, nq = (u >> 2) & 31, kvh = u & 3;
    const bf16_t* QA = (const bf16_t*)(p.ws + WS_QA); const bf16_t* KA = (const bf16_t*)(p.ws + WS_KA); const bf16_t* VA = (const bf16_t*)(p.ws + WS_VA);
    const int P0 = (nq - 1) * 128;
    __syncthreads();
    for (int c = tid; c < 384 * 8; c += 512) { const int r = c >> 3, ch = c & 7; const int pos = P0 + r;
        i32x4 kv = {0, 0, 0, 0}, vv = {0, 0, 0, 0};
        if (pos >= 0 && pos < SEQ) { const size_t g = ((size_t)(b * SEQ + pos)) * 256 + kvh * 64 + ch * 8; kv = *(const i32x4*)(KA + g); vv = *(const i32x4*)(VA + g); }
        *(LAS i32x4*)(lds + AA_K + r * AA_PITCH + ch * 16) = kv; *(LAS i32x4*)(lds + AA_V + r * AA_PITCH + ch * 16) = vv; }
    __syncthreads();
    LAS float* wsf = (LAS float*)(lds + AA_WS) + wid * 64;
    const int hq = kvh * 4 + (wid >> 1);
    const float slope2 = __builtin_amdgcn_exp2f(-8.f * (float)(hq + 1) / 16.f) * LOG2E;
    const float sink2 = p.a_sink[hq] * LOG2E;
    const float C = 0.125f * LOG2E;
    const float* ga = p.out_norm_a + hq * 64;
    bf16_t* Y = (bf16_t*)(p.ws + WS_Y); float* ssqa = (float*)(p.ws + WS_SSQP);
    for (int blk = 0; blk < 2; ++blk) {
        const int q0 = nq * 128 + (wid & 1) * 64 + blk * 32;
        const int tq = q0 + r32;
        bf16x8 qr[4];
        { const bf16_t* qp = QA + ((size_t)(b * SEQ + tq)) * 1024 + hq * 64 + hi * 8;
#pragma unroll
          for (int d0 = 0; d0 < 4; ++d0) qr[d0] = *(const bf16x8*)(qp + d0 * 16); }
        float m_reg = sink2, l_reg = 1.f; f32x16 o[2] = {};
        for (int jt = 0; jt < 6; ++jt) {
            const int kp0 = P0 + jt * 64;
            if (kp0 + 63 < q0 - 128 || kp0 > q0 + 31 + 128 || kp0 + 63 < 0 || kp0 >= SEQ) continue;
            f32x16 p0 = {}, p1 = {};
#pragma unroll
            for (int d0 = 0; d0 < 4; ++d0) {
                const bf16x8 k0 = *(const LAS bf16x8*)(lds + AA_K + (jt * 64 + r32) * AA_PITCH + (d0 * 16 + hi * 8) * 2);
                const bf16x8 k1 = *(const LAS bf16x8*)(lds + AA_K + (jt * 64 + 32 + r32) * AA_PITCH + (d0 * 16 + hi * 8) * 2);
                p0 = __builtin_amdgcn_mfma_f32_32x32x16_bf16(k0, qr[d0], p0, 0, 0, 0);
                p1 = __builtin_amdgcn_mfma_f32_32x32x16_bf16(k1, qr[d0], p1, 0, 0, 0);
            }
            float pmax = -1e30f;
#pragma unroll
            for (int r = 0; r < 16; ++r) {
                { const int kp = kp0 + crow(r, hi); const int dist = tq > kp ? tq - kp : kp - tq; const bool ok = dist <= 128 && kp >= 0 && kp < SEQ;
                  p0[r] = ok ? p0[r] * C - slope2 * (float)dist : -1e30f; pmax = fmaxf(pmax, p0[r]); }
                { const int kp = kp0 + 32 + crow(r, hi); const int dist = tq > kp ? tq - kp : kp - tq; const bool ok = dist <= 128 && kp >= 0 && kp < SEQ;
                  p1[r] = ok ? p1[r] * C - slope2 * (float)dist : -1e30f; pmax = fmaxf(pmax, p1[r]); }
            }
            { auto rr = __builtin_amdgcn_permlane32_swap(__float_as_uint(pmax), __float_as_uint(pmax), false, false); pmax = fmaxf(__uint_as_float(rr[0]), __uint_as_float(rr[1])); }
            const float mn = fmaxf(m_reg, pmax); const float alpha = __builtin_amdgcn_exp2f(m_reg - mn); m_reg = mn;
            float ps = 0.f;
#pragma unroll
            for (int r = 0; r < 16; ++r) { p0[r] = __builtin_amdgcn_exp2f(p0[r] - mn); p1[r] = __builtin_amdgcn_exp2f(p1[r] - mn); ps += p0[r] + p1[r]; }
            { auto rr = __builtin_amdgcn_permlane32_swap(__float_as_uint(ps), __float_as_uint(ps), false, false); ps = __uint_as_float(rr[0]) + __uint_as_float(rr[1]); }
            l_reg = l_reg * alpha + ps;
            if (hi == 0) wsf[r32] = alpha;
            WAIT_L0();
#pragma unroll
            for (int r = 0; r < 16; ++r) { const float a = wsf[crow(r, hi)]; o[0][r] *= a; o[1][r] *= a; }
            bf16x8 pa[4];
#define PK4(P, BASE, OUT) do { unsigned a0 = pk_bf16(P[BASE + 0], P[BASE + 1]), a1 = pk_bf16(P[BASE + 2], P[BASE + 3]); \
    unsigned b0 = pk_bf16(P[BASE + 4], P[BASE + 5]), b1 = pk_bf16(P[BASE + 6], P[BASE + 7]); \
    auto r0_ = __builtin_amdgcn_permlane32_swap(a0, b0, false, false); auto r1_ = __builtin_amdgcn_permlane32_swap(a1, b1, false, false); \
    u32x4 w_ = {r0_[0], r1_[0], r0_[1], r1_[1]}; OUT = __builtin_bit_cast(bf16x8, w_); } while (0)
            PK4(p0, 0, pa[0]); PK4(p0, 8, pa[1]); PK4(p1, 0, pa[2]); PK4(p1, 8, pa[3]);
            const int g16 = (lane >> 4) & 1, qq = (lane & 15) >> 2, pp = lane & 3;
#pragma unroll
            for (int db = 0; db < 2; ++db) {
#pragma unroll
                for (int ks = 0; ks < 4; ++ks) {
                    const LAS char* vp = lds + AA_V + (jt * 64 + ks * 16 + 8 * hi + qq) * AA_PITCH + (db * 32 + 16 * g16 + 4 * pp) * 2;
                    const s16x4 lo = vtr(vp), hh = vtr(vp + 4 * AA_PITCH);
                    const bf16x8 vb = (bf16x8){lo[0], lo[1], lo[2], lo[3], hh[0], hh[1], hh[2], hh[3]};
                    o[db] = __builtin_amdgcn_mfma_f32_32x32x16_bf16(pa[ks], vb, o[db], 0, 0, 0);
                }
            }
            WAIT_L0();
        }
        if (hi == 0) wsf[r32] = 1.f / l_reg;
        WAIT_L0();
        const float g0 = ga[r32], g1 = ga[32 + r32];
#pragma unroll
        for (int r = 0; r < 16; ++r) { const int qrow = crow(r, hi); const float il = wsf[qrow]; const float v0 = o[0][r] * il, v1 = o[1][r] * il;
            const size_t tok = (size_t)(b * SEQ + q0 + qrow);
            bf16_t* yp = Y + tok * 2048 + hq * 64;
            yp[r32] = (bf16_t)(pk_bf16(v0 * g0, 0.f) & 0xffffu); yp[32 + r32] = (bf16_t)(pk_bf16(v1 * g1, 0.f) & 0xffffu);
            float ss = v0 * v0 + v1 * v1;
#pragma unroll
            for (int s = 16; s >= 1; s >>= 1) ss += __shfl_xor(ss, s, 64);
            if (r32 == 0) ssqa[tok * 24 + hq] = ss; }
        WAIT_L0();
    }
}

constexpr int MB_V = 0, MB_KN = 32768, MB_KP = 65536, MB_WS = 81920, MB_QP = 83968;
#define KSWZ(row, colB) ((row) * 256 + ((colB) ^ (((row) & 7) << 4)))
#define KPSWZ(row, colB) ((row) * 128 + ((colB) ^ (((row) & 7) << 4)))
constexpr float MLA_SCALE = 0.07216878364870322f;
constexpr float MLA_THR = 8.f;
__device__ __forceinline__ void mla_partialSM(f32x16& p0, f32x16& p1, float& m_reg, float& mn, float& alpha) {
    constexpr float C = MLA_SCALE * LOG2E;
    float pmax = p0[0];
#pragma unroll
    for (int r = 1; r < 16; ++r) pmax = fmaxf(pmax, p0[r]);
#pragma unroll
    for (int r = 0; r < 16; ++r) pmax = fmaxf(pmax, p1[r]);
    { auto rr = __builtin_amdgcn_permlane32_swap(__float_as_uint(pmax), __float_as_uint(pmax), false, false); pmax = fmaxf(__uint_as_float(rr[0]), __uint_as_float(rr[1])); }
    if (__builtin_expect(__all(pmax - m_reg <= MLA_THR / MLA_SCALE), 1)) { mn = m_reg; alpha = 1.f; }
    else { mn = fmaxf(m_reg, pmax); alpha = __builtin_amdgcn_exp2f((m_reg - mn) * C); m_reg = mn; }
    const float mnC = -mn * C;
#pragma unroll
    for (int r = 0; r < 16; ++r) p0[r] = fmaf(p0[r], C, mnC);
#pragma unroll
    for (int r = 0; r < 16; ++r) p1[r] = fmaf(p1[r], C, mnC);
#pragma unroll
    for (int r = 0; r < 16; ++r) p0[r] = __builtin_amdgcn_exp2f(p0[r]);
}
__device__ __forceinline__ void mla_finishSM(f32x16& p0, f32x16& p1, float alpha, float& l_reg, bf16x8& pa0, bf16x8& pa1, bf16x8& pa2, bf16x8& pa3) {
#pragma unroll
    for (int r = 0; r < 16; ++r) p1[r] = __builtin_amdgcn_exp2f(p1[r]);
    float ps = 0;
#pragma unroll
    for (int r = 0; r < 16; ++r) ps += p0[r];
#pragma unroll
    for (int r = 0; r < 16; ++r) ps += p1[r];
    { auto rr = __builtin_amdgcn_permlane32_swap(__float_as_uint(ps), __float_as_uint(ps), false, false); ps = __uint_as_float(rr[0]) + __uint_as_float(rr[1]); }
    l_reg = l_reg * alpha + ps;
    PK4(p0, 0, pa0); PK4(p0, 8, pa1); PK4(p1, 0, pa2); PK4(p1, 8, pa3);
}
__device__ __forceinline__ void mla_qkt(f32x16& p0, f32x16& p1, const LAS char* Kn, const LAS char* Kp, const bf16x8* qr, const LAS char* qp, int r32, int hi) {
    p0 = f32x16{}; p1 = f32x16{};
#pragma unroll
    for (int d0 = 0; d0 < 8; ++d0) { const int cb = (d0 * 16 + hi * 8) * 2;
        const bf16x8 b0 = *(const LAS bf16x8*)(Kn + KSWZ(r32, cb)); const bf16x8 b1 = *(const LAS bf16x8*)(Kn + KSWZ(32 + r32, cb));
        p0 = __builtin_amdgcn_mfma_f32_32x32x16_bf16(b0, qr[d0], p0, 0, 0, 0); p1 = __builtin_amdgcn_mfma_f32_32x32x16_bf16(b1, qr[d0], p1, 0, 0, 0); }
#pragma unroll
    for (int d0 = 0; d0 < 4; ++d0) { const int cb = (d0 * 16 + hi * 8) * 2;
        const bf16x8 b0 = *(const LAS bf16x8*)(Kp + KPSWZ(r32, cb)); const bf16x8 b1 = *(const LAS bf16x8*)(Kp + KPSWZ(32 + r32, cb));
        const bf16x8 q = *(const LAS bf16x8*)(qp + d0 * 1024);
        p0 = __builtin_amdgcn_mfma_f32_32x32x16_bf16(b0, q, p0, 0, 0, 0); p1 = __builtin_amdgcn_mfma_f32_32x32x16_bf16(b1, q, p1, 0, 0, 0); }
}
__device__ __forceinline__ int v_st(int k, int c) { const int kk = (k & ~0xC) | ((k & 4) << 1) | ((k & 8) >> 1); return ((kk >> 3) * 4 + (c >> 5)) * 512 + ((kk & 7) * 32 + (c & 31)) * 2; }
__device__ __forceinline__ int v_rd_base(int lane) { return ((lane & 3) << 3) | (((lane >> 2) & 3) << 6) | (((lane >> 4) & 1) << 5) | (((lane >> 5) & 1) << 8); }
constexpr int v_rd_off(int d0, int ks, int half) { return d0 * 512 + ks * 4096 + half * 2048; }
template <int D0> __device__ __forceinline__ void mla_pv_one(f32x16& od, const LAS char* vb, bf16x8 pa0, bf16x8 pa1, bf16x8 pa2, bf16x8 pa3) {
    const s16x4 l0 = vtr(vb + v_rd_off(D0, 0, 0)), h0 = vtr(vb + v_rd_off(D0, 0, 1)), l1 = vtr(vb + v_rd_off(D0, 1, 0)), h1 = vtr(vb + v_rd_off(D0, 1, 1));
    const s16x4 l2 = vtr(vb + v_rd_off(D0, 2, 0)), h2 = vtr(vb + v_rd_off(D0, 2, 1)), l3 = vtr(vb + v_rd_off(D0, 3, 0)), h3 = vtr(vb + v_rd_off(D0, 3, 1));
#define PKV(L, H) (bf16x8){L[0], L[1], L[2], L[3], H[0], H[1], H[2], H[3]}
    od = __builtin_amdgcn_mfma_f32_32x32x16_bf16(pa0, PKV(l0, h0), od, 0, 0, 0);
    od = __builtin_amdgcn_mfma_f32_32x32x16_bf16(pa1, PKV(l1, h1), od, 0, 0, 0);
    od = __builtin_amdgcn_mfma_f32_32x32x16_bf16(pa2, PKV(l2, h2), od, 0, 0, 0);
    od = __builtin_amdgcn_mfma_f32_32x32x16_bf16(pa3, PKV(l3, h3), od, 0, 0, 0);
#undef PKV
}
__device__ __forceinline__ void mla_pv(f32x16* o, const LAS char* vb, bf16x8 pa0, bf16x8 pa1, bf16x8 pa2, bf16x8 pa3) {
    mla_pv_one<0>(o[0], vb, pa0, pa1, pa2, pa3); mla_pv_one<1>(o[1], vb, pa0, pa1, pa2, pa3); mla_pv_one<2>(o[2], vb, pa0, pa1, pa2, pa3); mla_pv_one<3>(o[3], vb, pa0, pa1, pa2, pa3);
}
__device__ __forceinline__ void mla_unit(const Params& p, LAS char* lds, int u) {
    const int tid = threadIdx.x, wid = __builtin_amdgcn_readfirstlane(tid >> 6), lane = tid & 63, r32 = lane & 31, hi = lane >> 5;
    const int bh = u >> 4, qb = u & 15, b = bh >> 3, h = bh & 7;
    const bf16_t* QB = (const bf16_t*)(p.ws + WS_QB); const bf16_t* KVB = (const bf16_t*)(p.ws + WS_KVB); const bf16_t* KPE = (const bf16_t*)(p.ws + WS_KPE);
    const bf16_t* Kh = KVB + (size_t)b * SEQ * 2048 + h * 256;
    const bf16_t* Ph = KPE + (size_t)b * SEQ * 64;
    LAS float* wsf = (LAS float*)(lds + MB_WS) + wid * 64; LAS float* li_l = wsf; LAS float* al_l = wsf + 32;
    float m_reg = -1e30f, l_reg = 0; f32x16 o[4] = {}; bf16x8 qr[8];
    LAS char* qp = lds + MB_QP + wid * 4096 + lane * 16;
    { const bf16_t* Qw = QB + ((size_t)(b * SEQ + qb * 256 + wid * 32 + r32)) * 1536 + h * 192 + hi * 8;
#pragma unroll
      for (int d0 = 0; d0 < 8; ++d0) qr[d0] = *(const bf16x8*)(Qw + d0 * 16);
      __syncthreads();
#pragma unroll
      for (int d0 = 0; d0 < 4; ++d0) *(LAS bf16x8*)(qp + d0 * 1024) = *(const bf16x8*)(Qw + (8 + d0) * 16); }
    const int sr = tid >> 4, sc = (tid & 15) * 8, vst0 = v_st(sr, sc), vst1 = v_st(32 + sr, sc);
    const int pr = tid >> 3, pc = (tid & 7) * 8;
    const LAS char* vb0 = lds + MB_V + v_rd_base(lane);
    bf16x8 vs0, vs1, ks0, ks1, kp0;
#define SLOAD(k0) do { vs0 = *(const bf16x8*)(Kh + (size_t)((k0) + sr) * 2048 + 128 + sc); vs1 = *(const bf16x8*)(Kh + (size_t)((k0) + 32 + sr) * 2048 + 128 + sc); \
    ks0 = *(const bf16x8*)(Kh + (size_t)((k0) + sr) * 2048 + sc); ks1 = *(const bf16x8*)(Kh + (size_t)((k0) + 32 + sr) * 2048 + sc); \
    kp0 = *(const bf16x8*)(Ph + (size_t)((k0) + pr) * 64 + pc); } while (0)
#define SWRITE(bb) do { *(LAS bf16x8*)(lds + MB_V + (bb) * 16384 + vst0) = vs0; *(LAS bf16x8*)(lds + MB_V + (bb) * 16384 + vst1) = vs1; \
    *(LAS bf16x8*)(lds + MB_KN + (bb) * 16384 + KSWZ(sr, sc * 2)) = ks0; *(LAS bf16x8*)(lds + MB_KN + (bb) * 16384 + KSWZ(32 + sr, sc * 2)) = ks1; \
    *(LAS bf16x8*)(lds + MB_KP + (bb) * 8192 + KPSWZ(pr, pc * 2)) = kp0; } while (0)
#define RESC(a) do { if (__any((a) < 1.f)) { if (hi == 0) al_l[r32] = (a); WAIT_L0(); \
    _Pragma("unroll") for (int d = 0; d < 4; ++d) _Pragma("unroll") for (int r = 0; r < 16; ++r) o[d][r] *= al_l[crow(r, hi)]; } } while (0)
    f32x16 pA0, pA1, pB0, pB1; float mnA, mnB, alA, alB; bf16x8 pa0, pa1, pa2, pa3; constexpr int NT = SEQ / 64;
    SLOAD(0); SWRITE(0); __syncthreads();
    mla_qkt(pA0, pA1, lds + MB_KN, lds + MB_KP, qr, qp, r32, hi); mla_partialSM(pA0, pA1, m_reg, mnA, alA);
    SLOAD(64); SWRITE(1); __syncthreads();
    for (int j = 1; j + 1 < NT; j += 2) {
        SBAR(); mla_qkt(pB0, pB1, lds + MB_KN + 16384, lds + MB_KP + 8192, qr, qp, r32, hi);
        mla_finishSM(pA0, pA1, alA, l_reg, pa0, pa1, pa2, pa3); SBAR();
        SLOAD((j + 1) * 64); SBAR();
        mla_pv(o, vb0, pa0, pa1, pa2, pa3); mla_partialSM(pB0, pB1, m_reg, mnB, alB);
        __syncthreads(); SWRITE(0);
        RESC(alB); __syncthreads();
        SBAR(); mla_qkt(pA0, pA1, lds + MB_KN, lds + MB_KP, qr, qp, r32, hi);
        mla_finishSM(pB0, pB1, alB, l_reg, pa0, pa1, pa2, pa3); SBAR();
        SLOAD((j + 2) * 64); SBAR();
        mla_pv(o, vb0 + 16384, pa0, pa1, pa2, pa3); mla_partialSM(pA0, pA1, m_reg, mnA, alA);
        __syncthreads(); SWRITE(1);
        RESC(alA); __syncthreads();
    }
    SBAR(); mla_qkt(pB0, pB1, lds + MB_KN + 16384, lds + MB_KP + 8192, qr, qp, r32, hi);
    mla_finishSM(pA0, pA1, alA, l_reg, pa0, pa1, pa2, pa3); SBAR();
    mla_pv(o, vb0, pa0, pa1, pa2, pa3); mla_partialSM(pB0, pB1, m_reg, mnB, alB);
    __syncthreads(); RESC(alB);
    mla_finishSM(pB0, pB1, alB, l_reg, pa0, pa1, pa2, pa3); SBAR();
    mla_pv(o, vb0 + 16384, pa0, pa1, pa2, pa3);
    if (hi == 0) li_l[r32] = l_reg; WAIT_L0();
    bf16_t* Y = (bf16_t*)(p.ws + WS_Y); float* ssqb = (float*)(p.ws + WS_SSQP);
    const float* gb = p.out_norm_b + h * 128;
    float g[4];
#pragma unroll
    for (int d0 = 0; d0 < 4; ++d0) g[d0] = gb[d0 * 32 + r32];
#pragma unroll
    for (int r = 0; r < 16; ++r) { const int orow = crow(r, hi); const float il = __builtin_amdgcn_rcpf(li_l[orow]);
        const size_t tok = (size_t)(b * SEQ + qb * 256 + wid * 32 + orow); bf16_t* yp = Y + tok * 2048 + 1024 + h * 128; float ss = 0.f;
#pragma unroll
        for (int d0 = 0; d0 < 4; ++d0) { const float v = o[d0][r] * il; ss += v * v; yp[d0 * 32 + r32] = (bf16_t)(pk_bf16(v * g[d0], 0.f) & 0xffffu); }
#pragma unroll
        for (int s = 16; s >= 1; s >>= 1) ss += __shfl_xor(ss, s, 64);
        if (r32 == 0) ssqb[tok * 24 + 16 + h] = ss; }
#undef SLOAD
#undef SWRITE
#undef RESC
}

__device__ __forceinline__ void phase_router(const Params& p, LAS char* lds) {
    const int tid = threadIdx.x, wid = __builtin_amdgcn_readfirstlane(tid >> 6), lane = tid & 63;
    const float* x2 = (const float*)(p.ws + WS_X2); const float* wg = (const float*)(p.ws + WS_WRT);
    unsigned char* xn8 = p.ws + WS_XN; unsigned* cnt = (unsigned*)(p.ws + WS_CTL + CTL_CNT);
    int* tokl = (int*)(p.ws + WS_TOKL); int* sel_e = (int*)(p.ws + WS_SEL); int* sel_r = sel_e + NTOK * 4; float* sel_g = (float*)(sel_r + NTOK * 4);
    LAS float* part = (LAS float*)lds;
    LAS float* rsv = (LAS float*)(lds + 32768);
    LAS unsigned* hist = (LAS unsigned*)(lds + 32768 + 128); LAS unsigned* hbase = hist + 32;
    for (int t0 = blockIdx.x * 32; t0 < NTOK; t0 += gridDim.x * 32) {
        __syncthreads();
        if (tid < N_EXP) hist[tid] = 0u;
#pragma unroll 1
        for (int j = 0; j < 4; ++j) { const int t = t0 + 4 * wid + j; f32x4 xr[8]; float ss = 0.f;
#pragma unroll
            for (int i = 0; i < 8; ++i) { xr[i] = ((const f32x4*)(x2 + (size_t)t * D_MODEL))[lane + 64 * i]; ss += xr[i][0] * xr[i][0] + xr[i][1] * xr[i][1] + xr[i][2] * xr[i][2] + xr[i][3] * xr[i][3]; }
            const float rs = rsqrtf(wave_sum(ss) * (1.f / D_MODEL) + EPS);
            if (lane == 0) rsv[4 * wid + j] = rs;
#pragma unroll
            for (int i = 0; i < 8; ++i) { const f32x4 v = xr[i]; const f32x4 g = ((const f32x4*)p.mlp_norm)[lane + 64 * i]; const float s16 = 16.f * rs;
                *(unsigned*)(xn8 + (size_t)t * D_MODEL + 4 * (lane + 64 * i)) = pk4_fp8(s16 * v[0] * g[0], s16 * v[1] * g[1], s16 * v[2] * g[2], s16 * v[3] * g[3]); } }
        { f32x16 acc;
#pragma unroll
          for (int r = 0; r < 16; ++r) acc[r] = 0.f;
          const float* ap = x2 + (size_t)(t0 + (lane & 31)) * D_MODEL + 256 * wid + 4 * (lane >> 5);
          const float* bp = wg + (size_t)(256 * wid + 4 * (lane >> 5)) * N_EXP + (lane & 31);
#pragma unroll 4
          for (int c = 0; c < 32; ++c) { const f32x4 a4 = *(const f32x4*)(ap + 8 * c);
#pragma unroll
              for (int q = 0; q < 4; ++q) acc = __builtin_amdgcn_mfma_f32_32x32x2f32(a4[q], bp[(size_t)(8 * c + q) * N_EXP], acc, 0, 0, 0); }
#pragma unroll
          for (int r = 0; r < 16; ++r) part[wid * 1024 + crow(r, lane >> 5) * 32 + (lane & 31)] = acc[r]; }
        __syncthreads();
        int my_e[4]; unsigned my_lr[4]; float my_g[4];
#pragma unroll
        for (int j = 0; j < 4; ++j) { const int tl = 4 * wid + j;
            float v = -3.0e38f;
            if (lane < 32) { float s = 0.f;
#pragma unroll
                for (int w = 0; w < 8; ++w) s += part[w * 1024 + tl * 32 + lane];
                v = s * rsv[tl] + p.b_router[lane]; }
            float tv[4]; int ti[4];
#pragma unroll
            for (int r = 0; r < 4; ++r) {
                float bv = v; int bi = lane;
#pragma unroll
                for (int o = 32; o >= 1; o >>= 1) { const float ov = __shfl_xor(bv, o, 64); const int oi = __shfl_xor(bi, o, 64); if (ov > bv || (ov == bv && oi < bi)) { bv = ov; bi = oi; } }
                tv[r] = bv; ti[r] = bi; if (lane == bi) v = -3.0e38f;
            }
            const float e0 = 1.f, e1 = __expf(tv[1] - tv[0]), e2 = __expf(tv[2] - tv[0]), e3 = __expf(tv[3] - tv[0]); const float inv = 1.f / (e0 + e1 + e2 + e3);
            const float gts[4] = {e0 * inv, e1 * inv, e2 * inv, e3 * inv};
            my_e[j] = ti[lane & 3]; my_g[j] = gts[lane & 3]; my_lr[j] = 0u;
            if (lane < 4) my_lr[j] = __hip_atomic_fetch_add(hist + my_e[j], 1u, __ATOMIC_RELAXED, __HIP_MEMORY_SCOPE_WORKGROUP);
        }
        __syncthreads();
        if (tid < N_EXP) hbase[tid] = atomicAdd(cnt + tid * 16, hist[tid]);
        __syncthreads();
        if (lane < 4) {
#pragma unroll
            for (int j = 0; j < 4; ++j) { const int t = t0 + 4 * wid + j; const int e = my_e[j]; const unsigned rk = hbase[e] + my_lr[j];
                tokl[e * NTOK + rk] = t; sel_e[t * 4 + lane] = e; sel_r[t * 4 + lane] = (int)rk; sel_g[t * 4 + lane] = my_g[j]; }
        }
    }
}

__device__ __forceinline__ void phase_combine(const Params& p, const LAS int* s_roff) {
    const int tid = threadIdx.x, wid = tid >> 6, lane = tid & 63;
    const float* x2 = (const float*)(p.ws + WS_X2); const bf16_t* ys = (const bf16_t*)(p.ws + WS_YS);
    const int* sel_e = (const int*)(p.ws + WS_SEL); const int* sel_r = sel_e + NTOK * 4; const float* sel_g = (const float*)(sel_r + NTOK * 4);
    for (int t = blockIdx.x * 8 + wid; t < NTOK; t += gridDim.x * 8) {
        f32x4 v[8];
#pragma unroll
        for (int i = 0; i < 8; ++i) v[i] = ((const f32x4*)(x2 + (size_t)t * D_MODEL))[lane + 64 * i];
#pragma unroll
        for (int k = 0; k < 4; ++k) { const int e = sel_e[t * 4 + k]; const size_t slot = (size_t)(s_roff[e] + sel_r[t * 4 + k]); const float g = sel_g[t * 4 + k];
            const u32x2* yr = (const u32x2*)(ys + slot * D_MODEL);
#pragma unroll
            for (int i = 0; i < 8; ++i) { const u32x2 w = yr[lane + 64 * i]; v[i][0] += g * bf_lo(w[0]); v[i][1] += g * bf_hi(w[0]); v[i][2] += g * bf_lo(w[1]); v[i][3] += g * bf_hi(w[1]); } }
        float ss = 0.f;
#pragma unroll
        for (int i = 0; i < 8; ++i) ss += v[i][0] * v[i][0] + v[i][1] * v[i][1] + v[i][2] * v[i][2] + v[i][3] * v[i][3];
        ss = wave_sum(ss); const float rs = rsqrtf(ss * (1.f / D_MODEL) + EPS);
#pragma unroll
        for (int i = 0; i < 8; ++i) { const f32x4 g = ((const f32x4*)p.final_norm)[lane + 64 * i];
            ((f32x4*)(p.out + (size_t)t * D_MODEL))[lane + 64 * i] = (f32x4){v[i][0] * rs * g[0], v[i][1] * rs * g[1], v[i][2] * rs * g[2], v[i][3] * rs * g[3]}; }
    }
}

constexpr int NPHASE = 9;
__global__ void __launch_bounds__(512, 2) mega_fwd(Params p) {
    extern __shared__ __attribute__((aligned(1024))) char smem_raw[];
    LAS char* lds = (LAS char*)smem_raw;
    LAS unsigned* misc = (LAS unsigned*)(lds + LDS_MISC);
    const int tid = threadIdx.x;
    if (tid < 4) misc[tid] = 0u;
    __syncthreads();
    unsigned* bar = (unsigned*)(p.ws + WS_CTL + CTL_BAR);
    XcdBarrier xb = xcd_barrier_post(bar, (volatile LAS unsigned*)misc);
    const int lo = p.ph_lo, hi = p.ph_hi;
    const int G = gridDim.x, bid = blockIdx.x;
    const int xperm = (bid & 7) * (G >> 3) + (bid >> 3);
#ifdef PH_ONLY
#define IN(k) ((k)==PH_ONLY)
#else
#define IN(k) (lo <= (k) && (k) < hi)
#endif
#define SEAM(k) do { if (IN(k) && IN((k) + 1)) xcd_barrier(xb); } while (0)
    if (IN(0)) phase_prologue(p);
    SEAM(0);
    if (IN(1)) {
        for (int u = xperm; u < 32 * 8; u += G) {
            const int pn = u / 32, pm = u % 32;
            PEpiProj ep{pn, pm * 256, p.ws, p.b_q_norm, p.b_kv_norm};
            __syncthreads();
            gemm_unit_pg<false>(lds, (const bf16_t*)(p.ws + WS_XN) + (size_t)pm * 256 * D_MODEL, (const bf16_t*)(p.ws + WS_BT_IN) + (size_t)pn * 256 * D_MODEL, D_MODEL, ep);
        }
    }
    SEAM(1);
    if (IN(2)) {
        { const int b0 = bid;
            int qv;
            if ((b0 & 3) == 0) {
                const int h = b0 >> 2, pn = 8 + (h >> 5), pm = h & 31;
                PEpiProj ep{pn, pm * 256, p.ws, p.b_q_norm, p.b_kv_norm};
                __syncthreads();
                gemm_unit_pg<false>(lds, (const bf16_t*)(p.ws + WS_XN) + (size_t)pm * 256 * D_MODEL, (const bf16_t*)(p.ws + WS_BT_IN) + (size_t)pn * 256 * D_MODEL, D_MODEL, ep);
                qv = 128 + h;
            } else {
                const int v = (b0 >> 2) * 3 + (b0 & 3) - 1;
                if (v < 128) {
                    attn_a_unit(p, lds, v); qv = v;
                    pg_convert(p.w_o, D_MODEL, D_MODEL, D_MODEL, 2048, (bf16_t*)(p.ws + WS_BT_WO), v * 1024 + tid, 128 * 1024);
                    pg_convert(p.w_o, D_MODEL, D_MODEL, D_MODEL, 2048, (bf16_t*)(p.ws + WS_BT_WO), v * 1024 + 512 + tid, 128 * 1024);
                } else {
                    const int w = v - 128; qv = -1;
                    attn_a_unit(p, lds, 128 + 2 * w); attn_a_unit(p, lds, 129 + 2 * w);
                    if (w < 32) pg_convert(p.b_w_ukv, 256, 2048, 2048, 2048, (bf16_t*)(p.ws + WS_BT_UKV), w * 512 + tid, 32 * 512);
                }
            }
            if (qv >= 0) { const int pn = qv / 32, pm = qv % 32;
                PEpiQUp ep{pn, pm * 256, p.ws};
                __syncthreads();
                gemm_unit_pg<false>(lds, (const bf16_t*)(p.ws + WS_CQ) + (size_t)pm * 256 * 512, (const bf16_t*)(p.ws + WS_BT_UQ) + (size_t)pn * 256 * 512, 512, ep);
                __syncthreads(); }
        }
        xcd_barrier(xb);
        for (int u = xperm; u < 32 * 8; u += G) {
            const int pn = u / 32, pm = u % 32;
            PEpiKvUp ep{pn, pm * 256, p.ws};
            __syncthreads();
            gemm_unit_pg<false>(lds, (const bf16_t*)(p.ws + WS_CKV) + (size_t)pm * 256 * 256, (const bf16_t*)(p.ws + WS_BT_UKV) + (size_t)pn * 256 * 256, 256, ep);
        }
    }
    SEAM(2);
    if (IN(3)) { for (int u = xperm; u < 256; u += G) mla_unit(p, lds, u); }
    SEAM(3);
    if (IN(4)) {
        __syncthreads();
        for (int u = xperm; u < 32 * 8; u += G) {
            const int pn = u / 32, pm = u % 32;
            LAS float* tab = (LAS float*)(lds + 2 * G_STAGE_B);
            __syncthreads();
            if (tid < 256) { const f32x4* pp = (const f32x4*)((const float*)(p.ws + WS_SSQP) + (size_t)(pm * 256 + tid) * 24); float sa = 0.f, sb2 = 0.f;
#pragma unroll
                for (int q = 0; q < 4; ++q) { const f32x4 v = pp[q]; sa += (v[0] + v[1]) + (v[2] + v[3]); }
#pragma unroll
                for (int q = 4; q < 6; ++q) { const f32x4 v = pp[q]; sb2 += (v[0] + v[1]) + (v[2] + v[3]); }
                tab[tid] = sa * (1.f / 1024.f); tab[256 + tid] = sb2 * (1.f / 1024.f); }
            __syncthreads();
            PEpiWo ep{pn, pm * 256, p.ws, p.x, tab};
            gemm_unit_pg<true>(lds, (const bf16_t*)(p.ws + WS_Y) + (size_t)pm * 256 * D_MODEL, (const bf16_t*)(p.ws + WS_BT_WO) + (size_t)pn * 256 * D_MODEL, D_MODEL, ep);
        }
    }
    SEAM(4);
    if (IN(5)) phase_router(p, lds);
    SEAM(5);
    LAS int* s_cnt = (LAS int*)(misc + 16); LAS int* s_toff = (LAS int*)(misc + 48); LAS int* s_roff = (LAS int*)(misc + 96);
    if (IN(6) || IN(7) || IN(8)) {
        if (tid == 0) { const unsigned* cnt = (const unsigned*)(p.ws + WS_CTL + CTL_CNT); int to = 0;
            for (int e = 0; e < N_EXP; ++e) { const int c = (int)xb_ld((unsigned*)cnt + e * 16); s_cnt[e] = c; s_toff[e] = to; s_roff[e] = to * 256; to += (c + 255) >> 8; }
            s_toff[N_EXP] = to; }
        __syncthreads();
    }
    if (IN(6)) {
        const int TM = s_toff[N_EXP];
        const int T16 = TM * 16, NF = (T16 & ~255), R = T16 - NF;
        const bool halves = R > 0 && R <= 128;
        int round = 0;
        for (int L = xperm; L < (halves ? NF : T16); L += G, ++round) {
            if (round == ((xperm >> 3) & 7))
                conv_image(p.w_down + (size_t)(xperm >> 3) * D_FF * D_MODEL + (xperm & 7) * 256, (size_t)D_MODEL, p.ws + WS_IMG_DN + (size_t)xperm * 32 * 16384, 0, 32);
            int e = 0; while (s_toff[e + 1] * 16 <= L) ++e;
            const int w = L - s_toff[e] * 16, nte = s_toff[e + 1] - s_toff[e], ntile = w / nte, mt = w - ntile * nte, cntE = s_cnt[e];
            AGather8 af{p.ws + WS_XN, (const int*)(p.ws + WS_TOKL) + (size_t)e * NTOK, mt * 256, cntE};
            BGateUp bf{p.w_up + (size_t)e * D_MODEL * (2 * D_FF) + ntile * 128, (size_t)(2 * D_FF)};
            EpiUp8 ep{ntile * 128, mt * 256, cntE, p.ws + WS_ACT + ((size_t)s_roff[e] + mt * 256) * D_FF, p.b_up + (size_t)e * (2 * D_FF)};
            gemm_unit8<0x7B7B7B7B>(lds, (LAS unsigned*)(misc + 8), D_MODEL / 64, af, bf, ep);
        }
        if (round <= ((xperm >> 3) & 7))
            conv_image(p.w_down + (size_t)(xperm >> 3) * D_FF * D_MODEL + (xperm & 7) * 256, (size_t)D_MODEL, p.ws + WS_IMG_DN + (size_t)xperm * 32 * 16384, 0, 32);
        if (halves && xperm < 2 * R) {
            const int L = NF + (xperm >> 1), hf = xperm & 1;
            int e = 0; while (s_toff[e + 1] * 16 <= L) ++e;
            const int w = L - s_toff[e] * 16, nte = s_toff[e + 1] - s_toff[e], ntile = w / nte, mt = w - ntile * nte, cntE = s_cnt[e];
            AGather8 af{p.ws + WS_XN, (const int*)(p.ws + WS_TOKL) + (size_t)e * NTOK, mt * 256, cntE};
            BGateUp bf{p.w_up + (size_t)e * D_MODEL * (2 * D_FF) + ntile * 128 + hf * 64, (size_t)(2 * D_FF)};
            EpiUp8q ep{ntile * 128 + hf * 64, mt * 256, cntE, p.ws + WS_ACT + ((size_t)s_roff[e] + mt * 256) * D_FF, p.b_up + (size_t)e * (2 * D_FF)};
            gemm_unit8q<0x7B7B7B7B>(lds, (LAS unsigned*)(misc + 8), D_MODEL / 64, af, bf, ep);
        }
    }
    SEAM(6);
    if (IN(7)) {
        const int TM = s_toff[N_EXP];
        const int T8 = TM * 8, NF = T8 & ~255, R = T8 - NF;
        const bool halves = R > 0 && R <= 128;
        for (int L = xperm; L < (halves ? NF : T8); L += G) {
            int e = 0; while (s_toff[e + 1] * 8 <= L) ++e;
            const int w = L - s_toff[e] * 8, nte = s_toff[e + 1] - s_toff[e], ntile = w / nte, mt = w - ntile * nte, cntE = s_cnt[e];
            ARows8 af{p.ws + WS_ACT + ((size_t)s_roff[e] + mt * 256) * D_FF, (unsigned)D_FF};
            EpiDown8 ep{ntile * 256, mt * 256, cntE, (bf16_t*)(p.ws + WS_YS) + ((size_t)s_roff[e] + mt * 256) * D_MODEL, p.b_down + (size_t)e * D_MODEL};
            gemm_unit8b<0x7D7D7D7D>(lds, (LAS unsigned*)(misc + 8), D_FF / 64, af, p.ws + WS_IMG_DN + (size_t)(e * 8 + ntile) * 32 * 16384, ep);
        }
        if (halves && xperm < 2 * R) {
            const int L = NF + (xperm >> 1), hf = xperm & 1;
            int e = 0; while (s_toff[e + 1] * 8 <= L) ++e;
            const int w = L - s_toff[e] * 8, nte = s_toff[e + 1] - s_toff[e], ntile = w / nte, mt = w - ntile * nte, cntE = s_cnt[e];
            ARows8 af{p.ws + WS_ACT + ((size_t)s_roff[e] + mt * 256) * D_FF, (unsigned)D_FF};
            EpiDown8h ep{ntile * 256 + hf * 128, mt * 256, cntE, (bf16_t*)(p.ws + WS_YS) + ((size_t)s_roff[e] + mt * 256) * D_MODEL, p.b_down + (size_t)e * D_MODEL};
            gemm_unit8bh<0x7D7D7D7D>(lds, (LAS unsigned*)(misc + 8), D_FF / 64, af, p.ws + WS_IMG_DN + (size_t)(e * 8 + ntile) * 32 * 16384, hf, ep);
        }
    }
    SEAM(7);
    if (IN(8)) phase_combine(p, s_roff);
}

extern "C" void kernel_launch(void* const* d_in, const int* in_sizes, int n_in, void* d_out, int out_size, void* d_ws, size_t ws_size, hipStream_t stream) {
    static int ready = 0;
    if (!ready) {
        if (hipFuncSetAttribute((const void*)mega_fwd, hipFuncAttributeMaxDynamicSharedMemorySize, LDS_BYTES) != hipSuccess) { fprintf(stderr, "kernel_launch: hipFuncSetAttribute failed\n"); return; }
        int per_cu = 0; hipOccupancyMaxActiveBlocksPerMultiprocessor(&per_cu, (const void*)mega_fwd, 512, LDS_BYTES);
        if (per_cu < 1) { fprintf(stderr, "kernel_launch: occupancy query says 0 blocks per CU\n"); return; }
        ready = 1;
    }
    if (ws_size < WS_END) { fprintf(stderr, "kernel_launch: workspace too small\n"); return; }
    hipMemsetAsync((unsigned char*)d_ws + WS_CTL, 0, CTL_BYTES, stream);
    Params p{};
    const float** f = (const float**)&p;
    for (int i = 0; i < 19; ++i) f[i] = (const float*)d_in[i];
    p.out = (float*)d_out; p.ws = (unsigned char*)d_ws; p.ph_lo = 0; p.ph_hi = NPHASE;
    hipLaunchKernelGGL(mega_fwd, dim3(256), dim3(512), LDS_BYTES, stream, p);
}
```

```cpp
#include <hip/hip_runtime.h>
#include <stdint.h>
#include <stdio.h>

#define LAS __attribute__((address_space(3)))
typedef unsigned short bf16_t;
typedef short bf16x8 __attribute__((ext_vector_type(8)));
typedef short s16x4 __attribute__((ext_vector_type(4)));
typedef short v4i16_t __attribute__((ext_vector_type(4)));
typedef float f32x2 __attribute__((ext_vector_type(2)));
typedef float f32x4 __attribute__((ext_vector_type(4)));
typedef float f32x16 __attribute__((ext_vector_type(16)));
typedef int i32x4 __attribute__((ext_vector_type(4)));
typedef unsigned u32x2 __attribute__((ext_vector_type(2)));
typedef unsigned u32x4 __attribute__((ext_vector_type(4)));
typedef __bf16 bf16x2_t __attribute__((ext_vector_type(2)));
typedef int v8i __attribute__((ext_vector_type(8)));
typedef int v2i __attribute__((ext_vector_type(2)));
typedef short v2s __attribute__((ext_vector_type(2)));

constexpr int D_MODEL = 2048, SEQ = 4096, BATCH = 2, NTOK = BATCH * SEQ;
constexpr int IN_COLS = 2368;
constexpr int N_EXP = 32, TOP_K = 4, D_FF = 2048;
constexpr float EPS = 1e-5f;
constexpr float LOG2E = 1.4426950408889634f;

constexpr size_t MiB = 1u << 20;
constexpr size_t WS_CTL = 0, CTL_BYTES = 1 * MiB;
constexpr size_t WS_XN = 1 * MiB, WS_QA = 33 * MiB, WS_KA = 49 * MiB, WS_VA = 53 * MiB, WS_CQ = 57 * MiB, WS_CKV = 65 * MiB, WS_KPE = 69 * MiB;
constexpr size_t WS_QB = 70 * MiB, WS_KVB = 94 * MiB, WS_Y = 126 * MiB, WS_X2 = 158 * MiB, WS_ROPE = 222 * MiB, WS_WRT = 223 * MiB;
constexpr size_t WS_TOKL = 224 * MiB, WS_SEL = 225 * MiB, WS_ACT = 226 * MiB, WS_YS = 386 * MiB, WS_BT_IN = 546 * MiB, WS_BT_UQ = 558 * MiB, WS_BT_UKV = 560 * MiB, WS_BT_WO = 562 * MiB, WS_SSQ2 = 570 * MiB, WS_IMG_DN = 571 * MiB, WS_END = 699 * MiB;
constexpr size_t WS_SSQP = WS_WRT + 262144;
constexpr size_t WS_SSQC = WS_SSQ2;
constexpr size_t WS_SSQK = WS_SSQ2 + 524288;
constexpr size_t CTL_BAR = 0, CTL_CNT = 16384, CTL_SSQ_CQ = 65536, CTL_SSQ_CKV = 98304, CTL_SSQ_A = 131072, CTL_SSQ_B = 163840, CTL_SSQ_X2 = 196608;

__device__ __forceinline__ unsigned pk_bf16(float lo, float hi) { f32x2 v = {lo, hi}; bf16x2_t b = __builtin_convertvector(v, bf16x2_t); return __builtin_bit_cast(unsigned, b); }
__device__ __forceinline__ unsigned pk4_fp8(float a, float b, float c, float d) { int w = __builtin_amdgcn_cvt_pk_fp8_f32(a, b, 0, false); w = __builtin_amdgcn_cvt_pk_fp8_f32(c, d, w, true); return (unsigned)w; }
__device__ __forceinline__ unsigned pk4_fp8_x64(f32x4 v) { v2s r; asm("" : "=v"(r));
    r = __builtin_amdgcn_cvt_scalef32_pk_fp8_f32(r, v[0], v[1], 0.015625f, false); r = __builtin_amdgcn_cvt_scalef32_pk_fp8_f32(r, v[2], v[3], 0.015625f, true); return __builtin_bit_cast(unsigned, r); }
__device__ __forceinline__ float bf_lo(unsigned u) { return __uint_as_float(u << 16); }
__device__ __forceinline__ float bf_hi(unsigned u) { return __uint_as_float(u & 0xffff0000u); }
__device__ __forceinline__ float wave_sum(float v) {
#pragma unroll
    for (int o = 32; o >= 1; o >>= 1) v += __shfl_xor(v, o, 64);
    return v;
}
__device__ __forceinline__ int crow(int r, int hi) { return (r & 3) + 8 * (r >> 2) + 4 * hi; }
__device__ __forceinline__ s16x4 vtr(const LAS char* p) { return __builtin_bit_cast(s16x4, __builtin_amdgcn_ds_read_tr16_b64_v4i16((LAS v4i16_t*)p)); }
#define SBAR() __builtin_amdgcn_sched_barrier(0)

#define XB_TMO      128
#define XB_XCNT(j)  (256  + 64 * (j))
#define XB_XSUB(j)  (1280 + 64 * (j))
#define XB_XGEN(j)  (2304 + 64 * (j))
#define XB_TOP      3328
#define XB_TOPGEN   3392
#define XCD_BAR_WORDS 3456
#define XB_SPIN_CAP (1u << 18)
__device__ __forceinline__ unsigned xb_ld(unsigned* p)              { return __hip_atomic_load(p, __ATOMIC_RELAXED, __HIP_MEMORY_SCOPE_AGENT); }
__device__ __forceinline__ unsigned xb_add(unsigned* p, unsigned v) { return __hip_atomic_fetch_add(p, v, __ATOMIC_RELAXED, __HIP_MEMORY_SCOPE_AGENT); }
__device__ __forceinline__ unsigned xb_xcc_id() { return (unsigned)__builtin_amdgcn_s_getreg((3 << 11) | 20) & 0xFu; }
#define XB_SPIN(cond, bar) do { unsigned _sp = 0; while (cond) { __builtin_amdgcn_s_sleep(1); \
    if ((++_sp & 255u) == 0u) { if (xb_ld(&(bar)[XB_TMO])) break; if (_sp > XB_SPIN_CAP) { atomicAdd(&(bar)[XB_TMO], 1u); break; } } } } while (0)
struct XcdBarrier { unsigned* bar; unsigned x; volatile LAS unsigned* st; };
__device__ __forceinline__ XcdBarrier xcd_barrier_post(unsigned* bar, volatile LAS unsigned* st) {
    XcdBarrier b; b.bar = bar; b.x = xb_xcc_id(); b.st = st;
    if (threadIdx.x == 0) (void)xb_add(&bar[XB_XCNT(b.x)], 1u);
    return b;
}
__device__ __forceinline__ void xcd_barrier_complete(unsigned* bar, unsigned x, unsigned& nloc, unsigned& nx) {
    const unsigned G = gridDim.x * gridDim.y * gridDim.z;
    unsigned sum, cnt, mine, sp = 0u;
    for (;;) {
        sum = 0u; cnt = 0u; mine = 0u;
#pragma unroll
        for (unsigned j = 0; j < 16; ++j) { const unsigned c = xb_ld(&bar[XB_XCNT(j)]); sum += c; cnt += (c > 0u) ? 1u : 0u; mine = (j == x) ? c : mine; }
        if (sum == G) break;
        __builtin_amdgcn_s_sleep(1);
        if ((++sp & 255u) == 0u) { if (xb_ld(&bar[XB_TMO])) break; if (sp > XB_SPIN_CAP) { atomicAdd(&bar[XB_TMO], 1u); break; } }
    }
    nloc = mine > 0u ? mine : 1u; nx = cnt > 0u ? cnt : 1u;
}
__device__ __forceinline__ void xcd_barrier(const XcdBarrier& b) {
    asm volatile("s_waitcnt vmcnt(0)" ::: "memory");
    __syncthreads();
    if (threadIdx.x == 0) {
        unsigned* bar = b.bar;
        __builtin_amdgcn_s_waitcnt(0);
        unsigned nloc = b.st[0], nx = b.st[1];
        if (nloc == 0u) { xcd_barrier_complete(bar, b.x, nloc, nx); b.st[0] = nloc; b.st[1] = nx; }
        const unsigned old = xb_add(&bar[XB_XSUB(b.x)], 1u);
        const unsigned gen = old / nloc;
        if (old + 1u == (gen + 1u) * nloc) {
            __builtin_amdgcn_fence(__ATOMIC_RELEASE, "agent");
            asm volatile("s_waitcnt vmcnt(0)" ::: "memory");
            const unsigned og = xb_add(&bar[XB_TOP], 1u);
            const unsigned tg = og / nx;
            if (og + 1u == (tg + 1u) * nx) xb_add(&bar[XB_TOPGEN], 1u);
            else XB_SPIN(xb_ld(&bar[XB_TOPGEN]) == tg, bar);
            __builtin_amdgcn_fence(__ATOMIC_ACQUIRE, "agent");
            xb_add(&bar[XB_XGEN(b.x)], 1u);
            asm volatile("s_waitcnt vmcnt(0)" ::: "memory");
        } else {
            XB_SPIN(xb_ld(&bar[XB_XGEN(b.x)]) == gen, bar);
            __builtin_amdgcn_fence(__ATOMIC_ACQUIRE, "agent");
            asm volatile("s_waitcnt vmcnt(0)" ::: "memory");
        }
    }
    __syncthreads();
}

constexpr int A_TILE_B = 256 * 64 * 2;
constexpr int B_PITCH = 544;
constexpr int B_TILE_B = 64 * B_PITCH;
constexpr int G_STAGE_B = A_TILE_B + B_TILE_B;
constexpr int LDS_MISC = 155648;
constexpr int LDS_BYTES = LDS_MISC + 1024;

__device__ __forceinline__ int a_img_byte(int r, int chunk) { return r * 128 + ((chunk ^ ((r >> 1) & 7)) << 4); }
#define WAIT_L0() asm volatile("s_waitcnt lgkmcnt(0)" ::: "memory")
__device__ __forceinline__ void glds16(const void* gsrc, unsigned lds_dst) { unsigned keep;
    asm volatile("s_mov_b32 %0, m0\n\ts_mov_b32 m0, %2\n\ts_nop 0\n\tglobal_load_lds_dwordx4 %1, off\n\ts_mov_b32 m0, %0" : "=&s"(keep) : "v"(gsrc), "s"(lds_dst) : "memory"); }
#define RAW_BARRIER() do { WAIT_L0(); __builtin_amdgcn_s_barrier(); } while (0)

__device__ __forceinline__ const char* uniform_ptr(const void* p) {
    const unsigned long long v = (unsigned long long)p;
    const unsigned lo = __builtin_amdgcn_readfirstlane((unsigned)v), hi = __builtin_amdgcn_readfirstlane((unsigned)(v >> 32));
    return (const char*)(((unsigned long long)hi << 32) | lo);
}
__device__ __forceinline__ void glds16s(const char* sbase, unsigned voff, unsigned lds_dst) { unsigned keep;
    asm volatile("s_mov_b32 %0, m0\n\ts_mov_b32 m0, %3\n\ts_nop 4\n\tglobal_load_lds_dwordx4 %1, %2\n\ts_mov_b32 m0, %0" : "=&s"(keep) : "v"(voff), "s"(sbase), "s"(lds_dst) : "memory"); }
#define WAIT_V4(n, a, b, c, d) asm volatile("s_waitcnt vmcnt(" #n ")" : "+v"(a), "+v"(b), "+v"(c), "+v"(d) :: "memory")
template <bool MID, class AF, class BF, class EPI>
__device__ __forceinline__ void gemm_unit(LAS char* lds, const int nt, const AF& af, const BF& bf, EPI& epi) {
    const int tid = threadIdx.x, wid = __builtin_amdgcn_readfirstlane(tid >> 6), lane = tid & 63, wr = wid >> 2, wc = wid & 3, fr = lane & 15, fq = lane >> 4;
    const char* abase = uniform_ptr(af.base);
    unsigned aoff[4];
#pragma unroll
    for (int i = 0; i < 4; ++i) { const int R = wid * 8 + i * 64 + (lane >> 3), C = ((lane & 7) ^ ((R >> 1) & 7)) * 8; aoff[i] = (af.rowoff(R) + (unsigned)C) * 2u; }
    const int a_ldsw = wid * 1024;
    const unsigned lds_u = (unsigned)__builtin_amdgcn_readfirstlane((int)(unsigned)(size_t)lds);
    const size_t ldb4 = (size_t)bf.ld * 4;
    const char* bbase = uniform_ptr(bf.base) + (size_t)wid * ldb4;
    const unsigned boff = bf.coloff(4 * lane) * 4u;
    const int b_lds0 = A_TILE_B + wid * B_PITCH + 8 * lane, b_lds1 = A_TILE_B + wid * B_PITCH + ((8 * lane) ^ 128);
    const int a_rd0 = a_img_byte(wr * 128 + fr, fq), a_rd1 = a_rd0 ^ 64;
    const int b_rd = A_TILE_B + (8 * fq + ((lane & 15) >> 2)) * B_PITCH + ((wc ^ (fq & 1)) << 7) + 8 * (lane & 3);
    f32x4 acc[8][4];
#pragma unroll
    for (int m = 0; m < 8; ++m)
#pragma unroll
        for (int n = 0; n < 4; ++n) acc[m][n] = (f32x4){0.f, 0.f, 0.f, 0.f};
    f32x4 sb[8];
#define G_STAGE_A(i, kt, buf) glds16s(abase + (size_t)(kt) * 128, aoff[i], lds_u + (unsigned)((buf) * G_STAGE_B + a_ldsw + (i) * 8192))
#define G_ISSUE_B(i, kt) asm volatile("s_nop 4\n\tglobal_load_dwordx4 %0, %1, %2" : "=v"(sb[i]) : "v"(boff), "s"(bbase + ((size_t)(kt) * 64 + (i) * 8) * ldb4) : "memory")
#define G_WRITE_B(i, buf) do { u32x2 w_ = {pk_bf16(sb[i][0], sb[i][1]), pk_bf16(sb[i][2], sb[i][3])}; \
        *(LAS u32x2*)(lds + (buf) * G_STAGE_B + (((i) & 1) ? b_lds1 : b_lds0) + (i) * 8 * B_PITCH) = w_; } while (0)
#define G_KSTEP(buf, ks) do { bf16x8 At[8], Bf[4]; \
        _Pragma("unroll") for (int n = 0; n < 4; ++n) { const s16x4 lo_ = vtr(lds + (buf) * G_STAGE_B + b_rd + (ks) * 32 * B_PITCH + n * 32), hi_ = vtr(lds + (buf) * G_STAGE_B + b_rd + (ks) * 32 * B_PITCH + 4 * B_PITCH + n * 32); \
            Bf[n] = (bf16x8){lo_[0], lo_[1], lo_[2], lo_[3], hi_[0], hi_[1], hi_[2], hi_[3]}; } \
        _Pragma("unroll") for (int m = 0; m < 8; ++m) At[m] = *(const LAS bf16x8*)(lds + (buf) * G_STAGE_B + ((ks) ? a_rd1 : a_rd0) + m * 2048); \
        SBAR(); __builtin_amdgcn_s_setprio(1); \
        _Pragma("unroll") for (int m = 0; m < 8; ++m) _Pragma("unroll") for (int n = 0; n < 4; ++n) \
            acc[m][n] = __builtin_amdgcn_mfma_f32_16x16x32_bf16(Bf[n], At[m], acc[m][n], 0, 0, 0); \
        __builtin_amdgcn_s_setprio(0); SBAR(); } while (0)
#pragma unroll
    for (int i = 0; i < 4; ++i) G_STAGE_A(i, 0, 0);
#pragma unroll
    for (int i = 0; i < 8; ++i) G_ISSUE_B(i, 0);
    WAIT_V4(0, sb[0], sb[1], sb[2], sb[3]); WAIT_V4(0, sb[4], sb[5], sb[6], sb[7]);
#pragma unroll
    for (int i = 0; i < 8; ++i) G_WRITE_B(i, 0);
    SBAR();
#pragma unroll
    for (int i = 0; i < 8; ++i) G_ISSUE_B(i, 1);
    SBAR();
    RAW_BARRIER();
#pragma unroll 1
    for (int t = 0; t < nt; ++t) {
        const int cur = t & 1, nxt = cur ^ 1;
        if constexpr (MID) { if (t == (nt >> 1)) epi.mid(acc, wr, wc, fr, fq); }
        const int k1 = (t + 1 < nt) ? t + 1 : nt - 1, k2 = (t + 2 < nt) ? t + 2 : nt - 1;
        G_STAGE_A(0, k1, nxt); G_STAGE_A(1, k1, nxt); G_STAGE_A(2, k1, nxt); G_STAGE_A(3, k1, nxt);
        G_KSTEP(cur, 0);
        WAIT_V4(8, sb[0], sb[1], sb[2], sb[3]);
        G_WRITE_B(0, nxt); G_WRITE_B(1, nxt); G_WRITE_B(2, nxt); G_WRITE_B(3, nxt); SBAR();
        G_ISSUE_B(0, k2); G_ISSUE_B(1, k2); G_ISSUE_B(2, k2); G_ISSUE_B(3, k2); SBAR();
        G_KSTEP(cur, 1);
        WAIT_V4(8, sb[4], sb[5], sb[6], sb[7]);
        G_WRITE_B(4, nxt); G_WRITE_B(5, nxt); G_WRITE_B(6, nxt); G_WRITE_B(7, nxt); SBAR();
        G_ISSUE_B(4, k2); G_ISSUE_B(5, k2); G_ISSUE_B(6, k2); G_ISSUE_B(7, k2); SBAR();
        asm volatile("s_waitcnt vmcnt(8)" ::: "memory");
        RAW_BARRIER();
    }
    WAIT_V4(0, sb[0], sb[1], sb[2], sb[3]); WAIT_V4(0, sb[4], sb[5], sb[6], sb[7]);
    epi.fin(acc, wr, wc, fr, fq);
#undef G_STAGE_A
#undef G_ISSUE_B
#undef G_WRITE_B
#undef G_KSTEP
}

constexpr int A8_TILE_B = 16384, B8_PITCH = 288, B8_TILE_B = 64 * B8_PITCH;
constexpr int A8_RING = 5, B8_RING = 4, B8_OFF = A8_RING * A8_TILE_B;
static_assert(B8_OFF + B8_RING * B8_TILE_B <= LDS_MISC, "fp8 rings fit below the misc words");
__device__ __forceinline__ v2i vtr8(const LAS char* p) { return __builtin_amdgcn_ds_read_tr8_b64_v2i32((LAS v2i*)p); }
template <int SCALE_X, class AF, class BF, class EPI>
__device__ __forceinline__ void gemm_unit8(LAS char* lds, LAS unsigned* ring_cnt, const int nt, const AF& af, const BF& bf, EPI& epi) {
    const int tid = threadIdx.x, wid = __builtin_amdgcn_readfirstlane(tid >> 6), lane = tid & 63, wr = wid >> 2, wc = wid & 3, r32 = lane & 31, hi = lane >> 5;
    const char* abase = uniform_ptr(af.base);
    unsigned aoff[2];
#pragma unroll
    for (int i = 0; i < 2; ++i) { const int R = wid * 16 + i * 128 + (lane >> 2), C = ((lane & 3) ^ ((lane >> 4) & 3)) * 16; aoff[i] = af.rowoff(R) + (unsigned)C; }
    const unsigned lds_u = (unsigned)__builtin_amdgcn_readfirstlane((int)(unsigned)(size_t)lds) + (unsigned)(wid * 1024);
    const size_t ldb4 = (size_t)bf.ld * 4;
    const char* bbase = uniform_ptr(bf.base) + (size_t)wid * ldb4;
    const unsigned boff = bf.coloff(4 * lane) * 4u;
    const int b_wr = B8_OFF + wid * B8_PITCH + 4 * lane;
    const int a_rd0 = (wr * 128 + r32) * 64 + (((2 * hi) ^ ((r32 >> 2) & 3)) << 4), a_rd1 = a_rd0 ^ 16;
    const int b_rd = B8_OFF + (32 * hi + ((lane & 15) >> 1)) * B8_PITCH + wc * 64 + 16 * ((lane >> 4) & 1) + 8 * (lane & 1);
    f32x16 acc[4][2];
#pragma unroll
    for (int m = 0; m < 4; ++m)
#pragma unroll
        for (int n = 0; n < 2; ++n)
#pragma unroll
            for (int r = 0; r < 16; ++r) acc[m][n][r] = 0.f;
    f32x4 sb[8];
#define H_STAGE_A(i, kt, slot) glds16s(abase + (size_t)(kt) * 64, aoff[i], lds_u + (unsigned)((slot) * A8_TILE_B + (i) * 8192))
#define H_ISSUE_B(i, kt) asm volatile("s_nop 4\n\tglobal_load_dwordx4 %0, %1, %2" : "=v"(sb[i]) : "v"(boff), "s"(bbase + ((size_t)(kt) * 64 + (i) * 8) * ldb4) : "memory")
#define H_WRITE_B(i, slot) *(LAS unsigned*)(lds + (slot) * B8_TILE_B + b_wr + (i) * 8 * B8_PITCH) = pk4_fp8_x64(sb[i])
#define H_KSTEP(sa, sbk) do { v8i Xf[4], Wf[2]; \
        _Pragma("unroll") for (int n = 0; n < 2; ++n) _Pragma("unroll") for (int r = 0; r < 4; ++r) { const v2i t_ = vtr8(lds + (sbk) * B8_TILE_B + b_rd + r * 8 * B8_PITCH + n * 32); Wf[n][2 * r] = t_[0]; Wf[n][2 * r + 1] = t_[1]; } \
        _Pragma("unroll") for (int m = 0; m < 4; ++m) { const i32x4 lo_ = *(const LAS i32x4*)(lds + (sa) * A8_TILE_B + a_rd0 + m * 2048), hi_ = *(const LAS i32x4*)(lds + (sa) * A8_TILE_B + a_rd1 + m * 2048); \
            Xf[m] = (v8i){lo_[0], lo_[1], lo_[2], lo_[3], hi_[0], hi_[1], hi_[2], hi_[3]}; } \
        SBAR(); __builtin_amdgcn_s_setprio(1); \
        _Pragma("unroll") for (int m = 0; m < 4; ++m) _Pragma("unroll") for (int n = 0; n < 2; ++n) \
            acc[m][n] = __builtin_amdgcn_mfma_scale_f32_32x32x64_f8f6f4(Wf[n], Xf[m], acc[m][n], 0, 0, 0, 0x79797979, 0, SCALE_X); \
        __builtin_amdgcn_s_setprio(0); \
        _Pragma("unroll") for (int m = 0; m < 4; ++m) _Pragma("unroll") for (int n = 0; n < 2; ++n) asm volatile("" : "+v"(acc[m][n])); \
        SBAR(); } while (0)
    if (tid < 8) ring_cnt[tid] = 0u;
    H_STAGE_A(0, 0, 0); H_STAGE_A(1, 0, 0); H_STAGE_A(0, 1, 1); H_STAGE_A(1, 1, 1);
#pragma unroll
    for (int i = 0; i < 8; ++i) H_ISSUE_B(i, 0);
    WAIT_V4(0, sb[0], sb[1], sb[2], sb[3]); WAIT_V4(0, sb[4], sb[5], sb[6], sb[7]);
#pragma unroll
    for (int i = 0; i < 8; ++i) H_WRITE_B(i, 0);
    SBAR();
#pragma unroll
    for (int i = 0; i < 8; ++i) H_ISSUE_B(i, 1);
    WAIT_V4(0, sb[0], sb[1], sb[2], sb[3]); WAIT_V4(0, sb[4], sb[5], sb[6], sb[7]);
#pragma unroll
    for (int i = 0; i < 8; ++i) H_WRITE_B(i, 1);
    SBAR();
    H_STAGE_A(0, 2, 2); H_STAGE_A(1, 2, 2);
#pragma unroll
    for (int i = 0; i < 8; ++i) H_ISSUE_B(i, 2);
    SBAR();
    RAW_BARRIER();
    int sa_r = 0, sa_w = 3, sb_r = 0, sb_w = 2;
#pragma unroll 1
    for (int t = 0; t < nt; ++t) {
        if (t >= 2) {
            const unsigned need = (unsigned)(t - 1);
            for (;;) { asm volatile("" ::: "memory"); const unsigned v = *(volatile LAS unsigned*)(ring_cnt + (lane & 7)); if (__all(v >= need)) break; __builtin_amdgcn_s_sleep(1); }
            asm volatile("" ::: "memory");
        }
        const int k3 = (t + 3 < nt) ? t + 3 : nt - 1;
        H_STAGE_A(0, k3, sa_w); H_STAGE_A(1, k3, sa_w);
        H_KSTEP(sa_r, sb_r);
        WAIT_V4(6, sb[0], sb[1], sb[2], sb[3]);
        H_WRITE_B(0, sb_w); H_WRITE_B(1, sb_w); H_WRITE_B(2, sb_w); H_WRITE_B(3, sb_w); SBAR();
        H_ISSUE_B(0, k3); H_ISSUE_B(1, k3); H_ISSUE_B(2, k3); H_ISSUE_B(3, k3); SBAR();
        WAIT_V4(6, sb[4], sb[5], sb[6], sb[7]);
        H_WRITE_B(4, sb_w); H_WRITE_B(5, sb_w); H_WRITE_B(6, sb_w); H_WRITE_B(7, sb_w); SBAR();
        H_ISSUE_B(4, k3); H_ISSUE_B(5, k3); H_ISSUE_B(6, k3); H_ISSUE_B(7, k3); SBAR();
        asm volatile("" ::: "memory");
        if (lane == 0) *(volatile LAS unsigned*)(ring_cnt + wid) = (unsigned)(t + 1);
        asm volatile("" ::: "memory");
        sa_r = (sa_r == A8_RING - 1) ? 0 : sa_r + 1; sa_w = (sa_w == A8_RING - 1) ? 0 : sa_w + 1;
        sb_r = (sb_r == B8_RING - 1) ? 0 : sb_r + 1; sb_w = (sb_w == B8_RING - 1) ? 0 : sb_w + 1;
    }
    WAIT_V4(0, sb[0], sb[1], sb[2], sb[3]); WAIT_V4(0, sb[4], sb[5], sb[6], sb[7]);
    RAW_BARRIER();
    epi.fin(acc, wr, wc, r32, hi);
#undef H_STAGE_A
#undef H_ISSUE_B
#undef H_WRITE_B
#undef H_KSTEP
}

template <int SCALE_X, class AF, class BF, class EPI>
__device__ __forceinline__ void gemm_unit8h(LAS char* lds, LAS unsigned* ring_cnt, const int nt, const AF& af, const BF& bf, EPI& epi) {
    const int tid = threadIdx.x, wid = __builtin_amdgcn_readfirstlane(tid >> 6), lane = tid & 63, wr = wid >> 2, wc = wid & 3, r32 = lane & 31, hi = lane >> 5;
    const char* abase = uniform_ptr(af.base);
    unsigned aoff[2];
#pragma unroll
    for (int i = 0; i < 2; ++i) { const int R = wid * 16 + i * 128 + (lane >> 2), C = ((lane & 3) ^ ((lane >> 4) & 3)) * 16; aoff[i] = af.rowoff(R) + (unsigned)C; }
    const unsigned lds_u = (unsigned)__builtin_amdgcn_readfirstlane((int)(unsigned)(size_t)lds) + (unsigned)(wid * 1024);
    const size_t ldb4 = (size_t)bf.ld * 4;
    const char* bbase = uniform_ptr(bf.base) + (size_t)wid * ldb4;
    const unsigned boff = (unsigned)(lane >> 5) * 8u * (unsigned)ldb4 + bf.coloff(4 * (lane & 31)) * 4u;
    const int b_wr = B8_OFF + (wid + 8 * (lane >> 5)) * B8_PITCH + 4 * (lane & 31);
    const int a_rd0 = (wr * 128 + r32) * 64 + (((2 * hi) ^ ((r32 >> 2) & 3)) << 4), a_rd1 = a_rd0 ^ 16;
    const int b_rd = B8_OFF + (32 * hi + ((lane & 15) >> 1)) * B8_PITCH + wc * 32 + 16 * ((lane >> 4) & 1) + 8 * (lane & 1);
    f32x16 acc[4][1];
#pragma unroll
    for (int m = 0; m < 4; ++m)
#pragma unroll
        for (int n = 0; n < 1; ++n)
#pragma unroll
            for (int r = 0; r < 16; ++r) acc[m][n][r] = 0.f;
    f32x4 sb[4];
#define H_STAGE_A(i, kt, slot) glds16s(abase + (size_t)(kt) * 64, aoff[i], lds_u + (unsigned)((slot) * A8_TILE_B + (i) * 8192))
#define H_ISSUE_B(i, kt) asm volatile("s_nop 4\n\tglobal_load_dwordx4 %0, %1, %2" : "=v"(sb[i]) : "v"(boff), "s"(bbase + ((size_t)(kt) * 64 + (i) * 16) * ldb4) : "memory")
#define H_WRITE_B(i, slot) *(LAS unsigned*)(lds + (slot) * B8_TILE_B + b_wr + (i) * 16 * B8_PITCH) = pk4_fp8_x64(sb[i])
#define H_KSTEP(sa, sbk) do { v8i Xf[4], Wf[1]; \
        _Pragma("unroll") for (int n = 0; n < 1; ++n) _Pragma("unroll") for (int r = 0; r < 4; ++r) { const v2i t_ = vtr8(lds + (sbk) * B8_TILE_B + b_rd + r * 8 * B8_PITCH + n * 32); Wf[n][2 * r] = t_[0]; Wf[n][2 * r + 1] = t_[1]; } \
        _Pragma("unroll") for (int m = 0; m < 4; ++m) { const i32x4 lo_ = *(const LAS i32x4*)(lds + (sa) * A8_TILE_B + a_rd0 + m * 2048), hi_ = *(const LAS i32x4*)(lds + (sa) * A8_TILE_B + a_rd1 + m * 2048); \
            Xf[m] = (v8i){lo_[0], lo_[1], lo_[2], lo_[3], hi_[0], hi_[1], hi_[2], hi_[3]}; } \
        SBAR(); __builtin_amdgcn_s_setprio(1); \
        _Pragma("unroll") for (int m = 0; m < 4; ++m) _Pragma("unroll") for (int n = 0; n < 1; ++n) \
            acc[m][n] = __builtin_amdgcn_mfma_scale_f32_32x32x64_f8f6f4(Wf[n], Xf[m], acc[m][n], 0, 0, 0, 0x79797979, 0, SCALE_X); \
        __builtin_amdgcn_s_setprio(0); SBAR(); } while (0)
    if (tid < 8) ring_cnt[tid] = 0u;
    H_STAGE_A(0, 0, 0); H_STAGE_A(1, 0, 0); H_STAGE_A(0, 1, 1); H_STAGE_A(1, 1, 1);
#pragma unroll
    for (int i = 0; i < 4; ++i) H_ISSUE_B(i, 0);
    WAIT_V4(0, sb[0], sb[1], sb[2], sb[3]);
#pragma unroll
    for (int i = 0; i < 4; ++i) H_WRITE_B(i, 0);
    SBAR();
#pragma unroll
    for (int i = 0; i < 4; ++i) H_ISSUE_B(i, 1);
    WAIT_V4(0, sb[0], sb[1], sb[2], sb[3]);
#pragma unroll
    for (int i = 0; i < 4; ++i) H_WRITE_B(i, 1);
    SBAR();
    H_STAGE_A(0, 2, 2); H_STAGE_A(1, 2, 2);
#pragma unroll
    for (int i = 0; i < 4; ++i) H_ISSUE_B(i, 2);
    SBAR();
    RAW_BARRIER();
    int sa_r = 0, sa_w = 3, sb_r = 0, sb_w = 2;
#pragma unroll 1
    for (int t = 0; t < nt; ++t) {
        if (t >= 2) {
            const unsigned need = (unsigned)(t - 1);
            for (;;) { asm volatile("" ::: "memory"); const unsigned v = *(volatile LAS unsigned*)(ring_cnt + (lane & 7)); if (__all(v >= need)) break; __builtin_amdgcn_s_sleep(1); }
            asm volatile("" ::: "memory");
        }
        const int k3 = (t + 3 < nt) ? t + 3 : nt - 1;
        H_STAGE_A(0, k3, sa_w); H_STAGE_A(1, k3, sa_w);
        H_KSTEP(sa_r, sb_r);
        WAIT_V4(2, sb[0], sb[1], sb[2], sb[3]);
        H_WRITE_B(0, sb_w); H_WRITE_B(1, sb_w); H_WRITE_B(2, sb_w); H_WRITE_B(3, sb_w); SBAR();
        H_ISSUE_B(0, k3); H_ISSUE_B(1, k3); H_ISSUE_B(2, k3); H_ISSUE_B(3, k3); SBAR();
        asm volatile("" ::: "memory");
        if (lane == 0) *(volatile LAS unsigned*)(ring_cnt + wid) = (unsigned)(t + 1);
        asm volatile("" ::: "memory");
        sa_r = (sa_r == A8_RING - 1) ? 0 : sa_r + 1; sa_w = (sa_w == A8_RING - 1) ? 0 : sa_w + 1;
        sb_r = (sb_r == B8_RING - 1) ? 0 : sb_r + 1; sb_w = (sb_w == B8_RING - 1) ? 0 : sb_w + 1;
    }
    WAIT_V4(0, sb[0], sb[1], sb[2], sb[3]);
    RAW_BARRIER();
    epi.fin(acc, wr, wc, r32, hi);
#undef H_STAGE_A
#undef H_ISSUE_B
#undef H_WRITE_B
#undef H_KSTEP
}

template <int SCALE_X, class AF, class BF, class EPI>
__device__ __forceinline__ void gemm_unit8q(LAS char* lds, LAS unsigned* ring_cnt, const int nt, const AF& af, const BF& bf, EPI& epi) {
    const int tid = threadIdx.x, wid = __builtin_amdgcn_readfirstlane(tid >> 6), lane = tid & 63, wr = wid >> 1, wc = wid & 1, r32 = lane & 31, hi = lane >> 5;
    const char* abase = uniform_ptr(af.base);
    unsigned aoff[2];
#pragma unroll
    for (int i = 0; i < 2; ++i) { const int R = wid * 16 + i * 128 + (lane >> 2), C = ((lane & 3) ^ ((lane >> 4) & 3)) * 16; aoff[i] = af.rowoff(R) + (unsigned)C; }
    const unsigned lds_u = (unsigned)__builtin_amdgcn_readfirstlane((int)(unsigned)(size_t)lds) + (unsigned)(wid * 1024);
    const size_t ldb4 = (size_t)bf.ld * 4;
    const char* bbase = uniform_ptr(bf.base) + (size_t)wid * ldb4;
    const unsigned boff = (unsigned)(lane >> 5) * 8u * (unsigned)ldb4 + bf.coloff(4 * (lane & 31)) * 4u;
    const int b_wr = B8_OFF + (wid + 8 * (lane >> 5)) * B8_PITCH + 4 * (lane & 31);
    const int a_rd0 = (wr * 64 + r32) * 64 + (((2 * hi) ^ ((r32 >> 2) & 3)) << 4), a_rd1 = a_rd0 ^ 16;
    const int b_rd = B8_OFF + (32 * hi + ((lane & 15) >> 1)) * B8_PITCH + wc * 64 + 16 * ((lane >> 4) & 1) + 8 * (lane & 1);
    f32x16 acc[2][2];
#pragma unroll
    for (int m = 0; m < 2; ++m)
#pragma unroll
        for (int n = 0; n < 2; ++n)
#pragma unroll
            for (int r = 0; r < 16; ++r) acc[m][n][r] = 0.f;
    f32x4 sb[4];
#define H_STAGE_A(i, kt, slot) glds16s(abase + (size_t)(kt) * 64, aoff[i], lds_u + (unsigned)((slot) * A8_TILE_B + (i) * 8192))
#define H_ISSUE_B(i, kt) asm volatile("s_nop 4\n\tglobal_load_dwordx4 %0, %1, %2" : "=v"(sb[i]) : "v"(boff), "s"(bbase + ((size_t)(kt) * 64 + (i) * 16) * ldb4) : "memory")
#define H_WRITE_B(i, slot) *(LAS unsigned*)(lds + (slot) * B8_TILE_B + b_wr + (i) * 16 * B8_PITCH) = pk4_fp8_x64(sb[i])
#define H_KSTEP(sa, sbk) do { v8i Xf[2], Wf[2]; \
        _Pragma("unroll") for (int n = 0; n < 2; ++n) _Pragma("unroll") for (int r = 0; r < 4; ++r) { const v2i t_ = vtr8(lds + (sbk) * B8_TILE_B + b_rd + r * 8 * B8_PITCH + n * 32); Wf[n][2 * r] = t_[0]; Wf[n][2 * r + 1] = t_[1]; } \
        _Pragma("unroll") for (int m = 0; m < 2; ++m) { const i32x4 lo_ = *(const LAS i32x4*)(lds + (sa) * A8_TILE_B + a_rd0 + m * 2048), hi_ = *(const LAS i32x4*)(lds + (sa) * A8_TILE_B + a_rd1 + m * 2048); \
            Xf[m] = (v8i){lo_[0], lo_[1], lo_[2], lo_[3], hi_[0], hi_[1], hi_[2], hi_[3]}; } \
        SBAR(); __builtin_amdgcn_s_setprio(1); \
        _Pragma("unroll") for (int m = 0; m < 2; ++m) _Pragma("unroll") for (int n = 0; n < 2; ++n) \
            acc[m][n] = __builtin_amdgcn_mfma_scale_f32_32x32x64_f8f6f4(Wf[n], Xf[m], acc[m][n], 0, 0, 0, 0x79797979, 0, SCALE_X); \
        __builtin_amdgcn_s_setprio(0); SBAR(); } while (0)
    if (tid < 8) ring_cnt[tid] = 0u;
    H_STAGE_A(0, 0, 0); H_STAGE_A(1, 0, 0); H_STAGE_A(0, 1, 1); H_STAGE_A(1, 1, 1);
#pragma unroll
    for (int i = 0; i < 4; ++i) H_ISSUE_B(i, 0);
    WAIT_V4(0, sb[0], sb[1], sb[2], sb[3]);
#pragma unroll
    for (int i = 0; i < 4; ++i) H_WRITE_B(i, 0);
    SBAR();
#pragma unroll
    for (int i = 0; i < 4; ++i) H_ISSUE_B(i, 1);
    WAIT_V4(0, sb[0], sb[1], sb[2], sb[3]);
#pragma unroll
    for (int i = 0; i < 4; ++i) H_WRITE_B(i, 1);
    SBAR();
    H_STAGE_A(0, 2, 2); H_STAGE_A(1, 2, 2);
#pragma unroll
    for (int i = 0; i < 4; ++i) H_ISSUE_B(i, 2);
    SBAR();
    RAW_BARRIER();
    int sa_r = 0, sa_w = 3, sb_r = 0, sb_w = 2;
#pragma unroll 1
    for (int t = 0; t < nt; ++t) {
        if (t >= 2) {
            const unsigned need = (unsigned)(t - 1);
            for (;;) { asm volatile("" ::: "memory"); const unsigned v = *(volatile LAS unsigned*)(ring_cnt + (lane & 7)); if (__all(v >= need)) break; __builtin_amdgcn_s_sleep(1); }
            asm volatile("" ::: "memory");
        }
        const int k3 = (t + 3 < nt) ? t + 3 : nt - 1;
        H_STAGE_A(0, k3, sa_w); H_STAGE_A(1, k3, sa_w);
        H_KSTEP(sa_r, sb_r);
        WAIT_V4(2, sb[0], sb[1], sb[2], sb[3]);
        H_WRITE_B(0, sb_w); H_WRITE_B(1, sb_w); H_WRITE_B(2, sb_w); H_WRITE_B(3, sb_w); SBAR();
        H_ISSUE_B(0, k3); H_ISSUE_B(1, k3); H_ISSUE_B(2, k3); H_ISSUE_B(3, k3); SBAR();
        asm volatile("" ::: "memory");
        if (lane == 0) *(volatile LAS unsigned*)(ring_cnt + wid) = (unsigned)(t + 1);
        asm volatile("" ::: "memory");
        sa_r = (sa_r == A8_RING - 1) ? 0 : sa_r + 1; sa_w = (sa_w == A8_RING - 1) ? 0 : sa_w + 1;
        sb_r = (sb_r == B8_RING - 1) ? 0 : sb_r + 1; sb_w = (sb_w == B8_RING - 1) ? 0 : sb_w + 1;
    }
    WAIT_V4(0, sb[0], sb[1], sb[2], sb[3]);
    RAW_BARRIER();
    epi.fin(acc, wr, wc, r32, hi);
#undef H_STAGE_A
#undef H_ISSUE_B
#undef H_WRITE_B
#undef H_KSTEP
}

constexpr int C8_B_TILE = 16384, C8_B_OFF = A8_RING * A8_TILE_B;
template <int SCALE_X, class AF, class EPI>
__device__ __forceinline__ void gemm_unit8b(LAS char* lds, LAS unsigned* ring_cnt, const int nt, const AF& af, const unsigned char* img, EPI& epi) {
    const int tid = threadIdx.x, wid = __builtin_amdgcn_readfirstlane(tid >> 6), lane = tid & 63, wr = wid >> 2, wc = wid & 3, r32 = lane & 31, hi = lane >> 5;
    const char* abase = uniform_ptr(af.base);
    unsigned aoff[2];
#pragma unroll
    for (int i = 0; i < 2; ++i) { const int R = wid * 16 + i * 128 + (lane >> 2), C = ((lane & 3) ^ ((lane >> 4) & 3)) * 16; aoff[i] = af.rowoff(R) + (unsigned)C; }
    const unsigned lds_u = (unsigned)__builtin_amdgcn_readfirstlane((int)(unsigned)(size_t)lds) + (unsigned)(wid * 1024);
    const char* ibase = uniform_ptr(img);
    const unsigned ioff = (unsigned)(wid * 1024 + lane * 16);
    const int b_wr = C8_B_OFF + wid * 1024 + lane * 16;
    const int a_rd0 = (wr * 128 + r32) * 64 + (((2 * hi) ^ ((r32 >> 2) & 3)) << 4), a_rd1 = a_rd0 ^ 16;
    const int q8 = (lane & 15) >> 1;
    const int b_rd0 = C8_B_OFF + (32 * hi + q8) * 256 + ((wc * 64 + 16 * ((lane >> 4) & 1) + 8 * (lane & 1)) ^ (q8 << 5)), b_rd1 = b_rd0 ^ 32;
    i32x4 sv[2];
#define C_STAGE_A(i, kt, slot) glds16s(abase + (size_t)(kt) * 64, aoff[i], lds_u + (unsigned)((slot) * A8_TILE_B + (i) * 8192))
#define C_ISSUE_B(i, kt) asm volatile("s_nop 4\n\tglobal_load_dwordx4 %0, %1, %2" : "=v"(sv[i]) : "v"(ioff), "s"(ibase + (size_t)(kt) * 16384 + (i) * 8192) : "memory")
#define C_WRITE_B(i, slot) *(LAS i32x4*)(lds + (slot) * C8_B_TILE + b_wr + (i) * 8192) = sv[i]
#define C_WAIT(n) asm volatile("s_waitcnt vmcnt(" #n ")" : "+v"(sv[0]), "+v"(sv[1]) :: "memory")
    if (tid < 8) ring_cnt[tid] = 0u;
    C_STAGE_A(0, 0, 0); C_STAGE_A(1, 0, 0); C_STAGE_A(0, 1, 1); C_STAGE_A(1, 1, 1);
    C_ISSUE_B(0, 0); C_ISSUE_B(1, 0); C_WAIT(0); C_WRITE_B(0, 0); C_WRITE_B(1, 0); SBAR();
    C_ISSUE_B(0, 1); C_ISSUE_B(1, 1); C_WAIT(0); C_WRITE_B(0, 1); C_WRITE_B(1, 1); SBAR();
    C_STAGE_A(0, 2, 2); C_STAGE_A(1, 2, 2);
    C_ISSUE_B(0, 2); C_ISSUE_B(1, 2);
    SBAR();
    f32x16 acc[4][2];
#pragma unroll
    for (int m = 0; m < 4; ++m)
#pragma unroll
        for (int n = 0; n < 2; ++n)
#pragma unroll
            for (int r = 0; r < 16; ++r) acc[m][n][r] = 0.f;
    RAW_BARRIER();
    int sa_r = 0, sa_w = 3, sb_r = 0, sb_w = 2;
#pragma unroll 1
    for (int t = 0; t < nt; ++t) {
        if (t >= 2) { const unsigned need = (unsigned)(t - 1);
            for (;;) { asm volatile("" ::: "memory"); const unsigned v = *(volatile LAS unsigned*)(ring_cnt + (lane & 7)); if (__all(v >= need)) break; __builtin_amdgcn_s_sleep(1); }
            asm volatile("" ::: "memory"); }
        const int k3 = (t + 3 < nt) ? t + 3 : nt - 1;
        C_STAGE_A(0, k3, sa_w); C_STAGE_A(1, k3, sa_w);
        { v8i Xf[4], Wf[2];
#pragma unroll
          for (int r = 0; r < 4; ++r) { const v2i t0_ = vtr8(lds + sb_r * C8_B_TILE + b_rd0 + r * 2048), t1_ = vtr8(lds + sb_r * C8_B_TILE + b_rd1 + r * 2048); Wf[0][2 * r] = t0_[0]; Wf[0][2 * r + 1] = t0_[1]; Wf[1][2 * r] = t1_[0]; Wf[1][2 * r + 1] = t1_[1]; }
#pragma unroll
          for (int m = 0; m < 4; ++m) { const i32x4 lo_ = *(const LAS i32x4*)(lds + sa_r * A8_TILE_B + a_rd0 + m * 2048), hi_ = *(const LAS i32x4*)(lds + sa_r * A8_TILE_B + a_rd1 + m * 2048);
              Xf[m] = (v8i){lo_[0], lo_[1], lo_[2], lo_[3], hi_[0], hi_[1], hi_[2], hi_[3]}; }
          SBAR(); __builtin_amdgcn_s_setprio(1);
#pragma unroll
          for (int m = 0; m < 4; ++m)
#pragma unroll
              for (int n = 0; n < 2; ++n) acc[m][n] = __builtin_amdgcn_mfma_scale_f32_32x32x64_f8f6f4(Wf[n], Xf[m], acc[m][n], 0, 0, 0, 0x79797979, 0, SCALE_X);
          __builtin_amdgcn_s_setprio(0); SBAR(); }
        C_WAIT(2);
        C_WRITE_B(0, sb_w); C_WRITE_B(1, sb_w); SBAR();
        C_ISSUE_B(0, k3); C_ISSUE_B(1, k3); SBAR();
        asm volatile("" ::: "memory");
        if (lane == 0) *(volatile LAS unsigned*)(ring_cnt + wid) = (unsigned)(t + 1);
        asm volatile("" ::: "memory");
        sa_r = (sa_r == A8_RING - 1) ? 0 : sa_r + 1; sa_w = (sa_w == A8_RING - 1) ? 0 : sa_w + 1;
        sb_r = (sb_r == B8_RING - 1) ? 0 : sb_r + 1; sb_w = (sb_w == B8_RING - 1) ? 0 : sb_w + 1;
    }
    C_WAIT(0);
    RAW_BARRIER();
    epi.fin(acc, wr, wc, r32, hi);
#undef C_STAGE_A
#undef C_ISSUE_B
#undef C_WRITE_B
#undef C_WAIT
}
template <int SCALE_X, class AF, class EPI>
__device__ __forceinline__ void gemm_unit8bh(LAS char* lds, LAS unsigned* ring_cnt, const int nt, const AF& af, const unsigned char* img, const int hf, EPI& epi) {
    const int tid = threadIdx.x, wid = __builtin_amdgcn_readfirstlane(tid >> 6), lane = tid & 63, wr = wid >> 2, wc = wid & 3, r32 = lane & 31, hi = lane >> 5;
    const char* abase = uniform_ptr(af.base);
    unsigned aoff[2];
#pragma unroll
    for (int i = 0; i < 2; ++i) { const int R = wid * 16 + i * 128 + (lane >> 2), C = ((lane & 3) ^ ((lane >> 4) & 3)) * 16; aoff[i] = af.rowoff(R) + (unsigned)C; }
    const unsigned lds_u = (unsigned)__builtin_amdgcn_readfirstlane((int)(unsigned)(size_t)lds) + (unsigned)(wid * 1024);
    const char* ibase = uniform_ptr(img);
    const unsigned ioff = (unsigned)(wid * 1024 + lane * 16);
    const int b_wr = C8_B_OFF + wid * 1024 + lane * 16;
    const int a_rd0 = (wr * 128 + r32) * 64 + (((2 * hi) ^ ((r32 >> 2) & 3)) << 4), a_rd1 = a_rd0 ^ 16;
    const int q8 = (lane & 15) >> 1;
    const int b_rd0 = C8_B_OFF + (32 * hi + q8) * 256 + ((hf * 128 + wc * 32 + 16 * ((lane >> 4) & 1) + 8 * (lane & 1)) ^ (q8 << 5));
    i32x4 sv[2];
#define C_STAGE_A(i, kt, slot) glds16s(abase + (size_t)(kt) * 64, aoff[i], lds_u + (unsigned)((slot) * A8_TILE_B + (i) * 8192))
#define C_ISSUE_B(i, kt) asm volatile("s_nop 4\n\tglobal_load_dwordx4 %0, %1, %2" : "=v"(sv[i]) : "v"(ioff), "s"(ibase + (size_t)(kt) * 16384 + (i) * 8192) : "memory")
#define C_WRITE_B(i, slot) *(LAS i32x4*)(lds + (slot) * C8_B_TILE + b_wr + (i) * 8192) = sv[i]
#define C_WAIT(n) asm volatile("s_waitcnt vmcnt(" #n ")" : "+v"(sv[0]), "+v"(sv[1]) :: "memory")
    if (tid < 8) ring_cnt[tid] = 0u;
    C_STAGE_A(0, 0, 0); C_STAGE_A(1, 0, 0); C_STAGE_A(0, 1, 1); C_STAGE_A(1, 1, 1);
    C_ISSUE_B(0, 0); C_ISSUE_B(1, 0); C_WAIT(0); C_WRITE_B(0, 0); C_WRITE_B(1, 0); SBAR();
    C_ISSUE_B(0, 1); C_ISSUE_B(1, 1); C_WAIT(0); C_WRITE_B(0, 1); C_WRITE_B(1, 1); SBAR();
    C_STAGE_A(0, 2, 2); C_STAGE_A(1, 2, 2);
    C_ISSUE_B(0, 2); C_ISSUE_B(1, 2);
    SBAR();
    f32x16 acc[4][1];
#pragma unroll
    for (int m = 0; m < 4; ++m)
#pragma unroll
        for (int n = 0; n < 1; ++n)
#pragma unroll
            for (int r = 0; r < 16; ++r) acc[m][n][r] = 0.f;
    RAW_BARRIER();
    int sa_r = 0, sa_w = 3, sb_r = 0, sb_w = 2;
#pragma unroll 1
    for (int t = 0; t < nt; ++t) {
        if (t >= 2) { const unsigned need = (unsigned)(t - 1);
            for (;;) { asm volatile("" ::: "memory"); const unsigned v = *(volatile LAS unsigned*)(ring_cnt + (lane & 7)); if (__all(v >= need)) break; __builtin_amdgcn_s_sleep(1); }
            asm volatile("" ::: "memory"); }
        const int k3 = (t + 3 < nt) ? t + 3 : nt - 1;
        C_STAGE_A(0, k3, sa_w); C_STAGE_A(1, k3, sa_w);
        { v8i Xf[4], Wf[1];
#pragma unroll
          for (int r = 0; r < 4; ++r) { const v2i t0_ = vtr8(lds + sb_r * C8_B_TILE + b_rd0 + r * 2048); Wf[0][2 * r] = t0_[0]; Wf[0][2 * r + 1] = t0_[1]; }
#pragma unroll
          for (int m = 0; m < 4; ++m) { const i32x4 lo_ = *(const LAS i32x4*)(lds + sa_r * A8_TILE_B + a_rd0 + m * 2048), hi_ = *(const LAS i32x4*)(lds + sa_r * A8_TILE_B + a_rd1 + m * 2048);
              Xf[m] = (v8i){lo_[0], lo_[1], lo_[2], lo_[3], hi_[0], hi_[1], hi_[2], hi_[3]}; }
          SBAR(); __builtin_amdgcn_s_setprio(1);
#pragma unroll
          for (int m = 0; m < 4; ++m)
#pragma unroll
              for (int n = 0; n < 1; ++n) acc[m][n] = __builtin_amdgcn_mfma_scale_f32_32x32x64_f8f6f4(Wf[n], Xf[m], acc[m][n], 0, 0, 0, 0x79797979, 0, SCALE_X);
          __builtin_amdgcn_s_setprio(0); SBAR(); }
        C_WAIT(2);
        C_WRITE_B(0, sb_w); C_WRITE_B(1, sb_w); SBAR();
        C_ISSUE_B(0, k3); C_ISSUE_B(1, k3); SBAR();
        asm volatile("" ::: "memory");
        if (lane == 0) *(volatile LAS unsigned*)(ring_cnt + wid) = (unsigned)(t + 1);
        asm volatile("" ::: "memory");
        sa_r = (sa_r == A8_RING - 1) ? 0 : sa_r + 1; sa_w = (sa_w == A8_RING - 1) ? 0 : sa_w + 1;
        sb_r = (sb_r == B8_RING - 1) ? 0 : sb_r + 1; sb_w = (sb_w == B8_RING - 1) ? 0 : sb_w + 1;
    }
    C_WAIT(0);
    RAW_BARRIER();
    epi.fin(acc, wr, wc, r32, hi);
#undef C_STAGE_A
#undef C_ISSUE_B
#undef C_WRITE_B
#undef C_WAIT
}

__device__ __forceinline__ void conv_image(const float* W, size_t ld, unsigned char* img, int t0, int t1) {
    const int tid = threadIdx.x, wid = tid >> 6, lane = tid & 63;
    const float* wp = W + (size_t)wid * ld + 4 * lane;
    unsigned char* ip = img + wid * 256 + ((4 * lane) ^ (wid << 5));
    for (int t = t0; t < t1; t += 4) { f32x4 v[4][8];
#pragma unroll
        for (int u = 0; u < 4; ++u)
#pragma unroll
            for (int i = 0; i < 8; ++i) v[u][i] = *(const f32x4*)(wp + ((size_t)(t + u) * 64 + i * 8) * ld);
#pragma unroll
        for (int u = 0; u < 4; ++u)
#pragma unroll
            for (int i = 0; i < 8; ++i) *(unsigned*)(ip + (size_t)(t + u) * 16384 + i * 2048) = pk4_fp8_x64(v[u][i]); }
}

struct Params {
    const float *x, *attn_norm, *w_in, *a_sink, *b_q_norm, *b_w_uq, *b_kv_norm, *b_w_ukv, *out_norm_a, *out_norm_b, *w_o, *mlp_norm, *w_router, *b_router,
        *w_up, *b_up, *w_down, *b_down, *final_norm;
    float* out; unsigned char* ws; int ph_lo, ph_hi;
};

struct ARows { const bf16_t* base; unsigned ld; __device__ __forceinline__ unsigned rowoff(int r) const { return (unsigned)r * ld; } };
struct AGather { const bf16_t* base; const int* tokl; int r0, cnt; __device__ __forceinline__ unsigned rowoff(int r) const { int rk = r0 + r; rk = rk < cnt ? rk : 0; return (unsigned)tokl[rk] * (unsigned)D_MODEL; } };
struct ARows8 { const unsigned char* base; unsigned ld; __device__ __forceinline__ unsigned rowoff(int r) const { return (unsigned)r * ld; } };
struct AGather8 { const unsigned char* base; const int* tokl; int r0, cnt; __device__ __forceinline__ unsigned rowoff(int r) const { int rk = r0 + r; rk = rk < cnt ? rk : 0; return (unsigned)tokl[rk] * (unsigned)D_MODEL; } };
struct BPlain { const float* base; size_t ld; int ncols;
    __device__ __forceinline__ unsigned coloff(int c) const { return (unsigned)(c < ncols ? c : (c & (ncols - 1))); } };
struct BGateUp { const float* base; size_t ld;
    __device__ __forceinline__ unsigned coloff(int c) const { const int wc = c >> 6, w = c & 63; return (unsigned)(wc * 32 + (w & 31) + ((w & 32) ? D_FF : 0)); } };

struct EpiProj {
    int pn, brow; unsigned char* ws; const float *qg, *kvg;
    __device__ __forceinline__ void mid(f32x4 (&)[8][4], int, int, int, int) {}
    __device__ __forceinline__ void fin(f32x4 (&acc)[8][4], int wr, int wc, int fr, int fq) {
        if (pn < 6) {
            bf16_t* dst; int ldd, c0;
            if (pn < 4) { dst = (bf16_t*)(ws + WS_QA); ldd = 1024; c0 = pn * 256; } else if (pn == 4) { dst = (bf16_t*)(ws + WS_KA); ldd = 256; c0 = 0; } else { dst = (bf16_t*)(ws + WS_VA); ldd = 256; c0 = 0; }
#pragma unroll
            for (int m = 0; m < 8; ++m) { const int row = brow + wr * 128 + m * 16 + fr;
#pragma unroll
                for (int n = 0; n < 4; ++n) { const int col = c0 + wc * 64 + n * 16 + fq * 4; const f32x4 v = acc[m][n];
                    *(u32x2*)(dst + (size_t)row * ldd + col) = (u32x2){pk_bf16(v[0], v[1]), pk_bf16(v[2], v[3])}; } }
        } else if (pn < 9) {
            bf16_t* dst; int ldd, c0; const float* g; float* ssq; int nsl, sl;
            if (pn < 8) { dst = (bf16_t*)(ws + WS_CQ); ldd = 512; c0 = (pn - 6) * 256; g = qg; ssq = (float*)(ws + WS_SSQC); nsl = 8; sl = (pn - 6) * 4 + wc; }
            else { dst = (bf16_t*)(ws + WS_CKV); ldd = 256; c0 = 0; g = kvg; ssq = (float*)(ws + WS_SSQK); nsl = 4; sl = wc; }
            f32x4 gvv[4];
#pragma unroll
            for (int n = 0; n < 4; ++n) gvv[n] = *(const f32x4*)(g + c0 + wc * 64 + n * 16 + fq * 4);
#pragma unroll
            for (int m = 0; m < 8; ++m) { const int row = brow + wr * 128 + m * 16 + fr; float ss = 0.f;
#pragma unroll
                for (int n = 0; n < 4; ++n) { const int col = c0 + wc * 64 + n * 16 + fq * 4; const f32x4 v = acc[m][n]; const f32x4 gv = gvv[n];
                    ss += v[0] * v[0] + v[1] * v[1] + v[2] * v[2] + v[3] * v[3];
                    *(u32x2*)(dst + (size_t)row * ldd + col) = (u32x2){pk_bf16(v[0] * gv[0], v[1] * gv[1]), pk_bf16(v[2] * gv[2], v[3] * gv[3])}; }
                ss += __shfl_xor(ss, 16, 64); ss += __shfl_xor(ss, 32, 64);
                if (fq == 0) ssq[(size_t)row * nsl + sl] = ss; }
        } else {
            if (wc == 0) {
                bf16_t* dst = (bf16_t*)(ws + WS_KPE); const float* rope = (const float*)(ws + WS_ROPE);
#pragma unroll
                for (int m = 0; m < 8; ++m) { const int row = brow + wr * 128 + m * 16 + fr; const int pos = row & (SEQ - 1);
#pragma unroll
                    for (int n = 0; n < 2; ++n) { const int i0 = n * 16 + fq * 4; const f32x4 x1 = acc[m][n], x2 = acc[m][n + 2];
                        const f32x4 cs0 = *(const f32x4*)(rope + ((size_t)pos * 32 + i0) * 2), cs1 = *(const f32x4*)(rope + ((size_t)pos * 32 + i0) * 2 + 4);
                        const float c[4] = {cs0[0], cs0[2], cs1[0], cs1[2]}, s[4] = {cs0[1], cs0[3], cs1[1], cs1[3]};
                        float o1[4], o2[4];
#pragma unroll
                        for (int j = 0; j < 4; ++j) { o1[j] = x1[j] * c[j] - x2[j] * s[j]; o2[j] = x1[j] * s[j] + x2[j] * c[j]; }
                        *(u32x2*)(dst + (size_t)row * 64 + i0) = (u32x2){pk_bf16(o1[0], o1[1]), pk_bf16(o1[2], o1[3])};
                        *(u32x2*)(dst + (size_t)row * 64 + 32 + i0) = (u32x2){pk_bf16(o2[0], o2[1]), pk_bf16(o2[2], o2[3])}; } }
            }
        }
    }
};
struct EpiQUp {
    int pn, brow; unsigned char* ws;
    __device__ __forceinline__ void mid(f32x4 (&)[8][4], int, int, int, int) {}
    __device__ __forceinline__ void fin(f32x4 (&acc)[8][4], int wr, int wc, int fr, int fq) {
        bf16_t* dst = (bf16_t*)(ws + WS_QB); const float* rope = (const float*)(ws + WS_ROPE); const float* ssq = (const float*)(ws + WS_CTL + CTL_SSQ_CQ);
        const int seg = pn * 4 + wc, head = seg / 3, part = seg - head * 3;
        float sq[8];
#pragma unroll
        for (int m = 0; m < 8; ++m) { const f32x4* pp = (const f32x4*)((const float*)(ws + WS_SSQC) + (size_t)(brow + wr * 128 + m * 16 + fr) * 8); const f32x4 p0 = pp[0], p1 = pp[1];
            sq[m] = ((p0[0] + p0[1]) + (p0[2] + p0[3])) + ((p1[0] + p1[1]) + (p1[2] + p1[3])); }
#pragma unroll
        for (int m = 0; m < 8; ++m) { const int row = brow + wr * 128 + m * 16 + fr; const float rs = rsqrtf(sq[m] * (1.f / 512.f) + EPS);
            bf16_t* drow = dst + (size_t)row * 1536 + head * 192 + part * 64;
            if (part < 2) {
#pragma unroll
                for (int n = 0; n < 4; ++n) { const f32x4 v = acc[m][n]; *(u32x2*)(drow + n * 16 + fq * 4) = (u32x2){pk_bf16(v[0] * rs, v[1] * rs), pk_bf16(v[2] * rs, v[3] * rs)}; }
            } else { const int pos = row & (SEQ - 1);
#pragma unroll
                for (int n = 0; n < 2; ++n) { const int i0 = n * 16 + fq * 4; const f32x4 x1 = acc[m][n], x2 = acc[m][n + 2];
                    const f32x4 cs0 = *(const f32x4*)(rope + ((size_t)pos * 32 + i0) * 2), cs1 = *(const f32x4*)(rope + ((size_t)pos * 32 + i0) * 2 + 4);
                    const float c[4] = {cs0[0], cs0[2], cs1[0], cs1[2]}, s[4] = {cs0[1], cs0[3], cs1[1], cs1[3]};
                    float o1[4], o2[4];
#pragma unroll
                    for (int j = 0; j < 4; ++j) { o1[j] = (x1[j] * c[j] - x2[j] * s[j]) * rs; o2[j] = (x1[j] * s[j] + x2[j] * c[j]) * rs; }
                    *(u32x2*)(drow + i0) = (u32x2){pk_bf16(o1[0], o1[1]), pk_bf16(o1[2], o1[3])};
                    *(u32x2*)(drow + 32 + i0) = (u32x2){pk_bf16(o2[0], o2[1]), pk_bf16(o2[2], o2[3])}; } }
        }
    }
};
struct EpiKvUp {
    int pn, brow; unsigned char* ws;
    __device__ __forceinline__ void mid(f32x4 (&)[8][4], int, int, int, int) {}
    __device__ __forceinline__ void fin(f32x4 (&acc)[8][4], int wr, int wc, int fr, int fq) {
        bf16_t* dst = (bf16_t*)(ws + WS_KVB);
        float sq[8];
#pragma unroll
        for (int m = 0; m < 8; ++m) { const f32x4 p0 = *(const f32x4*)((const float*)(ws + WS_SSQK) + (size_t)(brow + wr * 128 + m * 16 + fr) * 4); sq[m] = (p0[0] + p0[1]) + (p0[2] + p0[3]); }
#pragma unroll
        for (int m = 0; m < 8; ++m) { const int row = brow + wr * 128 + m * 16 + fr; const float rs = rsqrtf(sq[m] * (1.f / 256.f) + EPS);
#pragma unroll
            for (int n = 0; n < 4; ++n) { const int col = pn * 256 + wc * 64 + n * 16 + fq * 4; const f32x4 v = acc[m][n];
                *(u32x2*)(dst + (size_t)row * 2048 + col) = (u32x2){pk_bf16(v[0] * rs, v[1] * rs), pk_bf16(v[2] * rs, v[3] * rs)}; } }
    }
};
struct EpiWo {
    int pn, brow; unsigned char* ws; const float* x; const LAS float* tab;
    __device__ __forceinline__ void mid(f32x4 (&acc)[8][4], int wr, int wc, int fr, int fq) {
#pragma unroll
        for (int m = 0; m < 8; ++m) { const int r = wr * 128 + m * 16 + fr;
            const float f = __builtin_amdgcn_sqrtf((tab[256 + r] + EPS) * __builtin_amdgcn_rcpf(tab[r] + EPS));
#pragma unroll
            for (int n = 0; n < 4; ++n) acc[m][n] *= f;
            SBAR(); }
    }
    __device__ __forceinline__ void fin(f32x4 (&acc)[8][4], int wr, int wc, int fr, int fq) {
        float* x2 = (float*)(ws + WS_X2);
#pragma unroll
        for (int m = 0; m < 8; ++m) { const int r = wr * 128 + m * 16 + fr, row = brow + r; const float rbm = rsqrtf(tab[256 + r] + EPS); f32x4 xv[4];
#pragma unroll
            for (int n = 0; n < 4; ++n) xv[n] = *(const f32x4*)(x + (size_t)row * D_MODEL + pn * 256 + wc * 64 + n * 16 + fq * 4);
#pragma unroll
            for (int n = 0; n < 4; ++n) { const int col = pn * 256 + wc * 64 + n * 16 + fq * 4;
                const f32x4 v = acc[m][n] * rbm + xv[n];
                *(f32x4*)(x2 + (size_t)row * D_MODEL + col) = v; } }
    }
};
struct EpiUp8 {
    int j0, r0, cnt; unsigned char* dst; const float* bias;
    __device__ __forceinline__ void fin(f32x16 (&acc)[4][2], int wr, int wc, int r32, int hi) {
        f32x4 bg[4], bu[4];
#pragma unroll
        for (int rg = 0; rg < 4; ++rg) { const int j = j0 + wc * 32 + 8 * rg + 4 * hi; bg[rg] = *(const f32x4*)(bias + j); bu[rg] = *(const f32x4*)(bias + D_FF + j); }
#pragma unroll
        for (int m = 0; m < 4; ++m) { const int r = wr * 128 + m * 32 + r32; unsigned o8[4];
#pragma unroll
            for (int rg = 0; rg < 4; ++rg) { float o[4];
#pragma unroll
                for (int q = 0; q < 4; ++q) { const float g = fminf(acc[m][0][4 * rg + q] + bg[rg][q], 7.f), u = fminf(fmaxf(acc[m][1][4 * rg + q] + bu[rg][q], -7.f), 7.f);
                    const float sg = __builtin_amdgcn_rcpf(1.f + __builtin_amdgcn_exp2f(-1.702f * LOG2E * g)); o[q] = 4.f * (u + 1.f) * (g * sg); }
                o8[rg] = pk4_fp8(o[0], o[1], o[2], o[3]); }
#pragma unroll
            for (int j = 0; j < 2; ++j) { const auto sw = __builtin_amdgcn_permlane32_swap(o8[2 * j], o8[2 * j + 1], false, false); o8[2 * j] = sw[0]; o8[2 * j + 1] = sw[1]; }
            if (r0 + r < cnt) {
#pragma unroll
                for (int j = 0; j < 2; ++j) *(u32x2*)(dst + (size_t)r * D_FF + j0 + wc * 32 + 16 * j + 8 * hi) = (u32x2){o8[2 * j], o8[2 * j + 1]}; }
        }
    }
};
struct EpiUp8q {
    int j0, r0, cnt; unsigned char* dst; const float* bias;
    __device__ __forceinline__ void fin(f32x16 (&acc)[2][2], int wr, int wc, int r32, int hi) {
        f32x4 bg[4], bu[4];
#pragma unroll
        for (int rg = 0; rg < 4; ++rg) { const int j = j0 + wc * 32 + 8 * rg + 4 * hi; bg[rg] = *(const f32x4*)(bias + j); bu[rg] = *(const f32x4*)(bias + D_FF + j); }
#pragma unroll
        for (int m = 0; m < 2; ++m) { const int r = wr * 64 + m * 32 + r32; unsigned o8[4];
#pragma unroll
            for (int rg = 0; rg < 4; ++rg) { float o[4];
#pragma unroll
                for (int q = 0; q < 4; ++q) { const float g = fminf(acc[m][0][4 * rg + q] + bg[rg][q], 7.f), u = fminf(fmaxf(acc[m][1][4 * rg + q] + bu[rg][q], -7.f), 7.f);
                    const float sg = __builtin_amdgcn_rcpf(1.f + __builtin_amdgcn_exp2f(-1.702f * LOG2E * g)); o[q] = 4.f * (u + 1.f) * (g * sg); }
                o8[rg] = pk4_fp8(o[0], o[1], o[2], o[3]); }
#pragma unroll
            for (int j = 0; j < 2; ++j) { const auto sw = __builtin_amdgcn_permlane32_swap(o8[2 * j], o8[2 * j + 1], false, false); o8[2 * j] = sw[0]; o8[2 * j + 1] = sw[1]; }
            if (r0 + r < cnt) {
#pragma unroll
                for (int j = 0; j < 2; ++j) *(u32x2*)(dst + (size_t)r * D_FF + j0 + wc * 32 + 16 * j + 8 * hi) = (u32x2){o8[2 * j], o8[2 * j + 1]}; }
        }
    }
};
struct EpiDown8 {
    int c0, r0, cnt; bf16_t* dst; const float* bias;
    __device__ __forceinline__ void fin(f32x16 (&acc)[4][2], int wr, int wc, int r32, int hi) {
        f32x4 b[2][4];
#pragma unroll
        for (int n = 0; n < 2; ++n)
#pragma unroll
            for (int rg = 0; rg < 4; ++rg) b[n][rg] = *(const f32x4*)(bias + c0 + wc * 64 + n * 32 + 8 * rg + 4 * hi);
#pragma unroll
        for (int m = 0; m < 4; ++m) { const int r = wr * 128 + m * 32 + r32;
#pragma unroll
            for (int n = 0; n < 2; ++n) { u32x2 pk[4];
#pragma unroll
                for (int rg = 0; rg < 4; ++rg) pk[rg] = (u32x2){pk_bf16(acc[m][n][4 * rg] + b[n][rg][0], acc[m][n][4 * rg + 1] + b[n][rg][1]), pk_bf16(acc[m][n][4 * rg + 2] + b[n][rg][2], acc[m][n][4 * rg + 3] + b[n][rg][3])};
#pragma unroll
                for (int j = 0; j < 2; ++j) { const auto s0 = __builtin_amdgcn_permlane32_swap(pk[2 * j][0], pk[2 * j + 1][0], false, false); const auto s1 = __builtin_amdgcn_permlane32_swap(pk[2 * j][1], pk[2 * j + 1][1], false, false);
                    pk[2 * j] = (u32x2){s0[0], s1[0]}; pk[2 * j + 1] = (u32x2){s0[1], s1[1]}; }
                if (r0 + r < cnt) {
#pragma unroll
                    for (int j = 0; j < 2; ++j) *(u32x4*)(dst + (size_t)r * D_MODEL + c0 + wc * 64 + n * 32 + 16 * j + 8 * hi) = (u32x4){pk[2 * j][0], pk[2 * j][1], pk[2 * j + 1][0], pk[2 * j + 1][1]}; } }
        }
    }
};
struct EpiDown8h {
    int c0, r0, cnt; bf16_t* dst; const float* bias;
    __device__ __forceinline__ void fin(f32x16 (&acc)[4][1], int wr, int wc, int r32, int hi) {
        f32x4 b[1][4];
#pragma unroll
        for (int n = 0; n < 1; ++n)
#pragma unroll
            for (int rg = 0; rg < 4; ++rg) b[n][rg] = *(const f32x4*)(bias + c0 + wc * 32 + n * 32 + 8 * rg + 4 * hi);
#pragma unroll
        for (int m = 0; m < 4; ++m) { const int r = wr * 128 + m * 32 + r32;
#pragma unroll
            for (int n = 0; n < 1; ++n) { u32x2 pk[4];
#pragma unroll
                for (int rg = 0; rg < 4; ++rg) pk[rg] = (u32x2){pk_bf16(acc[m][n][4 * rg] + b[n][rg][0], acc[m][n][4 * rg + 1] + b[n][rg][1]), pk_bf16(acc[m][n][4 * rg + 2] + b[n][rg][2], acc[m][n][4 * rg + 3] + b[n][rg][3])};
#pragma unroll
                for (int j = 0; j < 2; ++j) { const auto s0 = __builtin_amdgcn_permlane32_swap(pk[2 * j][0], pk[2 * j + 1][0], false, false); const auto s1 = __builtin_amdgcn_permlane32_swap(pk[2 * j][1], pk[2 * j + 1][1], false, false);
                    pk[2 * j] = (u32x2){s0[0], s1[0]}; pk[2 * j + 1] = (u32x2){s0[1], s1[1]}; }
                if (r0 + r < cnt) {
#pragma unroll
                    for (int j = 0; j < 2; ++j) *(u32x4*)(dst + (size_t)r * D_MODEL + c0 + wc * 32 + n * 32 + 16 * j + 8 * hi) = (u32x4){pk[2 * j][0], pk[2 * j][1], pk[2 * j + 1][0], pk[2 * j + 1][1]}; } }
        }
    }
};

constexpr int PG_HTB = 128 * 64 * 2;
__host__ __device__ __forceinline__ int pg_lds_byte(int r, int c) { const int st = (r >> 4) * 2 + (c >> 5), rr = r & 15, cc = c & 31, ob = rr * 64 + cc * 2; return st * 1024 + (ob ^ (((ob >> 9) & 1) << 5)); }
__host__ __device__ __forceinline__ void pg_stage_rc(int b, int& R, int& C) { const int st = b / 1024, sb = b % 1024, swz = sb ^ (((sb >> 9) & 1) << 5); R = (st >> 1) * 16 + swz / 64; C = (st & 1) * 32 + (swz % 64) / 2; }
__host__ __device__ __forceinline__ int pg_tcol(int rho) { return (rho & ~0x30) | ((rho & 0x10) << 1) | ((rho & 0x20) >> 1); }
template <bool MID, class EPI>
__device__ __forceinline__ void gemm_unit_pg(LAS char* lds, const bf16_t* A, const bf16_t* Bt, const int K, EPI& E) {
    const int tid = threadIdx.x, wid = __builtin_amdgcn_readfirstlane(tid >> 6), lane = tid & 63, wr = wid >> 2, wc = wid & 3, fr = lane & 15, fq = lane >> 4;
    const int nt = K / 64;
    unsigned voff[2];
#pragma unroll
    for (int i = 0; i < 2; ++i) { int R, C; pg_stage_rc(tid * 16 + i * 8192, R, C); voff[i] = (unsigned)(R * K + C) * 2u; }
    const size_t kstep = (size_t)(64 * 2), hstep = (size_t)128 * K * 2;
    const unsigned ldsw = (unsigned)wid * 1024u;
    const int aoff = pg_lds_byte(wr * 64 + fr, fq * 8), boff = pg_lds_byte(wc * 32 + fr, fq * 8);
#define PG_SA(b, h) (((b) * 2 + (h)) * PG_HTB)
#define PG_SB(b, h) ((4 + (b) * 2 + (h)) * PG_HTB)
#define PG_STAGE(bufoff, gbase) do { _Pragma("unroll") for (int _i = 0; _i < 2; ++_i) \
        __builtin_amdgcn_global_load_lds((const unsigned*)((const char*)(gbase) + voff[_i]), (LAS unsigned*)(lds + (bufoff) + ldsw + _i * 8192), 16, 0, 0); } while (0)
#define PG_LDA(dst, b, h) do { _Pragma("unroll") for (int m = 0; m < 4; ++m) _Pragma("unroll") for (int k = 0; k < 2; ++k) dst[m][k] = *(const LAS bf16x8*)(lds + PG_SA(b, h) + aoff + m * 2048 + k * 1024); } while (0)
#define PG_LDB(dst, b, h) do { _Pragma("unroll") for (int n = 0; n < 2; ++n) _Pragma("unroll") for (int k = 0; k < 2; ++k) dst[n][k] = *(const LAS bf16x8*)(lds + PG_SB(b, h) + boff + n * 2048 + k * 1024); } while (0)
#define PG_MMA(ai, bj, At_, Bt_) do { __builtin_amdgcn_s_setprio(1); _Pragma("unroll") for (int m = 0; m < 4; ++m) _Pragma("unroll") for (int n = 0; n < 2; ++n) _Pragma("unroll") for (int k = 0; k < 2; ++k) \
        acc[ai][bj][m][n] = __builtin_amdgcn_mfma_f32_16x16x32_bf16(Bt_[n][k], At_[m][k], acc[ai][bj][m][n], 0, 0, 0); __builtin_amdgcn_s_setprio(0); } while (0)
#define PG_WAIT_V(n) asm volatile("s_waitcnt vmcnt(" #n ")" ::: "memory")
#define PG_WAIT_L(n) asm volatile("s_waitcnt lgkmcnt(" #n ")" ::: "memory")
#define PG_BAR __builtin_amdgcn_s_barrier()
    f32x4 acc[2][2][4][2];
#pragma unroll
    for (int a = 0; a < 2; ++a)
#pragma unroll
        for (int b = 0; b < 2; ++b)
#pragma unroll
            for (int m = 0; m < 4; ++m)
#pragma unroll
                for (int n = 0; n < 2; ++n) acc[a][b][m][n] = (f32x4){0.f, 0.f, 0.f, 0.f};
    bf16x8 At[4][2], B0[2][2], B1[2][2];
    const char* cA = (const char*)A; const char* cB = (const char*)Bt;
    PG_STAGE(PG_SB(0, 0), cB); PG_STAGE(PG_SA(0, 0), cA); PG_STAGE(PG_SB(0, 1), cB + hstep); PG_STAGE(PG_SA(0, 1), cA + hstep);
    if (wr == 1) PG_BAR;
    PG_WAIT_V(4); PG_BAR;
    PG_STAGE(PG_SB(1, 0), cB + kstep); PG_STAGE(PG_SA(1, 0), cA + kstep); PG_STAGE(PG_SB(1, 1), cB + hstep + kstep);
    PG_WAIT_V(6); PG_BAR;
    for (int t = 0; t < nt; t += 2) {
        const bool last = (t == nt - 2);
        const char* a1 = cA + (size_t)(t + 1) * kstep;
        const char* a2 = cA + (size_t)(t + 2) * kstep; const char* b2 = cB + (size_t)(t + 2) * kstep;
        const char* a3 = a2 + kstep; const char* b3 = b2 + kstep;
        if (MID && t == (nt >> 1)) E.mid(acc, wr, wc, fr, fq);
        PG_LDB(B0, 0, 0); SBAR(); PG_LDA(At, 0, 0); PG_STAGE(PG_SA(1, 1), a1 + hstep);
        PG_WAIT_L(8); PG_BAR; PG_WAIT_L(0); PG_MMA(0, 0, At, B0); PG_BAR; SBAR();
        PG_LDB(B1, 0, 1); if (!last) PG_STAGE(PG_SB(0, 0), b2);
        PG_BAR; PG_WAIT_L(0); PG_MMA(0, 1, At, B1); PG_BAR;
        PG_LDA(At, 0, 1); if (!last) PG_STAGE(PG_SA(0, 0), a2);
        PG_BAR; PG_WAIT_L(0); PG_MMA(1, 0, At, B0); PG_BAR; SBAR();
        if (!last) { PG_STAGE(PG_SB(0, 1), b2 + hstep); PG_WAIT_V(6); } else PG_WAIT_V(0);
        PG_BAR; PG_MMA(1, 1, At, B1); PG_BAR;
        PG_LDB(B0, 1, 0); SBAR(); PG_LDA(At, 1, 0); if (!last) PG_STAGE(PG_SA(0, 1), a2 + hstep);
        PG_WAIT_L(8); PG_BAR; PG_WAIT_L(0); PG_MMA(0, 0, At, B0); PG_BAR; SBAR();
        PG_LDB(B1, 1, 1); if (!last) PG_STAGE(PG_SB(1, 0), b3);
        PG_BAR; PG_WAIT_L(0); PG_MMA(0, 1, At, B1); PG_BAR;
        PG_LDA(At, 1, 1); if (!last) PG_STAGE(PG_SA(1, 0), a3);
        PG_BAR; PG_WAIT_L(0); PG_MMA(1, 0, At, B0); PG_BAR; SBAR();
        if (!last) { PG_STAGE(PG_SB(1, 1), b3 + hstep); PG_WAIT_V(6); }
        PG_BAR; PG_MMA(1, 1, At, B1); PG_BAR;
    }
    E.fin(acc, wr, wc, fr, fq);
    PG_WAIT_V(0);
    if (wr == 0) PG_BAR;
    PG_BAR;
#undef PG_SA
#undef PG_SB
#undef PG_STAGE
#undef PG_LDA
#undef PG_LDB
#undef PG_MMA
#undef PG_WAIT_V
#undef PG_WAIT_L
#undef PG_BAR
}

#define PG_ROW(ai, m) (128 * (ai) + 64 * wr + 16 * (m) + fr)
#define PG_COL(bj, n) (128 * (bj) + 64 * (wc >> 1) + 32 * (n) + 16 * (wc & 1) + 4 * fq)
struct PEpiProj {
    int pn, brow; unsigned char* ws; const float *qg, *kvg;
    __device__ __forceinline__ void mid(f32x4 (&)[2][2][4][2], int, int, int, int) {}
    __device__ __forceinline__ void fin(f32x4 (&acc)[2][2][4][2], int wr, int wc, int fr, int fq) {
        if (pn < 6) {
            bf16_t* dst; int ldd, c0;
            if (pn < 4) { dst = (bf16_t*)(ws + WS_QA); ldd = 1024; c0 = pn * 256; } else if (pn == 4) { dst = (bf16_t*)(ws + WS_KA); ldd = 256; c0 = 0; } else { dst = (bf16_t*)(ws + WS_VA); ldd = 256; c0 = 0; }
#pragma unroll
            for (int ai = 0; ai < 2; ++ai)
#pragma unroll
                for (int m = 0; m < 4; ++m) { bf16_t* rowp = dst + (size_t)(brow + PG_ROW(ai, m)) * ldd + c0;
#pragma unroll
                    for (int bj = 0; bj < 2; ++bj)
#pragma unroll
                        for (int n = 0; n < 2; ++n) { const f32x4 v = acc[ai][bj][m][n]; *(u32x2*)(rowp + PG_COL(bj, n)) = (u32x2){pk_bf16(v[0], v[1]), pk_bf16(v[2], v[3])}; } }
        } else if (pn < 9) {
            bf16_t* dst; int ldd, c0; const float* g; float* ssq; int nsl, sl0;
            if (pn < 8) { dst = (bf16_t*)(ws + WS_CQ); ldd = 512; c0 = (pn - 6) * 256; g = qg; ssq = (float*)(ws + WS_SSQC); nsl = 16; sl0 = (pn - 6) * 8 + wc; }
            else { dst = (bf16_t*)(ws + WS_CKV); ldd = 256; c0 = 0; g = kvg; ssq = (float*)(ws + WS_SSQK); nsl = 8; sl0 = wc; }
            f32x4 gvv[2][2];
#pragma unroll
            for (int bj = 0; bj < 2; ++bj)
#pragma unroll
                for (int n = 0; n < 2; ++n) gvv[bj][n] = *(const f32x4*)(g + c0 + PG_COL(bj, n));
#pragma unroll
            for (int ai = 0; ai < 2; ++ai)
#pragma unroll
                for (int m = 0; m < 4; ++m) { const int row = brow + PG_ROW(ai, m);
#pragma unroll
                    for (int bj = 0; bj < 2; ++bj) { float ss = 0.f;
#pragma unroll
                        for (int n = 0; n < 2; ++n) { const f32x4 v = acc[ai][bj][m][n]; const f32x4 gv = gvv[bj][n];
                            ss += v[0] * v[0] + v[1] * v[1] + v[2] * v[2] + v[3] * v[3];
                            *(u32x2*)(dst + (size_t)row * ldd + c0 + PG_COL(bj, n)) = (u32x2){pk_bf16(v[0] * gv[0], v[1] * gv[1]), pk_bf16(v[2] * gv[2], v[3] * gv[3])}; }
                        ss += __shfl_xor(ss, 16, 64); ss += __shfl_xor(ss, 32, 64);
                        if (fq == 0) ssq[(size_t)row * nsl + sl0 + 4 * bj] = ss; } }
        } else {
            if (wc < 2) {
                bf16_t* dst = (bf16_t*)(ws + WS_KPE); const float* rope = (const float*)(ws + WS_ROPE); const int i0 = 16 * wc + 4 * fq;
#pragma unroll
                for (int ai = 0; ai < 2; ++ai)
#pragma unroll
                    for (int m = 0; m < 4; ++m) { const int row = brow + PG_ROW(ai, m); const int pos = row & (SEQ - 1); const f32x4 x1 = acc[ai][0][m][0], x2 = acc[ai][0][m][1];
                        const f32x4 cs0 = *(const f32x4*)(rope + ((size_t)pos * 32 + i0) * 2), cs1 = *(const f32x4*)(rope + ((size_t)pos * 32 + i0) * 2 + 4);
                        const float c[4] = {cs0[0], cs0[2], cs1[0], cs1[2]}, s[4] = {cs0[1], cs0[3], cs1[1], cs1[3]};
                        float o1[4], o2[4];
#pragma unroll
                        for (int j = 0; j < 4; ++j) { o1[j] = x1[j] * c[j] - x2[j] * s[j]; o2[j] = x1[j] * s[j] + x2[j] * c[j]; }
                        *(u32x2*)(dst + (size_t)row * 64 + i0) = (u32x2){pk_bf16(o1[0], o1[1]), pk_bf16(o1[2], o1[3])};
                        *(u32x2*)(dst + (size_t)row * 64 + 32 + i0) = (u32x2){pk_bf16(o2[0], o2[1]), pk_bf16(o2[2], o2[3])}; }
            }
        }
    }
};
struct PEpiQUp {
    int pn, brow; unsigned char* ws;
    __device__ __forceinline__ void mid(f32x4 (&)[2][2][4][2], int, int, int, int) {}
    __device__ __forceinline__ void fin(f32x4 (&acc)[2][2][4][2], int wr, int wc, int fr, int fq) {
        bf16_t* dst = (bf16_t*)(ws + WS_QB); const float* rope = (const float*)(ws + WS_ROPE);
        float rs[2][4];
#pragma unroll
        for (int ai = 0; ai < 2; ++ai)
#pragma unroll
            for (int m = 0; m < 4; ++m) { const f32x4* pp = (const f32x4*)((const float*)(ws + WS_SSQC) + (size_t)(brow + PG_ROW(ai, m)) * 16); const f32x4 p0 = pp[0], p1 = pp[1], p2 = pp[2], p3 = pp[3];
                const float sq = (((p0[0] + p0[1]) + (p0[2] + p0[3])) + ((p1[0] + p1[1]) + (p1[2] + p1[3]))) + (((p2[0] + p2[1]) + (p2[2] + p2[3])) + ((p3[0] + p3[1]) + (p3[2] + p3[3])));
                rs[ai][m] = rsqrtf(sq * (1.f / 512.f) + EPS); }
#pragma unroll
        for (int bj = 0; bj < 2; ++bj) { const int seg = pn * 4 + 2 * bj + (wc >> 1), head = seg / 3, part = seg - head * 3; const int i0 = 16 * (wc & 1) + 4 * fq;
#pragma unroll
            for (int ai = 0; ai < 2; ++ai)
#pragma unroll
                for (int m = 0; m < 4; ++m) { const int row = brow + PG_ROW(ai, m); const float r = rs[ai][m]; bf16_t* drow = dst + (size_t)row * 1536 + head * 192 + part * 64;
                    const f32x4 x1 = acc[ai][bj][m][0], x2 = acc[ai][bj][m][1];
                    if (part < 2) {
                        *(u32x2*)(drow + i0) = (u32x2){pk_bf16(x1[0] * r, x1[1] * r), pk_bf16(x1[2] * r, x1[3] * r)};
                        *(u32x2*)(drow + 32 + i0) = (u32x2){pk_bf16(x2[0] * r, x2[1] * r), pk_bf16(x2[2] * r, x2[3] * r)};
                    } else { const int pos = row & (SEQ - 1);
                        const f32x4 cs0 = *(const f32x4*)(rope + ((size_t)pos * 32 + i0) * 2), cs1 = *(const f32x4*)(rope + ((size_t)pos * 32 + i0) * 2 + 4);
                        const float c[4] = {cs0[0], cs0[2], cs1[0], cs1[2]}, s[4] = {cs0[1], cs0[3], cs1[1], cs1[3]};
                        float o1[4], o2[4];
#pragma unroll
                        for (int j = 0; j < 4; ++j) { o1[j] = (x1[j] * c[j] - x2[j] * s[j]) * r; o2[j] = (x1[j] * s[j] + x2[j] * c[j]) * r; }
                        *(u32x2*)(drow + i0) = (u32x2){pk_bf16(o1[0], o1[1]), pk_bf16(o1[2], o1[3])};
                        *(u32x2*)(drow + 32 + i0) = (u32x2){pk_bf16(o2[0], o2[1]), pk_bf16(o2[2], o2[3])}; } } }
    }
};
struct PEpiKvUp {
    int pn, brow; unsigned char* ws;
    __device__ __forceinline__ void mid(f32x4 (&)[2][2][4][2], int, int, int, int) {}
    __device__ __forceinline__ void fin(f32x4 (&acc)[2][2][4][2], int wr, int wc, int fr, int fq) {
        bf16_t* dst = (bf16_t*)(ws + WS_KVB);
#pragma unroll
        for (int ai = 0; ai < 2; ++ai)
#pragma unroll
            for (int m = 0; m < 4; ++m) { const int row = brow + PG_ROW(ai, m); const f32x4* pp = (const f32x4*)((const float*)(ws + WS_SSQK) + (size_t)row * 8); const f32x4 p0 = pp[0], p1 = pp[1];
                const float r = rsqrtf((((p0[0] + p0[1]) + (p0[2] + p0[3])) + ((p1[0] + p1[1]) + (p1[2] + p1[3]))) * (1.f / 256.f) + EPS);
#pragma unroll
                for (int bj = 0; bj < 2; ++bj)
#pragma unroll
                    for (int n = 0; n < 2; ++n) { const f32x4 v = acc[ai][bj][m][n];
                        *(u32x2*)(dst + (size_t)row * 2048 + pn * 256 + PG_COL(bj, n)) = (u32x2){pk_bf16(v[0] * r, v[1] * r), pk_bf16(v[2] * r, v[3] * r)}; } }
    }
};
struct PEpiWo {
    int pn, brow; unsigned char* ws; const float* x; const LAS float* tab;
    __device__ __forceinline__ void mid(f32x4 (&acc)[2][2][4][2], int wr, int wc, int fr, int fq) {
#pragma unroll
        for (int ai = 0; ai < 2; ++ai)
#pragma unroll
            for (int m = 0; m < 4; ++m) { const int r = PG_ROW(ai, m);
                const float f = __builtin_amdgcn_sqrtf((tab[256 + r] + EPS) * __builtin_amdgcn_rcpf(tab[r] + EPS));
#pragma unroll
                for (int bj = 0; bj < 2; ++bj)
#pragma unroll
                    for (int n = 0; n < 2; ++n) acc[ai][bj][m][n] *= f; }
        asm volatile("s_waitcnt lgkmcnt(0)" ::: "memory"); SBAR();
    }
    __device__ __forceinline__ void fin(f32x4 (&acc)[2][2][4][2], int wr, int wc, int fr, int fq) {
        float* x2 = (float*)(ws + WS_X2);
#pragma unroll
        for (int ai = 0; ai < 2; ++ai)
#pragma unroll
            for (int m = 0; m < 4; ++m) { const int r = PG_ROW(ai, m); const size_t o = (size_t)(brow + r) * D_MODEL + pn * 256; const float rbm = rsqrtf(tab[256 + r] + EPS); f32x4 xv[2][2];
#pragma unroll
                for (int bj = 0; bj < 2; ++bj)
#pragma unroll
                    for (int n = 0; n < 2; ++n) xv[bj][n] = *(const f32x4*)(x + o + PG_COL(bj, n));
#pragma unroll
                for (int bj = 0; bj < 2; ++bj)
#pragma unroll
                    for (int n = 0; n < 2; ++n) *(f32x4*)(x2 + o + PG_COL(bj, n)) = acc[ai][bj][m][n] * rbm + xv[bj][n]; }
    }
};
__device__ __forceinline__ void pg_convert(const float* W, int K, int ld, int ncols, int nrows, bf16_t* Bt, int item0, int nitems_stride) {
    const int total = nrows * (K >> 3);
    for (int it0 = item0; it0 < total; it0 += 4 * nitems_stride) { float v[4][8]; int row[4], k0[4]; bool ok[4];
#pragma unroll
        for (int b = 0; b < 4; ++b) { const int it = it0 + b * nitems_stride; const int itc = it < total ? it : item0; const int kc = itc / nrows; row[b] = itc - kc * nrows; k0[b] = kc << 3; ok[b] = it < total;
            const int col = (row[b] & ~255) + pg_tcol(row[b] & 255); const int colc = col < ncols ? col : 0; const float s = col < ncols ? 1.f : 0.f;
#pragma unroll
            for (int q = 0; q < 8; ++q) v[b][q] = W[(size_t)(k0[b] + q) * ld + colc] * s; }
#pragma unroll
        for (int b = 0; b < 4; ++b) if (ok[b])
            *(u32x4*)(Bt + (size_t)row[b] * K + k0[b]) = (u32x4){pk_bf16(v[b][0], v[b][1]), pk_bf16(v[b][2], v[b][3]), pk_bf16(v[b][4], v[b][5]), pk_bf16(v[b][6], v[b][7])}; }
}
__device__ __forceinline__ void sincos_d(double x, double& s, double& c) {
    const double k = __builtin_rint(x * 0.63661977236758134308);
    double r = __builtin_fma(-k, 1.57079632679489655800e+00, x); r = __builtin_fma(-k, 6.12323399573676603587e-17, r);
    const double r2 = r * r;
    double sp = -7.6471637318198164759e-13; sp = sp * r2 + 1.6059043836821614599e-10; sp = sp * r2 - 2.5052108385441718775e-08; sp = sp * r2 + 2.7557319223985890653e-06;
    sp = sp * r2 - 1.9841269841269841270e-04; sp = sp * r2 + 8.3333333333333333333e-03; sp = sp * r2 - 1.6666666666666666667e-01; const double sn = r + r * r2 * sp;
    double cp = 4.7794773323873852974e-14; cp = cp * r2 - 1.1470745597729724714e-11; cp = cp * r2 + 2.0876756987868098979e-09; cp = cp * r2 - 2.7557319223985890653e-07;
    cp = cp * r2 + 2.4801587301587301587e-05; cp = cp * r2 - 1.3888888888888888889e-03; cp = cp * r2 + 4.1666666666666666667e-02; cp = cp * r2 - 0.5; const double cn = 1.0 + r2 * cp;
    const int q = ((int)k) & 3;
    s = (q == 0) ? sn : (q == 1) ? cn : (q == 2) ? -sn : -cn;
    c = (q == 0) ? cn : (q == 1) ? -sn : (q == 2) ? -cn : sn;
}

__device__ __forceinline__ void phase_prologue(const Params& p) {
    const int tid = threadIdx.x, wid = tid >> 6, lane = tid & 63;
    bf16_t* xn = (bf16_t*)(p.ws + WS_XN);
    for (int row = blockIdx.x * 8 + wid; row < NTOK; row += gridDim.x * 8) {
        const f32x4* xr = (const f32x4*)(p.x + (size_t)row * D_MODEL); f32x4 v[8]; float ss = 0.f;
#pragma unroll
        for (int i = 0; i < 8; ++i) { v[i] = xr[lane + 64 * i]; ss += v[i][0] * v[i][0] + v[i][1] * v[i][1] + v[i][2] * v[i][2] + v[i][3] * v[i][3]; }
        ss = wave_sum(ss); const float rs = rsqrtf(ss * (1.f / D_MODEL) + EPS);
#pragma unroll
        for (int i = 0; i < 8; ++i) { const f32x4 g = ((const f32x4*)p.attn_norm)[lane + 64 * i];
            *(u32x2*)(xn + (size_t)row * D_MODEL + 4 * (lane + 64 * i)) = (u32x2){pk_bf16(v[i][0] * rs * g[0], v[i][1] * rs * g[1]), pk_bf16(v[i][2] * rs * g[2], v[i][3] * rs * g[3])}; }
    }
    const int gtid = blockIdx.x * 512 + tid;
    if (gtid < SEQ * 32) {
        const int pos = gtid >> 5, i = gtid & 31;
        double b = 10000.0; for (int q = 0; q < 5; ++q) b = __builtin_sqrt(b);
        double f = 1.0; for (int q = 0; q < i; ++q) f *= b;
        const float inv_freq = (float)(1.0 / f); const float ang = (float)pos * inv_freq;
        double s, c; sincos_d((double)ang, s, c);
        float* rope = (float*)(p.ws + WS_ROPE); rope[(size_t)gtid * 2] = (float)c; rope[(size_t)gtid * 2 + 1] = (float)s;
    }
    {
        const int nth = gridDim.x * 512;
        pg_convert(p.w_in, D_MODEL, IN_COLS, IN_COLS, 2560, (bf16_t*)(p.ws + WS_BT_IN), gtid, nth);
        pg_convert(p.b_w_uq, 512, 1536, 1536, 1536, (bf16_t*)(p.ws + WS_BT_UQ), gtid, nth);
    }
    if (gtid < N_EXP * D_MODEL) {
        ((float*)(p.ws + WS_WRT))[gtid] = p.w_router[gtid] * p.mlp_norm[gtid >> 5];
    }
}

constexpr int AA_PITCH = 144;
constexpr int AA_K = 0, AA_V = 384 * AA_PITCH;
constexpr int AA_WS = 2 * 384 * AA_PITCH;
__device__ __forceinline__ void attn_a_unit(const Params& p, LAS char* lds, int u) {
    const int tid = threadIdx.x, wid = __builtin_amdgcn_readfirstlane(tid >> 6), lane = tid & 63, r32 = lane & 31, hi = lane >> 5;
    const int b = u >> 7, nq = (u >> 2) & 31, kvh = u & 3;
    const bf16_t* QA = (const bf16_t*)(p.ws + WS_QA); const bf16_t* KA = (const bf16_t*)(p.ws + WS_KA); const bf16_t* VA = (const bf16_t*)(p.ws + WS_VA);
    const int P0 = (nq - 1) * 128;
    __syncthreads();
    for (int c = tid; c < 384 * 8; c += 512) { const int r = c >> 3, ch = c & 7; const int pos = P0 + r;
        i32x4 kv = {0, 0, 0, 0}, vv = {0, 0, 0, 0};
        if (pos >= 0 && pos < SEQ) { const size_t g = ((size_t)(b * SEQ + pos)) * 256 + kvh * 64 + ch * 8; kv = *(const i32x4*)(KA + g); vv = *(const i32x4*)(VA + g); }
        *(LAS i32x4*)(lds + AA_K + r * AA_PITCH + ch * 16) = kv; *(LAS i32x4*)(lds + AA_V + r * AA_PITCH + ch * 16) = vv; }
    __syncthreads();
    LAS float* wsf = (LAS float*)(lds + AA_WS) + wid * 64;
    const int hq = kvh * 4 + (wid >> 1);
    const float slope2 = __builtin_amdgcn_exp2f(-8.f * (float)(hq + 1) / 16.f) * LOG2E;
    const float sink2 = p.a_sink[hq] * LOG2E;
    const float C = 0.125f * LOG2E;
    const float* ga = p.out_norm_a + hq * 64;
    bf16_t* Y = (bf16_t*)(p.ws + WS_Y); float* ssqa = (float*)(p.ws + WS_SSQP);
    for (int blk = 0; blk < 2; ++blk) {
        const int q0 = nq * 128 + (wid & 1) * 64 + blk * 32;
        const int tq = q0 + r32;
        bf16x8 qr[4];
        { const bf16_t* qp = QA + ((size_t)(b * SEQ + tq)) * 1024 + hq * 64 + hi * 8;
#pragma unroll
          for (int d0 = 0; d0 < 4; ++d0) qr[d0] = *(const bf16x8*)(qp + d0 * 16); }
        float m_reg = sink2, l_reg = 1.f; f32x16 o[2] = {};
        for (int jt = 0; jt < 6; ++jt) {
            const int kp0 = P0 + jt * 64;
            if (kp0 + 63 < q0 - 128 || kp0 > q0 + 31 + 128 || kp0 + 63 < 0 || kp0 >= SEQ) continue;
            f32x16 p0 = {}, p1 = {};
#pragma unroll
            for (int d0 = 0; d0 < 4; ++d0) {
                const bf16x8 k0 = *(const LAS bf16x8*)(lds + AA_K + (jt * 64 + r32) * AA_PITCH + (d0 * 16 + hi * 8) * 2);
                const bf16x8 k1 = *(const LAS bf16x8*)(lds + AA_K + (jt * 64 + 32 + r32) * AA_PITCH + (d0 * 16 + hi * 8) * 2);
                p0 = __builtin_amdgcn_mfma_f32_32x32x16_bf16(k0, qr[d0], p0, 0, 0, 0);
                p1 = __builtin_amdgcn_mfma_f32_32x32x16_bf16(k1, qr[d0], p1, 0, 0, 0);
            }
            float pmax = -1e30f;
#pragma unroll
            for (int r = 0; r < 16; ++r) {
                { const int kp = kp0 + crow(r, hi); const int dist = tq > kp ? tq - kp : kp - tq; const bool ok = dist <= 128 && kp >= 0 && kp < SEQ;
                  p0[r] = ok ? p0[r] * C - slope2 * (float)dist : -1e30f; pmax = fmaxf(pmax, p0[r]); }
                { const int kp = kp0 + 32 + crow(r, hi); const int dist = tq > kp ? tq - kp : kp - tq; const bool ok = dist <= 128 && kp >= 0 && kp < SEQ;
                  p1[r] = ok ? p1[r] * C - slope2 * (float)dist : -1e30f; pmax = fmaxf(pmax, p1[r]); }
            }
            { auto rr = __builtin_amdgcn_permlane32_swap(__float_as_uint(pmax), __float_as_uint(pmax), false, false); pmax = fmaxf(__uint_as_float(rr[0]), __uint_as_float(rr[1])); }
            const float mn = fmaxf(m_reg, pmax); const float alpha = __builtin_amdgcn_exp2f(m_reg - mn); m_reg = mn;
            float ps = 0.f;
#pragma unroll
            for (int r = 0; r < 16; ++r) { p0[r] = __builtin_amdgcn_exp2f(p0[r] - mn); p1[r] = __builtin_amdgcn_exp2f(p1[r] - mn); ps += p0[r] + p1[r]; }
            { auto rr = __builtin_amdgcn_permlane32_swap(__float_as_uint(ps), __float_as_uint(ps), false, false); ps = __uint_as_float(rr[0]) + __uint_as_float(rr[1]); }
            l_reg = l_reg * alpha + ps;
            if (hi == 0) wsf[r32] = alpha;
            WAIT_L0();
#pragma unroll
            for (int r = 0; r < 16; ++r) { const float a = wsf[crow(r, hi)]; o[0][r] *= a; o[1][r] *= a; }
            bf16x8 pa[4];
#define PK4(P, BASE, OUT) do { unsigned a0 = pk_bf16(P[BASE + 0], P[BASE + 1]), a1 = pk_bf16(P[BASE + 2], P[BASE + 3]); \
    unsigned b0 = pk_bf16(P[BASE + 4], P[BASE + 5]), b1 = pk_bf16(P[BASE + 6], P[BASE + 7]); \
    auto r0_ = __builtin_amdgcn_permlane32_swap(a0, b0, false, false); auto r1_ = __builtin_amdgcn_permlane32_swap(a1, b1, false, false); \
    u32x4 w_ = {r0_[0], r1_[0], r0_[1], r1_[1]}; OUT = __builtin_bit_cast(bf16x8, w_); } while (0)
            PK4(p0, 0, pa[0]); PK4(p0, 8, pa[1]); PK4(p1, 0, pa[2]); PK4(p1, 8, pa[3]);
            const int g16 = (lane >> 4) & 1, qq = (lane & 15) >> 2, pp = lane & 3;
#pragma unroll
            for (int db = 0; db < 2; ++db) {
#pragma unroll
                for (int ks = 0; ks < 4; ++ks) {
                    const LAS char* vp = lds + AA_V + (jt * 64 + ks * 16 + 8 * hi + qq) * AA_PITCH + (db * 32 + 16 * g16 + 4 * pp) * 2;
                    const s16x4 lo = vtr(vp), hh = vtr(vp + 4 * AA_PITCH);
                    const bf16x8 vb = (bf16x8){lo[0], lo[1], lo[2], lo[3], hh[0], hh[1], hh[2], hh[3]};
                    o[db] = __builtin_amdgcn_mfma_f32_32x32x16_bf16(pa[ks], vb, o[db], 0, 0, 0);
                }
            }
            WAIT_L0();
        }
        if (hi == 0) wsf[r32] = 1.f / l_reg;
        WAIT_L0();
        const float g0 = ga[r32], g1 = ga[32 + r32];
#pragma unroll
        for (int r = 0; r < 16; ++r) { const int qrow = crow(r, hi); const float il = wsf[qrow]; const float v0 = o[0][r] * il, v1 = o[1][r] * il;
            const size_t tok = (size_t)(b * SEQ + q0 + qrow);
            bf16_t* yp = Y + tok * 2048 + hq * 64;
            yp[r32] = (bf16_t)(pk_bf16(v0 * g0, 0.f) & 0xffffu); yp[32 + r32] = (bf16_t)(pk_bf16(v1 * g1, 0.f) & 0xffffu);
            float ss = v0 * v0 + v1 * v1;
#pragma unroll
            for (int s = 16; s >= 1; s >>= 1) ss += __shfl_xor(ss, s, 64);
            if (r32 == 0) ssqa[tok * 24 + hq] = ss; }
        WAIT_L0();
    }
}

constexpr int MB_V = 0, MB_KN = 32768, MB_KP = 65536, MB_WS = 81920, MB_QP = 83968;
#define KSWZ(row, colB) ((row) * 256 + ((colB) ^ (((row) & 7) << 4)))
#define KPSWZ(row, colB) ((row) * 128 + ((colB) ^ (((row) & 7) << 4)))
constexpr float MLA_SCALE = 0.07216878364870322f;
constexpr float MLA_THR = 8.f;
__device__ __forceinline__ void mla_partialSM(f32x16& p0, f32x16& p1, float& m_reg, float& mn, float& alpha) {
    constexpr float C = MLA_SCALE * LOG2E;
    float pmax = p0[0];
#pragma unroll
    for (int r = 1; r < 16; ++r) pmax = fmaxf(pmax, p0[r]);
#pragma unroll
    for (int r = 0; r < 16; ++r) pmax = fmaxf(pmax, p1[r]);
    { auto rr = __builtin_amdgcn_permlane32_swap(__float_as_uint(pmax), __float_as_uint(pmax), false, false); pmax = fmaxf(__uint_as_float(rr[0]), __uint_as_float(rr[1])); }
    if (__builtin_expect(__all(pmax - m_reg <= MLA_THR / MLA_SCALE), 1)) { mn = m_reg; alpha = 1.f; }
    else { mn = fmaxf(m_reg, pmax); alpha = __builtin_amdgcn_exp2f((m_reg - mn) * C); m_reg = mn; }
    const float mnC = -mn * C;
#pragma unroll
    for (int r = 0; r < 16; ++r) p0[r] = fmaf(p0[r], C, mnC);
#pragma unroll
    for (int r = 0; r < 16; ++r) p1[r] = fmaf(p1[r], C, mnC);
#pragma unroll
    for (int r = 0; r < 16; ++r) p0[r] = __builtin_amdgcn_exp2f(p0[r]);
}
__device__ __forceinline__ void mla_finishSM(f32x16& p0, f32x16& p1, float alpha, float& l_reg, bf16x8& pa0, bf16x8& pa1, bf16x8& pa2, bf16x8& pa3) {
#pragma unroll
    for (int r = 0; r < 16; ++r) p1[r] = __builtin_amdgcn_exp2f(p1[r]);
    float ps = 0;
#pragma unroll
    for (int r = 0; r < 16; ++r) ps += p0[r];
#pragma unroll
    for (int r = 0; r < 16; ++r) ps += p1[r];
    { auto rr = __builtin_amdgcn_permlane32_swap(__float_as_uint(ps), __float_as_uint(ps), false, false); ps = __uint_as_float(rr[0]) + __uint_as_float(rr[1]); }
    l_reg = l_reg * alpha + ps;
    PK4(p0, 0, pa0); PK4(p0, 8, pa1); PK4(p1, 0, pa2); PK4(p1, 8, pa3);
}
__device__ __forceinline__ void mla_qkt(f32x16& p0, f32x16& p1, const LAS char* Kn, const LAS char* Kp, const bf16x8* qr, const LAS char* qp, int r32, int hi) {
    p0 = f32x16{}; p1 = f32x16{};
#pragma unroll
    for (int d0 = 0; d0 < 8; ++d0) { const int cb = (d0 * 16 + hi * 8) * 2;
        const bf16x8 b0 = *(const LAS bf16x8*)(Kn + KSWZ(r32, cb)); const bf16x8 b1 = *(const LAS bf16x8*)(Kn + KSWZ(32 + r32, cb));
        p0 = __builtin_amdgcn_mfma_f32_32x32x16_bf16(b0, qr[d0], p0, 0, 0, 0); p1 = __builtin_amdgcn_mfma_f32_32x32x16_bf16(b1, qr[d0], p1, 0, 0, 0); }
#pragma unroll
    for (int d0 = 0; d0 < 4; ++d0) { const int cb = (d0 * 16 + hi * 8) * 2;
        const bf16x8 b0 = *(const LAS bf16x8*)(Kp + KPSWZ(r32, cb)); const bf16x8 b1 = *(const LAS bf16x8*)(Kp + KPSWZ(32 + r32, cb));
        const bf16x8 q = *(const LAS bf16x8*)(qp + d0 * 1024);
        p0 = __builtin_amdgcn_mfma_f32_32x32x16_bf16(b0, q, p0, 0, 0, 0); p1 = __builtin_amdgcn_mfma_f32_32x32x16_bf16(b1, q, p1, 0, 0, 0); }
}
__device__ __forceinline__ int v_st(int k, int c) { const int kk = (k & ~0xC) | ((k & 4) << 1) | ((k & 8) >> 1); return ((kk >> 3) * 4 + (c >> 5)) * 512 + ((kk & 7) * 32 + (c & 31)) * 2; }
__device__ __forceinline__ int v_rd_base(int lane) { return ((lane & 3) << 3) | (((lane >> 2) & 3) << 6) | (((lane >> 4) & 1) << 5) | (((lane >> 5) & 1) << 8); }
constexpr int v_rd_off(int d0, int ks, int half) { return d0 * 512 + ks * 4096 + half * 2048; }
template <int D0> __device__ __forceinline__ void mla_pv_one(f32x16& od, const LAS char* vb, bf16x8 pa0, bf16x8 pa1, bf16x8 pa2, bf16x8 pa3) {
    const s16x4 l0 = vtr(vb + v_rd_off(D0, 0, 0)), h0 = vtr(vb + v_rd_off(D0, 0, 1)), l1 = vtr(vb + v_rd_off(D0, 1, 0)), h1 = vtr(vb + v_rd_off(D0, 1, 1));
    const s16x4 l2 = vtr(vb + v_rd_off(D0, 2, 0)), h2 = vtr(vb + v_rd_off(D0, 2, 1)), l3 = vtr(vb + v_rd_off(D0, 3, 0)), h3 = vtr(vb + v_rd_off(D0, 3, 1));
#define PKV(L, H) (bf16x8){L[0], L[1], L[2], L[3], H[0], H[1], H[2], H[3]}
    od = __builtin_amdgcn_mfma_f32_32x32x16_bf16(pa0, PKV(l0, h0), od, 0, 0, 0);
    od = __builtin_amdgcn_mfma_f32_32x32x16_bf16(pa1, PKV(l1, h1), od, 0, 0, 0);
    od = __builtin_amdgcn_mfma_f32_32x32x16_bf16(pa2, PKV(l2, h2), od, 0, 0, 0);
    od = __builtin_amdgcn_mfma_f32_32x32x16_bf16(pa3, PKV(l3, h3), od, 0, 0, 0);
#undef PKV
}
__device__ __forceinline__ void mla_pv(f32x16* o, const LAS char* vb, bf16x8 pa0, bf16x8 pa1, bf16x8 pa2, bf16x8 pa3) {
    mla_pv_one<0>(o[0], vb, pa0, pa1, pa2, pa3); mla_pv_one<1>(o[1], vb, pa0, pa1, pa2, pa3); mla_pv_one<2>(o[2], vb, pa0, pa1, pa2, pa3); mla_pv_one<3>(o[3], vb, pa0, pa1, pa2, pa3);
}
__device__ __forceinline__ void mla_unit(const Params& p, LAS char* lds, int u) {
    const int tid = threadIdx.x, wid = __builtin_amdgcn_readfirstlane(tid >> 6), lane = tid & 63, r32 = lane & 31, hi = lane >> 5;
    const int bh = u >> 4, qb = u & 15, b = bh >> 3, h = bh & 7;
    const bf16_t* QB = (const bf16_t*)(p.ws + WS_QB); const bf16_t* KVB = (const bf16_t*)(p.ws + WS_KVB); const bf16_t* KPE = (const bf16_t*)(p.ws + WS_KPE);
    const bf16_t* Kh = KVB + (size_t)b * SEQ * 2048 + h * 256;
    const bf16_t* Ph = KPE + (size_t)b * SEQ * 64;
    LAS float* wsf = (LAS float*)(lds + MB_WS) + wid * 64; LAS float* li_l = wsf; LAS float* al_l = wsf + 32;
    float m_reg = -1e30f, l_reg = 0; f32x16 o[4] = {}; bf16x8 qr[8];
    LAS char* qp = lds + MB_QP + wid * 4096 + lane * 16;
    { const bf16_t* Qw = QB + ((size_t)(b * SEQ + qb * 256 + wid * 32 + r32)) * 1536 + h * 192 + hi * 8;
#pragma unroll
      for (int d0 = 0; d0 < 8; ++d0) qr[d0] = *(const bf16x8*)(Qw + d0 * 16);
      __syncthreads();
#pragma unroll
      for (int d0 = 0; d0 < 4; ++d0) *(LAS bf16x8*)(qp + d0 * 1024) = *(const bf16x8*)(Qw + (8 + d0) * 16); }
    const int sr = tid >> 4, sc = (tid & 15) * 8, vst0 = v_st(sr, sc), vst1 = v_st(32 + sr, sc);
    const int pr = tid >> 3, pc = (tid & 7) * 8;
    const LAS char* vb0 = lds + MB_V + v_rd_base(lane);
    bf16x8 vs0, vs1, ks0, ks1, kp0;
#define SLOAD(k0) do { vs0 = *(const bf16x8*)(Kh + (size_t)((k0) + sr) * 2048 + 128 + sc); vs1 = *(const bf16x8*)(Kh + (size_t)((k0) + 32 + sr) * 2048 + 128 + sc); \
    ks0 = *(const bf16x8*)(Kh + (size_t)((k0) + sr) * 2048 + sc); ks1 = *(const bf16x8*)(Kh + (size_t)((k0) + 32 + sr) * 2048 + sc); \
    kp0 = *(const bf16x8*)(Ph + (size_t)((k0) + pr) * 64 + pc); } while (0)
#define SWRITE(bb) do { *(LAS bf16x8*)(lds + MB_V + (bb) * 16384 + vst0) = vs0; *(LAS bf16x8*)(lds + MB_V + (bb) * 16384 + vst1) = vs1; \
    *(LAS bf16x8*)(lds + MB_KN + (bb) * 16384 + KSWZ(sr, sc * 2)) = ks0; *(LAS bf16x8*)(lds + MB_KN + (bb) * 16384 + KSWZ(32 + sr, sc * 2)) = ks1; \
    *(LAS bf16x8*)(lds + MB_KP + (bb) * 8192 + KPSWZ(pr, pc * 2)) = kp0; } while (0)
#define RESC(a) do { if (__any((a) < 1.f)) { if (hi == 0) al_l[r32] = (a); WAIT_L0(); \
    _Pragma("unroll") for (int d = 0; d < 4; ++d) _Pragma("unroll") for (int r = 0; r < 16; ++r) o[d][r] *= al_l[crow(r, hi)]; } } while (0)
    f32x16 pA0, pA1, pB0, pB1; float mnA, mnB, alA, alB; bf16x8 pa0, pa1, pa2, pa3; constexpr int NT = SEQ / 64;
    SLOAD(0); SWRITE(0); __syncthreads();
    mla_qkt(pA0, pA1, lds + MB_KN, lds + MB_KP, qr, qp, r32, hi); mla_partialSM(pA0, pA1, m_reg, mnA, alA);
    SLOAD(64); SWRITE(1); __syncthreads();
    for (int j = 1; j + 1 < NT; j += 2) {
        SBAR(); mla_qkt(pB0, pB1, lds + MB_KN + 16384, lds + MB_KP + 8192, qr, qp, r32, hi);
        mla_finishSM(pA0, pA1, alA, l_reg, pa0, pa1, pa2, pa3); SBAR();
        SLOAD((j + 1) * 64); SBAR();
        mla_pv(o, vb0, pa0, pa1, pa2, pa3); mla_partialSM(pB0, pB1, m_reg, mnB, alB);
        __syncthreads(); SWRITE(0);
        RESC(alB); __syncthreads();
        SBAR(); mla_qkt(pA0, pA1, lds + MB_KN, lds + MB_KP, qr, qp, r32, hi);
        mla_finishSM(pB0, pB1, alB, l_reg, pa0, pa1, pa2, pa3); SBAR();
        SLOAD((j + 2) * 64); SBAR();
        mla_pv(o, vb0 + 16384, pa0, pa1, pa2, pa3); mla_partialSM(pA0, pA1, m_reg, mnA, alA);
        __syncthreads(); SWRITE(1);
        RESC(alA); __syncthreads();
    }
    SBAR(); mla_qkt(pB0, pB1, lds + MB_KN + 16384, lds + MB_KP + 8192, qr, qp, r32, hi);
    mla_finishSM(pA0, pA1, alA, l_reg, pa0, pa1, pa2, pa3); SBAR();
    mla_pv(o, vb0, pa0, pa1, pa2, pa3); mla_partialSM(pB0, pB1, m_reg, mnB, alB);
    __syncthreads(); RESC(alB);
    mla_finishSM(pB0, pB1, alB, l_reg, pa0, pa1, pa2, pa3); SBAR();
    mla_pv(o, vb0 + 16384, pa0, pa1, pa2, pa3);
    if (hi == 0) li_l[r32] = l_reg; WAIT_L0();
    bf16_t* Y = (bf16_t*)(p.ws + WS_Y); float* ssqb = (float*)(p.ws + WS_SSQP);
    const float* gb = p.out_norm_b + h * 128;
    float g[4];
#pragma unroll
    for (int d0 = 0; d0 < 4; ++d0) g[d0] = gb[d0 * 32 + r32];
#pragma unroll
    for (int r = 0; r < 16; ++r) { const int orow = crow(r, hi); const float il = __builtin_amdgcn_rcpf(li_l[orow]);
        const size_t tok = (size_t)(b * SEQ + qb * 256 + wid * 32 + orow); bf16_t* yp = Y + tok * 2048 + 1024 + h * 128; float ss = 0.f;
#pragma unroll
        for (int d0 = 0; d0 < 4; ++d0) { const float v = o[d0][r] * il; ss += v * v; yp[d0 * 32 + r32] = (bf16_t)(pk_bf16(v * g[d0], 0.f) & 0xffffu); }
#pragma unroll
        for (int s = 16; s >= 1; s >>= 1) ss += __shfl_xor(ss, s, 64);
        if (r32 == 0) ssqb[tok * 24 + 16 + h] = ss; }
#undef SLOAD
#undef SWRITE
#undef RESC
}

__device__ __forceinline__ void phase_router(const Params& p, LAS char* lds) {
    const int tid = threadIdx.x, wid = __builtin_amdgcn_readfirstlane(tid >> 6), lane = tid & 63;
    const float* x2 = (const float*)(p.ws + WS_X2); const float* wg = (const float*)(p.ws + WS_WRT);
    unsigned char* xn8 = p.ws + WS_XN; unsigned* cnt = (unsigned*)(p.ws + WS_CTL + CTL_CNT);
    int* tokl = (int*)(p.ws + WS_TOKL); int* sel_e = (int*)(p.ws + WS_SEL); int* sel_r = sel_e + NTOK * 4; float* sel_g = (float*)(sel_r + NTOK * 4);
    LAS float* part = (LAS float*)lds;
    LAS float* rsv = (LAS float*)(lds + 32768);
    LAS unsigned* hist = (LAS unsigned*)(lds + 32768 + 128); LAS unsigned* hbase = hist + 32;
    for (int t0 = blockIdx.x * 32; t0 < NTOK; t0 += gridDim.x * 32) {
        __syncthreads();
        if (tid < N_EXP) hist[tid] = 0u;
#pragma unroll 1
        for (int j = 0; j < 4; ++j) { const int t = t0 + 4 * wid + j; f32x4 xr[8]; float ss = 0.f;
#pragma unroll
            for (int i = 0; i < 8; ++i) { xr[i] = ((const f32x4*)(x2 + (size_t)t * D_MODEL))[lane + 64 * i]; ss += xr[i][0] * xr[i][0] + xr[i][1] * xr[i][1] + xr[i][2] * xr[i][2] + xr[i][3] * xr[i][3]; }
            const float rs = rsqrtf(wave_sum(ss) * (1.f / D_MODEL) + EPS);
            if (lane == 0) rsv[4 * wid + j] = rs;
#pragma unroll
            for (int i = 0; i < 8; ++i) { const f32x4 v = xr[i]; const f32x4 g = ((const f32x4*)p.mlp_norm)[lane + 64 * i]; const float s16 = 16.f * rs;
                *(unsigned*)(xn8 + (size_t)t * D_MODEL + 4 * (lane + 64 * i)) = pk4_fp8(s16 * v[0] * g[0], s16 * v[1] * g[1], s16 * v[2] * g[2], s16 * v[3] * g[3]); } }
        { f32x16 acc;
#pragma unroll
          for (int r = 0; r < 16; ++r) acc[r] = 0.f;
          const float* ap = x2 + (size_t)(t0 + (lane & 31)) * D_MODEL + 256 * wid + 4 * (lane >> 5);
          const float* bp = wg + (size_t)(256 * wid + 4 * (lane >> 5)) * N_EXP + (lane & 31);
#pragma unroll 4
          for (int c = 0; c < 32; ++c) { const f32x4 a4 = *(const f32x4*)(ap + 8 * c);
#pragma unroll
              for (int q = 0; q < 4; ++q) acc = __builtin_amdgcn_mfma_f32_32x32x2f32(a4[q], bp[(size_t)(8 * c + q) * N_EXP], acc, 0, 0, 0); }
#pragma unroll
          for (int r = 0; r < 16; ++r) part[wid * 1024 + crow(r, lane >> 5) * 32 + (lane & 31)] = acc[r]; }
        __syncthreads();
        int my_e[4]; unsigned my_lr[4]; float my_g[4];
#pragma unroll
        for (int j = 0; j < 4; ++j) { const int tl = 4 * wid + j;
            float v = -3.0e38f;
            if (lane < 32) { float s = 0.f;
#pragma unroll
                for (int w = 0; w < 8; ++w) s += part[w * 1024 + tl * 32 + lane];
                v = s * rsv[tl] + p.b_router[lane]; }
            float tv[4]; int ti[4];
#pragma unroll
            for (int r = 0; r < 4; ++r) {
                float bv = v; int bi = lane;
#pragma unroll
                for (int o = 32; o >= 1; o >>= 1) { const float ov = __shfl_xor(bv, o, 64); const int oi = __shfl_xor(bi, o, 64); if (ov > bv || (ov == bv && oi < bi)) { bv = ov; bi = oi; } }
                tv[r] = bv; ti[r] = bi; if (lane == bi) v = -3.0e38f;
            }
            const float e0 = 1.f, e1 = __expf(tv[1] - tv[0]), e2 = __expf(tv[2] - tv[0]), e3 = __expf(tv[3] - tv[0]); const float inv = 1.f / (e0 + e1 + e2 + e3);
            const float gts[4] = {e0 * inv, e1 * inv, e2 * inv, e3 * inv};
            my_e[j] = ti[lane & 3]; my_g[j] = gts[lane & 3]; my_lr[j] = 0u;
            if (lane < 4) my_lr[j] = __hip_atomic_fetch_add(hist + my_e[j], 1u, __ATOMIC_RELAXED, __HIP_MEMORY_SCOPE_WORKGROUP);
        }
        __syncthreads();
        if (tid < N_EXP) hbase[tid] = atomicAdd(cnt + tid * 16, hist[tid]);
        __syncthreads();
        if (lane < 4) {
#pragma unroll
            for (int j = 0; j < 4; ++j) { const int t = t0 + 4 * wid + j; const int e = my_e[j]; const unsigned rk = hbase[e] + my_lr[j];
                tokl[e * NTOK + rk] = t; sel_e[t * 4 + lane] = e; sel_r[t * 4 + lane] = (int)rk; sel_g[t * 4 + lane] = my_g[j]; }
        }
    }
}

__device__ __forceinline__ void phase_combine(const Params& p, const LAS int* s_roff) {
    const int tid = threadIdx.x, wid = tid >> 6, lane = tid & 63;
    const float* x2 = (const float*)(p.ws + WS_X2); const bf16_t* ys = (const bf16_t*)(p.ws + WS_YS);
    const int* sel_e = (const int*)(p.ws + WS_SEL); const int* sel_r = sel_e + NTOK * 4; const float* sel_g = (const float*)(sel_r + NTOK * 4);
    for (int t = blockIdx.x * 8 + wid; t < NTOK; t += gridDim.x * 8) {
        f32x4 v[8];
#pragma unroll
        for (int i = 0; i < 8; ++i) v[i] = ((const f32x4*)(x2 + (size_t)t * D_MODEL))[lane + 64 * i];
#pragma unroll
        for (int k = 0; k < 4; ++k) { const int e = sel_e[t * 4 + k]; const size_t slot = (size_t)(s_roff[e] + sel_r[t * 4 + k]); const float g = sel_g[t * 4 + k];
            const u32x2* yr = (const u32x2*)(ys + slot * D_MODEL);
#pragma unroll
            for (int i = 0; i < 8; ++i) { const u32x2 w = yr[lane + 64 * i]; v[i][0] += g * bf_lo(w[0]); v[i][1] += g * bf_hi(w[0]); v[i][2] += g * bf_lo(w[1]); v[i][3] += g * bf_hi(w[1]); } }
        float ss = 0.f;
#pragma unroll
        for (int i = 0; i < 8; ++i) ss += v[i][0] * v[i][0] + v[i][1] * v[i][1] + v[i][2] * v[i][2] + v[i][3] * v[i][3];
        ss = wave_sum(ss); const float rs = rsqrtf(ss * (1.f / D_MODEL) + EPS);
#pragma unroll
        for (int i = 0; i < 8; ++i) { const f32x4 g = ((const f32x4*)p.final_norm)[lane + 64 * i];
            ((f32x4*)(p.out + (size_t)t * D_MODEL))[lane + 64 * i] = (f32x4){v[i][0] * rs * g[0], v[i][1] * rs * g[1], v[i][2] * rs * g[2], v[i][3] * rs * g[3]}; }
    }
}

constexpr int NPHASE = 9;
__global__ void __launch_bounds__(512, 2) mega_fwd(Params p) {
    extern __shared__ __attribute__((aligned(1024))) char smem_raw[];
    LAS char* lds = (LAS char*)smem_raw;
    LAS unsigned* misc = (LAS unsigned*)(lds + LDS_MISC);
    const int tid = threadIdx.x;
    if (tid < 4) misc[tid] = 0u;
    __syncthreads();
    unsigned* bar = (unsigned*)(p.ws + WS_CTL + CTL_BAR);
    XcdBarrier xb = xcd_barrier_post(bar, (volatile LAS unsigned*)misc);
    const int lo = p.ph_lo, hi = p.ph_hi;
    const int G = gridDim.x, bid = blockIdx.x;
    const int xperm = (bid & 7) * (G >> 3) + (bid >> 3);
#ifdef PH_ONLY
#define IN(k) ((k)==PH_ONLY)
#else
#define IN(k) (lo <= (k) && (k) < hi)
#endif
#define SEAM(k) do { if (IN(k) && IN((k) + 1)) xcd_barrier(xb); } while (0)
    if (IN(0)) phase_prologue(p);
    SEAM(0);
    if (IN(1)) {
        for (int u = xperm; u < 32 * 8; u += G) {
            const int pn = u / 32, pm = u % 32;
            PEpiProj ep{pn, pm * 256, p.ws, p.b_q_norm, p.b_kv_norm};
            __syncthreads();
            gemm_unit_pg<false>(lds, (const bf16_t*)(p.ws + WS_XN) + (size_t)pm * 256 * D_MODEL, (const bf16_t*)(p.ws + WS_BT_IN) + (size_t)pn * 256 * D_MODEL, D_MODEL, ep);
        }
    }
    SEAM(1);
    if (IN(2)) {
        { const int b0 = bid;
            int qv;
            if ((b0 & 3) == 0) {
                const int h = b0 >> 2, pn = 8 + (h >> 5), pm = h & 31;
                PEpiProj ep{pn, pm * 256, p.ws, p.b_q_norm, p.b_kv_norm};
                __syncthreads();
                gemm_unit_pg<false>(lds, (const bf16_t*)(p.ws + WS_XN) + (size_t)pm * 256 * D_MODEL, (const bf16_t*)(p.ws + WS_BT_IN) + (size_t)pn * 256 * D_MODEL, D_MODEL, ep);
                qv = 128 + h;
            } else {
                const int v = (b0 >> 2) * 3 + (b0 & 3) - 1;
                if (v < 128) {
                    attn_a_unit(p, lds, v); qv = v;
                    pg_convert(p.w_o, D_MODEL, D_MODEL, D_MODEL, 2048, (bf16_t*)(p.ws + WS_BT_WO), v * 1024 + tid, 128 * 1024);
                    pg_convert(p.w_o, D_MODEL, D_MODEL, D_MODEL, 2048, (bf16_t*)(p.ws + WS_BT_WO), v * 1024 + 512 + tid, 128 * 1024);
                } else {
                    const int w = v - 128; qv = -1;
                    attn_a_unit(p, lds, 128 + 2 * w); attn_a_unit(p, lds, 129 + 2 * w);
                    if (w < 32) pg_convert(p.b_w_ukv, 256, 2048, 2048, 2048, (bf16_t*)(p.ws + WS_BT_UKV), w * 512 + tid, 32 * 512);
                }
            }
            if (qv >= 0) { const int pn = qv / 32, pm = qv % 32;
                PEpiQUp ep{pn, pm * 256, p.ws};
                __syncthreads();
                gemm_unit_pg<false>(lds, (const bf16_t*)(p.ws + WS_CQ) + (size_t)pm * 256 * 512, (const bf16_t*)(p.ws + WS_BT_UQ) + (size_t)pn * 256 * 512, 512, ep);
                __syncthreads(); }
        }
        xcd_barrier(xb);
        for (int u = xperm; u < 32 * 8; u += G) {
            const int pn = u / 32, pm = u % 32;
            PEpiKvUp ep{pn, pm * 256, p.ws};
            __syncthreads();
            gemm_unit_pg<false>(lds, (const bf16_t*)(p.ws + WS_CKV) + (size_t)pm * 256 * 256, (const bf16_t*)(p.ws + WS_BT_UKV) + (size_t)pn * 256 * 256, 256, ep);
        }
    }
    SEAM(2);
    if (IN(3)) { for (int u = xperm; u < 256; u += G) mla_unit(p, lds, u); }
    SEAM(3);
    if (IN(4)) {
        __syncthreads();
        for (int u = xperm; u < 32 * 8; u += G) {
            const int pn = u / 32, pm = u % 32;
            LAS float* tab = (LAS float*)(lds + 2 * G_STAGE_B);
            __syncthreads();
            if (tid < 256) { const f32x4* pp = (const f32x4*)((const float*)(p.ws + WS_SSQP) + (size_t)(pm * 256 + tid) * 24); float sa = 0.f, sb2 = 0.f;
#pragma unroll
                for (int q = 0; q < 4; ++q) { const f32x4 v = pp[q]; sa += (v[0] + v[1]) + (v[2] + v[3]); }
#pragma unroll
                for (int q = 4; q < 6; ++q) { const f32x4 v = pp[q]; sb2 += (v[0] + v[1]) + (v[2] + v[3]); }
                tab[tid] = sa * (1.f / 1024.f); tab[256 + tid] = sb2 * (1.f / 1024.f); }
            __syncthreads();
            PEpiWo ep{pn, pm * 256, p.ws, p.x, tab};
            gemm_unit_pg<true>(lds, (const bf16_t*)(p.ws + WS_Y) + (size_t)pm * 256 * D_MODEL, (const bf16_t*)(p.ws + WS_BT_WO) + (size_t)pn * 256 * D_MODEL, D_MODEL, ep);
        }
    }
    SEAM(4);
    if (IN(5)) phase_router(p, lds);
    SEAM(5);
    LAS int* s_cnt = (LAS int*)(misc + 16); LAS int* s_toff = (LAS int*)(misc + 48); LAS int* s_roff = (LAS int*)(misc + 96);
    if (IN(6) || IN(7) || IN(8)) {
        if (tid == 0) { const unsigned* cnt = (const unsigned*)(p.ws + WS_CTL + CTL_CNT); int to = 0;
            for (int e = 0; e < N_EXP; ++e) { const int c = (int)xb_ld((unsigned*)cnt + e * 16); s_cnt[e] = c; s_toff[e] = to; s_roff[e] = to * 256; to += (c + 255) >> 8; }
            s_toff[N_EXP] = to; }
        __syncthreads();
    }
    if (IN(6)) {
        const int TM = s_toff[N_EXP];
        const int T16 = TM * 16, NF = (T16 & ~255), R = T16 - NF;
        const bool halves = R > 0 && R <= 128;
        int round = 0;
        for (int L = xperm; L < (halves ? NF : T16); L += G, ++round) {
            if (round == ((xperm >> 3) & 7))
                conv_image(p.w_down + (size_t)(xperm >> 3) * D_FF * D_MODEL + (xperm & 7) * 256, (size_t)D_MODEL, p.ws + WS_IMG_DN + (size_t)xperm * 32 * 16384, 0, 32);
            int e = 0; while (s_toff[e + 1] * 16 <= L) ++e;
            const int w = L - s_toff[e] * 16, nte = s_toff[e + 1] - s_toff[e], ntile = w / nte, mt = w - ntile * nte, cntE = s_cnt[e];
            AGather8 af{p.ws + WS_XN, (const int*)(p.ws + WS_TOKL) + (size_t)e * NTOK, mt * 256, cntE};
            BGateUp bf{p.w_up + (size_t)e * D_MODEL * (2 * D_FF) + ntile * 128, (size_t)(2 * D_FF)};
            EpiUp8 ep{ntile * 128, mt * 256, cntE, p.ws + WS_ACT + ((size_t)s_roff[e] + mt * 256) * D_FF, p.b_up + (size_t)e * (2 * D_FF)};
            gemm_unit8<0x7B7B7B7B>(lds, (LAS unsigned*)(misc + 8), D_MODEL / 64, af, bf, ep);
        }
        if (round <= ((xperm >> 3) & 7))
            conv_image(p.w_down + (size_t)(xperm >> 3) * D_FF * D_MODEL + (xperm & 7) * 256, (size_t)D_MODEL, p.ws + WS_IMG_DN + (size_t)xperm * 32 * 16384, 0, 32);
        if (halves && xperm < 2 * R) {
            const int L = NF + (xperm >> 1), hf = xperm & 1;
            int e = 0; while (s_toff[e + 1] * 16 <= L) ++e;
            const int w = L - s_toff[e] * 16, nte = s_toff[e + 1] - s_toff[e], ntile = w / nte, mt = w - ntile * nte, cntE = s_cnt[e];
            AGather8 af{p.ws + WS_XN, (const int*)(p.ws + WS_TOKL) + (size_t)e * NTOK, mt * 256, cntE};
            BGateUp bf{p.w_up + (size_t)e * D_MODEL * (2 * D_FF) + ntile * 128 + hf * 64, (size_t)(2 * D_FF)};
            EpiUp8q ep{ntile * 128 + hf * 64, mt * 256, cntE, p.ws + WS_ACT + ((size_t)s_roff[e] + mt * 256) * D_FF, p.b_up + (size_t)e * (2 * D_FF)};
            gemm_unit8q<0x7B7B7B7B>(lds, (LAS unsigned*)(misc + 8), D_MODEL / 64, af, bf, ep);
        }
    }
    SEAM(6);
    if (IN(7)) {
        const int TM = s_toff[N_EXP];
        const int T8 = TM * 8, NF = T8 & ~255, R = T8 - NF;
        const bool halves = R > 0 && R <= 128;
        for (int L = xperm; L < (halves ? NF : T8); L += G) {
            int e = 0; while (s_toff[e + 1] * 8 <= L) ++e;
            const int w = L - s_toff[e] * 8, nte = s_toff[e + 1] - s_toff[e], ntile = w / nte, mt = w - ntile * nte, cntE = s_cnt[e];
            ARows8 af{p.ws + WS_ACT + ((size_t)s_roff[e] + mt * 256) * D_FF, (unsigned)D_FF};
            EpiDown8 ep{ntile * 256, mt * 256, cntE, (bf16_t*)(p.ws + WS_YS) + ((size_t)s_roff[e] + mt * 256) * D_MODEL, p.b_down + (size_t)e * D_MODEL};
            gemm_unit8b<0x7D7D7D7D>(lds, (LAS unsigned*)(misc + 8), D_FF / 64, af, p.ws + WS_IMG_DN + (size_t)(e * 8 + ntile) * 32 * 16384, ep);
        }
        if (halves && xperm < 2 * R) {
            const int L = NF + (xperm >> 1), hf = xperm & 1;
            int e = 0; while (s_toff[e + 1] * 8 <= L) ++e;
            const int w = L - s_toff[e] * 8, nte = s_toff[e + 1] - s_toff[e], ntile = w / nte, mt = w - ntile * nte, cntE = s_cnt[e];
            ARows8 af{p.ws + WS_ACT + ((size_t)s_roff[e] + mt * 256) * D_FF, (unsigned)D_FF};
            EpiDown8h ep{ntile * 256 + hf * 128, mt * 256, cntE, (bf16_t*)(p.ws + WS_YS) + ((size_t)s_roff[e] + mt * 256) * D_MODEL, p.b_down + (size_t)e * D_MODEL};
            gemm_unit8bh<0x7D7D7D7D>(lds, (LAS unsigned*)(misc + 8), D_FF / 64, af, p.ws + WS_IMG_DN + (size_t)(e * 8 + ntile) * 32 * 16384, hf, ep);
        }
    }
    SEAM(7);
    if (IN(8)) phase_combine(p, s_roff);
}

extern "C" void kernel_launch(void* const* d_in, const int* in_sizes, int n_in, void* d_out, int out_size, void* d_ws, size_t ws_size, hipStream_t stream) {
    static int ready = 0;
    if (!ready) {
        if (hipFuncSetAttribute((const void*)mega_fwd, hipFuncAttributeMaxDynamicSharedMemorySize, LDS_BYTES) != hipSuccess) { fprintf(stderr, "kernel_launch: hipFuncSetAttribute failed\n"); return; }
        int per_cu = 0; hipOccupancyMaxActiveBlocksPerMultiprocessor(&per_cu, (const void*)mega_fwd, 512, LDS_BYTES);
        if (per_cu < 1) { fprintf(stderr, "kernel_launch: occupancy query says 0 blocks per CU\n"); return; }
        ready = 1;
    }
    if (ws_size < WS_END) { fprintf(stderr, "kernel_launch: workspace too small\n"); return; }
    hipMemsetAsync((unsigned char*)d_ws + WS_CTL, 0, CTL_BYTES, stream);
    Params p{};
    const float** f = (const float**)&p;
    for (int i = 0; i < 19; ++i) f[i] = (const float*)d_in[i];
    p.out = (float*)d_out; p.ws = (unsigned char*)d_ws; p.ph_lo = 0; p.ph_hi = NPHASE;
    hipLaunchKernelGGL(mega_fwd, dim3(256), dim3(512), LDS_BYTES, stream, p);
}
```

```cpp
#include <hip/hip_runtime.h>
#include <stdint.h>
#include <stdio.h>

#define LAS __attribute__((address_space(3)))
typedef unsigned short bf16_t;
typedef short bf16x8 __attribute__((ext_vector_type(8)));
typedef short s16x4 __attribute__((ext_vector_type(4)));
typedef short v4i16_t __attribute__((ext_vector_type(4)));
typedef float f32x2 __attribute__((ext_vector_type(2)));
typedef float f32x4 __attribute__((ext_vector_type(4)));
typedef float f32x16 __attribute__((ext_vector_type(16)));
typedef int i32x4 __attribute__((ext_vector_type(4)));
typedef unsigned u32x2 __attribute__((ext_vector_type(2)));
typedef unsigned u32x4 __attribute__((ext_vector_type(4)));
typedef __bf16 bf16x2_t __attribute__((ext_vector_type(2)));
typedef int v8i __attribute__((ext_vector_type(8)));
typedef int v2i __attribute__((ext_vector_type(2)));
typedef short v2s __attribute__((ext_vector_type(2)));

constexpr int D_MODEL = 2048, SEQ = 4096, BATCH = 2, NTOK = BATCH * SEQ;
constexpr int IN_COLS = 2368;
constexpr int N_EXP = 32, TOP_K = 4, D_FF = 2048;
constexpr float EPS = 1e-5f;
constexpr float LOG2E = 1.4426950408889634f;

constexpr size_t MiB = 1u << 20;
constexpr size_t WS_CTL = 0, CTL_BYTES = 1 * MiB;
constexpr size_t WS_XN = 1 * MiB, WS_QA = 33 * MiB, WS_KA = 49 * MiB, WS_VA = 53 * MiB, WS_CQ = 57 * MiB, WS_CKV = 65 * MiB, WS_KPE = 69 * MiB;
constexpr size_t WS_QB = 70 * MiB, WS_KVB = 94 * MiB, WS_Y = 126 * MiB, WS_X2 = 158 * MiB, WS_ROPE = 222 * MiB, WS_WRT = 223 * MiB;
constexpr size_t WS_TOKL = 224 * MiB, WS_SEL = 225 * MiB, WS_ACT = 226 * MiB, WS_YS = 386 * MiB, WS_BT_IN = 546 * MiB, WS_BT_UQ = 558 * MiB, WS_BT_UKV = 560 * MiB, WS_BT_WO = 562 * MiB, WS_SSQ2 = 570 * MiB, WS_IMG_DN = 571 * MiB, WS_END = 699 * MiB;
constexpr size_t WS_SSQP = WS_WRT + 262144;
constexpr size_t WS_SSQC = WS_SSQ2;
constexpr size_t WS_SSQK = WS_SSQ2 + 524288;
constexpr size_t CTL_BAR = 0, CTL_CNT = 16384, CTL_SSQ_CQ = 65536, CTL_SSQ_CKV = 98304, CTL_SSQ_A = 131072, CTL_SSQ_B = 163840, CTL_SSQ_X2 = 196608;

__device__ __forceinline__ unsigned pk_bf16(float lo, float hi) { f32x2 v = {lo, hi}; bf16x2_t b = __builtin_convertvector(v, bf16x2_t); return __builtin_bit_cast(unsigned, b); }
__device__ __forceinline__ unsigned pk4_fp8(float a, float b, float c, float d) { int w = __builtin_amdgcn_cvt_pk_fp8_f32(a, b, 0, false); w = __builtin_amdgcn_cvt_pk_fp8_f32(c, d, w, true); return (unsigned)w; }
__device__ __forceinline__ unsigned pk4_fp8_x64(f32x4 v) { v2s r; asm("" : "=v"(r));
    r = __builtin_amdgcn_cvt_scalef32_pk_fp8_f32(r, v[0], v[1], 0.015625f, false); r = __builtin_amdgcn_cvt_scalef32_pk_fp8_f32(r, v[2], v[3], 0.015625f, true); return __builtin_bit_cast(unsigned, r); }
__device__ __forceinline__ float bf_lo(unsigned u) { return __uint_as_float(u << 16); }
__device__ __forceinline__ float bf_hi(unsigned u) { return __uint_as_float(u & 0xffff0000u); }
__device__ __forceinline__ float wave_sum(float v) {
#pragma unroll
    for (int o = 32; o >= 1; o >>= 1) v += __shfl_xor(v, o, 64);
    return v;
}
__device__ __forceinline__ int crow(int r, int hi) { return (r & 3) + 8 * (r >> 2) + 4 * hi; }
__device__ __forceinline__ s16x4 vtr(const LAS char* p) { return __builtin_bit_cast(s16x4, __builtin_amdgcn_ds_read_tr16_b64_v4i16((LAS v4i16_t*)p)); }
#define SBAR() __builtin_amdgcn_sched_barrier(0)

#define XB_TMO      128
#define XB_XCNT(j)  (256  + 64 * (j))
#define XB_XSUB(j)  (1280 + 64 * (j))
#define XB_XGEN(j)  (2304 + 64 * (j))
#define XB_TOP      3328
#define XB_TOPGEN   3392
#define XCD_BAR_WORDS 3456
#define XB_SPIN_CAP (1u << 18)
__device__ __forceinline__ unsigned xb_ld(unsigned* p)              { return __hip_atomic_load(p, __ATOMIC_RELAXED, __HIP_MEMORY_SCOPE_AGENT); }
__device__ __forceinline__ unsigned xb_add(unsigned* p, unsigned v) { return __hip_atomic_fetch_add(p, v, __ATOMIC_RELAXED, __HIP_MEMORY_SCOPE_AGENT); }
__device__ __forceinline__ unsigned xb_xcc_id() { return (unsigned)__builtin_amdgcn_s_getreg((3 << 11) | 20) & 0xFu; }
#define XB_SPIN(cond, bar) do { unsigned _sp = 0; while (cond) { __builtin_amdgcn_s_sleep(1); \
    if ((++_sp & 255u) == 0u) { if (xb_ld(&(bar)[XB_TMO])) break; if (_sp > XB_SPIN_CAP) { atomicAdd(&(bar)[XB_TMO], 1u); break; } } } } while (0)
struct XcdBarrier { unsigned* bar; unsigned x; volatile LAS unsigned* st; };
__device__ __forceinline__ XcdBarrier xcd_barrier_post(unsigned* bar, volatile LAS unsigned* st) {
    XcdBarrier b; b.bar = bar; b.x = xb_xcc_id(); b.st = st;
    if (threadIdx.x == 0) (void)xb_add(&bar[XB_XCNT(b.x)], 1u);
    return b;
}
__device__ __forceinline__ void xcd_barrier_complete(unsigned* bar, unsigned x, unsigned& nloc, unsigned& nx) {
    const unsigned G = gridDim.x * gridDim.y * gridDim.z;
    unsigned sum, cnt, mine, sp = 0u;
    for (;;) {
        sum = 0u; cnt = 0u; mine = 0u;
#pragma unroll
        for (unsigned j = 0; j < 16; ++j) { const unsigned c = xb_ld(&bar[XB_XCNT(j)]); sum += c; cnt += (c > 0u) ? 1u : 0u; mine = (j == x) ? c : mine; }
        if (sum == G) break;
        __builtin_amdgcn_s_sleep(1);
        if ((++sp & 255u) == 0u) { if (xb_ld(&bar[XB_TMO])) break; if (sp > XB_SPIN_CAP) { atomicAdd(&bar[XB_TMO], 1u); break; } }
    }
    nloc = mine > 0u ? mine : 1u; nx = cnt > 0u ? cnt : 1u;
}
__device__ __forceinline__ void xcd_barrier(const XcdBarrier& b) {
    asm volatile("s_waitcnt vmcnt(0)" ::: "memory");
    __syncthreads();
    if (threadIdx.x == 0) {
        unsigned* bar = b.bar;
        __builtin_amdgcn_s_waitcnt(0);
        unsigned nloc = b.st[0], nx = b.st[1];
        if (nloc == 0u) { xcd_barrier_complete(bar, b.x, nloc, nx); b.st[0] = nloc; b.st[1] = nx; }
        const unsigned old = xb_add(&bar[XB_XSUB(b.x)], 1u);
        const unsigned gen = old / nloc;
        if (old + 1u == (gen + 1u) * nloc) {
            __builtin_amdgcn_fence(__ATOMIC_RELEASE, "agent");
            asm volatile("s_waitcnt vmcnt(0)" ::: "memory");
            const unsigned og = xb_add(&bar[XB_TOP], 1u);
            const unsigned tg = og / nx;
            if (og + 1u == (tg + 1u) * nx) xb_add(&bar[XB_TOPGEN], 1u);
            else XB_SPIN(xb_ld(&bar[XB_TOPGEN]) == tg, bar);
            __builtin_amdgcn_fence(__ATOMIC_ACQUIRE, "agent");
            xb_add(&bar[XB_XGEN(b.x)], 1u);
            asm volatile("s_waitcnt vmcnt(0)" ::: "memory");
        } else {
            XB_SPIN(xb_ld(&bar[XB_XGEN(b.x)]) == gen, bar);
            __builtin_amdgcn_fence(__ATOMIC_ACQUIRE, "agent");
            asm volatile("s_waitcnt vmcnt(0)" ::: "memory");
        }
    }
    __syncthreads();
}

constexpr int A_TILE_B = 256 * 64 * 2;
constexpr int B_PITCH = 544;
constexpr int B_TILE_B = 64 * B_PITCH;
constexpr int G_STAGE_B = A_TILE_B + B_TILE_B;
constexpr int LDS_MISC = 155648;
constexpr int LDS_BYTES = LDS_MISC + 1024;

__device__ __forceinline__ int a_img_byte(int r, int chunk) { return r * 128 + ((chunk ^ ((r >> 1) & 7)) << 4); }
#define WAIT_L0() asm volatile("s_waitcnt lgkmcnt(0)" ::: "memory")
__device__ __forceinline__ void glds16(const void* gsrc, unsigned lds_dst) { unsigned keep;
    asm volatile("s_mov_b32 %0, m0\n\ts_mov_b32 m0, %2\n\ts_nop 0\n\tglobal_load_lds_dwordx4 %1, off\n\ts_mov_b32 m0, %0" : "=&s"(keep) : "v"(gsrc), "s"(lds_dst) : "memory"); }
#define RAW_BARRIER() do { WAIT_L0(); __builtin_amdgcn_s_barrier(); } while (0)

__device__ __forceinline__ const char* uniform_ptr(const void* p) {
    const unsigned long long v = (unsigned long long)p;
    const unsigned lo = __builtin_amdgcn_readfirstlane((unsigned)v), hi = __builtin_amdgcn_readfirstlane((unsigned)(v >> 32));
    return (const char*)(((unsigned long long)hi << 32) | lo);
}
__device__ __forceinline__ void glds16s(const char* sbase, unsigned voff, unsigned lds_dst) { unsigned keep;
    asm volatile("s_mov_b32 %0, m0\n\ts_mov_b32 m0, %3\n\ts_nop 4\n\tglobal_load_lds_dwordx4 %1, %2\n\ts_mov_b32 m0, %0" : "=&s"(keep) : "v"(voff), "s"(sbase), "s"(lds_dst) : "memory"); }
#define WAIT_V4(n, a, b, c, d) asm volatile("s_waitcnt vmcnt(" #n ")" : "+v"(a), "+v"(b), "+v"(c), "+v"(d) :: "memory")
template <bool MID, class AF, class BF, class EPI>
__device__ __forceinline__ void gemm_unit(LAS char* lds, const int nt, const AF& af, const BF& bf, EPI& epi) {
    const int tid = threadIdx.x, wid = __builtin_amdgcn_readfirstlane(tid >> 6), lane = tid & 63, wr = wid >> 2, wc = wid & 3, fr = lane & 15, fq = lane >> 4;
    const char* abase = uniform_ptr(af.base);
    unsigned aoff[4];
#pragma unroll
    for (int i = 0; i < 4; ++i) { const int R = wid * 8 + i * 64 + (lane >> 3), C = ((lane & 7) ^ ((R >> 1) & 7)) * 8; aoff[i] = (af.rowoff(R) + (unsigned)C) * 2u; }
    const int a_ldsw = wid * 1024;
    const unsigned lds_u = (unsigned)__builtin_amdgcn_readfirstlane((int)(unsigned)(size_t)lds);
    const size_t ldb4 = (size_t)bf.ld * 4;
    const char* bbase = uniform_ptr(bf.base) + (size_t)wid * ldb4;
    const unsigned boff = bf.coloff(4 * lane) * 4u;
    const int b_lds0 = A_TILE_B + wid * B_PITCH + 8 * lane, b_lds1 = A_TILE_B + wid * B_PITCH + ((8 * lane) ^ 128);
    const int a_rd0 = a_img_byte(wr * 128 + fr, fq), a_rd1 = a_rd0 ^ 64;
    const int b_rd = A_TILE_B + (8 * fq + ((lane & 15) >> 2)) * B_PITCH + ((wc ^ (fq & 1)) << 7) + 8 * (lane & 3);
    f32x4 acc[8][4];
#pragma unroll
    for (int m = 0; m < 8; ++m)
#pragma unroll
        for (int n = 0; n < 4; ++n) acc[m][n] = (f32x4){0.f, 0.f, 0.f, 0.f};
    f32x4 sb[8];
#define G_STAGE_A(i, kt, buf) glds16s(abase + (size_t)(kt) * 128, aoff[i], lds_u + (unsigned)((buf) * G_STAGE_B + a_ldsw + (i) * 8192))
#define G_ISSUE_B(i, kt) asm volatile("s_nop 4\n\tglobal_load_dwordx4 %0, %1, %2" : "=v"(sb[i]) : "v"(boff), "s"(bbase + ((size_t)(kt) * 64 + (i) * 8) * ldb4) : "memory")
#define G_WRITE_B(i, buf) do { u32x2 w_ = {pk_bf16(sb[i][0], sb[i][1]), pk_bf16(sb[i][2], sb[i][3])}; \
        *(LAS u32x2*)(lds + (buf) * G_STAGE_B + (((i) & 1) ? b_lds1 : b_lds0) + (i) * 8 * B_PITCH) = w_; } while (0)
#define G_KSTEP(buf, ks) do { bf16x8 At[8], Bf[4]; \
        _Pragma("unroll") for (int n = 0; n < 4; ++n) { const s16x4 lo_ = vtr(lds + (buf) * G_STAGE_B + b_rd + (ks) * 32 * B_PITCH + n * 32), hi_ = vtr(lds + (buf) * G_STAGE_B + b_rd + (ks) * 32 * B_PITCH + 4 * B_PITCH + n * 32); \
            Bf[n] = (bf16x8){lo_[0], lo_[1], lo_[2], lo_[3], hi_[0], hi_[1], hi_[2], hi_[3]}; } \
        _Pragma("unroll") for (int m = 0; m < 8; ++m) At[m] = *(const LAS bf16x8*)(lds + (buf) * G_STAGE_B + ((ks) ? a_rd1 : a_rd0) + m * 2048); \
        SBAR(); __builtin_amdgcn_s_setprio(1); \
        _Pragma("unroll") for (int m = 0; m < 8; ++m) _Pragma("unroll") for (int n = 0; n < 4; ++n) \
            acc[m][n] = __builtin_amdgcn_mfma_f32_16x16x32_bf16(Bf[n], At[m], acc[m][n], 0, 0, 0); \
        __builtin_amdgcn_s_setprio(0); SBAR(); } while (0)
#pragma unroll
    for (int i = 0; i < 4; ++i) G_STAGE_A(i, 0, 0);
#pragma unroll
    for (int i = 0; i < 8; ++i) G_ISSUE_B(i, 0);
    WAIT_V4(0, sb[0], sb[1], sb[2], sb[3]); WAIT_V4(0, sb[4], sb[5], sb[6], sb[7]);
#pragma unroll
    for (int i = 0; i < 8; ++i) G_WRITE_B(i, 0);
    SBAR();
#pragma unroll
    for (int i = 0; i < 8; ++i) G_ISSUE_B(i, 1);
    SBAR();
    RAW_BARRIER();
#pragma unroll 1
    for (int t = 0; t < nt; ++t) {
        const int cur = t & 1, nxt = cur ^ 1;
        if constexpr (MID) { if (t == (nt >> 1)) epi.mid(acc, wr, wc, fr, fq); }
        const int k1 = (t + 1 < nt) ? t + 1 : nt - 1, k2 = (t + 2 < nt) ? t + 2 : nt - 1;
        G_STAGE_A(0, k1, nxt); G_STAGE_A(1, k1, nxt); G_STAGE_A(2, k1, nxt); G_STAGE_A(3, k1, nxt);
        G_KSTEP(cur, 0);
        WAIT_V4(8, sb[0], sb[1], sb[2], sb[3]);
        G_WRITE_B(0, nxt); G_WRITE_B(1, nxt); G_WRITE_B(2, nxt); G_WRITE_B(3, nxt); SBAR();
        G_ISSUE_B(0, k2); G_ISSUE_B(1, k2); G_ISSUE_B(2, k2); G_ISSUE_B(3, k2); SBAR();
        G_KSTEP(cur, 1);
        WAIT_V4(8, sb[4], sb[5], sb[6], sb[7]);
        G_WRITE_B(4, nxt); G_WRITE_B(5, nxt); G_WRITE_B(6, nxt); G_WRITE_B(7, nxt); SBAR();
        G_ISSUE_B(4, k2); G_ISSUE_B(5, k2); G_ISSUE_B(6, k2); G_ISSUE_B(7, k2); SBAR();
        asm volatile("s_waitcnt vmcnt(8)" ::: "memory");
        RAW_BARRIER();
    }
    WAIT_V4(0, sb[0], sb[1], sb[2], sb[3]); WAIT_V4(0, sb[4], sb[5], sb[6], sb[7]);
    epi.fin(acc, wr, wc, fr, fq);
#undef G_STAGE_A
#undef G_ISSUE_B
#undef G_WRITE_B
#undef G_KSTEP
}

constexpr int A8_TILE_B = 16384, B8_PITCH = 288, B8_TILE_B = 64 * B8_PITCH;
constexpr int A8_RING = 5, B8_RING = 4, B8_OFF = A8_RING * A8_TILE_B;
static_assert(B8_OFF + B8_RING * B8_TILE_B <= LDS_MISC, "fp8 rings fit below the misc words");
__device__ __forceinline__ v2i vtr8(const LAS char* p) { return __builtin_amdgcn_ds_read_tr8_b64_v2i32((LAS v2i*)p); }
template <int SCALE_X, class AF, class BF, class EPI>
__device__ __forceinline__ void gemm_unit8(LAS char* lds, LAS unsigned* ring_cnt, const int nt, const AF& af, const BF& bf, EPI& epi) {
    const int tid = threadIdx.x, wid = __builtin_amdgcn_readfirstlane(tid >> 6), lane = tid & 63, wr = wid >> 2, wc = wid & 3, r32 = lane & 31, hi = lane >> 5;
    const char* abase = uniform_ptr(af.base);
    unsigned aoff[2];
#pragma unroll
    for (int i = 0; i < 2; ++i) { const int R = wid * 16 + i * 128 + (lane >> 2), C = ((lane & 3) ^ ((lane >> 4) & 3)) * 16; aoff[i] = af.rowoff(R) + (unsigned)C; }
    const unsigned lds_u = (unsigned)__builtin_amdgcn_readfirstlane((int)(unsigned)(size_t)lds) + (unsigned)(wid * 1024);
    const size_t ldb4 = (size_t)bf.ld * 4;
    const char* bbase = uniform_ptr(bf.base) + (size_t)wid * ldb4;
    const unsigned boff = bf.coloff(4 * lane) * 4u;
    const int b_wr = B8_OFF + wid * B8_PITCH + 4 * lane;
    const int a_rd0 = (wr * 128 + r32) * 64 + (((2 * hi) ^ ((r32 >> 2) & 3)) << 4), a_rd1 = a_rd0 ^ 16;
    const int b_rd = B8_OFF + (32 * hi + ((lane & 15) >> 1)) * B8_PITCH + wc * 64 + 16 * ((lane >> 4) & 1) + 8 * (lane & 1);
    f32x16 acc[4][2];
#pragma unroll
    for (int m = 0; m < 4; ++m)
#pragma unroll
        for (int n = 0; n < 2; ++n)
#pragma unroll
            for (int r = 0; r < 16; ++r) acc[m][n][r] = 0.f;
    f32x4 sb[8];
#define H_STAGE_A(i, kt, slot) glds16s(abase + (size_t)(kt) * 64, aoff[i], lds_u + (unsigned)((slot) * A8_TILE_B + (i) * 8192))
#define H_ISSUE_B(i, kt) asm volatile("s_nop 4\n\tglobal_load_dwordx4 %0, %1, %2" : "=v"(sb[i]) : "v"(boff), "s"(bbase + ((size_t)(kt) * 64 + (i) * 8) * ldb4) : "memory")
#define H_WRITE_B(i, slot) *(LAS unsigned*)(lds + (slot) * B8_TILE_B + b_wr + (i) * 8 * B8_PITCH) = pk4_fp8_x64(sb[i])
#define H_KSTEP(sa, sbk) do { v8i Xf[4], Wf[2]; \
        _Pragma("unroll") for (int n = 0; n < 2; ++n) _Pragma("unroll") for (int r = 0; r < 4; ++r) { const v2i t_ = vtr8(lds + (sbk) * B8_TILE_B + b_rd + r * 8 * B8_PITCH + n * 32); Wf[n][2 * r] = t_[0]; Wf[n][2 * r + 1] = t_[1]; } \
        _Pragma("unroll") for (int m = 0; m < 4; ++m) { const i32x4 lo_ = *(const LAS i32x4*)(lds + (sa) * A8_TILE_B + a_rd0 + m * 2048), hi_ = *(const LAS i32x4*)(lds + (sa) * A8_TILE_B + a_rd1 + m * 2048); \
            Xf[m] = (v8i){lo_[0], lo_[1], lo_[2], lo_[3], hi_[0], hi_[1], hi_[2], hi_[3]}; } \
        SBAR(); __builtin_amdgcn_s_setprio(1); \
        _Pragma("unroll") for (int m = 0; m < 4; ++m) _Pragma("unroll") for (int n = 0; n < 2; ++n) \
            acc[m][n] = __builtin_amdgcn_mfma_scale_f32_32x32x64_f8f6f4(Wf[n], Xf[m], acc[m][n], 0, 0, 0, 0x79797979, 0, SCALE_X); \
        __builtin_amdgcn_s_setprio(0); \
        _Pragma("unroll") for (int m = 0; m < 4; ++m) _Pragma("unroll") for (int n = 0; n < 2; ++n) asm volatile("" : "+v"(acc[m][n])); \
        SBAR(); } while (0)
    if (tid < 8) ring_cnt[tid] = 0u;
    H_STAGE_A(0, 0, 0); H_STAGE_A(1, 0, 0); H_STAGE_A(0, 1, 1); H_STAGE_A(1, 1, 1);
#pragma unroll
    for (int i = 0; i < 8; ++i) H_ISSUE_B(i, 0);
    WAIT_V4(0, sb[0], sb[1], sb[2], sb[3]); WAIT_V4(0, sb[4], sb[5], sb[6], sb[7]);
#pragma unroll
    for (int i = 0; i < 8; ++i) H_WRITE_B(i, 0);
    SBAR();
#pragma unroll
    for (int i = 0; i < 8; ++i) H_ISSUE_B(i, 1);
    WAIT_V4(0, sb[0], sb[1], sb[2], sb[3]); WAIT_V4(0, sb[4], sb[5], sb[6], sb[7]);
#pragma unroll
    for (int i = 0; i < 8; ++i) H_WRITE_B(i, 1);
    SBAR();
    H_STAGE_A(0, 2, 2); H_STAGE_A(1, 2, 2);
#pragma unroll
    for (int i = 0; i < 8; ++i) H_ISSUE_B(i, 2);
    SBAR();
    RAW_BARRIER();
    int sa_r = 0, sa_w = 3, sb_r = 0, sb_w = 2;
#pragma unroll 1
    for (int t = 0; t < nt; ++t) {
        if (t >= 2) {
            const unsigned need = (unsigned)(t - 1);
            for (;;) { asm volatile("" ::: "memory"); const unsigned v = *(volatile LAS unsigned*)(ring_cnt + (lane & 7)); if (__all(v >= need)) break; __builtin_amdgcn_s_sleep(1); }
            asm volatile("" ::: "memory");
        }
        const int k3 = (t + 3 < nt) ? t + 3 : nt - 1;
        H_STAGE_A(0, k3, sa_w); H_STAGE_A(1, k3, sa_w);
        H_KSTEP(sa_r, sb_r);
        WAIT_V4(6, sb[0], sb[1], sb[2], sb[3]);
        H_WRITE_B(0, sb_w); H_WRITE_B(1, sb_w); H_WRITE_B(2, sb_w); H_WRITE_B(3, sb_w); SBAR();
        H_ISSUE_B(0, k3); H_ISSUE_B(1, k3); H_ISSUE_B(2, k3); H_ISSUE_B(3, k3); SBAR();
        WAIT_V4(6, sb[4], sb[5], sb[6], sb[7]);
        H_WRITE_B(4, sb_w); H_WRITE_B(5, sb_w); H_WRITE_B(6, sb_w); H_WRITE_B(7, sb_w); SBAR();
        H_ISSUE_B(4, k3); H_ISSUE_B(5, k3); H_ISSUE_B(6, k3); H_ISSUE_B(7, k3); SBAR();
        asm volatile("" ::: "memory");
        if (lane == 0) *(volatile LAS unsigned*)(ring_cnt + wid) = (unsigned)(t + 1);
        asm volatile("" ::: "memory");
        sa_r = (sa_r == A8_RING - 1) ? 0 : sa_r + 1; sa_w = (sa_w == A8_RING - 1) ? 0 : sa_w + 1;
        sb_r = (sb_r == B8_RING - 1) ? 0 : sb_r + 1; sb_w = (sb_w == B8_RING - 1) ? 0 : sb_w + 1;
    }
    WAIT_V4(0, sb[0], sb[1], sb[2], sb[3]); WAIT_V4(0, sb[4], sb[5], sb[6], sb[7]);
    RAW_BARRIER();
    epi.fin(acc, wr, wc, r32, hi);
#undef H_STAGE_A
#undef H_ISSUE_B
#undef H_WRITE_B
#undef H_KSTEP
}

template <int SCALE_X, class AF, class BF, class EPI>
__device__ __forceinline__ void gemm_unit8h(LAS char* lds, LAS unsigned* ring_cnt, const int nt, const AF& af, const BF& bf, EPI& epi) {
    const int tid = threadIdx.x, wid = __builtin_amdgcn_readfirstlane(tid >> 6), lane = tid & 63, wr = wid >> 2, wc = wid & 3, r32 = lane & 31, hi = lane >> 5;
    const char* abase = uniform_ptr(af.base);
    unsigned aoff[2];
#pragma unroll
    for (int i = 0; i < 2; ++i) { const int R = wid * 16 + i * 128 + (lane >> 2), C = ((lane & 3) ^ ((lane >> 4) & 3)) * 16; aoff[i] = af.rowoff(R) + (unsigned)C; }
    const unsigned lds_u = (unsigned)__builtin_amdgcn_readfirstlane((int)(unsigned)(size_t)lds) + (unsigned)(wid * 1024);
    const size_t ldb4 = (size_t)bf.ld * 4;
    const char* bbase = uniform_ptr(bf.base) + (size_t)wid * ldb4;
    const unsigned boff = (unsigned)(lane >> 5) * 8u * (unsigned)ldb4 + bf.coloff(4 * (lane & 31)) * 4u;
    const int b_wr = B8_OFF + (wid + 8 * (lane >> 5)) * B8_PITCH + 4 * (lane & 31);
    const int a_rd0 = (wr * 128 + r32) * 64 + (((2 * hi) ^ ((r32 >> 2) & 3)) << 4), a_rd1 = a_rd0 ^ 16;
    const int b_rd = B8_OFF + (32 * hi + ((lane & 15) >> 1)) * B8_PITCH + wc * 32 + 16 * ((lane >> 4) & 1) + 8 * (lane & 1);
    f32x16 acc[4][1];
#pragma unroll
    for (int m = 0; m < 4; ++m)
#pragma unroll
        for (int n = 0; n < 1; ++n)
#pragma unroll
            for (int r = 0; r < 16; ++r) acc[m][n][r] = 0.f;
    f32x4 sb[4];
#define H_STAGE_A(i, kt, slot) glds16s(abase + (size_t)(kt) * 64, aoff[i], lds_u + (unsigned)((slot) * A8_TILE_B + (i) * 8192))
#define H_ISSUE_B(i, kt) asm volatile("s_nop 4\n\tglobal_load_dwordx4 %0, %1, %2" : "=v"(sb[i]) : "v"(boff), "s"(bbase + ((size_t)(kt) * 64 + (i) * 16) * ldb4) : "memory")
#define H_WRITE_B(i, slot) *(LAS unsigned*)(lds + (slot) * B8_TILE_B + b_wr + (i) * 16 * B8_PITCH) = pk4_fp8_x64(sb[i])
#define H_KSTEP(sa, sbk) do { v8i Xf[4], Wf[1]; \
        _Pragma("unroll") for (int n = 0; n < 1; ++n) _Pragma("unroll") for (int r = 0; r < 4; ++r) { const v2i t_ = vtr8(lds + (sbk) * B8_TILE_B + b_rd + r * 8 * B8_PITCH + n * 32); Wf[n][2 * r] = t_[0]; Wf[n][2 * r + 1] = t_[1]; } \
        _Pragma("unroll") for (int m = 0; m < 4; ++m) { const i32x4 lo_ = *(const LAS i32x4*)(lds + (sa) * A8_TILE_B + a_rd0 + m * 2048), hi_ = *(const LAS i32x4*)(lds + (sa) * A8_TILE_B + a_rd1 + m * 2048); \
            Xf[m] = (v8i){lo_[0], lo_[1], lo_[2], lo_[3], hi_[0], hi_[1], hi_[2], hi_[3]}; } \
        SBAR(); __builtin_amdgcn_s_setprio(1); \
        _Pragma("unroll") for (int m = 0; m < 4; ++m) _Pragma("unroll") for (int n = 0; n < 1; ++n) \
            acc[m][n] = __builtin_amdgcn_mfma_scale_f32_32x32x64_f8f6f4(Wf[n], Xf[m], acc[m][n], 0, 0, 0, 0x79797979, 0, SCALE_X); \
        __builtin_amdgcn_s_setprio(0); SBAR(); } while (0)
    if (tid < 8) ring_cnt[tid] = 0u;
    H_STAGE_A(0, 0, 0); H_STAGE_A(1, 0, 0); H_STAGE_A(0, 1, 1); H_STAGE_A(1, 1, 1);
#pragma unroll
    for (int i = 0; i < 4; ++i) H_ISSUE_B(i, 0);
    WAIT_V4(0, sb[0], sb[1], sb[2], sb[3]);
#pragma unroll
    for (int i = 0; i < 4; ++i) H_WRITE_B(i, 0);
    SBAR();
#pragma unroll
    for (int i = 0; i < 4; ++i) H_ISSUE_B(i, 1);
    WAIT_V4(0, sb[0], sb[1], sb[2], sb[3]);
#pragma unroll
    for (int i = 0; i < 4; ++i) H_WRITE_B(i, 1);
    SBAR();
    H_STAGE_A(0, 2, 2); H_STAGE_A(1, 2, 2);
#pragma unroll
    for (int i = 0; i < 4; ++i) H_ISSUE_B(i, 2);
    SBAR();
    RAW_BARRIER();
    int sa_r = 0, sa_w = 3, sb_r = 0, sb_w = 2;
#pragma unroll 1
    for (int t = 0; t < nt; ++t) {
        if (t >= 2) {
            const unsigned need = (unsigned)(t - 1);
            for (;;) { asm volatile("" ::: "memory"); const unsigned v = *(volatile LAS unsigned*)(ring_cnt + (lane & 7)); if (__all(v >= need)) break; __builtin_amdgcn_s_sleep(1); }
            asm volatile("" ::: "memory");
        }
        const int k3 = (t + 3 < nt) ? t + 3 : nt - 1;
        H_STAGE_A(0, k3, sa_w); H_STAGE_A(1, k3, sa_w);
        H_KSTEP(sa_r, sb_r);
        WAIT_V4(2, sb[0], sb[1], sb[2], sb[3]);
        H_WRITE_B(0, sb_w); H_WRITE_B(1, sb_w); H_WRITE_B(2, sb_w); H_WRITE_B(3, sb_w); SBAR();
        H_ISSUE_B(0, k3); H_ISSUE_B(1, k3); H_ISSUE_B(2, k3); H_ISSUE_B(3, k3); SBAR();
        asm volatile("" ::: "memory");
        if (lane == 0) *(volatile LAS unsigned*)(ring_cnt + wid) = (unsigned)(t + 1);
        asm volatile("" ::: "memory");
        sa_r = (sa_r == A8_RING - 1) ? 0 : sa_r + 1; sa_w = (sa_w == A8_RING - 1) ? 0 : sa_w + 1;
        sb_r = (sb_r == B8_RING - 1) ? 0 : sb_r + 1; sb_w = (sb_w == B8_RING - 1) ? 0 : sb_w + 1;
    }
    WAIT_V4(0, sb[0], sb[1], sb[2], sb[3]);
    RAW_BARRIER();
    epi.fin(acc, wr, wc, r32, hi);
#undef H_STAGE_A
#undef H_ISSUE_B
#undef H_WRITE_B
#undef H_KSTEP
}

template <int SCALE_X, class AF, class BF, class EPI>
__device__ __forceinline__ void gemm_unit8q(LAS char* lds, LAS unsigned* ring_cnt, const int nt, const AF& af, const BF& bf, EPI& epi) {
    const int tid = threadIdx.x, wid = __builtin_amdgcn_readfirstlane(tid >> 6), lane = tid & 63, wr = wid >> 1, wc = wid & 1, r32 = lane & 31, hi = lane >> 5;
    const char* abase = uniform_ptr(af.base);
    unsigned aoff[2];
#pragma unroll
    for (int i = 0; i < 2; ++i) { const int R = wid * 16 + i * 128 + (lane >> 2), C = ((lane & 3) ^ ((lane >> 4) & 3)) * 16; aoff[i] = af.rowoff(R) + (unsigned)C; }
    const unsigned lds_u = (unsigned)__builtin_amdgcn_readfirstlane((int)(unsigned)(size_t)lds) + (unsigned)(wid * 1024);
    const size_t ldb4 = (size_t)bf.ld * 4;
    const char* bbase = uniform_ptr(bf.base) + (size_t)wid * ldb4;
    const unsigned boff = (unsigned)(lane >> 5) * 8u * (unsigned)ldb4 + bf.coloff(4 * (lane & 31)) * 4u;
    const int b_wr = B8_OFF + (wid + 8 * (lane >> 5)) * B8_PITCH + 4 * (lane & 31);
    const int a_rd0 = (wr * 64 + r32) * 64 + (((2 * hi) ^ ((r32 >> 2) & 3)) << 4), a_rd1 = a_rd0 ^ 16;
    const int b_rd = B8_OFF + (32 * hi + ((lane & 15) >> 1)) * B8_PITCH + wc * 64 + 16 * ((lane >> 4) & 1) + 8 * (lane & 1);
    f32x16 acc[2][2];
#pragma unroll
    for (int m = 0; m < 2; ++m)
#pragma unroll
        for (int n = 0; n < 2; ++n)
#pragma unroll
            for (int r = 0; r < 16; ++r) acc[m][n][r] = 0.f;
    f32x4 sb[4];
#define H_STAGE_A(i, kt, slot) glds16s(abase + (size_t)(kt) * 64, aoff[i], lds_u + (unsigned)((slot) * A8_TILE_B + (i) * 8192))
#define H_ISSUE_B(i, kt) asm volatile("s_nop 4\n\tglobal_load_dwordx4 %0, %1, %2" : "=v"(sb[i]) : "v"(boff), "s"(bbase + ((size_t)(kt) * 64 + (i) * 16) * ldb4) : "memory")
#define H_WRITE_B(i, slot) *(LAS unsigned*)(lds + (slot) * B8_TILE_B + b_wr + (i) * 16 * B8_PITCH) = pk4_fp8_x64(sb[i])
#define H_KSTEP(sa, sbk) do { v8i Xf[2], Wf[2]; \
        _Pragma("unroll") for (int n = 0; n < 2; ++n) _Pragma("unroll") for (int r = 0; r < 4; ++r) { const v2i t_ = vtr8(lds + (sbk) * B8_TILE_B + b_rd + r * 8 * B8_PITCH + n * 32); Wf[n][2 * r] = t_[0]; Wf[n][2 * r + 1] = t_[1]; } \
        _Pragma("unroll") for (int m = 0; m < 2; ++m) { const i32x4 lo_ = *(const LAS i32x4*)(lds + (sa) * A8_TILE_B + a_rd0 + m * 2048), hi_ = *(const LAS i32x4*)(lds + (sa) * A8_TILE_B + a_rd1 + m * 2048); \
            Xf[m] = (v8i){lo_[0], lo_[1], lo_[2], lo_[3], hi_[0], hi_[1], hi_[2], hi_[3]}; } \
        SBAR(); __builtin_amdgcn_s_setprio(1); \
        _Pragma("unroll") for (int m = 0; m < 2; ++m) _Pragma("unroll") for (int n = 0; n < 2; ++n) \
            acc[m][n] = __builtin_amdgcn_mfma_scale_f32_32x32x64_f8f6f4(Wf[n], Xf[m], acc[m][n], 0, 0, 0, 0x79797979, 0, SCALE_X); \
        __builtin_amdgcn_s_setprio(0); SBAR(); } while (0)
    if (tid < 8) ring_cnt[tid] = 0u;
    H_STAGE_A(0, 0, 0); H_STAGE_A(1, 0, 0); H_STAGE_A(0, 1, 1); H_STAGE_A(1, 1, 1);
#pragma unroll
    for (int i = 0; i < 4; ++i) H_ISSUE_B(i, 0);
    WAIT_V4(0, sb[0], sb[1], sb[2], sb[3]);
#pragma unroll
    for (int i = 0; i < 4; ++i) H_WRITE_B(i, 0);
    SBAR();
#pragma unroll
    for (int i = 0; i < 4; ++i) H_ISSUE_B(i, 1);
    WAIT_V4(0, sb[0], sb[1], sb[2], sb[3]);
#pragma unroll
    for (int i = 0; i < 4; ++i) H_WRITE_B(i, 1);
    SBAR();
    H_STAGE_A(0, 2, 2); H_STAGE_A(1, 2, 2);
#pragma unroll
    for (int i = 0; i < 4; ++i) H_ISSUE_B(i, 2);
    SBAR();
    RAW_BARRIER();
    int sa_r = 0, sa_w = 3, sb_r = 0, sb_w = 2;
#pragma unroll 1
    for (int t = 0; t < nt; ++t) {
        if (t >= 2) {
            const unsigned need = (unsigned)(t - 1);
            for (;;) { asm volatile("" ::: "memory"); const unsigned v = *(volatile LAS unsigned*)(ring_cnt + (lane & 7)); if (__all(v >= need)) break; __builtin_amdgcn_s_sleep(1); }
            asm volatile("" ::: "memory");
        }
        const int k3 = (t + 3 < nt) ? t + 3 : nt - 1;
        H_STAGE_A(0, k3, sa_w); H_STAGE_A(1, k3, sa_w);
        H_KSTEP(sa_r, sb_r);
        WAIT_V4(2, sb[0], sb[1], sb[2], sb[3]);
        H_WRITE_B(0, sb_w); H_WRITE_B(1, sb_w); H_WRITE_B(2, sb_w); H_WRITE_B(3, sb_w); SBAR();
        H_ISSUE_B(0, k3); H_ISSUE_B(1, k3); H_ISSUE_B(2, k3); H_ISSUE_B(3, k3); SBAR();
        asm volatile("" ::: "memory");
        if (lane == 0) *(volatile LAS unsigned*)(ring_cnt + wid) = (unsigned)(t + 1);
        asm volatile("" ::: "memory");
        sa_r = (sa_r == A8_RING - 1) ? 0 : sa_r + 1; sa_w = (sa_w == A8_RING - 1) ? 0 : sa_w + 1;
        sb_r = (sb_r == B8_RING - 1) ? 0 : sb_r + 1; sb_w = (sb_w == B8_RING - 1) ? 0 : sb_w + 1;
    }
    WAIT_V4(0, sb[0], sb[1], sb[2], sb[3]);
    RAW_BARRIER();
    epi.fin(acc, wr, wc, r32, hi);
#undef H_STAGE_A
#undef H_ISSUE_B
#undef H_WRITE_B
#undef H_KSTEP
}

constexpr int C8_B_TILE = 16384, C8_B_OFF = A8_RING * A8_TILE_B;
template <int SCALE_X, class AF, class EPI>
__device__ __forceinline__ void gemm_unit8b(LAS char* lds, LAS unsigned* ring_cnt, const int nt, const AF& af, const unsigned char* img, EPI& epi) {
    const int tid = threadIdx.x, wid = __builtin_amdgcn_readfirstlane(tid >> 6), lane = tid & 63, wr = wid >> 2, wc = wid & 3, r32 = lane & 31, hi = lane >> 5;
    const char* abase = uniform_ptr(af.base);
    unsigned aoff[2];
#pragma unroll
    for (int i = 0; i < 2; ++i) { const int R = wid * 16 + i * 128 + (lane >> 2), C = ((lane & 3) ^ ((lane >> 4) & 3)) * 16; aoff[i] = af.rowoff(R) + (unsigned)C; }
    const unsigned lds_u = (unsigned)__builtin_amdgcn_readfirstlane((int)(unsigned)(size_t)lds) + (unsigned)(wid * 1024);
    const char* ibase = uniform_ptr(img);
    const unsigned ioff = (unsigned)(wid * 1024 + lane * 16);
    const int b_wr = C8_B_OFF + wid * 1024 + lane * 16;
    const int a_rd0 = (wr * 128 + r32) * 64 + (((2 * hi) ^ ((r32 >> 2) & 3)) << 4), a_rd1 = a_rd0 ^ 16;
    const int q8 = (lane & 15) >> 1;
    const int b_rd0 = C8_B_OFF + (32 * hi + q8) * 256 + ((wc * 64 + 16 * ((lane >> 4) & 1) + 8 * (lane & 1)) ^ (q8 << 5)), b_rd1 = b_rd0 ^ 32;
    i32x4 sv[2];
#define C_STAGE_A(i, kt, slot) glds16s(abase + (size_t)(kt) * 64, aoff[i], lds_u + (unsigned)((slot) * A8_TILE_B + (i) * 8192))
#define C_ISSUE_B(i, kt) asm volatile("s_nop 4\n\tglobal_load_dwordx4 %0, %1, %2" : "=v"(sv[i]) : "v"(ioff), "s"(ibase + (size_t)(kt) * 16384 + (i) * 8192) : "memory")
#define C_WRITE_B(i, slot) *(LAS i32x4*)(lds + (slot) * C8_B_TILE + b_wr + (i) * 8192) = sv[i]
#define C_WAIT(n) asm volatile("s_waitcnt vmcnt(" #n ")" : "+v"(sv[0]), "+v"(sv[1]) :: "memory")
    if (tid < 8) ring_cnt[tid] = 0u;
    C_STAGE_A(0, 0, 0); C_STAGE_A(1, 0, 0); C_STAGE_A(0, 1, 1); C_STAGE_A(1, 1, 1);
    C_ISSUE_B(0, 0); C_ISSUE_B(1, 0); C_WAIT(0); C_WRITE_B(0, 0); C_WRITE_B(1, 0); SBAR();
    C_ISSUE_B(0, 1); C_ISSUE_B(1, 1); C_WAIT(0); C_WRITE_B(0, 1); C_WRITE_B(1, 1); SBAR();
    C_STAGE_A(0, 2, 2); C_STAGE_A(1, 2, 2);
    C_ISSUE_B(0, 2); C_ISSUE_B(1, 2);
    SBAR();
    f32x16 acc[4][2];
#pragma unroll
    for (int m = 0; m < 4; ++m)
#pragma unroll
        for (int n = 0; n < 2; ++n)
#pragma unroll
            for (int r = 0; r < 16; ++r) acc[m][n][r] = 0.f;
    RAW_BARRIER();
    int sa_r = 0, sa_w = 3, sb_r = 0, sb_w = 2;
#pragma unroll 1
    for (int t = 0; t < nt; ++t) {
        if (t >= 2) { const unsigned need = (unsigned)(t - 1);
            for (;;) { asm volatile("" ::: "memory"); const unsigned v = *(volatile LAS unsigned*)(ring_cnt + (lane & 7)); if (__all(v >= need)) break; __builtin_amdgcn_s_sleep(1); }
            asm volatile("" ::: "memory"); }
        const int k3 = (t + 3 < nt) ? t + 3 : nt - 1;
        C_STAGE_A(0, k3, sa_w); C_STAGE_A(1, k3, sa_w);
        { v8i Xf[4], Wf[2];
#pragma unroll
          for (int r = 0; r < 4; ++r) { const v2i t0_ = vtr8(lds + sb_r * C8_B_TILE + b_rd0 + r * 2048), t1_ = vtr8(lds + sb_r * C8_B_TILE + b_rd1 + r * 2048); Wf[0][2 * r] = t0_[0]; Wf[0][2 * r + 1] = t0_[1]; Wf[1][2 * r] = t1_[0]; Wf[1][2 * r + 1] = t1_[1]; }
#pragma unroll
          for (int m = 0; m < 4; ++m) { const i32x4 lo_ = *(const LAS i32x4*)(lds + sa_r * A8_TILE_B + a_rd0 + m * 2048), hi_ = *(const LAS i32x4*)(lds + sa_r * A8_TILE_B + a_rd1 + m * 2048);
              Xf[m] = (v8i){lo_[0], lo_[1], lo_[2], lo_[3], hi_[0], hi_[1], hi_[2], hi_[3]}; }
          SBAR(); __builtin_amdgcn_s_setprio(1);
#pragma unroll
          for (int m = 0; m < 4; ++m)
#pragma unroll
              for (int n = 0; n < 2; ++n) acc[m][n] = __builtin_amdgcn_mfma_scale_f32_32x32x64_f8f6f4(Wf[n], Xf[m], acc[m][n], 0, 0, 0, 0x79797979, 0, SCALE_X);
          __builtin_amdgcn_s_setprio(0); SBAR(); }
        C_WAIT(2);
        C_WRITE_B(0, sb_w); C_WRITE_B(1, sb_w); SBAR();
        C_ISSUE_B(0, k3); C_ISSUE_B(1, k3); SBAR();
        asm volatile("" ::: "memory");
        if (lane == 0) *(volatile LAS unsigned*)(ring_cnt + wid) = (unsigned)(t + 1);
        asm volatile("" ::: "memory");
        sa_r = (sa_r == A8_RING - 1) ? 0 : sa_r + 1; sa_w = (sa_w == A8_RING - 1) ? 0 : sa_w + 1;
        sb_r = (sb_r == B8_RING - 1) ? 0 : sb_r + 1; sb_w = (sb_w == B8_RING - 1) ? 0 : sb_w + 1;
    }
    C_WAIT(0);
    RAW_BARRIER();
    epi.fin(acc, wr, wc, r32, hi);
#undef C_STAGE_A
#undef C_ISSUE_B
#undef C_WRITE_B
#undef C_WAIT
}
template <int SCALE_X, class AF, class EPI>
__device__ __forceinline__ void gemm_unit8bh(LAS char* lds, LAS unsigned* ring_cnt, const int nt, const AF& af, const unsigned char* img, const int hf, EPI& epi) {
    const int tid = threadIdx.x, wid = __builtin_amdgcn_readfirstlane(tid >> 6), lane = tid & 63, wr = wid >> 2, wc = wid & 3, r32 = lane & 31, hi = lane >> 5;
    const char* abase = uniform_ptr(af.base);
    unsigned aoff[2];
#pragma unroll
    for (int i = 0; i < 2; ++i) { const int R = wid * 16 + i * 128 + (lane >> 2), C = ((lane & 3) ^ ((lane >> 4) & 3)) * 16; aoff[i] = af.rowoff(R) + (unsigned)C; }
    const unsigned lds_u = (unsigned)__builtin_amdgcn_readfirstlane((int)(unsigned)(size_t)lds) + (unsigned)(wid * 1024);
    const char* ibase = uniform_ptr(img);
    const unsigned ioff = (unsigned)(wid * 1024 + lane * 16);
    const int b_wr = C8_B_OFF + wid * 1024 + lane * 16;
    const int a_rd0 = (wr * 128 + r32) * 64 + (((2 * hi) ^ ((r32 >> 2) & 3)) << 4), a_rd1 = a_rd0 ^ 16;
    const int q8 = (lane & 15) >> 1;
    const int b_rd0 = C8_B_OFF + (32 * hi + q8) * 256 + ((hf * 128 + wc * 32 + 16 * ((lane >> 4) & 1) + 8 * (lane & 1)) ^ (q8 << 5));
    i32x4 sv[2];
#define C_STAGE_A(i, kt, slot) glds16s(abase + (size_t)(kt) * 64, aoff[i], lds_u + (unsigned)((slot) * A8_TILE_B + (i) * 8192))
#define C_ISSUE_B(i, kt) asm volatile("s_nop 4\n\tglobal_load_dwordx4 %0, %1, %2" : "=v"(sv[i]) : "v"(ioff), "s"(ibase + (size_t)(kt) * 16384 + (i) * 8192) : "memory")
#define C_WRITE_B(i, slot) *(LAS i32x4*)(lds + (slot) * C8_B_TILE + b_wr + (i) * 8192) = sv[i]
#define C_WAIT(n) asm volatile("s_waitcnt vmcnt(" #n ")" : "+v"(sv[0]), "+v"(sv[1]) :: "memory")
    if (tid < 8) ring_cnt[tid] = 0u;
    C_STAGE_A(0, 0, 0); C_STAGE_A(1, 0, 0); C_STAGE_A(0, 1, 1); C_STAGE_A(1, 1, 1);
    C_ISSUE_B(0, 0); C_ISSUE_B(1, 0); C_WAIT(0); C_WRITE_B(0, 0); C_WRITE_B(1, 0); SBAR();
    C_ISSUE_B(0, 1); C_ISSUE_B(1, 1); C_WAIT(0); C_WRITE_B(0, 1); C_WRITE_B(1, 1); SBAR();
    C_STAGE_A(0, 2, 2); C_STAGE_A(1, 2, 2);
    C_ISSUE_B(0, 2); C_ISSUE_B(1, 2);
    SBAR();
    f32x16 acc[4][1];
#pragma unroll
    for (int m = 0; m < 4; ++m)
#pragma unroll
        for (int n = 0; n < 1; ++n)
#pragma unroll
            for (int r = 0; r < 16; ++r) acc[m][n][r] = 0.f;
    RAW_BARRIER();
    int sa_r = 0, sa_w = 3, sb_r = 0, sb_w = 2;
#pragma unroll 1
    for (int t = 0; t < nt; ++t) {
        if (t >= 2) { const unsigned need = (unsigned)(t - 1);
            for (;;) { asm volatile("" ::: "memory"); const unsigned v = *(volatile LAS unsigned*)(ring_cnt + (lane & 7)); if (__all(v >= need)) break; __builtin_amdgcn_s_sleep(1); }
            asm volatile("" ::: "memory"); }
        const int k3 = (t + 3 < nt) ? t + 3 : nt - 1;
        C_STAGE_A(0, k3, sa_w); C_STAGE_A(1, k3, sa_w);
        { v8i Xf[4], Wf[1];
#pragma unroll
          for (int r = 0; r < 4; ++r) { const v2i t0_ = vtr8(lds + sb_r * C8_B_TILE + b_rd0 + r * 2048); Wf[0][2 * r] = t0_[0]; Wf[0][2 * r + 1] = t0_[1]; }
#pragma unroll
          for (int m = 0; m < 4; ++m) { const i32x4 lo_ = *(const LAS i32x4*)(lds + sa_r * A8_TILE_B + a_rd0 + m * 2048), hi_ = *(const LAS i32x4*)(lds + sa_r * A8_TILE_B + a_rd1 + m * 2048);
              Xf[m] = (v8i){lo_[0], lo_[1], lo_[2], lo_[3], hi_[0], hi_[1], hi_[2], hi_[3]}; }
          SBAR(); __builtin_amdgcn_s_setprio(1);
#pragma unroll
          for (int m = 0; m < 4; ++m)
#pragma unroll
              for (int n = 0; n < 1; ++n) acc[m][n] = __builtin_amdgcn_mfma_scale_f32_32x32x64_f8f6f4(Wf[n], Xf[m], acc[m][n], 0, 0, 0, 0x79797979, 0, SCALE_X);
          __builtin_amdgcn_s_setprio(0); SBAR(); }
        C_WAIT(2);
        C_WRITE_B(0, sb_w); C_WRITE_B(1, sb_w); SBAR();
        C_ISSUE_B(0, k3); C_ISSUE_B(1, k3); SBAR();
        asm volatile("" ::: "memory");
        if (lane == 0) *(volatile LAS unsigned*)(ring_cnt + wid) = (unsigned)(t + 1);
        asm volatile("" ::: "memory");
        sa_r = (sa_r == A8_RING - 1) ? 0 : sa_r + 1; sa_w = (sa_w == A8_RING - 1) ? 0 : sa_w + 1;
        sb_r = (sb_r == B8_RING - 1) ? 0 : sb_r + 1; sb_w = (sb_w == B8_RING - 1) ? 0 : sb_w + 1;
    }
    C_WAIT(0);
    RAW_BARRIER();
    epi.fin(acc, wr, wc, r32, hi);
#undef C_STAGE_A
#undef C_ISSUE_B
#undef C_WRITE_B
#undef C_WAIT
}

__device__ __forceinline__ void conv_image(const float* W, size_t ld, unsigned char* img, int t0, int t1) {
    const int tid = threadIdx.x, wid = tid >> 6, lane = tid & 63;
    const float* wp = W + (size_t)wid * ld + 4 * lane;
    unsigned char* ip = img + wid * 256 + ((4 * lane) ^ (wid << 5));
    for (int t = t0; t < t1; t += 4) { f32x4 v[4][8];
#pragma unroll
        for (int u = 0; u < 4; ++u)
#pragma unroll
            for (int i = 0; i < 8; ++i) v[u][i] = *(const f32x4*)(wp + ((size_t)(t + u) * 64 + i * 8) * ld);
#pragma unroll
        for (int u = 0; u < 4; ++u)
#pragma unroll
            for (int i = 0; i < 8; ++i) *(unsigned*)(ip + (size_t)(t + u) * 16384 + i * 2048) = pk4_fp8_x64(v[u][i]); }
}

struct Params {
    const float *x, *attn_norm, *w_in, *a_sink, *b_q_norm, *b_w_uq, *b_kv_norm, *b_w_ukv, *out_norm_a, *out_norm_b, *w_o, *mlp_norm, *w_router, *b_router,
        *w_up, *b_up, *w_down, *b_down, *final_norm;
    float* out; unsigned char* ws; int ph_lo, ph_hi;
};

struct ARows { const bf16_t* base; unsigned ld; __device__ __forceinline__ unsigned rowoff(int r) const { return (unsigned)r * ld; } };
struct AGather { const bf16_t* base; const int* tokl; int r0, cnt; __device__ __forceinline__ unsigned rowoff(int r) const { int rk = r0 + r; rk = rk < cnt ? rk : 0; return (unsigned)tokl[rk] * (unsigned)D_MODEL; } };
struct ARows8 { const unsigned char* base; unsigned ld; __device__ __forceinline__ unsigned rowoff(int r) const { return (unsigned)r * ld; } };
struct AGather8 { const unsigned char* base; const int* tokl; int r0, cnt; __device__ __forceinline__ unsigned rowoff(int r) const { int rk = r0 + r; rk = rk < cnt ? rk : 0; return (unsigned)tokl[rk] * (unsigned)D_MODEL; } };
struct BPlain { const float* base; size_t ld; int ncols;
    __device__ __forceinline__ unsigned coloff(int c) const { return (unsigned)(c < ncols ? c : (c & (ncols - 1))); } };
struct BGateUp { const float* base; size_t ld;
    __device__ __forceinline__ unsigned coloff(int c) const { const int wc = c >> 6, w = c & 63; return (unsigned)(wc * 32 + (w & 31) + ((w & 32) ? D_FF : 0)); } };

struct EpiProj {
    int pn, brow; unsigned char* ws; const float *qg, *kvg;
    __device__ __forceinline__ void mid(f32x4 (&)[8][4], int, int, int, int) {}
    __device__ __forceinline__ void fin(f32x4 (&acc)[8][4], int wr, int wc, int fr, int fq) {
        if (pn < 6) {
            bf16_t* dst; int ldd, c0;
            if (pn < 4) { dst = (bf16_t*)(ws + WS_QA); ldd = 1024; c0 = pn * 256; } else if (pn == 4) { dst = (bf16_t*)(ws + WS_KA); ldd = 256; c0 = 0; } else { dst = (bf16_t*)(ws + WS_VA); ldd = 256; c0 = 0; }
#pragma unroll
            for (int m = 0; m < 8; ++m) { const int row = brow + wr * 128 + m * 16 + fr;
#pragma unroll
                for (int n = 0; n < 4; ++n) { const int col = c0 + wc * 64 + n * 16 + fq * 4; const f32x4 v = acc[m][n];
                    *(u32x2*)(dst + (size_t)row * ldd + col) = (u32x2){pk_bf16(v[0], v[1]), pk_bf16(v[2], v[3])}; } }
        } else if (pn < 9) {
            bf16_t* dst; int ldd, c0; const float* g; float* ssq; int nsl, sl;
            if (pn < 8) { dst = (bf16_t*)(ws + WS_CQ); ldd = 512; c0 = (pn - 6) * 256; g = qg; ssq = (float*)(ws + WS_SSQC); nsl = 8; sl = (pn - 6) * 4 + wc; }
            else { dst = (bf16_t*)(ws + WS_CKV); ldd = 256; c0 = 0; g = kvg; ssq = (float*)(ws + WS_SSQK); nsl = 4; sl = wc; }
            f32x4 gvv[4];
#pragma unroll
            for (int n = 0; n < 4; ++n) gvv[n] = *(const f32x4*)(g + c0 + wc * 64 + n * 16 + fq * 4);
#pragma unroll
            for (int m = 0; m < 8; ++m) { const int row = brow + wr * 128 + m * 16 + fr; float ss = 0.f;
#pragma unroll
                for (int n = 0; n < 4; ++n) { const int col = c0 + wc * 64 + n * 16 + fq * 4; const f32x4 v = acc[m][n]; const f32x4 gv = gvv[n];
                    ss += v[0] * v[0] + v[1] * v[1] + v[2] * v[2] + v[3] * v[3];
                    *(u32x2*)(dst + (size_t)row * ldd + col) = (u32x2){pk_bf16(v[0] * gv[0], v[1] * gv[1]), pk_bf16(v[2] * gv[2], v[3] * gv[3])}; }
                ss += __shfl_xor(ss, 16, 64); ss += __shfl_xor(ss, 32, 64);
                if (fq == 0) ssq[(size_t)row * nsl + sl] = ss; }
        } else {
            if (wc == 0) {
                bf16_t* dst = (bf16_t*)(ws + WS_KPE); const float* rope = (const float*)(ws + WS_ROPE);
#pragma unroll
                for (int m = 0; m < 8; ++m) { const int row = brow + wr * 128 + m * 16 + fr; const int pos = row & (SEQ - 1);
#pragma unroll
                    for (int n = 0; n < 2; ++n) { const int i0 = n * 16 + fq * 4; const f32x4 x1 = acc[m][n], x2 = acc[m][n + 2];
                        const f32x4 cs0 = *(const f32x4*)(rope + ((size_t)pos * 32 + i0) * 2), cs1 = *(const f32x4*)(rope + ((size_t)pos * 32 + i0) * 2 + 4);
                        const float c[4] = {cs0[0], cs0[2], cs1[0], cs1[2]}, s[4] = {cs0[1], cs0[3], cs1[1], cs1[3]};
                        float o1[4], o2[4];
#pragma unroll
                        for (int j = 0; j < 4; ++j) { o1[j] = x1[j] * c[j] - x2[j] * s[j]; o2[j] = x1[j] * s[j] + x2[j] * c[j]; }
                        *(u32x2*)(dst + (size_t)row * 64 + i0) = (u32x2){pk_bf16(o1[0], o1[1]), pk_bf16(o1[2], o1[3])};
                        *(u32x2*)(dst + (size_t)row * 64 + 32 + i0) = (u32x2){pk_bf16(o2[0], o2[1]), pk_bf16(o2[2], o2[3])}; } }
            }
        }
    }
};
struct EpiQUp {
    int pn, brow; unsigned char* ws;
    __device__ __forceinline__ void mid(f32x4 (&)[8][4], int, int, int, int) {}
    __device__ __forceinline__ void fin(f32x4 (&acc)[8][4], int wr, int wc, int fr, int fq) {
        bf16_t* dst = (bf16_t*)(ws + WS_QB); const float* rope = (const float*)(ws + WS_ROPE); const float* ssq = (const float*)(ws + WS_CTL + CTL_SSQ_CQ);
        const int seg = pn * 4 + wc, head = seg / 3, part = seg - head * 3;
        float sq[8];
#pragma unroll
        for (int m = 0; m < 8; ++m) { const f32x4* pp = (const f32x4*)((const float*)(ws + WS_SSQC) + (size_t)(brow + wr * 128 + m * 16 + fr) * 8); const f32x4 p0 = pp[0], p1 = pp[1];
            sq[m] = ((p0[0] + p0[1]) + (p0[2] + p0[3])) + ((p1[0] + p1[1]) + (p1[2] + p1[3])); }
#pragma unroll
        for (int m = 0; m < 8; ++m) { const int row = brow + wr * 128 + m * 16 + fr; const float rs = rsqrtf(sq[m] * (1.f / 512.f) + EPS);
            bf16_t* drow = dst + (size_t)row * 1536 + head * 192 + part * 64;
            if (part < 2) {
#pragma unroll
                for (int n = 0; n < 4; ++n) { const f32x4 v = acc[m][n]; *(u32x2*)(drow + n * 16 + fq * 4) = (u32x2){pk_bf16(v[0] * rs, v[1] * rs), pk_bf16(v[2] * rs, v[3] * rs)}; }
            } else { const int pos = row & (SEQ - 1);
#pragma unroll
                for (int n = 0; n < 2; ++n) { const int i0 = n * 16 + fq * 4; const f32x4 x1 = acc[m][n], x2 = acc[m][n + 2];
                    const f32x4 cs0 = *(const f32x4*)(rope + ((size_t)pos * 32 + i0) * 2), cs1 = *(const f32x4*)(rope + ((size_t)pos * 32 + i0) * 2 + 4);
                    const float c[4] = {cs0[0], cs0[2], cs1[0], cs1[2]}, s[4] = {cs0[1], cs0[3], cs1[1], cs1[3]};
                    float o1[4], o2[4];
#pragma unroll
                    for (int j = 0; j < 4; ++j) { o1[j] = (x1[j] * c[j] - x2[j] * s[j]) * rs; o2[j] = (x1[j] * s[j] + x2[j] * c[j]) * rs; }
                    *(u32x2*)(drow + i0) = (u32x2){pk_bf16(o1[0], o1[1]), pk_bf16(o1[2], o1[3])};
                    *(u32x2*)(drow + 32 + i0) = (u32x2){pk_bf16(o2[0], o2[1]), pk_bf16(o2[2], o2[3])}; } }
        }
    }
};
struct EpiKvUp {
    int pn, brow; unsigned char* ws;
    __device__ __forceinline__ void mid(f32x4 (&)[8][4], int, int, int, int) {}
    __device__ __forceinline__ void fin(f32x4 (&acc)[8][4], int wr, int wc, int fr, int fq) {
        bf16_t* dst = (bf16_t*)(ws + WS_KVB);
        float sq[8];
#pragma unroll
        for (int m = 0; m < 8; ++m) { const f32x4 p0 = *(const f32x4*)((const float*)(ws + WS_SSQK) + (size_t)(brow + wr * 128 + m * 16 + fr) * 4); sq[m] = (p0[0] + p0[1]) + (p0[2] + p0[3]); }
#pragma unroll
        for (int m = 0; m < 8; ++m) { const int row = brow + wr * 128 + m * 16 + fr; const float rs = rsqrtf(sq[m] * (1.f / 256.f) + EPS);
#pragma unroll
            for (int n = 0; n < 4; ++n) { const int col = pn * 256 + wc * 64 + n * 16 + fq * 4; const f32x4 v = acc[m][n];
                *(u32x2*)(dst + (size_t)row * 2048 + col) = (u32x2){pk_bf16(v[0] * rs, v[1] * rs), pk_bf16(v[2] * rs, v[3] * rs)}; } }
    }
};
struct EpiWo {
    int pn, brow; unsigned char* ws; const float* x; const LAS float* tab;
    __device__ __forceinline__ void mid(f32x4 (&acc)[8][4], int wr, int wc, int fr, int fq) {
#pragma unroll
        for (int m = 0; m < 8; ++m) { const int r = wr * 128 + m * 16 + fr;
            const float f = __builtin_amdgcn_sqrtf((tab[256 + r] + EPS) * __builtin_amdgcn_rcpf(tab[r] + EPS));
#pragma unroll
            for (int n = 0; n < 4; ++n) acc[m][n] *= f;
            SBAR(); }
    }
    __device__ __forceinline__ void fin(f32x4 (&acc)[8][4], int wr, int wc, int fr, int fq) {
        float* x2 = (float*)(ws + WS_X2);
#pragma unroll
        for (int m = 0; m < 8; ++m) { const int r = wr * 128 + m * 16 + fr, row = brow + r; const float rbm = rsqrtf(tab[256 + r] + EPS); f32x4 xv[4];
#pragma unroll
            for (int n = 0; n < 4; ++n) xv[n] = *(const f32x4*)(x + (size_t)row * D_MODEL + pn * 256 + wc * 64 + n * 16 + fq * 4);
#pragma unroll
            for (int n = 0; n < 4; ++n) { const int col = pn * 256 + wc * 64 + n * 16 + fq * 4;
                const f32x4 v = acc[m][n] * rbm + xv[n];
                *(f32x4*)(x2 + (size_t)row * D_MODEL + col) = v; } }
    }
};
struct EpiUp8 {
    int j0, r0, cnt; unsigned char* dst; const float* bias;
    __device__ __forceinline__ void fin(f32x16 (&acc)[4][2], int wr, int wc, int r32, int hi) {
        f32x4 bg[4], bu[4];
#pragma unroll
        for (int rg = 0; rg < 4; ++rg) { const int j = j0 + wc * 32 + 8 * rg + 4 * hi; bg[rg] = *(const f32x4*)(bias + j); bu[rg] = *(const f32x4*)(bias + D_FF + j); }
#pragma unroll
        for (int m = 0; m < 4; ++m) { const int r = wr * 128 + m * 32 + r32; unsigned o8[4];
#pragma unroll
            for (int rg = 0; rg < 4; ++rg) { float o[4];
#pragma unroll
                for (int q = 0; q < 4; ++q) { const float g = fminf(acc[m][0][4 * rg + q] + bg[rg][q], 7.f), u = fminf(fmaxf(acc[m][1][4 * rg + q] + bu[rg][q], -7.f), 7.f);
                    const float sg = __builtin_amdgcn_rcpf(1.f + __builtin_amdgcn_exp2f(-1.702f * LOG2E * g)); o[q] = 4.f * (u + 1.f) * (g * sg); }
                o8[rg] = pk4_fp8(o[0], o[1], o[2], o[3]); }
#pragma unroll
            for (int j = 0; j < 2; ++j) { const auto sw = __builtin_amdgcn_permlane32_swap(o8[2 * j], o8[2 * j + 1], false, false); o8[2 * j] = sw[0]; o8[2 * j + 1] = sw[1]; }
            if (r0 + r < cnt) {
#pragma unroll
                for (int j = 0; j < 2; ++j) *(u32x2*)(dst + (size_t)r * D_FF + j0 + wc * 32 + 16 * j + 8 * hi) = (u32x2){o8[2 * j], o8[2 * j + 1]}; }
        }
    }
};
struct EpiUp8q {
    int j0, r0, cnt; unsigned char* dst; const float* bias;
    __device__ __forceinline__ void fin(f32x16 (&acc)[2][2], int wr, int wc, int r32, int hi) {
        f32x4 bg[4], bu[4];
#pragma unroll
        for (int rg = 0; rg < 4; ++rg) { const int j = j0 + wc * 32 + 8 * rg + 4 * hi; bg[rg] = *(const f32x4*)(bias + j); bu[rg] = *(const f32x4*)(bias + D_FF + j); }
#pragma unroll
        for (int m = 0; m < 2; ++m) { const int r = wr * 64 + m * 32 + r32; unsigned o8[4];
#pragma unroll
            for (int rg = 0; rg < 4; ++rg) { float o[4];
#pragma unroll
                for (int q = 0; q < 4; ++q) { const float g = fminf(acc[m][0][4 * rg + q] + bg[rg][q], 7.f), u = fminf(fmaxf(acc[m][1][4 * rg + q] + bu[rg][q], -7.f), 7.f);
                    const float sg = __builtin_amdgcn_rcpf(1.f + __builtin_amdgcn_exp2f(-1.702f * LOG2E * g)); o[q] = 4.f * (u + 1.f) * (g * sg); }
                o8[rg] = pk4_fp8(o[0], o[1], o[2], o[3]); }
#pragma unroll
            for (int j = 0; j < 2; ++j) { const auto sw = __builtin_amdgcn_permlane32_swap(o8[2 * j], o8[2 * j + 1], false, false); o8[2 * j] = sw[0]; o8[2 * j + 1] = sw[1]; }
            if (r0 + r < cnt) {
#pragma unroll
                for (int j = 0; j < 2; ++j) *(u32x2*)(dst + (size_t)r * D_FF + j0 + wc * 32 + 16 * j + 8 * hi) = (u32x2){o8[2 * j], o8[2 * j + 1]}; }
        }
    }
};
struct EpiDown8 {
    int c0, r0, cnt; bf16_t* dst; const float* bias;
    __device__ __forceinline__ void fin(f32x16 (&acc)[4][2], int wr, int wc, int r32, int hi) {
        f32x4 b[2][4];
#pragma unroll
        for (int n = 0; n < 2; ++n)
#pragma unroll
            for (int rg = 0; rg < 4; ++rg) b[n][rg] = *(const f32x4*)(bias + c0 + wc * 64 + n * 32 + 8 * rg + 4 * hi);
#pragma unroll
        for (int m = 0; m < 4; ++m) { const int r = wr * 128 + m * 32 + r32;
#pragma unroll
            for (int n = 0; n < 2; ++n) { u32x2 pk[4];
#pragma unroll
                for (int rg = 0; rg < 4; ++rg) pk[rg] = (u32x2){pk_bf16(acc[m][n][4 * rg] + b[n][rg][0], acc[m][n][4 * rg + 1] + b[n][rg][1]), pk_bf16(acc[m][n][4 * rg + 2] + b[n][rg][2], acc[m][n][4 * rg + 3] + b[n][rg][3])};
#pragma unroll
                for (int j = 0; j < 2; ++j) { const auto s0 = __builtin_amdgcn_permlane32_swap(pk[2 * j][0], pk[2 * j + 1][0], false, false); const auto s1 = __builtin_amdgcn_permlane32_swap(pk[2 * j][1], pk[2 * j + 1][1], false, false);
                    pk[2 * j] = (u32x2){s0[0], s1[0]}; pk[2 * j + 1] = (u32x2){s0[1], s1[1]}; }
                if (r0 + r < cnt) {
#pragma unroll
                    for (int j = 0; j < 2; ++j) *(u32x4*)(dst + (size_t)r * D_MODEL + c0 + wc * 64 + n * 32 + 16 * j + 8 * hi) = (u32x4){pk[2 * j][0], pk[2 * j][1], pk[2 * j + 1][0], pk[2 * j + 1][1]}; } }
        }
    }
};
struct EpiDown8h {
    int c0, r0, cnt; bf16_t* dst; const float* bias;
    __device__ __forceinline__ void fin(f32x16 (&acc)[4][1], int wr, int wc, int r32, int hi) {
        f32x4 b[1][4];
#pragma unroll
        for (int n = 0; n < 1; ++n)
#pragma unroll
            for (int rg = 0; rg < 4; ++rg) b[n][rg] = *(const f32x4*)(bias + c0 + wc * 32 + n * 32 + 8 * rg + 4 * hi);
#pragma unroll
        for (int m = 0; m < 4; ++m) { const int r = wr * 128 + m * 32 + r32;
#pragma unroll
            for (int n = 0; n < 1; ++n) { u32x2 pk[4];
#pragma unroll
                for (int rg = 0; rg < 4; ++rg) pk[rg] = (u32x2){pk_bf16(acc[m][n][4 * rg] + b[n][rg][0], acc[m][n][4 * rg + 1] + b[n][rg][1]), pk_bf16(acc[m][n][4 * rg + 2] + b[n][rg][2], acc[m][n][4 * rg + 3] + b[n][rg][3])};
#pragma unroll
                for (int j = 0; j < 2; ++j) { const auto s0 = __builtin_amdgcn_permlane32_swap(pk[2 * j][0], pk[2 * j + 1][0], false, false); const auto s1 = __builtin_amdgcn_permlane32_swap(pk[2 * j][1], pk[2 * j + 1][1], false, false);
                    pk[2 * j] = (u32x2){s0[0], s1[0]}; pk[2 * j + 1] = (u32x2){s0[1], s1[1]}; }
                if (r0 + r < cnt) {
#pragma unroll
                    for (int j = 0; j < 2; ++j) *(u32x4*)(dst + (size_t)r * D_MODEL + c0 + wc * 32 + n * 32 + 16 * j + 8 * hi) = (u32x4){pk[2 * j][0], pk[2 * j][1], pk[2 * j + 1][0], pk[2 * j + 1][1]}; } }
        }
    }
};

constexpr int PG_HTB = 128 * 64 * 2;
__host__ __device__ __forceinline__ int pg_lds_byte(int r, int c) { const int st = (r >> 4) * 2 + (c >> 5), rr = r & 15, cc = c & 31, ob = rr * 64 + cc * 2; return st * 1024 + (ob ^ (((ob >> 9) & 1) << 5)); }
__host__ __device__ __forceinline__ void pg_stage_rc(int b, int& R, int& C) { const int st = b / 1024, sb = b % 1024, swz = sb ^ (((sb >> 9) & 1) << 5); R = (st >> 1) * 16 + swz / 64; C = (st & 1) * 32 + (swz % 64) / 2; }
__host__ __device__ __forceinline__ int pg_tcol(int rho) { return (rho & ~0x30) | ((rho & 0x10) << 1) | ((rho & 0x20) >> 1); }
template <bool MID, class EPI>
__device__ __forceinline__ void gemm_unit_pg(LAS char* lds, const bf16_t* A, const bf16_t* Bt, const int K, EPI& E) {
    const int tid = threadIdx.x, wid = __builtin_amdgcn_readfirstlane(tid >> 6), lane = tid & 63, wr = wid >> 2, wc = wid & 3, fr = lane & 15, fq = lane >> 4;
    const int nt = K / 64;
    unsigned voff[2];
#pragma unroll
    for (int i = 0; i < 2; ++i) { int R, C; pg_stage_rc(tid * 16 + i * 8192, R, C); voff[i] = (unsigned)(R * K + C) * 2u; }
    const size_t kstep = (size_t)(64 * 2), hstep = (size_t)128 * K * 2;
    const unsigned ldsw = (unsigned)wid * 1024u;
    const int aoff = pg_lds_byte(wr * 64 + fr, fq * 8), boff = pg_lds_byte(wc * 32 + fr, fq * 8);
#define PG_SA(b, h) (((b) * 2 + (h)) * PG_HTB)
#define PG_SB(b, h) ((4 + (b) * 2 + (h)) * PG_HTB)
#define PG_STAGE(bufoff, gbase) do { _Pragma("unroll") for (int _i = 0; _i < 2; ++_i) \
        __builtin_amdgcn_global_load_lds((const unsigned*)((const char*)(gbase) + voff[_i]), (LAS unsigned*)(lds + (bufoff) + ldsw + _i * 8192), 16, 0, 0); } while (0)
#define PG_LDA(dst, b, h) do { _Pragma("unroll") for (int m = 0; m < 4; ++m) _Pragma("unroll") for (int k = 0; k < 2; ++k) dst[m][k] = *(const LAS bf16x8*)(lds + PG_SA(b, h) + aoff + m * 2048 + k * 1024); } while (0)
#define PG_LDB(dst, b, h) do { _Pragma("unroll") for (int n = 0; n < 2; ++n) _Pragma("unroll") for (int k = 0; k < 2; ++k) dst[n][k] = *(const LAS bf16x8*)(lds + PG_SB(b, h) + boff + n * 2048 + k * 1024); } while (0)
#define PG_MMA(ai, bj, At_, Bt_) do { __builtin_amdgcn_s_setprio(1); _Pragma("unroll") for (int m = 0; m < 4; ++m) _Pragma("unroll") for (int n = 0; n < 2; ++n) _Pragma("unroll") for (int k = 0; k < 2; ++k) \
        acc[ai][bj][m][n] = __builtin_amdgcn_mfma_f32_16x16x32_bf16(Bt_[n][k], At_[m][k], acc[ai][bj][m][n], 0, 0, 0); __builtin_amdgcn_s_setprio(0); } while (0)
#define PG_WAIT_V(n) asm volatile("s_waitcnt vmcnt(" #n ")" ::: "memory")
#define PG_WAIT_L(n) asm volatile("s_waitcnt lgkmcnt(" #n ")" ::: "memory")
#define PG_BAR __builtin_amdgcn_s_barrier()
    f32x4 acc[2][2][4][2];
#pragma unroll
    for (int a = 0; a < 2; ++a)
#pragma unroll
        for (int b = 0; b < 2; ++b)
#pragma unroll
            for (int m = 0; m < 4; ++m)
#pragma unroll
                for (int n = 0; n < 2; ++n) acc[a][b][m][n] = (f32x4){0.f, 0.f, 0.f, 0.f};
    bf16x8 At[4][2], B0[2][2], B1[2][2];
    const char* cA = (const char*)A; const char* cB = (const char*)Bt;
    PG_STAGE(PG_SB(0, 0), cB); PG_STAGE(PG_SA(0, 0), cA); PG_STAGE(PG_SB(0, 1), cB + hstep); PG_STAGE(PG_SA(0, 1), cA + hstep);
    if (wr == 1) PG_BAR;
    PG_WAIT_V(4); PG_BAR;
    PG_STAGE(PG_SB(1, 0), cB + kstep); PG_STAGE(PG_SA(1, 0), cA + kstep); PG_STAGE(PG_SB(1, 1), cB + hstep + kstep);
    PG_WAIT_V(6); PG_BAR;
    for (int t = 0; t < nt; t += 2) {
        const bool last = (t == nt - 2);
        const char* a1 = cA + (size_t)(t + 1) * kstep;
        const char* a2 = cA + (size_t)(t + 2) * kstep; const char* b2 = cB + (size_t)(t + 2) * kstep;
        const char* a3 = a2 + kstep; const char* b3 = b2 + kstep;
        if (MID && t == (nt >> 1)) E.mid(acc, wr, wc, fr, fq);
        PG_LDB(B0, 0, 0); SBAR(); PG_LDA(At, 0, 0); PG_STAGE(PG_SA(1, 1), a1 + hstep);
        PG_WAIT_L(8); PG_BAR; PG_WAIT_L(0); PG_MMA(0, 0, At, B0); PG_BAR; SBAR();
        PG_LDB(B1, 0, 1); if (!last) PG_STAGE(PG_SB(0, 0), b2);
        PG_BAR; PG_WAIT_L(0); PG_MMA(0, 1, At, B1); PG_BAR;
        PG_LDA(At, 0, 1); if (!last) PG_STAGE(PG_SA(0, 0), a2);
        PG_BAR; PG_WAIT_L(0); PG_MMA(1, 0, At, B0); PG_BAR; SBAR();
        if (!last) { PG_STAGE(PG_SB(0, 1), b2 + hstep); PG_WAIT_V(6); } else PG_WAIT_V(0);
        PG_BAR; PG_MMA(1, 1, At, B1); PG_BAR;
        PG_LDB(B0, 1, 0); SBAR(); PG_LDA(At, 1, 0); if (!last) PG_STAGE(PG_SA(0, 1), a2 + hstep);
        PG_WAIT_L(8); PG_BAR; PG_WAIT_L(0); PG_MMA(0, 0, At, B0); PG_BAR; SBAR();
        PG_LDB(B1, 1, 1); if (!last) PG_STAGE(PG_SB(1, 0), b3);
        PG_BAR; PG_WAIT_L(0); PG_MMA(0, 1, At, B1); PG_BAR;
        PG_LDA(At, 1, 1); if (!last) PG_STAGE(PG_SA(1, 0), a3);
        PG_BAR; PG_WAIT_L(0); PG_MMA(1, 0, At, B0); PG_BAR; SBAR();
        if (!last) { PG_STAGE(PG_SB(1, 1), b3 + hstep); PG_WAIT_V(6); }
        PG_BAR; PG_MMA(1, 1, At, B1); PG_BAR;
    }
    E.fin(acc, wr, wc, fr, fq);
    PG_WAIT_V(0);
    if (wr == 0) PG_BAR;
    PG_BAR;
#undef PG_SA
#undef PG_SB
#undef PG_STAGE
#undef PG_LDA
#undef PG_LDB
#undef PG_MMA
#undef PG_WAIT_V
#undef PG_WAIT_L
#undef PG_BAR
}

#define PG_ROW(ai, m) (128 * (ai) + 64 * wr + 16 * (m) + fr)
#define PG_COL(bj, n) (128 * (bj) + 64 * (wc >> 1) + 32 * (n) + 16 * (wc & 1) + 4 * fq)
__device__ __forceinline__ void pg_store_pair(bf16_t* rowp, u32x2 a, u32x2 b, int fq) {
    const auto s0 = __builtin_amdgcn_permlane16_swap(a[0], b[0], false, false); const auto s1 = __builtin_amdgcn_permlane16_swap(a[1], b[1], false, false);
    *(u32x4*)(rowp + 32 * (fq & 1) + 4 * (fq & 2)) = (u32x4){s0[0], s1[0], s0[1], s1[1]};
}
#define PG_CBASE(bj) (128 * (bj) + 64 * (wc >> 1) + 16 * (wc & 1))
struct PEpiProj {
    int pn, brow; unsigned char* ws; const float *qg, *kvg;
    __device__ __forceinline__ void mid(f32x4 (&)[2][2][4][2], int, int, int, int) {}
    __device__ __forceinline__ void fin(f32x4 (&acc)[2][2][4][2], int wr, int wc, int fr, int fq) {
        if (pn < 6) {
            bf16_t* dst; int ldd, c0;
            if (pn < 4) { dst = (bf16_t*)(ws + WS_QA); ldd = 1024; c0 = pn * 256; } else if (pn == 4) { dst = (bf16_t*)(ws + WS_KA); ldd = 256; c0 = 0; } else { dst = (bf16_t*)(ws + WS_VA); ldd = 256; c0 = 0; }
#pragma unroll
            for (int ai = 0; ai < 2; ++ai)
#pragma unroll
                for (int m = 0; m < 4; ++m) { bf16_t* rowp = dst + (size_t)(brow + PG_ROW(ai, m)) * ldd + c0;
#pragma unroll
                    for (int bj = 0; bj < 2; ++bj) { const f32x4 v = acc[ai][bj][m][0], w = acc[ai][bj][m][1];
                        pg_store_pair(rowp + PG_CBASE(bj), (u32x2){pk_bf16(v[0], v[1]), pk_bf16(v[2], v[3])}, (u32x2){pk_bf16(w[0], w[1]), pk_bf16(w[2], w[3])}, fq); } }
        } else if (pn < 9) {
            bf16_t* dst; int ldd, c0; const float* g; float* ssq; int nsl, sl0;
            if (pn < 8) { dst = (bf16_t*)(ws + WS_CQ); ldd = 512; c0 = (pn - 6) * 256; g = qg; ssq = (float*)(ws + WS_SSQC); nsl = 16; sl0 = (pn - 6) * 8 + wc; }
            else { dst = (bf16_t*)(ws + WS_CKV); ldd = 256; c0 = 0; g = kvg; ssq = (float*)(ws + WS_SSQK); nsl = 8; sl0 = wc; }
            f32x4 gvv[2][2];
#pragma unroll
            for (int bj = 0; bj < 2; ++bj)
#pragma unroll
                for (int n = 0; n < 2; ++n) gvv[bj][n] = *(const f32x4*)(g + c0 + PG_COL(bj, n));
#pragma unroll
            for (int ai = 0; ai < 2; ++ai)
#pragma unroll
                for (int m = 0; m < 4; ++m) { const int row = brow + PG_ROW(ai, m);
#pragma unroll
                    for (int bj = 0; bj < 2; ++bj) { float ss = 0.f; u32x2 pk[2];
#pragma unroll
                        for (int n = 0; n < 2; ++n) { const f32x4 v = acc[ai][bj][m][n]; const f32x4 gv = gvv[bj][n];
                            ss += v[0] * v[0] + v[1] * v[1] + v[2] * v[2] + v[3] * v[3];
                            pk[n] = (u32x2){pk_bf16(v[0] * gv[0], v[1] * gv[1]), pk_bf16(v[2] * gv[2], v[3] * gv[3])}; }
                        pg_store_pair(dst + (size_t)row * ldd + c0 + PG_CBASE(bj), pk[0], pk[1], fq);
                        ss += __shfl_xor(ss, 16, 64); ss += __shfl_xor(ss, 32, 64);
                        if (fq == 0) ssq[(size_t)row * nsl + sl0 + 4 * bj] = ss; } }
        } else {
            if (wc < 2) {
                bf16_t* dst = (bf16_t*)(ws + WS_KPE); const float* rope = (const float*)(ws + WS_ROPE); const int i0 = 16 * wc + 4 * fq;
#pragma unroll
                for (int ai = 0; ai < 2; ++ai)
#pragma unroll
                    for (int m = 0; m < 4; ++m) { const int row = brow + PG_ROW(ai, m); const int pos = row & (SEQ - 1); const f32x4 x1 = acc[ai][0][m][0], x2 = acc[ai][0][m][1];
                        const f32x4 cs0 = *(const f32x4*)(rope + ((size_t)pos * 32 + i0) * 2), cs1 = *(const f32x4*)(rope + ((size_t)pos * 32 + i0) * 2 + 4);
                        const float c[4] = {cs0[0], cs0[2], cs1[0], cs1[2]}, s[4] = {cs0[1], cs0[3], cs1[1], cs1[3]};
                        float o1[4], o2[4];
#pragma unroll
                        for (int j = 0; j < 4; ++j) { o1[j] = x1[j] * c[j] - x2[j] * s[j]; o2[j] = x1[j] * s[j] + x2[j] * c[j]; }
                        pg_store_pair(dst + (size_t)row * 64 + 16 * wc, (u32x2){pk_bf16(o1[0], o1[1]), pk_bf16(o1[2], o1[3])}, (u32x2){pk_bf16(o2[0], o2[1]), pk_bf16(o2[2], o2[3])}, fq); }
            }
        }
    }
};
struct PEpiQUp {
    int pn, brow; unsigned char* ws;
    __device__ __forceinline__ void mid(f32x4 (&)[2][2][4][2], int, int, int, int) {}
    __device__ __forceinline__ void fin(f32x4 (&acc)[2][2][4][2], int wr, int wc, int fr, int fq) {
        bf16_t* dst = (bf16_t*)(ws + WS_QB); const float* rope = (const float*)(ws + WS_ROPE);
        float rs[2][4];
#pragma unroll
        for (int ai = 0; ai < 2; ++ai)
#pragma unroll
            for (int m = 0; m < 4; ++m) { const f32x4* pp = (const f32x4*)((const float*)(ws + WS_SSQC) + (size_t)(brow + PG_ROW(ai, m)) * 16); const f32x4 p0 = pp[0], p1 = pp[1], p2 = pp[2], p3 = pp[3];
                const float sq = (((p0[0] + p0[1]) + (p0[2] + p0[3])) + ((p1[0] + p1[1]) + (p1[2] + p1[3]))) + (((p2[0] + p2[1]) + (p2[2] + p2[3])) + ((p3[0] + p3[1]) + (p3[2] + p3[3])));
                rs[ai][m] = rsqrtf(sq * (1.f / 512.f) + EPS); }
#pragma unroll
        for (int bj = 0; bj < 2; ++bj) { const int seg = pn * 4 + 2 * bj + (wc >> 1), head = seg / 3, part = seg - head * 3; const int i0 = 16 * (wc & 1) + 4 * fq;
#pragma unroll
            for (int ai = 0; ai < 2; ++ai)
#pragma unroll
                for (int m = 0; m < 4; ++m) { const int row = brow + PG_ROW(ai, m); const float r = rs[ai][m]; bf16_t* drow = dst + (size_t)row * 1536 + head * 192 + part * 64;
                    const f32x4 x1 = acc[ai][bj][m][0], x2 = acc[ai][bj][m][1];
                    if (part < 2) {
                        pg_store_pair(drow + 16 * (wc & 1), (u32x2){pk_bf16(x1[0] * r, x1[1] * r), pk_bf16(x1[2] * r, x1[3] * r)}, (u32x2){pk_bf16(x2[0] * r, x2[1] * r), pk_bf16(x2[2] * r, x2[3] * r)}, fq);
                    } else { const int pos = row & (SEQ - 1);
                        const f32x4 cs0 = *(const f32x4*)(rope + ((size_t)pos * 32 + i0) * 2), cs1 = *(const f32x4*)(rope + ((size_t)pos * 32 + i0) * 2 + 4);
                        const float c[4] = {cs0[0], cs0[2], cs1[0], cs1[2]}, s[4] = {cs0[1], cs0[3], cs1[1], cs1[3]};
                        float o1[4], o2[4];
#pragma unroll
                        for (int j = 0; j < 4; ++j) { o1[j] = (x1[j] * c[j] - x2[j] * s[j]) * r; o2[j] = (x1[j] * s[j] + x2[j] * c[j]) * r; }
                        pg_store_pair(drow + 16 * (wc & 1), (u32x2){pk_bf16(o1[0], o1[1]), pk_bf16(o1[2], o1[3])}, (u32x2){pk_bf16(o2[0], o2[1]), pk_bf16(o2[2], o2[3])}, fq); } } }
    }
};
struct PEpiKvUp {
    int pn, brow; unsigned char* ws;
    __device__ __forceinline__ void mid(f32x4 (&)[2][2][4][2], int, int, int, int) {}
    __device__ __forceinline__ void fin(f32x4 (&acc)[2][2][4][2], int wr, int wc, int fr, int fq) {
        bf16_t* dst = (bf16_t*)(ws + WS_KVB);
#pragma unroll
        for (int ai = 0; ai < 2; ++ai)
#pragma unroll
            for (int m = 0; m < 4; ++m) { const int row = brow + PG_ROW(ai, m); const f32x4* pp = (const f32x4*)((const float*)(ws + WS_SSQK) + (size_t)row * 8); const f32x4 p0 = pp[0], p1 = pp[1];
                const float r = rsqrtf((((p0[0] + p0[1]) + (p0[2] + p0[3])) + ((p1[0] + p1[1]) + (p1[2] + p1[3]))) * (1.f / 256.f) + EPS);
#pragma unroll
                for (int bj = 0; bj < 2; ++bj) { const f32x4 v = acc[ai][bj][m][0], w = acc[ai][bj][m][1];
                    pg_store_pair(dst + (size_t)row * 2048 + pn * 256 + PG_CBASE(bj), (u32x2){pk_bf16(v[0] * r, v[1] * r), pk_bf16(v[2] * r, v[3] * r)}, (u32x2){pk_bf16(w[0] * r, w[1] * r), pk_bf16(w[2] * r, w[3] * r)}, fq); } }
    }
};
struct PEpiWo {
    int pn, brow; unsigned char* ws; const float* x; const LAS float* tab;
    __device__ __forceinline__ void mid(f32x4 (&acc)[2][2][4][2], int wr, int wc, int fr, int fq) {
#pragma unroll
        for (int ai = 0; ai < 2; ++ai)
#pragma unroll
            for (int m = 0; m < 4; ++m) { const int r = PG_ROW(ai, m);
                const float f = __builtin_amdgcn_sqrtf((tab[256 + r] + EPS) * __builtin_amdgcn_rcpf(tab[r] + EPS));
#pragma unroll
                for (int bj = 0; bj < 2; ++bj)
#pragma unroll
                    for (int n = 0; n < 2; ++n) acc[ai][bj][m][n] *= f; }
        asm volatile("s_waitcnt lgkmcnt(0)" ::: "memory"); SBAR();
    }
    __device__ __forceinline__ void fin(f32x4 (&acc)[2][2][4][2], int wr, int wc, int fr, int fq) {
        float* x2 = (float*)(ws + WS_X2);
#pragma unroll
        for (int ai = 0; ai < 2; ++ai)
#pragma unroll
            for (int m = 0; m < 4; ++m) { const int r = PG_ROW(ai, m); const size_t o = (size_t)(brow + r) * D_MODEL + pn * 256; const float rbm = rsqrtf(tab[256 + r] + EPS); f32x4 xv[2][2];
#pragma unroll
                for (int bj = 0; bj < 2; ++bj)
#pragma unroll
                    for (int n = 0; n < 2; ++n) xv[bj][n] = *(const f32x4*)(x + o + PG_COL(bj, n));
#pragma unroll
                for (int bj = 0; bj < 2; ++bj)
#pragma unroll
                    for (int n = 0; n < 2; ++n) *(f32x4*)(x2 + o + PG_COL(bj, n)) = acc[ai][bj][m][n] * rbm + xv[bj][n]; }
    }
};
__device__ __forceinline__ void pg_convert(const float* W, int K, int ld, int ncols, int nrows, bf16_t* Bt, int item0, int nitems_stride) {
    const int total = nrows * (K >> 3);
    for (int it0 = item0; it0 < total; it0 += 4 * nitems_stride) { float v[4][8]; int row[4], k0[4]; bool ok[4];
#pragma unroll
        for (int b = 0; b < 4; ++b) { const int it = it0 + b * nitems_stride; const int itc = it < total ? it : item0; const int kc = itc / nrows; row[b] = itc - kc * nrows; k0[b] = kc << 3; ok[b] = it < total;
            const int col = (row[b] & ~255) + pg_tcol(row[b] & 255); const int colc = col < ncols ? col : 0; const float s = col < ncols ? 1.f : 0.f;
#pragma unroll
            for (int q = 0; q < 8; ++q) v[b][q] = W[(size_t)(k0[b] + q) * ld + colc] * s; }
#pragma unroll
        for (int b = 0; b < 4; ++b) if (ok[b])
            *(u32x4*)(Bt + (size_t)row[b] * K + k0[b]) = (u32x4){pk_bf16(v[b][0], v[b][1]), pk_bf16(v[b][2], v[b][3]), pk_bf16(v[b][4], v[b][5]), pk_bf16(v[b][6], v[b][7])}; }
}
__device__ __forceinline__ void sincos_d(double x, double& s, double& c) {
    const double k = __builtin_rint(x * 0.63661977236758134308);
    double r = __builtin_fma(-k, 1.57079632679489655800e+00, x); r = __builtin_fma(-k, 6.12323399573676603587e-17, r);
    const double r2 = r * r;
    double sp = -7.6471637318198164759e-13; sp = sp * r2 + 1.6059043836821614599e-10; sp = sp * r2 - 2.5052108385441718775e-08; sp = sp * r2 + 2.7557319223985890653e-06;
    sp = sp * r2 - 1.9841269841269841270e-04; sp = sp * r2 + 8.3333333333333333333e-03; sp = sp * r2 - 1.6666666666666666667e-01; const double sn = r + r * r2 * sp;
    double cp = 4.7794773323873852974e-14; cp = cp * r2 - 1.1470745597729724714e-11; cp = cp * r2 + 2.0876756987868098979e-09; cp = cp * r2 - 2.7557319223985890653e-07;
    cp = cp * r2 + 2.4801587301587301587e-05; cp = cp * r2 - 1.3888888888888888889e-03; cp = cp * r2 + 4.1666666666666666667e-02; cp = cp * r2 - 0.5; const double cn = 1.0 + r2 * cp;
    const int q = ((int)k) & 3;
    s = (q == 0) ? sn : (q == 1) ? cn : (q == 2) ? -sn : -cn;
    c = (q == 0) ? cn : (q == 1) ? -sn : (q == 2) ? -cn : sn;
}

__device__ __forceinline__ void phase_prologue(const Params& p) {
    const int tid = threadIdx.x, wid = tid >> 6, lane = tid & 63;
    bf16_t* xn = (bf16_t*)(p.ws + WS_XN);
    for (int row = blockIdx.x * 8 + wid; row < NTOK; row += gridDim.x * 8) {
        const f32x4* xr = (const f32x4*)(p.x + (size_t)row * D_MODEL); f32x4 v[8]; float ss = 0.f;
#pragma unroll
        for (int i = 0; i < 8; ++i) { v[i] = xr[lane + 64 * i]; ss += v[i][0] * v[i][0] + v[i][1] * v[i][1] + v[i][2] * v[i][2] + v[i][3] * v[i][3]; }
        ss = wave_sum(ss); const float rs = rsqrtf(ss * (1.f / D_MODEL) + EPS);
#pragma unroll
        for (int i = 0; i < 8; ++i) { const f32x4 g = ((const f32x4*)p.attn_norm)[lane + 64 * i];
            *(u32x2*)(xn + (size_t)row * D_MODEL + 4 * (lane + 64 * i)) = (u32x2){pk_bf16(v[i][0] * rs * g[0], v[i][1] * rs * g[1]), pk_bf16(v[i][2] * rs * g[2], v[i][3] * rs * g[3])}; }
    }
    const int gtid = blockIdx.x * 512 + tid;
    if (gtid < SEQ * 32) {
        const int pos = gtid >> 5, i = gtid & 31;
        double b = 10000.0; for (int q = 0; q < 5; ++q) b = __builtin_sqrt(b);
        double f = 1.0; for (int q = 0; q < i; ++q) f *= b;
        const float inv_freq = (float)(1.0 / f); const float ang = (float)pos * inv_freq;
        double s, c; sincos_d((double)ang, s, c);
        float* rope = (float*)(p.ws + WS_ROPE); rope[(size_t)gtid * 2] = (float)c; rope[(size_t)gtid * 2 + 1] = (float)s;
    }
    {
        const int nth = gridDim.x * 512;
        pg_convert(p.w_in, D_MODEL, IN_COLS, IN_COLS, 2560, (bf16_t*)(p.ws + WS_BT_IN), gtid, nth);
        pg_convert(p.b_w_uq, 512, 1536, 1536, 1536, (bf16_t*)(p.ws + WS_BT_UQ), gtid, nth);
    }
    if (gtid < N_EXP * D_MODEL) {
        ((float*)(p.ws + WS_WRT))[gtid] = p.w_router[gtid] * p.mlp_norm[gtid >> 5];
    }
}

constexpr int AA_PITCH = 144;
constexpr int AA_K = 0, AA_V = 384 * AA_PITCH;
constexpr int AA_WS = 2 * 384 * AA_PITCH;
__device__ __forceinline__ void attn_a_unit(const Params& p, LAS char* lds, int u) {
    const int tid = threadIdx.x, wid = __builtin_amdgcn_readfirstlane(tid >> 6), lane = tid & 63, r32 = lane & 31, hi = lane >> 5;
    const int b = u >> 7, nq = (u >> 2) & 31, kvh = u & 3;
    const bf16_t* QA = (const bf16_t*)(p.ws + WS_QA); const bf16_t* KA = (const bf16_t*)(p.ws + WS_KA); const bf16_t* VA = (const bf16_t*)(p.ws + WS_VA);
    const int P0 = (nq - 1) * 128;
    __syncthreads();
    for (int c = tid; c < 384 * 8; c += 512) { const int r = c >> 3, ch = c & 7; const int pos = P0 + r;
        i32x4 kv = {0, 0, 0, 0}, vv = {0, 0, 0, 0};
        if (pos >= 0 && pos < SEQ) { const size_t g = ((size_t)(b * SEQ + pos)) * 256 + kvh * 64 + ch * 8; kv = *(const i32x4*)(KA + g); vv = *(const i32x4*)(VA + g); }
        *(LAS i32x4*)(lds + AA_K + r * AA_PITCH + ch * 16) = kv; *(LAS i32x4*)(lds + AA_V + r * AA_PITCH + ch * 16) = vv; }
    __syncthreads();
    LAS float* wsf = (LAS float*)(lds + AA_WS) + wid * 64;
    const int hq = kvh * 4 + (wid >> 1);
    const float slope2 = __builtin_amdgcn_exp2f(-8.f * (float)(hq + 1) / 16.f) * LOG2E;
    const float sink2 = p.a_sink[hq] * LOG2E;
    const float C = 0.125f * LOG2E;
    const float* ga = p.out_norm_a + hq * 64;
    bf16_t* Y = (bf16_t*)(p.ws + WS_Y); float* ssqa = (float*)(p.ws + WS_SSQP);
    for (int blk = 0; blk < 2; ++blk) {
        const int q0 = nq * 128 + (wid & 1) * 64 + blk * 32;
        const int tq = q0 + r32;
        bf16x8 qr[4];
        { const bf16_t* qp = QA + ((size_t)(b * SEQ + tq)) * 1024 + hq * 64 + hi * 8;
#pragma unroll
          for (int d0 = 0; d0 < 4; ++d0) qr[d0] = *(const bf16x8*)(qp + d0 * 16); }
        float m_reg = sink2, l_reg = 1.f; f32x16 o[2] = {};
        for (int jt = 0; jt < 6; ++jt) {
            const int kp0 = P0 + jt * 64;
            if (kp0 + 63 < q0 - 128 || kp0 > q0 + 31 + 128 || kp0 + 63 < 0 || kp0 >= SEQ) continue;
            f32x16 p0 = {}, p1 = {};
#pragma unroll
            for (int d0 = 0; d0 < 4; ++d0) {
                const bf16x8 k0 = *(const LAS bf16x8*)(lds + AA_K + (jt * 64 + r32) * AA_PITCH + (d0 * 16 + hi * 8) * 2);
                const bf16x8 k1 = *(const LAS bf16x8*)(lds + AA_K + (jt * 64 + 32 + r32) * AA_PITCH + (d0 * 16 + hi * 8) * 2);
                p0 = __builtin_amdgcn_mfma_f32_32x32x16_bf16(k0, qr[d0], p0, 0, 0, 0);
                p1 = __builtin_amdgcn_mfma_f32_32x32x16_bf16(k1, qr[d0], p1, 0, 0, 0);
            }
            float pmax = -1e30f;
#pragma unroll
            for (int r = 0; r < 16; ++r) {
                { const int kp = kp0 + crow(r, hi); const int dist = tq > kp ? tq - kp : kp - tq; const bool ok = dist <= 128 && kp >= 0 && kp < SEQ;
                  p0[r] = ok ? p0[r] * C - slope2 * (float)dist : -1e30f; pmax = fmaxf(pmax, p0[r]); }
                { const int kp = kp0 + 32 + crow(r, hi); const int dist = tq > kp ? tq - kp : kp - tq; const bool ok = dist <= 128 && kp >= 0 && kp < SEQ;
                  p1[r] = ok ? p1[r] * C - slope2 * (float)dist : -1e30f; pmax = fmaxf(pmax, p1[r]); }
            }
            { auto rr = __builtin_amdgcn_permlane32_swap(__float_as_uint(pmax), __float_as_uint(pmax), false, false); pmax = fmaxf(__uint_as_float(rr[0]), __uint_as_float(rr[1])); }
            const float mn = fmaxf(m_reg, pmax); const float alpha = __builtin_amdgcn_exp2f(m_reg - mn); m_reg = mn;
            float ps = 0.f;
#pragma unroll
            for (int r = 0; r < 16; ++r) { p0[r] = __builtin_amdgcn_exp2f(p0[r] - mn); p1[r] = __builtin_amdgcn_exp2f(p1[r] - mn); ps += p0[r] + p1[r]; }
            { auto rr = __builtin_amdgcn_permlane32_swap(__float_as_uint(ps), __float_as_uint(ps), false, false); ps = __uint_as_float(rr[0]) + __uint_as_float(rr[1]); }
            l_reg = l_reg * alpha + ps;
            if (hi == 0) wsf[r32] = alpha;
            WAIT_L0();
#pragma unroll
            for (int r = 0; r < 16; ++r) { const float a = wsf[crow(r, hi)]; o[0][r] *= a; o[1][r] *= a; }
            bf16x8 pa[4];
#define PK4(P, BASE, OUT) do { unsigned a0 = pk_bf16(P[BASE + 0], P[BASE + 1]), a1 = pk_bf16(P[BASE + 2], P[BASE + 3]); \
    unsigned b0 = pk_bf16(P[BASE + 4], P[BASE + 5]), b1 = pk_bf16(P[BASE + 6], P[BASE + 7]); \
    auto r0_ = __builtin_amdgcn_permlane32_swap(a0, b0, false, false); auto r1_ = __builtin_amdgcn_permlane32_swap(a1, b1, false, false); \
    u32x4 w_ = {r0_[0], r1_[0], r0_[1], r1_[1]}; OUT = __builtin_bit_cast(bf16x8, w_); } while (0)
            PK4(p0, 0, pa[0]); PK4(p0, 8, pa[1]); PK4(p1, 0, pa[2]); PK4(p1, 8, pa[3]);
            const int g16 = (lane >> 4) & 1, qq = (lane & 15) >> 2, pp = lane & 3;
#pragma unroll
            for (int db = 0; db < 2; ++db) {
#pragma unroll
                for (int ks = 0; ks < 4; ++ks) {
                    const LAS char* vp = lds + AA_V + (jt * 64 + ks * 16 + 8 * hi + qq) * AA_PITCH + (db * 32 + 16 * g16 + 4 * pp) * 2;
                    const s16x4 lo = vtr(vp), hh = vtr(vp + 4 * AA_PITCH);
                    const bf16x8 vb = (bf16x8){lo[0], lo[1], lo[2], lo[3], hh[0], hh[1], hh[2], hh[3]};
                    o[db] = __builtin_amdgcn_mfma_f32_32x32x16_bf16(pa[ks], vb, o[db], 0, 0, 0);
                }
            }
            WAIT_L0();
        }
        if (hi == 0) wsf[r32] = 1.f / l_reg;
        WAIT_L0();
        const float g0 = ga[r32], g1 = ga[32 + r32];
#pragma unroll
        for (int r = 0; r < 16; ++r) { const int qrow = crow(r, hi); const float il = wsf[qrow]; const float v0 = o[0][r] * il, v1 = o[1][r] * il;
            const size_t tok = (size_t)(b * SEQ + q0 + qrow);
            bf16_t* yp = Y + tok * 2048 + hq * 64;
            yp[r32] = (bf16_t)(pk_bf16(v0 * g0, 0.f) & 0xffffu); yp[32 + r32] = (bf16_t)(pk_bf16(v1 * g1, 0.f) & 0xffffu);
            float ss = v0 * v0 + v1 * v1;
#pragma unroll
            for (int s = 16; s >= 1; s >>= 1) ss += __shfl_xor(ss, s, 64);
            if (r32 == 0) ssqa[tok * 24 + hq] = ss; }
        WAIT_L0();
    }
}

constexpr int MB_V = 0, MB_KN = 32768, MB_KP = 65536, MB_WS = 81920, MB_QP = 83968;
#define KSWZ(row, colB) ((row) * 256 + ((colB) ^ (((row) & 7) << 4)))
#define KPSWZ(row, colB) ((row) * 128 + ((colB) ^ (((row) & 7) << 4)))
constexpr float MLA_SCALE = 0.07216878364870322f;
constexpr float MLA_THR = 8.f;
__device__ __forceinline__ void mla_partialSM(f32x16& p0, f32x16& p1, float& m_reg, float& mn, float& alpha) {
    constexpr float C = MLA_SCALE * LOG2E;
    float pmax = p0[0];
#pragma unroll
    for (int r = 1; r < 16; ++r) pmax = fmaxf(pmax, p0[r]);
#pragma unroll
    for (int r = 0; r < 16; ++r) pmax = fmaxf(pmax, p1[r]);
    { auto rr = __builtin_amdgcn_permlane32_swap(__float_as_uint(pmax), __float_as_uint(pmax), false, false); pmax = fmaxf(__uint_as_float(rr[0]), __uint_as_float(rr[1])); }
    if (__builtin_expect(__all(pmax - m_reg <= MLA_THR / MLA_SCALE), 1)) { mn = m_reg; alpha = 1.f; }
    else { mn = fmaxf(m_reg, pmax); alpha = __builtin_amdgcn_exp2f((m_reg - mn) * C); m_reg = mn; }
    const float mnC = -mn * C;
#pragma unroll
    for (int r = 0; r < 16; ++r) p0[r] = fmaf(p0[r], C, mnC);
#pragma unroll
    for (int r = 0; r < 16; ++r) p1[r] = fmaf(p1[r], C, mnC);
#pragma unroll
    for (int r = 0; r < 16; ++r) p0[r] = __builtin_amdgcn_exp2f(p0[r]);
}
__device__ __forceinline__ void mla_finishSM(f32x16& p0, f32x16& p1, float alpha, float& l_reg, bf16x8& pa0, bf16x8& pa1, bf16x8& pa2, bf16x8& pa3) {
#pragma unroll
    for (int r = 0; r < 16; ++r) p1[r] = __builtin_amdgcn_exp2f(p1[r]);
    float ps = 0;
#pragma unroll
    for (int r = 0; r < 16; ++r) ps += p0[r];
#pragma unroll
    for (int r = 0; r < 16; ++r) ps += p1[r];
    { auto rr = __builtin_amdgcn_permlane32_swap(__float_as_uint(ps), __float_as_uint(ps), false, false); ps = __uint_as_float(rr[0]) + __uint_as_float(rr[1]); }
    l_reg = l_reg * alpha + ps;
    PK4(p0, 0, pa0); PK4(p0, 8, pa1); PK4(p1, 0, pa2); PK4(p1, 8, pa3);
}
__device__ __forceinline__ void mla_qkt(f32x16& p0, f32x16& p1, const LAS char* Kn, const LAS char* Kp, const bf16x8* qr, const LAS char* qp, int r32, int hi) {
    p0 = f32x16{}; p1 = f32x16{};
#pragma unroll
    for (int d0 = 0; d0 < 8; ++d0) { const int cb = (d0 * 16 + hi * 8) * 2;
        const bf16x8 b0 = *(const LAS bf16x8*)(Kn + KSWZ(r32, cb)); const bf16x8 b1 = *(const LAS bf16x8*)(Kn + KSWZ(32 + r32, cb));
        p0 = __builtin_amdgcn_mfma_f32_32x32x16_bf16(b0, qr[d0], p0, 0, 0, 0); p1 = __builtin_amdgcn_mfma_f32_32x32x16_bf16(b1, qr[d0], p1, 0, 0, 0); }
#pragma unroll
    for (int d0 = 0; d0 < 4; ++d0) { const int cb = (d0 * 16 + hi * 8) * 2;
        const bf16x8 b0 = *(const LAS bf16x8*)(Kp + KPSWZ(r32, cb)); const bf16x8 b1 = *(const LAS bf16x8*)(Kp + KPSWZ(32 + r32, cb));
        const bf16x8 q = *(const LAS bf16x8*)(qp + d0 * 1024);
        p0 = __builtin_amdgcn_mfma_f32_32x32x16_bf16(b0, q, p0, 0, 0, 0); p1 = __builtin_amdgcn_mfma_f32_32x32x16_bf16(b1, q, p1, 0, 0, 0); }
}
__device__ __forceinline__ int v_st(int k, int c) { const int kk = (k & ~0xC) | ((k & 4) << 1) | ((k & 8) >> 1); return ((kk >> 3) * 4 + (c >> 5)) * 512 + ((kk & 7) * 32 + (c & 31)) * 2; }
__device__ __forceinline__ int v_rd_base(int lane) { return ((lane & 3) << 3) | (((lane >> 2) & 3) << 6) | (((lane >> 4) & 1) << 5) | (((lane >> 5) & 1) << 8); }
constexpr int v_rd_off(int d0, int ks, int half) { return d0 * 512 + ks * 4096 + half * 2048; }
template <int D0> __device__ __forceinline__ void mla_pv_one(f32x16& od, const LAS char* vb, bf16x8 pa0, bf16x8 pa1, bf16x8 pa2, bf16x8 pa3) {
    const s16x4 l0 = vtr(vb + v_rd_off(D0, 0, 0)), h0 = vtr(vb + v_rd_off(D0, 0, 1)), l1 = vtr(vb + v_rd_off(D0, 1, 0)), h1 = vtr(vb + v_rd_off(D0, 1, 1));
    const s16x4 l2 = vtr(vb + v_rd_off(D0, 2, 0)), h2 = vtr(vb + v_rd_off(D0, 2, 1)), l3 = vtr(vb + v_rd_off(D0, 3, 0)), h3 = vtr(vb + v_rd_off(D0, 3, 1));
#define PKV(L, H) (bf16x8){L[0], L[1], L[2], L[3], H[0], H[1], H[2], H[3]}
    od = __builtin_amdgcn_mfma_f32_32x32x16_bf16(pa0, PKV(l0, h0), od, 0, 0, 0);
    od = __builtin_amdgcn_mfma_f32_32x32x16_bf16(pa1, PKV(l1, h1), od, 0, 0, 0);
    od = __builtin_amdgcn_mfma_f32_32x32x16_bf16(pa2, PKV(l2, h2), od, 0, 0, 0);
    od = __builtin_amdgcn_mfma_f32_32x32x16_bf16(pa3, PKV(l3, h3), od, 0, 0, 0);
#undef PKV
}
__device__ __forceinline__ void mla_pv(f32x16* o, const LAS char* vb, bf16x8 pa0, bf16x8 pa1, bf16x8 pa2, bf16x8 pa3) {
    mla_pv_one<0>(o[0], vb, pa0, pa1, pa2, pa3); mla_pv_one<1>(o[1], vb, pa0, pa1, pa2, pa3); mla_pv_one<2>(o[2], vb, pa0, pa1, pa2, pa3); mla_pv_one<3>(o[3], vb, pa0, pa1, pa2, pa3);
}
__device__ __forceinline__ void mla_unit(const Params& p, LAS char* lds, int u) {
    const int tid = threadIdx.x, wid = __builtin_amdgcn_readfirstlane(tid >> 6), lane = tid & 63, r32 = lane & 31, hi = lane >> 5;
    const int bh = u >> 4, qb = u & 15, b = bh >> 3, h = bh & 7;
    const bf16_t* QB = (const bf16_t*)(p.ws + WS_QB); const bf16_t* KVB = (const bf16_t*)(p.ws + WS_KVB); const bf16_t* KPE = (const bf16_t*)(p.ws + WS_KPE);
    const bf16_t* Kh = KVB + (size_t)b * SEQ * 2048 + h * 256;
    const bf16_t* Ph = KPE + (size_t)b * SEQ * 64;
    LAS float* wsf = (LAS float*)(lds + MB_WS) + wid * 64; LAS float* li_l = wsf; LAS float* al_l = wsf + 32;
    float m_reg = -1e30f, l_reg = 0; f32x16 o[4] = {}; bf16x8 qr[8];
    LAS char* qp = lds + MB_QP + wid * 4096 + lane * 16;
    { const bf16_t* Qw = QB + ((size_t)(b * SEQ + qb * 256 + wid * 32 + r32)) * 1536 + h * 192 + hi * 8;
#pragma unroll
      for (int d0 = 0; d0 < 8; ++d0) qr[d0] = *(const bf16x8*)(Qw + d0 * 16);
      __syncthreads();
#pragma unroll
      for (int d0 = 0; d0 < 4; ++d0) *(LAS bf16x8*)(qp + d0 * 1024) = *(const bf16x8*)(Qw + (8 + d0) * 16); }
    const int sr = tid >> 4, sc = (tid & 15) * 8, vst0 = v_st(sr, sc), vst1 = v_st(32 + sr, sc);
    const int pr = tid >> 3, pc = (tid & 7) * 8;
    const LAS char* vb0 = lds + MB_V + v_rd_base(lane);
    bf16x8 vs0, vs1, ks0, ks1, kp0;
#define SLOAD(k0) do { vs0 = *(const bf16x8*)(Kh + (size_t)((k0) + sr) * 2048 + 128 + sc); vs1 = *(const bf16x8*)(Kh + (size_t)((k0) + 32 + sr) * 2048 + 128 + sc); \
    ks0 = *(const bf16x8*)(Kh + (size_t)((k0) + sr) * 2048 + sc); ks1 = *(const bf16x8*)(Kh + (size_t)((k0) + 32 + sr) * 2048 + sc); \
    kp0 = *(const bf16x8*)(Ph + (size_t)((k0) + pr) * 64 + pc); } while (0)
#define SWRITE(bb) do { *(LAS bf16x8*)(lds + MB_V + (bb) * 16384 + vst0) = vs0; *(LAS bf16x8*)(lds + MB_V + (bb) * 16384 + vst1) = vs1; \
    *(LAS bf16x8*)(lds + MB_KN + (bb) * 16384 + KSWZ(sr, sc * 2)) = ks0; *(LAS bf16x8*)(lds + MB_KN + (bb) * 16384 + KSWZ(32 + sr, sc * 2)) = ks1; \
    *(LAS bf16x8*)(lds + MB_KP + (bb) * 8192 + KPSWZ(pr, pc * 2)) = kp0; } while (0)
#define RESC(a) do { if (__any((a) < 1.f)) { if (hi == 0) al_l[r32] = (a); WAIT_L0(); \
    _Pragma("unroll") for (int d = 0; d < 4; ++d) _Pragma("unroll") for (int r = 0; r < 16; ++r) o[d][r] *= al_l[crow(r, hi)]; } } while (0)
    f32x16 pA0, pA1, pB0, pB1; float mnA, mnB, alA, alB; bf16x8 pa0, pa1, pa2, pa3; constexpr int NT = SEQ / 64;
    SLOAD(0); SWRITE(0); __syncthreads();
    mla_qkt(pA0, pA1, lds + MB_KN, lds + MB_KP, qr, qp, r32, hi); mla_partialSM(pA0, pA1, m_reg, mnA, alA);
    SLOAD(64); SWRITE(1); __syncthreads();
    for (int j = 1; j + 1 < NT; j += 2) {
        SBAR(); mla_qkt(pB0, pB1, lds + MB_KN + 16384, lds + MB_KP + 8192, qr, qp, r32, hi);
        mla_finishSM(pA0, pA1, alA, l_reg, pa0, pa1, pa2, pa3); SBAR();
        SLOAD((j + 1) * 64); SBAR();
        mla_pv(o, vb0, pa0, pa1, pa2, pa3); mla_partialSM(pB0, pB1, m_reg, mnB, alB);
        __syncthreads(); SWRITE(0);
        RESC(alB); __syncthreads();
        SBAR(); mla_qkt(pA0, pA1, lds + MB_KN, lds + MB_KP, qr, qp, r32, hi);
        mla_finishSM(pB0, pB1, alB, l_reg, pa0, pa1, pa2, pa3); SBAR();
        SLOAD((j + 2) * 64); SBAR();
        mla_pv(o, vb0 + 16384, pa0, pa1, pa2, pa3); mla_partialSM(pA0, pA1, m_reg, mnA, alA);
        __syncthreads(); SWRITE(1);
        RESC(alA); __syncthreads();
    }
    SBAR(); mla_qkt(pB0, pB1, lds + MB_KN + 16384, lds + MB_KP + 8192, qr, qp, r32, hi);
    mla_finishSM(pA0, pA1, alA, l_reg, pa0, pa1, pa2, pa3); SBAR();
    mla_pv(o, vb0, pa0, pa1, pa2, pa3); mla_partialSM(pB0, pB1, m_reg, mnB, alB);
    __syncthreads(); RESC(alB);
    mla_finishSM(pB0, pB1, alB, l_reg, pa0, pa1, pa2, pa3); SBAR();
    mla_pv(o, vb0 + 16384, pa0, pa1, pa2, pa3);
    if (hi == 0) li_l[r32] = l_reg; WAIT_L0();
    bf16_t* Y = (bf16_t*)(p.ws + WS_Y); float* ssqb = (float*)(p.ws + WS_SSQP);
    const float* gb = p.out_norm_b + h * 128;
    float g[4];
#pragma unroll
    for (int d0 = 0; d0 < 4; ++d0) g[d0] = gb[d0 * 32 + r32];
#pragma unroll
    for (int r = 0; r < 16; ++r) { const int orow = crow(r, hi); const float il = __builtin_amdgcn_rcpf(li_l[orow]);
        const size_t tok = (size_t)(b * SEQ + qb * 256 + wid * 32 + orow); bf16_t* yp = Y + tok * 2048 + 1024 + h * 128; float ss = 0.f;
#pragma unroll
        for (int d0 = 0; d0 < 4; ++d0) { const float v = o[d0][r] * il; ss += v * v; yp[d0 * 32 + r32] = (bf16_t)(pk_bf16(v * g[d0], 0.f) & 0xffffu); }
#pragma unroll
        for (int s = 16; s >= 1; s >>= 1) ss += __shfl_xor(ss, s, 64);
        if (r32 == 0) ssqb[tok * 24 + 16 + h] = ss; }
#undef SLOAD
#undef SWRITE
#undef RESC
}

__device__ __forceinline__ void phase_router(const Params& p, LAS char* lds) {
    const int tid = threadIdx.x, wid = __builtin_amdgcn_readfirstlane(tid >> 6), lane = tid & 63;
    const float* x2 = (const float*)(p.ws + WS_X2); const float* wg = (const float*)(p.ws + WS_WRT);
    unsigned char* xn8 = p.ws + WS_XN; unsigned* cnt = (unsigned*)(p.ws + WS_CTL + CTL_CNT);
    int* tokl = (int*)(p.ws + WS_TOKL); int* sel_e = (int*)(p.ws + WS_SEL); int* sel_r = sel_e + NTOK * 4; float* sel_g = (float*)(sel_r + NTOK * 4);
    LAS float* part = (LAS float*)lds;
    LAS float* rsv = (LAS float*)(lds + 32768);
    LAS unsigned* hist = (LAS unsigned*)(lds + 32768 + 128); LAS unsigned* hbase = hist + 32;
    for (int t0 = blockIdx.x * 32; t0 < NTOK; t0 += gridDim.x * 32) {
        __syncthreads();
        if (tid < N_EXP) hist[tid] = 0u;
#pragma unroll 1
        for (int j = 0; j < 4; ++j) { const int t = t0 + 4 * wid + j; f32x4 xr[8]; float ss = 0.f;
#pragma unroll
            for (int i = 0; i < 8; ++i) { xr[i] = ((const f32x4*)(x2 + (size_t)t * D_MODEL))[lane + 64 * i]; ss += xr[i][0] * xr[i][0] + xr[i][1] * xr[i][1] + xr[i][2] * xr[i][2] + xr[i][3] * xr[i][3]; }
            const float rs = rsqrtf(wave_sum(ss) * (1.f / D_MODEL) + EPS);
            if (lane == 0) rsv[4 * wid + j] = rs;
#pragma unroll
            for (int i = 0; i < 8; ++i) { const f32x4 v = xr[i]; const f32x4 g = ((const f32x4*)p.mlp_norm)[lane + 64 * i]; const float s16 = 16.f * rs;
                *(unsigned*)(xn8 + (size_t)t * D_MODEL + 4 * (lane + 64 * i)) = pk4_fp8(s16 * v[0] * g[0], s16 * v[1] * g[1], s16 * v[2] * g[2], s16 * v[3] * g[3]); } }
        { f32x16 acc;
#pragma unroll
          for (int r = 0; r < 16; ++r) acc[r] = 0.f;
          const float* ap = x2 + (size_t)(t0 + (lane & 31)) * D_MODEL + 256 * wid + 4 * (lane >> 5);
          const float* bp = wg + (size_t)(256 * wid + 4 * (lane >> 5)) * N_EXP + (lane & 31);
#pragma unroll 4
          for (int c = 0; c < 32; ++c) { const f32x4 a4 = *(const f32x4*)(ap + 8 * c);
#pragma unroll
              for (int q = 0; q < 4; ++q) acc = __builtin_amdgcn_mfma_f32_32x32x2f32(a4[q], bp[(size_t)(8 * c + q) * N_EXP], acc, 0, 0, 0); }
#pragma unroll
          for (int r = 0; r < 16; ++r) part[wid * 1024 + crow(r, lane >> 5) * 32 + (lane & 31)] = acc[r]; }
        __syncthreads();
        int my_e[4]; unsigned my_lr[4]; float my_g[4];
#pragma unroll
        for (int j = 0; j < 4; ++j) { const int tl = 4 * wid + j;
            float v = -3.0e38f;
            if (lane < 32) { float s = 0.f;
#pragma unroll
                for (int w = 0; w < 8; ++w) s += part[w * 1024 + tl * 32 + lane];
                v = s * rsv[tl] + p.b_router[lane]; }
            float tv[4]; int ti[4];
#pragma unroll
            for (int r = 0; r < 4; ++r) {
                float bv = v; int bi = lane;
#pragma unroll
                for (int o = 32; o >= 1; o >>= 1) { const float ov = __shfl_xor(bv, o, 64); const int oi = __shfl_xor(bi, o, 64); if (ov > bv || (ov == bv && oi < bi)) { bv = ov; bi = oi; } }
                tv[r] = bv; ti[r] = bi; if (lane == bi) v = -3.0e38f;
            }
            const float e0 = 1.f, e1 = __expf(tv[1] - tv[0]), e2 = __expf(tv[2] - tv[0]), e3 = __expf(tv[3] - tv[0]); const float inv = 1.f / (e0 + e1 + e2 + e3);
            const float gts[4] = {e0 * inv, e1 * inv, e2 * inv, e3 * inv};
            my_e[j] = ti[lane & 3]; my_g[j] = gts[lane & 3]; my_lr[j] = 0u;
            if (lane < 4) my_lr[j] = __hip_atomic_fetch_add(hist + my_e[j], 1u, __ATOMIC_RELAXED, __HIP_MEMORY_SCOPE_WORKGROUP);
        }
        __syncthreads();
        if (tid < N_EXP) hbase[tid] = atomicAdd(cnt + tid * 16, hist[tid]);
        __syncthreads();
        if (lane < 4) {
#pragma unroll
            for (int j = 0; j < 4; ++j) { const int t = t0 + 4 * wid + j; const int e = my_e[j]; const unsigned rk = hbase[e] + my_lr[j];
                tokl[e * NTOK + rk] = t; sel_e[t * 4 + lane] = e; sel_r[t * 4 + lane] = (int)rk; sel_g[t * 4 + lane] = my_g[j]; }
        }
    }
}

__device__ __forceinline__ void phase_combine(const Params& p, const LAS int* s_roff) {
    const int tid = threadIdx.x, wid = tid >> 6, lane = tid & 63;
    const float* x2 = (const float*)(p.ws + WS_X2); const bf16_t* ys = (const bf16_t*)(p.ws + WS_YS);
    const int* sel_e = (const int*)(p.ws + WS_SEL); const int* sel_r = sel_e + NTOK * 4; const float* sel_g = (const float*)(sel_r + NTOK * 4);
    for (int t = blockIdx.x * 8 + wid; t < NTOK; t += gridDim.x * 8) {
        f32x4 v[8];
#pragma unroll
        for (int i = 0; i < 8; ++i) v[i] = ((const f32x4*)(x2 + (size_t)t * D_MODEL))[lane + 64 * i];
#pragma unroll
        for (int k = 0; k < 4; ++k) { const int e = sel_e[t * 4 + k]; const size_t slot = (size_t)(s_roff[e] + sel_r[t * 4 + k]); const float g = sel_g[t * 4 + k];
            const u32x2* yr = (const u32x2*)(ys + slot * D_MODEL);
#pragma unroll
            for (int i = 0; i < 8; ++i) { const u32x2 w = yr[lane + 64 * i]; v[i][0] += g * bf_lo(w[0]); v[i][1] += g * bf_hi(w[0]); v[i][2] += g * bf_lo(w[1]); v[i][3] += g * bf_hi(w[1]); } }
        float ss = 0.f;
#pragma unroll
        for (int i = 0; i < 8; ++i) ss += v[i][0] * v[i][0] + v[i][1] * v[i][1] + v[i][2] * v[i][2] + v[i][3] * v[i][3];
        ss = wave_sum(ss); const float rs = rsqrtf(ss * (1.f / D_MODEL) + EPS);
#pragma unroll
        for (int i = 0; i < 8; ++i) { const f32x4 g = ((const f32x4*)p.final_norm)[lane + 64 * i];
            ((f32x4*)(p.out + (size_t)t * D_MODEL))[lane + 64 * i] = (f32x4){v[i][0] * rs * g[0], v[i][1] * rs * g[1], v[i][2] * rs * g[2], v[i][3] * rs * g[3]}; }
    }
}

constexpr int NPHASE = 9;
__global__ void __launch_bounds__(512, 2) mega_fwd(Params p) {
    extern __shared__ __attribute__((aligned(1024))) char smem_raw[];
    LAS char* lds = (LAS char*)smem_raw;
    LAS unsigned* misc = (LAS unsigned*)(lds + LDS_MISC);
    const int tid = threadIdx.x;
    if (tid < 4) misc[tid] = 0u;
    __syncthreads();
    unsigned* bar = (unsigned*)(p.ws + WS_CTL + CTL_BAR);
    XcdBarrier xb = xcd_barrier_post(bar, (volatile LAS unsigned*)misc);
    const int lo = p.ph_lo, hi = p.ph_hi;
    const int G = gridDim.x, bid = blockIdx.x;
    const int xperm = (bid & 7) * (G >> 3) + (bid >> 3);
#ifdef PH_ONLY
#define IN(k) ((k)==PH_ONLY)
#else
#define IN(k) (lo <= (k) && (k) < hi)
#endif
#define SEAM(k) do { if (IN(k) && IN((k) + 1)) xcd_barrier(xb); } while (0)
    if (IN(0)) phase_prologue(p);
    SEAM(0);
    if (IN(1)) {
        for (int u = xperm; u < 32 * 8; u += G) {
            const int pn = u / 32, pm = u % 32;
            PEpiProj ep{pn, pm * 256, p.ws, p.b_q_norm, p.b_kv_norm};
            __syncthreads();
            gemm_unit_pg<false>(lds, (const bf16_t*)(p.ws + WS_XN) + (size_t)pm * 256 * D_MODEL, (const bf16_t*)(p.ws + WS_BT_IN) + (size_t)pn * 256 * D_MODEL, D_MODEL, ep);
        }
    }
    SEAM(1);
    if (IN(2)) {
        { const int b0 = bid;
            int qv;
            if ((b0 & 3) == 0) {
                const int h = b0 >> 2, pn = 8 + (h >> 5), pm = h & 31;
                PEpiProj ep{pn, pm * 256, p.ws, p.b_q_norm, p.b_kv_norm};
                __syncthreads();
                gemm_unit_pg<false>(lds, (const bf16_t*)(p.ws + WS_XN) + (size_t)pm * 256 * D_MODEL, (const bf16_t*)(p.ws + WS_BT_IN) + (size_t)pn * 256 * D_MODEL, D_MODEL, ep);
                qv = 128 + h;
            } else {
                const int v = (b0 >> 2) * 3 + (b0 & 3) - 1;
                if (v < 128) {
                    attn_a_unit(p, lds, v); qv = v;
                    pg_convert(p.w_o, D_MODEL, D_MODEL, D_MODEL, 2048, (bf16_t*)(p.ws + WS_BT_WO), v * 1024 + tid, 128 * 1024);
                    pg_convert(p.w_o, D_MODEL, D_MODEL, D_MODEL, 2048, (bf16_t*)(p.ws + WS_BT_WO), v * 1024 + 512 + tid, 128 * 1024);
                } else {
                    const int w = v - 128; qv = -1;
                    attn_a_unit(p, lds, 128 + 2 * w); attn_a_unit(p, lds, 129 + 2 * w);
                    if (w < 32) pg_convert(p.b_w_ukv, 256, 2048, 2048, 2048, (bf16_t*)(p.ws + WS_BT_UKV), w * 512 + tid, 32 * 512);
                }
            }
            if (qv >= 0) { const int pn = qv / 32, pm = qv % 32;
                PEpiQUp ep{pn, pm * 256, p.ws};
                __syncthreads();
                gemm_unit_pg<false>(lds, (const bf16_t*)(p.ws + WS_CQ) + (size_t)pm * 256 * 512, (const bf16_t*)(p.ws + WS_BT_UQ) + (size_t)pn * 256 * 512, 512, ep);
                __syncthreads(); }
        }
        xcd_barrier(xb);
        for (int u = xperm; u < 32 * 8; u += G) {
            const int pn = u / 32, pm = u % 32;
            PEpiKvUp ep{pn, pm * 256, p.ws};
            __syncthreads();
            gemm_unit_pg<false>(lds, (const bf16_t*)(p.ws + WS_CKV) + (size_t)pm * 256 * 256, (const bf16_t*)(p.ws + WS_BT_UKV) + (size_t)pn * 256 * 256, 256, ep);
        }
    }
    SEAM(2);
    if (IN(3)) { for (int u = xperm; u < 256; u += G) mla_unit(p, lds, u); }
    SEAM(3);
    if (IN(4)) {
        __syncthreads();
        for (int u = xperm; u < 32 * 8; u += G) {
            const int pn = u / 32, pm = u % 32;
            LAS float* tab = (LAS float*)(lds + 2 * G_STAGE_B);
            __syncthreads();
            if (tid < 256) { const f32x4* pp = (const f32x4*)((const float*)(p.ws + WS_SSQP) + (size_t)(pm * 256 + tid) * 24); float sa = 0.f, sb2 = 0.f;
#pragma unroll
                for (int q = 0; q < 4; ++q) { const f32x4 v = pp[q]; sa += (v[0] + v[1]) + (v[2] + v[3]); }
#pragma unroll
                for (int q = 4; q < 6; ++q) { const f32x4 v = pp[q]; sb2 += (v[0] + v[1]) + (v[2] + v[3]); }
                tab[tid] = sa * (1.f / 1024.f); tab[256 + tid] = sb2 * (1.f / 1024.f); }
            __syncthreads();
            PEpiWo ep{pn, pm * 256, p.ws, p.x, tab};
            gemm_unit_pg<true>(lds, (const bf16_t*)(p.ws + WS_Y) + (size_t)pm * 256 * D_MODEL, (const bf16_t*)(p.ws + WS_BT_WO) + (size_t)pn * 256 * D_MODEL, D_MODEL, ep);
        }
    }
    SEAM(4);
    if (IN(5)) phase_router(p, lds);
    SEAM(5);
    LAS int* s_cnt = (LAS int*)(misc + 16); LAS int* s_toff = (LAS int*)(misc + 48); LAS int* s_roff = (LAS int*)(misc + 96);
    if (IN(6) || IN(7) || IN(8)) {
        if (tid == 0) { const unsigned* cnt = (const unsigned*)(p.ws + WS_CTL + CTL_CNT); int to = 0;
            for (int e = 0; e < N_EXP; ++e) { const int c = (int)xb_ld((unsigned*)cnt + e * 16); s_cnt[e] = c; s_toff[e] = to; s_roff[e] = to * 256; to += (c + 255) >> 8; }
            s_toff[N_EXP] = to; }
        __syncthreads();
    }
    if (IN(6)) {
        const int TM = s_toff[N_EXP];
        const int T16 = TM * 16, NF = (T16 & ~255), R = T16 - NF;
        const bool halves = R > 0 && R <= 128;
        int round = 0;
        for (int L = xperm; L < (halves ? NF : T16); L += G, ++round) {
            if (round == ((xperm >> 3) & 7))
                conv_image(p.w_down + (size_t)(xperm >> 3) * D_FF * D_MODEL + (xperm & 7) * 256, (size_t)D_MODEL, p.ws + WS_IMG_DN + (size_t)xperm * 32 * 16384, 0, 32);
            int e = 0; while (s_toff[e + 1] * 16 <= L) ++e;
            const int w = L - s_toff[e] * 16, nte = s_toff[e + 1] - s_toff[e], ntile = w / nte, mt = w - ntile * nte, cntE = s_cnt[e];
            AGather8 af{p.ws + WS_XN, (const int*)(p.ws + WS_TOKL) + (size_t)e * NTOK, mt * 256, cntE};
            BGateUp bf{p.w_up + (size_t)e * D_MODEL * (2 * D_FF) + ntile * 128, (size_t)(2 * D_FF)};
            EpiUp8 ep{ntile * 128, mt * 256, cntE, p.ws + WS_ACT + ((size_t)s_roff[e] + mt * 256) * D_FF, p.b_up + (size_t)e * (2 * D_FF)};
            gemm_unit8<0x7B7B7B7B>(lds, (LAS unsigned*)(misc + 8), D_MODEL / 64, af, bf, ep);
        }
        if (round <= ((xperm >> 3) & 7))
            conv_image(p.w_down + (size_t)(xperm >> 3) * D_FF * D_MODEL + (xperm & 7) * 256, (size_t)D_MODEL, p.ws + WS_IMG_DN + (size_t)xperm * 32 * 16384, 0, 32);
        if (halves && xperm < 2 * R) {
            const int L = NF + (xperm >> 1), hf = xperm & 1;
            int e = 0; while (s_toff[e + 1] * 16 <= L) ++e;
            const int w = L - s_toff[e] * 16, nte = s_toff[e + 1] - s_toff[e], ntile = w / nte, mt = w - ntile * nte, cntE = s_cnt[e];
            AGather8 af{p.ws + WS_XN, (const int*)(p.ws + WS_TOKL) + (size_t)e * NTOK, mt * 256, cntE};
            BGateUp bf{p.w_up + (size_t)e * D_MODEL * (2 * D_FF) + ntile * 128 + hf * 64, (size_t)(2 * D_FF)};
            EpiUp8q ep{ntile * 128 + hf * 64, mt * 256, cntE, p.ws + WS_ACT + ((size_t)s_roff[e] + mt * 256) * D_FF, p.b_up + (size_t)e * (2 * D_FF)};
            gemm_unit8q<0x7B7B7B7B>(lds, (LAS unsigned*)(misc + 8), D_MODEL / 64, af, bf, ep);
        }
    }
    SEAM(6);
    if (IN(7)) {
        const int TM = s_toff[N_EXP];
        const int T8 = TM * 8, NF = T8 & ~255, R = T8 - NF;
        const bool halves = R > 0 && R <= 128;
        for (int L = xperm; L < (halves ? NF : T8); L += G) {
            int e = 0; while (s_toff[e + 1] * 8 <= L) ++e;
            const int w = L - s_toff[e] * 8, nte = s_toff[e + 1] - s_toff[e], ntile = w / nte, mt = w - ntile * nte, cntE = s_cnt[e];
            ARows8 af{p.ws + WS_ACT + ((size_t)s_roff[e] + mt * 256) * D_FF, (unsigned)D_FF};
            EpiDown8 ep{ntile * 256, mt * 256, cntE, (bf16_t*)(p.ws + WS_YS) + ((size_t)s_roff[e] + mt * 256) * D_MODEL, p.b_down + (size_t)e * D_MODEL};
            gemm_unit8b<0x7D7D7D7D>(lds, (LAS unsigned*)(misc + 8), D_FF / 64, af, p.ws + WS_IMG_DN + (size_t)(e * 8 + ntile) * 32 * 16384, ep);
        }
        if (halves && xperm < 2 * R) {
            const int L = NF + (xperm >> 1), hf = xperm & 1;
            int e = 0; while (s_toff[e + 1] * 8 <= L) ++e;
            const int w = L - s_toff[e] * 8, nte = s_toff[e + 1] - s_toff[e], ntile = w / nte, mt = w - ntile * nte, cntE = s_cnt[e];
            ARows8 af{p.ws + WS_ACT + ((size_t)s_roff[e] + mt * 256) * D_FF, (unsigned)D_FF};
            EpiDown8h ep{ntile * 256 + hf * 128, mt * 256, cntE, (bf16_t*)(p.ws + WS_YS) + ((size_t)s_roff[e] + mt * 256) * D_MODEL, p.b_down + (size_t)e * D_MODEL};
            gemm_unit8bh<0x7D7D7D7D>(lds, (LAS unsigned*)(misc + 8), D_FF / 64, af, p.ws + WS_IMG_DN + (size_t)(e * 8 + ntile) * 32 * 16384, hf, ep);
        }
    }
    SEAM(7);
    if (IN(8)) phase_combine(p, s_roff);
}

extern "C" void kernel_launch(void* const* d_in, const int* in_sizes, int n_in, void* d_out, int out_size, void* d_ws, size_t ws_size, hipStream_t stream) {
    static int ready = 0;
    if (!ready) {
        if (hipFuncSetAttribute((const void*)mega_fwd, hipFuncAttributeMaxDynamicSharedMemorySize, LDS_BYTES) != hipSuccess) { fprintf(stderr, "kernel_launch: hipFuncSetAttribute failed\n"); return; }
        int per_cu = 0; hipOccupancyMaxActiveBlocksPerMultiprocessor(&per_cu, (const void*)mega_fwd, 512, LDS_BYTES);
        if (per_cu < 1) { fprintf(stderr, "kernel_launch: occupancy query says 0 blocks per CU\n"); return; }
        ready = 1;
    }
    if (ws_size < WS_END) { fprintf(stderr, "kernel_launch: workspace too small\n"); return; }
    hipMemsetAsync((unsigned char*)d_ws + WS_CTL, 0, CTL_BYTES, stream);
    Params p{};
    const float** f = (const float**)&p;
    for (int i = 0; i < 19; ++i) f[i] = (const float*)d_in[i];
    p.out = (float*)d_out; p.ws = (unsigned char*)d_ws; p.ph_lo = 0; p.ph_hi = NPHASE;
    hipLaunchKernelGGL(mega_fwd, dim3(256), dim3(512), LDS_BYTES, stream, p);
}
```

```cpp
#include <hip/hip_runtime.h>
#include <stdint.h>
#include <stdio.h>

#define LAS __attribute__((address_space(3)))
typedef unsigned short bf16_t;
typedef short bf16x8 __attribute__((ext_vector_type(8)));
typedef short s16x4 __attribute__((ext_vector_type(4)));
typedef short v4i16_t __attribute__((ext_vector_type(4)));
typedef float f32x2 __attribute__((ext_vector_type(2)));
typedef float f32x4 __attribute__((ext_vector_type(4)));
typedef float f32x16 __attribute__((ext_vector_type(16)));
typedef int i32x4 __attribute__((ext_vector_type(4)));
typedef unsigned u32x2 __attribute__((ext_vector_type(2)));
typedef unsigned u32x4 __attribute__((ext_vector_type(4)));
typedef __bf16 bf16x2_t __attribute__((ext_vector_type(2)));
typedef int v8i __attribute__((ext_vector_type(8)));
typedef int v2i __attribute__((ext_vector_type(2)));
typedef short v2s __attribute__((ext_vector_type(2)));

constexpr int D_MODEL = 2048, SEQ = 4096, BATCH = 2, NTOK = BATCH * SEQ;
constexpr int IN_COLS = 2368;
constexpr int N_EXP = 32, TOP_K = 4, D_FF = 2048;
constexpr float EPS = 1e-5f;
constexpr float LOG2E = 1.4426950408889634f;

constexpr size_t MiB = 1u << 20;
constexpr size_t WS_CTL = 0, CTL_BYTES = 1 * MiB;
constexpr size_t WS_XN = 1 * MiB, WS_QA = 33 * MiB, WS_KA = 49 * MiB, WS_VA = 53 * MiB, WS_CQ = 57 * MiB, WS_CKV = 65 * MiB, WS_KPE = 69 * MiB;
constexpr size_t WS_QB = 70 * MiB, WS_KVB = 94 * MiB, WS_Y = 126 * MiB, WS_X2 = 158 * MiB, WS_ROPE = 222 * MiB, WS_WRT = 223 * MiB;
constexpr size_t WS_TOKL = 224 * MiB, WS_SEL = 225 * MiB, WS_ACT = 226 * MiB, WS_YS = 386 * MiB, WS_BT_IN = 546 * MiB, WS_BT_UQ = 558 * MiB, WS_BT_UKV = 560 * MiB, WS_BT_WO = 562 * MiB, WS_SSQ2 = 570 * MiB, WS_IMG_DN = 571 * MiB, WS_END = 699 * MiB;
constexpr size_t WS_SSQP = WS_WRT + 262144;
constexpr size_t WS_SSQC = WS_SSQ2;
constexpr size_t WS_SSQK = WS_SSQ2 + 524288;
constexpr size_t CTL_RDY = 49152;
constexpr size_t CTL_BAR = 0, CTL_CNT = 16384, CTL_SSQ_CQ = 65536, CTL_SSQ_CKV = 98304, CTL_SSQ_A = 131072, CTL_SSQ_B = 163840, CTL_SSQ_X2 = 196608;

__device__ __forceinline__ unsigned pk_bf16(float lo, float hi) { f32x2 v = {lo, hi}; bf16x2_t b = __builtin_convertvector(v, bf16x2_t); return __builtin_bit_cast(unsigned, b); }
__device__ __forceinline__ unsigned pk4_fp8(float a, float b, float c, float d) { int w = __builtin_amdgcn_cvt_pk_fp8_f32(a, b, 0, false); w = __builtin_amdgcn_cvt_pk_fp8_f32(c, d, w, true); return (unsigned)w; }
__device__ __forceinline__ unsigned pk4_fp8_x64(f32x4 v) { v2s r; asm("" : "=v"(r));
    r = __builtin_amdgcn_cvt_scalef32_pk_fp8_f32(r, v[0], v[1], 0.015625f, false); r = __builtin_amdgcn_cvt_scalef32_pk_fp8_f32(r, v[2], v[3], 0.015625f, true); return __builtin_bit_cast(unsigned, r); }
__device__ __forceinline__ float bf_lo(unsigned u) { return __uint_as_float(u << 16); }
__device__ __forceinline__ float bf_hi(unsigned u) { return __uint_as_float(u & 0xffff0000u); }
__device__ __forceinline__ float wave_sum(float v) {
#pragma unroll
    for (int o = 32; o >= 1; o >>= 1) v += __shfl_xor(v, o, 64);
    return v;
}
__device__ __forceinline__ int crow(int r, int hi) { return (r & 3) + 8 * (r >> 2) + 4 * hi; }
__device__ __forceinline__ s16x4 vtr(const LAS char* p) { return __builtin_bit_cast(s16x4, __builtin_amdgcn_ds_read_tr16_b64_v4i16((LAS v4i16_t*)p)); }
#define SBAR() __builtin_amdgcn_sched_barrier(0)

#define XB_TMO      128
#define XB_XCNT(j)  (256  + 64 * (j))
#define XB_XSUB(j)  (1280 + 64 * (j))
#define XB_XGEN(j)  (2304 + 64 * (j))
#define XB_TOP      3328
#define XB_TOPGEN   3392
#define XCD_BAR_WORDS 3456
#define XB_SPIN_CAP (1u << 18)
__device__ __forceinline__ unsigned xb_ld(unsigned* p)              { return __hip_atomic_load(p, __ATOMIC_RELAXED, __HIP_MEMORY_SCOPE_AGENT); }
__device__ __forceinline__ unsigned xb_add(unsigned* p, unsigned v) { return __hip_atomic_fetch_add(p, v, __ATOMIC_RELAXED, __HIP_MEMORY_SCOPE_AGENT); }
__device__ __forceinline__ unsigned xb_xcc_id() { return (unsigned)__builtin_amdgcn_s_getreg((3 << 11) | 20) & 0xFu; }
#define XB_SPIN(cond, bar) do { unsigned _sp = 0; while (cond) { __builtin_amdgcn_s_sleep(1); \
    if ((++_sp & 255u) == 0u) { if (xb_ld(&(bar)[XB_TMO])) break; if (_sp > XB_SPIN_CAP) { atomicAdd(&(bar)[XB_TMO], 1u); break; } } } } while (0)
struct XcdBarrier { unsigned* bar; unsigned x; volatile LAS unsigned* st; };
__device__ __forceinline__ XcdBarrier xcd_barrier_post(unsigned* bar, volatile LAS unsigned* st) {
    XcdBarrier b; b.bar = bar; b.x = xb_xcc_id(); b.st = st;
    if (threadIdx.x == 0) (void)xb_add(&bar[XB_XCNT(b.x)], 1u);
    return b;
}
__device__ __forceinline__ void xcd_barrier_complete(unsigned* bar, unsigned x, unsigned& nloc, unsigned& nx) {
    const unsigned G = gridDim.x * gridDim.y * gridDim.z;
    unsigned sum, cnt, mine, sp = 0u;
    for (;;) {
        sum = 0u; cnt = 0u; mine = 0u;
#pragma unroll
        for (unsigned j = 0; j < 16; ++j) { const unsigned c = xb_ld(&bar[XB_XCNT(j)]); sum += c; cnt += (c > 0u) ? 1u : 0u; mine = (j == x) ? c : mine; }
        if (sum == G) break;
        __builtin_amdgcn_s_sleep(1);
        if ((++sp & 255u) == 0u) { if (xb_ld(&bar[XB_TMO])) break; if (sp > XB_SPIN_CAP) { atomicAdd(&bar[XB_TMO], 1u); break; } }
    }
    nloc = mine > 0u ? mine : 1u; nx = cnt > 0u ? cnt : 1u;
}
__device__ __forceinline__ void xcd_barrier(const XcdBarrier& b) {
    asm volatile("s_waitcnt vmcnt(0)" ::: "memory");
    __syncthreads();
    if (threadIdx.x == 0) {
        unsigned* bar = b.bar;
        __builtin_amdgcn_s_waitcnt(0);
        unsigned nloc = b.st[0], nx = b.st[1];
        if (nloc == 0u) { xcd_barrier_complete(bar, b.x, nloc, nx); b.st[0] = nloc; b.st[1] = nx; }
        const unsigned old = xb_add(&bar[XB_XSUB(b.x)], 1u);
        const unsigned gen = old / nloc;
        if (old + 1u == (gen + 1u) * nloc) {
            __builtin_amdgcn_fence(__ATOMIC_RELEASE, "agent");
            asm volatile("s_waitcnt vmcnt(0)" ::: "memory");
            const unsigned og = xb_add(&bar[XB_TOP], 1u);
            const unsigned tg = og / nx;
            if (og + 1u == (tg + 1u) * nx) xb_add(&bar[XB_TOPGEN], 1u);
            else XB_SPIN(xb_ld(&bar[XB_TOPGEN]) == tg, bar);
            __builtin_amdgcn_fence(__ATOMIC_ACQUIRE, "agent");
            xb_add(&bar[XB_XGEN(b.x)], 1u);
            asm volatile("s_waitcnt vmcnt(0)" ::: "memory");
        } else {
            XB_SPIN(xb_ld(&bar[XB_XGEN(b.x)]) == gen, bar);
            __builtin_amdgcn_fence(__ATOMIC_ACQUIRE, "agent");
            asm volatile("s_waitcnt vmcnt(0)" ::: "memory");
        }
    }
    __syncthreads();
}

constexpr int A_TILE_B = 256 * 64 * 2;
constexpr int B_PITCH = 544;
constexpr int B_TILE_B = 64 * B_PITCH;
constexpr int G_STAGE_B = A_TILE_B + B_TILE_B;
constexpr int LDS_MISC = 155648;
constexpr int LDS_BYTES = LDS_MISC + 1024;

__device__ __forceinline__ int a_img_byte(int r, int chunk) { return r * 128 + ((chunk ^ ((r >> 1) & 7)) << 4); }
#define WAIT_L0() asm volatile("s_waitcnt lgkmcnt(0)" ::: "memory")
__device__ __forceinline__ void glds16(const void* gsrc, unsigned lds_dst) { unsigned keep;
    asm volatile("s_mov_b32 %0, m0\n\ts_mov_b32 m0, %2\n\ts_nop 0\n\tglobal_load_lds_dwordx4 %1, off\n\ts_mov_b32 m0, %0" : "=&s"(keep) : "v"(gsrc), "s"(lds_dst) : "memory"); }
#define RAW_BARRIER() do { WAIT_L0(); __builtin_amdgcn_s_barrier(); } while (0)

__device__ __forceinline__ const char* uniform_ptr(const void* p) {
    const unsigned long long v = (unsigned long long)p;
    const unsigned lo = __builtin_amdgcn_readfirstlane((unsigned)v), hi = __builtin_amdgcn_readfirstlane((unsigned)(v >> 32));
    return (const char*)(((unsigned long long)hi << 32) | lo);
}
__device__ __forceinline__ void glds16s(const char* sbase, unsigned voff, unsigned lds_dst) { unsigned keep;
    asm volatile("s_mov_b32 %0, m0\n\ts_mov_b32 m0, %3\n\ts_nop 4\n\tglobal_load_lds_dwordx4 %1, %2\n\ts_mov_b32 m0, %0" : "=&s"(keep) : "v"(voff), "s"(sbase), "s"(lds_dst) : "memory"); }
#define WAIT_V4(n, a, b, c, d) asm volatile("s_waitcnt vmcnt(" #n ")" : "+v"(a), "+v"(b), "+v"(c), "+v"(d) :: "memory")
template <bool MID, class AF, class BF, class EPI>
__device__ __forceinline__ void gemm_unit(LAS char* lds, const int nt, const AF& af, const BF& bf, EPI& epi) {
    const int tid = threadIdx.x, wid = __builtin_amdgcn_readfirstlane(tid >> 6), lane = tid & 63, wr = wid >> 2, wc = wid & 3, fr = lane & 15, fq = lane >> 4;
    const char* abase = uniform_ptr(af.base);
    unsigned aoff[4];
#pragma unroll
    for (int i = 0; i < 4; ++i) { const int R = wid * 8 + i * 64 + (lane >> 3), C = ((lane & 7) ^ ((R >> 1) & 7)) * 8; aoff[i] = (af.rowoff(R) + (unsigned)C) * 2u; }
    const int a_ldsw = wid * 1024;
    const unsigned lds_u = (unsigned)__builtin_amdgcn_readfirstlane((int)(unsigned)(size_t)lds);
    const size_t ldb4 = (size_t)bf.ld * 4;
    const char* bbase = uniform_ptr(bf.base) + (size_t)wid * ldb4;
    const unsigned boff = bf.coloff(4 * lane) * 4u;
    const int b_lds0 = A_TILE_B + wid * B_PITCH + 8 * lane, b_lds1 = A_TILE_B + wid * B_PITCH + ((8 * lane) ^ 128);
    const int a_rd0 = a_img_byte(wr * 128 + fr, fq), a_rd1 = a_rd0 ^ 64;
    const int b_rd = A_TILE_B + (8 * fq + ((lane & 15) >> 2)) * B_PITCH + ((wc ^ (fq & 1)) << 7) + 8 * (lane & 3);
    f32x4 acc[8][4];
#pragma unroll
    for (int m = 0; m < 8; ++m)
#pragma unroll
        for (int n = 0; n < 4; ++n) acc[m][n] = (f32x4){0.f, 0.f, 0.f, 0.f};
    f32x4 sb[8];
#define G_STAGE_A(i, kt, buf) glds16s(abase + (size_t)(kt) * 128, aoff[i], lds_u + (unsigned)((buf) * G_STAGE_B + a_ldsw + (i) * 8192))
#define G_ISSUE_B(i, kt) asm volatile("s_nop 4\n\tglobal_load_dwordx4 %0, %1, %2" : "=v"(sb[i]) : "v"(boff), "s"(bbase + ((size_t)(kt) * 64 + (i) * 8) * ldb4) : "memory")
#define G_WRITE_B(i, buf) do { u32x2 w_ = {pk_bf16(sb[i][0], sb[i][1]), pk_bf16(sb[i][2], sb[i][3])}; \
        *(LAS u32x2*)(lds + (buf) * G_STAGE_B + (((i) & 1) ? b_lds1 : b_lds0) + (i) * 8 * B_PITCH) = w_; } while (0)
#define G_KSTEP(buf, ks) do { bf16x8 At[8], Bf[4]; \
        _Pragma("unroll") for (int n = 0; n < 4; ++n) { const s16x4 lo_ = vtr(lds + (buf) * G_STAGE_B + b_rd + (ks) * 32 * B_PITCH + n * 32), hi_ = vtr(lds + (buf) * G_STAGE_B + b_rd + (ks) * 32 * B_PITCH + 4 * B_PITCH + n * 32); \
            Bf[n] = (bf16x8){lo_[0], lo_[1], lo_[2], lo_[3], hi_[0], hi_[1], hi_[2], hi_[3]}; } \
        _Pragma("unroll") for (int m = 0; m < 8; ++m) At[m] = *(const LAS bf16x8*)(lds + (buf) * G_STAGE_B + ((ks) ? a_rd1 : a_rd0) + m * 2048); \
        SBAR(); __builtin_amdgcn_s_setprio(1); \
        _Pragma("unroll") for (int m = 0; m < 8; ++m) _Pragma("unroll") for (int n = 0; n < 4; ++n) \
            acc[m][n] = __builtin_amdgcn_mfma_f32_16x16x32_bf16(Bf[n], At[m], acc[m][n], 0, 0, 0); \
        __builtin_amdgcn_s_setprio(0); SBAR(); } while (0)
#pragma unroll
    for (int i = 0; i < 4; ++i) G_STAGE_A(i, 0, 0);
#pragma unroll
    for (int i = 0; i < 8; ++i) G_ISSUE_B(i, 0);
    WAIT_V4(0, sb[0], sb[1], sb[2], sb[3]); WAIT_V4(0, sb[4], sb[5], sb[6], sb[7]);
#pragma unroll
    for (int i = 0; i < 8; ++i) G_WRITE_B(i, 0);
    SBAR();
#pragma unroll
    for (int i = 0; i < 8; ++i) G_ISSUE_B(i, 1);
    SBAR();
    RAW_BARRIER();
#pragma unroll 1
    for (int t = 0; t < nt; ++t) {
        const int cur = t & 1, nxt = cur ^ 1;
        if constexpr (MID) { if (t == (nt >> 1)) epi.mid(acc, wr, wc, fr, fq); }
        const int k1 = (t + 1 < nt) ? t + 1 : nt - 1, k2 = (t + 2 < nt) ? t + 2 : nt - 1;
        G_STAGE_A(0, k1, nxt); G_STAGE_A(1, k1, nxt); G_STAGE_A(2, k1, nxt); G_STAGE_A(3, k1, nxt);
        G_KSTEP(cur, 0);
        WAIT_V4(8, sb[0], sb[1], sb[2], sb[3]);
        G_WRITE_B(0, nxt); G_WRITE_B(1, nxt); G_WRITE_B(2, nxt); G_WRITE_B(3, nxt); SBAR();
        G_ISSUE_B(0, k2); G_ISSUE_B(1, k2); G_ISSUE_B(2, k2); G_ISSUE_B(3, k2); SBAR();
        G_KSTEP(cur, 1);
        WAIT_V4(8, sb[4], sb[5], sb[6], sb[7]);
        G_WRITE_B(4, nxt); G_WRITE_B(5, nxt); G_WRITE_B(6, nxt); G_WRITE_B(7, nxt); SBAR();
        G_ISSUE_B(4, k2); G_ISSUE_B(5, k2); G_ISSUE_B(6, k2); G_ISSUE_B(7, k2); SBAR();
        asm volatile("s_waitcnt vmcnt(8)" ::: "memory");
        RAW_BARRIER();
    }
    WAIT_V4(0, sb[0], sb[1], sb[2], sb[3]); WAIT_V4(0, sb[4], sb[5], sb[6], sb[7]);
    epi.fin(acc, wr, wc, fr, fq);
#undef G_STAGE_A
#undef G_ISSUE_B
#undef G_WRITE_B
#undef G_KSTEP
}

constexpr int A8_TILE_B = 16384, B8_PITCH = 288, B8_TILE_B = 64 * B8_PITCH;
constexpr int A8_RING = 5, B8_RING = 4, B8_OFF = A8_RING * A8_TILE_B;
static_assert(B8_OFF + B8_RING * B8_TILE_B <= LDS_MISC, "fp8 rings fit below the misc words");
__device__ __forceinline__ v2i vtr8(const LAS char* p) { return __builtin_amdgcn_ds_read_tr8_b64_v2i32((LAS v2i*)p); }
template <int SCALE_X, class AF, class BF, class EPI>
__device__ __forceinline__ void gemm_unit8(LAS char* lds, LAS unsigned* ring_cnt, const int nt, const AF& af, const BF& bf, EPI& epi) {
    const int tid = threadIdx.x, wid = __builtin_amdgcn_readfirstlane(tid >> 6), lane = tid & 63, wr = wid >> 2, wc = wid & 3, r32 = lane & 31, hi = lane >> 5;
    const char* abase = uniform_ptr(af.base);
    unsigned aoff[2];
#pragma unroll
    for (int i = 0; i < 2; ++i) { const int R = wid * 16 + i * 128 + (lane >> 2), C = ((lane & 3) ^ ((lane >> 4) & 3)) * 16; aoff[i] = af.rowoff(R) + (unsigned)C; }
    const unsigned lds_u = (unsigned)__builtin_amdgcn_readfirstlane((int)(unsigned)(size_t)lds) + (unsigned)(wid * 1024);
    const size_t ldb4 = (size_t)bf.ld * 4;
    const char* bbase = uniform_ptr(bf.base) + (size_t)wid * ldb4;
    const unsigned boff = bf.coloff(4 * lane) * 4u;
    const int b_wr = B8_OFF + wid * B8_PITCH + 4 * lane;
    const int a_rd0 = (wr * 128 + r32) * 64 + (((2 * hi) ^ ((r32 >> 2) & 3)) << 4), a_rd1 = a_rd0 ^ 16;
    const int b_rd = B8_OFF + (32 * hi + ((lane & 15) >> 1)) * B8_PITCH + wc * 64 + 16 * ((lane >> 4) & 1) + 8 * (lane & 1);
    f32x16 acc[4][2];
#pragma unroll
    for (int m = 0; m < 4; ++m)
#pragma unroll
        for (int n = 0; n < 2; ++n)
#pragma unroll
            for (int r = 0; r < 16; ++r) acc[m][n][r] = 0.f;
    f32x4 sb[8];
#define H_STAGE_A(i, kt, slot) glds16s(abase + (size_t)(kt) * 64, aoff[i], lds_u + (unsigned)((slot) * A8_TILE_B + (i) * 8192))
#define H_ISSUE_B(i, kt) asm volatile("s_nop 4\n\tglobal_load_dwordx4 %0, %1, %2" : "=v"(sb[i]) : "v"(boff), "s"(bbase + ((size_t)(kt) * 64 + (i) * 8) * ldb4) : "memory")
#define H_WRITE_B(i, slot) *(LAS unsigned*)(lds + (slot) * B8_TILE_B + b_wr + (i) * 8 * B8_PITCH) = pk4_fp8_x64(sb[i])
#define H_KSTEP(sa, sbk) do { v8i Xf[4], Wf[2]; \
        _Pragma("unroll") for (int n = 0; n < 2; ++n) _Pragma("unroll") for (int r = 0; r < 4; ++r) { const v2i t_ = vtr8(lds + (sbk) * B8_TILE_B + b_rd + r * 8 * B8_PITCH + n * 32); Wf[n][2 * r] = t_[0]; Wf[n][2 * r + 1] = t_[1]; } \
        _Pragma("unroll") for (int m = 0; m < 4; ++m) { const i32x4 lo_ = *(const LAS i32x4*)(lds + (sa) * A8_TILE_B + a_rd0 + m * 2048), hi_ = *(const LAS i32x4*)(lds + (sa) * A8_TILE_B + a_rd1 + m * 2048); \
            Xf[m] = (v8i){lo_[0], lo_[1], lo_[2], lo_[3], hi_[0], hi_[1], hi_[2], hi_[3]}; } \
        SBAR(); __builtin_amdgcn_s_setprio(1); \
        _Pragma("unroll") for (int m = 0; m < 4; ++m) _Pragma("unroll") for (int n = 0; n < 2; ++n) \
            acc[m][n] = __builtin_amdgcn_mfma_scale_f32_32x32x64_f8f6f4(Wf[n], Xf[m], acc[m][n], 0, 0, 0, 0x79797979, 0, SCALE_X); \
        __builtin_amdgcn_s_setprio(0); \
        _Pragma("unroll") for (int m = 0; m < 4; ++m) _Pragma("unroll") for (int n = 0; n < 2; ++n) asm volatile("" : "+v"(acc[m][n])); \
        SBAR(); } while (0)
    if (tid < 8) ring_cnt[tid] = 0u;
    H_STAGE_A(0, 0, 0); H_STAGE_A(1, 0, 0); H_STAGE_A(0, 1, 1); H_STAGE_A(1, 1, 1);
#pragma unroll
    for (int i = 0; i < 8; ++i) H_ISSUE_B(i, 0);
    WAIT_V4(0, sb[0], sb[1], sb[2], sb[3]); WAIT_V4(0, sb[4], sb[5], sb[6], sb[7]);
#pragma unroll
    for (int i = 0; i < 8; ++i) H_WRITE_B(i, 0);
    SBAR();
#pragma unroll
    for (int i = 0; i < 8; ++i) H_ISSUE_B(i, 1);
    WAIT_V4(0, sb[0], sb[1], sb[2], sb[3]); WAIT_V4(0, sb[4], sb[5], sb[6], sb[7]);
#pragma unroll
    for (int i = 0; i < 8; ++i) H_WRITE_B(i, 1);
    SBAR();
    H_STAGE_A(0, 2, 2); H_STAGE_A(1, 2, 2);
#pragma unroll
    for (int i = 0; i < 8; ++i) H_ISSUE_B(i, 2);
    SBAR();
    RAW_BARRIER();
    int sa_r = 0, sa_w = 3, sb_r = 0, sb_w = 2;
#pragma unroll 1
    for (int t = 0; t < nt; ++t) {
        if (t >= 2) {
            const unsigned need = (unsigned)(t - 1);
            for (;;) { asm volatile("" ::: "memory"); const unsigned v = *(volatile LAS unsigned*)(ring_cnt + (lane & 7)); if (__all(v >= need)) break; __builtin_amdgcn_s_sleep(1); }
            asm volatile("" ::: "memory");
        }
        const int k3 = (t + 3 < nt) ? t + 3 : nt - 1;
        H_STAGE_A(0, k3, sa_w); H_STAGE_A(1, k3, sa_w);
        H_KSTEP(sa_r, sb_r);
        WAIT_V4(6, sb[0], sb[1], sb[2], sb[3]);
        H_WRITE_B(0, sb_w); H_WRITE_B(1, sb_w); H_WRITE_B(2, sb_w); H_WRITE_B(3, sb_w); SBAR();
        H_ISSUE_B(0, k3); H_ISSUE_B(1, k3); H_ISSUE_B(2, k3); H_ISSUE_B(3, k3); SBAR();
        WAIT_V4(6, sb[4], sb[5], sb[6], sb[7]);
        H_WRITE_B(4, sb_w); H_WRITE_B(5, sb_w); H_WRITE_B(6, sb_w); H_WRITE_B(7, sb_w); SBAR();
        H_ISSUE_B(4, k3); H_ISSUE_B(5, k3); H_ISSUE_B(6, k3); H_ISSUE_B(7, k3); SBAR();
        asm volatile("" ::: "memory");
        if (lane == 0) *(volatile LAS unsigned*)(ring_cnt + wid) = (unsigned)(t + 1);
        asm volatile("" ::: "memory");
        sa_r = (sa_r == A8_RING - 1) ? 0 : sa_r + 1; sa_w = (sa_w == A8_RING - 1) ? 0 : sa_w + 1;
        sb_r = (sb_r == B8_RING - 1) ? 0 : sb_r + 1; sb_w = (sb_w == B8_RING - 1) ? 0 : sb_w + 1;
    }
    WAIT_V4(0, sb[0], sb[1], sb[2], sb[3]); WAIT_V4(0, sb[4], sb[5], sb[6], sb[7]);
    RAW_BARRIER();
    epi.fin(acc, wr, wc, r32, hi);
#undef H_STAGE_A
#undef H_ISSUE_B
#undef H_WRITE_B
#undef H_KSTEP
}

template <int SCALE_X, class AF, class BF, class EPI>
__device__ __forceinline__ void gemm_unit8h(LAS char* lds, LAS unsigned* ring_cnt, const int nt, const AF& af, const BF& bf, EPI& epi) {
    const int tid = threadIdx.x, wid = __builtin_amdgcn_readfirstlane(tid >> 6), lane = tid & 63, wr = wid >> 2, wc = wid & 3, r32 = lane & 31, hi = lane >> 5;
    const char* abase = uniform_ptr(af.base);
    unsigned aoff[2];
#pragma unroll
    for (int i = 0; i < 2; ++i) { const int R = wid * 16 + i * 128 + (lane >> 2), C = ((lane & 3) ^ ((lane >> 4) & 3)) * 16; aoff[i] = af.rowoff(R) + (unsigned)C; }
    const unsigned lds_u = (unsigned)__builtin_amdgcn_readfirstlane((int)(unsigned)(size_t)lds) + (unsigned)(wid * 1024);
    const size_t ldb4 = (size_t)bf.ld * 4;
    const char* bbase = uniform_ptr(bf.base) + (size_t)wid * ldb4;
    const unsigned boff = (unsigned)(lane >> 5) * 8u * (unsigned)ldb4 + bf.coloff(4 * (lane & 31)) * 4u;
    const int b_wr = B8_OFF + (wid + 8 * (lane >> 5)) * B8_PITCH + 4 * (lane & 31);
    const int a_rd0 = (wr * 128 + r32) * 64 + (((2 * hi) ^ ((r32 >> 2) & 3)) << 4), a_rd1 = a_rd0 ^ 16;
    const int b_rd = B8_OFF + (32 * hi + ((lane & 15) >> 1)) * B8_PITCH + wc * 32 + 16 * ((lane >> 4) & 1) + 8 * (lane & 1);
    f32x16 acc[4][1];
#pragma unroll
    for (int m = 0; m < 4; ++m)
#pragma unroll
        for (int n = 0; n < 1; ++n)
#pragma unroll
            for (int r = 0; r < 16; ++r) acc[m][n][r] = 0.f;
    f32x4 sb[4];
#define H_STAGE_A(i, kt, slot) glds16s(abase + (size_t)(kt) * 64, aoff[i], lds_u + (unsigned)((slot) * A8_TILE_B + (i) * 8192))
#define H_ISSUE_B(i, kt) asm volatile("s_nop 4\n\tglobal_load_dwordx4 %0, %1, %2" : "=v"(sb[i]) : "v"(boff), "s"(bbase + ((size_t)(kt) * 64 + (i) * 16) * ldb4) : "memory")
#define H_WRITE_B(i, slot) *(LAS unsigned*)(lds + (slot) * B8_TILE_B + b_wr + (i) * 16 * B8_PITCH) = pk4_fp8_x64(sb[i])
#define H_KSTEP(sa, sbk) do { v8i Xf[4], Wf[1]; \
        _Pragma("unroll") for (int n = 0; n < 1; ++n) _Pragma("unroll") for (int r = 0; r < 4; ++r) { const v2i t_ = vtr8(lds + (sbk) * B8_TILE_B + b_rd + r * 8 * B8_PITCH + n * 32); Wf[n][2 * r] = t_[0]; Wf[n][2 * r + 1] = t_[1]; } \
        _Pragma("unroll") for (int m = 0; m < 4; ++m) { const i32x4 lo_ = *(const LAS i32x4*)(lds + (sa) * A8_TILE_B + a_rd0 + m * 2048), hi_ = *(const LAS i32x4*)(lds + (sa) * A8_TILE_B + a_rd1 + m * 2048); \
            Xf[m] = (v8i){lo_[0], lo_[1], lo_[2], lo_[3], hi_[0], hi_[1], hi_[2], hi_[3]}; } \
        SBAR(); __builtin_amdgcn_s_setprio(1); \
        _Pragma("unroll") for (int m = 0; m < 4; ++m) _Pragma("unroll") for (int n = 0; n < 1; ++n) \
            acc[m][n] = __builtin_amdgcn_mfma_scale_f32_32x32x64_f8f6f4(Wf[n], Xf[m], acc[m][n], 0, 0, 0, 0x79797979, 0, SCALE_X); \
        __builtin_amdgcn_s_setprio(0); SBAR(); } while (0)
    if (tid < 8) ring_cnt[tid] = 0u;
    H_STAGE_A(0, 0, 0); H_STAGE_A(1, 0, 0); H_STAGE_A(0, 1, 1); H_STAGE_A(1, 1, 1);
#pragma unroll
    for (int i = 0; i < 4; ++i) H_ISSUE_B(i, 0);
    WAIT_V4(0, sb[0], sb[1], sb[2], sb[3]);
#pragma unroll
    for (int i = 0; i < 4; ++i) H_WRITE_B(i, 0);
    SBAR();
#pragma unroll
    for (int i = 0; i < 4; ++i) H_ISSUE_B(i, 1);
    WAIT_V4(0, sb[0], sb[1], sb[2], sb[3]);
#pragma unroll
    for (int i = 0; i < 4; ++i) H_WRITE_B(i, 1);
    SBAR();
    H_STAGE_A(0, 2, 2); H_STAGE_A(1, 2, 2);
#pragma unroll
    for (int i = 0; i < 4; ++i) H_ISSUE_B(i, 2);
    SBAR();
    RAW_BARRIER();
    int sa_r = 0, sa_w = 3, sb_r = 0, sb_w = 2;
#pragma unroll 1
    for (int t = 0; t < nt; ++t) {
        if (t >= 2) {
            const unsigned need = (unsigned)(t - 1);
            for (;;) { asm volatile("" ::: "memory"); const unsigned v = *(volatile LAS unsigned*)(ring_cnt + (lane & 7)); if (__all(v >= need)) break; __builtin_amdgcn_s_sleep(1); }
            asm volatile("" ::: "memory");
        }
        const int k3 = (t + 3 < nt) ? t + 3 : nt - 1;
        H_STAGE_A(0, k3, sa_w); H_STAGE_A(1, k3, sa_w);
        H_KSTEP(sa_r, sb_r);
        WAIT_V4(2, sb[0], sb[1], sb[2], sb[3]);
        H_WRITE_B(0, sb_w); H_WRITE_B(1, sb_w); H_WRITE_B(2, sb_w); H_WRITE_B(3, sb_w); SBAR();
        H_ISSUE_B(0, k3); H_ISSUE_B(1, k3); H_ISSUE_B(2, k3); H_ISSUE_B(3, k3); SBAR();
        asm volatile("" ::: "memory");
        if (lane == 0) *(volatile LAS unsigned*)(ring_cnt + wid) = (unsigned)(t + 1);
        asm volatile("" ::: "memory");
        sa_r = (sa_r == A8_RING - 1) ? 0 : sa_r + 1; sa_w = (sa_w == A8_RING - 1) ? 0 : sa_w + 1;
        sb_r = (sb_r == B8_RING - 1) ? 0 : sb_r + 1; sb_w = (sb_w == B8_RING - 1) ? 0 : sb_w + 1;
    }
    WAIT_V4(0, sb[0], sb[1], sb[2], sb[3]);
    RAW_BARRIER();
    epi.fin(acc, wr, wc, r32, hi);
#undef H_STAGE_A
#undef H_ISSUE_B
#undef H_WRITE_B
#undef H_KSTEP
}

template <int SCALE_X, class AF, class BF, class EPI>
__device__ __forceinline__ void gemm_unit8q(LAS char* lds, LAS unsigned* ring_cnt, const int nt, const AF& af, const BF& bf, EPI& epi) {
    const int tid = threadIdx.x, wid = __builtin_amdgcn_readfirstlane(tid >> 6), lane = tid & 63, wr = wid >> 1, wc = wid & 1, r32 = lane & 31, hi = lane >> 5;
    const char* abase = uniform_ptr(af.base);
    unsigned aoff[2];
#pragma unroll
    for (int i = 0; i < 2; ++i) { const int R = wid * 16 + i * 128 + (lane >> 2), C = ((lane & 3) ^ ((lane >> 4) & 3)) * 16; aoff[i] = af.rowoff(R) + (unsigned)C; }
    const unsigned lds_u = (unsigned)__builtin_amdgcn_readfirstlane((int)(unsigned)(size_t)lds) + (unsigned)(wid * 1024);
    const size_t ldb4 = (size_t)bf.ld * 4;
    const char* bbase = uniform_ptr(bf.base) + (size_t)wid * ldb4;
    const unsigned boff = (unsigned)(lane >> 5) * 8u * (unsigned)ldb4 + bf.coloff(4 * (lane & 31)) * 4u;
    const int b_wr = B8_OFF + (wid + 8 * (lane >> 5)) * B8_PITCH + 4 * (lane & 31);
    const int a_rd0 = (wr * 64 + r32) * 64 + (((2 * hi) ^ ((r32 >> 2) & 3)) << 4), a_rd1 = a_rd0 ^ 16;
    const int b_rd = B8_OFF + (32 * hi + ((lane & 15) >> 1)) * B8_PITCH + wc * 64 + 16 * ((lane >> 4) & 1) + 8 * (lane & 1);
    f32x16 acc[2][2];
#pragma unroll
    for (int m = 0; m < 2; ++m)
#pragma unroll
        for (int n = 0; n < 2; ++n)
#pragma unroll
            for (int r = 0; r < 16; ++r) acc[m][n][r] = 0.f;
    f32x4 sb[4];
#define H_STAGE_A(i, kt, slot) glds16s(abase + (size_t)(kt) * 64, aoff[i], lds_u + (unsigned)((slot) * A8_TILE_B + (i) * 8192))
#define H_ISSUE_B(i, kt) asm volatile("s_nop 4\n\tglobal_load_dwordx4 %0, %1, %2" : "=v"(sb[i]) : "v"(boff), "s"(bbase + ((size_t)(kt) * 64 + (i) * 16) * ldb4) : "memory")
#define H_WRITE_B(i, slot) *(LAS unsigned*)(lds + (slot) * B8_TILE_B + b_wr + (i) * 16 * B8_PITCH) = pk4_fp8_x64(sb[i])
#define H_KSTEP(sa, sbk) do { v8i Xf[2], Wf[2]; \
        _Pragma("unroll") for (int n = 0; n < 2; ++n) _Pragma("unroll") for (int r = 0; r < 4; ++r) { const v2i t_ = vtr8(lds + (sbk) * B8_TILE_B + b_rd + r * 8 * B8_PITCH + n * 32); Wf[n][2 * r] = t_[0]; Wf[n][2 * r + 1] = t_[1]; } \
        _Pragma("unroll") for (int m = 0; m < 2; ++m) { const i32x4 lo_ = *(const LAS i32x4*)(lds + (sa) * A8_TILE_B + a_rd0 + m * 2048), hi_ = *(const LAS i32x4*)(lds + (sa) * A8_TILE_B + a_rd1 + m * 2048); \
            Xf[m] = (v8i){lo_[0], lo_[1], lo_[2], lo_[3], hi_[0], hi_[1], hi_[2], hi_[3]}; } \
        SBAR(); __builtin_amdgcn_s_setprio(1); \
        _Pragma("unroll") for (int m = 0; m < 2; ++m) _Pragma("unroll") for (int n = 0; n < 2; ++n) \
            acc[m][n] = __builtin_amdgcn_mfma_scale_f32_32x32x64_f8f6f4(Wf[n], Xf[m], acc[m][n], 0, 0, 0, 0x79797979, 0, SCALE_X); \
        __builtin_amdgcn_s_setprio(0); SBAR(); } while (0)
    if (tid < 8) ring_cnt[tid] = 0u;
    H_STAGE_A(0, 0, 0); H_STAGE_A(1, 0, 0); H_STAGE_A(0, 1, 1); H_STAGE_A(1, 1, 1);
#pragma unroll
    for (int i = 0; i < 4; ++i) H_ISSUE_B(i, 0);
    WAIT_V4(0, sb[0], sb[1], sb[2], sb[3]);
#pragma unroll
    for (int i = 0; i < 4; ++i) H_WRITE_B(i, 0);
    SBAR();
#pragma unroll
    for (int i = 0; i < 4; ++i) H_ISSUE_B(i, 1);
    WAIT_V4(0, sb[0], sb[1], sb[2], sb[3]);
#pragma unroll
    for (int i = 0; i < 4; ++i) H_WRITE_B(i, 1);
    SBAR();
    H_STAGE_A(0, 2, 2); H_STAGE_A(1, 2, 2);
#pragma unroll
    for (int i = 0; i < 4; ++i) H_ISSUE_B(i, 2);
    SBAR();
    RAW_BARRIER();
    int sa_r = 0, sa_w = 3, sb_r = 0, sb_w = 2;
#pragma unroll 1
    for (int t = 0; t < nt; ++t) {
        if (t >= 2) {
            const unsigned need = (unsigned)(t - 1);
            for (;;) { asm volatile("" ::: "memory"); const unsigned v = *(volatile LAS unsigned*)(ring_cnt + (lane & 7)); if (__all(v >= need)) break; __builtin_amdgcn_s_sleep(1); }
            asm volatile("" ::: "memory");
        }
        const int k3 = (t + 3 < nt) ? t + 3 : nt - 1;
        H_STAGE_A(0, k3, sa_w); H_STAGE_A(1, k3, sa_w);
        H_KSTEP(sa_r, sb_r);
        WAIT_V4(2, sb[0], sb[1], sb[2], sb[3]);
        H_WRITE_B(0, sb_w); H_WRITE_B(1, sb_w); H_WRITE_B(2, sb_w); H_WRITE_B(3, sb_w); SBAR();
        H_ISSUE_B(0, k3); H_ISSUE_B(1, k3); H_ISSUE_B(2, k3); H_ISSUE_B(3, k3); SBAR();
        asm volatile("" ::: "memory");
        if (lane == 0) *(volatile LAS unsigned*)(ring_cnt + wid) = (unsigned)(t + 1);
        asm volatile("" ::: "memory");
        sa_r = (sa_r == A8_RING - 1) ? 0 : sa_r + 1; sa_w = (sa_w == A8_RING - 1) ? 0 : sa_w + 1;
        sb_r = (sb_r == B8_RING - 1) ? 0 : sb_r + 1; sb_w = (sb_w == B8_RING - 1) ? 0 : sb_w + 1;
    }
    WAIT_V4(0, sb[0], sb[1], sb[2], sb[3]);
    RAW_BARRIER();
    epi.fin(acc, wr, wc, r32, hi);
#undef H_STAGE_A
#undef H_ISSUE_B
#undef H_WRITE_B
#undef H_KSTEP
}

constexpr int C8_B_TILE = 16384, C8_B_OFF = A8_RING * A8_TILE_B;
template <int SCALE_X, class AF, class EPI>
__device__ __forceinline__ void gemm_unit8b(LAS char* lds, LAS unsigned* ring_cnt, const int nt, const AF& af, const unsigned char* img, EPI& epi) {
    const int tid = threadIdx.x, wid = __builtin_amdgcn_readfirstlane(tid >> 6), lane = tid & 63, wr = wid >> 2, wc = wid & 3, r32 = lane & 31, hi = lane >> 5;
    const char* abase = uniform_ptr(af.base);
    unsigned aoff[2];
#pragma unroll
    for (int i = 0; i < 2; ++i) { const int R = wid * 16 + i * 128 + (lane >> 2), C = ((lane & 3) ^ ((lane >> 4) & 3)) * 16; aoff[i] = af.rowoff(R) + (unsigned)C; }
    const unsigned lds_u = (unsigned)__builtin_amdgcn_readfirstlane((int)(unsigned)(size_t)lds) + (unsigned)(wid * 1024);
    const char* ibase = uniform_ptr(img);
    const unsigned ioff = (unsigned)(wid * 1024 + lane * 16);
    const int b_wr = C8_B_OFF + wid * 1024 + lane * 16;
    const int a_rd0 = (wr * 128 + r32) * 64 + (((2 * hi) ^ ((r32 >> 2) & 3)) << 4), a_rd1 = a_rd0 ^ 16;
    const int q8 = (lane & 15) >> 1;
    const int b_rd0 = C8_B_OFF + (32 * hi + q8) * 256 + ((wc * 64 + 16 * ((lane >> 4) & 1) + 8 * (lane & 1)) ^ (q8 << 5)), b_rd1 = b_rd0 ^ 32;
    i32x4 sv[2];
#define C_STAGE_A(i, kt, slot) glds16s(abase + (size_t)(kt) * 64, aoff[i], lds_u + (unsigned)((slot) * A8_TILE_B + (i) * 8192))
#define C_ISSUE_B(i, kt) asm volatile("s_nop 4\n\tglobal_load_dwordx4 %0, %1, %2" : "=v"(sv[i]) : "v"(ioff), "s"(ibase + (size_t)(kt) * 16384 + (i) * 8192) : "memory")
#define C_WRITE_B(i, slot) *(LAS i32x4*)(lds + (slot) * C8_B_TILE + b_wr + (i) * 8192) = sv[i]
#define C_WAIT(n) asm volatile("s_waitcnt vmcnt(" #n ")" : "+v"(sv[0]), "+v"(sv[1]) :: "memory")
    if (tid < 8) ring_cnt[tid] = 0u;
    C_STAGE_A(0, 0, 0); C_STAGE_A(1, 0, 0); C_STAGE_A(0, 1, 1); C_STAGE_A(1, 1, 1);
    C_ISSUE_B(0, 0); C_ISSUE_B(1, 0); C_WAIT(0); C_WRITE_B(0, 0); C_WRITE_B(1, 0); SBAR();
    C_ISSUE_B(0, 1); C_ISSUE_B(1, 1); C_WAIT(0); C_WRITE_B(0, 1); C_WRITE_B(1, 1); SBAR();
    C_STAGE_A(0, 2, 2); C_STAGE_A(1, 2, 2);
    C_ISSUE_B(0, 2); C_ISSUE_B(1, 2);
    SBAR();
    f32x16 acc[4][2];
#pragma unroll
    for (int m = 0; m < 4; ++m)
#pragma unroll
        for (int n = 0; n < 2; ++n)
#pragma unroll
            for (int r = 0; r < 16; ++r) acc[m][n][r] = 0.f;
    RAW_BARRIER();
    int sa_r = 0, sa_w = 3, sb_r = 0, sb_w = 2;
#pragma unroll 1
    for (int t = 0; t < nt; ++t) {
        if (t >= 2) { const unsigned need = (unsigned)(t - 1);
            for (;;) { asm volatile("" ::: "memory"); const unsigned v = *(volatile LAS unsigned*)(ring_cnt + (lane & 7)); if (__all(v >= need)) break; __builtin_amdgcn_s_sleep(1); }
            asm volatile("" ::: "memory"); }
        const int k3 = (t + 3 < nt) ? t + 3 : nt - 1;
        C_STAGE_A(0, k3, sa_w); C_STAGE_A(1, k3, sa_w);
        { v8i Xf[4], Wf[2];
#pragma unroll
          for (int r = 0; r < 4; ++r) { const v2i t0_ = vtr8(lds + sb_r * C8_B_TILE + b_rd0 + r * 2048), t1_ = vtr8(lds + sb_r * C8_B_TILE + b_rd1 + r * 2048); Wf[0][2 * r] = t0_[0]; Wf[0][2 * r + 1] = t0_[1]; Wf[1][2 * r] = t1_[0]; Wf[1][2 * r + 1] = t1_[1]; }
#pragma unroll
          for (int m = 0; m < 4; ++m) { const i32x4 lo_ = *(const LAS i32x4*)(lds + sa_r * A8_TILE_B + a_rd0 + m * 2048), hi_ = *(const LAS i32x4*)(lds + sa_r * A8_TILE_B + a_rd1 + m * 2048);
              Xf[m] = (v8i){lo_[0], lo_[1], lo_[2], lo_[3], hi_[0], hi_[1], hi_[2], hi_[3]}; }
          SBAR(); __builtin_amdgcn_s_setprio(1);
#pragma unroll
          for (int m = 0; m < 4; ++m)
#pragma unroll
              for (int n = 0; n < 2; ++n) acc[m][n] = __builtin_amdgcn_mfma_scale_f32_32x32x64_f8f6f4(Wf[n], Xf[m], acc[m][n], 0, 0, 0, 0x79797979, 0, SCALE_X);
          __builtin_amdgcn_s_setprio(0); SBAR(); }
        C_WAIT(2);
        C_WRITE_B(0, sb_w); C_WRITE_B(1, sb_w); SBAR();
        C_ISSUE_B(0, k3); C_ISSUE_B(1, k3); SBAR();
        asm volatile("" ::: "memory");
        if (lane == 0) *(volatile LAS unsigned*)(ring_cnt + wid) = (unsigned)(t + 1);
        asm volatile("" ::: "memory");
        sa_r = (sa_r == A8_RING - 1) ? 0 : sa_r + 1; sa_w = (sa_w == A8_RING - 1) ? 0 : sa_w + 1;
        sb_r = (sb_r == B8_RING - 1) ? 0 : sb_r + 1; sb_w = (sb_w == B8_RING - 1) ? 0 : sb_w + 1;
    }
    C_WAIT(0);
    RAW_BARRIER();
    epi.fin(acc, wr, wc, r32, hi);
#undef C_STAGE_A
#undef C_ISSUE_B
#undef C_WRITE_B
#undef C_WAIT
}
template <int SCALE_X, class AF, class EPI>
__device__ __forceinline__ void gemm_unit8bh(LAS char* lds, LAS unsigned* ring_cnt, const int nt, const AF& af, const unsigned char* img, const int hf, EPI& epi) {
    const int tid = threadIdx.x, wid = __builtin_amdgcn_readfirstlane(tid >> 6), lane = tid & 63, wr = wid >> 2, wc = wid & 3, r32 = lane & 31, hi = lane >> 5;
    const char* abase = uniform_ptr(af.base);
    unsigned aoff[2];
#pragma unroll
    for (int i = 0; i < 2; ++i) { const int R = wid * 16 + i * 128 + (lane >> 2), C = ((lane & 3) ^ ((lane >> 4) & 3)) * 16; aoff[i] = af.rowoff(R) + (unsigned)C; }
    const unsigned lds_u = (unsigned)__builtin_amdgcn_readfirstlane((int)(unsigned)(size_t)lds) + (unsigned)(wid * 1024);
    const char* ibase = uniform_ptr(img);
    const unsigned ioff = (unsigned)(wid * 1024 + lane * 16);
    const int b_wr = C8_B_OFF + wid * 1024 + lane * 16;
    const int a_rd0 = (wr * 128 + r32) * 64 + (((2 * hi) ^ ((r32 >> 2) & 3)) << 4), a_rd1 = a_rd0 ^ 16;
    const int q8 = (lane & 15) >> 1;
    const int b_rd0 = C8_B_OFF + (32 * hi + q8) * 256 + ((hf * 128 + wc * 32 + 16 * ((lane >> 4) & 1) + 8 * (lane & 1)) ^ (q8 << 5));
    i32x4 sv[2];
#define C_STAGE_A(i, kt, slot) glds16s(abase + (size_t)(kt) * 64, aoff[i], lds_u + (unsigned)((slot) * A8_TILE_B + (i) * 8192))
#define C_ISSUE_B(i, kt) asm volatile("s_nop 4\n\tglobal_load_dwordx4 %0, %1, %2" : "=v"(sv[i]) : "v"(ioff), "s"(ibase + (size_t)(kt) * 16384 + (i) * 8192) : "memory")
#define C_WRITE_B(i, slot) *(LAS i32x4*)(lds + (slot) * C8_B_TILE + b_wr + (i) * 8192) = sv[i]
#define C_WAIT(n) asm volatile("s_waitcnt vmcnt(" #n ")" : "+v"(sv[0]), "+v"(sv[1]) :: "memory")
    if (tid < 8) ring_cnt[tid] = 0u;
    C_STAGE_A(0, 0, 0); C_STAGE_A(1, 0, 0); C_STAGE_A(0, 1, 1); C_STAGE_A(1, 1, 1);
    C_ISSUE_B(0, 0); C_ISSUE_B(1, 0); C_WAIT(0); C_WRITE_B(0, 0); C_WRITE_B(1, 0); SBAR();
    C_ISSUE_B(0, 1); C_ISSUE_B(1, 1); C_WAIT(0); C_WRITE_B(0, 1); C_WRITE_B(1, 1); SBAR();
    C_STAGE_A(0, 2, 2); C_STAGE_A(1, 2, 2);
    C_ISSUE_B(0, 2); C_ISSUE_B(1, 2);
    SBAR();
    f32x16 acc[4][1];
#pragma unroll
    for (int m = 0; m < 4; ++m)
#pragma unroll
        for (int n = 0; n < 1; ++n)
#pragma unroll
            for (int r = 0; r < 16; ++r) acc[m][n][r] = 0.f;
    RAW_BARRIER();
    int sa_r = 0, sa_w = 3, sb_r = 0, sb_w = 2;
#pragma unroll 1
    for (int t = 0; t < nt; ++t) {
        if (t >= 2) { const unsigned need = (unsigned)(t - 1);
            for (;;) { asm volatile("" ::: "memory"); const unsigned v = *(volatile LAS unsigned*)(ring_cnt + (lane & 7)); if (__all(v >= need)) break; __builtin_amdgcn_s_sleep(1); }
            asm volatile("" ::: "memory"); }
        const int k3 = (t + 3 < nt) ? t + 3 : nt - 1;
        C_STAGE_A(0, k3, sa_w); C_STAGE_A(1, k3, sa_w);
        { v8i Xf[4], Wf[1];
#pragma unroll
          for (int r = 0; r < 4; ++r) { const v2i t0_ = vtr8(lds + sb_r * C8_B_TILE + b_rd0 + r * 2048); Wf[0][2 * r] = t0_[0]; Wf[0][2 * r + 1] = t0_[1]; }
#pragma unroll
          for (int m = 0; m < 4; ++m) { const i32x4 lo_ = *(const LAS i32x4*)(lds + sa_r * A8_TILE_B + a_rd0 + m * 2048), hi_ = *(const LAS i32x4*)(lds + sa_r * A8_TILE_B + a_rd1 + m * 2048);
              Xf[m] = (v8i){lo_[0], lo_[1], lo_[2], lo_[3], hi_[0], hi_[1], hi_[2], hi_[3]}; }
          SBAR(); __builtin_amdgcn_s_setprio(1);
#pragma unroll
          for (int m = 0; m < 4; ++m)
#pragma unroll
              for (int n = 0; n < 1; ++n) acc[m][n] = __builtin_amdgcn_mfma_scale_f32_32x32x64_f8f6f4(Wf[n], Xf[m], acc[m][n], 0, 0, 0, 0x79797979, 0, SCALE_X);
          __builtin_amdgcn_s_setprio(0); SBAR(); }
        C_WAIT(2);
        C_WRITE_B(0, sb_w); C_WRITE_B(1, sb_w); SBAR();
        C_ISSUE_B(0, k3); C_ISSUE_B(1, k3); SBAR();
        asm volatile("" ::: "memory");
        if (lane == 0) *(volatile LAS unsigned*)(ring_cnt + wid) = (unsigned)(t + 1);
        asm volatile("" ::: "memory");
        sa_r = (sa_r == A8_RING - 1) ? 0 : sa_r + 1; sa_w = (sa_w == A8_RING - 1) ? 0 : sa_w + 1;
        sb_r = (sb_r == B8_RING - 1) ? 0 : sb_r + 1; sb_w = (sb_w == B8_RING - 1) ? 0 : sb_w + 1;
    }
    C_WAIT(0);
    RAW_BARRIER();
    epi.fin(acc, wr, wc, r32, hi);
#undef C_STAGE_A
#undef C_ISSUE_B
#undef C_WRITE_B
#undef C_WAIT
}

__device__ __forceinline__ void conv_image(const float* W, size_t ld, unsigned char* img, int t0, int t1) {
    const int tid = threadIdx.x, wid = tid >> 6, lane = tid & 63;
    const float* wp = W + (size_t)wid * ld + 4 * lane;
    unsigned char* ip = img + wid * 256 + ((4 * lane) ^ (wid << 5));
    for (int t = t0; t < t1; t += 4) { f32x4 v[4][8];
#pragma unroll
        for (int u = 0; u < 4; ++u)
#pragma unroll
            for (int i = 0; i < 8; ++i) v[u][i] = *(const f32x4*)(wp + ((size_t)(t + u) * 64 + i * 8) * ld);
#pragma unroll
        for (int u = 0; u < 4; ++u)
#pragma unroll
            for (int i = 0; i < 8; ++i) *(unsigned*)(ip + (size_t)(t + u) * 16384 + i * 2048) = pk4_fp8_x64(v[u][i]); }
}

struct Params {
    const float *x, *attn_norm, *w_in, *a_sink, *b_q_norm, *b_w_uq, *b_kv_norm, *b_w_ukv, *out_norm_a, *out_norm_b, *w_o, *mlp_norm, *w_router, *b_router,
        *w_up, *b_up, *w_down, *b_down, *final_norm;
    float* out; unsigned char* ws; int ph_lo, ph_hi;
};

struct ARows { const bf16_t* base; unsigned ld; __device__ __forceinline__ unsigned rowoff(int r) const { return (unsigned)r * ld; } };
struct AGather { const bf16_t* base; const int* tokl; int r0, cnt; __device__ __forceinline__ unsigned rowoff(int r) const { int rk = r0 + r; rk = rk < cnt ? rk : 0; return (unsigned)tokl[rk] * (unsigned)D_MODEL; } };
struct ARows8 { const unsigned char* base; unsigned ld; __device__ __forceinline__ unsigned rowoff(int r) const { return (unsigned)r * ld; } };
struct AGather8 { const unsigned char* base; const int* tokl; int r0, cnt; __device__ __forceinline__ unsigned rowoff(int r) const { int rk = r0 + r; rk = rk < cnt ? rk : 0; return (unsigned)tokl[rk] * (unsigned)D_MODEL; } };
struct BPlain { const float* base; size_t ld; int ncols;
    __device__ __forceinline__ unsigned coloff(int c) const { return (unsigned)(c < ncols ? c : (c & (ncols - 1))); } };
struct BGateUp { const float* base; size_t ld;
    __device__ __forceinline__ unsigned coloff(int c) const { const int wc = c >> 6, w = c & 63; return (unsigned)(wc * 32 + (w & 31) + ((w & 32) ? D_FF : 0)); } };

struct EpiProj {
    int pn, brow; unsigned char* ws; const float *qg, *kvg;
    __device__ __forceinline__ void mid(f32x4 (&)[8][4], int, int, int, int) {}
    __device__ __forceinline__ void fin(f32x4 (&acc)[8][4], int wr, int wc, int fr, int fq) {
        if (pn < 6) {
            bf16_t* dst; int ldd, c0;
            if (pn < 4) { dst = (bf16_t*)(ws + WS_QA); ldd = 1024; c0 = pn * 256; } else if (pn == 4) { dst = (bf16_t*)(ws + WS_KA); ldd = 256; c0 = 0; } else { dst = (bf16_t*)(ws + WS_VA); ldd = 256; c0 = 0; }
#pragma unroll
            for (int m = 0; m < 8; ++m) { const int row = brow + wr * 128 + m * 16 + fr;
#pragma unroll
                for (int n = 0; n < 4; ++n) { const int col = c0 + wc * 64 + n * 16 + fq * 4; const f32x4 v = acc[m][n];
                    *(u32x2*)(dst + (size_t)row * ldd + col) = (u32x2){pk_bf16(v[0], v[1]), pk_bf16(v[2], v[3])}; } }
        } else if (pn < 9) {
            bf16_t* dst; int ldd, c0; const float* g; float* ssq; int nsl, sl;
            if (pn < 8) { dst = (bf16_t*)(ws + WS_CQ); ldd = 512; c0 = (pn - 6) * 256; g = qg; ssq = (float*)(ws + WS_SSQC); nsl = 8; sl = (pn - 6) * 4 + wc; }
            else { dst = (bf16_t*)(ws + WS_CKV); ldd = 256; c0 = 0; g = kvg; ssq = (float*)(ws + WS_SSQK); nsl = 4; sl = wc; }
            f32x4 gvv[4];
#pragma unroll
            for (int n = 0; n < 4; ++n) gvv[n] = *(const f32x4*)(g + c0 + wc * 64 + n * 16 + fq * 4);
#pragma unroll
            for (int m = 0; m < 8; ++m) { const int row = brow + wr * 128 + m * 16 + fr; float ss = 0.f;
#pragma unroll
                for (int n = 0; n < 4; ++n) { const int col = c0 + wc * 64 + n * 16 + fq * 4; const f32x4 v = acc[m][n]; const f32x4 gv = gvv[n];
                    ss += v[0] * v[0] + v[1] * v[1] + v[2] * v[2] + v[3] * v[3];
                    *(u32x2*)(dst + (size_t)row * ldd + col) = (u32x2){pk_bf16(v[0] * gv[0], v[1] * gv[1]), pk_bf16(v[2] * gv[2], v[3] * gv[3])}; }
                ss += __shfl_xor(ss, 16, 64); ss += __shfl_xor(ss, 32, 64);
                if (fq == 0) ssq[(size_t)row * nsl + sl] = ss; }
        } else {
            if (wc == 0) {
                bf16_t* dst = (bf16_t*)(ws + WS_KPE); const float* rope = (const float*)(ws + WS_ROPE);
#pragma unroll
                for (int m = 0; m < 8; ++m) { const int row = brow + wr * 128 + m * 16 + fr; const int pos = row & (SEQ - 1);
#pragma unroll
                    for (int n = 0; n < 2; ++n) { const int i0 = n * 16 + fq * 4; const f32x4 x1 = acc[m][n], x2 = acc[m][n + 2];
                        const f32x4 cs0 = *(const f32x4*)(rope + ((size_t)pos * 32 + i0) * 2), cs1 = *(const f32x4*)(rope + ((size_t)pos * 32 + i0) * 2 + 4);
                        const float c[4] = {cs0[0], cs0[2], cs1[0], cs1[2]}, s[4] = {cs0[1], cs0[3], cs1[1], cs1[3]};
                        float o1[4], o2[4];
#pragma unroll
                        for (int j = 0; j < 4; ++j) { o1[j] = x1[j] * c[j] - x2[j] * s[j]; o2[j] = x1[j] * s[j] + x2[j] * c[j]; }
                        *(u32x2*)(dst + (size_t)row * 64 + i0) = (u32x2){pk_bf16(o1[0], o1[1]), pk_bf16(o1[2], o1[3])};
                        *(u32x2*)(dst + (size_t)row * 64 + 32 + i0) = (u32x2){pk_bf16(o2[0], o2[1]), pk_bf16(o2[2], o2[3])}; } }
            }
        }
    }
};
struct EpiQUp {
    int pn, brow; unsigned char* ws;
    __device__ __forceinline__ void mid(f32x4 (&)[8][4], int, int, int, int) {}
    __device__ __forceinline__ void fin(f32x4 (&acc)[8][4], int wr, int wc, int fr, int fq) {
        bf16_t* dst = (bf16_t*)(ws + WS_QB); const float* rope = (const float*)(ws + WS_ROPE); const float* ssq = (const float*)(ws + WS_CTL + CTL_SSQ_CQ);
        const int seg = pn * 4 + wc, head = seg / 3, part = seg - head * 3;
        float sq[8];
#pragma unroll
        for (int m = 0; m < 8; ++m) { const f32x4* pp = (const f32x4*)((const float*)(ws + WS_SSQC) + (size_t)(brow + wr * 128 + m * 16 + fr) * 8); const f32x4 p0 = pp[0], p1 = pp[1];
            sq[m] = ((p0[0] + p0[1]) + (p0[2] + p0[3])) + ((p1[0] + p1[1]) + (p1[2] + p1[3])); }
#pragma unroll
        for (int m = 0; m < 8; ++m) { const int row = brow + wr * 128 + m * 16 + fr; const float rs = rsqrtf(sq[m] * (1.f / 512.f) + EPS);
            bf16_t* drow = dst + (size_t)row * 1536 + head * 192 + part * 64;
            if (part < 2) {
#pragma unroll
                for (int n = 0; n < 4; ++n) { const f32x4 v = acc[m][n]; *(u32x2*)(drow + n * 16 + fq * 4) = (u32x2){pk_bf16(v[0] * rs, v[1] * rs), pk_bf16(v[2] * rs, v[3] * rs)}; }
            } else { const int pos = row & (SEQ - 1);
#pragma unroll
                for (int n = 0; n < 2; ++n) { const int i0 = n * 16 + fq * 4; const f32x4 x1 = acc[m][n], x2 = acc[m][n + 2];
                    const f32x4 cs0 = *(const f32x4*)(rope + ((size_t)pos * 32 + i0) * 2), cs1 = *(const f32x4*)(rope + ((size_t)pos * 32 + i0) * 2 + 4);
                    const float c[4] = {cs0[0], cs0[2], cs1[0], cs1[2]}, s[4] = {cs0[1], cs0[3], cs1[1], cs1[3]};
                    float o1[4], o2[4];
#pragma unroll
                    for (int j = 0; j < 4; ++j) { o1[j] = (x1[j] * c[j] - x2[j] * s[j]) * rs; o2[j] = (x1[j] * s[j] + x2[j] * c[j]) * rs; }
                    *(u32x2*)(drow + i0) = (u32x2){pk_bf16(o1[0], o1[1]), pk_bf16(o1[2], o1[3])};
                    *(u32x2*)(drow + 32 + i0) = (u32x2){pk_bf16(o2[0], o2[1]), pk_bf16(o2[2], o2[3])}; } }
        }
    }
};
struct EpiKvUp {
    int pn, brow; unsigned char* ws;
    __device__ __forceinline__ void mid(f32x4 (&)[8][4], int, int, int, int) {}
    __device__ __forceinline__ void fin(f32x4 (&acc)[8][4], int wr, int wc, int fr, int fq) {
        bf16_t* dst = (bf16_t*)(ws + WS_KVB);
        float sq[8];
#pragma unroll
        for (int m = 0; m < 8; ++m) { const f32x4 p0 = *(const f32x4*)((const float*)(ws + WS_SSQK) + (size_t)(brow + wr * 128 + m * 16 + fr) * 4); sq[m] = (p0[0] + p0[1]) + (p0[2] + p0[3]); }
#pragma unroll
        for (int m = 0; m < 8; ++m) { const int row = brow + wr * 128 + m * 16 + fr; const float rs = rsqrtf(sq[m] * (1.f / 256.f) + EPS);
#pragma unroll
            for (int n = 0; n < 4; ++n) { const int col = pn * 256 + wc * 64 + n * 16 + fq * 4; const f32x4 v = acc[m][n];
                *(u32x2*)(dst + (size_t)row * 2048 + col) = (u32x2){pk_bf16(v[0] * rs, v[1] * rs), pk_bf16(v[2] * rs, v[3] * rs)}; } }
    }
};
struct EpiWo {
    int pn, brow; unsigned char* ws; const float* x; const LAS float* tab;
    __device__ __forceinline__ void mid(f32x4 (&acc)[8][4], int wr, int wc, int fr, int fq) {
#pragma unroll
        for (int m = 0; m < 8; ++m) { const int r = wr * 128 + m * 16 + fr;
            const float f = __builtin_amdgcn_sqrtf((tab[256 + r] + EPS) * __builtin_amdgcn_rcpf(tab[r] + EPS));
#pragma unroll
            for (int n = 0; n < 4; ++n) acc[m][n] *= f;
            SBAR(); }
    }
    __device__ __forceinline__ void fin(f32x4 (&acc)[8][4], int wr, int wc, int fr, int fq) {
        float* x2 = (float*)(ws + WS_X2);
#pragma unroll
        for (int m = 0; m < 8; ++m) { const int r = wr * 128 + m * 16 + fr, row = brow + r; const float rbm = rsqrtf(tab[256 + r] + EPS); f32x4 xv[4];
#pragma unroll
            for (int n = 0; n < 4; ++n) xv[n] = *(const f32x4*)(x + (size_t)row * D_MODEL + pn * 256 + wc * 64 + n * 16 + fq * 4);
#pragma unroll
            for (int n = 0; n < 4; ++n) { const int col = pn * 256 + wc * 64 + n * 16 + fq * 4;
                const f32x4 v = acc[m][n] * rbm + xv[n];
                *(f32x4*)(x2 + (size_t)row * D_MODEL + col) = v; } }
    }
};
struct EpiUp8 {
    int j0, r0, cnt; unsigned char* dst; const float* bias;
    __device__ __forceinline__ void fin(f32x16 (&acc)[4][2], int wr, int wc, int r32, int hi) {
        f32x4 bg[4], bu[4];
#pragma unroll
        for (int rg = 0; rg < 4; ++rg) { const int j = j0 + wc * 32 + 8 * rg + 4 * hi; bg[rg] = *(const f32x4*)(bias + j); bu[rg] = *(const f32x4*)(bias + D_FF + j); }
#pragma unroll
        for (int m = 0; m < 4; ++m) { const int r = wr * 128 + m * 32 + r32; unsigned o8[4];
#pragma unroll
            for (int rg = 0; rg < 4; ++rg) { float o[4];
#pragma unroll
                for (int q = 0; q < 4; ++q) { const float g = fminf(acc[m][0][4 * rg + q] + bg[rg][q], 7.f), u = fminf(fmaxf(acc[m][1][4 * rg + q] + bu[rg][q], -7.f), 7.f);
                    const float sg = __builtin_amdgcn_rcpf(1.f + __builtin_amdgcn_exp2f(-1.702f * LOG2E * g)); o[q] = 4.f * (u + 1.f) * (g * sg); }
                o8[rg] = pk4_fp8(o[0], o[1], o[2], o[3]); }
#pragma unroll
            for (int j = 0; j < 2; ++j) { const auto sw = __builtin_amdgcn_permlane32_swap(o8[2 * j], o8[2 * j + 1], false, false); o8[2 * j] = sw[0]; o8[2 * j + 1] = sw[1]; }
            if (r0 + r < cnt) {
#pragma unroll
                for (int j = 0; j < 2; ++j) *(u32x2*)(dst + (size_t)r * D_FF + j0 + wc * 32 + 16 * j + 8 * hi) = (u32x2){o8[2 * j], o8[2 * j + 1]}; }
        }
    }
};
struct EpiUp8q {
    int j0, r0, cnt; unsigned char* dst; const float* bias;
    __device__ __forceinline__ void fin(f32x16 (&acc)[2][2], int wr, int wc, int r32, int hi) {
        f32x4 bg[4], bu[4];
#pragma unroll
        for (int rg = 0; rg < 4; ++rg) { const int j = j0 + wc * 32 + 8 * rg + 4 * hi; bg[rg] = *(const f32x4*)(bias + j); bu[rg] = *(const f32x4*)(bias + D_FF + j); }
#pragma unroll
        for (int m = 0; m < 2; ++m) { const int r = wr * 64 + m * 32 + r32; unsigned o8[4];
#pragma unroll
            for (int rg = 0; rg < 4; ++rg) { float o[4];
#pragma unroll
                for (int q = 0; q < 4; ++q) { const float g = fminf(acc[m][0][4 * rg + q] + bg[rg][q], 7.f), u = fminf(fmaxf(acc[m][1][4 * rg + q] + bu[rg][q], -7.f), 7.f);
                    const float sg = __builtin_amdgcn_rcpf(1.f + __builtin_amdgcn_exp2f(-1.702f * LOG2E * g)); o[q] = 4.f * (u + 1.f) * (g * sg); }
                o8[rg] = pk4_fp8(o[0], o[1], o[2], o[3]); }
#pragma unroll
            for (int j = 0; j < 2; ++j) { const auto sw = __builtin_amdgcn_permlane32_swap(o8[2 * j], o8[2 * j + 1], false, false); o8[2 * j] = sw[0]; o8[2 * j + 1] = sw[1]; }
            if (r0 + r < cnt) {
#pragma unroll
                for (int j = 0; j < 2; ++j) *(u32x2*)(dst + (size_t)r * D_FF + j0 + wc * 32 + 16 * j + 8 * hi) = (u32x2){o8[2 * j], o8[2 * j + 1]}; }
        }
    }
};
struct EpiDown8 {
    int c0, r0, cnt; bf16_t* dst; const float* bias;
    __device__ __forceinline__ void fin(f32x16 (&acc)[4][2], int wr, int wc, int r32, int hi) {
        f32x4 b[2][4];
#pragma unroll
        for (int n = 0; n < 2; ++n)
#pragma unroll
            for (int rg = 0; rg < 4; ++rg) b[n][rg] = *(const f32x4*)(bias + c0 + wc * 64 + n * 32 + 8 * rg + 4 * hi);
#pragma unroll
        for (int m = 0; m < 4; ++m) { const int r = wr * 128 + m * 32 + r32;
#pragma unroll
            for (int n = 0; n < 2; ++n) { u32x2 pk[4];
#pragma unroll
                for (int rg = 0; rg < 4; ++rg) pk[rg] = (u32x2){pk_bf16(acc[m][n][4 * rg] + b[n][rg][0], acc[m][n][4 * rg + 1] + b[n][rg][1]), pk_bf16(acc[m][n][4 * rg + 2] + b[n][rg][2], acc[m][n][4 * rg + 3] + b[n][rg][3])};
#pragma unroll
                for (int j = 0; j < 2; ++j) { const auto s0 = __builtin_amdgcn_permlane32_swap(pk[2 * j][0], pk[2 * j + 1][0], false, false); const auto s1 = __builtin_amdgcn_permlane32_swap(pk[2 * j][1], pk[2 * j + 1][1], false, false);
                    pk[2 * j] = (u32x2){s0[0], s1[0]}; pk[2 * j + 1] = (u32x2){s0[1], s1[1]}; }
                if (r0 + r < cnt) {
#pragma unroll
                    for (int j = 0; j < 2; ++j) *(u32x4*)(dst + (size_t)r * D_MODEL + c0 + wc * 64 + n * 32 + 16 * j + 8 * hi) = (u32x4){pk[2 * j][0], pk[2 * j][1], pk[2 * j + 1][0], pk[2 * j + 1][1]}; } }
        }
    }
};
struct EpiDown8h {
    int c0, r0, cnt; bf16_t* dst; const float* bias;
    __device__ __forceinline__ void fin(f32x16 (&acc)[4][1], int wr, int wc, int r32, int hi) {
        f32x4 b[1][4];
#pragma unroll
        for (int n = 0; n < 1; ++n)
#pragma unroll
            for (int rg = 0; rg < 4; ++rg) b[n][rg] = *(const f32x4*)(bias + c0 + wc * 32 + n * 32 + 8 * rg + 4 * hi);
#pragma unroll
        for (int m = 0; m < 4; ++m) { const int r = wr * 128 + m * 32 + r32;
#pragma unroll
            for (int n = 0; n < 1; ++n) { u32x2 pk[4];
#pragma unroll
                for (int rg = 0; rg < 4; ++rg) pk[rg] = (u32x2){pk_bf16(acc[m][n][4 * rg] + b[n][rg][0], acc[m][n][4 * rg + 1] + b[n][rg][1]), pk_bf16(acc[m][n][4 * rg + 2] + b[n][rg][2], acc[m][n][4 * rg + 3] + b[n][rg][3])};
#pragma unroll
                for (int j = 0; j < 2; ++j) { const auto s0 = __builtin_amdgcn_permlane32_swap(pk[2 * j][0], pk[2 * j + 1][0], false, false); const auto s1 = __builtin_amdgcn_permlane32_swap(pk[2 * j][1], pk[2 * j + 1][1], false, false);
                    pk[2 * j] = (u32x2){s0[0], s1[0]}; pk[2 * j + 1] = (u32x2){s0[1], s1[1]}; }
                if (r0 + r < cnt) {
#pragma unroll
                    for (int j = 0; j < 2; ++j) *(u32x4*)(dst + (size_t)r * D_MODEL + c0 + wc * 32 + n * 32 + 16 * j + 8 * hi) = (u32x4){pk[2 * j][0], pk[2 * j][1], pk[2 * j + 1][0], pk[2 * j + 1][1]}; } }
        }
    }
};

constexpr int PG_HTB = 128 * 64 * 2;
__host__ __device__ __forceinline__ int pg_lds_byte(int r, int c) { const int st = (r >> 4) * 2 + (c >> 5), rr = r & 15, cc = c & 31, ob = rr * 64 + cc * 2; return st * 1024 + (ob ^ (((ob >> 9) & 1) << 5)); }
__host__ __device__ __forceinline__ void pg_stage_rc(int b, int& R, int& C) { const int st = b / 1024, sb = b % 1024, swz = sb ^ (((sb >> 9) & 1) << 5); R = (st >> 1) * 16 + swz / 64; C = (st & 1) * 32 + (swz % 64) / 2; }
__host__ __device__ __forceinline__ int pg_tcol(int rho) { return (rho & ~0x30) | ((rho & 0x10) << 1) | ((rho & 0x20) >> 1); }
template <bool MID, class EPI>
__device__ __forceinline__ void gemm_unit_pg(LAS char* lds, const bf16_t* A, const bf16_t* Bt, const int K, EPI& E) {
    const int tid = threadIdx.x, wid = __builtin_amdgcn_readfirstlane(tid >> 6), lane = tid & 63, wr = wid >> 2, wc = wid & 3, fr = lane & 15, fq = lane >> 4;
    const int nt = K / 64;
    unsigned voff[2];
#pragma unroll
    for (int i = 0; i < 2; ++i) { int R, C; pg_stage_rc(tid * 16 + i * 8192, R, C); voff[i] = (unsigned)(R * K + C) * 2u; }
    const size_t kstep = (size_t)(64 * 2), hstep = (size_t)128 * K * 2;
    const unsigned ldsw = (unsigned)wid * 1024u;
    const int aoff = pg_lds_byte(wr * 64 + fr, fq * 8), boff = pg_lds_byte(wc * 32 + fr, fq * 8);
#define PG_SA(b, h) (((b) * 2 + (h)) * PG_HTB)
#define PG_SB(b, h) ((4 + (b) * 2 + (h)) * PG_HTB)
#define PG_STAGE(bufoff, gbase) do { _Pragma("unroll") for (int _i = 0; _i < 2; ++_i) \
        __builtin_amdgcn_global_load_lds((const unsigned*)((const char*)(gbase) + voff[_i]), (LAS unsigned*)(lds + (bufoff) + ldsw + _i * 8192), 16, 0, 0); } while (0)
#define PG_LDA(dst, b, h) do { _Pragma("unroll") for (int m = 0; m < 4; ++m) _Pragma("unroll") for (int k = 0; k < 2; ++k) dst[m][k] = *(const LAS bf16x8*)(lds + PG_SA(b, h) + aoff + m * 2048 + k * 1024); } while (0)
#define PG_LDB(dst, b, h) do { _Pragma("unroll") for (int n = 0; n < 2; ++n) _Pragma("unroll") for (int k = 0; k < 2; ++k) dst[n][k] = *(const LAS bf16x8*)(lds + PG_SB(b, h) + boff + n * 2048 + k * 1024); } while (0)
#define PG_MMA(ai, bj, At_, Bt_) do { __builtin_amdgcn_s_setprio(1); _Pragma("unroll") for (int m = 0; m < 4; ++m) _Pragma("unroll") for (int n = 0; n < 2; ++n) _Pragma("unroll") for (int k = 0; k < 2; ++k) \
        acc[ai][bj][m][n] = __builtin_amdgcn_mfma_f32_16x16x32_bf16(Bt_[n][k], At_[m][k], acc[ai][bj][m][n], 0, 0, 0); __builtin_amdgcn_s_setprio(0); } while (0)
#define PG_WAIT_V(n) asm volatile("s_waitcnt vmcnt(" #n ")" ::: "memory")
#define PG_WAIT_L(n) asm volatile("s_waitcnt lgkmcnt(" #n ")" ::: "memory")
#define PG_BAR __builtin_amdgcn_s_barrier()
    f32x4 acc[2][2][4][2];
#pragma unroll
    for (int a = 0; a < 2; ++a)
#pragma unroll
        for (int b = 0; b < 2; ++b)
#pragma unroll
            for (int m = 0; m < 4; ++m)
#pragma unroll
                for (int n = 0; n < 2; ++n) acc[a][b][m][n] = (f32x4){0.f, 0.f, 0.f, 0.f};
    bf16x8 At[4][2], B0[2][2], B1[2][2];
    const char* cA = (const char*)A; const char* cB = (const char*)Bt;
    PG_STAGE(PG_SB(0, 0), cB); PG_STAGE(PG_SA(0, 0), cA); PG_STAGE(PG_SB(0, 1), cB + hstep); PG_STAGE(PG_SA(0, 1), cA + hstep);
    if (wr == 1) PG_BAR;
    PG_WAIT_V(4); PG_BAR;
    PG_STAGE(PG_SB(1, 0), cB + kstep); PG_STAGE(PG_SA(1, 0), cA + kstep); PG_STAGE(PG_SB(1, 1), cB + hstep + kstep);
    PG_WAIT_V(6); PG_BAR;
    for (int t = 0; t < nt; t += 2) {
        const bool last = (t == nt - 2);
        const char* a1 = cA + (size_t)(t + 1) * kstep;
        const char* a2 = cA + (size_t)(t + 2) * kstep; const char* b2 = cB + (size_t)(t + 2) * kstep;
        const char* a3 = a2 + kstep; const char* b3 = b2 + kstep;
        if (MID && t == (nt >> 1)) E.mid(acc, wr, wc, fr, fq);
        PG_LDB(B0, 0, 0); SBAR(); PG_LDA(At, 0, 0); PG_STAGE(PG_SA(1, 1), a1 + hstep);
        PG_WAIT_L(8); PG_BAR; PG_WAIT_L(0); PG_MMA(0, 0, At, B0); PG_BAR; SBAR();
        PG_LDB(B1, 0, 1); if (!last) PG_STAGE(PG_SB(0, 0), b2);
        PG_BAR; PG_WAIT_L(0); PG_MMA(0, 1, At, B1); PG_BAR;
        PG_LDA(At, 0, 1); if (!last) PG_STAGE(PG_SA(0, 0), a2);
        PG_BAR; PG_WAIT_L(0); PG_MMA(1, 0, At, B0); PG_BAR; SBAR();
        if (!last) { PG_STAGE(PG_SB(0, 1), b2 + hstep); PG_WAIT_V(6); } else PG_WAIT_V(0);
        PG_BAR; PG_MMA(1, 1, At, B1); PG_BAR;
        PG_LDB(B0, 1, 0); SBAR(); PG_LDA(At, 1, 0); if (!last) PG_STAGE(PG_SA(0, 1), a2 + hstep);
        PG_WAIT_L(8); PG_BAR; PG_WAIT_L(0); PG_MMA(0, 0, At, B0); PG_BAR; SBAR();
        PG_LDB(B1, 1, 1); if (!last) PG_STAGE(PG_SB(1, 0), b3);
        PG_BAR; PG_WAIT_L(0); PG_MMA(0, 1, At, B1); PG_BAR;
        PG_LDA(At, 1, 1); if (!last) PG_STAGE(PG_SA(1, 0), a3);
        PG_BAR; PG_WAIT_L(0); PG_MMA(1, 0, At, B0); PG_BAR; SBAR();
        if (!last) { PG_STAGE(PG_SB(1, 1), b3 + hstep); PG_WAIT_V(6); }
        PG_BAR; PG_MMA(1, 1, At, B1); PG_BAR;
    }
    E.fin(acc, wr, wc, fr, fq);
    PG_WAIT_V(0);
    if (wr == 0) PG_BAR;
    PG_BAR;
#undef PG_SA
#undef PG_SB
#undef PG_STAGE
#undef PG_LDA
#undef PG_LDB
#undef PG_MMA
#undef PG_WAIT_V
#undef PG_WAIT_L
#undef PG_BAR
}

#define PG_ROW(ai, m) (128 * (ai) + 64 * wr + 16 * (m) + fr)
#define PG_COL(bj, n) (128 * (bj) + 64 * (wc >> 1) + 32 * (n) + 16 * (wc & 1) + 4 * fq)
__device__ __forceinline__ void pg_store_pair(bf16_t* rowp, u32x2 a, u32x2 b, int fq) {
    const auto s0 = __builtin_amdgcn_permlane16_swap(a[0], b[0], false, false); const auto s1 = __builtin_amdgcn_permlane16_swap(a[1], b[1], false, false);
    *(u32x4*)(rowp + 32 * (fq & 1) + 4 * (fq & 2)) = (u32x4){s0[0], s1[0], s0[1], s1[1]};
}
#define PG_CBASE(bj) (128 * (bj) + 64 * (wc >> 1) + 16 * (wc & 1))
struct PEpiProj {
    int pn, brow; unsigned char* ws; const float *qg, *kvg;
    __device__ __forceinline__ void mid(f32x4 (&)[2][2][4][2], int, int, int, int) {}
    __device__ __forceinline__ void fin(f32x4 (&acc)[2][2][4][2], int wr, int wc, int fr, int fq) {
        if (pn < 6) {
            bf16_t* dst; int ldd, c0;
            if (pn < 4) { dst = (bf16_t*)(ws + WS_QA); ldd = 1024; c0 = pn * 256; } else if (pn == 4) { dst = (bf16_t*)(ws + WS_KA); ldd = 256; c0 = 0; } else { dst = (bf16_t*)(ws + WS_VA); ldd = 256; c0 = 0; }
#pragma unroll
            for (int ai = 0; ai < 2; ++ai)
#pragma unroll
                for (int m = 0; m < 4; ++m) { bf16_t* rowp = dst + (size_t)(brow + PG_ROW(ai, m)) * ldd + c0;
#pragma unroll
                    for (int bj = 0; bj < 2; ++bj) { const f32x4 v = acc[ai][bj][m][0], w = acc[ai][bj][m][1];
                        pg_store_pair(rowp + PG_CBASE(bj), (u32x2){pk_bf16(v[0], v[1]), pk_bf16(v[2], v[3])}, (u32x2){pk_bf16(w[0], w[1]), pk_bf16(w[2], w[3])}, fq); } }
        } else if (pn < 9) {
            bf16_t* dst; int ldd, c0; const float* g; float* ssq; int nsl, sl0;
            if (pn < 8) { dst = (bf16_t*)(ws + WS_CQ); ldd = 512; c0 = (pn - 6) * 256; g = qg; ssq = (float*)(ws + WS_SSQC); nsl = 16; sl0 = (pn - 6) * 8 + wc; }
            else { dst = (bf16_t*)(ws + WS_CKV); ldd = 256; c0 = 0; g = kvg; ssq = (float*)(ws + WS_SSQK); nsl = 8; sl0 = wc; }
            f32x4 gvv[2][2];
#pragma unroll
            for (int bj = 0; bj < 2; ++bj)
#pragma unroll
                for (int n = 0; n < 2; ++n) gvv[bj][n] = *(const f32x4*)(g + c0 + PG_COL(bj, n));
#pragma unroll
            for (int ai = 0; ai < 2; ++ai)
#pragma unroll
                for (int m = 0; m < 4; ++m) { const int row = brow + PG_ROW(ai, m);
#pragma unroll
                    for (int bj = 0; bj < 2; ++bj) { float ss = 0.f; u32x2 pk[2];
#pragma unroll
                        for (int n = 0; n < 2; ++n) { const f32x4 v = acc[ai][bj][m][n]; const f32x4 gv = gvv[bj][n];
                            ss += v[0] * v[0] + v[1] * v[1] + v[2] * v[2] + v[3] * v[3];
                            pk[n] = (u32x2){pk_bf16(v[0] * gv[0], v[1] * gv[1]), pk_bf16(v[2] * gv[2], v[3] * gv[3])}; }
                        pg_store_pair(dst + (size_t)row * ldd + c0 + PG_CBASE(bj), pk[0], pk[1], fq);
                        ss += __shfl_xor(ss, 16, 64); ss += __shfl_xor(ss, 32, 64);
                        if (fq == 0) ssq[(size_t)row * nsl + sl0 + 4 * bj] = ss; } }
        } else {
            if (wc < 2) {
                bf16_t* dst = (bf16_t*)(ws + WS_KPE); const float* rope = (const float*)(ws + WS_ROPE); const int i0 = 16 * wc + 4 * fq;
#pragma unroll
                for (int ai = 0; ai < 2; ++ai)
#pragma unroll
                    for (int m = 0; m < 4; ++m) { const int row = brow + PG_ROW(ai, m); const int pos = row & (SEQ - 1); const f32x4 x1 = acc[ai][0][m][0], x2 = acc[ai][0][m][1];
                        const f32x4 cs0 = *(const f32x4*)(rope + ((size_t)pos * 32 + i0) * 2), cs1 = *(const f32x4*)(rope + ((size_t)pos * 32 + i0) * 2 + 4);
                        const float c[4] = {cs0[0], cs0[2], cs1[0], cs1[2]}, s[4] = {cs0[1], cs0[3], cs1[1], cs1[3]};
                        float o1[4], o2[4];
#pragma unroll
                        for (int j = 0; j < 4; ++j) { o1[j] = x1[j] * c[j] - x2[j] * s[j]; o2[j] = x1[j] * s[j] + x2[j] * c[j]; }
                        pg_store_pair(dst + (size_t)row * 64 + 16 * wc, (u32x2){pk_bf16(o1[0], o1[1]), pk_bf16(o1[2], o1[3])}, (u32x2){pk_bf16(o2[0], o2[1]), pk_bf16(o2[2], o2[3])}, fq); }
            }
        }
    }
};
struct PEpiQUp {
    int pn, brow; unsigned char* ws;
    __device__ __forceinline__ void mid(f32x4 (&)[2][2][4][2], int, int, int, int) {}
    __device__ __forceinline__ void fin(f32x4 (&acc)[2][2][4][2], int wr, int wc, int fr, int fq) {
        bf16_t* dst = (bf16_t*)(ws + WS_QB); const float* rope = (const float*)(ws + WS_ROPE);
        float rs[2][4];
#pragma unroll
        for (int ai = 0; ai < 2; ++ai)
#pragma unroll
            for (int m = 0; m < 4; ++m) { const f32x4* pp = (const f32x4*)((const float*)(ws + WS_SSQC) + (size_t)(brow + PG_ROW(ai, m)) * 16); const f32x4 p0 = pp[0], p1 = pp[1], p2 = pp[2], p3 = pp[3];
                const float sq = (((p0[0] + p0[1]) + (p0[2] + p0[3])) + ((p1[0] + p1[1]) + (p1[2] + p1[3]))) + (((p2[0] + p2[1]) + (p2[2] + p2[3])) + ((p3[0] + p3[1]) + (p3[2] + p3[3])));
                rs[ai][m] = rsqrtf(sq * (1.f / 512.f) + EPS); }
#pragma unroll
        for (int bj = 0; bj < 2; ++bj) { const int seg = pn * 4 + 2 * bj + (wc >> 1), head = seg / 3, part = seg - head * 3; const int i0 = 16 * (wc & 1) + 4 * fq;
#pragma unroll
            for (int ai = 0; ai < 2; ++ai)
#pragma unroll
                for (int m = 0; m < 4; ++m) { const int row = brow + PG_ROW(ai, m); const float r = rs[ai][m]; bf16_t* drow = dst + (size_t)row * 1536 + head * 192 + part * 64;
                    const f32x4 x1 = acc[ai][bj][m][0], x2 = acc[ai][bj][m][1];
                    if (part < 2) {
                        pg_store_pair(drow + 16 * (wc & 1), (u32x2){pk_bf16(x1[0] * r, x1[1] * r), pk_bf16(x1[2] * r, x1[3] * r)}, (u32x2){pk_bf16(x2[0] * r, x2[1] * r), pk_bf16(x2[2] * r, x2[3] * r)}, fq);
                    } else { const int pos = row & (SEQ - 1);
                        const f32x4 cs0 = *(const f32x4*)(rope + ((size_t)pos * 32 + i0) * 2), cs1 = *(const f32x4*)(rope + ((size_t)pos * 32 + i0) * 2 + 4);
                        const float c[4] = {cs0[0], cs0[2], cs1[0], cs1[2]}, s[4] = {cs0[1], cs0[3], cs1[1], cs1[3]};
                        float o1[4], o2[4];
#pragma unroll
                        for (int j = 0; j < 4; ++j) { o1[j] = (x1[j] * c[j] - x2[j] * s[j]) * r; o2[j] = (x1[j] * s[j] + x2[j] * c[j]) * r; }
                        pg_store_pair(drow + 16 * (wc & 1), (u32x2){pk_bf16(o1[0], o1[1]), pk_bf16(o1[2], o1[3])}, (u32x2){pk_bf16(o2[0], o2[1]), pk_bf16(o2[2], o2[3])}, fq); } } }
    }
};
struct PEpiKvUp {
    int pn, brow; unsigned char* ws;
    __device__ __forceinline__ void mid(f32x4 (&)[2][2][4][2], int, int, int, int) {}
    __device__ __forceinline__ void fin(f32x4 (&acc)[2][2][4][2], int wr, int wc, int fr, int fq) {
        bf16_t* dst = (bf16_t*)(ws + WS_KVB);
#pragma unroll
        for (int ai = 0; ai < 2; ++ai)
#pragma unroll
            for (int m = 0; m < 4; ++m) { const int row = brow + PG_ROW(ai, m); const f32x4* pp = (const f32x4*)((const float*)(ws + WS_SSQK) + (size_t)row * 8); const f32x4 p0 = pp[0], p1 = pp[1];
                const float r = rsqrtf((((p0[0] + p0[1]) + (p0[2] + p0[3])) + ((p1[0] + p1[1]) + (p1[2] + p1[3]))) * (1.f / 256.f) + EPS);
#pragma unroll
                for (int bj = 0; bj < 2; ++bj) { const f32x4 v = acc[ai][bj][m][0], w = acc[ai][bj][m][1];
                    pg_store_pair(dst + (size_t)row * 2048 + pn * 256 + PG_CBASE(bj), (u32x2){pk_bf16(v[0] * r, v[1] * r), pk_bf16(v[2] * r, v[3] * r)}, (u32x2){pk_bf16(w[0] * r, w[1] * r), pk_bf16(w[2] * r, w[3] * r)}, fq); } }
    }
};
struct PEpiWo {
    int pn, brow; unsigned char* ws; const float* x; const LAS float* tab;
    __device__ __forceinline__ void mid(f32x4 (&acc)[2][2][4][2], int wr, int wc, int fr, int fq) {
#pragma unroll
        for (int ai = 0; ai < 2; ++ai)
#pragma unroll
            for (int m = 0; m < 4; ++m) { const int r = PG_ROW(ai, m);
                const float f = __builtin_amdgcn_sqrtf((tab[256 + r] + EPS) * __builtin_amdgcn_rcpf(tab[r] + EPS));
#pragma unroll
                for (int bj = 0; bj < 2; ++bj)
#pragma unroll
                    for (int n = 0; n < 2; ++n) acc[ai][bj][m][n] *= f; }
        asm volatile("s_waitcnt lgkmcnt(0)" ::: "memory"); SBAR();
    }
    __device__ __forceinline__ void fin(f32x4 (&acc)[2][2][4][2], int wr, int wc, int fr, int fq) {
        float* x2 = (float*)(ws + WS_X2);
#pragma unroll
        for (int ai = 0; ai < 2; ++ai)
#pragma unroll
            for (int m = 0; m < 4; ++m) { const int r = PG_ROW(ai, m); const size_t o = (size_t)(brow + r) * D_MODEL + pn * 256; const float rbm = rsqrtf(tab[256 + r] + EPS); f32x4 xv[2][2];
#pragma unroll
                for (int bj = 0; bj < 2; ++bj)
#pragma unroll
                    for (int n = 0; n < 2; ++n) xv[bj][n] = *(const f32x4*)(x + o + PG_COL(bj, n));
#pragma unroll
                for (int bj = 0; bj < 2; ++bj)
#pragma unroll
                    for (int n = 0; n < 2; ++n) *(f32x4*)(x2 + o + PG_COL(bj, n)) = acc[ai][bj][m][n] * rbm + xv[bj][n]; }
    }
};
__device__ __forceinline__ void pg_convert(const float* W, int K, int ld, int ncols, int nrows, bf16_t* Bt, int item0, int nitems_stride) {
    const int total = nrows * (K >> 3);
    for (int it0 = item0; it0 < total; it0 += 4 * nitems_stride) { float v[4][8]; int row[4], k0[4]; bool ok[4];
#pragma unroll
        for (int b = 0; b < 4; ++b) { const int it = it0 + b * nitems_stride; const int itc = it < total ? it : item0; const int kc = itc / nrows; row[b] = itc - kc * nrows; k0[b] = kc << 3; ok[b] = it < total;
            const int col = (row[b] & ~255) + pg_tcol(row[b] & 255); const int colc = col < ncols ? col : 0; const float s = col < ncols ? 1.f : 0.f;
#pragma unroll
            for (int q = 0; q < 8; ++q) v[b][q] = W[(size_t)(k0[b] + q) * ld + colc] * s; }
#pragma unroll
        for (int b = 0; b < 4; ++b) if (ok[b])
            *(u32x4*)(Bt + (size_t)row[b] * K + k0[b]) = (u32x4){pk_bf16(v[b][0], v[b][1]), pk_bf16(v[b][2], v[b][3]), pk_bf16(v[b][4], v[b][5]), pk_bf16(v[b][6], v[b][7])}; }
}
__device__ __forceinline__ void sincos_d(double x, double& s, double& c) {
    const double k = __builtin_rint(x * 0.63661977236758134308);
    double r = __builtin_fma(-k, 1.57079632679489655800e+00, x); r = __builtin_fma(-k, 6.12323399573676603587e-17, r);
    const double r2 = r * r;
    double sp = -7.6471637318198164759e-13; sp = sp * r2 + 1.6059043836821614599e-10; sp = sp * r2 - 2.5052108385441718775e-08; sp = sp * r2 + 2.7557319223985890653e-06;
    sp = sp * r2 - 1.9841269841269841270e-04; sp = sp * r2 + 8.3333333333333333333e-03; sp = sp * r2 - 1.6666666666666666667e-01; const double sn = r + r * r2 * sp;
    double cp = 4.7794773323873852974e-14; cp = cp * r2 - 1.1470745597729724714e-11; cp = cp * r2 + 2.0876756987868098979e-09; cp = cp * r2 - 2.7557319223985890653e-07;
    cp = cp * r2 + 2.4801587301587301587e-05; cp = cp * r2 - 1.3888888888888888889e-03; cp = cp * r2 + 4.1666666666666666667e-02; cp = cp * r2 - 0.5; const double cn = 1.0 + r2 * cp;
    const int q = ((int)k) & 3;
    s = (q == 0) ? sn : (q == 1) ? cn : (q == 2) ? -sn : -cn;
    c = (q == 0) ? cn : (q == 1) ? -sn : (q == 2) ? -cn : sn;
}

__device__ __forceinline__ void phase_prologue(const Params& p) {
    const int tid = threadIdx.x, wid = tid >> 6, lane = tid & 63;
    bf16_t* xn = (bf16_t*)(p.ws + WS_XN);
    for (int row = blockIdx.x * 8 + wid; row < NTOK; row += gridDim.x * 8) {
        const f32x4* xr = (const f32x4*)(p.x + (size_t)row * D_MODEL); f32x4 v[8]; float ss = 0.f;
#pragma unroll
        for (int i = 0; i < 8; ++i) { v[i] = xr[lane + 64 * i]; ss += v[i][0] * v[i][0] + v[i][1] * v[i][1] + v[i][2] * v[i][2] + v[i][3] * v[i][3]; }
        ss = wave_sum(ss); const float rs = rsqrtf(ss * (1.f / D_MODEL) + EPS);
#pragma unroll
        for (int i = 0; i < 8; ++i) { const f32x4 g = ((const f32x4*)p.attn_norm)[lane + 64 * i];
            *(u32x2*)(xn + (size_t)row * D_MODEL + 4 * (lane + 64 * i)) = (u32x2){pk_bf16(v[i][0] * rs * g[0], v[i][1] * rs * g[1]), pk_bf16(v[i][2] * rs * g[2], v[i][3] * rs * g[3])}; }
    }
    const int gtid = blockIdx.x * 512 + tid;
    if (gtid < SEQ * 32) {
        const int pos = gtid >> 5, i = gtid & 31;
        double b = 10000.0; for (int q = 0; q < 5; ++q) b = __builtin_sqrt(b);
        double f = 1.0; for (int q = 0; q < i; ++q) f *= b;
        const float inv_freq = (float)(1.0 / f); const float ang = (float)pos * inv_freq;
        double s, c; sincos_d((double)ang, s, c);
        float* rope = (float*)(p.ws + WS_ROPE); rope[(size_t)gtid * 2] = (float)c; rope[(size_t)gtid * 2 + 1] = (float)s;
    }
    {
        const int nth = gridDim.x * 512;
        pg_convert(p.w_in, D_MODEL, IN_COLS, IN_COLS, 2560, (bf16_t*)(p.ws + WS_BT_IN), gtid, nth);
        pg_convert(p.b_w_uq, 512, 1536, 1536, 1536, (bf16_t*)(p.ws + WS_BT_UQ), gtid, nth);
        pg_convert(p.b_w_ukv, 256, 2048, 2048, 2048, (bf16_t*)(p.ws + WS_BT_UKV), gtid, nth);
    }
    if (gtid < N_EXP * D_MODEL) {
        ((float*)(p.ws + WS_WRT))[gtid] = p.w_router[gtid] * p.mlp_norm[gtid >> 5];
    }
}

constexpr int AA_PITCH = 144;
constexpr int AA_K = 0, AA_V = 384 * AA_PITCH;
constexpr int AA_WS = 2 * 384 * AA_PITCH;
__device__ __forceinline__ void attn_a_unit(const Params& p, LAS char* lds, int u) {
    const int tid = threadIdx.x, wid = __builtin_amdgcn_readfirstlane(tid >> 6), lane = tid & 63, r32 = lane & 31, hi = lane >> 5;
    const int b = u >> 7, nq = (u >> 2) & 31, kvh = u & 3;
    const bf16_t* QA = (const bf16_t*)(p.ws + WS_QA); const bf16_t* KA = (const bf16_t*)(p.ws + WS_KA); const bf16_t* VA = (const bf16_t*)(p.ws + WS_VA);
    const int P0 = (nq - 1) * 128;
    __syncthreads();
    for (int c = tid; c < 384 * 8; c += 512) { const int r = c >> 3, ch = c & 7; const int pos = P0 + r;
        i32x4 kv = {0, 0, 0, 0}, vv = {0, 0, 0, 0};
        if (pos >= 0 && pos < SEQ) { const size_t g = ((size_t)(b * SEQ + pos)) * 256 + kvh * 64 + ch * 8; kv = *(const i32x4*)(KA + g); vv = *(const i32x4*)(VA + g); }
        *(LAS i32x4*)(lds + AA_K + r * AA_PITCH + ch * 16) = kv; *(LAS i32x4*)(lds + AA_V + r * AA_PITCH + ch * 16) = vv; }
    __syncthreads();
    LAS float* wsf = (LAS float*)(lds + AA_WS) + wid * 64;
    const int hq = kvh * 4 + (wid >> 1);
    const float slope2 = __builtin_amdgcn_exp2f(-8.f * (float)(hq + 1) / 16.f) * LOG2E;
    const float sink2 = p.a_sink[hq] * LOG2E;
    const float C = 0.125f * LOG2E;
    const float* ga = p.out_norm_a + hq * 64;
    bf16_t* Y = (bf16_t*)(p.ws + WS_Y); float* ssqa = (float*)(p.ws + WS_SSQP);
    for (int blk = 0; blk < 2; ++blk) {
        const int q0 = nq * 128 + (wid & 1) * 64 + blk * 32;
        const int tq = q0 + r32;
        bf16x8 qr[4];
        { const bf16_t* qp = QA + ((size_t)(b * SEQ + tq)) * 1024 + hq * 64 + hi * 8;
#pragma unroll
          for (int d0 = 0; d0 < 4; ++d0) qr[d0] = *(const bf16x8*)(qp + d0 * 16); }
        float m_reg = sink2, l_reg = 1.f; f32x16 o[2] = {};
        for (int jt = 0; jt < 6; ++jt) {
            const int kp0 = P0 + jt * 64;
            if (kp0 + 63 < q0 - 128 || kp0 > q0 + 31 + 128 || kp0 + 63 < 0 || kp0 >= SEQ) continue;
            f32x16 p0 = {}, p1 = {};
#pragma unroll
            for (int d0 = 0; d0 < 4; ++d0) {
                const bf16x8 k0 = *(const LAS bf16x8*)(lds + AA_K + (jt * 64 + r32) * AA_PITCH + (d0 * 16 + hi * 8) * 2);
                const bf16x8 k1 = *(const LAS bf16x8*)(lds + AA_K + (jt * 64 + 32 + r32) * AA_PITCH + (d0 * 16 + hi * 8) * 2);
                p0 = __builtin_amdgcn_mfma_f32_32x32x16_bf16(k0, qr[d0], p0, 0, 0, 0);
                p1 = __builtin_amdgcn_mfma_f32_32x32x16_bf16(k1, qr[d0], p1, 0, 0, 0);
            }
            float pmax = -1e30f;
#pragma unroll
            for (int r = 0; r < 16; ++r) {
                { const int kp = kp0 + crow(r, hi); const int dist = tq > kp ? tq - kp : kp - tq; const bool ok = dist <= 128 && kp >= 0 && kp < SEQ;
                  p0[r] = ok ? p0[r] * C - slope2 * (float)dist : -1e30f; pmax = fmaxf(pmax, p0[r]); }
                { const int kp = kp0 + 32 + crow(r, hi); const int dist = tq > kp ? tq - kp : kp - tq; const bool ok = dist <= 128 && kp >= 0 && kp < SEQ;
                  p1[r] = ok ? p1[r] * C - slope2 * (float)dist : -1e30f; pmax = fmaxf(pmax, p1[r]); }
            }
            { auto rr = __builtin_amdgcn_permlane32_swap(__float_as_uint(pmax), __float_as_uint(pmax), false, false); pmax = fmaxf(__uint_as_float(rr[0]), __uint_as_float(rr[1])); }
            const float mn = fmaxf(m_reg, pmax); const float alpha = __builtin_amdgcn_exp2f(m_reg - mn); m_reg = mn;
            float ps = 0.f;
#pragma unroll
            for (int r = 0; r < 16; ++r) { p0[r] = __builtin_amdgcn_exp2f(p0[r] - mn); p1[r] = __builtin_amdgcn_exp2f(p1[r] - mn); ps += p0[r] + p1[r]; }
            { auto rr = __builtin_amdgcn_permlane32_swap(__float_as_uint(ps), __float_as_uint(ps), false, false); ps = __uint_as_float(rr[0]) + __uint_as_float(rr[1]); }
            l_reg = l_reg * alpha + ps;
            if (hi == 0) wsf[r32] = alpha;
            WAIT_L0();
#pragma unroll
            for (int r = 0; r < 16; ++r) { const float a = wsf[crow(r, hi)]; o[0][r] *= a; o[1][r] *= a; }
            bf16x8 pa[4];
#define PK4(P, BASE, OUT) do { unsigned a0 = pk_bf16(P[BASE + 0], P[BASE + 1]), a1 = pk_bf16(P[BASE + 2], P[BASE + 3]); \
    unsigned b0 = pk_bf16(P[BASE + 4], P[BASE + 5]), b1 = pk_bf16(P[BASE + 6], P[BASE + 7]); \
    auto r0_ = __builtin_amdgcn_permlane32_swap(a0, b0, false, false); auto r1_ = __builtin_amdgcn_permlane32_swap(a1, b1, false, false); \
    u32x4 w_ = {r0_[0], r1_[0], r0_[1], r1_[1]}; OUT = __builtin_bit_cast(bf16x8, w_); } while (0)
            PK4(p0, 0, pa[0]); PK4(p0, 8, pa[1]); PK4(p1, 0, pa[2]); PK4(p1, 8, pa[3]);
            const int g16 = (lane >> 4) & 1, qq = (lane & 15) >> 2, pp = lane & 3;
#pragma unroll
            for (int db = 0; db < 2; ++db) {
#pragma unroll
                for (int ks = 0; ks < 4; ++ks) {
                    const LAS char* vp = lds + AA_V + (jt * 64 + ks * 16 + 8 * hi + qq) * AA_PITCH + (db * 32 + 16 * g16 + 4 * pp) * 2;
                    const s16x4 lo = vtr(vp), hh = vtr(vp + 4 * AA_PITCH);
                    const bf16x8 vb = (bf16x8){lo[0], lo[1], lo[2], lo[3], hh[0], hh[1], hh[2], hh[3]};
                    o[db] = __builtin_amdgcn_mfma_f32_32x32x16_bf16(pa[ks], vb, o[db], 0, 0, 0);
                }
            }
            WAIT_L0();
        }
        if (hi == 0) wsf[r32] = 1.f / l_reg;
        WAIT_L0();
        const float g0 = ga[r32], g1 = ga[32 + r32];
#pragma unroll
        for (int r = 0; r < 16; ++r) { const int qrow = crow(r, hi); const float il = wsf[qrow]; const float v0 = o[0][r] * il, v1 = o[1][r] * il;
            const size_t tok = (size_t)(b * SEQ + q0 + qrow);
            bf16_t* yp = Y + tok * 2048 + hq * 64;
            yp[r32] = (bf16_t)(pk_bf16(v0 * g0, 0.f) & 0xffffu); yp[32 + r32] = (bf16_t)(pk_bf16(v1 * g1, 0.f) & 0xffffu);
            float ss = v0 * v0 + v1 * v1;
#pragma unroll
            for (int s = 16; s >= 1; s >>= 1) ss += __shfl_xor(ss, s, 64);
            if (r32 == 0) ssqa[tok * 24 + hq] = ss; }
        WAIT_L0();
    }
}

constexpr int MB_V = 0, MB_KN = 32768, MB_KP = 65536, MB_WS = 81920, MB_QP = 83968;
#define KSWZ(row, colB) ((row) * 256 + ((colB) ^ (((row) & 7) << 4)))
#define KPSWZ(row, colB) ((row) * 128 + ((colB) ^ (((row) & 7) << 4)))
constexpr float MLA_SCALE = 0.07216878364870322f;
constexpr float MLA_THR = 8.f;
__device__ __forceinline__ void mla_partialSM(f32x16& p0, f32x16& p1, float& m_reg, float& mn, float& alpha) {
    constexpr float C = MLA_SCALE * LOG2E;
    float pmax = p0[0];
#pragma unroll
    for (int r = 1; r < 16; ++r) pmax = fmaxf(pmax, p0[r]);
#pragma unroll
    for (int r = 0; r < 16; ++r) pmax = fmaxf(pmax, p1[r]);
    { auto rr = __builtin_amdgcn_permlane32_swap(__float_as_uint(pmax), __float_as_uint(pmax), false, false); pmax = fmaxf(__uint_as_float(rr[0]), __uint_as_float(rr[1])); }
    if (__builtin_expect(__all(pmax - m_reg <= MLA_THR / MLA_SCALE), 1)) { mn = m_reg; alpha = 1.f; }
    else { mn = fmaxf(m_reg, pmax); alpha = __builtin_amdgcn_exp2f((m_reg - mn) * C); m_reg = mn; }
    const float mnC = -mn * C;
#pragma unroll
    for (int r = 0; r < 16; ++r) p0[r] = fmaf(p0[r], C, mnC);
#pragma unroll
    for (int r = 0; r < 16; ++r) p1[r] = fmaf(p1[r], C, mnC);
#pragma unroll
    for (int r = 0; r < 16; ++r) p0[r] = __builtin_amdgcn_exp2f(p0[r]);
}
__device__ __forceinline__ void mla_finishSM(f32x16& p0, f32x16& p1, float alpha, float& l_reg, bf16x8& pa0, bf16x8& pa1, bf16x8& pa2, bf16x8& pa3) {
#pragma unroll
    for (int r = 0; r < 16; ++r) p1[r] = __builtin_amdgcn_exp2f(p1[r]);
    float ps = 0;
#pragma unroll
    for (int r = 0; r < 16; ++r) ps += p0[r];
#pragma unroll
    for (int r = 0; r < 16; ++r) ps += p1[r];
    { auto rr = __builtin_amdgcn_permlane32_swap(__float_as_uint(ps), __float_as_uint(ps), false, false); ps = __uint_as_float(rr[0]) + __uint_as_float(rr[1]); }
    l_reg = l_reg * alpha + ps;
    PK4(p0, 0, pa0); PK4(p0, 8, pa1); PK4(p1, 0, pa2); PK4(p1, 8, pa3);
}
__device__ __forceinline__ void mla_qkt(f32x16& p0, f32x16& p1, const LAS char* Kn, const LAS char* Kp, const bf16x8* qr, const LAS char* qp, int r32, int hi) {
    p0 = f32x16{}; p1 = f32x16{};
#pragma unroll
    for (int d0 = 0; d0 < 8; ++d0) { const int cb = (d0 * 16 + hi * 8) * 2;
        const bf16x8 b0 = *(const LAS bf16x8*)(Kn + KSWZ(r32, cb)); const bf16x8 b1 = *(const LAS bf16x8*)(Kn + KSWZ(32 + r32, cb));
        p0 = __builtin_amdgcn_mfma_f32_32x32x16_bf16(b0, qr[d0], p0, 0, 0, 0); p1 = __builtin_amdgcn_mfma_f32_32x32x16_bf16(b1, qr[d0], p1, 0, 0, 0); }
#pragma unroll
    for (int d0 = 0; d0 < 4; ++d0) { const int cb = (d0 * 16 + hi * 8) * 2;
        const bf16x8 b0 = *(const LAS bf16x8*)(Kp + KPSWZ(r32, cb)); const bf16x8 b1 = *(const LAS bf16x8*)(Kp + KPSWZ(32 + r32, cb));
        const bf16x8 q = *(const LAS bf16x8*)(qp + d0 * 1024);
        p0 = __builtin_amdgcn_mfma_f32_32x32x16_bf16(b0, q, p0, 0, 0, 0); p1 = __builtin_amdgcn_mfma_f32_32x32x16_bf16(b1, q, p1, 0, 0, 0); }
}
__device__ __forceinline__ int v_st(int k, int c) { const int kk = (k & ~0xC) | ((k & 4) << 1) | ((k & 8) >> 1); return ((kk >> 3) * 4 + (c >> 5)) * 512 + ((kk & 7) * 32 + (c & 31)) * 2; }
__device__ __forceinline__ int v_rd_base(int lane) { return ((lane & 3) << 3) | (((lane >> 2) & 3) << 6) | (((lane >> 4) & 1) << 5) | (((lane >> 5) & 1) << 8); }
constexpr int v_rd_off(int d0, int ks, int half) { return d0 * 512 + ks * 4096 + half * 2048; }
template <int D0> __device__ __forceinline__ void mla_pv_one(f32x16& od, const LAS char* vb, bf16x8 pa0, bf16x8 pa1, bf16x8 pa2, bf16x8 pa3) {
    const s16x4 l0 = vtr(vb + v_rd_off(D0, 0, 0)), h0 = vtr(vb + v_rd_off(D0, 0, 1)), l1 = vtr(vb + v_rd_off(D0, 1, 0)), h1 = vtr(vb + v_rd_off(D0, 1, 1));
    const s16x4 l2 = vtr(vb + v_rd_off(D0, 2, 0)), h2 = vtr(vb + v_rd_off(D0, 2, 1)), l3 = vtr(vb + v_rd_off(D0, 3, 0)), h3 = vtr(vb + v_rd_off(D0, 3, 1));
#define PKV(L, H) (bf16x8){L[0], L[1], L[2], L[3], H[0], H[1], H[2], H[3]}
    od = __builtin_amdgcn_mfma_f32_32x32x16_bf16(pa0, PKV(l0, h0), od, 0, 0, 0);
    od = __builtin_amdgcn_mfma_f32_32x32x16_bf16(pa1, PKV(l1, h1), od, 0, 0, 0);
    od = __builtin_amdgcn_mfma_f32_32x32x16_bf16(pa2, PKV(l2, h2), od, 0, 0, 0);
    od = __builtin_amdgcn_mfma_f32_32x32x16_bf16(pa3, PKV(l3, h3), od, 0, 0, 0);
#undef PKV
}
__device__ __forceinline__ void mla_pv(f32x16* o, const LAS char* vb, bf16x8 pa0, bf16x8 pa1, bf16x8 pa2, bf16x8 pa3) {
    mla_pv_one<0>(o[0], vb, pa0, pa1, pa2, pa3); mla_pv_one<1>(o[1], vb, pa0, pa1, pa2, pa3); mla_pv_one<2>(o[2], vb, pa0, pa1, pa2, pa3); mla_pv_one<3>(o[3], vb, pa0, pa1, pa2, pa3);
}
__device__ __forceinline__ void mla_unit(const Params& p, LAS char* lds, int u) {
    const int tid = threadIdx.x, wid = __builtin_amdgcn_readfirstlane(tid >> 6), lane = tid & 63, r32 = lane & 31, hi = lane >> 5;
    const int bh = u >> 4, qb = u & 15, b = bh >> 3, h = bh & 7;
    const bf16_t* QB = (const bf16_t*)(p.ws + WS_QB); const bf16_t* KVB = (const bf16_t*)(p.ws + WS_KVB); const bf16_t* KPE = (const bf16_t*)(p.ws + WS_KPE);
    const bf16_t* Kh = KVB + (size_t)b * SEQ * 2048 + h * 256;
    const bf16_t* Ph = KPE + (size_t)b * SEQ * 64;
    LAS float* wsf = (LAS float*)(lds + MB_WS) + wid * 64; LAS float* li_l = wsf; LAS float* al_l = wsf + 32;
    float m_reg = -1e30f, l_reg = 0; f32x16 o[4] = {}; bf16x8 qr[8];
    LAS char* qp = lds + MB_QP + wid * 4096 + lane * 16;
    { const bf16_t* Qw = QB + ((size_t)(b * SEQ + qb * 256 + wid * 32 + r32)) * 1536 + h * 192 + hi * 8;
#pragma unroll
      for (int d0 = 0; d0 < 8; ++d0) qr[d0] = *(const bf16x8*)(Qw + d0 * 16);
      __syncthreads();
#pragma unroll
      for (int d0 = 0; d0 < 4; ++d0) *(LAS bf16x8*)(qp + d0 * 1024) = *(const bf16x8*)(Qw + (8 + d0) * 16); }
    const int sr = tid >> 4, sc = (tid & 15) * 8, vst0 = v_st(sr, sc), vst1 = v_st(32 + sr, sc);
    const int pr = tid >> 3, pc = (tid & 7) * 8;
    const LAS char* vb0 = lds + MB_V + v_rd_base(lane);
    bf16x8 vs0, vs1, ks0, ks1, kp0;
#define SLOAD(k0) do { vs0 = *(const bf16x8*)(Kh + (size_t)((k0) + sr) * 2048 + 128 + sc); vs1 = *(const bf16x8*)(Kh + (size_t)((k0) + 32 + sr) * 2048 + 128 + sc); \
    ks0 = *(const bf16x8*)(Kh + (size_t)((k0) + sr) * 2048 + sc); ks1 = *(const bf16x8*)(Kh + (size_t)((k0) + 32 + sr) * 2048 + sc); \
    kp0 = *(const bf16x8*)(Ph + (size_t)((k0) + pr) * 64 + pc); } while (0)
#define SWRITE(bb) do { *(LAS bf16x8*)(lds + MB_V + (bb) * 16384 + vst0) = vs0; *(LAS bf16x8*)(lds + MB_V + (bb) * 16384 + vst1) = vs1; \
    *(LAS bf16x8*)(lds + MB_KN + (bb) * 16384 + KSWZ(sr, sc * 2)) = ks0; *(LAS bf16x8*)(lds + MB_KN + (bb) * 16384 + KSWZ(32 + sr, sc * 2)) = ks1; \
    *(LAS bf16x8*)(lds + MB_KP + (bb) * 8192 + KPSWZ(pr, pc * 2)) = kp0; } while (0)
#define RESC(a) do { if (__any((a) < 1.f)) { if (hi == 0) al_l[r32] = (a); WAIT_L0(); \
    _Pragma("unroll") for (int d = 0; d < 4; ++d) _Pragma("unroll") for (int r = 0; r < 16; ++r) o[d][r] *= al_l[crow(r, hi)]; } } while (0)
    f32x16 pA0, pA1, pB0, pB1; float mnA, mnB, alA, alB; bf16x8 pa0, pa1, pa2, pa3; constexpr int NT = SEQ / 64;
    SLOAD(0); SWRITE(0); __syncthreads();
    mla_qkt(pA0, pA1, lds + MB_KN, lds + MB_KP, qr, qp, r32, hi); mla_partialSM(pA0, pA1, m_reg, mnA, alA);
    SLOAD(64); SWRITE(1); __syncthreads();
    for (int j = 1; j + 1 < NT; j += 2) {
        SBAR(); mla_qkt(pB0, pB1, lds + MB_KN + 16384, lds + MB_KP + 8192, qr, qp, r32, hi);
        mla_finishSM(pA0, pA1, alA, l_reg, pa0, pa1, pa2, pa3); SBAR();
        SLOAD((j + 1) * 64); SBAR();
        mla_pv(o, vb0, pa0, pa1, pa2, pa3); mla_partialSM(pB0, pB1, m_reg, mnB, alB);
        __syncthreads(); SWRITE(0);
        RESC(alB); __syncthreads();
        SBAR(); mla_qkt(pA0, pA1, lds + MB_KN, lds + MB_KP, qr, qp, r32, hi);
        mla_finishSM(pB0, pB1, alB, l_reg, pa0, pa1, pa2, pa3); SBAR();
        SLOAD((j + 2) * 64); SBAR();
        mla_pv(o, vb0 + 16384, pa0, pa1, pa2, pa3); mla_partialSM(pA0, pA1, m_reg, mnA, alA);
        __syncthreads(); SWRITE(1);
        RESC(alA); __syncthreads();
    }
    SBAR(); mla_qkt(pB0, pB1, lds + MB_KN + 16384, lds + MB_KP + 8192, qr, qp, r32, hi);
    mla_finishSM(pA0, pA1, alA, l_reg, pa0, pa1, pa2, pa3); SBAR();
    mla_pv(o, vb0, pa0, pa1, pa2, pa3); mla_partialSM(pB0, pB1, m_reg, mnB, alB);
    __syncthreads(); RESC(alB);
    mla_finishSM(pB0, pB1, alB, l_reg, pa0, pa1, pa2, pa3); SBAR();
    mla_pv(o, vb0 + 16384, pa0, pa1, pa2, pa3);
    if (hi == 0) li_l[r32] = l_reg; WAIT_L0();
    bf16_t* Y = (bf16_t*)(p.ws + WS_Y); float* ssqb = (float*)(p.ws + WS_SSQP);
    const float* gb = p.out_norm_b + h * 128;
    float g[4];
#pragma unroll
    for (int d0 = 0; d0 < 4; ++d0) g[d0] = gb[d0 * 32 + r32];
#pragma unroll
    for (int r = 0; r < 16; ++r) { const int orow = crow(r, hi); const float il = __builtin_amdgcn_rcpf(li_l[orow]);
        const size_t tok = (size_t)(b * SEQ + qb * 256 + wid * 32 + orow); bf16_t* yp = Y + tok * 2048 + 1024 + h * 128; float ss = 0.f;
#pragma unroll
        for (int d0 = 0; d0 < 4; ++d0) { const float v = o[d0][r] * il; ss += v * v; yp[d0 * 32 + r32] = (bf16_t)(pk_bf16(v * g[d0], 0.f) & 0xffffu); }
#pragma unroll
        for (int s = 16; s >= 1; s >>= 1) ss += __shfl_xor(ss, s, 64);
        if (r32 == 0) ssqb[tok * 24 + 16 + h] = ss; }
#undef SLOAD
#undef SWRITE
#undef RESC
}

__device__ __forceinline__ void phase_router(const Params& p, LAS char* lds) {
    const int tid = threadIdx.x, wid = __builtin_amdgcn_readfirstlane(tid >> 6), lane = tid & 63;
    const float* x2 = (const float*)(p.ws + WS_X2); const float* wg = (const float*)(p.ws + WS_WRT);
    unsigned char* xn8 = p.ws + WS_XN; unsigned* cnt = (unsigned*)(p.ws + WS_CTL + CTL_CNT);
    int* tokl = (int*)(p.ws + WS_TOKL); int* sel_e = (int*)(p.ws + WS_SEL); int* sel_r = sel_e + NTOK * 4; float* sel_g = (float*)(sel_r + NTOK * 4);
    LAS float* part = (LAS float*)lds;
    LAS float* rsv = (LAS float*)(lds + 32768);
    LAS unsigned* hist = (LAS unsigned*)(lds + 32768 + 128); LAS unsigned* hbase = hist + 32;
    for (int t0 = blockIdx.x * 32; t0 < NTOK; t0 += gridDim.x * 32) {
        __syncthreads();
        if (tid < N_EXP) hist[tid] = 0u;
#pragma unroll 1
        for (int j = 0; j < 4; ++j) { const int t = t0 + 4 * wid + j; f32x4 xr[8]; float ss = 0.f;
#pragma unroll
            for (int i = 0; i < 8; ++i) { xr[i] = ((const f32x4*)(x2 + (size_t)t * D_MODEL))[lane + 64 * i]; ss += xr[i][0] * xr[i][0] + xr[i][1] * xr[i][1] + xr[i][2] * xr[i][2] + xr[i][3] * xr[i][3]; }
            const float rs = rsqrtf(wave_sum(ss) * (1.f / D_MODEL) + EPS);
            if (lane == 0) rsv[4 * wid + j] = rs;
#pragma unroll
            for (int i = 0; i < 8; ++i) { const f32x4 v = xr[i]; const f32x4 g = ((const f32x4*)p.mlp_norm)[lane + 64 * i]; const float s16 = 16.f * rs;
                *(unsigned*)(xn8 + (size_t)t * D_MODEL + 4 * (lane + 64 * i)) = pk4_fp8(s16 * v[0] * g[0], s16 * v[1] * g[1], s16 * v[2] * g[2], s16 * v[3] * g[3]); } }
        { f32x16 acc;
#pragma unroll
          for (int r = 0; r < 16; ++r) acc[r] = 0.f;
          const float* ap = x2 + (size_t)(t0 + (lane & 31)) * D_MODEL + 256 * wid + 4 * (lane >> 5);
          const float* bp = wg + (size_t)(256 * wid + 4 * (lane >> 5)) * N_EXP + (lane & 31);
#pragma unroll 4
          for (int c = 0; c < 32; ++c) { const f32x4 a4 = *(const f32x4*)(ap + 8 * c);
#pragma unroll
              for (int q = 0; q < 4; ++q) acc = __builtin_amdgcn_mfma_f32_32x32x2f32(a4[q], bp[(size_t)(8 * c + q) * N_EXP], acc, 0, 0, 0); }
#pragma unroll
          for (int r = 0; r < 16; ++r) part[wid * 1024 + crow(r, lane >> 5) * 32 + (lane & 31)] = acc[r]; }
        __syncthreads();
        int my_e[4]; unsigned my_lr[4]; float my_g[4];
#pragma unroll
        for (int j = 0; j < 4; ++j) { const int tl = 4 * wid + j;
            float v = -3.0e38f;
            if (lane < 32) { float s = 0.f;
#pragma unroll
                for (int w = 0; w < 8; ++w) s += part[w * 1024 + tl * 32 + lane];
                v = s * rsv[tl] + p.b_router[lane]; }
            float tv[4]; int ti[4];
#pragma unroll
            for (int r = 0; r < 4; ++r) {
                float bv = v; int bi = lane;
#pragma unroll
                for (int o = 32; o >= 1; o >>= 1) { const float ov = __shfl_xor(bv, o, 64); const int oi = __shfl_xor(bi, o, 64); if (ov > bv || (ov == bv && oi < bi)) { bv = ov; bi = oi; } }
                tv[r] = bv; ti[r] = bi; if (lane == bi) v = -3.0e38f;
            }
            const float e0 = 1.f, e1 = __expf(tv[1] - tv[0]), e2 = __expf(tv[2] - tv[0]), e3 = __expf(tv[3] - tv[0]); const float inv = 1.f / (e0 + e1 + e2 + e3);
            const float gts[4] = {e0 * inv, e1 * inv, e2 * inv, e3 * inv};
            my_e[j] = ti[lane & 3]; my_g[j] = gts[lane & 3]; my_lr[j] = 0u;
            if (lane < 4) my_lr[j] = __hip_atomic_fetch_add(hist + my_e[j], 1u, __ATOMIC_RELAXED, __HIP_MEMORY_SCOPE_WORKGROUP);
        }
        __syncthreads();
        if (tid < N_EXP) hbase[tid] = atomicAdd(cnt + tid * 16, hist[tid]);
        __syncthreads();
        if (lane < 4) {
#pragma unroll
            for (int j = 0; j < 4; ++j) { const int t = t0 + 4 * wid + j; const int e = my_e[j]; const unsigned rk = hbase[e] + my_lr[j];
                tokl[e * NTOK + rk] = t; sel_e[t * 4 + lane] = e; sel_r[t * 4 + lane] = (int)rk; sel_g[t * 4 + lane] = my_g[j]; }
        }
    }
}

__device__ __forceinline__ void phase_combine(const Params& p, const LAS int* s_roff) {
    const int tid = threadIdx.x, wid = tid >> 6, lane = tid & 63;
    const float* x2 = (const float*)(p.ws + WS_X2); const bf16_t* ys = (const bf16_t*)(p.ws + WS_YS);
    const int* sel_e = (const int*)(p.ws + WS_SEL); const int* sel_r = sel_e + NTOK * 4; const float* sel_g = (const float*)(sel_r + NTOK * 4);
    for (int t = blockIdx.x * 8 + wid; t < NTOK; t += gridDim.x * 8) {
        f32x4 v[8];
#pragma unroll
        for (int i = 0; i < 8; ++i) v[i] = ((const f32x4*)(x2 + (size_t)t * D_MODEL))[lane + 64 * i];
#pragma unroll
        for (int k = 0; k < 4; ++k) { const int e = sel_e[t * 4 + k]; const size_t slot = (size_t)(s_roff[e] + sel_r[t * 4 + k]); const float g = sel_g[t * 4 + k];
            const u32x2* yr = (const u32x2*)(ys + slot * D_MODEL);
#pragma unroll
            for (int i = 0; i < 8; ++i) { const u32x2 w = yr[lane + 64 * i]; v[i][0] += g * bf_lo(w[0]); v[i][1] += g * bf_hi(w[0]); v[i][2] += g * bf_lo(w[1]); v[i][3] += g * bf_hi(w[1]); } }
        float ss = 0.f;
#pragma unroll
        for (int i = 0; i < 8; ++i) ss += v[i][0] * v[i][0] + v[i][1] * v[i][1] + v[i][2] * v[i][2] + v[i][3] * v[i][3];
        ss = wave_sum(ss); const float rs = rsqrtf(ss * (1.f / D_MODEL) + EPS);
#pragma unroll
        for (int i = 0; i < 8; ++i) { const f32x4 g = ((const f32x4*)p.final_norm)[lane + 64 * i];
            ((f32x4*)(p.out + (size_t)t * D_MODEL))[lane + 64 * i] = (f32x4){v[i][0] * rs * g[0], v[i][1] * rs * g[1], v[i][2] * rs * g[2], v[i][3] * rs * g[3]}; }
    }
}

constexpr int NPHASE = 9;
__global__ void __launch_bounds__(512, 2) mega_fwd(Params p) {
    extern __shared__ __attribute__((aligned(1024))) char smem_raw[];
    LAS char* lds = (LAS char*)smem_raw;
    LAS unsigned* misc = (LAS unsigned*)(lds + LDS_MISC);
    const int tid = threadIdx.x;
    if (tid < 4) misc[tid] = 0u;
    __syncthreads();
    unsigned* bar = (unsigned*)(p.ws + WS_CTL + CTL_BAR);
    XcdBarrier xb = xcd_barrier_post(bar, (volatile LAS unsigned*)misc);
    const int lo = p.ph_lo, hi = p.ph_hi;
    const int G = gridDim.x, bid = blockIdx.x;
    const int xperm = (bid & 7) * (G >> 3) + (bid >> 3);
#ifdef PH_ONLY
#define IN(k) ((k)==PH_ONLY)
#else
#define IN(k) (lo <= (k) && (k) < hi)
#endif
#define SEAM(k) do { if (IN(k) && IN((k) + 1)) xcd_barrier(xb); } while (0)
    if (IN(0)) phase_prologue(p);
    SEAM(0);
    if (IN(1)) {
        for (int u = xperm; u < 32 * 8; u += G) {
            const int pn = u / 32, pm = u % 32;
            PEpiProj ep{pn, pm * 256, p.ws, p.b_q_norm, p.b_kv_norm};
            __syncthreads();
            gemm_unit_pg<false>(lds, (const bf16_t*)(p.ws + WS_XN) + (size_t)pm * 256 * D_MODEL, (const bf16_t*)(p.ws + WS_BT_IN) + (size_t)pn * 256 * D_MODEL, D_MODEL, ep);
        }
    }
    SEAM(1);
    if (IN(2)) {
        unsigned* rdy = (unsigned*)(p.ws + WS_CTL + CTL_RDY);
        { const int b0 = bid;
            int qv;
            if ((b0 & 3) == 0) {
                const int h = b0 >> 2, pn = 8 + (h >> 5), pm = h & 31;
                PEpiProj ep{pn, pm * 256, p.ws, p.b_q_norm, p.b_kv_norm};
                __syncthreads();
                gemm_unit_pg<false>(lds, (const bf16_t*)(p.ws + WS_XN) + (size_t)pm * 256 * D_MODEL, (const bf16_t*)(p.ws + WS_BT_IN) + (size_t)pn * 256 * D_MODEL, D_MODEL, ep);
                if (pn == 8) {
                    asm volatile("s_waitcnt vmcnt(0)" ::: "memory");
                    __syncthreads();
                    if (tid == 0) { __builtin_amdgcn_fence(__ATOMIC_RELEASE, "agent"); asm volatile("s_waitcnt vmcnt(0)" ::: "memory"); (void)xb_add(rdy + pm * 16, 1u); }
                }
                qv = 128 + h;
            } else {
                const int v = (b0 >> 2) * 3 + (b0 & 3) - 1;
                if (v < 128) {
                    attn_a_unit(p, lds, v); qv = v;
                    pg_convert(p.w_o, D_MODEL, D_MODEL, D_MODEL, 2048, (bf16_t*)(p.ws + WS_BT_WO), v * 1024 + tid, 128 * 1024);
                    pg_convert(p.w_o, D_MODEL, D_MODEL, D_MODEL, 2048, (bf16_t*)(p.ws + WS_BT_WO), v * 1024 + 512 + tid, 128 * 1024);
                } else {
                    const int w = v - 128; qv = -1;
                    attn_a_unit(p, lds, 128 + 2 * w); attn_a_unit(p, lds, 129 + 2 * w);
                }
            }
            if (qv >= 0) { const int pn = qv / 32, pm = qv % 32;
                PEpiQUp ep{pn, pm * 256, p.ws};
                __syncthreads();
                gemm_unit_pg<false>(lds, (const bf16_t*)(p.ws + WS_CQ) + (size_t)pm * 256 * 512, (const bf16_t*)(p.ws + WS_BT_UQ) + (size_t)pn * 256 * 512, 512, ep);
                __syncthreads(); }
        }
        for (int u = xperm; u < 32 * 8; u += G) {
            const int pn = u / 32, pm = u % 32;
            PEpiKvUp ep{pn, pm * 256, p.ws};
            __syncthreads();
            if (tid == 0) { XB_SPIN(xb_ld(rdy + pm * 16) == 0u, bar); __builtin_amdgcn_fence(__ATOMIC_ACQUIRE, "agent"); asm volatile("s_waitcnt vmcnt(0)" ::: "memory"); }
            __syncthreads();
            gemm_unit_pg<false>(lds, (const bf16_t*)(p.ws + WS_CKV) + (size_t)pm * 256 * 256, (const bf16_t*)(p.ws + WS_BT_UKV) + (size_t)pn * 256 * 256, 256, ep);
        }
    }
    SEAM(2);
    if (IN(3)) { for (int u = xperm; u < 256; u += G) mla_unit(p, lds, u); }
    SEAM(3);
    if (IN(4)) {
        __syncthreads();
        for (int u = xperm; u < 32 * 8; u += G) {
            const int pn = u / 32, pm = u % 32;
            LAS float* tab = (LAS float*)(lds + 2 * G_STAGE_B);
            __syncthreads();
            if (tid < 256) { const f32x4* pp = (const f32x4*)((const float*)(p.ws + WS_SSQP) + (size_t)(pm * 256 + tid) * 24); float sa = 0.f, sb2 = 0.f;
#pragma unroll
                for (int q = 0; q < 4; ++q) { const f32x4 v = pp[q]; sa += (v[0] + v[1]) + (v[2] + v[3]); }
#pragma unroll
                for (int q = 4; q < 6; ++q) { const f32x4 v = pp[q]; sb2 += (v[0] + v[1]) + (v[2] + v[3]); }
                tab[tid] = sa * (1.f / 1024.f); tab[256 + tid] = sb2 * (1.f / 1024.f); }
            __syncthreads();
            PEpiWo ep{pn, pm * 256, p.ws, p.x, tab};
            gemm_unit_pg<true>(lds, (const bf16_t*)(p.ws + WS_Y) + (size_t)pm * 256 * D_MODEL, (const bf16_t*)(p.ws + WS_BT_WO) + (size_t)pn * 256 * D_MODEL, D_MODEL, ep);
        }
    }
    SEAM(4);
    if (IN(5)) phase_router(p, lds);
    SEAM(5);
    LAS int* s_cnt = (LAS int*)(misc + 16); LAS int* s_toff = (LAS int*)(misc + 48); LAS int* s_roff = (LAS int*)(misc + 96);
    if (IN(6) || IN(7) || IN(8)) {
        if (tid == 0) { const unsigned* cnt = (const unsigned*)(p.ws + WS_CTL + CTL_CNT); int to = 0;
            for (int e = 0; e < N_EXP; ++e) { const int c = (int)xb_ld((unsigned*)cnt + e * 16); s_cnt[e] = c; s_toff[e] = to; s_roff[e] = to * 256; to += (c + 255) >> 8; }
            s_toff[N_EXP] = to; }
        __syncthreads();
    }
    if (IN(6)) {
        const int TM = s_toff[N_EXP];
        const int T16 = TM * 16, NF = (T16 & ~255), R = T16 - NF;
        const bool halves = R > 0 && R <= 128;
        int round = 0;
        for (int L = xperm; L < (halves ? NF : T16); L += G, ++round) {
            if (round == ((xperm >> 3) & 7))
                conv_image(p.w_down + (size_t)(xperm >> 3) * D_FF * D_MODEL + (xperm & 7) * 256, (size_t)D_MODEL, p.ws + WS_IMG_DN + (size_t)xperm * 32 * 16384, 0, 32);
            int e = 0; while (s_toff[e + 1] * 16 <= L) ++e;
            const int w = L - s_toff[e] * 16, nte = s_toff[e + 1] - s_toff[e], ntile = w / nte, mt = w - ntile * nte, cntE = s_cnt[e];
            AGather8 af{p.ws + WS_XN, (const int*)(p.ws + WS_TOKL) + (size_t)e * NTOK, mt * 256, cntE};
            BGateUp bf{p.w_up + (size_t)e * D_MODEL * (2 * D_FF) + ntile * 128, (size_t)(2 * D_FF)};
            EpiUp8 ep{ntile * 128, mt * 256, cntE, p.ws + WS_ACT + ((size_t)s_roff[e] + mt * 256) * D_FF, p.b_up + (size_t)e * (2 * D_FF)};
            gemm_unit8<0x7B7B7B7B>(lds, (LAS unsigned*)(misc + 8), D_MODEL / 64, af, bf, ep);
        }
        if (round <= ((xperm >> 3) & 7))
            conv_image(p.w_down + (size_t)(xperm >> 3) * D_FF * D_MODEL + (xperm & 7) * 256, (size_t)D_MODEL, p.ws + WS_IMG_DN + (size_t)xperm * 32 * 16384, 0, 32);
        if (halves && xperm < 2 * R) {
            const int L = NF + (xperm >> 1), hf = xperm & 1;
            int e = 0; while (s_toff[e + 1] * 16 <= L) ++e;
            const int w = L - s_toff[e] * 16, nte = s_toff[e + 1] - s_toff[e], ntile = w / nte, mt = w - ntile * nte, cntE = s_cnt[e];
            AGather8 af{p.ws + WS_XN, (const int*)(p.ws + WS_TOKL) + (size_t)e * NTOK, mt * 256, cntE};
            BGateUp bf{p.w_up + (size_t)e * D_MODEL * (2 * D_FF) + ntile * 128 + hf * 64, (size_t)(2 * D_FF)};
            EpiUp8q ep{ntile * 128 + hf * 64, mt * 256, cntE, p.ws + WS_ACT + ((size_t)s_roff[e] + mt * 256) * D_FF, p.b_up + (size_t)e * (2 * D_FF)};
            gemm_unit8q<0x7B7B7B7B>(lds, (LAS unsigned*)(misc + 8), D_MODEL / 64, af, bf, ep);
        }
    }
    SEAM(6);
    if (IN(7)) {
        const int TM = s_toff[N_EXP];
        const int T8 = TM * 8, NF = T8 & ~255, R = T8 - NF;
        const bool halves = R > 0 && R <= 128;
        for (int L = xperm; L < (halves ? NF : T8); L += G) {
            int e = 0; while (s_toff[e + 1] * 8 <= L) ++e;
            const int w = L - s_toff[e] * 8, nte = s_toff[e + 1] - s_toff[e], ntile = w / nte, mt = w - ntile * nte, cntE = s_cnt[e];
            ARows8 af{p.ws + WS_ACT + ((size_t)s_roff[e] + mt * 256) * D_FF, (unsigned)D_FF};
            EpiDown8 ep{ntile * 256, mt * 256, cntE, (bf16_t*)(p.ws + WS_YS) + ((size_t)s_roff[e] + mt * 256) * D_MODEL, p.b_down + (size_t)e * D_MODEL};
            gemm_unit8b<0x7D7D7D7D>(lds, (LAS unsigned*)(misc + 8), D_FF / 64, af, p.ws + WS_IMG_DN + (size_t)(e * 8 + ntile) * 32 * 16384, ep);
        }
        if (halves && xperm < 2 * R) {
            const int L = NF + (xperm >> 1), hf = xperm & 1;
            int e = 0; while (s_toff[e + 1] * 8 <= L) ++e;
            const int w = L - s_toff[e] * 8, nte = s_toff[e + 1] - s_toff[e], ntile = w / nte, mt = w - ntile * nte, cntE = s_cnt[e];
            ARows8 af{p.ws + WS_ACT + ((size_t)s_roff[e] + mt * 256) * D_FF, (unsigned)D_FF};
            EpiDown8h ep{ntile * 256 + hf * 128, mt * 256, cntE, (bf16_t*)(p.ws + WS_YS) + ((size_t)s_roff[e] + mt * 256) * D_MODEL, p.b_down + (size_t)e * D_MODEL};
            gemm_unit8bh<0x7D7D7D7D>(lds, (LAS unsigned*)(misc + 8), D_FF / 64, af, p.ws + WS_IMG_DN + (size_t)(e * 8 + ntile) * 32 * 16384, hf, ep);
        }
    }
    SEAM(7);
    if (IN(8)) phase_combine(p, s_roff);
}

extern "C" void kernel_launch(void* const* d_in, const int* in_sizes, int n_in, void* d_out, int out_size, void* d_ws, size_t ws_size, hipStream_t stream) {
    static int ready = 0;
    if (!ready) {
        if (hipFuncSetAttribute((const void*)mega_fwd, hipFuncAttributeMaxDynamicSharedMemorySize, LDS_BYTES) != hipSuccess) { fprintf(stderr, "kernel_launch: hipFuncSetAttribute failed\n"); return; }
        int per_cu = 0; hipOccupancyMaxActiveBlocksPerMultiprocessor(&per_cu, (const void*)mega_fwd, 512, LDS_BYTES);
        if (per_cu < 1) { fprintf(stderr, "kernel_launch: occupancy query says 0 blocks per CU\n"); return; }
        ready = 1;
    }
    if (ws_size < WS_END) { fprintf(stderr, "kernel_launch: workspace too small\n"); return; }
    hipMemsetAsync((unsigned char*)d_ws + WS_CTL, 0, CTL_BYTES, stream);
    Params p{};
    const float** f = (const float**)&p;
    for (int i = 0; i < 19; ++i) f[i] = (const float*)d_in[i];
    p.out = (float*)d_out; p.ws = (unsigned char*)d_ws; p.ph_lo = 0; p.ph_hi = NPHASE;
    hipLaunchKernelGGL(mega_fwd, dim3(256), dim3(512), LDS_BYTES, stream, p);
}
```
